# Optimizing an MI355X kernel written in HIP

```python
import math
import numpy as np
import jax
import jax.numpy as jnp
from jax import lax


D_MODEL = 2048
BATCH = 1
SEQ = 16384
DEPTH = 2

HEAD_DIM = 128
N_HEADS_NSA = 8
N_KV_NSA = 2
N_HEADS_MOBA = 8
NSA_WIDTH = N_HEADS_NSA * HEAD_DIM
NSA_KV_WIDTH = N_KV_NSA * HEAD_DIM
MOBA_WIDTH = N_HEADS_MOBA * HEAD_DIM
MIX_WIDTH = NSA_WIDTH + MOBA_WIDTH
IN_SPLITS = [NSA_WIDTH] + [NSA_KV_WIDTH] * 6 + [3 * N_HEADS_NSA] + [MOBA_WIDTH] * 3
IN_WIDTH = sum(IN_SPLITS)
ROPE_THETA = 10000.0
CMP_LEN = 32
CMP_STRIDE = 16
CMP_HIDDEN = 256
SLC_BLOCK = 64
SLC_TOPN = 16
WINDOW = 512
MOBA_BLOCK = 256
MOBA_TOPK = 3
Q_CHUNK = 64
N_EXPERTS = 32
N_GROUPS = 4
EXPERTS_PER_GROUP = N_EXPERTS // N_GROUPS
TOP_K_EXPERTS = 2
D_EXPERT = 512
MOE_BLOCK = 128
RMS_EPS = 1e-6
NEG_INF = -1e30
FORCE = 1e9
F32 = jnp.float32

kernel_name = 'hybrid_nsa_moba_grouped_moe_adaln'


def rms_norm(x, g):
    x32 = x.astype(F32)
    y = x32 * lax.rsqrt(jnp.mean(x32 * x32, axis=-1, keepdims=True) + RMS_EPS)
    return (y * g.astype(F32)).astype(x.dtype)


def rope_tables(pos):
    inv = 1.0 / (ROPE_THETA ** (jnp.arange(0, HEAD_DIM, 2, dtype=F32) / HEAD_DIM))
    ang = pos.astype(F32)[:, None] * inv[None, :]
    ang = jnp.concatenate([ang, ang], axis=-1)
    return jnp.cos(ang), jnp.sin(ang)


def apply_rope(x, cos, sin):
    x32 = x.astype(F32)
    x1, x2 = jnp.split(x32, 2, axis=-1)
    rot = jnp.concatenate([-x2, x1], axis=-1)
    return (x32 * cos[:, None, :] + rot * sin[:, None, :]).astype(x.dtype)


def masked_softmax(s, mask):
    s = jnp.where(mask, s.astype(F32), NEG_INF)
    p = jax.nn.softmax(s, axis=-1)
    return jnp.where(mask, p, 0.0)


def compress(raw, pe, w1, b1, w2):
    S, G, Dh = raw.shape
    ch = raw.reshape(S // CMP_STRIDE, CMP_STRIDE, G, Dh)
    blocks = jnp.concatenate([ch[:-1], ch[1:]], axis=1) + pe[None, :, None, :]
    flat = blocks.transpose(0, 2, 1, 3).reshape(blocks.shape[0], G, CMP_LEN * Dh)
    return jax.nn.gelu(flat @ w1 + b1) @ w2


def nsa_attention(q, k_cmp, v_cmp, k_slc, v_slc, k_win, v_win, gates):
    S = q.shape[0]
    G, R = N_KV_NSA, N_HEADS_NSA // N_KV_NSA
    nc = k_cmp.shape[0]
    nsb = S // SLC_BLOCK
    topn = min(SLC_TOPN, nsb)
    scale = HEAD_DIM ** -0.5
    cmp_start = jnp.arange(nc) * CMP_STRIDE
    cmp_end = cmp_start + CMP_LEN - 1
    slc_start = jnp.arange(nsb) * SLC_BLOCK
    overlap = ((cmp_end[:, None] >= slc_start[None, :]) &
               (cmp_start[:, None] < slc_start[None, :] + SLC_BLOCK)).astype(F32)
    kb = k_slc.reshape(nsb, SLC_BLOCK, G, HEAD_DIM).transpose(2, 0, 1, 3)
    vb = v_slc.reshape(nsb, SLC_BLOCK, G, HEAD_DIM).transpose(2, 0, 1, 3)
    kw = jnp.pad(k_win, ((WINDOW, 0), (0, 0), (0, 0)))
    vw = jnp.pad(v_win, ((WINDOW, 0), (0, 0), (0, 0)))
    g_idx = jnp.arange(G)[None, :, None]

    def chunk(ci):
        c0 = ci * Q_CHUNK
        t = c0 + jnp.arange(Q_CHUNK)
        qc = lax.dynamic_slice_in_dim(q, c0, Q_CHUNK, 0).reshape(Q_CHUNK, G, R, HEAD_DIM) * scale
        gc = jax.nn.sigmoid(lax.dynamic_slice_in_dim(gates, c0, Q_CHUNK, 0).astype(F32)).reshape(Q_CHUNK, G, R, 3)
        s = jnp.einsum('qgrd,cgd->qgrc', qc, k_cmp)
        m = (cmp_end[None, :] <= t[:, None])[:, None, None, :]
        p_cmp = masked_softmax(s, m)
        o_cmp = jnp.einsum('qgrc,cgd->qgrd', p_cmp.astype(v_cmp.dtype), v_cmp)
        imp = jnp.einsum('qgrc,cj->qgj', p_cmp, overlap)
        jblk = jnp.arange(nsb)[None, None, :]
        tb = (t // SLC_BLOCK)[:, None, None]
        valid = jblk <= tb
        forced = (jblk == 0) | (jblk == tb) | (jblk == tb - 1)
        imp = jnp.where(valid, jnp.where(forced, FORCE, imp), NEG_INF)
        _, idx = lax.top_k(imp, topn)
        ks = kb[g_idx, idx].reshape(Q_CHUNK, G, topn * SLC_BLOCK, HEAD_DIM)
        vs = vb[g_idx, idx].reshape(Q_CHUNK, G, topn * SLC_BLOCK, HEAD_DIM)
        s = jnp.einsum('qgrd,qgmd->qgrm', qc, ks)
        kpos = (idx[..., None] * SLC_BLOCK + jnp.arange(SLC_BLOCK)).reshape(Q_CHUNK, G, 1, topn * SLC_BLOCK)
        p = masked_softmax(s, kpos <= t[:, None, None, None])
        o_slc = jnp.einsum('qgrm,qgmd->qgrd', p.astype(vs.dtype), vs)
        kwc = lax.dynamic_slice_in_dim(kw, c0, WINDOW + Q_CHUNK, 0)
        vwc = lax.dynamic_slice_in_dim(vw, c0, WINDOW + Q_CHUNK, 0)
        s = jnp.einsum('qgrd,kgd->qgrk', qc, kwc)
        wpos = c0 - WINDOW + jnp.arange(WINDOW + Q_CHUNK)
        m = ((wpos[None, :] <= t[:, None]) & (wpos[None, :] > t[:, None] - WINDOW) & (wpos[None, :] >= 0))[:, None, None, :]
        p = masked_softmax(s, m)
        o_win = jnp.einsum('qgrk,kgd->qgrd', p.astype(vwc.dtype), vwc)
        o = gc[..., 0:1] * o_cmp + gc[..., 1:2] * o_slc + gc[..., 2:3] * o_win
        return o.reshape(Q_CHUNK, NSA_WIDTH).astype(q.dtype)

    return lax.map(chunk, jnp.arange(S // Q_CHUNK)).reshape(S, NSA_WIDTH)


def moba_attention(q, k, v):
    S = q.shape[0]
    H = N_HEADS_MOBA
    nb = -(-S // MOBA_BLOCK)
    topk = min(MOBA_TOPK, nb)
    pad = nb * MOBA_BLOCK - S
    kp = jnp.pad(k, ((0, pad), (0, 0), (0, 0)))
    vp = jnp.pad(v, ((0, pad), (0, 0), (0, 0)))
    kblk = kp.reshape(nb, MOBA_BLOCK, H, HEAD_DIM)
    kmean = jnp.mean(kblk.astype(F32), axis=1).astype(k.dtype)
    kb = kblk.transpose(2, 0, 1, 3)
    vb = vp.reshape(nb, MOBA_BLOCK, H, HEAD_DIM).transpose(2, 0, 1, 3)
    h_idx = jnp.arange(H)[None, :, None]
    scale = HEAD_DIM ** -0.5

    def chunk(ci):
        c0 = ci * Q_CHUNK
        t = c0 + jnp.arange(Q_CHUNK)
        own = c0 // MOBA_BLOCK
        qc = lax.dynamic_slice_in_dim(q, c0, Q_CHUNK, 0) * scale
        gate = jnp.einsum('qhd,nhd->qhn', qc, kmean).astype(F32)
        past = (jnp.arange(nb) < own)[None, None, :]
        _, idx = lax.top_k(jnp.where(past, gate, NEG_INF), topk)
        sel_ok = jnp.broadcast_to((idx < own)[..., None], (Q_CHUNK, H, topk, MOBA_BLOCK)).reshape(Q_CHUNK, H, topk * MOBA_BLOCK)
        ks = kb[h_idx, idx].reshape(Q_CHUNK, H, topk * MOBA_BLOCK, HEAD_DIM)
        vs = vb[h_idx, idx].reshape(Q_CHUNK, H, topk * MOBA_BLOCK, HEAD_DIM)
        s_sel = jnp.einsum('qhd,qhmd->qhm', qc, ks)
        k_own = lax.dynamic_slice_in_dim(kp, own * MOBA_BLOCK, MOBA_BLOCK, 0)
        v_own = lax.dynamic_slice_in_dim(vp, own * MOBA_BLOCK, MOBA_BLOCK, 0)
        s_own = jnp.einsum('qhd,khd->qhk', qc, k_own)
        opos = own * MOBA_BLOCK + jnp.arange(MOBA_BLOCK)
        m_own = jnp.broadcast_to((opos[None, :] <= t[:, None])[:, None, :], s_own.shape)
        p = masked_softmax(jnp.concatenate([s_sel, s_own], axis=-1), jnp.concatenate([sel_ok, m_own], axis=-1))
        p = p.astype(v.dtype)
        n_sel = topk * MOBA_BLOCK
        o = jnp.einsum('qhm,qhmd->qhd', p[..., :n_sel], vs) + jnp.einsum('qhk,khd->qhd', p[..., n_sel:], v_own)
        return o.reshape(Q_CHUNK, MOBA_WIDTH)

    return lax.map(chunk, jnp.arange(S // Q_CHUNK)).reshape(S, MOBA_WIDTH)


def hybrid_mixer(h, w_in, w_out, cmp_pe, cmp_w1, cmp_b1, cmp_w2, cos, sin, cos_c, sin_c):
    B, S, _ = h.shape
    proj = h @ w_in
    offs = list(np.cumsum(IN_SPLITS)[:-1])
    q_n, kc, vc, ks, vs, kw, vw, gts, q_m, k_m, v_m = jnp.split(proj, offs, axis=-1)
    kvshape = (B, S, N_KV_NSA, HEAD_DIM)
    q_n = apply_rope(q_n.reshape(B, S, N_HEADS_NSA, HEAD_DIM), cos, sin)
    ks = apply_rope(ks.reshape(kvshape), cos, sin)
    kw = apply_rope(kw.reshape(kvshape), cos, sin)
    cmp = jax.vmap(compress, in_axes=(0, None, None, None, None))
    k_cmp = apply_rope(cmp(kc.reshape(kvshape), cmp_pe[0], cmp_w1[0], cmp_b1[0], cmp_w2[0]), cos_c, sin_c)
    v_cmp = cmp(vc.reshape(kvshape), cmp_pe[1], cmp_w1[1], cmp_b1[1], cmp_w2[1])
    o_nsa = jax.vmap(nsa_attention)(q_n, k_cmp, v_cmp, ks, vs.reshape(kvshape), kw, vw.reshape(kvshape),
                                    gts.reshape(B, S, N_HEADS_NSA, 3))
    mshape = (B, S, N_HEADS_MOBA, HEAD_DIM)
    o_moba = jax.vmap(moba_attention)(apply_rope(q_m.reshape(mshape), cos, sin),
                                      apply_rope(k_m.reshape(mshape), cos, sin), v_m.reshape(mshape))
    return jnp.concatenate([o_nsa, o_moba], axis=-1) @ w_out


def moe_ffn(h, w_router, b_router, w_gate, w_up, w_down):
    B, S, D = h.shape
    n = B * S
    hf = h.reshape(n, D)
    scores = jax.nn.sigmoid((hf @ w_router).astype(F32))
    biased = (scores + b_router.astype(F32)).reshape(n, N_GROUPS, EXPERTS_PER_GROUP)
    grp = jnp.argmax(lax.top_k(biased, 2)[0].sum(-1), axis=-1)
    in_grp = jnp.take_along_axis(biased, grp[:, None, None], axis=1)[:, 0]
    _, local = lax.top_k(in_grp, TOP_K_EXPERTS)
    expert = grp[:, None] * EXPERTS_PER_GROUP + local
    wsel = jnp.take_along_axis(scores, expert, axis=1)
    wsel = wsel / jnp.sum(wsel, axis=-1, keepdims=True)
    n_pair = n * TOP_K_EXPERTS
    flat_e = expert.reshape(-1)
    flat_t = jnp.repeat(jnp.arange(n, dtype=jnp.int32), TOP_K_EXPERTS)
    order = jnp.argsort(flat_e)
    se, st, sw = flat_e[order], flat_t[order], wsel.reshape(-1)[order]
    counts = jnp.bincount(flat_e, length=N_EXPERTS)
    starts = jnp.cumsum(counts) - counts
    padded = (counts + MOE_BLOCK - 1) // MOE_BLOCK * MOE_BLOCK
    pend = jnp.cumsum(padded)
    pstart = pend - padded
    slot = pstart[se] + jnp.arange(n_pair) - starts[se]
    n_slots = n_pair + N_EXPERTS * MOE_BLOCK
    slot_tok = jnp.zeros((n_slots,), jnp.int32).at[slot].set(st)
    slot_w = jnp.zeros((n_slots,), F32).at[slot].set(sw)
    n_blk = n_slots // MOE_BLOCK
    blk_exp = jnp.minimum(jnp.searchsorted(pend, jnp.arange(n_blk) * MOE_BLOCK, side='right'), N_EXPERTS - 1)

    def run_block(b):
        tok = lax.dynamic_slice_in_dim(slot_tok, b * MOE_BLOCK, MOE_BLOCK)
        wt = lax.dynamic_slice_in_dim(slot_w, b * MOE_BLOCK, MOE_BLOCK)
        e = blk_exp[b]
        xb = hf[tok]
        y = (jax.nn.silu(xb @ w_gate[e]) * (xb @ w_up[e])) @ w_down[e]
        return (y.astype(F32) * wt[:, None]).astype(h.dtype)

    ys = lax.map(run_block, jnp.arange(n_blk))
    out = jnp.zeros((n, D), h.dtype).at[slot_tok].add(ys.reshape(n_slots, D))
    return out.reshape(B, S, D)


def setup_inputs(seed: int = 0) -> dict:
    key = jax.random.key(seed)
    k = jax.random.split(key, 20)

    def nrm(kk, shape, s):
        return jax.random.normal(kk, shape, F32) * s

    return {
        'x': nrm(k[0], (BATCH, SEQ, D_MODEL), 1.0),
        'c': nrm(k[1], (BATCH, D_MODEL), 1.0),
        'w_ada': nrm(k[2], (DEPTH, D_MODEL, 6 * D_MODEL), 0.5 * D_MODEL ** -0.5),
        'b_ada': nrm(k[3], (DEPTH, 6 * D_MODEL), 0.01),
        'g_attn': 1.0 + nrm(k[4], (DEPTH, D_MODEL), 0.02),
        'g_ffn': 1.0 + nrm(k[5], (DEPTH, D_MODEL), 0.02),
        'w_in': nrm(k[6], (DEPTH, D_MODEL, IN_WIDTH), D_MODEL ** -0.5),
        'w_out': nrm(k[7], (DEPTH, MIX_WIDTH, D_MODEL), MIX_WIDTH ** -0.5),
        'cmp_pe': nrm(k[8], (DEPTH, 2, CMP_LEN, HEAD_DIM), 0.1),
        'cmp_w1': nrm(k[9], (DEPTH, 2, CMP_LEN * HEAD_DIM, CMP_HIDDEN), (CMP_LEN * HEAD_DIM) ** -0.5),
        'cmp_b1': nrm(k[10], (DEPTH, 2, CMP_HIDDEN), 0.01),
        'cmp_w2': nrm(k[11], (DEPTH, 2, CMP_HIDDEN, HEAD_DIM), CMP_HIDDEN ** -0.5),
        'w_router': nrm(k[12], (D_MODEL, N_EXPERTS), D_MODEL ** -0.5),
        'b_router': nrm(k[13], (N_EXPERTS,), 0.01),
        'w_gate': nrm(k[14], (DEPTH, N_EXPERTS, D_MODEL, D_EXPERT), D_MODEL ** -0.5),
        'w_up': nrm(k[15], (DEPTH, N_EXPERTS, D_MODEL, D_EXPERT), D_MODEL ** -0.5),
        'w_down': nrm(k[16], (DEPTH, N_EXPERTS, D_EXPERT, D_MODEL), D_EXPERT ** -0.5),
        'g_final': 1.0 + nrm(k[17], (D_MODEL,), 0.02),
    }


def reference(x, c, w_ada, b_ada, g_attn, g_ffn, w_in, w_out, cmp_pe, cmp_w1, cmp_b1, cmp_w2,
              w_router, b_router, w_gate, w_up, w_down, g_final):
    B, S, D = x.shape
    cos, sin = rope_tables(jnp.arange(S))
    nc = S // CMP_STRIDE - 1
    cos_c, sin_c = rope_tables(jnp.arange(nc) * CMP_STRIDE + CMP_LEN - 1)
    cond = jax.nn.silu(c)
    for l in range(DEPTH):
        mod = (cond @ w_ada[l] + b_ada[l])[:, None, :]
        sh1, sc1, gt1, sh2, sc2, gt2 = jnp.split(mod, 6, axis=-1)
        h = rms_norm(x, g_attn[l]) * (1.0 + sc1) + sh1
        x = x + gt1 * hybrid_mixer(h, w_in[l], w_out[l], cmp_pe[l], cmp_w1[l], cmp_b1[l], cmp_w2[l],
                                   cos, sin, cos_c, sin_c)
        h = rms_norm(x, g_ffn[l]) * (1.0 + sc2) + sh2
        x = x + gt2 * moe_ffn(h, w_router, b_router, w_gate[l], w_up[l], w_down[l])
    return rms_norm(x, g_final)
```

```cpp
#include <hip/hip_runtime.h>
#include <cstdio>
#include <cstdint>

namespace pg8 {
#define PG8_LAS __attribute__((address_space(3)))
typedef unsigned short bf16_t;
typedef short bf16x8 __attribute__((ext_vector_type(8)));
typedef float f32x4 __attribute__((ext_vector_type(4)));
typedef unsigned u32x4 __attribute__((ext_vector_type(4)));
constexpr int BM = 256, BK = 64, HALF = 128, HTB = HALF * BK * 2, STAGE_BYTES = 8 * HTB, NXCD = 8, WGM = 8;

__host__ __device__ __forceinline__ int lds_byte(int r, int c) { const int st = (r >> 4) * 2 + (c >> 5), rr = r & 15, cc = c & 31, ob = rr * 64 + cc * 2; return st * 1024 + (ob ^ (((ob >> 9) & 1) << 5)); }
__host__ __device__ __forceinline__ void stage_rc(int b, int& R, int& C) { const int st = b / 1024, sb = b % 1024, swz = sb ^ (((sb >> 9) & 1) << 5); R = (st >> 1) * 16 + swz / 64; C = (st & 1) * 32 + (swz % 64) / 2; }
__host__ __device__ __forceinline__ int perm32(int rho) { const int n = rho >> 4, i = rho & 15; return 8 * (i >> 2) + 4 * n + (i & 3); }

struct Unit { int pm, pn, e, mt, pnl; };
struct Gemm { const bf16_t* A; const bf16_t* Bt; int M, N, K; };

struct StaticOrder {
    static constexpr bool GATHER = false;
    int nM, nN, nwg, G, c;
    __host__ __device__ void init(int M, int N, int G_, int c_) { nM = M / BM; nN = N / BM; nwg = nM * nN; G = G_; c = c_; }
    __host__ __device__ bool next(int i, Unit& u) const {
        const long L = (long)i * G + c; if (L >= nwg) return false;
        int wgid = (int)L; { const int q = nwg / NXCD, r = nwg % NXCD, xcd = wgid % NXCD, off = wgid / NXCD; wgid = (xcd < r ? xcd * (q + 1) : r * (q + 1) + (xcd - r) * q) + off; }
        const int nig = WGM * nN, gid = wgid / nig, fm = gid * WGM, gsz = (nM - fm) < WGM ? (nM - fm) : WGM;
        u.pm = fm + ((wgid % nig) % gsz); u.pn = (wgid % nig) / gsz; u.e = 0; u.mt = 0; u.pnl = u.pn; return true;
    }
    __device__ __forceinline__ void a_offs(const Unit&, int, int, int, int, int, unsigned (&)[2][2]) const {}
    __device__ __forceinline__ void a_ready(const Unit&) const {}
    __device__ __forceinline__ void done(const Unit&) const {}
};

__device__ __forceinline__ unsigned cvt_pk_bf16(float lo, float hi) { unsigned r; asm volatile("v_cvt_pk_bf16_f32 %0, %1, %2" : "=v"(r) : "v"(lo), "v"(hi)); return r; }

template <class Epi, class Sched, bool ALIGN_EPI = false, bool SP2 = false>
__device__ __forceinline__ void gemm_phase(PG8_LAS unsigned char* lds, const Gemm g, const Sched& S, const Epi& E) {
    int tid_ = threadIdx.x; asm volatile("" : "+v"(tid_));
    const int tid = tid_, wid = __builtin_amdgcn_readfirstlane(tid >> 6), lane = tid & 63, wr = wid >> 2, wc = wid & 3, fr = lane & 15, fq = lane >> 4;
    const int K = g.K, nt = K / BK;
    unsigned voffA[2], voffB[2]; int RR[2], CC[2];
#pragma unroll
    for (int i = 0; i < 2; ++i) { int R, C; stage_rc(tid * 16 + i * 8192, R, C); const int Rb = Epi::PERM ? ((R & ~31) + perm32(R & 31)) : R;
        RR[i] = R; CC[i] = C; voffA[i] = (unsigned)(R * K + C) * 2u; voffB[i] = (unsigned)(Rb * K + C) * 2u; }
    const size_t kstep = (size_t)(BK * 2);
    const size_t hstep = (size_t)HALF * K * 2;
    const size_t tstep = 2 * hstep;
    const unsigned ldsw = (unsigned)wid * 1024u;
    const int aoff = lds_byte(wr * 64 + fr, fq * 8), boff = lds_byte(wc * 32 + fr, fq * 8);
    const char* gA = (const char*)g.A;
    unsigned aoC[2][2] = {{0u, 0u}, {0u, 0u}}, aoN[2][2] = {{0u, 0u}, {0u, 0u}};
#define PG8_SA(b, h) (((b) * 2 + (h)) * HTB)
#define PG8_SB(b, h) ((4 + (b) * 2 + (h)) * HTB)
#define PG8_STAGE(bufoff, gbase, voff) do { _Pragma("unroll") for (int _i = 0; _i < 2; ++_i) \
        __builtin_amdgcn_global_load_lds((const unsigned*)((const char*)(gbase) + (voff)[_i]), (PG8_LAS unsigned*)(lds + (bufoff) + ldsw + _i * 8192), 16, 0, 0); } while (0)
#define PG8_STAGE_A(bufoff, h, PN, KO) do { if constexpr (Sched::GATHER) { _Pragma("unroll") for (int _i = 0; _i < 2; ++_i) \
        __builtin_amdgcn_global_load_lds((const unsigned*)(gA + aoC[h][_i] + (KO)), (PG8_LAS unsigned*)(lds + (bufoff) + ldsw + _i * 8192), 16, 0, 0); } \
        else { PG8_STAGE(bufoff, (PN) + (h) * hstep, voffA); } } while (0)
#define PG8_LDA(dst, b, h) do { _Pragma("unroll") for (int m = 0; m < 4; ++m) _Pragma("unroll") for (int k = 0; k < 2; ++k) dst[m][k] = *(const PG8_LAS bf16x8*)(lds + PG8_SA(b, h) + aoff + m * 2048 + k * 1024); } while (0)
#define PG8_LDB(dst, b, h) do { _Pragma("unroll") for (int n = 0; n < 2; ++n) _Pragma("unroll") for (int k = 0; k < 2; ++k) dst[n][k] = *(const PG8_LAS bf16x8*)(lds + PG8_SB(b, h) + boff + n * 2048 + k * 1024); } while (0)
#define PG8_MMA(ai, bj, At, Bt) do { __builtin_amdgcn_s_setprio(1); _Pragma("unroll") for (int m = 0; m < 4; ++m) _Pragma("unroll") for (int n = 0; n < 2; ++n) _Pragma("unroll") for (int k = 0; k < 2; ++k) \
        acc[ai][bj][m][n] = __builtin_amdgcn_mfma_f32_16x16x32_bf16(Bt[n][k], At[m][k], acc[ai][bj][m][n], 0, 0, 0); __builtin_amdgcn_s_setprio(0); } while (0)
#define PG8_WAIT_V(n) asm volatile("s_waitcnt vmcnt(" #n ")" ::: "memory")
#define PG8_WAIT_L(n) asm volatile("s_waitcnt lgkmcnt(" #n ")" ::: "memory")
#define PG8_BAR __builtin_amdgcn_s_barrier()
#define PG8_SCHED __builtin_amdgcn_sched_barrier(0)
    Unit cur, nxt; int ui = 0;
    if (!S.next(0, cur)) return;
    f32x4 acc[2][2][4][2];
#pragma unroll
    for (int a = 0; a < 2; ++a)
#pragma unroll
        for (int b = 0; b < 2; ++b)
#pragma unroll
            for (int m = 0; m < 4; ++m)
#pragma unroll
                for (int n = 0; n < 2; ++n) acc[a][b][m][n] = (f32x4){0.f, 0.f, 0.f, 0.f};
    bf16x8 At[4][2], B0[2][2], B1[2][2];
    const char* cA = (const char*)g.A + (size_t)cur.pm * tstep; const char* cB = (const char*)g.Bt + (size_t)cur.pn * tstep;
    if constexpr (Sched::GATHER) S.a_offs(cur, RR[0], RR[1], CC[0], CC[1], K, aoC);
    S.a_ready(cur);
    if constexpr (SP2) {
        PG8_STAGE(PG8_SB(0, 0), cB, voffB); PG8_STAGE(PG8_SB(0, 1), cB + hstep, voffB); PG8_STAGE_A(PG8_SA(0, 0), 0, cA, 0); PG8_STAGE_A(PG8_SA(0, 1), 1, cA, 0);
        if (wr == 1) PG8_BAR;
        PG8_WAIT_V(2); PG8_BAR;
        PG8_STAGE(PG8_SB(1, 0), cB + kstep, voffB); PG8_STAGE_A(PG8_SA(1, 0), 0, cA + kstep, kstep); PG8_STAGE(PG8_SB(1, 1), cB + hstep + kstep, voffB);
        PG8_WAIT_V(6); PG8_BAR;
    } else {
        PG8_STAGE(PG8_SB(0, 0), cB, voffB); PG8_STAGE_A(PG8_SA(0, 0), 0, cA, 0); PG8_STAGE(PG8_SB(0, 1), cB + hstep, voffB); PG8_STAGE_A(PG8_SA(0, 1), 1, cA, 0);
        if (wr == 1) PG8_BAR;
        PG8_WAIT_V(4); PG8_BAR;
        PG8_STAGE(PG8_SB(1, 0), cB + kstep, voffB); PG8_STAGE_A(PG8_SA(1, 0), 0, cA + kstep, kstep); PG8_STAGE(PG8_SB(1, 1), cB + hstep + kstep, voffB);
        PG8_WAIT_V(6); PG8_BAR;
    }
    for (;;) {
        const bool has_next = S.next(ui + 1, nxt);
        const char* nA = has_next ? (const char*)g.A + (size_t)nxt.pm * tstep : cA; const char* nB = has_next ? (const char*)g.Bt + (size_t)nxt.pn * tstep : cB;
        if constexpr (Sched::GATHER) {
            if (has_next) S.a_offs(nxt, RR[0], RR[1], CC[0], CC[1], K, aoN);
            else {
#pragma unroll
                for (int h = 0; h < 2; ++h)
#pragma unroll
                    for (int i = 0; i < 2; ++i) aoN[h][i] = aoC[h][i]; }
        }
        for (int t = 0; t < nt; t += 2) {
            const bool last = (t == nt - 2);
            const char* a1 = cA + (size_t)(t + 1) * kstep;
            const char* a2 = last ? nA : cA + (size_t)(t + 2) * kstep; const char* b2 = last ? nB : cB + (size_t)(t + 2) * kstep;
            const char* a3 = a2 + kstep; const char* b3 = b2 + kstep;
            const size_t k1 = (size_t)(t + 1) * kstep, k2 = last ? (size_t)0 : (size_t)(t + 2) * kstep, k3 = k2 + kstep;
            if (last && has_next) S.a_ready(nxt);
            if constexpr (SP2) {
            PG8_LDB(B0, 0, 0); PG8_LDB(B1, 0, 1); PG8_SCHED; PG8_LDA(At, 0, 0); PG8_STAGE_A(PG8_SA(1, 1), 1, a1, k1);
            if constexpr (Sched::GATHER) { if (last) {
#pragma unroll
                for (int h = 0; h < 2; ++h)
#pragma unroll
                    for (int i = 0; i < 2; ++i) aoC[h][i] = aoN[h][i]; } }
            PG8_WAIT_V(8); PG8_WAIT_L(0); PG8_BAR; PG8_MMA(0, 0, At, B0); PG8_MMA(0, 1, At, B1); PG8_BAR; PG8_SCHED;
            PG8_LDA(At, 0, 1); PG8_STAGE(PG8_SB(0, 0), b2, voffB); PG8_STAGE(PG8_SB(0, 1), b2 + hstep, voffB); PG8_STAGE_A(PG8_SA(0, 0), 0, a2, k2);
            PG8_WAIT_V(8); PG8_WAIT_L(0); PG8_BAR; PG8_MMA(1, 0, At, B0); PG8_MMA(1, 1, At, B1); PG8_BAR; PG8_SCHED;
            PG8_LDB(B0, 1, 0); PG8_LDB(B1, 1, 1); PG8_SCHED; PG8_LDA(At, 1, 0); PG8_STAGE_A(PG8_SA(0, 1), 1, a2, k2);
            PG8_WAIT_V(8); PG8_WAIT_L(0); PG8_BAR; PG8_MMA(0, 0, At, B0); PG8_MMA(0, 1, At, B1); PG8_BAR; PG8_SCHED;
            PG8_LDA(At, 1, 1); PG8_STAGE(PG8_SB(1, 0), b3, voffB); PG8_STAGE(PG8_SB(1, 1), b3 + hstep, voffB); PG8_STAGE_A(PG8_SA(1, 0), 0, a3, k3);
            PG8_WAIT_V(8); PG8_WAIT_L(0); PG8_BAR; PG8_MMA(1, 0, At, B0); PG8_MMA(1, 1, At, B1); PG8_BAR; PG8_SCHED;
            } else {
            PG8_LDB(B0, 0, 0); PG8_SCHED; PG8_LDA(At, 0, 0); PG8_STAGE_A(PG8_SA(1, 1), 1, a1, k1);
            if constexpr (Sched::GATHER) { if (last) {
#pragma unroll
                for (int h = 0; h < 2; ++h)
#pragma unroll
                    for (int i = 0; i < 2; ++i) aoC[h][i] = aoN[h][i]; } }
            PG8_WAIT_L(8); PG8_BAR; PG8_WAIT_L(0); PG8_MMA(0, 0, At, B0); PG8_BAR; PG8_SCHED;
            PG8_LDB(B1, 0, 1); PG8_STAGE(PG8_SB(0, 0), b2, voffB);
            PG8_BAR; PG8_WAIT_L(0); PG8_MMA(0, 1, At, B1); PG8_BAR;
            PG8_LDA(At, 0, 1); PG8_STAGE_A(PG8_SA(0, 0), 0, a2, k2);
            PG8_BAR; PG8_WAIT_L(0); PG8_MMA(1, 0, At, B0); PG8_BAR; PG8_SCHED;
            PG8_STAGE(PG8_SB(0, 1), b2 + hstep, voffB);
            PG8_WAIT_V(6); PG8_BAR; PG8_MMA(1, 1, At, B1); PG8_BAR;
            PG8_LDB(B0, 1, 0); PG8_SCHED; PG8_LDA(At, 1, 0); PG8_STAGE_A(PG8_SA(0, 1), 1, a2, k2);
            PG8_WAIT_L(8); PG8_BAR; PG8_WAIT_L(0); PG8_MMA(0, 0, At, B0); PG8_BAR; PG8_SCHED;
            PG8_LDB(B1, 1, 1); PG8_STAGE(PG8_SB(1, 0), b3, voffB);
            PG8_BAR; PG8_WAIT_L(0); PG8_MMA(0, 1, At, B1); PG8_BAR;
            PG8_LDA(At, 1, 1); PG8_STAGE_A(PG8_SA(1, 0), 0, a3, k3);
            PG8_BAR; PG8_WAIT_L(0); PG8_MMA(1, 0, At, B0); PG8_BAR; PG8_SCHED;
            PG8_STAGE(PG8_SB(1, 1), b3 + hstep, voffB);
            PG8_WAIT_V(6); PG8_BAR; PG8_MMA(1, 1, At, B1); PG8_BAR;
            }
        }
        if constexpr (ALIGN_EPI) { if (wr == 0) PG8_BAR; }
        E(acc, cur, wr, wc, fr, fq); S.done(cur);
        if (!has_next) break;
#pragma unroll
        for (int a = 0; a < 2; ++a)
#pragma unroll
            for (int b = 0; b < 2; ++b)
#pragma unroll
                for (int m = 0; m < 4; ++m)
#pragma unroll
                    for (int n = 0; n < 2; ++n) acc[a][b][m][n] = (f32x4){0.f, 0.f, 0.f, 0.f};
        cur = nxt; cA = nA; cB = nB; ++ui;
        if constexpr (ALIGN_EPI) { if (wr == 1) PG8_BAR; }
    }
    PG8_WAIT_V(0);
    if constexpr (!ALIGN_EPI) { if (wr == 0) PG8_BAR; }
    PG8_BAR;
#undef PG8_SA
#undef PG8_SB
#undef PG8_STAGE
#undef PG8_STAGE_A
#undef PG8_LDA
#undef PG8_LDB
#undef PG8_MMA
#undef PG8_WAIT_V
#undef PG8_WAIT_L
#undef PG8_BAR
#undef PG8_SCHED
}
}

#ifndef MK_N_LAUNCHES
#define MK_N_LAUNCHES 1
#endif
constexpr int NWAVES = 8, NTHR = 512;
constexpr int S_ = 16384, D_ = 2048, DEPTH = 2, HD = 128;
constexpr int IN_W = 5656, NIN = 5888;
constexpr int NC = 1023;
constexpr int NEXP = 32, DEXP = 512, ECAP = 16384, NSLOT = 40960;
constexpr float RMS_EPS = 1e-6f;
constexpr float ATT_SCALE = 0.08838834764831845f;
constexpr int NPH = 22;

constexpr size_t MiB = 1u << 20;
constexpr size_t WS_CTL = 0, CTL_ZERO_BYTES = 1 * MiB;
constexpr size_t WS_ROPE = 1 * MiB, WS_WINT = 9 * MiB, WS_WOUTT = 55 * MiB, WS_WGUT = 71 * MiB, WS_WDT = 327 * MiB, WS_WC1T = 455 * MiB;
constexpr size_t WS_H = 463 * MiB, WS_QN = 527 * MiB, WS_QM = 559 * MiB, WS_KM = 591 * MiB, WS_VM = 623 * MiB;
constexpr size_t WS_KC = 655 * MiB, WS_VC = 663 * MiB, WS_KS = 671 * MiB, WS_VS = 679 * MiB, WS_KW = 687 * MiB, WS_VW = 695 * MiB;
constexpr size_t WS_GATES = 703 * MiB, WS_UL = 705 * MiB, WS_KCMP = 713 * MiB, WS_VCMP = 713 * MiB + 512 * 1024, WS_KMEAN = 714 * MiB;
constexpr size_t WS_OMIX = 715 * MiB, WS_OCMP = 779 * MiB, WS_OWIN = 811 * MiB, WS_SEL = 843 * MiB, WS_TE = 845 * MiB, WS_TOKIDX = 846 * MiB, WS_WTS = 848 * MiB;
constexpr size_t WS_HACT = 850 * MiB, WS_Y = 890 * MiB, WS_END = 1050 * MiB;
constexpr int CW_TMO = 0, CW_BAR = 4096, CW_CNT = 8192, CW_MOD = 16384, CW_B1E = 40960;

constexpr int RING_BYTES = 131072, LDSCTL_OFF = RING_BYTES, MISC_OFF = LDSCTL_OFF + 320, MOETAB_OFF = LDSCTL_OFF + 512, LDS_BYTES = 147456;

#define GAS __attribute__((address_space(1)))
#define LAS __attribute__((address_space(3)))
typedef unsigned short bf16;
typedef unsigned v4u __attribute__((ext_vector_type(4)));
typedef float f32x4 __attribute__((ext_vector_type(4)));
typedef float f32x2 __attribute__((ext_vector_type(2)));
typedef GAS unsigned gu32;
#define RLX_AGENT __ATOMIC_RELAXED, __HIP_MEMORY_SCOPE_AGENT
#define LDS_WAIT() asm volatile("s_waitcnt lgkmcnt(0)" ::: "memory")
__device__ __forceinline__ unsigned f2bf(float f) { unsigned u = __builtin_bit_cast(unsigned, f); return (u + 0x7fffu + ((u >> 16) & 1u)) >> 16; }
__device__ __forceinline__ unsigned pk2(float lo, float hi) { return f2bf(lo) | (f2bf(hi) << 16); }
__device__ __forceinline__ float bf2f(unsigned b) { return __builtin_bit_cast(float, b << 16); }
__device__ __forceinline__ float bflo(unsigned w) { return __builtin_bit_cast(float, w << 16); }
__device__ __forceinline__ float bfhi(unsigned w) { return __builtin_bit_cast(float, w & 0xffff0000u); }

#define XB_TMO      128
#define XB_XCNT(j)  (256  + 64 * (j))
#define XB_XSUB(j)  (1280 + 64 * (j))
#define XB_XGEN(j)  (2304 + 64 * (j))
#define XB_TOP      3328
#define XB_TOPGEN   3392
#define XCD_BAR_WORDS 3456
#define XB_SPIN_CAP (1u << 23)
__device__ __forceinline__ unsigned xb_ld(unsigned* p)              { return __hip_atomic_load(p, __ATOMIC_RELAXED, __HIP_MEMORY_SCOPE_AGENT); }
__device__ __forceinline__ unsigned xb_add(unsigned* p, unsigned v) { return __hip_atomic_fetch_add(p, v, __ATOMIC_RELAXED, __HIP_MEMORY_SCOPE_AGENT); }
__device__ __forceinline__ unsigned xb_xcc_id() { return (unsigned)__builtin_amdgcn_s_getreg((3 << 11) | 20) & 0xFu; }
#define XB_SPIN(cond, bar) do { unsigned _sp = 0; while (cond) { __builtin_amdgcn_s_sleep(1); \
    if ((++_sp & 255u) == 0u) { if (xb_ld(&(bar)[XB_TMO])) break; if (_sp > XB_SPIN_CAP) { atomicAdd(&(bar)[XB_TMO], 1u); break; } } } } while (0)
struct XcdBarrier { unsigned* bar; unsigned x; volatile LAS unsigned* st; };
__device__ __forceinline__ XcdBarrier xcd_barrier_post(unsigned* bar, volatile LAS unsigned* st) {
    XcdBarrier b; b.bar = bar; b.x = xb_xcc_id(); b.st = st;
    if (threadIdx.x == 0) (void)xb_add(&bar[XB_XCNT(b.x)], 1u);
    return b;
}
__device__ __forceinline__ void xcd_barrier_complete(unsigned* bar, unsigned x, unsigned& nloc, unsigned& nx) {
    const unsigned G = gridDim.x * gridDim.y * gridDim.z;
    unsigned sum, cnt, mine, sp = 0u;
    for (;;) {
        sum = 0u; cnt = 0u; mine = 0u;
#pragma unroll
        for (unsigned j = 0; j < 16; ++j) { const unsigned c = xb_ld(&bar[XB_XCNT(j)]); sum += c; cnt += (c > 0u) ? 1u : 0u; mine = (j == x) ? c : mine; }
        if (sum == G) break;
        __builtin_amdgcn_s_sleep(1);
        if ((++sp & 255u) == 0u) { if (xb_ld(&bar[XB_TMO])) break; if (sp > XB_SPIN_CAP) { atomicAdd(&bar[XB_TMO], 1u); break; } }
    }
    nloc = mine > 0u ? mine : 1u; nx = cnt > 0u ? cnt : 1u;
}
__device__ __forceinline__ void xcd_barrier(const XcdBarrier& b) {
    asm volatile("s_waitcnt vmcnt(0)" ::: "memory");
    __syncthreads();
    if (threadIdx.x == 0) {
        unsigned* bar = b.bar;
        __builtin_amdgcn_s_waitcnt(0);
        unsigned nloc = b.st[0], nx = b.st[1];
        if (nloc == 0u) { xcd_barrier_complete(bar, b.x, nloc, nx); b.st[0] = nloc; b.st[1] = nx; }
        const unsigned old = xb_add(&bar[XB_XSUB(b.x)], 1u);
        const unsigned gen = old / nloc;
        if (old + 1u == (gen + 1u) * nloc) {
            __builtin_amdgcn_fence(__ATOMIC_RELEASE, "agent");
            asm volatile("s_waitcnt vmcnt(0)" ::: "memory");
            const unsigned og = xb_add(&bar[XB_TOP], 1u);
            const unsigned tg = og / nx;
            if (og + 1u == (tg + 1u) * nx) xb_add(&bar[XB_TOPGEN], 1u);
            else XB_SPIN(xb_ld(&bar[XB_TOPGEN]) == tg, bar);
            __builtin_amdgcn_fence(__ATOMIC_ACQUIRE, "agent");
            xb_add(&bar[XB_XGEN(b.x)], 1u);
            asm volatile("s_waitcnt vmcnt(0)" ::: "memory");
        } else {
            XB_SPIN(xb_ld(&bar[XB_XGEN(b.x)]) == gen, bar);
            __builtin_amdgcn_fence(__ATOMIC_ACQUIRE, "agent");
            asm volatile("s_waitcnt vmcnt(0)" ::: "memory");
        }
    }
    __syncthreads();
}

__device__ __forceinline__ float wave_sum(float v) {
#pragma unroll
    for (int o = 1; o < 64; o <<= 1) v += __shfl_xor(v, o);
    return v;
}
__device__ __forceinline__ float wave_max(float v) {
#pragma unroll
    for (int o = 1; o < 64; o <<= 1) v = fmaxf(v, __shfl_xor(v, o));
    return v;
}

__device__ __forceinline__ int il(int d) { return (d < 64) ? 2 * d : 2 * (d - 64) + 1; }
__device__ __forceinline__ int inproj_row(int s) {
    if (s < 1024) return (s & ~127) + il(s & 127);
    if (s < 1536) return s;
    if (s < 1792) return (s & ~127) + il(s & 127);
    if (s < 2048) return s;
    if (s < 2304) return (s & ~127) + il(s & 127);
    if (s < 2560) return s;
    if (s < 2584) return 5632 + (s - 2560);
    if (s < 3608) { const int r = s - 2584; return 2560 + (r & ~127) + il(r & 127); }
    if (s < 4632) { const int r = s - 3608; return 3584 + (r & ~127) + il(r & 127); }
    return 4608 + (s - 4632);
}
template <int MODE>
__device__ __forceinline__ void transpose_item(const float* W, int K, int N, bf16* WT, int dpitch, int row_off, LAS float* scr, int item, int lane) {
    const int nblk = (N + 31) / 32, kb = item / nblk, nb = item % nblk, k0 = 64 * kb, n0 = 32 * nb;
    const int nsrc = n0 + (lane & 31);
#pragma unroll 8
    for (int i = 0; i < 32; ++i) { const int kk = 2 * i + (lane >> 5); scr[kk * 33 + (lane & 31)] = (nsrc < N) ? W[(size_t)(k0 + kk) * N + nsrc] : 0.f; }
    LDS_WAIT(); asm volatile("" ::: "memory");
    const int c = lane & 7;
#pragma unroll
    for (int j = 0; j < 4; ++j) { const int nl = (lane >> 3) + 8 * j, n = n0 + nl; const LAS float* s = scr + (8 * c) * 33 + nl;
        v4u o; o.x = pk2(s[0 * 33], s[1 * 33]); o.y = pk2(s[2 * 33], s[3 * 33]); o.z = pk2(s[4 * 33], s[5 * 33]); o.w = pk2(s[6 * 33], s[7 * 33]);
        if (n < N) { int dr;
            if (MODE == 0) dr = n; else if (MODE == 1) dr = inproj_row(n); else if (MODE == 2) dr = (n >> 7) * 256 + (n & 127); else dr = (n >> 7) * 256 + 128 + (n & 127);
            *(GAS v4u*)(WT + (size_t)(row_off + dr) * dpitch + k0 + 8 * c) = o; } }
    LDS_WAIT(); asm volatile("" ::: "memory");
}

using pg8::Unit;
struct EpiInProj {
    static constexpr bool PERM = true;
    bf16 *QN, *KC, *VC, *KS, *VS, *KW, *VW, *QM, *KM, *VM; float* GATES; const float* rope;
    __device__ __forceinline__ void operator()(const f32x4 (&acc)[2][2][4][2], const Unit& u, int wr, int wc, int fr, int fq) const {
        const int pn = u.pn, row0 = u.pm * 256 + wr * 64 + fr, c8 = wc * 32 + 8 * fq;
        if (pn == 22) {
            if (c8 < 24) {
#pragma unroll
                for (int ai = 0; ai < 2; ++ai)
#pragma unroll
                    for (int m = 0; m < 4; ++m) { const int row = row0 + ai * 128 + m * 16; float* gp = GATES + (size_t)row * 32 + c8;
                        f32x4 a = acc[ai][0][m][0], b = acc[ai][0][m][1], ga, gb;
#pragma unroll
                        for (int j = 0; j < 4; ++j) { ga[j] = 1.f / (1.f + __expf(-a[j])); gb[j] = 1.f / (1.f + __expf(-b[j])); }
                        *(f32x4*)gp = ga; *(f32x4*)(gp + 4) = gb; }
            }
            return;
        }
        bf16* base; int pitch; size_t bjs; bool rot;
        if (pn < 4)       { base = QN + pn * 256;        pitch = 1024; bjs = 128; rot = true; }
        else if (pn == 4) { base = KC;                   pitch = 128;  bjs = (size_t)S_ * 128; rot = false; }
        else if (pn == 5) { base = VC;                   pitch = 128;  bjs = (size_t)S_ * 128; rot = false; }
        else if (pn == 6) { base = KS;                   pitch = 256;  bjs = 128; rot = true; }
        else if (pn == 7) { base = VS;                   pitch = 256;  bjs = 128; rot = false; }
        else if (pn == 8) { base = KW;                   pitch = 256;  bjs = 128; rot = true; }
        else if (pn == 9) { base = VW;                   pitch = 256;  bjs = 128; rot = false; }
        else if (pn < 14) { base = QM + (pn - 10) * 256; pitch = 1024; bjs = 128; rot = true; }
        else if (pn < 18) { base = KM + (pn - 14) * 256; pitch = 1024; bjs = 128; rot = true; }
        else              { base = VM + (pn - 18) * 256; pitch = 1024; bjs = 128; rot = false; }
#pragma unroll
        for (int ai = 0; ai < 2; ++ai)
#pragma unroll
            for (int m = 0; m < 4; ++m) { const int row = row0 + ai * 128 + m * 16;
                f32x4 t0 = (f32x4){1.f, 0.f, 1.f, 0.f}, t1 = t0;
                if (rot) { const f32x4* tp = (const f32x4*)(rope + (size_t)row * 128 + (c8 >> 1) * 2); t0 = tp[0]; t1 = tp[1]; }
#pragma unroll
                for (int bj = 0; bj < 2; ++bj) { f32x4 v0 = acc[ai][bj][m][0], v1 = acc[ai][bj][m][1];
                    if (rot) { f32x4 w0, w1;
                        w0[0] = v0[0] * t0[0] - v0[1] * t0[1]; w0[1] = v0[1] * t0[0] + v0[0] * t0[1]; w0[2] = v0[2] * t0[2] - v0[3] * t0[3]; w0[3] = v0[3] * t0[2] + v0[2] * t0[3];
                        w1[0] = v1[0] * t1[0] - v1[1] * t1[1]; w1[1] = v1[1] * t1[0] + v1[0] * t1[1]; w1[2] = v1[2] * t1[2] - v1[3] * t1[3]; w1[3] = v1[3] * t1[2] + v1[2] * t1[3];
                        v0 = w0; v1 = w1; }
                    pg8::u32x4 w; w.x = pg8::cvt_pk_bf16(v0[0], v0[1]); w.y = pg8::cvt_pk_bf16(v0[2], v0[3]); w.z = pg8::cvt_pk_bf16(v1[0], v1[1]); w.w = pg8::cvt_pk_bf16(v1[2], v1[3]);
                    *(pg8::u32x4*)(base + (size_t)row * pitch + bj * bjs + c8) = w; } }
    }
};
struct EpiOutProj {
    static constexpr bool PERM = false;
    const float* xsrc; float* X; const float* gt;
    __device__ __forceinline__ void operator()(const f32x4 (&acc)[2][2][4][2], const Unit& u, int wr, int wc, int fr, int fq) const {
        const int row0 = u.pm * 256 + wr * 64 + fr, col0 = u.pnl * 256 + wc * 32 + 4 * fq;
        f32x4 gv[2][2];
#pragma unroll
        for (int bj = 0; bj < 2; ++bj)
#pragma unroll
            for (int n = 0; n < 2; ++n) gv[bj][n] = *(const f32x4*)(gt + col0 + bj * 128 + n * 16);
#pragma unroll
        for (int ai = 0; ai < 2; ++ai)
#pragma unroll
            for (int m = 0; m < 4; ++m) { const size_t ro = (size_t)(row0 + ai * 128 + m * 16) * D_ + col0;
#pragma unroll
                for (int bj = 0; bj < 2; ++bj)
#pragma unroll
                    for (int n = 0; n < 2; ++n) { const f32x4 xv = *(const f32x4*)(xsrc + ro + bj * 128 + n * 16); *(f32x4*)(X + ro + bj * 128 + n * 16) = xv + gv[bj][n] * acc[ai][bj][m][n]; } }
    }
};
struct EpiF32 {
    static constexpr bool PERM = false;
    float* C; int ldc;
    __device__ __forceinline__ void operator()(const f32x4 (&acc)[2][2][4][2], const Unit& u, int wr, int wc, int fr, int fq) const {
        const int row0 = u.pm * 256 + wr * 64 + fr, col0 = u.pnl * 256 + wc * 32 + 4 * fq;
#pragma unroll
        for (int ai = 0; ai < 2; ++ai)
#pragma unroll
            for (int m = 0; m < 4; ++m) { float* rowp = C + (size_t)(row0 + ai * 128 + m * 16) * ldc + col0;
#pragma unroll
                for (int bj = 0; bj < 2; ++bj)
#pragma unroll
                    for (int n = 0; n < 2; ++n) *(f32x4*)(rowp + bj * 128 + n * 16) = acc[ai][bj][m][n]; }
    }
};
struct EpiGateUp {
    static constexpr bool PERM = true;
    bf16* HACT;
    __device__ __forceinline__ void operator()(const f32x4 (&acc)[2][2][4][2], const Unit& u, int wr, int wc, int fr, int fq) const {
        const int row0 = u.pm * 256 + wr * 64 + fr, col0 = u.pnl * 128 + wc * 32 + 8 * fq;
#pragma unroll
        for (int ai = 0; ai < 2; ++ai)
#pragma unroll
            for (int m = 0; m < 4; ++m) { const int row = row0 + ai * 128 + m * 16; f32x4 h[2];
#pragma unroll
                for (int n = 0; n < 2; ++n)
#pragma unroll
                    for (int j = 0; j < 4; ++j) { const float gg = acc[ai][0][m][n][j], uu = acc[ai][1][m][n][j]; h[n][j] = gg / (1.f + __expf(-gg)) * uu; }
                pg8::u32x4 w; w.x = pg8::cvt_pk_bf16(h[0][0], h[0][1]); w.y = pg8::cvt_pk_bf16(h[0][2], h[0][3]); w.z = pg8::cvt_pk_bf16(h[1][0], h[1][1]); w.w = pg8::cvt_pk_bf16(h[1][2], h[1][3]);
                *(pg8::u32x4*)(HACT + (size_t)row * DEXP + col0) = w; }
    }
};
struct EpiDown {
    static constexpr bool PERM = true;
    bf16* Y; const float* WTS; const LAS int* tab;
    __device__ __forceinline__ void operator()(const f32x4 (&acc)[2][2][4][2], const Unit& u, int wr, int wc, int fr, int fq) const {
        const int rl0 = wr * 64 + fr, col0 = u.pnl * 256 + wc * 32 + 8 * fq, cnt = tab[u.e];
#pragma unroll
        for (int ai = 0; ai < 2; ++ai)
#pragma unroll
            for (int m = 0; m < 4; ++m) { const int rl = rl0 + ai * 128 + m * 16, pos = u.mt * 256 + rl;
                const float w = (pos < cnt) ? WTS[(size_t)u.e * ECAP + pos] : 0.f;
                bf16* rowp = Y + (size_t)(u.pm * 256 + rl) * D_ + col0;
#pragma unroll
                for (int bj = 0; bj < 2; ++bj) { const f32x4 v0 = acc[ai][bj][m][0] * w, v1 = acc[ai][bj][m][1] * w;
                    pg8::u32x4 o; o.x = pg8::cvt_pk_bf16(v0[0], v0[1]); o.y = pg8::cvt_pk_bf16(v0[2], v0[3]); o.z = pg8::cvt_pk_bf16(v1[0], v1[1]); o.w = pg8::cvt_pk_bf16(v1[2], v1[3]);
                    *(pg8::u32x4*)(rowp + bj * 128) = o; } }
    }
};

struct CompressOrder {
    static constexpr bool GATHER = false;
    int G, c;
    __device__ bool next(int i, Unit& u) const { const int L = i * G + c; if (L >= 32) return false; u.pm = L >> 1; u.pnl = L & 1; u.pn = (u.pm >= 8 ? 2 : 0) + u.pnl; u.e = 0; u.mt = 0; return true; }
    __device__ __forceinline__ void a_offs(const Unit&, int, int, int, int, int, unsigned (&)[2][2]) const {}
    __device__ __forceinline__ void a_ready(const Unit&) const {}
    __device__ __forceinline__ void done(const Unit&) const {}
};
template <bool GATHER_>
struct MoeOrder {
    static constexpr bool GATHER = GATHER_;
    const LAS int* tab; int NT, G, c, bt_per_e, bt_base; const int* tokidx;
    __device__ bool next(int i, Unit& u) const {
        const int L = i * G + c; if (L >= tab[64]) return false;
        int e = 0;
        for (int k = 1; k < NEXP; ++k) e += (L >= tab[32 + k]) ? 1 : 0;
        e = __builtin_amdgcn_readfirstlane(e);
        const int r = L - tab[32 + e];
        u.e = e; u.mt = r / NT; u.pnl = r % NT; u.pn = bt_base + e * bt_per_e + u.pnl; u.pm = (tab[65 + e] >> 8) + u.mt; return true;
    }
    __device__ __forceinline__ void a_offs(const Unit& u, int R0, int R1, int C0, int C1, int K, unsigned (&o)[2][2]) const {
        const int cnt = tab[u.e]; const int* tk = tokidx + (size_t)u.e * ECAP;
#pragma unroll
        for (int h = 0; h < 2; ++h) {
            int p0 = u.mt * 256 + h * 128 + R0, p1 = u.mt * 256 + h * 128 + R1; p0 = p0 < cnt ? p0 : cnt - 1; p1 = p1 < cnt ? p1 : cnt - 1;
            o[h][0] = ((unsigned)tk[p0] * (unsigned)K + (unsigned)C0) * 2u; o[h][1] = ((unsigned)tk[p1] * (unsigned)K + (unsigned)C1) * 2u; }
    }
    __device__ __forceinline__ void a_ready(const Unit&) const {}
    __device__ __forceinline__ void done(const Unit&) const {}
};

constexpr int SM_Q = 0, SM_P = 512, SM_KP = 4608, SM_RED = 5632, SM_PART = 5696, SM_MISC = 6208;
template <int NH, class KeyFn>
__device__ __forceinline__ float naive_attend(LAS float* sm, int tid, int nkeys, const KeyFn keyfn, const bf16* Kb, int kpitch, const bf16* Vb, int vpitch) {
    LAS int* kp = (LAS int*)(sm + SM_KP);
    const int lane = tid & 63, wave = tid >> 6;
    float sc[NH][2];
#pragma unroll
    for (int i = 0; i < 2; ++i) {
        const int kk = tid + 512 * i; const int kpos = (kk < nkeys) ? keyfn(kk) : -1; kp[kk] = kpos;
        float a[NH];
#pragma unroll
        for (int h = 0; h < NH; ++h) a[h] = 0.f;
        if (kpos >= 0) { const v4u* kr = (const v4u*)(Kb + (size_t)kpos * kpitch);
#pragma unroll 4
            for (int c = 0; c < 16; ++c) { const v4u kv = kr[c];
                const float k0 = bflo(kv.x), k1 = bfhi(kv.x), k2 = bflo(kv.y), k3 = bfhi(kv.y), k4 = bflo(kv.z), k5 = bfhi(kv.z), k6 = bflo(kv.w), k7 = bfhi(kv.w);
#pragma unroll
                for (int h = 0; h < NH; ++h) { const f32x4 qa = *(const LAS f32x4*)(sm + SM_Q + h * 128 + 8 * c), qb = *(const LAS f32x4*)(sm + SM_Q + h * 128 + 8 * c + 4);
                    a[h] += qa[0] * k0 + qa[1] * k1 + qa[2] * k2 + qa[3] * k3 + qb[0] * k4 + qb[1] * k5 + qb[2] * k6 + qb[3] * k7; } } }
#pragma unroll
        for (int h = 0; h < NH; ++h) sc[h][i] = (kpos >= 0) ? a[h] * ATT_SCALE : -INFINITY;
    }
#pragma unroll
    for (int h = 0; h < NH; ++h) { const float m = wave_max(fmaxf(sc[h][0], sc[h][1])); if (lane == 0) sm[SM_RED + wave * NH + h] = m; }
    __syncthreads();
    float mx[NH];
#pragma unroll
    for (int h = 0; h < NH; ++h) { float m = sm[SM_RED + h];
#pragma unroll
        for (int w = 1; w < 8; ++w) m = fmaxf(m, sm[SM_RED + w * NH + h]); mx[h] = m; }
    __syncthreads();
#pragma unroll
    for (int h = 0; h < NH; ++h) {
#pragma unroll
        for (int i = 0; i < 2; ++i) sc[h][i] = (sc[h][i] == -INFINITY) ? 0.f : __expf(sc[h][i] - mx[h]);
        const float s = wave_sum(sc[h][0] + sc[h][1]); if (lane == 0) sm[SM_RED + wave * NH + h] = s; }
    __syncthreads();
#pragma unroll
    for (int h = 0; h < NH; ++h) { float s = 0.f;
#pragma unroll
        for (int w = 0; w < 8; ++w) s += sm[SM_RED + w * NH + h];
        const float inv = s > 0.f ? 1.f / s : 0.f;
#pragma unroll
        for (int i = 0; i < 2; ++i) sm[SM_P + h * 1024 + tid + 512 * i] = sc[h][i] * inv; }
    __syncthreads();
    const int d = tid & 127, hs = tid >> 7;
    float o = 0.f;
    {
        const int hrow = (NH == 4) ? hs * 1024 : 0;
        const int k0 = (NH == 4) ? 0 : hs * 256, k1 = (NH == 4) ? nkeys : ((k0 + 256 < nkeys) ? k0 + 256 : nkeys);
        for (int kb = k0; kb < k1; kb += 8) {
            int kq[8]; float pq[8], vq[8];
#pragma unroll
            for (int j = 0; j < 8; ++j) { const int kpos = kp[kb + j]; pq[j] = (kpos >= 0 && kb + j < k1) ? sm[SM_P + hrow + kb + j] : 0.f; kq[j] = kpos >= 0 ? kpos : 0; }
#pragma unroll
            for (int j = 0; j < 8; ++j) vq[j] = bf2f(Vb[(size_t)kq[j] * vpitch + d]);
#pragma unroll
            for (int j = 0; j < 8; ++j) o += pq[j] * vq[j];
        }
    }
    if (NH == 1) {
        sm[SM_PART + tid] = o; __syncthreads();
        if (tid < 128) o = sm[SM_PART + tid] + sm[SM_PART + 128 + tid] + sm[SM_PART + 256 + tid] + sm[SM_PART + 384 + tid];
    }
    return o;
}

struct Args { const float* in[18]; float* out; unsigned char* ws; int ph_lo, ph_hi, li, pad; };
typedef const __attribute__((address_space(4))) Args* ArgsP;
__device__ __forceinline__ ArgsP get_args() { auto p = __builtin_amdgcn_kernarg_segment_ptr(); asm volatile("" : "+s"(p)); return (ArgsP)p; }

__global__ void __launch_bounds__(NTHR, 2) mk_fwd(Args args_unused) {
    extern __shared__ __attribute__((aligned(16))) unsigned char lds_raw[];
    LAS unsigned char* lds = (LAS unsigned char*)lds_raw;
    LAS float* sm = (LAS float*)lds;
    volatile LAS unsigned* MISC = (volatile LAS unsigned*)(lds + MISC_OFF);
    LAS int* moetab = (LAS int*)(lds + MOETAB_OFF);
    const int G = gridDim.x, bid = blockIdx.x, NGW = G * NWAVES;
#define PH_IDS() int tid_ = threadIdx.x; asm volatile("" : "+v"(tid_)); const int tid = tid_, lane = tid & 63, wave = __builtin_amdgcn_readfirstlane(tid >> 6), gw = bid * NWAVES + wave; (void)lane; (void)gw;
#define AP() get_args()
#define CTLP(ws) ((gu32*)((ws) + WS_CTL))

    for (int u = threadIdx.x; u < (LDS_BYTES - LDSCTL_OFF) / 4; u += NTHR) ((LAS unsigned*)(lds + LDSCTL_OFF))[u] = 0u;
    __syncthreads();
    XcdBarrier bar; bar.bar = nullptr; bar.x = 0; bar.st = nullptr;
    if (MK_N_LAUNCHES == 1) bar = xcd_barrier_post((unsigned*)(CTLP(AP()->ws) + CW_BAR), MISC + 8);
#define GRID_BAR() do { if (MK_N_LAUNCHES == 1) { XcdBarrier b_ = bar; b_.bar = (unsigned*)(CTLP(AP()->ws) + CW_BAR); xcd_barrier(b_); } } while (0)
    const int lo = AP()->ph_lo, hi = AP()->ph_hi;
#define IN(k) (lo <= (k) && (k) < hi)
#define BOTH(k) (IN(k) && IN((k) + 1))

    if (IN(0)) {
        PH_IDS(); ArgsP ap = AP(); unsigned char* ws = ap->ws;
        LAS float* scr = (LAS float*)(lds + wave * 16384);
        constexpr int I_IN = 32 * 177, I_OUT = 32 * 64, I_GU = 32 * 16, I_DN = 8 * 64, I_W1 = 32 * 8;
        constexpr int N_IN = 2 * I_IN, N_OUT = 2 * I_OUT, N_G = 64 * I_GU, N_U = 64 * I_GU, N_D = 64 * I_DN, N_W1 = 8 * I_W1;
        constexpr int NITEMS = N_IN + N_OUT + N_G + N_U + N_D + N_W1;
        for (int it = gw; it < NITEMS; it += NGW) {
            int r = it;
            if (r < N_IN) { const int l = r / I_IN; transpose_item<1>(ap->in[6] + (size_t)l * D_ * IN_W, D_, IN_W, (bf16*)(ws + WS_WINT) + (size_t)l * NIN * D_, D_, 0, scr, r % I_IN, lane); continue; } r -= N_IN;
            if (r < N_OUT) { const int l = r / I_OUT; transpose_item<0>(ap->in[7] + (size_t)l * D_ * D_, D_, D_, (bf16*)(ws + WS_WOUTT) + (size_t)l * D_ * D_, D_, 0, scr, r % I_OUT, lane); continue; } r -= N_OUT;
            if (r < N_G) { const int le = r / I_GU; transpose_item<2>(ap->in[14] + (size_t)le * D_ * DEXP, D_, DEXP, (bf16*)(ws + WS_WGUT) + (size_t)le * 1024 * D_, D_, 0, scr, r % I_GU, lane); continue; } r -= N_G;
            if (r < N_U) { const int le = r / I_GU; transpose_item<3>(ap->in[15] + (size_t)le * D_ * DEXP, D_, DEXP, (bf16*)(ws + WS_WGUT) + (size_t)le * 1024 * D_, D_, 0, scr, r % I_GU, lane); continue; } r -= N_U;
            if (r < N_D) { const int le = r / I_DN; transpose_item<0>(ap->in[16] + (size_t)le * DEXP * D_, DEXP, D_, (bf16*)(ws + WS_WDT) + (size_t)le * D_ * DEXP, DEXP, 0, scr, r % I_DN, lane); continue; } r -= N_D;
            { const int m = r / I_W1, lk = m >> 1, half = m & 1;
              transpose_item<0>(ap->in[9] + (size_t)lk * 4096 * 256 + (size_t)half * 2048 * 256, 2048, 256, (bf16*)(ws + WS_WC1T) + (size_t)lk * 512 * 2048, 2048, half * 256, scr, r % I_W1, lane); }
        }
        { f32x2* ROPE = (f32x2*)(ws + WS_ROPE);
          for (int idx = bid * NTHR + tid; idx < S_ * 64; idx += G * NTHR) { const int pos = idx >> 6, i = idx & 63;
            const double inv = exp(-(double)i * (9.210340371976184 / 64.0)); const double ang = (double)pos * inv; double sv, cv; sincos(ang, &sv, &cv);
            ROPE[idx] = (f32x2){(float)cv, (float)sv}; } }
        __syncthreads();
        { float* MOD = (float*)(CTLP(ws) + CW_MOD); const float* c_in = ap->in[1]; const float* w_ada = ap->in[2]; const float* b_ada = ap->in[3];
          for (int k = tid; k < D_; k += NTHR) { const float cv = c_in[k]; sm[k] = cv / (1.f + __expf(-cv)); }
          __syncthreads();
          for (int it = bid; it < 2 * 96; it += G) { const int l = it / 96, cb = it % 96, grp = tid >> 5, col = cb * 128 + (tid & 31) * 4;
            f32x4 a = (f32x4){0.f, 0.f, 0.f, 0.f};
            const float* wp = w_ada + ((size_t)l * D_ + grp) * 12288 + col;
#pragma unroll 8
            for (int i = 0; i < 128; ++i) a += *(const f32x4*)(wp + (size_t)i * 16 * 12288) * sm[grp + 16 * i];
            *(LAS f32x4*)(sm + 4096 + grp * 128 + (tid & 31) * 4) = a;
            __syncthreads();
            if (tid < 128) { float s = b_ada[l * 12288 + cb * 128 + tid];
#pragma unroll
                for (int q = 0; q < 16; ++q) s += sm[4096 + q * 128 + tid];
                MOD[l * 12288 + cb * 128 + tid] = s; }
            __syncthreads(); } }
        { float* B1E = (float*)(CTLP(ws) + CW_B1E); const float* cmp_pe = ap->in[8]; const float* cmp_w1 = ap->in[9]; const float* cmp_b1 = ap->in[10];
          for (int it = bid - 192; it >= 0 && it < 4; it += G) { const int lk = it, grp = tid >> 6, n = (tid & 63) * 4;
            f32x4 a = (f32x4){0.f, 0.f, 0.f, 0.f};
            const float* wp = cmp_w1 + ((size_t)lk * 4096 + grp) * 256 + n; const float* pe = cmp_pe + (size_t)lk * 4096 + grp;
#pragma unroll 8
            for (int i = 0; i < 512; ++i) a += *(const f32x4*)(wp + (size_t)i * 8 * 256) * pe[i * 8];
            *(LAS f32x4*)(sm + 4096 + grp * 256 + n) = a;
            __syncthreads();
            if (tid < 256) { float s = cmp_b1[lk * 256 + tid];
#pragma unroll
                for (int q = 0; q < 8; ++q) s += sm[4096 + q * 256 + tid];
                B1E[lk * 256 + tid] = s; }
            __syncthreads(); } }
        if (BOTH(0)) GRID_BAR();
    }

    for (int l = 0; l < DEPTH; ++l) {
        const int pb = 1 + 10 * l;
#define LOAD_MOETAB(CNTP, NT_) do { __syncthreads(); if (tid < 32) moetab[tid] = (int)__hip_atomic_load((CNTP) + tid, RLX_AGENT); __syncthreads(); \
        if (tid == 0) { int us = 0, ps = 0; for (int e = 0; e < NEXP; ++e) { const int c = moetab[e], tl = (c + 255) >> 8; moetab[32 + e] = us; moetab[65 + e] = ps; us += tl * (NT_); ps += tl << 8; } moetab[64] = us; } \
        __syncthreads(); } while (0)

        if (IN(pb + 0)) {
            PH_IDS(); ArgsP ap = AP(); unsigned char* ws = ap->ws;
            const float* MOD = (const float*)(CTLP(ws) + CW_MOD); const float* mod = MOD + l * 12288;
            float* X = ap->out; bf16* H = (bf16*)(ws + WS_H); const bf16* Y = (const bf16*)(ws + WS_Y); const int* TE = (const int*)(ws + WS_TE);
            if (l > 0) LOAD_MOETAB((unsigned*)(CTLP(ws) + CW_CNT) + (l - 1) * 32, 1);
            { const float* g_attn = ap->in[4];
              for (int k = tid; k < D_; k += NTHR) { sm[k] = g_attn[l * D_ + k] * (1.f + mod[2048 + k]); sm[2048 + k] = mod[k]; sm[4096 + k] = (l > 0) ? MOD[(l - 1) * 12288 + 10240 + k] : 0.f; } }
            __syncthreads();
            const float* x_in = ap->in[0];
            for (int t = gw; t < S_; t += NGW) {
                f32x4 v[8]; float ss = 0.f;
                if (l == 0) {
#pragma unroll
                    for (int j = 0; j < 8; ++j) v[j] = *(const f32x4*)(x_in + (size_t)t * D_ + 256 * j + 4 * lane);
                } else {
                    const int4 te = *(const int4*)(TE + 4 * t);
                    const bf16* y0 = Y + (size_t)(moetab[65 + te.x] + te.y) * D_; const bf16* y1 = Y + (size_t)(moetab[65 + te.z] + te.w) * D_;
#pragma unroll
                    for (int j = 0; j < 8; ++j) { const int k = 256 * j + 4 * lane; const uint2 a = *(const uint2*)(y0 + k), b = *(const uint2*)(y1 + k);
                        const f32x4 gt2 = *(const LAS f32x4*)(sm + 4096 + k);
                        f32x4 ysum = (f32x4){bflo(a.x) + bflo(b.x), bfhi(a.x) + bfhi(b.x), bflo(a.y) + bflo(b.y), bfhi(a.y) + bfhi(b.y)};
                        v[j] = *(const f32x4*)(X + (size_t)t * D_ + k) + gt2 * ysum; *(f32x4*)(X + (size_t)t * D_ + k) = v[j]; }
                }
#pragma unroll
                for (int j = 0; j < 8; ++j) ss += (v[j][0] * v[j][0] + v[j][1] * v[j][1]) + (v[j][2] * v[j][2] + v[j][3] * v[j][3]);
                const float rstd = 1.f / sqrtf(wave_sum(ss) * (1.f / D_) + RMS_EPS);
#pragma unroll
                for (int j = 0; j < 8; ++j) { const int k = 256 * j + 4 * lane; const f32x4 h = v[j] * rstd * *(const LAS f32x4*)(sm + k) + *(const LAS f32x4*)(sm + 2048 + k);
                    *(uint2*)(H + (size_t)t * D_ + k) = make_uint2(pk2(h[0], h[1]), pk2(h[2], h[3])); }
            }
            if (BOTH(pb + 0)) GRID_BAR();
        }
        if (IN(pb + 1)) {
            ArgsP ap = AP(); unsigned char* ws = ap->ws;
            pg8::Gemm g{(const bf16*)(ws + WS_H), (const bf16*)(ws + WS_WINT) + (size_t)l * NIN * D_, S_, NIN, D_}; pg8::StaticOrder So; So.init(S_, NIN, G, bid);
            EpiInProj E{(bf16*)(ws + WS_QN), (bf16*)(ws + WS_KC), (bf16*)(ws + WS_VC), (bf16*)(ws + WS_KS), (bf16*)(ws + WS_VS), (bf16*)(ws + WS_KW), (bf16*)(ws + WS_VW),
                        (bf16*)(ws + WS_QM), (bf16*)(ws + WS_KM), (bf16*)(ws + WS_VM), (float*)(ws + WS_GATES), (const float*)(ws + WS_ROPE)};
            pg8::gemm_phase<EpiInProj, pg8::StaticOrder, true, true>(lds, g, So, E);
            if (BOTH(pb + 1)) GRID_BAR();
        }
        if (IN(pb + 2)) {
            PH_IDS(); ArgsP ap = AP(); unsigned char* ws = ap->ws;
            if (bid < 32) {
                pg8::Gemm g{(const bf16*)(ws + WS_KC), (const bf16*)(ws + WS_WC1T) + (size_t)l * 2 * 512 * 2048, 4096, 512, 2048}; CompressOrder So{G, bid};
                EpiF32 E{(float*)(ws + WS_UL), 512};
                pg8::gemm_phase<EpiF32, CompressOrder, false, true>(lds, g, So, E);
            }
            {
                const bf16* KM = (const bf16*)(ws + WS_KM); float* KMEAN = (float*)(ws + WS_KMEAN);
                const int nb = (G > 32) ? G - 32 : G, b0 = (G > 32) ? bid - 32 : bid;
                if (b0 >= 0) for (int u = b0; u < 512; u += nb) { const int n = u >> 3, h = u & 7, p = tid & 127, q = tid >> 7;
                    float s = 0.f; const bf16* kp = KM + (size_t)(n * 256 + q * 64) * 1024 + h * 128 + p;
#pragma unroll 16
                    for (int i = 0; i < 64; ++i) s += bf2f(kp[(size_t)i * 1024]);
                    sm[tid] = s; __syncthreads();
                    if (tid < 128) KMEAN[(size_t)(n * 8 + h) * 128 + tid] = (sm[tid] + sm[128 + tid] + sm[256 + tid] + sm[384 + tid]) * (1.f / 256.f);
                    __syncthreads(); }
            }
            if (BOTH(pb + 2)) GRID_BAR();
        }
        if (IN(pb + 3)) {
            PH_IDS(); ArgsP ap = AP(); unsigned char* ws = ap->ws;
            const float* UL = (const float*)(ws + WS_UL); const float* B1E = (const float*)(CTLP(ws) + CW_B1E); const f32x2* ROPE = (const f32x2*)(ws + WS_ROPE);
            bf16* KCMP = (bf16*)(ws + WS_KCMP); bf16* VCMP = (bf16*)(ws + WS_VCMP); const float* cmp_w2 = ap->in[11];
            LAS float* hid = sm + wave * 256;
            for (int u = gw; u < 2 * NC * 2; u += NGW) { const int kv = u / (NC * 2), r = u % (NC * 2), c = r >> 1, g = r & 1;
                const float* Ur = UL + ((size_t)kv * 2048 + g * 1024 + c) * 512; const float* Lr = UL + ((size_t)kv * 2048 + g * 1024 + c + 1) * 512 + 256;
                const float* be = B1E + (l * 2 + kv) * 256;
#pragma unroll
                for (int j = 0; j < 4; ++j) { const int n = lane + 64 * j; const float v = Ur[n] + Lr[n] + be[n];
                    hid[n] = 0.5f * v * (1.f + tanhf(0.7978845608028654f * (v + 0.044715f * v * v * v))); }
                LDS_WAIT(); asm volatile("" ::: "memory");
                const float* w2 = cmp_w2 + (size_t)(l * 2 + kv) * 256 * 128;
                float o0 = 0.f, o1 = 0.f;
#pragma unroll 8
                for (int n = 0; n < 256; ++n) { const float hv = hid[n]; o0 += hv * w2[n * 128 + lane]; o1 += hv * w2[n * 128 + 64 + lane]; }
                if (kv == 0) { const f32x2 cs = ROPE[(size_t)(16 * c + 31) * 64 + lane];
                    const float a = o0 * cs[0] - o1 * cs[1], b = o1 * cs[0] + o0 * cs[1];
                    *(unsigned*)(KCMP + ((size_t)c * 2 + g) * 128 + 2 * lane) = pk2(a, b);
                } else { VCMP[((size_t)c * 2 + g) * 128 + lane] = (bf16)f2bf(o0); VCMP[((size_t)c * 2 + g) * 128 + 64 + lane] = (bf16)f2bf(o1); }
                LDS_WAIT(); asm volatile("" ::: "memory");
            }
            if (BOTH(pb + 3)) GRID_BAR();
        }
        if (IN(pb + 4)) {
            PH_IDS(); LAS int* mi = (LAS int*)(sm + SM_MISC);
            {   ArgsP ap = AP(); unsigned char* ws = ap->ws;
                const bf16* QN = (const bf16*)(ws + WS_QN); const bf16* KCMP = (const bf16*)(ws + WS_KCMP); const bf16* VCMP = (const bf16*)(ws + WS_VCMP);
                const bf16* KW = (const bf16*)(ws + WS_KW); const bf16* VW = (const bf16*)(ws + WS_VW); const float* GATES = (const float*)(ws + WS_GATES);
                bf16* OCMP = (bf16*)(ws + WS_OCMP); bf16* OWIN = (bf16*)(ws + WS_OWIN); int* SEL = (int*)(ws + WS_SEL);
            for (int u = bid; u < S_ * 2; u += G) { const int t = u >> 1, g = u & 1, hq = tid >> 7, dq = tid & 127;
                sm[SM_Q + tid] = bf2f(QN[(size_t)t * 1024 + (g * 4 + hq) * 128 + dq]);
                __syncthreads();
                const int ncv = (t >= 31) ? ((t - 31) >> 4) + 1 : 0;
                { auto kf = [](int kk) { return kk; };
                  const float o = naive_attend<4>(sm, tid, ncv, kf, KCMP + g * 128, 256, VCMP + g * 128, 256);
                  const float g0 = GATES[(size_t)t * 32 + (g * 4 + hq) * 3 + 0];
                  OCMP[(size_t)t * 1024 + (g * 4 + hq) * 128 + dq] = (bf16)f2bf(g0 * o); }
                const int tb = t >> 6;
                LAS float* vals = sm + SM_PART;
                if (tid < 256) { const int j = tid; float imp = 0.f;
                    for (int c = 4 * j - 1; c <= 4 * j + 3; ++c) if (c >= 0 && c < ncv) imp += sm[SM_P + c] + sm[SM_P + 1024 + c] + sm[SM_P + 2048 + c] + sm[SM_P + 3072 + c];
                    const bool forced = (j == 0) || (j == tb) || (j == tb - 1);
                    vals[j] = (j > tb) ? -INFINITY : (forced ? 1e9f : imp); }
                __syncthreads();
                bool selq = false;
                if (tid < 256) { const int j = tid; const float v = vals[j]; int rank = 0;
                    for (int jj = 0; jj < 256; ++jj) { const float w = vals[jj]; rank += (w > v || (w == v && jj < j)) ? 1 : 0; }
                    selq = (rank < 16) && (j <= tb); }
                const unsigned long long bal = __ballot(selq);
                if (lane == 0) mi[wave] = __popcll(bal);
                __syncthreads();
                { int off = 0; for (int w = 0; w < wave; ++w) off += mi[w];
                  const int pos = off + __popcll(bal & ((1ull << lane) - 1ull));
                  int* sp = SEL + (size_t)u * 16;
                  if (selq) sp[pos] = tid;
                  const int tot = mi[0] + mi[1] + mi[2] + mi[3];
                  if (tid >= tot && tid < 16) sp[tid] = -1; }
                __syncthreads();
                { const int lo_ = (t >= 511) ? t - 511 : 0; auto kf = [lo_](int kk) { return lo_ + kk; };
                  const float o = naive_attend<4>(sm, tid, t - lo_ + 1, kf, KW + g * 128, 256, VW + g * 128, 256);
                  const float g2 = GATES[(size_t)t * 32 + (g * 4 + hq) * 3 + 2];
                  OWIN[(size_t)t * 1024 + (g * 4 + hq) * 128 + dq] = (bf16)f2bf(g2 * o); }
                __syncthreads();
            } }
            {   ArgsP ap = AP(); unsigned char* ws = ap->ws;
                const bf16* QM = (const bf16*)(ws + WS_QM); const bf16* KM = (const bf16*)(ws + WS_KM); const bf16* VM = (const bf16*)(ws + WS_VM);
                const float* KMEAN = (const float*)(ws + WS_KMEAN); bf16* OMIX = (bf16*)(ws + WS_OMIX);
            for (int u = bid; u < S_ * 8; u += G) { const int t = u >> 3, h = u & 7, own = t >> 8;
                if (tid < 128) sm[SM_Q + tid] = bf2f(QM[(size_t)t * 1024 + h * 128 + tid]);
                __syncthreads();
                if (tid < 64) { float gv = -INFINITY;
                    if (tid < own) { const float* km = KMEAN + (size_t)(tid * 8 + h) * 128; float a = 0.f; for (int d = 0; d < 128; ++d) a += sm[SM_Q + d] * km[d]; gv = a; }
                    for (int r = 0; r < 3; ++r) { float bv = gv; int bi = tid;
#pragma unroll
                        for (int o = 1; o < 64; o <<= 1) { const float ov = __shfl_xor(bv, o); const int oi = __shfl_xor(bi, o); if (ov > bv || (ov == bv && oi < bi)) { bv = ov; bi = oi; } }
                        if (tid == 0) mi[r] = (bv == -INFINITY) ? -1 : bi;
                        if (tid == bi) gv = -INFINITY; }
                }
                __syncthreads();
                { const int nsel = own < 3 ? own : 3;
                  auto kf = [=](int kk) { const int b = kk >> 8; if (b < nsel) { const int blk = mi[b]; return blk * 256 + (kk & 255); } const int kpos = own * 256 + (kk - nsel * 256); return kpos <= t ? kpos : -1; };
                  const float o = naive_attend<1>(sm, tid, nsel * 256 + (t - own * 256 + 1), kf, KM + h * 128, 1024, VM + h * 128, 1024);
                  if (tid < 128) OMIX[(size_t)t * 2048 + 1024 + h * 128 + tid] = (bf16)f2bf(o); }
                __syncthreads();
            } }
            if (BOTH(pb + 4)) GRID_BAR();
        }
        if (IN(pb + 5)) {
            PH_IDS(); ArgsP ap = AP(); unsigned char* ws = ap->ws;
            const bf16* QN = (const bf16*)(ws + WS_QN); const bf16* KS = (const bf16*)(ws + WS_KS); const bf16* VS = (const bf16*)(ws + WS_VS); const float* GATES = (const float*)(ws + WS_GATES);
            const bf16* OCMP = (const bf16*)(ws + WS_OCMP); const bf16* OWIN = (const bf16*)(ws + WS_OWIN); const int* SEL = (const int*)(ws + WS_SEL); bf16* OMIX = (bf16*)(ws + WS_OMIX);
            LAS int* mi = (LAS int*)(sm + SM_MISC);
            for (int u = bid; u < S_ * 2; u += G) { const int t = u >> 1, g = u & 1, hq = tid >> 7, dq = tid & 127;
                sm[SM_Q + tid] = bf2f(QN[(size_t)t * 1024 + (g * 4 + hq) * 128 + dq]);
                if (tid < 16) mi[tid] = SEL[(size_t)u * 16 + tid];
                __syncthreads();
                int nsel = 0; for (int k = 0; k < 16; ++k) nsel += (mi[k] >= 0) ? 1 : 0;
                auto kf = [=](int kk) { const int kpos = mi[kk >> 6] * 64 + (kk & 63); return kpos <= t ? kpos : -1; };
                const float o = naive_attend<4>(sm, tid, nsel * 64, kf, KS + g * 128, 256, VS + g * 128, 256);
                const float g1 = GATES[(size_t)t * 32 + (g * 4 + hq) * 3 + 1];
                const size_t oi = (size_t)t * 1024 + (g * 4 + hq) * 128 + dq;
                OMIX[(size_t)t * 2048 + (g * 4 + hq) * 128 + dq] = (bf16)f2bf(g1 * o + bf2f(OCMP[oi]) + bf2f(OWIN[oi]));
                __syncthreads();
            }
            if (BOTH(pb + 5)) GRID_BAR();
        }
        if (IN(pb + 6)) {
            ArgsP ap = AP(); unsigned char* ws = ap->ws;
            pg8::Gemm g{(const bf16*)(ws + WS_OMIX), (const bf16*)(ws + WS_WOUTT) + (size_t)l * D_ * D_, S_, D_, D_}; pg8::StaticOrder So; So.init(S_, D_, G, bid);
            EpiOutProj E{l == 0 ? ap->in[0] : (const float*)ap->out, ap->out, (const float*)(CTLP(ws) + CW_MOD) + l * 12288 + 4096};
            pg8::gemm_phase<EpiOutProj, pg8::StaticOrder, true, true>(lds, g, So, E);
            if (BOTH(pb + 6)) GRID_BAR();
        }
        if (IN(pb + 7)) {
            PH_IDS(); ArgsP ap = AP(); unsigned char* ws = ap->ws;
            const float* mod = (const float*)(CTLP(ws) + CW_MOD) + l * 12288;
            const float* X = ap->out; bf16* H = (bf16*)(ws + WS_H); const float* w_router = ap->in[12]; const float* b_router = ap->in[13];
            unsigned* CNT = (unsigned*)(CTLP(ws) + CW_CNT) + l * 32; int* TE = (int*)(ws + WS_TE); int* TOKIDX = (int*)(ws + WS_TOKIDX); float* WTS = (float*)(ws + WS_WTS);
            { const float* g_ffn = ap->in[5];
              for (int k = tid; k < D_; k += NTHR) { sm[k] = g_ffn[l * D_ + k] * (1.f + mod[8192 + k]); sm[2048 + k] = mod[6144 + k]; }
              if (tid < 32) sm[4096 + tid] = b_router[tid]; }
            __syncthreads();
            for (int t = gw; t < S_; t += NGW) {
                f32x4 v[8]; float ss = 0.f;
#pragma unroll
                for (int j = 0; j < 8; ++j) { v[j] = *(const f32x4*)(X + (size_t)t * D_ + 256 * j + 4 * lane); ss += (v[j][0] * v[j][0] + v[j][1] * v[j][1]) + (v[j][2] * v[j][2] + v[j][3] * v[j][3]); }
                const float rstd = 1.f / sqrtf(wave_sum(ss) * (1.f / D_) + RMS_EPS);
#pragma unroll
                for (int j = 0; j < 8; ++j) { const int k = 256 * j + 4 * lane; v[j] = v[j] * rstd * *(const LAS f32x4*)(sm + k) + *(const LAS f32x4*)(sm + 2048 + k);
                    *(uint2*)(H + (size_t)t * D_ + k) = make_uint2(pk2(v[j][0], v[j][1]), pk2(v[j][2], v[j][3])); }
                { LAS float* hrow = sm + 8192 + wave * 2048;
#pragma unroll
                  for (int j = 0; j < 8; ++j) *(LAS f32x4*)(hrow + 256 * j + 4 * lane) = v[j];
                  LDS_WAIT(); asm volatile("" ::: "memory");
                  const int e = lane & 31, k0 = (lane >> 5) * 1024; const float* wp = w_router + (size_t)k0 * 32 + e; float acc = 0.f;
#pragma unroll 4
                  for (int k = 0; k < 1024; k += 4) { const f32x4 hv = *(const LAS f32x4*)(hrow + k0 + k);
                      acc += hv[0] * wp[(size_t)k * 32] + hv[1] * wp[(size_t)(k + 1) * 32] + hv[2] * wp[(size_t)(k + 2) * 32] + hv[3] * wp[(size_t)(k + 3) * 32]; }
                  acc += __shfl_xor(acc, 32);
                  if (lane < 32) sm[4160 + wave * 32 + lane] = acc;
                  LDS_WAIT(); asm volatile("" ::: "memory"); }
                float lg[32];
#pragma unroll
                for (int e = 0; e < 32; ++e) lg[e] = sm[4160 + wave * 32 + e];
                int grp = 0; float best = -INFINITY;
#pragma unroll
                for (int e = 0; e < 32; ++e) lg[e] = 1.f / (1.f + __expf(-lg[e]));
#pragma unroll
                for (int gq = 0; gq < 4; ++gq) { float m1 = -INFINITY, m2 = -INFINITY;
#pragma unroll
                    for (int i = 0; i < 8; ++i) { const float b = lg[gq * 8 + i] + sm[4096 + gq * 8 + i]; if (b > m1) { m2 = m1; m1 = b; } else if (b > m2) m2 = b; }
                    const float sgs = m1 + m2; if (sgs > best) { best = sgs; grp = gq; } }
                float m1 = -INFINITY, m2 = -INFINITY, s1 = 0.f, s2 = 0.f; int i1 = 0, i2 = 0;
#pragma unroll
                for (int e = 0; e < 32; ++e) { const bool ing = (e >> 3) == grp; const float b = lg[e] + sm[4096 + e];
                    if (ing && b > m1) { m2 = m1; i2 = i1; s2 = s1; m1 = b; i1 = e; s1 = lg[e]; } else if (ing && b > m2) { m2 = b; i2 = e; s2 = lg[e]; } }
                if (lane == 0) {
                    const float inv = 1.f / (s1 + s2);
                    const unsigned p1 = atomicAdd(CNT + i1, 1u), p2 = atomicAdd(CNT + i2, 1u);
                    TOKIDX[(size_t)i1 * ECAP + p1] = t; TOKIDX[(size_t)i2 * ECAP + p2] = t; WTS[(size_t)i1 * ECAP + p1] = s1 * inv; WTS[(size_t)i2 * ECAP + p2] = s2 * inv;
                    *(int4*)(TE + 4 * t) = make_int4(i1, (int)p1, i2, (int)p2);
                }
            }
            if (BOTH(pb + 7)) GRID_BAR();
        }
        if (IN(pb + 8)) {
            PH_IDS(); ArgsP ap = AP(); unsigned char* ws = ap->ws;
            LOAD_MOETAB((unsigned*)(CTLP(ws) + CW_CNT) + l * 32, 4);
            pg8::Gemm g{(const bf16*)(ws + WS_H), (const bf16*)(ws + WS_WGUT), 0, 0, D_}; MoeOrder<true> So{moetab, 4, G, bid, 4, l * 32 * 4, (const int*)(ws + WS_TOKIDX)};
            EpiGateUp E{(bf16*)(ws + WS_HACT)};
            pg8::gemm_phase<EpiGateUp, MoeOrder<true>, true, true>(lds, g, So, E);
            if (BOTH(pb + 8)) GRID_BAR();
        }
        if (IN(pb + 9)) {
            PH_IDS(); ArgsP ap = AP(); unsigned char* ws = ap->ws;
            LOAD_MOETAB((unsigned*)(CTLP(ws) + CW_CNT) + l * 32, 8);
            pg8::Gemm g{(const bf16*)(ws + WS_HACT), (const bf16*)(ws + WS_WDT), 0, 0, DEXP}; MoeOrder<false> So{moetab, 8, G, bid, 8, l * 32 * 8, nullptr};
            EpiDown E{(bf16*)(ws + WS_Y), (const float*)(ws + WS_WTS), moetab};
            pg8::gemm_phase<EpiDown, MoeOrder<false>, true, true>(lds, g, So, E);
            if (BOTH(pb + 9)) GRID_BAR();
        }
    }
    if (IN(21)) {
        PH_IDS(); ArgsP ap = AP(); unsigned char* ws = ap->ws;
        float* X = ap->out; const bf16* Y = (const bf16*)(ws + WS_Y); const int* TE = (const int*)(ws + WS_TE);
        LOAD_MOETAB((unsigned*)(CTLP(ws) + CW_CNT) + 32, 1);
        const bool tmo_set = (MK_N_LAUNCHES == 1) && (__hip_atomic_load((unsigned*)(CTLP(ws) + CW_BAR) + XB_TMO, RLX_AGENT) != 0u);
        { const float* g_final = ap->in[17]; const float* MOD = (const float*)(CTLP(ws) + CW_MOD);
          for (int k = tid; k < D_; k += NTHR) { sm[k] = g_final[k]; sm[2048 + k] = MOD[12288 + 10240 + k]; } }
        __syncthreads();
        for (int t = gw; t < S_; t += NGW) {
            f32x4 v[8]; float ss = 0.f;
            const int4 te = *(const int4*)(TE + 4 * t);
            const bf16* y0 = Y + (size_t)(moetab[65 + te.x] + te.y) * D_; const bf16* y1 = Y + (size_t)(moetab[65 + te.z] + te.w) * D_;
#pragma unroll
            for (int j = 0; j < 8; ++j) { const int k = 256 * j + 4 * lane; const uint2 a = *(const uint2*)(y0 + k), b = *(const uint2*)(y1 + k);
                const f32x4 gt2 = *(const LAS f32x4*)(sm + 2048 + k);
                f32x4 ysum = (f32x4){bflo(a.x) + bflo(b.x), bfhi(a.x) + bfhi(b.x), bflo(a.y) + bflo(b.y), bfhi(a.y) + bfhi(b.y)};
                v[j] = *(const f32x4*)(X + (size_t)t * D_ + k) + gt2 * ysum;
                ss += (v[j][0] * v[j][0] + v[j][1] * v[j][1]) + (v[j][2] * v[j][2] + v[j][3] * v[j][3]); }
            const float rstd = (tmo_set ? __builtin_nanf("") : 1.f) / sqrtf(wave_sum(ss) * (1.f / D_) + RMS_EPS);
#pragma unroll
            for (int j = 0; j < 8; ++j) { const int k = 256 * j + 4 * lane; *(f32x4*)(X + (size_t)t * D_ + k) = v[j] * rstd * *(const LAS f32x4*)(sm + k); }
        }
    }
#undef IN
#undef BOTH
#undef GRID_BAR
#undef LOAD_MOETAB
#undef AP
#undef CTLP
#undef PH_IDS
}

extern "C" void kernel_launch(void* const* d_in, const int* in_sizes, int n_in, void* d_out, int out_size, void* d_ws, size_t ws_size, hipStream_t stream) {
    static int grid = 0;
    if (grid == 0) {
        if (n_in != 18 || out_size != S_ * D_ || ws_size < WS_END) { fprintf(stderr, "kernel_launch: unexpected shapes (n_in %d out %d ws %zu)\n", n_in, out_size, ws_size); grid = -1; return; }
        int dev = 0, cus = 0, per_cu = 0;
        if (hipGetDevice(&dev) != hipSuccess || hipDeviceGetAttribute(&cus, hipDeviceAttributeMultiprocessorCount, dev) != hipSuccess) { grid = -1; return; }
        if (hipFuncSetAttribute((const void*)mk_fwd, hipFuncAttributeMaxDynamicSharedMemorySize, LDS_BYTES) != hipSuccess) { fprintf(stderr, "kernel_launch: hipFuncSetAttribute failed\n"); grid = -1; return; }
        if (hipOccupancyMaxActiveBlocksPerMultiprocessor(&per_cu, (const void*)mk_fwd, NTHR, LDS_BYTES) != hipSuccess || per_cu < 1) { fprintf(stderr, "kernel_launch: occupancy query says %d\n", per_cu); }
        (void)hipGetLastError();
        grid = cus;
    }
    if (grid < 0) return;
    if (hipMemsetAsync((char*)d_ws + WS_CTL, 0, CTL_ZERO_BYTES, stream) != hipSuccess) return;
    Args a{};
    for (int i = 0; i < 18; ++i) a.in[i] = (const float*)d_in[i];
    a.out = (float*)d_out; a.ws = (unsigned char*)d_ws; a.pad = 0;
    if (MK_N_LAUNCHES == 1) {
        a.ph_lo = 0; a.ph_hi = NPH; a.li = 0;
        hipLaunchKernelGGL(mk_fwd, dim3(grid), dim3(NTHR), LDS_BYTES, stream, a);
    } else {
        for (int p = 0; p < NPH; ++p) { a.ph_lo = p; a.ph_hi = p + 1; a.li = p; hipLaunchKernelGGL(mk_fwd, dim3(grid), dim3(NTHR), LDS_BYTES, stream, a); }
    }
}
```

```cpp
#include <hip/hip_runtime.h>
#include <cstdio>
#include <cstdint>

namespace pg8 {
#define PG8_LAS __attribute__((address_space(3)))
typedef unsigned short bf16_t;
typedef short bf16x8 __attribute__((ext_vector_type(8)));
typedef float f32x4 __attribute__((ext_vector_type(4)));
typedef unsigned u32x4 __attribute__((ext_vector_type(4)));
constexpr int BM = 256, BK = 64, HALF = 128, HTB = HALF * BK * 2, STAGE_BYTES = 8 * HTB, NXCD = 8, WGM = 8;

__host__ __device__ __forceinline__ int lds_byte(int r, int c) { const int st = (r >> 4) * 2 + (c >> 5), rr = r & 15, cc = c & 31, ob = rr * 64 + cc * 2; return st * 1024 + (ob ^ (((ob >> 9) & 1) << 5)); }
__host__ __device__ __forceinline__ void stage_rc(int b, int& R, int& C) { const int st = b / 1024, sb = b % 1024, swz = sb ^ (((sb >> 9) & 1) << 5); R = (st >> 1) * 16 + swz / 64; C = (st & 1) * 32 + (swz % 64) / 2; }
__host__ __device__ __forceinline__ int perm32(int rho) { const int n = rho >> 4, i = rho & 15; return 8 * (i >> 2) + 4 * n + (i & 3); }

struct Unit { int pm, pn, e, mt, pnl; };
struct Gemm { const bf16_t* A; const bf16_t* Bt; int M, N, K; };

struct StaticOrder {
    static constexpr bool GATHER = false;
    int nM, nN, nwg, G, c;
    __host__ __device__ void init(int M, int N, int G_, int c_) { nM = M / BM; nN = N / BM; nwg = nM * nN; G = G_; c = c_; }
    __host__ __device__ bool next(int i, Unit& u) const {
        const long L = (long)i * G + c; if (L >= nwg) return false;
        int wgid = (int)L; { const int q = nwg / NXCD, r = nwg % NXCD, xcd = wgid % NXCD, off = wgid / NXCD; wgid = (xcd < r ? xcd * (q + 1) : r * (q + 1) + (xcd - r) * q) + off; }
        const int nig = WGM * nN, gid = wgid / nig, fm = gid * WGM, gsz = (nM - fm) < WGM ? (nM - fm) : WGM;
        u.pm = fm + ((wgid % nig) % gsz); u.pn = (wgid % nig) / gsz; u.e = 0; u.mt = 0; u.pnl = u.pn; return true;
    }
    __device__ __forceinline__ void a_offs(const Unit&, int, int, int, int, int, unsigned (&)[2][2]) const {}
    __device__ __forceinline__ void a_ready(const Unit&) const {}
    __device__ __forceinline__ void done(const Unit&) const {}
};

__device__ __forceinline__ unsigned cvt_pk_bf16(float lo, float hi) { unsigned r; asm volatile("v_cvt_pk_bf16_f32 %0, %1, %2" : "=v"(r) : "v"(lo), "v"(hi)); return r; }

template <class Epi, class Sched, bool ALIGN_EPI = false, bool SP2 = false>
__device__ __forceinline__ void gemm_phase(PG8_LAS unsigned char* lds, const Gemm g, const Sched& S, const Epi& E) {
    int tid_ = threadIdx.x; asm volatile("" : "+v"(tid_));
    const int tid = tid_, wid = __builtin_amdgcn_readfirstlane(tid >> 6), lane = tid & 63, wr = wid >> 2, wc = wid & 3, fr = lane & 15, fq = lane >> 4;
    const int K = g.K, nt = K / BK;
    unsigned voffA[2], voffB[2]; int RR[2], CC[2];
#pragma unroll
    for (int i = 0; i < 2; ++i) { int R, C; stage_rc(tid * 16 + i * 8192, R, C); const int Rb = Epi::PERM ? ((R & ~31) + perm32(R & 31)) : R;
        RR[i] = R; CC[i] = C; voffA[i] = (unsigned)(R * K + C) * 2u; voffB[i] = (unsigned)(Rb * K + C) * 2u; }
    const size_t kstep = (size_t)(BK * 2);
    const size_t hstep = (size_t)HALF * K * 2;
    const size_t tstep = 2 * hstep;
    const unsigned ldsw = (unsigned)wid * 1024u;
    const int aoff = lds_byte(wr * 64 + fr, fq * 8), boff = lds_byte(wc * 32 + fr, fq * 8);
    const char* gA = (const char*)g.A;
    unsigned aoC[2][2] = {{0u, 0u}, {0u, 0u}}, aoN[2][2] = {{0u, 0u}, {0u, 0u}};
#define PG8_SA(b, h) (((b) * 2 + (h)) * HTB)
#define PG8_SB(b, h) ((4 + (b) * 2 + (h)) * HTB)
#define PG8_STAGE(bufoff, gbase, voff) do { _Pragma("unroll") for (int _i = 0; _i < 2; ++_i) \
        __builtin_amdgcn_global_load_lds((const unsigned*)((const char*)(gbase) + (voff)[_i]), (PG8_LAS unsigned*)(lds + (bufoff) + ldsw + _i * 8192), 16, 0, 0); } while (0)
#define PG8_STAGE_A(bufoff, h, PN, KO) do { if constexpr (Sched::GATHER) { _Pragma("unroll") for (int _i = 0; _i < 2; ++_i) \
        __builtin_amdgcn_global_load_lds((const unsigned*)(gA + aoC[h][_i] + (KO)), (PG8_LAS unsigned*)(lds + (bufoff) + ldsw + _i * 8192), 16, 0, 0); } \
        else { PG8_STAGE(bufoff, (PN) + (h) * hstep, voffA); } } while (0)
#define PG8_LDA(dst, b, h) do { _Pragma("unroll") for (int m = 0; m < 4; ++m) _Pragma("unroll") for (int k = 0; k < 2; ++k) dst[m][k] = *(const PG8_LAS bf16x8*)(lds + PG8_SA(b, h) + aoff + m * 2048 + k * 1024); } while (0)
#define PG8_LDB(dst, b, h) do { _Pragma("unroll") for (int n = 0; n < 2; ++n) _Pragma("unroll") for (int k = 0; k < 2; ++k) dst[n][k] = *(const PG8_LAS bf16x8*)(lds + PG8_SB(b, h) + boff + n * 2048 + k * 1024); } while (0)
#define PG8_MMA(ai, bj, At, Bt) do { __builtin_amdgcn_s_setprio(1); _Pragma("unroll") for (int m = 0; m < 4; ++m) _Pragma("unroll") for (int n = 0; n < 2; ++n) _Pragma("unroll") for (int k = 0; k < 2; ++k) \
        acc[ai][bj][m][n] = __builtin_amdgcn_mfma_f32_16x16x32_bf16(Bt[n][k], At[m][k], acc[ai][bj][m][n], 0, 0, 0); __builtin_amdgcn_s_setprio(0); } while (0)
#define PG8_WAIT_V(n) asm volatile("s_waitcnt vmcnt(" #n ")" ::: "memory")
#define PG8_WAIT_L(n) asm volatile("s_waitcnt lgkmcnt(" #n ")" ::: "memory")
#define PG8_BAR __builtin_amdgcn_s_barrier()
#define PG8_SCHED __builtin_amdgcn_sched_barrier(0)
    Unit cur, nxt; int ui = 0;
    if (!S.next(0, cur)) return;
    f32x4 acc[2][2][4][2];
#pragma unroll
    for (int a = 0; a < 2; ++a)
#pragma unroll
        for (int b = 0; b < 2; ++b)
#pragma unroll
            for (int m = 0; m < 4; ++m)
#pragma unroll
                for (int n = 0; n < 2; ++n) acc[a][b][m][n] = (f32x4){0.f, 0.f, 0.f, 0.f};
    bf16x8 At[4][2], B0[2][2], B1[2][2];
    const char* cA = (const char*)g.A + (size_t)cur.pm * tstep; const char* cB = (const char*)g.Bt + (size_t)cur.pn * tstep;
    if constexpr (Sched::GATHER) S.a_offs(cur, RR[0], RR[1], CC[0], CC[1], K, aoC);
    S.a_ready(cur);
    if constexpr (SP2) {
        PG8_STAGE(PG8_SB(0, 0), cB, voffB); PG8_STAGE(PG8_SB(0, 1), cB + hstep, voffB); PG8_STAGE_A(PG8_SA(0, 0), 0, cA, 0); PG8_STAGE_A(PG8_SA(0, 1), 1, cA, 0);
        if (wr == 1) PG8_BAR;
        PG8_WAIT_V(2); PG8_BAR;
        PG8_STAGE(PG8_SB(1, 0), cB + kstep, voffB); PG8_STAGE_A(PG8_SA(1, 0), 0, cA + kstep, kstep); PG8_STAGE(PG8_SB(1, 1), cB + hstep + kstep, voffB);
        PG8_WAIT_V(6); PG8_BAR;
    } else {
        PG8_STAGE(PG8_SB(0, 0), cB, voffB); PG8_STAGE_A(PG8_SA(0, 0), 0, cA, 0); PG8_STAGE(PG8_SB(0, 1), cB + hstep, voffB); PG8_STAGE_A(PG8_SA(0, 1), 1, cA, 0);
        if (wr == 1) PG8_BAR;
        PG8_WAIT_V(4); PG8_BAR;
        PG8_STAGE(PG8_SB(1, 0), cB + kstep, voffB); PG8_STAGE_A(PG8_SA(1, 0), 0, cA + kstep, kstep); PG8_STAGE(PG8_SB(1, 1), cB + hstep + kstep, voffB);
        PG8_WAIT_V(6); PG8_BAR;
    }
    for (;;) {
        const bool has_next = S.next(ui + 1, nxt);
        const char* nA = has_next ? (const char*)g.A + (size_t)nxt.pm * tstep : cA; const char* nB = has_next ? (const char*)g.Bt + (size_t)nxt.pn * tstep : cB;
        if constexpr (Sched::GATHER) {
            if (has_next) S.a_offs(nxt, RR[0], RR[1], CC[0], CC[1], K, aoN);
            else {
#pragma unroll
                for (int h = 0; h < 2; ++h)
#pragma unroll
                    for (int i = 0; i < 2; ++i) aoN[h][i] = aoC[h][i]; }
        }
        for (int t = 0; t < nt; t += 2) {
            const bool last = (t == nt - 2);
            const char* a1 = cA + (size_t)(t + 1) * kstep;
            const char* a2 = last ? nA : cA + (size_t)(t + 2) * kstep; const char* b2 = last ? nB : cB + (size_t)(t + 2) * kstep;
            const char* a3 = a2 + kstep; const char* b3 = b2 + kstep;
            const size_t k1 = (size_t)(t + 1) * kstep, k2 = last ? (size_t)0 : (size_t)(t + 2) * kstep, k3 = k2 + kstep;
            if (last && has_next) S.a_ready(nxt);
            if constexpr (SP2) {
            PG8_LDB(B0, 0, 0); PG8_LDB(B1, 0, 1); PG8_SCHED; PG8_LDA(At, 0, 0); PG8_STAGE_A(PG8_SA(1, 1), 1, a1, k1);
            if constexpr (Sched::GATHER) { if (last) {
#pragma unroll
                for (int h = 0; h < 2; ++h)
#pragma unroll
                    for (int i = 0; i < 2; ++i) aoC[h][i] = aoN[h][i]; } }
            PG8_WAIT_V(8); PG8_WAIT_L(0); PG8_BAR; PG8_MMA(0, 0, At, B0); PG8_MMA(0, 1, At, B1); PG8_BAR; PG8_SCHED;
            PG8_LDA(At, 0, 1); PG8_STAGE(PG8_SB(0, 0), b2, voffB); PG8_STAGE(PG8_SB(0, 1), b2 + hstep, voffB); PG8_STAGE_A(PG8_SA(0, 0), 0, a2, k2);
            PG8_WAIT_V(8); PG8_WAIT_L(0); PG8_BAR; PG8_MMA(1, 0, At, B0); PG8_MMA(1, 1, At, B1); PG8_BAR; PG8_SCHED;
            PG8_LDB(B0, 1, 0); PG8_LDB(B1, 1, 1); PG8_SCHED; PG8_LDA(At, 1, 0); PG8_STAGE_A(PG8_SA(0, 1), 1, a2, k2);
            PG8_WAIT_V(8); PG8_WAIT_L(0); PG8_BAR; PG8_MMA(0, 0, At, B0); PG8_MMA(0, 1, At, B1); PG8_BAR; PG8_SCHED;
            PG8_LDA(At, 1, 1); PG8_STAGE(PG8_SB(1, 0), b3, voffB); PG8_STAGE(PG8_SB(1, 1), b3 + hstep, voffB); PG8_STAGE_A(PG8_SA(1, 0), 0, a3, k3);
            PG8_WAIT_V(8); PG8_WAIT_L(0); PG8_BAR; PG8_MMA(1, 0, At, B0); PG8_MMA(1, 1, At, B1); PG8_BAR; PG8_SCHED;
            } else {
            PG8_LDB(B0, 0, 0); PG8_SCHED; PG8_LDA(At, 0, 0); PG8_STAGE_A(PG8_SA(1, 1), 1, a1, k1);
            if constexpr (Sched::GATHER) { if (last) {
#pragma unroll
                for (int h = 0; h < 2; ++h)
#pragma unroll
                    for (int i = 0; i < 2; ++i) aoC[h][i] = aoN[h][i]; } }
            PG8_WAIT_L(8); PG8_BAR; PG8_WAIT_L(0); PG8_MMA(0, 0, At, B0); PG8_BAR; PG8_SCHED;
            PG8_LDB(B1, 0, 1); PG8_STAGE(PG8_SB(0, 0), b2, voffB);
            PG8_BAR; PG8_WAIT_L(0); PG8_MMA(0, 1, At, B1); PG8_BAR;
            PG8_LDA(At, 0, 1); PG8_STAGE_A(PG8_SA(0, 0), 0, a2, k2);
            PG8_BAR; PG8_WAIT_L(0); PG8_MMA(1, 0, At, B0); PG8_BAR; PG8_SCHED;
            PG8_STAGE(PG8_SB(0, 1), b2 + hstep, voffB);
            PG8_WAIT_V(6); PG8_BAR; PG8_MMA(1, 1, At, B1); PG8_BAR;
            PG8_LDB(B0, 1, 0); PG8_SCHED; PG8_LDA(At, 1, 0); PG8_STAGE_A(PG8_SA(0, 1), 1, a2, k2);
            PG8_WAIT_L(8); PG8_BAR; PG8_WAIT_L(0); PG8_MMA(0, 0, At, B0); PG8_BAR; PG8_SCHED;
            PG8_LDB(B1, 1, 1); PG8_STAGE(PG8_SB(1, 0), b3, voffB);
            PG8_BAR; PG8_WAIT_L(0); PG8_MMA(0, 1, At, B1); PG8_BAR;
            PG8_LDA(At, 1, 1); PG8_STAGE_A(PG8_SA(1, 0), 0, a3, k3);
            PG8_BAR; PG8_WAIT_L(0); PG8_MMA(1, 0, At, B0); PG8_BAR; PG8_SCHED;
            PG8_STAGE(PG8_SB(1, 1), b3 + hstep, voffB);
            PG8_WAIT_V(6); PG8_BAR; PG8_MMA(1, 1, At, B1); PG8_BAR;
            }
        }
        if constexpr (ALIGN_EPI) { if (wr == 0) PG8_BAR; }
        E(acc, cur, wr, wc, fr, fq); S.done(cur);
        if (!has_next) break;
#pragma unroll
        for (int a = 0; a < 2; ++a)
#pragma unroll
            for (int b = 0; b < 2; ++b)
#pragma unroll
                for (int m = 0; m < 4; ++m)
#pragma unroll
                    for (int n = 0; n < 2; ++n) acc[a][b][m][n] = (f32x4){0.f, 0.f, 0.f, 0.f};
        cur = nxt; cA = nA; cB = nB; ++ui;
        if constexpr (ALIGN_EPI) { if (wr == 1) PG8_BAR; }
    }
    PG8_WAIT_V(0);
    if constexpr (!ALIGN_EPI) { if (wr == 0) PG8_BAR; }
    PG8_BAR;
#undef PG8_SA
#undef PG8_SB
#undef PG8_STAGE
#undef PG8_STAGE_A
#undef PG8_LDA
#undef PG8_LDB
#undef PG8_MMA
#undef PG8_WAIT_V
#undef PG8_WAIT_L
#undef PG8_BAR
#undef PG8_SCHED
}
}

#ifndef MK_N_LAUNCHES
#define MK_N_LAUNCHES 1
#endif
constexpr int NWAVES = 8, NTHR = 512;
constexpr int S_ = 16384, D_ = 2048, DEPTH = 2, HD = 128;
constexpr int IN_W = 5656, NIN = 5888;
constexpr int NC = 1023;
constexpr int NEXP = 32, DEXP = 512, ECAP = 16384, NSLOT = 40960;
constexpr float RMS_EPS = 1e-6f;
constexpr float ATT_SCALE = 0.08838834764831845f;
constexpr int NPL = 15, NPH = 2 + 2 * NPL;

constexpr size_t MiB = 1u << 20;
constexpr size_t WS_CTL = 0, CTL_ZERO_BYTES = 1 * MiB;
constexpr size_t WS_ROPE = 1 * MiB, WS_WINT = 9 * MiB, WS_WOUTT = 55 * MiB, WS_WGUT = 71 * MiB, WS_WDT = 327 * MiB, WS_WC1T = 455 * MiB;
constexpr size_t WS_H = 463 * MiB, WS_QN = 527 * MiB, WS_QM = 559 * MiB, WS_KM = 591 * MiB, WS_VM = 623 * MiB;
constexpr size_t WS_KC = 655 * MiB, WS_VC = 663 * MiB, WS_KS = 671 * MiB, WS_VS = 679 * MiB, WS_KW = 687 * MiB, WS_VW = 695 * MiB;
constexpr size_t WS_GATES = 703 * MiB, WS_UL = 705 * MiB, WS_KCMP = 713 * MiB, WS_VCMP = 713 * MiB + 512 * 1024, WS_KMEAN = 714 * MiB;
constexpr size_t WS_OMIX = 715 * MiB, WS_OCMP = 779 * MiB, WS_OWIN = 811 * MiB, WS_SEL = 843 * MiB, WS_TE = 845 * MiB, WS_TOKIDX = 846 * MiB, WS_WTS = 848 * MiB;
constexpr size_t WS_HACT = 850 * MiB, WS_Y = 890 * MiB;
constexpr size_t WS_NLIST = WS_H, WS_PSLC = 850 * MiB, WS_LSEN = 1106 * MiB;
constexpr size_t WS_MLIST = 1050 * MiB, WS_PSEL = 1082 * MiB, WS_POWN = 1178 * MiB, WS_LSES = 1210 * MiB, WS_LSEO = 1211 * MiB + 512 * 1024, WS_END = 1212 * MiB;
constexpr int CW_TMO = 0, CW_BAR = 4096, CW_CNT = 8192, CW_MCNT = 8704, CW_NCNT = 9728, CW_MOD = 16384, CW_B1E = 40960;

constexpr int RING_BYTES = 131072, LDSCTL_OFF = RING_BYTES, MISC_OFF = LDSCTL_OFF + 320, MOETAB_OFF = LDSCTL_OFF + 512, LDS_BYTES = 147456;

#define GAS __attribute__((address_space(1)))
#define LAS __attribute__((address_space(3)))
typedef unsigned short bf16;
typedef unsigned v4u __attribute__((ext_vector_type(4)));
typedef float f32x4 __attribute__((ext_vector_type(4)));
typedef float f32x2 __attribute__((ext_vector_type(2)));
typedef GAS unsigned gu32;
#define RLX_AGENT __ATOMIC_RELAXED, __HIP_MEMORY_SCOPE_AGENT
#define LDS_WAIT() asm volatile("s_waitcnt lgkmcnt(0)" ::: "memory")
__device__ __forceinline__ unsigned f2bf(float f) { unsigned u = __builtin_bit_cast(unsigned, f); return (u + 0x7fffu + ((u >> 16) & 1u)) >> 16; }
__device__ __forceinline__ unsigned pk2(float lo, float hi) { return f2bf(lo) | (f2bf(hi) << 16); }
__device__ __forceinline__ float bf2f(unsigned b) { return __builtin_bit_cast(float, b << 16); }
__device__ __forceinline__ float bflo(unsigned w) { return __builtin_bit_cast(float, w << 16); }
__device__ __forceinline__ float bfhi(unsigned w) { return __builtin_bit_cast(float, w & 0xffff0000u); }

#define XB_TMO      128
#define XB_XCNT(j)  (256  + 64 * (j))
#define XB_XSUB(j)  (1280 + 64 * (j))
#define XB_XGEN(j)  (2304 + 64 * (j))
#define XB_TOP      3328
#define XB_TOPGEN   3392
#define XCD_BAR_WORDS 3456
#define XB_SPIN_CAP (1u << 23)
__device__ __forceinline__ unsigned xb_ld(unsigned* p)              { return __hip_atomic_load(p, __ATOMIC_RELAXED, __HIP_MEMORY_SCOPE_AGENT); }
__device__ __forceinline__ unsigned xb_add(unsigned* p, unsigned v) { return __hip_atomic_fetch_add(p, v, __ATOMIC_RELAXED, __HIP_MEMORY_SCOPE_AGENT); }
__device__ __forceinline__ unsigned xb_xcc_id() { return (unsigned)__builtin_amdgcn_s_getreg((3 << 11) | 20) & 0xFu; }
#define XB_SPIN(cond, bar) do { unsigned _sp = 0; while (cond) { __builtin_amdgcn_s_sleep(1); \
    if ((++_sp & 255u) == 0u) { if (xb_ld(&(bar)[XB_TMO])) break; if (_sp > XB_SPIN_CAP) { atomicAdd(&(bar)[XB_TMO], 1u); break; } } } } while (0)
struct XcdBarrier { unsigned* bar; unsigned x; volatile LAS unsigned* st; };
__device__ __forceinline__ XcdBarrier xcd_barrier_post(unsigned* bar, volatile LAS unsigned* st) {
    XcdBarrier b; b.bar = bar; b.x = xb_xcc_id(); b.st = st;
    if (threadIdx.x == 0) (void)xb_add(&bar[XB_XCNT(b.x)], 1u);
    return b;
}
__device__ __forceinline__ void xcd_barrier_complete(unsigned* bar, unsigned x, unsigned& nloc, unsigned& nx) {
    const unsigned G = gridDim.x * gridDim.y * gridDim.z;
    unsigned sum, cnt, mine, sp = 0u;
    for (;;) {
        sum = 0u; cnt = 0u; mine = 0u;
#pragma unroll
        for (unsigned j = 0; j < 16; ++j) { const unsigned c = xb_ld(&bar[XB_XCNT(j)]); sum += c; cnt += (c > 0u) ? 1u : 0u; mine = (j == x) ? c : mine; }
        if (sum == G) break;
        __builtin_amdgcn_s_sleep(1);
        if ((++sp & 255u) == 0u) { if (xb_ld(&bar[XB_TMO])) break; if (sp > XB_SPIN_CAP) { atomicAdd(&bar[XB_TMO], 1u); break; } }
    }
    nloc = mine > 0u ? mine : 1u; nx = cnt > 0u ? cnt : 1u;
}
__device__ __forceinline__ void xcd_barrier(const XcdBarrier& b) {
    asm volatile("s_waitcnt vmcnt(0)" ::: "memory");
    __syncthreads();
    if (threadIdx.x == 0) {
        unsigned* bar = b.bar;
        __builtin_amdgcn_s_waitcnt(0);
        unsigned nloc = b.st[0], nx = b.st[1];
        if (nloc == 0u) { xcd_barrier_complete(bar, b.x, nloc, nx); b.st[0] = nloc; b.st[1] = nx; }
        const unsigned old = xb_add(&bar[XB_XSUB(b.x)], 1u);
        const unsigned gen = old / nloc;
        if (old + 1u == (gen + 1u) * nloc) {
            __builtin_amdgcn_fence(__ATOMIC_RELEASE, "agent");
            asm volatile("s_waitcnt vmcnt(0)" ::: "memory");
            const unsigned og = xb_add(&bar[XB_TOP], 1u);
            const unsigned tg = og / nx;
            if (og + 1u == (tg + 1u) * nx) xb_add(&bar[XB_TOPGEN], 1u);
            else XB_SPIN(xb_ld(&bar[XB_TOPGEN]) == tg, bar);
            __builtin_amdgcn_fence(__ATOMIC_ACQUIRE, "agent");
            xb_add(&bar[XB_XGEN(b.x)], 1u);
            asm volatile("s_waitcnt vmcnt(0)" ::: "memory");
        } else {
            XB_SPIN(xb_ld(&bar[XB_XGEN(b.x)]) == gen, bar);
            __builtin_amdgcn_fence(__ATOMIC_ACQUIRE, "agent");
            asm volatile("s_waitcnt vmcnt(0)" ::: "memory");
        }
    }
    __syncthreads();
}

__device__ __forceinline__ float wave_sum(float v) {
#pragma unroll
    for (int o = 1; o < 64; o <<= 1) v += __shfl_xor(v, o);
    return v;
}
__device__ __forceinline__ float wave_max(float v) {
#pragma unroll
    for (int o = 1; o < 64; o <<= 1) v = fmaxf(v, __shfl_xor(v, o));
    return v;
}

__device__ __forceinline__ int il(int d) { return (d < 64) ? 2 * d : 2 * (d - 64) + 1; }
__device__ __forceinline__ int inproj_row(int s) {
    if (s < 1024) return (s & ~127) + il(s & 127);
    if (s < 1536) return s;
    if (s < 1792) return (s & ~127) + il(s & 127);
    if (s < 2048) return s;
    if (s < 2304) return (s & ~127) + il(s & 127);
    if (s < 2560) return s;
    if (s < 2584) return 5632 + (s - 2560);
    if (s < 3608) { const int r = s - 2584; return 2560 + (r & ~127) + il(r & 127); }
    if (s < 4632) { const int r = s - 3608; return 3584 + (r & ~127) + il(r & 127); }
    return 4608 + (s - 4632);
}
template <int MODE>
__device__ __forceinline__ void transpose_item(const float* W, int K, int N, bf16* WT, int dpitch, int row_off, LAS float* scr, int item, int lane) {
    const int nblk = (N + 31) / 32, kb = item / nblk, nb = item % nblk, k0 = 64 * kb, n0 = 32 * nb;
    const int nsrc = n0 + (lane & 31);
#pragma unroll 8
    for (int i = 0; i < 32; ++i) { const int kk = 2 * i + (lane >> 5); scr[kk * 33 + (lane & 31)] = (nsrc < N) ? W[(size_t)(k0 + kk) * N + nsrc] : 0.f; }
    LDS_WAIT(); asm volatile("" ::: "memory");
    const int c = lane & 7;
#pragma unroll
    for (int j = 0; j < 4; ++j) { const int nl = (lane >> 3) + 8 * j, n = n0 + nl; const LAS float* s = scr + (8 * c) * 33 + nl;
        v4u o; o.x = pk2(s[0 * 33], s[1 * 33]); o.y = pk2(s[2 * 33], s[3 * 33]); o.z = pk2(s[4 * 33], s[5 * 33]); o.w = pk2(s[6 * 33], s[7 * 33]);
        if (n < N) { int dr;
            if (MODE == 0) dr = n; else if (MODE == 1) dr = inproj_row(n); else if (MODE == 2) dr = (n >> 7) * 256 + (n & 127); else dr = (n >> 7) * 256 + 128 + (n & 127);
            *(GAS v4u*)(WT + (size_t)(row_off + dr) * dpitch + k0 + 8 * c) = o; } }
    LDS_WAIT(); asm volatile("" ::: "memory");
}

using pg8::Unit;
struct EpiInProj {
    static constexpr bool PERM = true;
    bf16 *QN, *KC, *VC, *KS, *VS, *KW, *VW, *QM, *KM, *VM; float* GATES; const float* rope;
    __device__ __forceinline__ void operator()(const f32x4 (&acc)[2][2][4][2], const Unit& u, int wr, int wc, int fr, int fq) const {
        const int pn = u.pn, row0 = u.pm * 256 + wr * 64 + fr, c8 = wc * 32 + 8 * fq;
        if (pn == 22) {
            if (c8 < 24) {
#pragma unroll
                for (int ai = 0; ai < 2; ++ai)
#pragma unroll
                    for (int m = 0; m < 4; ++m) { const int row = row0 + ai * 128 + m * 16; float* gp = GATES + (size_t)row * 32 + c8;
                        f32x4 a = acc[ai][0][m][0], b = acc[ai][0][m][1], ga, gb;
#pragma unroll
                        for (int j = 0; j < 4; ++j) { ga[j] = 1.f / (1.f + __expf(-a[j])); gb[j] = 1.f / (1.f + __expf(-b[j])); }
                        *(f32x4*)gp = ga; *(f32x4*)(gp + 4) = gb; }
            }
            return;
        }
        bf16* base; int pitch; size_t bjs; bool rot;
        if (pn < 4)       { base = QN + pn * 256;        pitch = 1024; bjs = 128; rot = true; }
        else if (pn == 4) { base = KC;                   pitch = 128;  bjs = (size_t)S_ * 128; rot = false; }
        else if (pn == 5) { base = VC;                   pitch = 128;  bjs = (size_t)S_ * 128; rot = false; }
        else if (pn == 6) { base = KS;                   pitch = 256;  bjs = 128; rot = true; }
        else if (pn == 7) { base = VS;                   pitch = 256;  bjs = 128; rot = false; }
        else if (pn == 8) { base = KW;                   pitch = 256;  bjs = 128; rot = true; }
        else if (pn == 9) { base = VW;                   pitch = 256;  bjs = 128; rot = false; }
        else if (pn < 14) { base = QM + (pn - 10) * 256; pitch = 1024; bjs = 128; rot = true; }
        else if (pn < 18) { base = KM + (pn - 14) * 256; pitch = 1024; bjs = 128; rot = true; }
        else              { base = VM + (pn - 18) * 256; pitch = 1024; bjs = 128; rot = false; }
#pragma unroll
        for (int ai = 0; ai < 2; ++ai)
#pragma unroll
            for (int m = 0; m < 4; ++m) { const int row = row0 + ai * 128 + m * 16;
                f32x4 t0 = (f32x4){1.f, 0.f, 1.f, 0.f}, t1 = t0;
                if (rot) { const f32x4* tp = (const f32x4*)(rope + (size_t)row * 128 + (c8 >> 1) * 2); t0 = tp[0]; t1 = tp[1]; }
#pragma unroll
                for (int bj = 0; bj < 2; ++bj) { f32x4 v0 = acc[ai][bj][m][0], v1 = acc[ai][bj][m][1];
                    if (rot) { f32x4 w0, w1;
                        w0[0] = v0[0] * t0[0] - v0[1] * t0[1]; w0[1] = v0[1] * t0[0] + v0[0] * t0[1]; w0[2] = v0[2] * t0[2] - v0[3] * t0[3]; w0[3] = v0[3] * t0[2] + v0[2] * t0[3];
                        w1[0] = v1[0] * t1[0] - v1[1] * t1[1]; w1[1] = v1[1] * t1[0] + v1[0] * t1[1]; w1[2] = v1[2] * t1[2] - v1[3] * t1[3]; w1[3] = v1[3] * t1[2] + v1[2] * t1[3];
                        v0 = w0; v1 = w1; }
                    pg8::u32x4 w; w.x = pg8::cvt_pk_bf16(v0[0], v0[1]); w.y = pg8::cvt_pk_bf16(v0[2], v0[3]); w.z = pg8::cvt_pk_bf16(v1[0], v1[1]); w.w = pg8::cvt_pk_bf16(v1[2], v1[3]);
                    *(pg8::u32x4*)(base + (size_t)row * pitch + bj * bjs + c8) = w; } }
    }
};
struct EpiOutProj {
    static constexpr bool PERM = false;
    const float* xsrc; float* X; const float* gt;
    __device__ __forceinline__ void operator()(const f32x4 (&acc)[2][2][4][2], const Unit& u, int wr, int wc, int fr, int fq) const {
        const int row0 = u.pm * 256 + wr * 64 + fr, col0 = u.pnl * 256 + wc * 32 + 4 * fq;
        f32x4 gv[2][2];
#pragma unroll
        for (int bj = 0; bj < 2; ++bj)
#pragma unroll
            for (int n = 0; n < 2; ++n) gv[bj][n] = *(const f32x4*)(gt + col0 + bj * 128 + n * 16);
#pragma unroll
        for (int ai = 0; ai < 2; ++ai)
#pragma unroll
            for (int m = 0; m < 4; ++m) { const size_t ro = (size_t)(row0 + ai * 128 + m * 16) * D_ + col0;
#pragma unroll
                for (int bj = 0; bj < 2; ++bj)
#pragma unroll
                    for (int n = 0; n < 2; ++n) { const f32x4 xv = *(const f32x4*)(xsrc + ro + bj * 128 + n * 16); *(f32x4*)(X + ro + bj * 128 + n * 16) = xv + gv[bj][n] * acc[ai][bj][m][n]; } }
    }
};
struct EpiF32 {
    static constexpr bool PERM = false;
    float* C; int ldc;
    __device__ __forceinline__ void operator()(const f32x4 (&acc)[2][2][4][2], const Unit& u, int wr, int wc, int fr, int fq) const {
        const int row0 = u.pm * 256 + wr * 64 + fr, col0 = u.pnl * 256 + wc * 32 + 4 * fq;
#pragma unroll
        for (int ai = 0; ai < 2; ++ai)
#pragma unroll
            for (int m = 0; m < 4; ++m) { float* rowp = C + (size_t)(row0 + ai * 128 + m * 16) * ldc + col0;
#pragma unroll
                for (int bj = 0; bj < 2; ++bj)
#pragma unroll
                    for (int n = 0; n < 2; ++n) *(f32x4*)(rowp + bj * 128 + n * 16) = acc[ai][bj][m][n]; }
    }
};
struct EpiGateUp {
    static constexpr bool PERM = true;
    bf16* HACT;
    __device__ __forceinline__ void operator()(const f32x4 (&acc)[2][2][4][2], const Unit& u, int wr, int wc, int fr, int fq) const {
        const int row0 = u.pm * 256 + wr * 64 + fr, col0 = u.pnl * 128 + wc * 32 + 8 * fq;
#pragma unroll
        for (int ai = 0; ai < 2; ++ai)
#pragma unroll
            for (int m = 0; m < 4; ++m) { const int row = row0 + ai * 128 + m * 16; f32x4 h[2];
#pragma unroll
                for (int n = 0; n < 2; ++n)
#pragma unroll
                    for (int j = 0; j < 4; ++j) { const float gg = acc[ai][0][m][n][j], uu = acc[ai][1][m][n][j]; h[n][j] = gg / (1.f + __expf(-gg)) * uu; }
                pg8::u32x4 w; w.x = pg8::cvt_pk_bf16(h[0][0], h[0][1]); w.y = pg8::cvt_pk_bf16(h[0][2], h[0][3]); w.z = pg8::cvt_pk_bf16(h[1][0], h[1][1]); w.w = pg8::cvt_pk_bf16(h[1][2], h[1][3]);
                *(pg8::u32x4*)(HACT + (size_t)row * DEXP + col0) = w; }
    }
};
struct EpiDown {
    static constexpr bool PERM = true;
    bf16* Y; const float* WTS; const LAS int* tab;
    __device__ __forceinline__ void operator()(const f32x4 (&acc)[2][2][4][2], const Unit& u, int wr, int wc, int fr, int fq) const {
        const int rl0 = wr * 64 + fr, col0 = u.pnl * 256 + wc * 32 + 8 * fq, cnt = tab[u.e];
#pragma unroll
        for (int ai = 0; ai < 2; ++ai)
#pragma unroll
            for (int m = 0; m < 4; ++m) { const int rl = rl0 + ai * 128 + m * 16, pos = u.mt * 256 + rl;
                const float w = (pos < cnt) ? WTS[(size_t)u.e * ECAP + pos] : 0.f;
                bf16* rowp = Y + (size_t)(u.pm * 256 + rl) * D_ + col0;
#pragma unroll
                for (int bj = 0; bj < 2; ++bj) { const f32x4 v0 = acc[ai][bj][m][0] * w, v1 = acc[ai][bj][m][1] * w;
                    pg8::u32x4 o; o.x = pg8::cvt_pk_bf16(v0[0], v0[1]); o.y = pg8::cvt_pk_bf16(v0[2], v0[3]); o.z = pg8::cvt_pk_bf16(v1[0], v1[1]); o.w = pg8::cvt_pk_bf16(v1[2], v1[3]);
                    *(pg8::u32x4*)(rowp + bj * 128) = o; } }
    }
};

struct CompressOrder {
    static constexpr bool GATHER = false;
    int G, c;
    __device__ bool next(int i, Unit& u) const { const int L = i * G + c; if (L >= 32) return false; u.pm = L >> 1; u.pnl = L & 1; u.pn = (u.pm >= 8 ? 2 : 0) + u.pnl; u.e = 0; u.mt = 0; return true; }
    __device__ __forceinline__ void a_offs(const Unit&, int, int, int, int, int, unsigned (&)[2][2]) const {}
    __device__ __forceinline__ void a_ready(const Unit&) const {}
    __device__ __forceinline__ void done(const Unit&) const {}
};
template <bool GATHER_>
struct MoeOrder {
    static constexpr bool GATHER = GATHER_;
    const LAS int* tab; int NT, G, c, bt_per_e, bt_base; const int* tokidx;
    __device__ bool next(int i, Unit& u) const {
        const int L = i * G + c; if (L >= tab[64]) return false;
        int e = 0;
        for (int k = 1; k < NEXP; ++k) e += (L >= tab[32 + k]) ? 1 : 0;
        e = __builtin_amdgcn_readfirstlane(e);
        const int r = L - tab[32 + e];
        u.e = e; u.mt = r / NT; u.pnl = r % NT; u.pn = bt_base + e * bt_per_e + u.pnl; u.pm = (tab[65 + e] >> 8) + u.mt; return true;
    }
    __device__ __forceinline__ void a_offs(const Unit& u, int R0, int R1, int C0, int C1, int K, unsigned (&o)[2][2]) const {
        const int cnt = tab[u.e]; const int* tk = tokidx + (size_t)u.e * ECAP;
#pragma unroll
        for (int h = 0; h < 2; ++h) {
            int p0 = u.mt * 256 + h * 128 + R0, p1 = u.mt * 256 + h * 128 + R1; p0 = p0 < cnt ? p0 : cnt - 1; p1 = p1 < cnt ? p1 : cnt - 1;
            o[h][0] = ((unsigned)tk[p0] * (unsigned)K + (unsigned)C0) * 2u; o[h][1] = ((unsigned)tk[p1] * (unsigned)K + (unsigned)C1) * 2u; }
    }
    __device__ __forceinline__ void a_ready(const Unit&) const {}
    __device__ __forceinline__ void done(const Unit&) const {}
};

constexpr int SM_Q = 0, SM_P = 512, SM_KP = 4608, SM_RED = 5632, SM_PART = 5696, SM_MISC = 6208;
template <int NH, class KeyFn>
__device__ __forceinline__ float naive_attend(LAS float* sm, int tid, int nkeys, const KeyFn keyfn, const bf16* Kb, int kpitch, const bf16* Vb, int vpitch) {
    LAS int* kp = (LAS int*)(sm + SM_KP);
    const int lane = tid & 63, wave = tid >> 6;
    float sc[NH][2];
#pragma unroll
    for (int i = 0; i < 2; ++i) {
        const int kk = tid + 512 * i; const int kpos = (kk < nkeys) ? keyfn(kk) : -1; kp[kk] = kpos;
        float a[NH];
#pragma unroll
        for (int h = 0; h < NH; ++h) a[h] = 0.f;
        if (kpos >= 0) { const v4u* kr = (const v4u*)(Kb + (size_t)kpos * kpitch);
#pragma unroll 4
            for (int c = 0; c < 16; ++c) { const v4u kv = kr[c];
                const float k0 = bflo(kv.x), k1 = bfhi(kv.x), k2 = bflo(kv.y), k3 = bfhi(kv.y), k4 = bflo(kv.z), k5 = bfhi(kv.z), k6 = bflo(kv.w), k7 = bfhi(kv.w);
#pragma unroll
                for (int h = 0; h < NH; ++h) { const f32x4 qa = *(const LAS f32x4*)(sm + SM_Q + h * 128 + 8 * c), qb = *(const LAS f32x4*)(sm + SM_Q + h * 128 + 8 * c + 4);
                    a[h] += qa[0] * k0 + qa[1] * k1 + qa[2] * k2 + qa[3] * k3 + qb[0] * k4 + qb[1] * k5 + qb[2] * k6 + qb[3] * k7; } } }
#pragma unroll
        for (int h = 0; h < NH; ++h) sc[h][i] = (kpos >= 0) ? a[h] * ATT_SCALE : -INFINITY;
    }
#pragma unroll
    for (int h = 0; h < NH; ++h) { const float m = wave_max(fmaxf(sc[h][0], sc[h][1])); if (lane == 0) sm[SM_RED + wave * NH + h] = m; }
    __syncthreads();
    float mx[NH];
#pragma unroll
    for (int h = 0; h < NH; ++h) { float m = sm[SM_RED + h];
#pragma unroll
        for (int w = 1; w < 8; ++w) m = fmaxf(m, sm[SM_RED + w * NH + h]); mx[h] = m; }
    __syncthreads();
#pragma unroll
    for (int h = 0; h < NH; ++h) {
#pragma unroll
        for (int i = 0; i < 2; ++i) sc[h][i] = (sc[h][i] == -INFINITY) ? 0.f : __expf(sc[h][i] - mx[h]);
        const float s = wave_sum(sc[h][0] + sc[h][1]); if (lane == 0) sm[SM_RED + wave * NH + h] = s; }
    __syncthreads();
#pragma unroll
    for (int h = 0; h < NH; ++h) { float s = 0.f;
#pragma unroll
        for (int w = 0; w < 8; ++w) s += sm[SM_RED + w * NH + h];
        const float inv = s > 0.f ? 1.f / s : 0.f;
#pragma unroll
        for (int i = 0; i < 2; ++i) sm[SM_P + h * 1024 + tid + 512 * i] = sc[h][i] * inv; }
    __syncthreads();
    const int d = tid & 127, hs = tid >> 7;
    float o = 0.f;
    {
        const int hrow = (NH == 4) ? hs * 1024 : 0;
        const int k0 = (NH == 4) ? 0 : hs * 256, k1 = (NH == 4) ? nkeys : ((k0 + 256 < nkeys) ? k0 + 256 : nkeys);
        for (int kb = k0; kb < k1; kb += 8) {
            int kq[8]; float pq[8], vq[8];
#pragma unroll
            for (int j = 0; j < 8; ++j) { const int kpos = kp[kb + j]; pq[j] = (kpos >= 0 && kb + j < k1) ? sm[SM_P + hrow + kb + j] : 0.f; kq[j] = kpos >= 0 ? kpos : 0; }
#pragma unroll
            for (int j = 0; j < 8; ++j) vq[j] = bf2f(Vb[(size_t)kq[j] * vpitch + d]);
#pragma unroll
            for (int j = 0; j < 8; ++j) o += pq[j] * vq[j];
        }
    }
    if (NH == 1) {
        sm[SM_PART + tid] = o; __syncthreads();
        if (tid < 128) o = sm[SM_PART + tid] + sm[SM_PART + 128 + tid] + sm[SM_PART + 256 + tid] + sm[SM_PART + 384 + tid];
    }
    return o;
}

namespace att {
constexpr int D = 128, NW = 8, QBLK = 32, KVBLK = 64, QB = NW * QBLK;
constexpr int SHM_V = KVBLK * D * 2, SHM_K = KVBLK * D * 2;
constexpr int OFF_WS = 2 * SHM_V + 2 * SHM_K, OFF_OT = OFF_WS + NW * 64 * 4, LDS_BYTES = OFF_OT + NW * 32 * 4;
constexpr float SCALE = 0.08838834764831845f, THR = 8.f;
typedef short bf16x8 __attribute__((ext_vector_type(8)));
typedef short s16x4 __attribute__((ext_vector_type(4)));
typedef float f32x16 __attribute__((ext_vector_type(16)));
typedef float f32x4 __attribute__((ext_vector_type(4)));
typedef unsigned u32x4 __attribute__((ext_vector_type(4)));
typedef unsigned short bf16;
#define KSWZ(row, colB) ((row) * 256 + ((colB) ^ (((row) & 7) << 4)))
#define SBAR() __builtin_amdgcn_sched_barrier(0)
__device__ __forceinline__ int v_st(int k, int c) { const int kk = (k & ~0xC) | ((k & 4) << 1) | ((k & 8) >> 1); return ((kk >> 3) * 4 + (c >> 5)) * 512 + ((kk & 7) * 32 + (c & 31)) * 2; }
__device__ __forceinline__ int v_rd_base(int lane) { return ((lane & 3) << 3) | (((lane >> 2) & 3) << 6) | (((lane >> 4) & 1) << 5) | (((lane >> 5) & 1) << 8); }
constexpr int v_rd_off(int d0, int ks, int half) { return d0 * 512 + ks * 4096 + half * 2048; }
__device__ __forceinline__ int crow(int r, int hi) { return (r & 3) + 8 * (r >> 2) + 4 * hi; }
__device__ __forceinline__ unsigned cvtpk(float lo, float hi) { unsigned r; asm volatile("v_cvt_pk_bf16_f32 %0, %1, %2" : "=v"(r) : "v"(lo), "v"(hi)); return r; }
__device__ __forceinline__ bf16x8 load8(const bf16* p) { return *reinterpret_cast<const bf16x8*>(p); }
__device__ __forceinline__ void mask_tile(f32x16& p0, f32x16& p1, int dq, unsigned W) {
    const float NEG = -__builtin_inff();
#pragma unroll
    for (int r = 0; r < 16; ++r) {
        const int c = (r & 3) + 8 * (r >> 2);
        if ((unsigned)(dq - c) >= W) p0[r] = NEG;
        if ((unsigned)(dq - c - 32) >= W) p1[r] = NEG;
    }
}
__device__ __forceinline__ void partialSM(f32x16& p0, f32x16& p1, float& m_reg, float& mn, float& alpha) {
    float pmax = p0[0]; for (int r = 1; r < 16; ++r) pmax = fmaxf(pmax, p0[r]); for (int r = 0; r < 16; ++r) pmax = fmaxf(pmax, p1[r]);
    { auto rr = __builtin_amdgcn_permlane32_swap(__float_as_uint(pmax), __float_as_uint(pmax), false, false);
      pmax = fmaxf(__uint_as_float(rr[0]), __uint_as_float(rr[1])); }
    constexpr float C2 = 1.4426950408889634f * SCALE;
    if (__builtin_expect(__all((pmax - m_reg) * SCALE <= THR), 1)) { mn = m_reg; alpha = 1.f; }
    else { mn = fmaxf(m_reg, pmax); alpha = __builtin_amdgcn_exp2f((m_reg - mn) * C2); m_reg = mn; }
    const float mnL = -mn * C2;
    for (int r = 0; r < 16; ++r) p0[r] = fmaf(p0[r], C2, mnL); for (int r = 0; r < 16; ++r) p1[r] = fmaf(p1[r], C2, mnL);
    for (int r = 0; r < 16; ++r) p0[r] = __builtin_amdgcn_exp2f(p0[r]);
}
__device__ __forceinline__ void finishSM(f32x16& p0, f32x16& p1, float alpha, float& l_reg, bf16x8& pa0, bf16x8& pa1, bf16x8& pa2, bf16x8& pa3) {
    for (int r = 0; r < 16; ++r) p1[r] = __builtin_amdgcn_exp2f(p1[r]);
    float ps = 0; for (int r = 0; r < 16; ++r) ps += p0[r]; for (int r = 0; r < 16; ++r) ps += p1[r];
    { auto rr = __builtin_amdgcn_permlane32_swap(__float_as_uint(ps), __float_as_uint(ps), false, false);
      ps = __uint_as_float(rr[0]) + __uint_as_float(rr[1]); }
    l_reg = l_reg * alpha + ps;
#define PK4(P, B_, OUT) do { unsigned a0 = cvtpk(P[B_+0], P[B_+1]), a1 = cvtpk(P[B_+2], P[B_+3]);                          \
        unsigned b0 = cvtpk(P[B_+4], P[B_+5]), b1 = cvtpk(P[B_+6], P[B_+7]);                                             \
        auto r0 = __builtin_amdgcn_permlane32_swap(a0, b0, false, false); auto r1 = __builtin_amdgcn_permlane32_swap(a1, b1, false, false); \
        u32x4 w = {r0[0], r1[0], r0[1], r1[1]}; OUT = *reinterpret_cast<bf16x8*>(&w); } while (0)
    PK4(p0, 0, pa0); PK4(p0, 8, pa1); PK4(p1, 0, pa2); PK4(p1, 8, pa3);
#undef PK4
}
template <int KB, bool SK>
__device__ __forceinline__ void qkt(f32x16& p0, f32x16& p1, const char* K_lds, int r32, int hi, const bf16x8* qr, bool act) {
    if (SK && !act) { const float NEG = -__builtin_inff();
#pragma unroll
        for (int r = 0; r < 16; ++r) { p0[r] = NEG; p1[r] = NEG; } return; }
    p0 = f32x16{}; p1 = f32x16{};
    const char* kb[4];
#pragma unroll
    for (int dd = 0; dd < 4; ++dd) kb[dd] = K_lds + KB * SHM_K + KSWZ(r32, (dd * 16 + hi * 8) * 2);
#pragma unroll
    for (int d0 = 0; d0 < 8; ++d0) { const char* a = kb[d0 & 3] + (d0 >> 2) * 128;
        bf16x8 b0 = *reinterpret_cast<const bf16x8*>(a);
        bf16x8 b1 = *reinterpret_cast<const bf16x8*>(a + 32 * 256);
        p0 = __builtin_amdgcn_mfma_f32_32x32x16_bf16(b0, qr[d0], p0, 0, 0, 0);
        p1 = __builtin_amdgcn_mfma_f32_32x32x16_bf16(b1, qr[d0], p1, 0, 0, 0); }
}
template <int VB, bool SK>
__device__ __forceinline__ void pv_tile(f32x16* o, int vb0, bf16x8 pa0, bf16x8 pa1, bf16x8 pa2, bf16x8 pa3, bool act) {
    if (SK && !act) return;
#define TRRD(dst, off) asm volatile("ds_read_b64_tr_b16 %0, %1 offset:%2" : "=&v"(dst) : "v"(vb0), "i"(off) : "memory")
#define PV_D0(d0) do { s16x4 l0, l1, l2, l3, h0, h1, h2, h3; constexpr int b_ = VB * SHM_V + v_rd_off(d0, 0, 0); \
        TRRD(l0, b_); TRRD(h0, b_ + 2048); TRRD(l1, b_ + 4096); TRRD(h1, b_ + 6144); TRRD(l2, b_ + 8192); TRRD(h2, b_ + 10240); TRRD(l3, b_ + 12288); TRRD(h3, b_ + 14336); \
        asm volatile("s_waitcnt lgkmcnt(0)" ::: "memory"); SBAR();   \
        o[d0] = __builtin_amdgcn_mfma_f32_32x32x16_bf16(pa0, (bf16x8){l0[0], l0[1], l0[2], l0[3], h0[0], h0[1], h0[2], h0[3]}, o[d0], 0, 0, 0);   \
        o[d0] = __builtin_amdgcn_mfma_f32_32x32x16_bf16(pa1, (bf16x8){l1[0], l1[1], l1[2], l1[3], h1[0], h1[1], h1[2], h1[3]}, o[d0], 0, 0, 0);   \
        o[d0] = __builtin_amdgcn_mfma_f32_32x32x16_bf16(pa2, (bf16x8){l2[0], l2[1], l2[2], l2[3], h2[0], h2[1], h2[2], h2[3]}, o[d0], 0, 0, 0);   \
        o[d0] = __builtin_amdgcn_mfma_f32_32x32x16_bf16(pa3, (bf16x8){l3[0], l3[1], l3[2], l3[3], h3[0], h3[1], h3[2], h3[3]}, o[d0], 0, 0, 0); } while (0)
    PV_D0(0); PV_D0(1); PV_D0(2); PV_D0(3);
#undef PV_D0
#undef TRRD
}
struct Ref { const bf16* Q; const bf16* K; const bf16* V; bf16* O; const int* list; int kpitch, j_lo, j_hi, P0, W, a0, a1; };
struct Seam { bf16x8 qr[8]; bf16x8 st_v0, st_v1, st_k0, st_k1; };
#define ROW(p, kp, k0, rr) ((p) + (size_t)((k0) + (rr)) * (kp) + sc)
#define VMW() asm volatile("s_waitcnt vmcnt(0)" ::: "memory")
#define VMWN(n) asm volatile("s_waitcnt vmcnt(%0)" :: "i"(n) : "memory")
#define SLOAD_H(Kp, Vp, kp, k0) do { S.st_v0 = load8(ROW(Vp, kp, k0, sr)); S.st_v1 = load8(ROW(Vp, kp, k0, 32 + sr));              \
                         S.st_k0 = load8(ROW(Kp, kp, k0, sr)); S.st_k1 = load8(ROW(Kp, kp, k0, 32 + sr)); } while (0)
#define SWRITE_HK(bf) do { *(bf16x8*)(K_lds + (bf) * SHM_K + kws) = S.st_k0; *(bf16x8*)(K_lds + (bf) * SHM_K + kws + 32 * 256) = S.st_k1; } while (0)
#define SWRITE_HV(bf) do { *(bf16x8*)(V_lds + (bf) * SHM_V + vst0) = S.st_v0; *(bf16x8*)(V_lds + (bf) * SHM_V + vst1) = S.st_v1; } while (0)
#define SWRITE_H(bf) do { SWRITE_HV(bf); SWRITE_HK(bf); } while (0)
template <class RF>
__device__ __forceinline__ void prime(const Ref& cur, char* lds, Seam& S) {
    int tid_ = threadIdx.x; asm volatile("" : "+v"(tid_));
    const int tid = tid_, wid = __builtin_amdgcn_readfirstlane(tid >> 6), lane = tid & 63, r32 = lane & 31, hi = lane >> 5;
    const int sr = tid >> 4, sc = (tid & 15) * 8, kws = KSWZ(sr, sc * 2); char* K_lds = lds + 2 * SHM_V;
    const int kb0 = cur.j_lo * KVBLK;
    { const bf16* qrow = cur.Q + RF::q_off(cur, wid * QBLK + r32);
      for (int d0 = 0; d0 < 8; ++d0) S.qr[d0] = load8(qrow + d0 * 16 + hi * 8); }
    SLOAD_H(cur.K, cur.V, cur.kpitch, kb0); VMW(); SWRITE_HK(0);
    __syncthreads();
}
template <int MODE, bool WSKIP, class RF>
__device__ __forceinline__ void block(const Ref& cur, const Ref& nxt, float* LSE, char* lds, Seam& S) {
    int tid_ = threadIdx.x; asm volatile("" : "+v"(tid_));
    const int tid = tid_, wid = __builtin_amdgcn_readfirstlane(tid >> 6), lane = tid & 63, r32 = lane & 31, hi = lane >> 5;
    const int j_lo = cur.j_lo, NT = cur.j_hi - cur.j_lo;
    const int kbn = nxt.j_lo * KVBLK;
    const int W = cur.W;
    const int qlo = cur.P0 + wid * QBLK;
    const int qm = (MODE == 2 ? RF::pos(cur, wid * QBLK + r32) : qlo + r32) - 4 * hi;
    const unsigned Wm = (MODE == 2) ? (unsigned)RF::Wl(cur, wid * QBLK + r32) : (unsigned)W;
    char* V_lds = lds; char* K_lds = lds + 2 * SHM_V;
    float* ws = (float*)(lds + OFF_WS) + wid * 64; float* li_l = ws, * al_l = ws + 32; int* ot_l = (int*)(lds + OFF_OT) + wid * 32;
    float m_reg = -1e30f, l_reg = 0; f32x16 o[4] = {};
    const int sr = tid >> 4, sc = (tid & 15) * 8, vst0 = v_st(sr, sc), vst1 = v_st(32 + sr, sc), kws = KSWZ(sr, sc * 2);
    const int vb0 = (int)(uintptr_t)V_lds + v_rd_base(lane);
    const bf16* Kh = cur.K; const bf16* Vh = cur.V; const int kp = cur.kpitch;
#define RESC(a) do { if (__any((a) < 1.f)) { if (hi == 0) al_l[r32] = (a); asm volatile("s_waitcnt lgkmcnt(0)" ::: "memory");              \
                     for (int d_ = 0; d_ < 4; ++d_) for (int r = 0; r < 16; ++r) o[d_][r] *= al_l[crow(r, hi)]; } } while (0)
#define KBASE(t) ((j_lo + (t)) * KVBLK)
#define ACT(t) (MODE != 0 || (KBASE(t) <= qlo + QBLK - 1 && KBASE(t) + KVBLK - 1 >= qlo - W + 1))
#define MASKT(P0_, P1_, t) do { const int kb_ = KBASE(t); if (MODE == 2) mask_tile(P0_, P1_, qm - kb_, Wm); \
        else if (MODE == 0) { if ((!SK || ACT(t)) && (kb_ + KVBLK - 1 > qlo || kb_ <= qlo + QBLK - 1 - W)) mask_tile(P0_, P1_, qm - kb_, Wm); } } while (0)
    constexpr int NQL = 8;
    constexpr bool SK = WSKIP && MODE == 0;
#define SEAM_K0() do { VMWN(NQL); SWRITE_HK(0); SBAR(); } while (0)
    f32x16 pA0, pA1, pB0, pB1; float mnA, mnB, alA, alB; bf16x8 pa0, pa1, pa2, pa3;
    SWRITE_HV(0); SBAR();
    if (NT > 1) { SLOAD_H(Kh, Vh, kp, KBASE(1)); }
    SBAR(); qkt<0, SK>(pA0, pA1, K_lds, r32, hi, S.qr, ACT(0));
    MASKT(pA0, pA1, 0); partialSM(pA0, pA1, m_reg, mnA, alA);
    if (NT > 1) { VMW(); SWRITE_H(1); }
    __syncthreads();
#define HALF_STEP(PX0, PX1, mnX, alX, PY0, PY1, alY, t, KB, VB, SB) do {                                                      \
        SBAR(); qkt<KB, SK>(PX0, PX1, K_lds, r32, hi, S.qr, ACT(t));                                             \
        finishSM(PY0, PY1, alY, l_reg, pa0, pa1, pa2, pa3); SBAR();                                                           \
        if ((t) + 1 < NT) { SLOAD_H(Kh, Vh, kp, KBASE((t) + 1)); SBAR(); }                                               \
        pv_tile<VB, SK>(o, vb0, pa0, pa1, pa2, pa3, ACT((t) - 1)); MASKT(PX0, PX1, (t)); partialSM(PX0, PX1, m_reg, mnX, alX);                                        \
        __syncthreads();                                                                                                      \
        if ((t) + 1 < NT) { VMW(); SWRITE_H(SB); }                                                                          \
        RESC(alX); __syncthreads(); } while (0)
    for (int t = 1; t + 1 < NT; t += 2) {
        HALF_STEP(pB0, pB1, mnB, alB, pA0, pA1, alA, t, 1, 0, 0);
        HALF_STEP(pA0, pA1, mnA, alA, pB0, pB1, alB, t + 1, 0, 1, 1);
    }
    const bool even = (NT & 1) == 0;
    if (even) { SBAR(); qkt<1, SK>(pB0, pB1, K_lds, r32, hi, S.qr, ACT(NT - 1)); SBAR(); }
    SLOAD_H(nxt.K, nxt.V, nxt.kpitch, kbn); SBAR();
    { const bf16* qrow = nxt.Q + RF::q_off(nxt, wid * QBLK + r32);
#pragma unroll
      for (int d0 = 0; d0 < 8; ++d0) S.qr[d0] = load8(qrow + d0 * 16 + hi * 8); }
    SBAR();
    finishSM(pA0, pA1, alA, l_reg, pa0, pa1, pa2, pa3); SBAR();
    pv_tile<0, SK>(o, vb0, pa0, pa1, pa2, pa3, ACT(even ? NT - 2 : NT - 1));
    if (even) { MASKT(pB0, pB1, NT - 1); partialSM(pB0, pB1, m_reg, mnB, alB); __syncthreads(); RESC(alB);
        finishSM(pB0, pB1, alB, l_reg, pa0, pa1, pa2, pa3); SBAR(); pv_tile<1, SK>(o, vb0, pa0, pa1, pa2, pa3, ACT(NT - 1)); }
    SBAR(); SEAM_K0();
    if (hi == 0) { li_l[r32] = l_reg; ot_l[r32] = RF::o_off(cur, wid * QBLK + r32); } asm volatile("s_waitcnt lgkmcnt(0)" ::: "memory");
    if (LSE != nullptr && hi == 0) { const int lq = RF::l_idx(cur, wid * QBLK + r32); if (lq >= 0) LSE[lq] = (l_reg > 0.f) ? m_reg * SCALE + __logf(l_reg) : -__builtin_inff(); }
    bf16* O = cur.O;
#pragma unroll
    for (int r = 0; r < 16; ++r) { const int orow = crow(r, hi); const float lv = li_l[orow]; const float rl = (lv > 0.f) ? __builtin_amdgcn_rcpf(lv) : 0.f; const int oo = ot_l[orow];
#pragma unroll
        for (int d0 = 0; d0 < 4; ++d0) { const float v = o[d0][r] * rl; const float vn = __shfl_xor(v, 1);
            if (oo >= 0 && (r32 & 1) == 0) *(unsigned*)(O + (size_t)oo + d0 * 32 + r32) = cvtpk(v, vn); } }
    __syncthreads();
#undef RESC
#undef KBASE
#undef ACT
#undef MASKT
#undef SEAM_K0
#undef HALF_STEP
}
#undef ROW
#undef VMW
#undef VMWN
#undef SLOAD_H
#undef SWRITE_HK
#undef SWRITE_HV
#undef SWRITE_H
#undef KSWZ
#undef SBAR
}

struct RFReg {
    static __device__ __forceinline__ int q_off(const att::Ref&, int row) { return row * 1024; }
    static __device__ __forceinline__ int o_off(const att::Ref&, int row) { return row * 1024; }
    static __device__ __forceinline__ int l_idx(const att::Ref& u, int row) { return u.a0 >= 0 ? u.a0 + row * 8 : -1; }
    static __device__ __forceinline__ int pos(const att::Ref& u, int row) { return u.P0 + row; }
    static __device__ __forceinline__ int Wl(const att::Ref& u, int) { return u.W; }
};
__device__ __forceinline__ att::Ref win_ref(int L, const bf16* QN, const bf16* KW, const bf16* VW, bf16* OWIN) {
    const int h = L & 7, qb = L >> 3;
    att::Ref r; r.Q = QN + (size_t)qb * 256 * 1024 + h * 128; r.O = OWIN + (size_t)qb * 256 * 1024 + h * 128; r.K = KW + (h >> 2) * 128; r.V = VW + (h >> 2) * 128; r.kpitch = 256; r.list = nullptr;
    r.P0 = qb * 256; r.W = 512; r.j_lo = (r.P0 >= 511) ? (r.P0 - 511) >> 6 : 0; r.j_hi = ((r.P0 + 255) >> 6) + 1; r.a0 = -1; r.a1 = 0; return r;
}
__device__ __forceinline__ att::Ref mown_ref(int L, const bf16* QM, const bf16* KM, const bf16* VM, bf16* POWN) {
    const int h = L & 7, n = L >> 3; const size_t o = (size_t)n * 256 * 1024 + h * 128;
    att::Ref r; r.Q = QM + o; r.O = POWN + o; r.K = KM + o; r.V = VM + o; r.kpitch = 1024; r.list = nullptr;
    r.P0 = 0; r.W = 1 << 20; r.j_lo = 0; r.j_hi = 4; r.a0 = n * 256 * 8 + h; r.a1 = 0; return r;
}
struct RFSel {
    static __device__ __forceinline__ int q_off(const att::Ref& u, int row) { const int e = u.list[row < u.a0 ? row : 0]; return (e >> 2) * 1024; }
    static __device__ __forceinline__ int o_off(const att::Ref& u, int row) { if (row >= u.a0) return -1; const int e = u.list[row]; return (((e >> 2) * 8 + u.a1) * 3 + (e & 3)) * 128; }
    static __device__ __forceinline__ int l_idx(const att::Ref& u, int row) { if (row >= u.a0) return -1; const int e = u.list[row]; return ((e >> 2) * 8 + u.a1) * 3 + (e & 3); }
    static __device__ __forceinline__ int pos(const att::Ref&, int) { return 0; }
    static __device__ __forceinline__ int Wl(const att::Ref&, int) { return 0; }
};
__device__ __forceinline__ att::Ref msel_ref(int L, const LAS int* tab, const int* MLIST, const bf16* QM, const bf16* KM, const bf16* VM, bf16* PSEL) {
    int lo = 0, hi = 512;
    while (hi - lo > 1) { const int mid = (lo + hi) >> 1; if (tab[512 + mid] <= L) lo = mid; else hi = mid; }
    const int lid = __builtin_amdgcn_readfirstlane(lo), k = L - tab[512 + lid], h = lid >> 6, n = lid & 63;
    att::Ref r; r.Q = QM + h * 128; r.O = PSEL; r.K = KM + (size_t)n * 256 * 1024 + h * 128; r.V = VM + (size_t)n * 256 * 1024 + h * 128; r.kpitch = 1024;
    r.list = MLIST + (size_t)lid * 16384 + k * 256; r.P0 = 0; r.W = 0; r.j_lo = 0; r.j_hi = 4; r.a0 = tab[lid] - k * 256; r.a1 = h; return r;
}

struct RFSlc {
    static __device__ __forceinline__ int q_off(const att::Ref& u, int row) { const int e = u.list[(row >> 2) < u.a0 ? (row >> 2) : 0]; return (e >> 4) * 1024 + (row & 3) * 128; }
    static __device__ __forceinline__ int o_off(const att::Ref& u, int row) { if ((row >> 2) >= u.a0) return -1; const int e = u.list[row >> 2]; return (e * 4 + (row & 3)) * 128; }
    static __device__ __forceinline__ int l_idx(const att::Ref& u, int row) { if ((row >> 2) >= u.a0) return -1; const int e = u.list[row >> 2]; return e * 4 + (row & 3); }
    static __device__ __forceinline__ int pos(const att::Ref& u, int row) { const int e = u.list[(row >> 2) < u.a0 ? (row >> 2) : 0]; return (e >> 4) - 64 * u.a1; }
    static __device__ __forceinline__ int Wl(const att::Ref&, int) { return 1 << 30; }
};
__device__ __forceinline__ att::Ref nsel_ref(int L, int g, const LAS int* tab, const int* NLIST, const bf16* QN, const bf16* KS, const bf16* VS, bf16* PSLC) {
    int lo = 0, hi = 256;
    while (hi - lo > 1) { const int mid = (lo + hi) >> 1; if (tab[256 + mid] <= L) lo = mid; else hi = mid; }
    const int j = __builtin_amdgcn_readfirstlane(lo), k = L - tab[256 + j];
    att::Ref r; r.Q = QN + g * 512; r.O = PSLC; r.K = KS + (size_t)j * 64 * 256 + g * 128; r.V = VS + (size_t)j * 64 * 256 + g * 128; r.kpitch = 256;
    r.list = NLIST + (size_t)(g * 256 + j) * 16384 + k * 64; r.P0 = 0; r.W = 0; r.j_lo = 0; r.j_hi = 1; r.a0 = tab[j] - k * 64; r.a1 = j; return r;
}

struct Args { const float* in[18]; float* out; unsigned char* ws; int ph_lo, ph_hi, li, pad; };
typedef const __attribute__((address_space(4))) Args* ArgsP;
__device__ __forceinline__ ArgsP get_args() { auto p = __builtin_amdgcn_kernarg_segment_ptr(); asm volatile("" : "+s"(p)); return (ArgsP)p; }

__global__ void __launch_bounds__(NTHR, 2) mk_fwd(Args args_unused) {
    extern __shared__ __attribute__((aligned(16))) unsigned char lds_raw[];
    LAS unsigned char* lds = (LAS unsigned char*)lds_raw;
    LAS float* sm = (LAS float*)lds;
    volatile LAS unsigned* MISC = (volatile LAS unsigned*)(lds + MISC_OFF);
    LAS int* moetab = (LAS int*)(lds + MOETAB_OFF);
    const int G = gridDim.x, bid = blockIdx.x, NGW = G * NWAVES;
#define PH_IDS() int tid_ = threadIdx.x; asm volatile("" : "+v"(tid_)); const int tid = tid_, lane = tid & 63, wave = __builtin_amdgcn_readfirstlane(tid >> 6), gw = bid * NWAVES + wave; (void)lane; (void)gw;
#define AP() get_args()
#define CTLP(ws) ((gu32*)((ws) + WS_CTL))

    for (int u = threadIdx.x; u < (LDS_BYTES - LDSCTL_OFF) / 4; u += NTHR) ((LAS unsigned*)(lds + LDSCTL_OFF))[u] = 0u;
    __syncthreads();
    XcdBarrier bar; bar.bar = nullptr; bar.x = 0; bar.st = nullptr;
    if (MK_N_LAUNCHES == 1) bar = xcd_barrier_post((unsigned*)(CTLP(AP()->ws) + CW_BAR), MISC + 8);
#define GRID_BAR() do { if (MK_N_LAUNCHES == 1) { XcdBarrier b_ = bar; b_.bar = (unsigned*)(CTLP(AP()->ws) + CW_BAR); xcd_barrier(b_); } } while (0)
    const int lo = AP()->ph_lo, hi = AP()->ph_hi;
#define IN(k) (lo <= (k) && (k) < hi)
#define BOTH(k) (IN(k) && IN((k) + 1))

    if (IN(0)) {
        PH_IDS(); ArgsP ap = AP(); unsigned char* ws = ap->ws;
        LAS float* scr = (LAS float*)(lds + wave * 16384);
        constexpr int I_IN = 32 * 177, I_OUT = 32 * 64, I_GU = 32 * 16, I_DN = 8 * 64, I_W1 = 32 * 8;
        constexpr int N_IN = 2 * I_IN, N_OUT = 2 * I_OUT, N_G = 64 * I_GU, N_U = 64 * I_GU, N_D = 64 * I_DN, N_W1 = 8 * I_W1;
        constexpr int NITEMS = N_IN + N_OUT + N_G + N_U + N_D + N_W1;
        for (int it = gw; it < NITEMS; it += NGW) {
            int r = it;
            if (r < N_IN) { const int l = r / I_IN; transpose_item<1>(ap->in[6] + (size_t)l * D_ * IN_W, D_, IN_W, (bf16*)(ws + WS_WINT) + (size_t)l * NIN * D_, D_, 0, scr, r % I_IN, lane); continue; } r -= N_IN;
            if (r < N_OUT) { const int l = r / I_OUT; transpose_item<0>(ap->in[7] + (size_t)l * D_ * D_, D_, D_, (bf16*)(ws + WS_WOUTT) + (size_t)l * D_ * D_, D_, 0, scr, r % I_OUT, lane); continue; } r -= N_OUT;
            if (r < N_G) { const int le = r / I_GU; transpose_item<2>(ap->in[14] + (size_t)le * D_ * DEXP, D_, DEXP, (bf16*)(ws + WS_WGUT) + (size_t)le * 1024 * D_, D_, 0, scr, r % I_GU, lane); continue; } r -= N_G;
            if (r < N_U) { const int le = r / I_GU; transpose_item<3>(ap->in[15] + (size_t)le * D_ * DEXP, D_, DEXP, (bf16*)(ws + WS_WGUT) + (size_t)le * 1024 * D_, D_, 0, scr, r % I_GU, lane); continue; } r -= N_U;
            if (r < N_D) { const int le = r / I_DN; transpose_item<0>(ap->in[16] + (size_t)le * DEXP * D_, DEXP, D_, (bf16*)(ws + WS_WDT) + (size_t)le * D_ * DEXP, DEXP, 0, scr, r % I_DN, lane); continue; } r -= N_D;
            { const int m = r / I_W1, lk = m >> 1, half = m & 1;
              transpose_item<0>(ap->in[9] + (size_t)lk * 4096 * 256 + (size_t)half * 2048 * 256, 2048, 256, (bf16*)(ws + WS_WC1T) + (size_t)lk * 512 * 2048, 2048, half * 256, scr, r % I_W1, lane); }
        }
        { f32x2* ROPE = (f32x2*)(ws + WS_ROPE);
          for (int idx = bid * NTHR + tid; idx < S_ * 64; idx += G * NTHR) { const int pos = idx >> 6, i = idx & 63;
            const double inv = exp(-(double)i * (9.210340371976184 / 64.0)); const double ang = (double)pos * inv; double sv, cv; sincos(ang, &sv, &cv);
            ROPE[idx] = (f32x2){(float)cv, (float)sv}; } }
        __syncthreads();
        { float* MOD = (float*)(CTLP(ws) + CW_MOD); const float* c_in = ap->in[1]; const float* w_ada = ap->in[2]; const float* b_ada = ap->in[3];
          for (int k = tid; k < D_; k += NTHR) { const float cv = c_in[k]; sm[k] = cv / (1.f + __expf(-cv)); }
          __syncthreads();
          for (int it = bid; it < 2 * 96; it += G) { const int l = it / 96, cb = it % 96, grp = tid >> 5, col = cb * 128 + (tid & 31) * 4;
            f32x4 a = (f32x4){0.f, 0.f, 0.f, 0.f};
            const float* wp = w_ada + ((size_t)l * D_ + grp) * 12288 + col;
#pragma unroll 8
            for (int i = 0; i < 128; ++i) a += *(const f32x4*)(wp + (size_t)i * 16 * 12288) * sm[grp + 16 * i];
            *(LAS f32x4*)(sm + 4096 + grp * 128 + (tid & 31) * 4) = a;
            __syncthreads();
            if (tid < 128) { float s = b_ada[l * 12288 + cb * 128 + tid];
#pragma unroll
                for (int q = 0; q < 16; ++q) s += sm[4096 + q * 128 + tid];
                MOD[l * 12288 + cb * 128 + tid] = s; }
            __syncthreads(); } }
        { float* B1E = (float*)(CTLP(ws) + CW_B1E); const float* cmp_pe = ap->in[8]; const float* cmp_w1 = ap->in[9]; const float* cmp_b1 = ap->in[10];
          for (int it = bid - 192; it >= 0 && it < 4; it += G) { const int lk = it, grp = tid >> 6, n = (tid & 63) * 4;
            f32x4 a = (f32x4){0.f, 0.f, 0.f, 0.f};
            const float* wp = cmp_w1 + ((size_t)lk * 4096 + grp) * 256 + n; const float* pe = cmp_pe + (size_t)lk * 4096 + grp;
#pragma unroll 8
            for (int i = 0; i < 512; ++i) a += *(const f32x4*)(wp + (size_t)i * 8 * 256) * pe[i * 8];
            *(LAS f32x4*)(sm + 4096 + grp * 256 + n) = a;
            __syncthreads();
            if (tid < 256) { float s = cmp_b1[lk * 256 + tid];
#pragma unroll
                for (int q = 0; q < 8; ++q) s += sm[4096 + q * 256 + tid];
                B1E[lk * 256 + tid] = s; }
            __syncthreads(); } }
        if (BOTH(0)) GRID_BAR();
    }

    for (int l = 0; l < DEPTH; ++l) {
        const int pb = 1 + NPL * l;
#define LOAD_MOETAB(CNTP, NT_) do { __syncthreads(); if (tid < 32) moetab[tid] = (int)__hip_atomic_load((CNTP) + tid, RLX_AGENT); __syncthreads(); \
        if (tid == 0) { int us = 0, ps = 0; for (int e = 0; e < NEXP; ++e) { const int c = moetab[e], tl = (c + 255) >> 8; moetab[32 + e] = us; moetab[65 + e] = ps; us += tl * (NT_); ps += tl << 8; } moetab[64] = us; } \
        __syncthreads(); } while (0)

        if (IN(pb + 0)) {
            PH_IDS(); ArgsP ap = AP(); unsigned char* ws = ap->ws;
            const float* MOD = (const float*)(CTLP(ws) + CW_MOD); const float* mod = MOD + l * 12288;
            float* X = ap->out; bf16* H = (bf16*)(ws + WS_H); const bf16* Y = (const bf16*)(ws + WS_Y); const int* TE = (const int*)(ws + WS_TE);
            if (l > 0) LOAD_MOETAB((unsigned*)(CTLP(ws) + CW_CNT) + (l - 1) * 32, 1);
            { const float* g_attn = ap->in[4];
              for (int k = tid; k < D_; k += NTHR) { sm[k] = g_attn[l * D_ + k] * (1.f + mod[2048 + k]); sm[2048 + k] = mod[k]; sm[4096 + k] = (l > 0) ? MOD[(l - 1) * 12288 + 10240 + k] : 0.f; } }
            __syncthreads();
            const float* x_in = ap->in[0];
            for (int t = gw; t < S_; t += NGW) {
                f32x4 v[8]; float ss = 0.f;
                if (l == 0) {
#pragma unroll
                    for (int j = 0; j < 8; ++j) v[j] = *(const f32x4*)(x_in + (size_t)t * D_ + 256 * j + 4 * lane);
                } else {
                    const int4 te = *(const int4*)(TE + 4 * t);
                    const bf16* y0 = Y + (size_t)(moetab[65 + te.x] + te.y) * D_; const bf16* y1 = Y + (size_t)(moetab[65 + te.z] + te.w) * D_;
#pragma unroll
                    for (int j = 0; j < 8; ++j) { const int k = 256 * j + 4 * lane; const uint2 a = *(const uint2*)(y0 + k), b = *(const uint2*)(y1 + k);
                        const f32x4 gt2 = *(const LAS f32x4*)(sm + 4096 + k);
                        f32x4 ysum = (f32x4){bflo(a.x) + bflo(b.x), bfhi(a.x) + bfhi(b.x), bflo(a.y) + bflo(b.y), bfhi(a.y) + bfhi(b.y)};
                        v[j] = *(const f32x4*)(X + (size_t)t * D_ + k) + gt2 * ysum; *(f32x4*)(X + (size_t)t * D_ + k) = v[j]; }
                }
#pragma unroll
                for (int j = 0; j < 8; ++j) ss += (v[j][0] * v[j][0] + v[j][1] * v[j][1]) + (v[j][2] * v[j][2] + v[j][3] * v[j][3]);
                const float rstd = 1.f / sqrtf(wave_sum(ss) * (1.f / D_) + RMS_EPS);
#pragma unroll
                for (int j = 0; j < 8; ++j) { const int k = 256 * j + 4 * lane; const f32x4 h = v[j] * rstd * *(const LAS f32x4*)(sm + k) + *(const LAS f32x4*)(sm + 2048 + k);
                    *(uint2*)(H + (size_t)t * D_ + k) = make_uint2(pk2(h[0], h[1]), pk2(h[2], h[3])); }
            }
            if (BOTH(pb + 0)) GRID_BAR();
        }
        if (IN(pb + 1)) {
            ArgsP ap = AP(); unsigned char* ws = ap->ws;
            pg8::Gemm g{(const bf16*)(ws + WS_H), (const bf16*)(ws + WS_WINT) + (size_t)l * NIN * D_, S_, NIN, D_}; pg8::StaticOrder So; So.init(S_, NIN, G, bid);
            EpiInProj E{(bf16*)(ws + WS_QN), (bf16*)(ws + WS_KC), (bf16*)(ws + WS_VC), (bf16*)(ws + WS_KS), (bf16*)(ws + WS_VS), (bf16*)(ws + WS_KW), (bf16*)(ws + WS_VW),
                        (bf16*)(ws + WS_QM), (bf16*)(ws + WS_KM), (bf16*)(ws + WS_VM), (float*)(ws + WS_GATES), (const float*)(ws + WS_ROPE)};
            pg8::gemm_phase<EpiInProj, pg8::StaticOrder, true, true>(lds, g, So, E);
            if (BOTH(pb + 1)) GRID_BAR();
        }
        if (IN(pb + 2)) {
            PH_IDS(); ArgsP ap = AP(); unsigned char* ws = ap->ws;
            if (bid < 32) {
                pg8::Gemm g{(const bf16*)(ws + WS_KC), (const bf16*)(ws + WS_WC1T) + (size_t)l * 2 * 512 * 2048, 4096, 512, 2048}; CompressOrder So{G, bid};
                EpiF32 E{(float*)(ws + WS_UL), 512};
                pg8::gemm_phase<EpiF32, CompressOrder, false, true>(lds, g, So, E);
            }
            {
                const bf16* KM = (const bf16*)(ws + WS_KM); float* KMEAN = (float*)(ws + WS_KMEAN);
                const int nb = (G > 32) ? G - 32 : G, b0 = (G > 32) ? bid - 32 : bid;
                if (b0 >= 0) for (int u = b0; u < 512; u += nb) { const int n = u >> 3, h = u & 7, p = tid & 127, q = tid >> 7;
                    float s = 0.f; const bf16* kp = KM + (size_t)(n * 256 + q * 64) * 1024 + h * 128 + p;
#pragma unroll 16
                    for (int i = 0; i < 64; ++i) s += bf2f(kp[(size_t)i * 1024]);
                    sm[tid] = s; __syncthreads();
                    if (tid < 128) KMEAN[(size_t)(n * 8 + h) * 128 + tid] = (sm[tid] + sm[128 + tid] + sm[256 + tid] + sm[384 + tid]) * (1.f / 256.f);
                    __syncthreads(); }
            }
            if (BOTH(pb + 2)) GRID_BAR();
        }
        if (IN(pb + 3)) {
            PH_IDS(); ArgsP ap = AP(); unsigned char* ws = ap->ws;
            const float* UL = (const float*)(ws + WS_UL); const float* B1E = (const float*)(CTLP(ws) + CW_B1E); const f32x2* ROPE = (const f32x2*)(ws + WS_ROPE);
            bf16* KCMP = (bf16*)(ws + WS_KCMP); bf16* VCMP = (bf16*)(ws + WS_VCMP); const float* cmp_w2 = ap->in[11];
            LAS float* hid = sm + wave * 256;
            for (int u = gw; u < 2 * NC * 2; u += NGW) { const int kv = u / (NC * 2), r = u % (NC * 2), c = r >> 1, g = r & 1;
                const float* Ur = UL + ((size_t)kv * 2048 + g * 1024 + c) * 512; const float* Lr = UL + ((size_t)kv * 2048 + g * 1024 + c + 1) * 512 + 256;
                const float* be = B1E + (l * 2 + kv) * 256;
#pragma unroll
                for (int j = 0; j < 4; ++j) { const int n = lane + 64 * j; const float v = Ur[n] + Lr[n] + be[n];
                    hid[n] = 0.5f * v * (1.f + tanhf(0.7978845608028654f * (v + 0.044715f * v * v * v))); }
                LDS_WAIT(); asm volatile("" ::: "memory");
                const float* w2 = cmp_w2 + (size_t)(l * 2 + kv) * 256 * 128;
                float o0 = 0.f, o1 = 0.f;
#pragma unroll 8
                for (int n = 0; n < 256; ++n) { const float hv = hid[n]; o0 += hv * w2[n * 128 + lane]; o1 += hv * w2[n * 128 + 64 + lane]; }
                if (kv == 0) { const f32x2 cs = ROPE[(size_t)(16 * c + 31) * 64 + lane];
                    const float a = o0 * cs[0] - o1 * cs[1], b = o1 * cs[0] + o0 * cs[1];
                    *(unsigned*)(KCMP + ((size_t)c * 2 + g) * 128 + 2 * lane) = pk2(a, b);
                } else { VCMP[((size_t)c * 2 + g) * 128 + lane] = (bf16)f2bf(o0); VCMP[((size_t)c * 2 + g) * 128 + 64 + lane] = (bf16)f2bf(o1); }
                LDS_WAIT(); asm volatile("" ::: "memory");
            }
            if (BOTH(pb + 3)) GRID_BAR();
        }
        if (IN(pb + 4)) {
            {   PH_IDS(); LAS int* mi = (LAS int*)(sm + SM_MISC); ArgsP ap = AP(); unsigned char* ws = ap->ws;
                const bf16* QN = (const bf16*)(ws + WS_QN); const bf16* KCMP = (const bf16*)(ws + WS_KCMP); const bf16* VCMP = (const bf16*)(ws + WS_VCMP);
                const bf16* KW = (const bf16*)(ws + WS_KW); const bf16* VW = (const bf16*)(ws + WS_VW); const float* GATES = (const float*)(ws + WS_GATES);
                bf16* OCMP = (bf16*)(ws + WS_OCMP); bf16* OWIN = (bf16*)(ws + WS_OWIN); int* SEL = (int*)(ws + WS_SEL);
                unsigned* NCNT = (unsigned*)(CTLP(ws) + CW_NCNT) + l * 512; int* NLIST = (int*)(ws + WS_NLIST);
            for (int u = bid; u < S_ * 2; u += G) { const int t = u >> 1, g = u & 1, hq = tid >> 7, dq = tid & 127;
                sm[SM_Q + tid] = bf2f(QN[(size_t)t * 1024 + (g * 4 + hq) * 128 + dq]);
                __syncthreads();
                const int ncv = (t >= 31) ? ((t - 31) >> 4) + 1 : 0;
                { auto kf = [](int kk) { return kk; };
                  const float o = naive_attend<4>(sm, tid, ncv, kf, KCMP + g * 128, 256, VCMP + g * 128, 256);
                  const float g0 = GATES[(size_t)t * 32 + (g * 4 + hq) * 3 + 0];
                  OCMP[(size_t)t * 1024 + (g * 4 + hq) * 128 + dq] = (bf16)f2bf(g0 * o); }
                const int tb = t >> 6;
                LAS float* vals = sm + SM_PART;
                if (tid < 256) { const int j = tid; float imp = 0.f;
                    for (int c = 4 * j - 1; c <= 4 * j + 3; ++c) if (c >= 0 && c < ncv) imp += sm[SM_P + c] + sm[SM_P + 1024 + c] + sm[SM_P + 2048 + c] + sm[SM_P + 3072 + c];
                    const bool forced = (j == 0) || (j == tb) || (j == tb - 1);
                    vals[j] = (j > tb) ? -INFINITY : (forced ? 1e9f : imp); }
                __syncthreads();
                bool selq = false;
                if (tid < 256) { const int j = tid; const float v = vals[j]; int rank = 0;
                    for (int jj = 0; jj < 256; ++jj) { const float w = vals[jj]; rank += (w > v || (w == v && jj < j)) ? 1 : 0; }
                    selq = (rank < 16) && (j <= tb); }
                const unsigned long long bal = __ballot(selq);
                if (lane == 0) mi[wave] = __popcll(bal);
                __syncthreads();
                { int off = 0; for (int w = 0; w < wave; ++w) off += mi[w];
                  const int pos = off + __popcll(bal & ((1ull << lane) - 1ull));
                  int* sp = SEL + (size_t)u * 16;
                  if (selq) { sp[pos] = tid; const unsigned p = atomicAdd(NCNT + g * 256 + tid, 1u); NLIST[(size_t)(g * 256 + tid) * 16384 + p] = t * 16 + pos; }
                  const int tot = mi[0] + mi[1] + mi[2] + mi[3];
                  if (tid >= tot && tid < 16) sp[tid] = -1; }
                __syncthreads();
            } }
            {   ArgsP ap = AP(); unsigned char* ws = ap->ws;
                const bf16* QN = (const bf16*)(ws + WS_QN); const bf16* KW = (const bf16*)(ws + WS_KW); const bf16* VW = (const bf16*)(ws + WS_VW); bf16* OWIN = (bf16*)(ws + WS_OWIN);
                __syncthreads();
                att::Seam S; int L = bid;
                if (L < 512) { att::Ref cur = win_ref(L, QN, KW, VW, OWIN); att::prime<RFReg>(cur, (char*)lds_raw, S);
                    for (;;) { const bool more = L + G < 512; const att::Ref nxt = more ? win_ref(L + G, QN, KW, VW, OWIN) : cur;
                        att::block<0, true, RFReg>(cur, nxt, nullptr, (char*)lds_raw, S);
                        if (!more) break; cur = nxt; L += G; } }
                __syncthreads();
            }
            {   PH_IDS(); ArgsP ap = AP(); unsigned char* ws = ap->ws;
                const bf16* QM = (const bf16*)(ws + WS_QM); const float* KMEAN = (const float*)(ws + WS_KMEAN);
                unsigned* MCNT = (unsigned*)(CTLP(ws) + CW_MCNT) + l * 512; int* MLIST = (int*)(ws + WS_MLIST); float* LSES = (float*)(ws + WS_LSES);
                LAS float* qs = sm; LAS float* ks = sm + 8192; LAS float* gs = sm + 8192 + 64 * 132;
                for (int u = bid; u < 2048; u += G) { const int c = u >> 3, h = u & 7, own = c >> 2;
                    __syncthreads();
                    for (int i = tid; i < 64 * 128; i += NTHR) qs[i] = bf2f(QM[(size_t)(c * 64 + (i >> 7)) * 1024 + h * 128 + (i & 127)]);
                    for (int i = tid; i < own * 128; i += NTHR) ks[(i >> 7) * 132 + (i & 127)] = KMEAN[(size_t)((i >> 7) * 8 + h) * 128 + (i & 127)];
                    __syncthreads();
                    { const int q = tid >> 3, nn = tid & 7;
                      for (int n = nn; n < own; n += 8) { float a = 0.f;
#pragma unroll 8
                          for (int d = 0; d < 128; d += 4) { const f32x4 qa = *(const LAS f32x4*)(qs + q * 128 + d), ka = *(const LAS f32x4*)(ks + n * 132 + d); a += qa[0] * ka[0] + qa[1] * ka[1] + qa[2] * ka[2] + qa[3] * ka[3]; }
                          gs[q * 64 + n] = a; } }
                    __syncthreads();
                    for (int qq = 0; qq < 8; ++qq) { const int q = wave * 8 + qq, t = c * 64 + q;
                        float gv = (lane < own) ? gs[q * 64 + lane] : -INFINITY; int mysel = -1;
                        for (int r = 0; r < 3; ++r) { float bv = gv; int bi = lane;
#pragma unroll
                            for (int o = 1; o < 64; o <<= 1) { const float ov = __shfl_xor(bv, o); const int oi = __shfl_xor(bi, o); if (ov > bv || (ov == bv && oi < bi)) { bv = ov; bi = oi; } }
                            if (lane == r) mysel = (bv == -INFINITY) ? -1 : bi;
                            if (lane == bi) gv = -INFINITY; }
                        if (lane < 3) {
                            if (mysel >= 0) { const unsigned p = atomicAdd(MCNT + h * 64 + mysel, 1u); MLIST[(size_t)(h * 64 + mysel) * 16384 + p] = t * 4 + lane; }
                            else LSES[(t * 8 + h) * 3 + lane] = -INFINITY; } }
                }
            }
            if (BOTH(pb + 4)) GRID_BAR();
        }
        if (IN(pb + 5)) {
            PH_IDS(); ArgsP ap = AP(); unsigned char* ws = ap->ws;
            {   PH_IDS(); ArgsP ap = AP(); unsigned char* ws = ap->ws;
                const bf16* QM = (const bf16*)(ws + WS_QM); const bf16* KM = (const bf16*)(ws + WS_KM); const bf16* VM = (const bf16*)(ws + WS_VM);
                bf16* POWN = (bf16*)(ws + WS_POWN); bf16* PSEL = (bf16*)(ws + WS_PSEL); float* LSEO = (float*)(ws + WS_LSEO); float* LSES = (float*)(ws + WS_LSES);
                const int* MLIST = (const int*)(ws + WS_MLIST); unsigned* MCNT = (unsigned*)(CTLP(ws) + CW_MCNT) + l * 512;
                LAS int* mtab = (LAS int*)(lds + att::LDS_BYTES);
                __syncthreads();
                mtab[tid] = (int)__hip_atomic_load(MCNT + tid, RLX_AGENT);
                __syncthreads();
                if (tid == 0) { int us = 0; for (int i = 0; i < 512; ++i) { mtab[512 + i] = us; us += (mtab[i] + 255) >> 8; } mtab[1024] = us; }
                __syncthreads();
                const int nsel = mtab[1024];
                att::Seam S;
                { int L = bid;
                  if (L < 512) { att::Ref cur = mown_ref(L, QM, KM, VM, POWN); att::prime<RFReg>(cur, (char*)lds_raw, S);
                    for (;;) { const bool more = L + G < 512; const att::Ref nxt = more ? mown_ref(L + G, QM, KM, VM, POWN) : cur;
                        att::block<0, true, RFReg>(cur, nxt, LSEO, (char*)lds_raw, S);
                        if (!more) break; cur = nxt; L += G; } } }
                __syncthreads();
                { int L = bid;
                  if (L < nsel) { att::Ref cur = msel_ref(L, mtab, MLIST, QM, KM, VM, PSEL); att::prime<RFSel>(cur, (char*)lds_raw, S);
                    for (;;) { const bool more = L + G < nsel; const att::Ref nxt = more ? msel_ref(L + G, mtab, MLIST, QM, KM, VM, PSEL) : cur;
                        att::block<1, false, RFSel>(cur, nxt, LSES, (char*)lds_raw, S);
                        if (!more) break; cur = nxt; L += G; } } }
                __syncthreads();
            }
            if (BOTH(pb + 5)) GRID_BAR();
        }
        if (IN(pb + 6)) {
            PH_IDS(); ArgsP ap = AP(); unsigned char* ws = ap->ws;
            const bf16* POWN = (const bf16*)(ws + WS_POWN); const bf16* PSEL = (const bf16*)(ws + WS_PSEL); const float* LSEO = (const float*)(ws + WS_LSEO); const float* LSES = (const float*)(ws + WS_LSES);
            bf16* OMIX = (bf16*)(ws + WS_OMIX);
            for (int t = gw; t < S_; t += NGW) {
#pragma unroll 2
                for (int h = 0; h < 8; ++h) {
                    const float l0 = LSEO[t * 8 + h], l1 = LSES[(t * 8 + h) * 3], l2 = LSES[(t * 8 + h) * 3 + 1], l3 = LSES[(t * 8 + h) * 3 + 2];
                    const float m = fmaxf(fmaxf(l0, l1), fmaxf(l2, l3));
                    const float w0 = __expf(l0 - m), w1 = __expf(l1 - m), w2 = __expf(l2 - m), w3 = __expf(l3 - m), inv = 1.f / (w0 + w1 + w2 + w3);
                    const unsigned a0 = *(const unsigned*)(POWN + (size_t)t * 1024 + h * 128 + 2 * lane);
                    float o0 = w0 * bflo(a0), o1 = w0 * bfhi(a0);
                    const bf16* ps = PSEL + (size_t)((t * 8 + h) * 3) * 128 + 2 * lane;
                    if (w1 > 0.f) { const unsigned a = *(const unsigned*)(ps); o0 += w1 * bflo(a); o1 += w1 * bfhi(a); }
                    if (w2 > 0.f) { const unsigned a = *(const unsigned*)(ps + 128); o0 += w2 * bflo(a); o1 += w2 * bfhi(a); }
                    if (w3 > 0.f) { const unsigned a = *(const unsigned*)(ps + 256); o0 += w3 * bflo(a); o1 += w3 * bfhi(a); }
                    *(unsigned*)(OMIX + (size_t)t * 2048 + 1024 + h * 128 + 2 * lane) = pk2(o0 * inv, o1 * inv);
                }
            }
            if (BOTH(pb + 6)) GRID_BAR();

        }
        for (int g = 0; g < 2; ++g) {
            if (IN(pb + 7 + 2 * g)) {
                PH_IDS(); ArgsP ap = AP(); unsigned char* ws = ap->ws;
                const bf16* QN = (const bf16*)(ws + WS_QN); const bf16* KS = (const bf16*)(ws + WS_KS); const bf16* VS = (const bf16*)(ws + WS_VS);
                bf16* PSLC = (bf16*)(ws + WS_PSLC); float* LSEN = (float*)(ws + WS_LSEN); const int* NLIST = (const int*)(ws + WS_NLIST); unsigned* NCNT = (unsigned*)(CTLP(ws) + CW_NCNT) + l * 512 + g * 256;
                LAS int* ntab = (LAS int*)(lds + att::LDS_BYTES);
                __syncthreads();
                if (tid < 256) ntab[tid] = (int)__hip_atomic_load(NCNT + tid, RLX_AGENT);
                __syncthreads();
                if (tid == 0) { int us = 0; for (int i = 0; i < 256; ++i) { ntab[256 + i] = us; us += (ntab[i] + 63) >> 6; } ntab[512] = us; }
                __syncthreads();
                const int nun = ntab[512];
                att::Seam S; int L = bid;
                if (L < nun) { att::Ref cur = nsel_ref(L, g, ntab, NLIST, QN, KS, VS, PSLC); att::prime<RFSlc>(cur, (char*)lds_raw, S);
                    for (;;) { const bool more = L + G < nun; const att::Ref nxt = more ? nsel_ref(L + G, g, ntab, NLIST, QN, KS, VS, PSLC) : cur;
                        att::block<2, false, RFSlc>(cur, nxt, LSEN, (char*)lds_raw, S);
                        if (!more) break; cur = nxt; L += G; } }
                __syncthreads();
                if (BOTH(pb + 7 + 2 * g)) GRID_BAR();
            }
            if (IN(pb + 8 + 2 * g)) {
                PH_IDS(); ArgsP ap = AP(); unsigned char* ws = ap->ws;
                const bf16* PSLC = (const bf16*)(ws + WS_PSLC); const float* LSEN = (const float*)(ws + WS_LSEN); const int* SEL = (const int*)(ws + WS_SEL); const float* GATES = (const float*)(ws + WS_GATES);
                const bf16* OCMP = (const bf16*)(ws + WS_OCMP); const bf16* OWIN = (const bf16*)(ws + WS_OWIN); bf16* OMIX = (bf16*)(ws + WS_OMIX);
                for (int t = gw; t < S_; t += NGW) {
                    int nsel = 0;
#pragma unroll
                    for (int s = 0; s < 16; ++s) nsel += (SEL[(size_t)(t * 2 + g) * 16 + s] >= 0) ? 1 : 0;
#pragma unroll 1
                    for (int r = 0; r < 4; ++r) {
                        float m = -INFINITY;
                        for (int s = 0; s < nsel; ++s) m = fmaxf(m, LSEN[(size_t)(t * 16 + s) * 4 + r]);
                        float o0 = 0.f, o1 = 0.f, wsum = 0.f;
                        for (int s = 0; s < nsel; ++s) { const float w = __expf(LSEN[(size_t)(t * 16 + s) * 4 + r] - m); const unsigned a = *(const unsigned*)(PSLC + ((size_t)(t * 16 + s) * 4 + r) * 128 + 2 * lane);
                            o0 += w * bflo(a); o1 += w * bfhi(a); wsum += w; }
                        const float inv = 1.f / wsum;
                        const int hd = g * 4 + r; const float g1 = GATES[(size_t)t * 32 + hd * 3 + 1], g2 = GATES[(size_t)t * 32 + hd * 3 + 2];
                        const size_t oi = (size_t)t * 1024 + hd * 128 + 2 * lane;
                        const unsigned c = *(const unsigned*)(OCMP + oi), w_ = *(const unsigned*)(OWIN + oi);
                        *(unsigned*)(OMIX + (size_t)t * 2048 + hd * 128 + 2 * lane) = pk2(g1 * o0 * inv + bflo(c) + g2 * bflo(w_), g1 * o1 * inv + bfhi(c) + g2 * bfhi(w_));
                    }
                }
                if (BOTH(pb + 8 + 2 * g)) GRID_BAR();
            }
        }
        if (IN(pb + 11)) {
            ArgsP ap = AP(); unsigned char* ws = ap->ws;
            pg8::Gemm g{(const bf16*)(ws + WS_OMIX), (const bf16*)(ws + WS_WOUTT) + (size_t)l * D_ * D_, S_, D_, D_}; pg8::StaticOrder So; So.init(S_, D_, G, bid);
            EpiOutProj E{l == 0 ? ap->in[0] : (const float*)ap->out, ap->out, (const float*)(CTLP(ws) + CW_MOD) + l * 12288 + 4096};
            pg8::gemm_phase<EpiOutProj, pg8::StaticOrder, true, true>(lds, g, So, E);
            if (BOTH(pb + 11)) GRID_BAR();
        }
        if (IN(pb + 12)) {
            PH_IDS(); ArgsP ap = AP(); unsigned char* ws = ap->ws;
            const float* mod = (const float*)(CTLP(ws) + CW_MOD) + l * 12288;
            const float* X = ap->out; bf16* H = (bf16*)(ws + WS_H); const float* w_router = ap->in[12]; const float* b_router = ap->in[13];
            unsigned* CNT = (unsigned*)(CTLP(ws) + CW_CNT) + l * 32; int* TE = (int*)(ws + WS_TE); int* TOKIDX = (int*)(ws + WS_TOKIDX); float* WTS = (float*)(ws + WS_WTS);
            { const float* g_ffn = ap->in[5];
              for (int k = tid; k < D_; k += NTHR) { sm[k] = g_ffn[l * D_ + k] * (1.f + mod[8192 + k]); sm[2048 + k] = mod[6144 + k]; }
              if (tid < 32) sm[4096 + tid] = b_router[tid]; }
            __syncthreads();
            for (int t = gw; t < S_; t += NGW) {
                f32x4 v[8]; float ss = 0.f;
#pragma unroll
                for (int j = 0; j < 8; ++j) { v[j] = *(const f32x4*)(X + (size_t)t * D_ + 256 * j + 4 * lane); ss += (v[j][0] * v[j][0] + v[j][1] * v[j][1]) + (v[j][2] * v[j][2] + v[j][3] * v[j][3]); }
                const float rstd = 1.f / sqrtf(wave_sum(ss) * (1.f / D_) + RMS_EPS);
#pragma unroll
                for (int j = 0; j < 8; ++j) { const int k = 256 * j + 4 * lane; v[j] = v[j] * rstd * *(const LAS f32x4*)(sm + k) + *(const LAS f32x4*)(sm + 2048 + k);
                    *(uint2*)(H + (size_t)t * D_ + k) = make_uint2(pk2(v[j][0], v[j][1]), pk2(v[j][2], v[j][3])); }
                { LAS float* hrow = sm + 8192 + wave * 2048;
#pragma unroll
                  for (int j = 0; j < 8; ++j) *(LAS f32x4*)(hrow + 256 * j + 4 * lane) = v[j];
                  LDS_WAIT(); asm volatile("" ::: "memory");
                  const int e = lane & 31, k0 = (lane >> 5) * 1024; const float* wp = w_router + (size_t)k0 * 32 + e; float acc = 0.f;
#pragma unroll 4
                  for (int k = 0; k < 1024; k += 4) { const f32x4 hv = *(const LAS f32x4*)(hrow + k0 + k);
                      acc += hv[0] * wp[(size_t)k * 32] + hv[1] * wp[(size_t)(k + 1) * 32] + hv[2] * wp[(size_t)(k + 2) * 32] + hv[3] * wp[(size_t)(k + 3) * 32]; }
                  acc += __shfl_xor(acc, 32);
                  if (lane < 32) sm[4160 + wave * 32 + lane] = acc;
                  LDS_WAIT(); asm volatile("" ::: "memory"); }
                float lg[32];
#pragma unroll
                for (int e = 0; e < 32; ++e) lg[e] = sm[4160 + wave * 32 + e];
                int grp = 0; float best = -INFINITY;
#pragma unroll
                for (int e = 0; e < 32; ++e) lg[e] = 1.f / (1.f + __expf(-lg[e]));
#pragma unroll
                for (int gq = 0; gq < 4; ++gq) { float m1 = -INFINITY, m2 = -INFINITY;
#pragma unroll
                    for (int i = 0; i < 8; ++i) { const float b = lg[gq * 8 + i] + sm[4096 + gq * 8 + i]; if (b > m1) { m2 = m1; m1 = b; } else if (b > m2) m2 = b; }
                    const float sgs = m1 + m2; if (sgs > best) { best = sgs; grp = gq; } }
                float m1 = -INFINITY, m2 = -INFINITY, s1 = 0.f, s2 = 0.f; int i1 = 0, i2 = 0;
#pragma unroll
                for (int e = 0; e < 32; ++e) { const bool ing = (e >> 3) == grp; const float b = lg[e] + sm[4096 + e];
                    if (ing && b > m1) { m2 = m1; i2 = i1; s2 = s1; m1 = b; i1 = e; s1 = lg[e]; } else if (ing && b > m2) { m2 = b; i2 = e; s2 = lg[e]; } }
                if (lane == 0) {
                    const float inv = 1.f / (s1 + s2);
                    const unsigned p1 = atomicAdd(CNT + i1, 1u), p2 = atomicAdd(CNT + i2, 1u);
                    TOKIDX[(size_t)i1 * ECAP + p1] = t; TOKIDX[(size_t)i2 * ECAP + p2] = t; WTS[(size_t)i1 * ECAP + p1] = s1 * inv; WTS[(size_t)i2 * ECAP + p2] = s2 * inv;
                    *(int4*)(TE + 4 * t) = make_int4(i1, (int)p1, i2, (int)p2);
                }
            }
            if (BOTH(pb + 12)) GRID_BAR();
        }
        if (IN(pb + 13)) {
            PH_IDS(); ArgsP ap = AP(); unsigned char* ws = ap->ws;
            LOAD_MOETAB((unsigned*)(CTLP(ws) + CW_CNT) + l * 32, 4);
            pg8::Gemm g{(const bf16*)(ws + WS_H), (const bf16*)(ws + WS_WGUT), 0, 0, D_}; MoeOrder<true> So{moetab, 4, G, bid, 4, l * 32 * 4, (const int*)(ws + WS_TOKIDX)};
            EpiGateUp E{(bf16*)(ws + WS_HACT)};
            pg8::gemm_phase<EpiGateUp, MoeOrder<true>, true, true>(lds, g, So, E);
            if (BOTH(pb + 13)) GRID_BAR();
        }
        if (IN(pb + 14)) {
            PH_IDS(); ArgsP ap = AP(); unsigned char* ws = ap->ws;
            LOAD_MOETAB((unsigned*)(CTLP(ws) + CW_CNT) + l * 32, 8);
            pg8::Gemm g{(const bf16*)(ws + WS_HACT), (const bf16*)(ws + WS_WDT), 0, 0, DEXP}; MoeOrder<false> So{moetab, 8, G, bid, 8, l * 32 * 8, nullptr};
            EpiDown E{(bf16*)(ws + WS_Y), (const float*)(ws + WS_WTS), moetab};
            pg8::gemm_phase<EpiDown, MoeOrder<false>, true, true>(lds, g, So, E);
            if (BOTH(pb + 14)) GRID_BAR();
        }
    }
    if (IN(NPH - 1)) {
        PH_IDS(); ArgsP ap = AP(); unsigned char* ws = ap->ws;
        float* X = ap->out; const bf16* Y = (const bf16*)(ws + WS_Y); const int* TE = (const int*)(ws + WS_TE);
        LOAD_MOETAB((unsigned*)(CTLP(ws) + CW_CNT) + 32, 1);
        const bool tmo_set = (MK_N_LAUNCHES == 1) && (__hip_atomic_load((unsigned*)(CTLP(ws) + CW_BAR) + XB_TMO, RLX_AGENT) != 0u);
        { const float* g_final = ap->in[17]; const float* MOD = (const float*)(CTLP(ws) + CW_MOD);
          for (int k = tid; k < D_; k += NTHR) { sm[k] = g_final[k]; sm[2048 + k] = MOD[12288 + 10240 + k]; } }
        __syncthreads();
        for (int t = gw; t < S_; t += NGW) {
            f32x4 v[8]; float ss = 0.f;
            const int4 te = *(const int4*)(TE + 4 * t);
            const bf16* y0 = Y + (size_t)(moetab[65 + te.x] + te.y) * D_; const bf16* y1 = Y + (size_t)(moetab[65 + te.z] + te.w) * D_;
#pragma unroll
            for (int j = 0; j < 8; ++j) { const int k = 256 * j + 4 * lane; const uint2 a = *(const uint2*)(y0 + k), b = *(const uint2*)(y1 + k);
                const f32x4 gt2 = *(const LAS f32x4*)(sm + 2048 + k);
                f32x4 ysum = (f32x4){bflo(a.x) + bflo(b.x), bfhi(a.x) + bfhi(b.x), bflo(a.y) + bflo(b.y), bfhi(a.y) + bfhi(b.y)};
                v[j] = *(const f32x4*)(X + (size_t)t * D_ + k) + gt2 * ysum;
                ss += (v[j][0] * v[j][0] + v[j][1] * v[j][1]) + (v[j][2] * v[j][2] + v[j][3] * v[j][3]); }
            const float rstd = (tmo_set ? __builtin_nanf("") : 1.f) / sqrtf(wave_sum(ss) * (1.f / D_) + RMS_EPS);
#pragma unroll
            for (int j = 0; j < 8; ++j) { const int k = 256 * j + 4 * lane; *(f32x4*)(X + (size_t)t * D_ + k) = v[j] * rstd * *(const LAS f32x4*)(sm + k); }
        }
    }
#undef IN
#undef BOTH
#undef GRID_BAR
#undef LOAD_MOETAB
#undef AP
#undef CTLP
#undef PH_IDS
}

extern "C" void kernel_launch(void* const* d_in, const int* in_sizes, int n_in, void* d_out, int out_size, void* d_ws, size_t ws_size, hipStream_t stream) {
    static int grid = 0;
    if (grid == 0) {
        if (n_in != 18 || out_size != S_ * D_ || ws_size < WS_END) { fprintf(stderr, "kernel_launch: unexpected shapes (n_in %d out %d ws %zu)\n", n_in, out_size, ws_size); grid = -1; return; }
        int dev = 0, cus = 0, per_cu = 0;
        if (hipGetDevice(&dev) != hipSuccess || hipDeviceGetAttribute(&cus, hipDeviceAttributeMultiprocessorCount, dev) != hipSuccess) { grid = -1; return; }
        if (hipFuncSetAttribute((const void*)mk_fwd, hipFuncAttributeMaxDynamicSharedMemorySize, LDS_BYTES) != hipSuccess) { fprintf(stderr, "kernel_launch: hipFuncSetAttribute failed\n"); grid = -1; return; }
        if (hipOccupancyMaxActiveBlocksPerMultiprocessor(&per_cu, (const void*)mk_fwd, NTHR, LDS_BYTES) != hipSuccess || per_cu < 1) { fprintf(stderr, "kernel_launch: occupancy query says %d\n", per_cu); }
        (void)hipGetLastError();
        grid = cus;
    }
    if (grid < 0) return;
    if (hipMemsetAsync((char*)d_ws + WS_CTL, 0, CTL_ZERO_BYTES, stream) != hipSuccess) return;
    Args a{};
    for (int i = 0; i < 18; ++i) a.in[i] = (const float*)d_in[i];
    a.out = (float*)d_out; a.ws = (unsigned char*)d_ws; a.pad = 0;
    if (MK_N_LAUNCHES == 1) {
        a.ph_lo = 0; a.ph_hi = NPH; a.li = 0;
        hipLaunchKernelGGL(mk_fwd, dim3(grid), dim3(NTHR), LDS_BYTES, stream, a);
    } else {
        for (int p = 0; p < NPH; ++p) { a.ph_lo = p; a.ph_hi = p + 1; a.li = p; hipLaunchKernelGGL(mk_fwd, dim3(grid), dim3(NTHR), LDS_BYTES, stream, a); }
    }
}
```

```cpp
#include <hip/hip_runtime.h>
#include <cstdio>
#include <cstdint>

namespace pg8 {
#define PG8_LAS __attribute__((address_space(3)))
typedef unsigned short bf16_t;
typedef short bf16x8 __attribute__((ext_vector_type(8)));
typedef float f32x4 __attribute__((ext_vector_type(4)));
typedef unsigned u32x4 __attribute__((ext_vector_type(4)));
constexpr int BM = 256, BK = 64, HALF = 128, HTB = HALF * BK * 2, STAGE_BYTES = 8 * HTB, NXCD = 8, WGM = 8;

__host__ __device__ __forceinline__ int lds_byte(int r, int c) { const int st = (r >> 4) * 2 + (c >> 5), rr = r & 15, cc = c & 31, ob = rr * 64 + cc * 2; return st * 1024 + (ob ^ (((ob >> 9) & 1) << 5)); }
__host__ __device__ __forceinline__ void stage_rc(int b, int& R, int& C) { const int st = b / 1024, sb = b % 1024, swz = sb ^ (((sb >> 9) & 1) << 5); R = (st >> 1) * 16 + swz / 64; C = (st & 1) * 32 + (swz % 64) / 2; }
__host__ __device__ __forceinline__ int perm32(int rho) { const int n = rho >> 4, i = rho & 15; return 8 * (i >> 2) + 4 * n + (i & 3); }

struct Unit { int pm, pn, e, mt, pnl; };
struct Gemm { const bf16_t* A; const bf16_t* Bt; int M, N, K; };

struct StaticOrder {
    static constexpr bool GATHER = false;
    int nM, nN, nwg, G, c;
    __host__ __device__ void init(int M, int N, int G_, int c_) { nM = M / BM; nN = N / BM; nwg = nM * nN; G = G_; c = c_; }
    __host__ __device__ bool next(int i, Unit& u) const {
        const long L = (long)i * G + c; if (L >= nwg) return false;
        int wgid = (int)L; { const int q = nwg / NXCD, r = nwg % NXCD, xcd = wgid % NXCD, off = wgid / NXCD; wgid = (xcd < r ? xcd * (q + 1) : r * (q + 1) + (xcd - r) * q) + off; }
        const int nig = WGM * nN, gid = wgid / nig, fm = gid * WGM, gsz = (nM - fm) < WGM ? (nM - fm) : WGM;
        u.pm = fm + ((wgid % nig) % gsz); u.pn = (wgid % nig) / gsz; u.e = 0; u.mt = 0; u.pnl = u.pn; return true;
    }
    __device__ __forceinline__ void a_offs(const Unit&, int, int, int, int, int, unsigned (&)[2][2]) const {}
    __device__ __forceinline__ void a_ready(const Unit&) const {}
    __device__ __forceinline__ void done(const Unit&) const {}
};

__device__ __forceinline__ unsigned cvt_pk_bf16(float lo, float hi) { unsigned r; asm volatile("v_cvt_pk_bf16_f32 %0, %1, %2" : "=v"(r) : "v"(lo), "v"(hi)); return r; }

template <class Epi, class Sched, bool ALIGN_EPI = false, bool SP2 = false>
__device__ __forceinline__ void gemm_phase(PG8_LAS unsigned char* lds, const Gemm g, const Sched& S, const Epi& E) {
    int tid_ = threadIdx.x; asm volatile("" : "+v"(tid_));
    const int tid = tid_, wid = __builtin_amdgcn_readfirstlane(tid >> 6), lane = tid & 63, wr = wid >> 2, wc = wid & 3, fr = lane & 15, fq = lane >> 4;
    const int K = g.K, nt = K / BK;
    unsigned voffA[2], voffB[2]; int RR[2], CC[2];
#pragma unroll
    for (int i = 0; i < 2; ++i) { int R, C; stage_rc(tid * 16 + i * 8192, R, C); const int Rb = Epi::PERM ? ((R & ~31) + perm32(R & 31)) : R;
        RR[i] = R; CC[i] = C; voffA[i] = (unsigned)(R * K + C) * 2u; voffB[i] = (unsigned)(Rb * K + C) * 2u; }
    const size_t kstep = (size_t)(BK * 2);
    const size_t hstep = (size_t)HALF * K * 2;
    const size_t tstep = 2 * hstep;
    const unsigned ldsw = (unsigned)wid * 1024u;
    const int aoff = lds_byte(wr * 64 + fr, fq * 8), boff = lds_byte(wc * 32 + fr, fq * 8);
    const char* gA = (const char*)g.A;
    unsigned aoC[2][2] = {{0u, 0u}, {0u, 0u}}, aoN[2][2] = {{0u, 0u}, {0u, 0u}};
#define PG8_SA(b, h) (((b) * 2 + (h)) * HTB)
#define PG8_SB(b, h) ((4 + (b) * 2 + (h)) * HTB)
#define PG8_STAGE(bufoff, gbase, voff) do { _Pragma("unroll") for (int _i = 0; _i < 2; ++_i) \
        __builtin_amdgcn_global_load_lds((const unsigned*)((const char*)(gbase) + (voff)[_i]), (PG8_LAS unsigned*)(lds + (bufoff) + ldsw + _i * 8192), 16, 0, 0); } while (0)
#define PG8_STAGE_A(bufoff, h, PN, KO) do { if constexpr (Sched::GATHER) { _Pragma("unroll") for (int _i = 0; _i < 2; ++_i) \
        __builtin_amdgcn_global_load_lds((const unsigned*)(gA + aoC[h][_i] + (KO)), (PG8_LAS unsigned*)(lds + (bufoff) + ldsw + _i * 8192), 16, 0, 0); } \
        else { PG8_STAGE(bufoff, (PN) + (h) * hstep, voffA); } } while (0)
#define PG8_LDA(dst, b, h) do { _Pragma("unroll") for (int m = 0; m < 4; ++m) _Pragma("unroll") for (int k = 0; k < 2; ++k) dst[m][k] = *(const PG8_LAS bf16x8*)(lds + PG8_SA(b, h) + aoff + m * 2048 + k * 1024); } while (0)
#define PG8_LDB(dst, b, h) do { _Pragma("unroll") for (int n = 0; n < 2; ++n) _Pragma("unroll") for (int k = 0; k < 2; ++k) dst[n][k] = *(const PG8_LAS bf16x8*)(lds + PG8_SB(b, h) + boff + n * 2048 + k * 1024); } while (0)
#define PG8_MMA(ai, bj, At, Bt) do { __builtin_amdgcn_s_setprio(1); _Pragma("unroll") for (int m = 0; m < 4; ++m) _Pragma("unroll") for (int n = 0; n < 2; ++n) _Pragma("unroll") for (int k = 0; k < 2; ++k) \
        acc[ai][bj][m][n] = __builtin_amdgcn_mfma_f32_16x16x32_bf16(Bt[n][k], At[m][k], acc[ai][bj][m][n], 0, 0, 0); __builtin_amdgcn_s_setprio(0); } while (0)
#define PG8_WAIT_V(n) asm volatile("s_waitcnt vmcnt(" #n ")" ::: "memory")
#define PG8_WAIT_L(n) asm volatile("s_waitcnt lgkmcnt(" #n ")" ::: "memory")
#define PG8_BAR __builtin_amdgcn_s_barrier()
#define PG8_SCHED __builtin_amdgcn_sched_barrier(0)
    Unit cur, nxt; int ui = 0;
    if (!S.next(0, cur)) return;
    f32x4 acc[2][2][4][2];
#pragma unroll
    for (int a = 0; a < 2; ++a)
#pragma unroll
        for (int b = 0; b < 2; ++b)
#pragma unroll
            for (int m = 0; m < 4; ++m)
#pragma unroll
                for (int n = 0; n < 2; ++n) acc[a][b][m][n] = (f32x4){0.f, 0.f, 0.f, 0.f};
    bf16x8 At[4][2], B0[2][2], B1[2][2];
    const char* cA = (const char*)g.A + (size_t)cur.pm * tstep; const char* cB = (const char*)g.Bt + (size_t)cur.pn * tstep;
    if constexpr (Sched::GATHER) S.a_offs(cur, RR[0], RR[1], CC[0], CC[1], K, aoC);
    S.a_ready(cur);
    if constexpr (SP2) {
        PG8_STAGE(PG8_SB(0, 0), cB, voffB); PG8_STAGE(PG8_SB(0, 1), cB + hstep, voffB); PG8_STAGE_A(PG8_SA(0, 0), 0, cA, 0); PG8_STAGE_A(PG8_SA(0, 1), 1, cA, 0);
        if (wr == 1) PG8_BAR;
        PG8_WAIT_V(2); PG8_BAR;
        PG8_STAGE(PG8_SB(1, 0), cB + kstep, voffB); PG8_STAGE_A(PG8_SA(1, 0), 0, cA + kstep, kstep); PG8_STAGE(PG8_SB(1, 1), cB + hstep + kstep, voffB);
        PG8_WAIT_V(6); PG8_BAR;
    } else {
        PG8_STAGE(PG8_SB(0, 0), cB, voffB); PG8_STAGE_A(PG8_SA(0, 0), 0, cA, 0); PG8_STAGE(PG8_SB(0, 1), cB + hstep, voffB); PG8_STAGE_A(PG8_SA(0, 1), 1, cA, 0);
        if (wr == 1) PG8_BAR;
        PG8_WAIT_V(4); PG8_BAR;
        PG8_STAGE(PG8_SB(1, 0), cB + kstep, voffB); PG8_STAGE_A(PG8_SA(1, 0), 0, cA + kstep, kstep); PG8_STAGE(PG8_SB(1, 1), cB + hstep + kstep, voffB);
        PG8_WAIT_V(6); PG8_BAR;
    }
    for (;;) {
        const bool has_next = S.next(ui + 1, nxt);
        const char* nA = has_next ? (const char*)g.A + (size_t)nxt.pm * tstep : cA; const char* nB = has_next ? (const char*)g.Bt + (size_t)nxt.pn * tstep : cB;
        if constexpr (Sched::GATHER) {
            if (has_next) S.a_offs(nxt, RR[0], RR[1], CC[0], CC[1], K, aoN);
            else {
#pragma unroll
                for (int h = 0; h < 2; ++h)
#pragma unroll
                    for (int i = 0; i < 2; ++i) aoN[h][i] = aoC[h][i]; }
        }
        for (int t = 0; t < nt; t += 2) {
            const bool last = (t == nt - 2);
            const char* a1 = cA + (size_t)(t + 1) * kstep;
            const char* a2 = last ? nA : cA + (size_t)(t + 2) * kstep; const char* b2 = last ? nB : cB + (size_t)(t + 2) * kstep;
            const char* a3 = a2 + kstep; const char* b3 = b2 + kstep;
            const size_t k1 = (size_t)(t + 1) * kstep, k2 = last ? (size_t)0 : (size_t)(t + 2) * kstep, k3 = k2 + kstep;
            if (last && has_next) S.a_ready(nxt);
            if constexpr (SP2) {
            PG8_LDB(B0, 0, 0); PG8_LDB(B1, 0, 1); PG8_SCHED; PG8_LDA(At, 0, 0); PG8_STAGE_A(PG8_SA(1, 1), 1, a1, k1);
            if constexpr (Sched::GATHER) { if (last) {
#pragma unroll
                for (int h = 0; h < 2; ++h)
#pragma unroll
                    for (int i = 0; i < 2; ++i) aoC[h][i] = aoN[h][i]; } }
            PG8_WAIT_V(8); PG8_WAIT_L(0); PG8_BAR; PG8_MMA(0, 0, At, B0); PG8_MMA(0, 1, At, B1); PG8_BAR; PG8_SCHED;
            PG8_LDA(At, 0, 1); PG8_STAGE(PG8_SB(0, 0), b2, voffB); PG8_STAGE(PG8_SB(0, 1), b2 + hstep, voffB); PG8_STAGE_A(PG8_SA(0, 0), 0, a2, k2);
            PG8_WAIT_V(8); PG8_WAIT_L(0); PG8_BAR; PG8_MMA(1, 0, At, B0); PG8_MMA(1, 1, At, B1); PG8_BAR; PG8_SCHED;
            PG8_LDB(B0, 1, 0); PG8_LDB(B1, 1, 1); PG8_SCHED; PG8_LDA(At, 1, 0); PG8_STAGE_A(PG8_SA(0, 1), 1, a2, k2);
            PG8_WAIT_V(8); PG8_WAIT_L(0); PG8_BAR; PG8_MMA(0, 0, At, B0); PG8_MMA(0, 1, At, B1); PG8_BAR; PG8_SCHED;
            PG8_LDA(At, 1, 1); PG8_STAGE(PG8_SB(1, 0), b3, voffB); PG8_STAGE(PG8_SB(1, 1), b3 + hstep, voffB); PG8_STAGE_A(PG8_SA(1, 0), 0, a3, k3);
            PG8_WAIT_V(8); PG8_WAIT_L(0); PG8_BAR; PG8_MMA(1, 0, At, B0); PG8_MMA(1, 1, At, B1); PG8_BAR; PG8_SCHED;
            } else {
            PG8_LDB(B0, 0, 0); PG8_SCHED; PG8_LDA(At, 0, 0); PG8_STAGE_A(PG8_SA(1, 1), 1, a1, k1);
            if constexpr (Sched::GATHER) { if (last) {
#pragma unroll
                for (int h = 0; h < 2; ++h)
#pragma unroll
                    for (int i = 0; i < 2; ++i) aoC[h][i] = aoN[h][i]; } }
            PG8_WAIT_L(8); PG8_BAR; PG8_WAIT_L(0); PG8_MMA(0, 0, At, B0); PG8_BAR; PG8_SCHED;
            PG8_LDB(B1, 0, 1); PG8_STAGE(PG8_SB(0, 0), b2, voffB);
            PG8_BAR; PG8_WAIT_L(0); PG8_MMA(0, 1, At, B1); PG8_BAR;
            PG8_LDA(At, 0, 1); PG8_STAGE_A(PG8_SA(0, 0), 0, a2, k2);
            PG8_BAR; PG8_WAIT_L(0); PG8_MMA(1, 0, At, B0); PG8_BAR; PG8_SCHED;
            PG8_STAGE(PG8_SB(0, 1), b2 + hstep, voffB);
            PG8_WAIT_V(6); PG8_BAR; PG8_MMA(1, 1, At, B1); PG8_BAR;
            PG8_LDB(B0, 1, 0); PG8_SCHED; PG8_LDA(At, 1, 0); PG8_STAGE_A(PG8_SA(0, 1), 1, a2, k2);
            PG8_WAIT_L(8); PG8_BAR; PG8_WAIT_L(0); PG8_MMA(0, 0, At, B0); PG8_BAR; PG8_SCHED;
            PG8_LDB(B1, 1, 1); PG8_STAGE(PG8_SB(1, 0), b3, voffB);
            PG8_BAR; PG8_WAIT_L(0); PG8_MMA(0, 1, At, B1); PG8_BAR;
            PG8_LDA(At, 1, 1); PG8_STAGE_A(PG8_SA(1, 0), 0, a3, k3);
            PG8_BAR; PG8_WAIT_L(0); PG8_MMA(1, 0, At, B0); PG8_BAR; PG8_SCHED;
            PG8_STAGE(PG8_SB(1, 1), b3 + hstep, voffB);
            PG8_WAIT_V(6); PG8_BAR; PG8_MMA(1, 1, At, B1); PG8_BAR;
            }
        }
        if constexpr (ALIGN_EPI) { if (wr == 0) PG8_BAR; }
        E(acc, cur, wr, wc, fr, fq); S.done(cur);
        if (!has_next) break;
#pragma unroll
        for (int a = 0; a < 2; ++a)
#pragma unroll
            for (int b = 0; b < 2; ++b)
#pragma unroll
                for (int m = 0; m < 4; ++m)
#pragma unroll
                    for (int n = 0; n < 2; ++n) acc[a][b][m][n] = (f32x4){0.f, 0.f, 0.f, 0.f};
        cur = nxt; cA = nA; cB = nB; ++ui;
        if constexpr (ALIGN_EPI) { if (wr == 1) PG8_BAR; }
    }
    PG8_WAIT_V(0);
    if constexpr (!ALIGN_EPI) { if (wr == 0) PG8_BAR; }
    PG8_BAR;
#undef PG8_SA
#undef PG8_SB
#undef PG8_STAGE
#undef PG8_STAGE_A
#undef PG8_LDA
#undef PG8_LDB
#undef PG8_MMA
#undef PG8_WAIT_V
#undef PG8_WAIT_L
#undef PG8_BAR
#undef PG8_SCHED
}
}

#ifndef MK_N_LAUNCHES
#define MK_N_LAUNCHES 1
#endif
constexpr int NWAVES = 8, NTHR = 512;
constexpr int S_ = 16384, D_ = 2048, DEPTH = 2, HD = 128;
constexpr int IN_W = 5656, NIN = 5888;
constexpr int NC = 1023;
constexpr int NEXP = 32, DEXP = 512, ECAP = 16384, NSLOT = 40960;
constexpr float RMS_EPS = 1e-6f;
constexpr float ATT_SCALE = 0.08838834764831845f;
constexpr int NPL = 15, NPH = 2 + 2 * NPL;

constexpr size_t MiB = 1u << 20;
constexpr size_t WS_CTL = 0, CTL_ZERO_BYTES = 1 * MiB;
constexpr size_t WS_ROPE = 1 * MiB, WS_WINT = 9 * MiB, WS_WOUTT = 55 * MiB, WS_WGUT = 71 * MiB, WS_WDT = 327 * MiB, WS_WC1T = 455 * MiB;
constexpr size_t WS_H = 463 * MiB, WS_QN = 527 * MiB, WS_QM = 559 * MiB, WS_KM = 591 * MiB, WS_VM = 623 * MiB;
constexpr size_t WS_KC = 655 * MiB, WS_VC = 663 * MiB, WS_KS = 671 * MiB, WS_VS = 679 * MiB, WS_KW = 687 * MiB, WS_VW = 695 * MiB;
constexpr size_t WS_GATES = 703 * MiB, WS_UL = 705 * MiB, WS_KCMP = 713 * MiB, WS_VCMP = 713 * MiB + 512 * 1024, WS_KMEAN = 714 * MiB;
constexpr size_t WS_OMIX = 715 * MiB, WS_OCMP = 779 * MiB, WS_OWIN = 811 * MiB, WS_SEL = 843 * MiB, WS_TE = 845 * MiB, WS_TOKIDX = 846 * MiB, WS_WTS = 848 * MiB;
constexpr size_t WS_HACT = 850 * MiB, WS_Y = 890 * MiB;
constexpr size_t WS_IMP = WS_H + 32 * MiB;
constexpr size_t WS_NLIST = WS_H, WS_PSLC = 850 * MiB, WS_LSEN = 1106 * MiB;
constexpr size_t WS_MLIST = 1050 * MiB, WS_PSEL = 1082 * MiB, WS_POWN = 1178 * MiB, WS_LSES = 1210 * MiB, WS_LSEO = 1211 * MiB + 512 * 1024, WS_END = 1212 * MiB;
constexpr int CW_TMO = 0, CW_BAR = 4096, CW_CNT = 8192, CW_MCNT = 8704, CW_NCNT = 9728, CW_MOD = 16384, CW_B1E = 40960;

constexpr int RING_BYTES = 131072, LDSCTL_OFF = RING_BYTES, MISC_OFF = LDSCTL_OFF + 320, MOETAB_OFF = LDSCTL_OFF + 512, LDS_BYTES = 147456;

#define GAS __attribute__((address_space(1)))
#define LAS __attribute__((address_space(3)))
typedef unsigned short bf16;
typedef unsigned v4u __attribute__((ext_vector_type(4)));
typedef float f32x4 __attribute__((ext_vector_type(4)));
typedef float f32x2 __attribute__((ext_vector_type(2)));
typedef GAS unsigned gu32;
#define RLX_AGENT __ATOMIC_RELAXED, __HIP_MEMORY_SCOPE_AGENT
#define LDS_WAIT() asm volatile("s_waitcnt lgkmcnt(0)" ::: "memory")
__device__ __forceinline__ unsigned f2bf(float f) { unsigned u = __builtin_bit_cast(unsigned, f); return (u + 0x7fffu + ((u >> 16) & 1u)) >> 16; }
__device__ __forceinline__ unsigned pk2(float lo, float hi) { return f2bf(lo) | (f2bf(hi) << 16); }
__device__ __forceinline__ float bf2f(unsigned b) { return __builtin_bit_cast(float, b << 16); }
__device__ __forceinline__ float bflo(unsigned w) { return __builtin_bit_cast(float, w << 16); }
__device__ __forceinline__ float bfhi(unsigned w) { return __builtin_bit_cast(float, w & 0xffff0000u); }

#define XB_TMO      128
#define XB_XCNT(j)  (256  + 64 * (j))
#define XB_XSUB(j)  (1280 + 64 * (j))
#define XB_XGEN(j)  (2304 + 64 * (j))
#define XB_TOP      3328
#define XB_TOPGEN   3392
#define XCD_BAR_WORDS 3456
#define XB_SPIN_CAP (1u << 23)
__device__ __forceinline__ unsigned xb_ld(unsigned* p)              { return __hip_atomic_load(p, __ATOMIC_RELAXED, __HIP_MEMORY_SCOPE_AGENT); }
__device__ __forceinline__ unsigned xb_add(unsigned* p, unsigned v) { return __hip_atomic_fetch_add(p, v, __ATOMIC_RELAXED, __HIP_MEMORY_SCOPE_AGENT); }
__device__ __forceinline__ unsigned xb_xcc_id() { return (unsigned)__builtin_amdgcn_s_getreg((3 << 11) | 20) & 0xFu; }
#define XB_SPIN(cond, bar) do { unsigned _sp = 0; while (cond) { __builtin_amdgcn_s_sleep(1); \
    if ((++_sp & 255u) == 0u) { if (xb_ld(&(bar)[XB_TMO])) break; if (_sp > XB_SPIN_CAP) { atomicAdd(&(bar)[XB_TMO], 1u); break; } } } } while (0)
struct XcdBarrier { unsigned* bar; unsigned x; volatile LAS unsigned* st; };
__device__ __forceinline__ XcdBarrier xcd_barrier_post(unsigned* bar, volatile LAS unsigned* st) {
    XcdBarrier b; b.bar = bar; b.x = xb_xcc_id(); b.st = st;
    if (threadIdx.x == 0) (void)xb_add(&bar[XB_XCNT(b.x)], 1u);
    return b;
}
__device__ __forceinline__ void xcd_barrier_complete(unsigned* bar, unsigned x, unsigned& nloc, unsigned& nx) {
    const unsigned G = gridDim.x * gridDim.y * gridDim.z;
    unsigned sum, cnt, mine, sp = 0u;
    for (;;) {
        sum = 0u; cnt = 0u; mine = 0u;
#pragma unroll
        for (unsigned j = 0; j < 16; ++j) { const unsigned c = xb_ld(&bar[XB_XCNT(j)]); sum += c; cnt += (c > 0u) ? 1u : 0u; mine = (j == x) ? c : mine; }
        if (sum == G) break;
        __builtin_amdgcn_s_sleep(1);
        if ((++sp & 255u) == 0u) { if (xb_ld(&bar[XB_TMO])) break; if (sp > XB_SPIN_CAP) { atomicAdd(&bar[XB_TMO], 1u); break; } }
    }
    nloc = mine > 0u ? mine : 1u; nx = cnt > 0u ? cnt : 1u;
}
__device__ __forceinline__ void xcd_barrier(const XcdBarrier& b) {
    asm volatile("s_waitcnt vmcnt(0)" ::: "memory");
    __syncthreads();
    if (threadIdx.x == 0) {
        unsigned* bar = b.bar;
        __builtin_amdgcn_s_waitcnt(0);
        unsigned nloc = b.st[0], nx = b.st[1];
        if (nloc == 0u) { xcd_barrier_complete(bar, b.x, nloc, nx); b.st[0] = nloc; b.st[1] = nx; }
        const unsigned old = xb_add(&bar[XB_XSUB(b.x)], 1u);
        const unsigned gen = old / nloc;
        if (old + 1u == (gen + 1u) * nloc) {
            __builtin_amdgcn_fence(__ATOMIC_RELEASE, "agent");
            asm volatile("s_waitcnt vmcnt(0)" ::: "memory");
            const unsigned og = xb_add(&bar[XB_TOP], 1u);
            const unsigned tg = og / nx;
            if (og + 1u == (tg + 1u) * nx) xb_add(&bar[XB_TOPGEN], 1u);
            else XB_SPIN(xb_ld(&bar[XB_TOPGEN]) == tg, bar);
            __builtin_amdgcn_fence(__ATOMIC_ACQUIRE, "agent");
            xb_add(&bar[XB_XGEN(b.x)], 1u);
            asm volatile("s_waitcnt vmcnt(0)" ::: "memory");
        } else {
            XB_SPIN(xb_ld(&bar[XB_XGEN(b.x)]) == gen, bar);
            __builtin_amdgcn_fence(__ATOMIC_ACQUIRE, "agent");
            asm volatile("s_waitcnt vmcnt(0)" ::: "memory");
        }
    }
    __syncthreads();
}

__device__ __forceinline__ float wave_sum(float v) {
#pragma unroll
    for (int o = 1; o < 64; o <<= 1) v += __shfl_xor(v, o);
    return v;
}
__device__ __forceinline__ float wave_max(float v) {
#pragma unroll
    for (int o = 1; o < 64; o <<= 1) v = fmaxf(v, __shfl_xor(v, o));
    return v;
}

__device__ __forceinline__ int il(int d) { return (d < 64) ? 2 * d : 2 * (d - 64) + 1; }
__device__ __forceinline__ int inproj_row(int s) {
    if (s < 1024) return (s & ~127) + il(s & 127);
    if (s < 1536) return s;
    if (s < 1792) return (s & ~127) + il(s & 127);
    if (s < 2048) return s;
    if (s < 2304) return (s & ~127) + il(s & 127);
    if (s < 2560) return s;
    if (s < 2584) return 5632 + (s - 2560);
    if (s < 3608) { const int r = s - 2584; return 2560 + (r & ~127) + il(r & 127); }
    if (s < 4632) { const int r = s - 3608; return 3584 + (r & ~127) + il(r & 127); }
    return 4608 + (s - 4632);
}
template <int MODE>
__device__ __forceinline__ void transpose_item(const float* W, int K, int N, bf16* WT, int dpitch, int row_off, LAS float* scr, int item, int lane) {
    const int nblk = (N + 31) / 32, kb = item / nblk, nb = item % nblk, k0 = 64 * kb, n0 = 32 * nb;
    const int nsrc = n0 + (lane & 31);
#pragma unroll 8
    for (int i = 0; i < 32; ++i) { const int kk = 2 * i + (lane >> 5); scr[kk * 33 + (lane & 31)] = (nsrc < N) ? W[(size_t)(k0 + kk) * N + nsrc] : 0.f; }
    LDS_WAIT(); asm volatile("" ::: "memory");
    const int c = lane & 7;
#pragma unroll
    for (int j = 0; j < 4; ++j) { const int nl = (lane >> 3) + 8 * j, n = n0 + nl; const LAS float* s = scr + (8 * c) * 33 + nl;
        v4u o; o.x = pk2(s[0 * 33], s[1 * 33]); o.y = pk2(s[2 * 33], s[3 * 33]); o.z = pk2(s[4 * 33], s[5 * 33]); o.w = pk2(s[6 * 33], s[7 * 33]);
        if (n < N) { int dr;
            if (MODE == 0) dr = n; else if (MODE == 1) dr = inproj_row(n); else if (MODE == 2) dr = (n >> 7) * 256 + (n & 127); else dr = (n >> 7) * 256 + 128 + (n & 127);
            *(GAS v4u*)(WT + (size_t)(row_off + dr) * dpitch + k0 + 8 * c) = o; } }
    LDS_WAIT(); asm volatile("" ::: "memory");
}

using pg8::Unit;
struct EpiInProj {
    static constexpr bool PERM = true;
    bf16 *QN, *KC, *VC, *KS, *VS, *KW, *VW, *QM, *KM, *VM; float* GATES; const float* rope;
    __device__ __forceinline__ void operator()(const f32x4 (&acc)[2][2][4][2], const Unit& u, int wr, int wc, int fr, int fq) const {
        const int pn = u.pn, row0 = u.pm * 256 + wr * 64 + fr, c8 = wc * 32 + 8 * fq;
        if (pn == 22) {
            if (c8 < 24) {
#pragma unroll
                for (int ai = 0; ai < 2; ++ai)
#pragma unroll
                    for (int m = 0; m < 4; ++m) { const int row = row0 + ai * 128 + m * 16; float* gp = GATES + (size_t)row * 32 + c8;
                        f32x4 a = acc[ai][0][m][0], b = acc[ai][0][m][1], ga, gb;
#pragma unroll
                        for (int j = 0; j < 4; ++j) { ga[j] = 1.f / (1.f + __expf(-a[j])); gb[j] = 1.f / (1.f + __expf(-b[j])); }
                        *(f32x4*)gp = ga; *(f32x4*)(gp + 4) = gb; }
            }
            return;
        }
        bf16* base; int pitch; size_t bjs; bool rot;
        if (pn < 4)       { base = QN + pn * 256;        pitch = 1024; bjs = 128; rot = true; }
        else if (pn == 4) { base = KC;                   pitch = 128;  bjs = (size_t)S_ * 128; rot = false; }
        else if (pn == 5) { base = VC;                   pitch = 128;  bjs = (size_t)S_ * 128; rot = false; }
        else if (pn == 6) { base = KS;                   pitch = 256;  bjs = 128; rot = true; }
        else if (pn == 7) { base = VS;                   pitch = 256;  bjs = 128; rot = false; }
        else if (pn == 8) { base = KW;                   pitch = 256;  bjs = 128; rot = true; }
        else if (pn == 9) { base = VW;                   pitch = 256;  bjs = 128; rot = false; }
        else if (pn < 14) { base = QM + (pn - 10) * 256; pitch = 1024; bjs = 128; rot = true; }
        else if (pn < 18) { base = KM + (pn - 14) * 256; pitch = 1024; bjs = 128; rot = true; }
        else              { base = VM + (pn - 18) * 256; pitch = 1024; bjs = 128; rot = false; }
#pragma unroll
        for (int ai = 0; ai < 2; ++ai)
#pragma unroll
            for (int m = 0; m < 4; ++m) { const int row = row0 + ai * 128 + m * 16;
                f32x4 t0 = (f32x4){1.f, 0.f, 1.f, 0.f}, t1 = t0;
                if (rot) { const f32x4* tp = (const f32x4*)(rope + (size_t)row * 128 + (c8 >> 1) * 2); t0 = tp[0]; t1 = tp[1]; }
#pragma unroll
                for (int bj = 0; bj < 2; ++bj) { f32x4 v0 = acc[ai][bj][m][0], v1 = acc[ai][bj][m][1];
                    if (rot) { f32x4 w0, w1;
                        w0[0] = v0[0] * t0[0] - v0[1] * t0[1]; w0[1] = v0[1] * t0[0] + v0[0] * t0[1]; w0[2] = v0[2] * t0[2] - v0[3] * t0[3]; w0[3] = v0[3] * t0[2] + v0[2] * t0[3];
                        w1[0] = v1[0] * t1[0] - v1[1] * t1[1]; w1[1] = v1[1] * t1[0] + v1[0] * t1[1]; w1[2] = v1[2] * t1[2] - v1[3] * t1[3]; w1[3] = v1[3] * t1[2] + v1[2] * t1[3];
                        v0 = w0; v1 = w1; }
                    pg8::u32x4 w; w.x = pg8::cvt_pk_bf16(v0[0], v0[1]); w.y = pg8::cvt_pk_bf16(v0[2], v0[3]); w.z = pg8::cvt_pk_bf16(v1[0], v1[1]); w.w = pg8::cvt_pk_bf16(v1[2], v1[3]);
                    *(pg8::u32x4*)(base + (size_t)row * pitch + bj * bjs + c8) = w; } }
    }
};
struct EpiOutProj {
    static constexpr bool PERM = false;
    const float* xsrc; float* X; const float* gt;
    __device__ __forceinline__ void operator()(const f32x4 (&acc)[2][2][4][2], const Unit& u, int wr, int wc, int fr, int fq) const {
        const int row0 = u.pm * 256 + wr * 64 + fr, col0 = u.pnl * 256 + wc * 32 + 4 * fq;
        f32x4 gv[2][2];
#pragma unroll
        for (int bj = 0; bj < 2; ++bj)
#pragma unroll
            for (int n = 0; n < 2; ++n) gv[bj][n] = *(const f32x4*)(gt + col0 + bj * 128 + n * 16);
#pragma unroll
        for (int ai = 0; ai < 2; ++ai)
#pragma unroll
            for (int m = 0; m < 4; ++m) { const size_t ro = (size_t)(row0 + ai * 128 + m * 16) * D_ + col0;
#pragma unroll
                for (int bj = 0; bj < 2; ++bj)
#pragma unroll
                    for (int n = 0; n < 2; ++n) { const f32x4 xv = *(const f32x4*)(xsrc + ro + bj * 128 + n * 16); *(f32x4*)(X + ro + bj * 128 + n * 16) = xv + gv[bj][n] * acc[ai][bj][m][n]; } }
    }
};
struct EpiF32 {
    static constexpr bool PERM = false;
    float* C; int ldc;
    __device__ __forceinline__ void operator()(const f32x4 (&acc)[2][2][4][2], const Unit& u, int wr, int wc, int fr, int fq) const {
        const int row0 = u.pm * 256 + wr * 64 + fr, col0 = u.pnl * 256 + wc * 32 + 4 * fq;
#pragma unroll
        for (int ai = 0; ai < 2; ++ai)
#pragma unroll
            for (int m = 0; m < 4; ++m) { float* rowp = C + (size_t)(row0 + ai * 128 + m * 16) * ldc + col0;
#pragma unroll
                for (int bj = 0; bj < 2; ++bj)
#pragma unroll
                    for (int n = 0; n < 2; ++n) *(f32x4*)(rowp + bj * 128 + n * 16) = acc[ai][bj][m][n]; }
    }
};
struct EpiGateUp {
    static constexpr bool PERM = true;
    bf16* HACT;
    __device__ __forceinline__ void operator()(const f32x4 (&acc)[2][2][4][2], const Unit& u, int wr, int wc, int fr, int fq) const {
        const int row0 = u.pm * 256 + wr * 64 + fr, col0 = u.pnl * 128 + wc * 32 + 8 * fq;
#pragma unroll
        for (int ai = 0; ai < 2; ++ai)
#pragma unroll
            for (int m = 0; m < 4; ++m) { const int row = row0 + ai * 128 + m * 16; f32x4 h[2];
#pragma unroll
                for (int n = 0; n < 2; ++n)
#pragma unroll
                    for (int j = 0; j < 4; ++j) { const float gg = acc[ai][0][m][n][j], uu = acc[ai][1][m][n][j]; h[n][j] = gg / (1.f + __expf(-gg)) * uu; }
                pg8::u32x4 w; w.x = pg8::cvt_pk_bf16(h[0][0], h[0][1]); w.y = pg8::cvt_pk_bf16(h[0][2], h[0][3]); w.z = pg8::cvt_pk_bf16(h[1][0], h[1][1]); w.w = pg8::cvt_pk_bf16(h[1][2], h[1][3]);
                *(pg8::u32x4*)(HACT + (size_t)row * DEXP + col0) = w; }
    }
};
struct EpiDown {
    static constexpr bool PERM = true;
    bf16* Y; const float* WTS; const LAS int* tab;
    __device__ __forceinline__ void operator()(const f32x4 (&acc)[2][2][4][2], const Unit& u, int wr, int wc, int fr, int fq) const {
        const int rl0 = wr * 64 + fr, col0 = u.pnl * 256 + wc * 32 + 8 * fq, cnt = tab[u.e];
#pragma unroll
        for (int ai = 0; ai < 2; ++ai)
#pragma unroll
            for (int m = 0; m < 4; ++m) { const int rl = rl0 + ai * 128 + m * 16, pos = u.mt * 256 + rl;
                const float w = (pos < cnt) ? WTS[(size_t)u.e * ECAP + pos] : 0.f;
                bf16* rowp = Y + (size_t)(u.pm * 256 + rl) * D_ + col0;
#pragma unroll
                for (int bj = 0; bj < 2; ++bj) { const f32x4 v0 = acc[ai][bj][m][0] * w, v1 = acc[ai][bj][m][1] * w;
                    pg8::u32x4 o; o.x = pg8::cvt_pk_bf16(v0[0], v0[1]); o.y = pg8::cvt_pk_bf16(v0[2], v0[3]); o.z = pg8::cvt_pk_bf16(v1[0], v1[1]); o.w = pg8::cvt_pk_bf16(v1[2], v1[3]);
                    *(pg8::u32x4*)(rowp + bj * 128) = o; } }
    }
};

struct CompressOrder {
    static constexpr bool GATHER = false;
    int G, c;
    __device__ bool next(int i, Unit& u) const { const int L = i * G + c; if (L >= 32) return false; u.pm = L >> 1; u.pnl = L & 1; u.pn = (u.pm >= 8 ? 2 : 0) + u.pnl; u.e = 0; u.mt = 0; return true; }
    __device__ __forceinline__ void a_offs(const Unit&, int, int, int, int, int, unsigned (&)[2][2]) const {}
    __device__ __forceinline__ void a_ready(const Unit&) const {}
    __device__ __forceinline__ void done(const Unit&) const {}
};
template <bool GATHER_>
struct MoeOrder {
    static constexpr bool GATHER = GATHER_;
    const LAS int* tab; int NT, G, c, bt_per_e, bt_base; const int* tokidx;
    __device__ bool next(int i, Unit& u) const {
        const int L = i * G + c; if (L >= tab[64]) return false;
        int e = 0;
        for (int k = 1; k < NEXP; ++k) e += (L >= tab[32 + k]) ? 1 : 0;
        e = __builtin_amdgcn_readfirstlane(e);
        const int r = L - tab[32 + e];
        u.e = e; u.mt = r / NT; u.pnl = r % NT; u.pn = bt_base + e * bt_per_e + u.pnl; u.pm = (tab[65 + e] >> 8) + u.mt; return true;
    }
    __device__ __forceinline__ void a_offs(const Unit& u, int R0, int R1, int C0, int C1, int K, unsigned (&o)[2][2]) const {
        const int cnt = tab[u.e]; const int* tk = tokidx + (size_t)u.e * ECAP;
#pragma unroll
        for (int h = 0; h < 2; ++h) {
            int p0 = u.mt * 256 + h * 128 + R0, p1 = u.mt * 256 + h * 128 + R1; p0 = p0 < cnt ? p0 : cnt - 1; p1 = p1 < cnt ? p1 : cnt - 1;
            o[h][0] = ((unsigned)tk[p0] * (unsigned)K + (unsigned)C0) * 2u; o[h][1] = ((unsigned)tk[p1] * (unsigned)K + (unsigned)C1) * 2u; }
    }
    __device__ __forceinline__ void a_ready(const Unit&) const {}
    __device__ __forceinline__ void done(const Unit&) const {}
};

constexpr int SM_Q = 0, SM_P = 512, SM_KP = 4608, SM_RED = 5632, SM_PART = 5696, SM_MISC = 6208;
template <int NH, class KeyFn>
__device__ __forceinline__ float naive_attend(LAS float* sm, int tid, int nkeys, const KeyFn keyfn, const bf16* Kb, int kpitch, const bf16* Vb, int vpitch) {
    LAS int* kp = (LAS int*)(sm + SM_KP);
    const int lane = tid & 63, wave = tid >> 6;
    float sc[NH][2];
#pragma unroll
    for (int i = 0; i < 2; ++i) {
        const int kk = tid + 512 * i; const int kpos = (kk < nkeys) ? keyfn(kk) : -1; kp[kk] = kpos;
        float a[NH];
#pragma unroll
        for (int h = 0; h < NH; ++h) a[h] = 0.f;
        if (kpos >= 0) { const v4u* kr = (const v4u*)(Kb + (size_t)kpos * kpitch);
#pragma unroll 4
            for (int c = 0; c < 16; ++c) { const v4u kv = kr[c];
                const float k0 = bflo(kv.x), k1 = bfhi(kv.x), k2 = bflo(kv.y), k3 = bfhi(kv.y), k4 = bflo(kv.z), k5 = bfhi(kv.z), k6 = bflo(kv.w), k7 = bfhi(kv.w);
#pragma unroll
                for (int h = 0; h < NH; ++h) { const f32x4 qa = *(const LAS f32x4*)(sm + SM_Q + h * 128 + 8 * c), qb = *(const LAS f32x4*)(sm + SM_Q + h * 128 + 8 * c + 4);
                    a[h] += qa[0] * k0 + qa[1] * k1 + qa[2] * k2 + qa[3] * k3 + qb[0] * k4 + qb[1] * k5 + qb[2] * k6 + qb[3] * k7; } } }
#pragma unroll
        for (int h = 0; h < NH; ++h) sc[h][i] = (kpos >= 0) ? a[h] * ATT_SCALE : -INFINITY;
    }
#pragma unroll
    for (int h = 0; h < NH; ++h) { const float m = wave_max(fmaxf(sc[h][0], sc[h][1])); if (lane == 0) sm[SM_RED + wave * NH + h] = m; }
    __syncthreads();
    float mx[NH];
#pragma unroll
    for (int h = 0; h < NH; ++h) { float m = sm[SM_RED + h];
#pragma unroll
        for (int w = 1; w < 8; ++w) m = fmaxf(m, sm[SM_RED + w * NH + h]); mx[h] = m; }
    __syncthreads();
#pragma unroll
    for (int h = 0; h < NH; ++h) {
#pragma unroll
        for (int i = 0; i < 2; ++i) sc[h][i] = (sc[h][i] == -INFINITY) ? 0.f : __expf(sc[h][i] - mx[h]);
        const float s = wave_sum(sc[h][0] + sc[h][1]); if (lane == 0) sm[SM_RED + wave * NH + h] = s; }
    __syncthreads();
#pragma unroll
    for (int h = 0; h < NH; ++h) { float s = 0.f;
#pragma unroll
        for (int w = 0; w < 8; ++w) s += sm[SM_RED + w * NH + h];
        const float inv = s > 0.f ? 1.f / s : 0.f;
#pragma unroll
        for (int i = 0; i < 2; ++i) sm[SM_P + h * 1024 + tid + 512 * i] = sc[h][i] * inv; }
    __syncthreads();
    const int d = tid & 127, hs = tid >> 7;
    float o = 0.f;
    {
        const int hrow = (NH == 4) ? hs * 1024 : 0;
        const int k0 = (NH == 4) ? 0 : hs * 256, k1 = (NH == 4) ? nkeys : ((k0 + 256 < nkeys) ? k0 + 256 : nkeys);
        for (int kb = k0; kb < k1; kb += 8) {
            int kq[8]; float pq[8], vq[8];
#pragma unroll
            for (int j = 0; j < 8; ++j) { const int kpos = kp[kb + j]; pq[j] = (kpos >= 0 && kb + j < k1) ? sm[SM_P + hrow + kb + j] : 0.f; kq[j] = kpos >= 0 ? kpos : 0; }
#pragma unroll
            for (int j = 0; j < 8; ++j) vq[j] = bf2f(Vb[(size_t)kq[j] * vpitch + d]);
#pragma unroll
            for (int j = 0; j < 8; ++j) o += pq[j] * vq[j];
        }
    }
    if (NH == 1) {
        sm[SM_PART + tid] = o; __syncthreads();
        if (tid < 128) o = sm[SM_PART + tid] + sm[SM_PART + 128 + tid] + sm[SM_PART + 256 + tid] + sm[SM_PART + 384 + tid];
    }
    return o;
}

namespace att {
constexpr int D = 128, NW = 8, QBLK = 32, KVBLK = 64, QB = NW * QBLK;
constexpr int SHM_V = KVBLK * D * 2, SHM_K = KVBLK * D * 2;
constexpr int OFF_WS = 2 * SHM_V + 2 * SHM_K, OFF_OT = OFF_WS + NW * 64 * 4, LDS_BYTES = OFF_OT + NW * 32 * 4;
constexpr float SCALE = 0.08838834764831845f, THR = 8.f;
typedef short bf16x8 __attribute__((ext_vector_type(8)));
typedef short s16x4 __attribute__((ext_vector_type(4)));
typedef float f32x16 __attribute__((ext_vector_type(16)));
typedef float f32x4 __attribute__((ext_vector_type(4)));
typedef unsigned u32x4 __attribute__((ext_vector_type(4)));
typedef unsigned short bf16;
#define KSWZ(row, colB) ((row) * 256 + ((colB) ^ (((row) & 7) << 4)))
#define SBAR() __builtin_amdgcn_sched_barrier(0)
__device__ __forceinline__ int v_st(int k, int c) { const int kk = (k & ~0xC) | ((k & 4) << 1) | ((k & 8) >> 1); return ((kk >> 3) * 4 + (c >> 5)) * 512 + ((kk & 7) * 32 + (c & 31)) * 2; }
__device__ __forceinline__ int v_rd_base(int lane) { return ((lane & 3) << 3) | (((lane >> 2) & 3) << 6) | (((lane >> 4) & 1) << 5) | (((lane >> 5) & 1) << 8); }
constexpr int v_rd_off(int d0, int ks, int half) { return d0 * 512 + ks * 4096 + half * 2048; }
__device__ __forceinline__ int crow(int r, int hi) { return (r & 3) + 8 * (r >> 2) + 4 * hi; }
__device__ __forceinline__ unsigned cvtpk(float lo, float hi) { unsigned r; asm volatile("v_cvt_pk_bf16_f32 %0, %1, %2" : "=v"(r) : "v"(lo), "v"(hi)); return r; }
__device__ __forceinline__ bf16x8 load8(const bf16* p) { return *reinterpret_cast<const bf16x8*>(p); }
__device__ __forceinline__ void mask_tile(f32x16& p0, f32x16& p1, int dq, unsigned W) {
    const float NEG = -__builtin_inff();
#pragma unroll
    for (int r = 0; r < 16; ++r) {
        const int c = (r & 3) + 8 * (r >> 2);
        if ((unsigned)(dq - c) >= W) p0[r] = NEG;
        if ((unsigned)(dq - c - 32) >= W) p1[r] = NEG;
    }
}
__device__ __forceinline__ void partialSM(f32x16& p0, f32x16& p1, float& m_reg, float& mn, float& alpha) {
    float pmax = p0[0]; for (int r = 1; r < 16; ++r) pmax = fmaxf(pmax, p0[r]); for (int r = 0; r < 16; ++r) pmax = fmaxf(pmax, p1[r]);
    { auto rr = __builtin_amdgcn_permlane32_swap(__float_as_uint(pmax), __float_as_uint(pmax), false, false);
      pmax = fmaxf(__uint_as_float(rr[0]), __uint_as_float(rr[1])); }
    constexpr float C2 = 1.4426950408889634f * SCALE;
    if (__builtin_expect(__all((pmax - m_reg) * SCALE <= THR), 1)) { mn = m_reg; alpha = 1.f; }
    else { mn = fmaxf(m_reg, pmax); alpha = __builtin_amdgcn_exp2f((m_reg - mn) * C2); m_reg = mn; }
    const float mnL = -mn * C2;
    for (int r = 0; r < 16; ++r) p0[r] = fmaf(p0[r], C2, mnL); for (int r = 0; r < 16; ++r) p1[r] = fmaf(p1[r], C2, mnL);
    for (int r = 0; r < 16; ++r) p0[r] = __builtin_amdgcn_exp2f(p0[r]);
}
__device__ __forceinline__ void finishSM(f32x16& p0, f32x16& p1, float alpha, float& l_reg, bf16x8& pa0, bf16x8& pa1, bf16x8& pa2, bf16x8& pa3) {
    for (int r = 0; r < 16; ++r) p1[r] = __builtin_amdgcn_exp2f(p1[r]);
    float ps = 0; for (int r = 0; r < 16; ++r) ps += p0[r]; for (int r = 0; r < 16; ++r) ps += p1[r];
    { auto rr = __builtin_amdgcn_permlane32_swap(__float_as_uint(ps), __float_as_uint(ps), false, false);
      ps = __uint_as_float(rr[0]) + __uint_as_float(rr[1]); }
    l_reg = l_reg * alpha + ps;
#define PK4(P, B_, OUT) do { unsigned a0 = cvtpk(P[B_+0], P[B_+1]), a1 = cvtpk(P[B_+2], P[B_+3]);                          \
        unsigned b0 = cvtpk(P[B_+4], P[B_+5]), b1 = cvtpk(P[B_+6], P[B_+7]);                                             \
        auto r0 = __builtin_amdgcn_permlane32_swap(a0, b0, false, false); auto r1 = __builtin_amdgcn_permlane32_swap(a1, b1, false, false); \
        u32x4 w = {r0[0], r1[0], r0[1], r1[1]}; OUT = *reinterpret_cast<bf16x8*>(&w); } while (0)
    PK4(p0, 0, pa0); PK4(p0, 8, pa1); PK4(p1, 0, pa2); PK4(p1, 8, pa3);
#undef PK4
}
template <int KB, bool SK>
__device__ __forceinline__ void qkt(f32x16& p0, f32x16& p1, const char* K_lds, int r32, int hi, const bf16x8* qr, bool act) {
    if (SK && !act) { const float NEG = -__builtin_inff();
#pragma unroll
        for (int r = 0; r < 16; ++r) { p0[r] = NEG; p1[r] = NEG; } return; }
    p0 = f32x16{}; p1 = f32x16{};
    const char* kb[4];
#pragma unroll
    for (int dd = 0; dd < 4; ++dd) kb[dd] = K_lds + KB * SHM_K + KSWZ(r32, (dd * 16 + hi * 8) * 2);
#pragma unroll
    for (int d0 = 0; d0 < 8; ++d0) { const char* a = kb[d0 & 3] + (d0 >> 2) * 128;
        bf16x8 b0 = *reinterpret_cast<const bf16x8*>(a);
        bf16x8 b1 = *reinterpret_cast<const bf16x8*>(a + 32 * 256);
        p0 = __builtin_amdgcn_mfma_f32_32x32x16_bf16(b0, qr[d0], p0, 0, 0, 0);
        p1 = __builtin_amdgcn_mfma_f32_32x32x16_bf16(b1, qr[d0], p1, 0, 0, 0); }
}
template <int VB, bool SK>
__device__ __forceinline__ void pv_tile(f32x16* o, int vb0, bf16x8 pa0, bf16x8 pa1, bf16x8 pa2, bf16x8 pa3, bool act) {
    if (SK && !act) return;
#define TRRD(dst, off) asm volatile("ds_read_b64_tr_b16 %0, %1 offset:%2" : "=&v"(dst) : "v"(vb0), "i"(off) : "memory")
#define PV_D0(d0) do { s16x4 l0, l1, l2, l3, h0, h1, h2, h3; constexpr int b_ = VB * SHM_V + v_rd_off(d0, 0, 0); \
        TRRD(l0, b_); TRRD(h0, b_ + 2048); TRRD(l1, b_ + 4096); TRRD(h1, b_ + 6144); TRRD(l2, b_ + 8192); TRRD(h2, b_ + 10240); TRRD(l3, b_ + 12288); TRRD(h3, b_ + 14336); \
        asm volatile("s_waitcnt lgkmcnt(0)" ::: "memory"); SBAR();   \
        o[d0] = __builtin_amdgcn_mfma_f32_32x32x16_bf16(pa0, (bf16x8){l0[0], l0[1], l0[2], l0[3], h0[0], h0[1], h0[2], h0[3]}, o[d0], 0, 0, 0);   \
        o[d0] = __builtin_amdgcn_mfma_f32_32x32x16_bf16(pa1, (bf16x8){l1[0], l1[1], l1[2], l1[3], h1[0], h1[1], h1[2], h1[3]}, o[d0], 0, 0, 0);   \
        o[d0] = __builtin_amdgcn_mfma_f32_32x32x16_bf16(pa2, (bf16x8){l2[0], l2[1], l2[2], l2[3], h2[0], h2[1], h2[2], h2[3]}, o[d0], 0, 0, 0);   \
        o[d0] = __builtin_amdgcn_mfma_f32_32x32x16_bf16(pa3, (bf16x8){l3[0], l3[1], l3[2], l3[3], h3[0], h3[1], h3[2], h3[3]}, o[d0], 0, 0, 0); } while (0)
    PV_D0(0); PV_D0(1); PV_D0(2); PV_D0(3);
#undef PV_D0
#undef TRRD
}
struct Ref { const bf16* Q; const bf16* K; const bf16* V; bf16* O; const int* list; int kpitch, j_lo, j_hi, P0, W, a0, a1; };
struct Seam { bf16x8 qr[8]; bf16x8 st_v0, st_v1, st_k0, st_k1; };
#define ROW(p, kp, k0, rr) ((p) + (size_t)((k0) + (rr)) * (kp) + sc)
#define VMW() asm volatile("s_waitcnt vmcnt(0)" ::: "memory")
#define VMWN(n) asm volatile("s_waitcnt vmcnt(%0)" :: "i"(n) : "memory")
#define SLOAD_H(Kp, Vp, kp, k0) do { S.st_v0 = load8(ROW(Vp, kp, k0, sr)); S.st_v1 = load8(ROW(Vp, kp, k0, 32 + sr));              \
                         S.st_k0 = load8(ROW(Kp, kp, k0, sr)); S.st_k1 = load8(ROW(Kp, kp, k0, 32 + sr)); } while (0)
#define SWRITE_HK(bf) do { *(bf16x8*)(K_lds + (bf) * SHM_K + kws) = S.st_k0; *(bf16x8*)(K_lds + (bf) * SHM_K + kws + 32 * 256) = S.st_k1; } while (0)
#define SWRITE_HV(bf) do { *(bf16x8*)(V_lds + (bf) * SHM_V + vst0) = S.st_v0; *(bf16x8*)(V_lds + (bf) * SHM_V + vst1) = S.st_v1; } while (0)
#define SWRITE_H(bf) do { SWRITE_HV(bf); SWRITE_HK(bf); } while (0)
template <class RF>
__device__ __forceinline__ void prime(const Ref& cur, char* lds, Seam& S) {
    int tid_ = threadIdx.x; asm volatile("" : "+v"(tid_));
    const int tid = tid_, wid = __builtin_amdgcn_readfirstlane(tid >> 6), lane = tid & 63, r32 = lane & 31, hi = lane >> 5;
    const int sr = tid >> 4, sc = (tid & 15) * 8, kws = KSWZ(sr, sc * 2); char* K_lds = lds + 2 * SHM_V;
    const int kb0 = cur.j_lo * KVBLK;
    { const bf16* qrow = cur.Q + RF::q_off(cur, wid * QBLK + r32);
      for (int d0 = 0; d0 < 8; ++d0) S.qr[d0] = load8(qrow + d0 * 16 + hi * 8); }
    SLOAD_H(cur.K, cur.V, cur.kpitch, kb0); VMW(); SWRITE_HK(0);
    __syncthreads();
}
template <int MODE, bool WSKIP, class RF>
__device__ __forceinline__ void block(const Ref& cur, const Ref& nxt, float* LSE, char* lds, Seam& S, float* lse_lane = nullptr) {
    int tid_ = threadIdx.x; asm volatile("" : "+v"(tid_));
    const int tid = tid_, wid = __builtin_amdgcn_readfirstlane(tid >> 6), lane = tid & 63, r32 = lane & 31, hi = lane >> 5;
    const int j_lo = cur.j_lo, NT = cur.j_hi - cur.j_lo;
    const int kbn = nxt.j_lo * KVBLK;
    const int W = cur.W;
    const int qlo = cur.P0 + wid * QBLK;
    const int qm = (MODE == 2 ? RF::pos(cur, wid * QBLK + r32) : qlo + r32) - 4 * hi;
    const unsigned Wm = (MODE == 2) ? (unsigned)RF::Wl(cur, wid * QBLK + r32) : (unsigned)W;
    char* V_lds = lds; char* K_lds = lds + 2 * SHM_V;
    float* ws = (float*)(lds + OFF_WS) + wid * 64; float* li_l = ws, * al_l = ws + 32; int* ot_l = (int*)(lds + OFF_OT) + wid * 32;
    float m_reg = -1e30f, l_reg = 0; f32x16 o[4] = {};
    const int sr = tid >> 4, sc = (tid & 15) * 8, vst0 = v_st(sr, sc), vst1 = v_st(32 + sr, sc), kws = KSWZ(sr, sc * 2);
    const int vb0 = (int)(uintptr_t)V_lds + v_rd_base(lane);
    const bf16* Kh = cur.K; const bf16* Vh = cur.V; const int kp = cur.kpitch;
#define RESC(a) do { if (__any((a) < 1.f)) { if (hi == 0) al_l[r32] = (a); asm volatile("s_waitcnt lgkmcnt(0)" ::: "memory");              \
                     for (int d_ = 0; d_ < 4; ++d_) for (int r = 0; r < 16; ++r) o[d_][r] *= al_l[crow(r, hi)]; } } while (0)
#define KBASE(t) ((j_lo + (t)) * KVBLK)
#define ACT(t) (MODE != 0 || (KBASE(t) <= qlo + QBLK - 1 && KBASE(t) + KVBLK - 1 >= qlo - W + 1))
#define MASKT(P0_, P1_, t) do { const int kb_ = KBASE(t); if (MODE == 2) mask_tile(P0_, P1_, qm - kb_, Wm); \
        else if (MODE == 0) { if ((!SK || ACT(t)) && (kb_ + KVBLK - 1 > qlo || kb_ <= qlo + QBLK - 1 - W)) mask_tile(P0_, P1_, qm - kb_, Wm); } } while (0)
    constexpr int NQL = 8;
    constexpr bool SK = WSKIP && MODE == 0;
#define SEAM_K0() do { VMWN(NQL); SWRITE_HK(0); SBAR(); } while (0)
    f32x16 pA0, pA1, pB0, pB1; float mnA, mnB, alA, alB; bf16x8 pa0, pa1, pa2, pa3;
    SWRITE_HV(0); SBAR();
    if (NT > 1) { SLOAD_H(Kh, Vh, kp, KBASE(1)); }
    SBAR(); qkt<0, SK>(pA0, pA1, K_lds, r32, hi, S.qr, ACT(0));
    MASKT(pA0, pA1, 0); partialSM(pA0, pA1, m_reg, mnA, alA);
    if (NT > 1) { VMW(); SWRITE_H(1); }
    __syncthreads();
#define HALF_STEP(PX0, PX1, mnX, alX, PY0, PY1, alY, t, KB, VB, SB) do {                                                      \
        SBAR(); qkt<KB, SK>(PX0, PX1, K_lds, r32, hi, S.qr, ACT(t));                                             \
        finishSM(PY0, PY1, alY, l_reg, pa0, pa1, pa2, pa3); SBAR();                                                           \
        if ((t) + 1 < NT) { SLOAD_H(Kh, Vh, kp, KBASE((t) + 1)); SBAR(); }                                               \
        pv_tile<VB, SK>(o, vb0, pa0, pa1, pa2, pa3, ACT((t) - 1)); MASKT(PX0, PX1, (t)); partialSM(PX0, PX1, m_reg, mnX, alX);                                        \
        __syncthreads();                                                                                                      \
        if ((t) + 1 < NT) { VMW(); SWRITE_H(SB); }                                                                          \
        RESC(alX); __syncthreads(); } while (0)
    for (int t = 1; t + 1 < NT; t += 2) {
        HALF_STEP(pB0, pB1, mnB, alB, pA0, pA1, alA, t, 1, 0, 0);
        HALF_STEP(pA0, pA1, mnA, alA, pB0, pB1, alB, t + 1, 0, 1, 1);
    }
    const bool even = (NT & 1) == 0;
    if (even) { SBAR(); qkt<1, SK>(pB0, pB1, K_lds, r32, hi, S.qr, ACT(NT - 1)); SBAR(); }
    SLOAD_H(nxt.K, nxt.V, nxt.kpitch, kbn); SBAR();
    { const bf16* qrow = nxt.Q + RF::q_off(nxt, wid * QBLK + r32);
#pragma unroll
      for (int d0 = 0; d0 < 8; ++d0) S.qr[d0] = load8(qrow + d0 * 16 + hi * 8); }
    SBAR();
    finishSM(pA0, pA1, alA, l_reg, pa0, pa1, pa2, pa3); SBAR();
    pv_tile<0, SK>(o, vb0, pa0, pa1, pa2, pa3, ACT(even ? NT - 2 : NT - 1));
    if (even) { MASKT(pB0, pB1, NT - 1); partialSM(pB0, pB1, m_reg, mnB, alB); __syncthreads(); RESC(alB);
        finishSM(pB0, pB1, alB, l_reg, pa0, pa1, pa2, pa3); SBAR(); pv_tile<1, SK>(o, vb0, pa0, pa1, pa2, pa3, ACT(NT - 1)); }
    SBAR(); SEAM_K0();
    if (hi == 0) { li_l[r32] = l_reg; ot_l[r32] = RF::o_off(cur, wid * QBLK + r32); } asm volatile("s_waitcnt lgkmcnt(0)" ::: "memory");
    if (LSE != nullptr && hi == 0) { const int lq = RF::l_idx(cur, wid * QBLK + r32); if (lq >= 0) LSE[lq] = (l_reg > 0.f) ? m_reg * SCALE + __logf(l_reg) : -__builtin_inff(); }
    if (lse_lane != nullptr) *lse_lane = (l_reg > 0.f) ? m_reg * SCALE + __logf(l_reg) : -__builtin_inff();
    bf16* O = cur.O;
#pragma unroll
    for (int r = 0; r < 16; ++r) { const int orow = crow(r, hi); const float lv = li_l[orow]; const float rl = (lv > 0.f) ? __builtin_amdgcn_rcpf(lv) : 0.f; const int oo = ot_l[orow];
#pragma unroll
        for (int d0 = 0; d0 < 4; ++d0) { const float v = o[d0][r] * rl; const float vn = __shfl_xor(v, 1);
            if (oo >= 0 && (r32 & 1) == 0) *(unsigned*)(O + (size_t)oo + d0 * 32 + r32) = cvtpk(v, vn); } }
    __syncthreads();
#undef RESC
#undef KBASE
#undef ACT
#undef MASKT
#undef SEAM_K0
#undef HALF_STEP
}

template <class RF>
__device__ __forceinline__ void imp_sweep(const Ref& cur, float lse_lane, float* IMP  , char* lds, Seam& S) {
    int tid_ = threadIdx.x; asm volatile("" : "+v"(tid_));
    const int tid = tid_, wid = __builtin_amdgcn_readfirstlane(tid >> 6), lane = tid & 63, r32 = lane & 31, hi = lane >> 5;
    const int NT = cur.j_hi - cur.j_lo;
    char* K_lds = lds + 2 * SHM_V;
    const int sr = tid >> 4, sc = (tid & 15) * 8, kws = KSWZ(sr, sc * 2);
    const bf16* Kh = cur.K; const int kp = cur.kpitch;
    const int row = wid * QBLK + r32;
    const int qm = RF::pos(cur, row) - 4 * hi; const unsigned Wm = (unsigned)RF::Wl(cur, row);
    constexpr float C2 = 1.4426950408889634f * SCALE;
    const float nl2 = (lse_lane == -__builtin_inff()) ? 0.f : -lse_lane * 1.4426950408889634f;
    float carry = 0.f;
    float* imp_row = IMP + (size_t)(row >> 2) * 512;
    f32x16 p0, p1;
#define IMP_TILE(t, KB) do { \
        if ((t) + 1 < NT) { S.st_k0 = load8(ROW(Kh, kp, (cur.j_lo + (t) + 1) * KVBLK, sr)); S.st_k1 = load8(ROW(Kh, kp, (cur.j_lo + (t) + 1) * KVBLK, 32 + sr)); } \
        SBAR(); qkt<KB, false>(p0, p1, K_lds, r32, hi, S.qr, true); \
        mask_tile(p0, p1, qm - (cur.j_lo + (t)) * KVBLK, Wm); \
        _Pragma("unroll") for (int r = 0; r < 16; ++r) { p0[r] = __builtin_amdgcn_exp2f(fmaf(p0[r], C2, nl2)); p1[r] = __builtin_amdgcn_exp2f(fmaf(p1[r], C2, nl2)); } \
        float Gs[8], Ls[8]; \
        _Pragma("unroll") for (int q = 0; q < 4; ++q) { Gs[q] = (p0[4 * q] + p0[4 * q + 1]) + (p0[4 * q + 2] + p0[4 * q + 3]); Ls[q] = p0[4 * q + 3]; \
                                              Gs[4 + q] = (p1[4 * q] + p1[4 * q + 1]) + (p1[4 * q + 2] + p1[4 * q + 3]); Ls[4 + q] = p1[4 * q + 3]; } \
          \
        float prevL = carry; \
        _Pragma("unroll") for (int q = 0; q < 8; ++q) { const float other = __shfl_xor(Ls[q], 32);        \
            const float add = hi ? other : prevL; prevL = other; Gs[q] += add; } \
        carry = prevL;                                            \
        _Pragma("unroll") for (int q = 0; q < 8; ++q) { float v = Gs[q]; v += __shfl_xor(v, 1); v += __shfl_xor(v, 2); \
            if ((r32 & 3) == 0) imp_row[((cur.j_lo + (t)) << 4) + 2 * q + hi] = v; } \
        if ((t) + 1 < NT) { asm volatile("s_waitcnt vmcnt(0)" ::: "memory"); *(bf16x8*)(K_lds + ((KB) ^ 1) * SHM_K + kws) = S.st_k0; *(bf16x8*)(K_lds + ((KB) ^ 1) * SHM_K + kws + 32 * 256) = S.st_k1; } \
        __syncthreads(); } while (0)
    for (int t = 0; t < NT; t += 2) { IMP_TILE(t, 0); if (t + 1 < NT) IMP_TILE(t + 1, 1); }
#undef IMP_TILE
}
#undef ROW
#undef VMW
#undef VMWN
#undef SLOAD_H
#undef SWRITE_HK
#undef SWRITE_HV
#undef SWRITE_H
#undef KSWZ
#undef SBAR
}

struct RFReg {
    static __device__ __forceinline__ int q_off(const att::Ref&, int row) { return row * 1024; }
    static __device__ __forceinline__ int o_off(const att::Ref&, int row) { return row * 1024; }
    static __device__ __forceinline__ int l_idx(const att::Ref& u, int row) { return u.a0 >= 0 ? u.a0 + row * 8 : -1; }
    static __device__ __forceinline__ int pos(const att::Ref& u, int row) { return u.P0 + row; }
    static __device__ __forceinline__ int Wl(const att::Ref& u, int) { return u.W; }
};
__device__ __forceinline__ att::Ref win_ref(int L, const bf16* QN, const bf16* KW, const bf16* VW, bf16* OWIN) {
    const int h = L & 7, qb = L >> 3;
    att::Ref r; r.Q = QN + (size_t)qb * 256 * 1024 + h * 128; r.O = OWIN + (size_t)qb * 256 * 1024 + h * 128; r.K = KW + (h >> 2) * 128; r.V = VW + (h >> 2) * 128; r.kpitch = 256; r.list = nullptr;
    r.P0 = qb * 256; r.W = 512; r.j_lo = (r.P0 >= 511) ? (r.P0 - 511) >> 6 : 0; r.j_hi = ((r.P0 + 255) >> 6) + 1; r.a0 = -1; r.a1 = 0; return r;
}
__device__ __forceinline__ att::Ref mown_ref(int L, const bf16* QM, const bf16* KM, const bf16* VM, bf16* POWN) {
    const int h = L & 7, n = L >> 3; const size_t o = (size_t)n * 256 * 1024 + h * 128;
    att::Ref r; r.Q = QM + o; r.O = POWN + o; r.K = KM + o; r.V = VM + o; r.kpitch = 1024; r.list = nullptr;
    r.P0 = 0; r.W = 1 << 20; r.j_lo = 0; r.j_hi = 4; r.a0 = n * 256 * 8 + h; r.a1 = 0; return r;
}
struct RFSel {
    static __device__ __forceinline__ int q_off(const att::Ref& u, int row) { const int e = u.list[row < u.a0 ? row : 0]; return (e >> 2) * 1024; }
    static __device__ __forceinline__ int o_off(const att::Ref& u, int row) { if (row >= u.a0) return -1; const int e = u.list[row]; return (((e >> 2) * 8 + u.a1) * 3 + (e & 3)) * 128; }
    static __device__ __forceinline__ int l_idx(const att::Ref& u, int row) { if (row >= u.a0) return -1; const int e = u.list[row]; return ((e >> 2) * 8 + u.a1) * 3 + (e & 3); }
    static __device__ __forceinline__ int pos(const att::Ref&, int) { return 0; }
    static __device__ __forceinline__ int Wl(const att::Ref&, int) { return 0; }
};
__device__ __forceinline__ att::Ref msel_ref(int L, const LAS int* tab, const int* MLIST, const bf16* QM, const bf16* KM, const bf16* VM, bf16* PSEL) {
    int lo = 0, hi = 512;
    while (hi - lo > 1) { const int mid = (lo + hi) >> 1; if (tab[512 + mid] <= L) lo = mid; else hi = mid; }
    const int lid = __builtin_amdgcn_readfirstlane(lo), k = L - tab[512 + lid], h = lid >> 6, n = lid & 63;
    att::Ref r; r.Q = QM + h * 128; r.O = PSEL; r.K = KM + (size_t)n * 256 * 1024 + h * 128; r.V = VM + (size_t)n * 256 * 1024 + h * 128; r.kpitch = 1024;
    r.list = MLIST + (size_t)lid * 16384 + k * 256; r.P0 = 0; r.W = 0; r.j_lo = 0; r.j_hi = 4; r.a0 = tab[lid] - k * 256; r.a1 = h; return r;
}

struct RFSlc {
    static __device__ __forceinline__ int q_off(const att::Ref& u, int row) { const int e = u.list[(row >> 2) < u.a0 ? (row >> 2) : 0]; return (e >> 4) * 1024 + (row & 3) * 128; }
    static __device__ __forceinline__ int o_off(const att::Ref& u, int row) { if ((row >> 2) >= u.a0) return -1; const int e = u.list[row >> 2]; return (e * 4 + (row & 3)) * 128; }
    static __device__ __forceinline__ int l_idx(const att::Ref& u, int row) { if ((row >> 2) >= u.a0) return -1; const int e = u.list[row >> 2]; return e * 4 + (row & 3); }
    static __device__ __forceinline__ int pos(const att::Ref& u, int row) { const int e = u.list[(row >> 2) < u.a0 ? (row >> 2) : 0]; return (e >> 4) - 64 * u.a1; }
    static __device__ __forceinline__ int Wl(const att::Ref&, int) { return 1 << 30; }
};
__device__ __forceinline__ att::Ref nsel_ref(int L, int g, const LAS int* tab, const int* NLIST, const bf16* QN, const bf16* KS, const bf16* VS, bf16* PSLC) {
    int lo = 0, hi = 256;
    while (hi - lo > 1) { const int mid = (lo + hi) >> 1; if (tab[256 + mid] <= L) lo = mid; else hi = mid; }
    const int j = __builtin_amdgcn_readfirstlane(lo), k = L - tab[256 + j];
    att::Ref r; r.Q = QN + g * 512; r.O = PSLC; r.K = KS + (size_t)j * 64 * 256 + g * 128; r.V = VS + (size_t)j * 64 * 256 + g * 128; r.kpitch = 256;
    r.list = NLIST + (size_t)(g * 256 + j) * 16384 + k * 64; r.P0 = 0; r.W = 0; r.j_lo = 0; r.j_hi = 1; r.a0 = tab[j] - k * 64; r.a1 = j; return r;
}

struct RFCmp {
    static __device__ __forceinline__ int q_off(const att::Ref&, int row) { return (row >> 2) * 1024 + (row & 3) * 128; }
    static __device__ __forceinline__ int o_off(const att::Ref&, int row) { return (row >> 2) * 1024 + (row & 3) * 128; }
    static __device__ __forceinline__ int l_idx(const att::Ref&, int) { return -1; }
    static __device__ __forceinline__ int pos(const att::Ref& u, int row) { const int t = u.P0 + (row >> 2); return t >= 31 ? (t - 31) >> 4 : -1; }
    static __device__ __forceinline__ int Wl(const att::Ref&, int) { return 1 << 30; }
};
__device__ __forceinline__ att::Ref cmp_ref(int L, const bf16* QN, const bf16* KCMP, const bf16* VCMP, bf16* OCMP) {
    const int g = L & 1, c = (L < 256) ? (L >> 1) : 255 - ((L - 256) >> 1);
    att::Ref r; r.Q = QN + (size_t)c * 64 * 1024 + g * 512; r.O = OCMP + (size_t)c * 64 * 1024 + g * 512; r.K = KCMP + g * 128; r.V = VCMP + g * 128; r.kpitch = 256; r.list = nullptr;
    r.P0 = c * 64; r.W = 0; r.j_lo = 0; r.j_hi = (4 * c + 3 + 63) >> 6; r.a0 = g; r.a1 = c; return r;
}

struct Args { const float* in[18]; float* out; unsigned char* ws; int ph_lo, ph_hi, li, pad; };
typedef const __attribute__((address_space(4))) Args* ArgsP;
__device__ __forceinline__ ArgsP get_args() { auto p = __builtin_amdgcn_kernarg_segment_ptr(); asm volatile("" : "+s"(p)); return (ArgsP)p; }

__global__ void __launch_bounds__(NTHR, 2) mk_fwd(Args args_unused) {
    extern __shared__ __attribute__((aligned(16))) unsigned char lds_raw[];
    LAS unsigned char* lds = (LAS unsigned char*)lds_raw;
    LAS float* sm = (LAS float*)lds;
    volatile LAS unsigned* MISC = (volatile LAS unsigned*)(lds + MISC_OFF);
    LAS int* moetab = (LAS int*)(lds + MOETAB_OFF);
    const int G = gridDim.x, bid = blockIdx.x, NGW = G * NWAVES;
#define PH_IDS() int tid_ = threadIdx.x; asm volatile("" : "+v"(tid_)); const int tid = tid_, lane = tid & 63, wave = __builtin_amdgcn_readfirstlane(tid >> 6), gw = bid * NWAVES + wave; (void)lane; (void)gw;
#define AP() get_args()
#define CTLP(ws) ((gu32*)((ws) + WS_CTL))

    for (int u = threadIdx.x; u < (LDS_BYTES - LDSCTL_OFF) / 4; u += NTHR) ((LAS unsigned*)(lds + LDSCTL_OFF))[u] = 0u;
    __syncthreads();
    XcdBarrier bar; bar.bar = nullptr; bar.x = 0; bar.st = nullptr;
    if (MK_N_LAUNCHES == 1) bar = xcd_barrier_post((unsigned*)(CTLP(AP()->ws) + CW_BAR), MISC + 8);
#define GRID_BAR() do { if (MK_N_LAUNCHES == 1) { XcdBarrier b_ = bar; b_.bar = (unsigned*)(CTLP(AP()->ws) + CW_BAR); xcd_barrier(b_); } } while (0)
    const int lo = AP()->ph_lo, hi = AP()->ph_hi;
#define IN(k) (lo <= (k) && (k) < hi)
#define BOTH(k) (IN(k) && IN((k) + 1))

    if (IN(0)) {
        PH_IDS(); ArgsP ap = AP(); unsigned char* ws = ap->ws;
        LAS float* scr = (LAS float*)(lds + wave * 16384);
        constexpr int I_IN = 32 * 177, I_OUT = 32 * 64, I_GU = 32 * 16, I_DN = 8 * 64, I_W1 = 32 * 8;
        constexpr int N_IN = 2 * I_IN, N_OUT = 2 * I_OUT, N_G = 64 * I_GU, N_U = 64 * I_GU, N_D = 64 * I_DN, N_W1 = 8 * I_W1;
        constexpr int NITEMS = N_IN + N_OUT + N_G + N_U + N_D + N_W1;
        for (int it = gw; it < NITEMS; it += NGW) {
            int r = it;
            if (r < N_IN) { const int l = r / I_IN; transpose_item<1>(ap->in[6] + (size_t)l * D_ * IN_W, D_, IN_W, (bf16*)(ws + WS_WINT) + (size_t)l * NIN * D_, D_, 0, scr, r % I_IN, lane); continue; } r -= N_IN;
            if (r < N_OUT) { const int l = r / I_OUT; transpose_item<0>(ap->in[7] + (size_t)l * D_ * D_, D_, D_, (bf16*)(ws + WS_WOUTT) + (size_t)l * D_ * D_, D_, 0, scr, r % I_OUT, lane); continue; } r -= N_OUT;
            if (r < N_G) { const int le = r / I_GU; transpose_item<2>(ap->in[14] + (size_t)le * D_ * DEXP, D_, DEXP, (bf16*)(ws + WS_WGUT) + (size_t)le * 1024 * D_, D_, 0, scr, r % I_GU, lane); continue; } r -= N_G;
            if (r < N_U) { const int le = r / I_GU; transpose_item<3>(ap->in[15] + (size_t)le * D_ * DEXP, D_, DEXP, (bf16*)(ws + WS_WGUT) + (size_t)le * 1024 * D_, D_, 0, scr, r % I_GU, lane); continue; } r -= N_U;
            if (r < N_D) { const int le = r / I_DN; transpose_item<0>(ap->in[16] + (size_t)le * DEXP * D_, DEXP, D_, (bf16*)(ws + WS_WDT) + (size_t)le * D_ * DEXP, DEXP, 0, scr, r % I_DN, lane); continue; } r -= N_D;
            { const int m = r / I_W1, lk = m >> 1, half = m & 1;
              transpose_item<0>(ap->in[9] + (size_t)lk * 4096 * 256 + (size_t)half * 2048 * 256, 2048, 256, (bf16*)(ws + WS_WC1T) + (size_t)lk * 512 * 2048, 2048, half * 256, scr, r % I_W1, lane); }
        }
        { f32x2* ROPE = (f32x2*)(ws + WS_ROPE);
          for (int idx = bid * NTHR + tid; idx < S_ * 64; idx += G * NTHR) { const int pos = idx >> 6, i = idx & 63;
            const double inv = exp(-(double)i * (9.210340371976184 / 64.0)); const double ang = (double)pos * inv; double sv, cv; sincos(ang, &sv, &cv);
            ROPE[idx] = (f32x2){(float)cv, (float)sv}; } }
        __syncthreads();
        { float* MOD = (float*)(CTLP(ws) + CW_MOD); const float* c_in = ap->in[1]; const float* w_ada = ap->in[2]; const float* b_ada = ap->in[3];
          for (int k = tid; k < D_; k += NTHR) { const float cv = c_in[k]; sm[k] = cv / (1.f + __expf(-cv)); }
          __syncthreads();
          for (int it = bid; it < 2 * 96; it += G) { const int l = it / 96, cb = it % 96, grp = tid >> 5, col = cb * 128 + (tid & 31) * 4;
            f32x4 a = (f32x4){0.f, 0.f, 0.f, 0.f};
            const float* wp = w_ada + ((size_t)l * D_ + grp) * 12288 + col;
#pragma unroll 8
            for (int i = 0; i < 128; ++i) a += *(const f32x4*)(wp + (size_t)i * 16 * 12288) * sm[grp + 16 * i];
            *(LAS f32x4*)(sm + 4096 + grp * 128 + (tid & 31) * 4) = a;
            __syncthreads();
            if (tid < 128) { float s = b_ada[l * 12288 + cb * 128 + tid];
#pragma unroll
                for (int q = 0; q < 16; ++q) s += sm[4096 + q * 128 + tid];
                MOD[l * 12288 + cb * 128 + tid] = s; }
            __syncthreads(); } }
        { float* B1E = (float*)(CTLP(ws) + CW_B1E); const float* cmp_pe = ap->in[8]; const float* cmp_w1 = ap->in[9]; const float* cmp_b1 = ap->in[10];
          for (int it = bid - 192; it >= 0 && it < 4; it += G) { const int lk = it, grp = tid >> 6, n = (tid & 63) * 4;
            f32x4 a = (f32x4){0.f, 0.f, 0.f, 0.f};
            const float* wp = cmp_w1 + ((size_t)lk * 4096 + grp) * 256 + n; const float* pe = cmp_pe + (size_t)lk * 4096 + grp;
#pragma unroll 8
            for (int i = 0; i < 512; ++i) a += *(const f32x4*)(wp + (size_t)i * 8 * 256) * pe[i * 8];
            *(LAS f32x4*)(sm + 4096 + grp * 256 + n) = a;
            __syncthreads();
            if (tid < 256) { float s = cmp_b1[lk * 256 + tid];
#pragma unroll
                for (int q = 0; q < 8; ++q) s += sm[4096 + q * 256 + tid];
                B1E[lk * 256 + tid] = s; }
            __syncthreads(); } }
        if (BOTH(0)) GRID_BAR();
    }

    for (int l = 0; l < DEPTH; ++l) {
        const int pb = 1 + NPL * l;
#define LOAD_MOETAB(CNTP, NT_) do { __syncthreads(); if (tid < 32) moetab[tid] = (int)__hip_atomic_load((CNTP) + tid, RLX_AGENT); __syncthreads(); \
        if (tid == 0) { int us = 0, ps = 0; for (int e = 0; e < NEXP; ++e) { const int c = moetab[e], tl = (c + 255) >> 8; moetab[32 + e] = us; moetab[65 + e] = ps; us += tl * (NT_); ps += tl << 8; } moetab[64] = us; } \
        __syncthreads(); } while (0)

        if (IN(pb + 0)) {
            PH_IDS(); ArgsP ap = AP(); unsigned char* ws = ap->ws;
            const float* MOD = (const float*)(CTLP(ws) + CW_MOD); const float* mod = MOD + l * 12288;
            float* X = ap->out; bf16* H = (bf16*)(ws + WS_H); const bf16* Y = (const bf16*)(ws + WS_Y); const int* TE = (const int*)(ws + WS_TE);
            if (l > 0) LOAD_MOETAB((unsigned*)(CTLP(ws) + CW_CNT) + (l - 1) * 32, 1);
            { const float* g_attn = ap->in[4];
              for (int k = tid; k < D_; k += NTHR) { sm[k] = g_attn[l * D_ + k] * (1.f + mod[2048 + k]); sm[2048 + k] = mod[k]; sm[4096 + k] = (l > 0) ? MOD[(l - 1) * 12288 + 10240 + k] : 0.f; } }
            __syncthreads();
            const float* x_in = ap->in[0];
            for (int t = gw; t < S_; t += NGW) {
                f32x4 v[8]; float ss = 0.f;
                if (l == 0) {
#pragma unroll
                    for (int j = 0; j < 8; ++j) v[j] = *(const f32x4*)(x_in + (size_t)t * D_ + 256 * j + 4 * lane);
                } else {
                    const int4 te = *(const int4*)(TE + 4 * t);
                    const bf16* y0 = Y + (size_t)(moetab[65 + te.x] + te.y) * D_; const bf16* y1 = Y + (size_t)(moetab[65 + te.z] + te.w) * D_;
#pragma unroll
                    for (int j = 0; j < 8; ++j) { const int k = 256 * j + 4 * lane; const uint2 a = *(const uint2*)(y0 + k), b = *(const uint2*)(y1 + k);
                        const f32x4 gt2 = *(const LAS f32x4*)(sm + 4096 + k);
                        f32x4 ysum = (f32x4){bflo(a.x) + bflo(b.x), bfhi(a.x) + bfhi(b.x), bflo(a.y) + bflo(b.y), bfhi(a.y) + bfhi(b.y)};
                        v[j] = *(const f32x4*)(X + (size_t)t * D_ + k) + gt2 * ysum; *(f32x4*)(X + (size_t)t * D_ + k) = v[j]; }
                }
#pragma unroll
                for (int j = 0; j < 8; ++j) ss += (v[j][0] * v[j][0] + v[j][1] * v[j][1]) + (v[j][2] * v[j][2] + v[j][3] * v[j][3]);
                const float rstd = 1.f / sqrtf(wave_sum(ss) * (1.f / D_) + RMS_EPS);
#pragma unroll
                for (int j = 0; j < 8; ++j) { const int k = 256 * j + 4 * lane; const f32x4 h = v[j] * rstd * *(const LAS f32x4*)(sm + k) + *(const LAS f32x4*)(sm + 2048 + k);
                    *(uint2*)(H + (size_t)t * D_ + k) = make_uint2(pk2(h[0], h[1]), pk2(h[2], h[3])); }
            }
            if (BOTH(pb + 0)) GRID_BAR();
        }
        if (IN(pb + 1)) {
            ArgsP ap = AP(); unsigned char* ws = ap->ws;
            pg8::Gemm g{(const bf16*)(ws + WS_H), (const bf16*)(ws + WS_WINT) + (size_t)l * NIN * D_, S_, NIN, D_}; pg8::StaticOrder So; So.init(S_, NIN, G, bid);
            EpiInProj E{(bf16*)(ws + WS_QN), (bf16*)(ws + WS_KC), (bf16*)(ws + WS_VC), (bf16*)(ws + WS_KS), (bf16*)(ws + WS_VS), (bf16*)(ws + WS_KW), (bf16*)(ws + WS_VW),
                        (bf16*)(ws + WS_QM), (bf16*)(ws + WS_KM), (bf16*)(ws + WS_VM), (float*)(ws + WS_GATES), (const float*)(ws + WS_ROPE)};
            pg8::gemm_phase<EpiInProj, pg8::StaticOrder, true, true>(lds, g, So, E);
            if (BOTH(pb + 1)) GRID_BAR();
        }
        if (IN(pb + 2)) {
            PH_IDS(); ArgsP ap = AP(); unsigned char* ws = ap->ws;
            if (bid < 32) {
                pg8::Gemm g{(const bf16*)(ws + WS_KC), (const bf16*)(ws + WS_WC1T) + (size_t)l * 2 * 512 * 2048, 4096, 512, 2048}; CompressOrder So{G, bid};
                EpiF32 E{(float*)(ws + WS_UL), 512};
                pg8::gemm_phase<EpiF32, CompressOrder, false, true>(lds, g, So, E);
            }
            {
                const bf16* KM = (const bf16*)(ws + WS_KM); float* KMEAN = (float*)(ws + WS_KMEAN);
                const int nb = (G > 32) ? G - 32 : G, b0 = (G > 32) ? bid - 32 : bid;
                if (b0 >= 0) for (int u = b0; u < 512; u += nb) { const int n = u >> 3, h = u & 7, p = tid & 127, q = tid >> 7;
                    float s = 0.f; const bf16* kp = KM + (size_t)(n * 256 + q * 64) * 1024 + h * 128 + p;
#pragma unroll 16
                    for (int i = 0; i < 64; ++i) s += bf2f(kp[(size_t)i * 1024]);
                    sm[tid] = s; __syncthreads();
                    if (tid < 128) KMEAN[(size_t)(n * 8 + h) * 128 + tid] = (sm[tid] + sm[128 + tid] + sm[256 + tid] + sm[384 + tid]) * (1.f / 256.f);
                    __syncthreads(); }
            }
            if (BOTH(pb + 2)) GRID_BAR();
        }
        if (IN(pb + 3)) {
            PH_IDS(); ArgsP ap = AP(); unsigned char* ws = ap->ws;
            const float* UL = (const float*)(ws + WS_UL); const float* B1E = (const float*)(CTLP(ws) + CW_B1E); const f32x2* ROPE = (const f32x2*)(ws + WS_ROPE);
            bf16* KCMP = (bf16*)(ws + WS_KCMP); bf16* VCMP = (bf16*)(ws + WS_VCMP); const float* cmp_w2 = ap->in[11];
            LAS float* hid = sm + wave * 256;
            for (int u = gw; u < 2 * NC * 2; u += NGW) { const int kv = u / (NC * 2), r = u % (NC * 2), c = r >> 1, g = r & 1;
                const float* Ur = UL + ((size_t)kv * 2048 + g * 1024 + c) * 512; const float* Lr = UL + ((size_t)kv * 2048 + g * 1024 + c + 1) * 512 + 256;
                const float* be = B1E + (l * 2 + kv) * 256;
#pragma unroll
                for (int j = 0; j < 4; ++j) { const int n = lane + 64 * j; const float v = Ur[n] + Lr[n] + be[n];
                    hid[n] = 0.5f * v * (1.f + tanhf(0.7978845608028654f * (v + 0.044715f * v * v * v))); }
                LDS_WAIT(); asm volatile("" ::: "memory");
                const float* w2 = cmp_w2 + (size_t)(l * 2 + kv) * 256 * 128;
                float o0 = 0.f, o1 = 0.f;
#pragma unroll 8
                for (int n = 0; n < 256; ++n) { const float hv = hid[n]; o0 += hv * w2[n * 128 + lane]; o1 += hv * w2[n * 128 + 64 + lane]; }
                if (kv == 0) { const f32x2 cs = ROPE[(size_t)(16 * c + 31) * 64 + lane];
                    const float a = o0 * cs[0] - o1 * cs[1], b = o1 * cs[0] + o0 * cs[1];
                    *(unsigned*)(KCMP + ((size_t)c * 2 + g) * 128 + 2 * lane) = pk2(a, b);
                } else { VCMP[((size_t)c * 2 + g) * 128 + lane] = (bf16)f2bf(o0); VCMP[((size_t)c * 2 + g) * 128 + 64 + lane] = (bf16)f2bf(o1); }
                LDS_WAIT(); asm volatile("" ::: "memory");
            }
            if (BOTH(pb + 3)) GRID_BAR();
        }
        if (IN(pb + 4)) {
            {   ArgsP ap = AP(); unsigned char* ws = ap->ws;
                const bf16* QN = (const bf16*)(ws + WS_QN); const bf16* KCMP = (const bf16*)(ws + WS_KCMP); const bf16* VCMP = (const bf16*)(ws + WS_VCMP);
                bf16* OCMP = (bf16*)(ws + WS_OCMP); float* IMP = (float*)(ws + WS_IMP);
                att::Seam S;
                for (int L = bid; L < 512; L += G) { const att::Ref cur = cmp_ref(L, QN, KCMP, VCMP, OCMP); float lse;
                    att::prime<RFCmp>(cur, (char*)lds_raw, S);
                    att::block<2, false, RFCmp>(cur, cur, nullptr, (char*)lds_raw, S, &lse);
                    att::imp_sweep<RFCmp>(cur, lse, IMP + ((size_t)cur.a1 * 64 * 2 + cur.a0) * 256, (char*)lds_raw, S); }
            }
            {   ArgsP ap = AP(); unsigned char* ws = ap->ws;
                const bf16* QN = (const bf16*)(ws + WS_QN); const bf16* KW = (const bf16*)(ws + WS_KW); const bf16* VW = (const bf16*)(ws + WS_VW); bf16* OWIN = (bf16*)(ws + WS_OWIN);
                __syncthreads();
                att::Seam S; int L = bid;
                if (L < 512) { att::Ref cur = win_ref(L, QN, KW, VW, OWIN); att::prime<RFReg>(cur, (char*)lds_raw, S);
                    for (;;) { const bool more = L + G < 512; const att::Ref nxt = more ? win_ref(L + G, QN, KW, VW, OWIN) : cur;
                        att::block<0, true, RFReg>(cur, nxt, nullptr, (char*)lds_raw, S);
                        if (!more) break; cur = nxt; L += G; } }
                __syncthreads();
            }
            {   PH_IDS(); ArgsP ap = AP(); unsigned char* ws = ap->ws;
                const bf16* QM = (const bf16*)(ws + WS_QM); const float* KMEAN = (const float*)(ws + WS_KMEAN);
                unsigned* MCNT = (unsigned*)(CTLP(ws) + CW_MCNT) + l * 512; int* MLIST = (int*)(ws + WS_MLIST); float* LSES = (float*)(ws + WS_LSES);
                LAS float* qs = sm; LAS float* ks = sm + 8192; LAS float* gs = sm + 8192 + 64 * 132;
                for (int u = bid; u < 2048; u += G) { const int c = u >> 3, h = u & 7, own = c >> 2;
                    __syncthreads();
                    for (int i = tid; i < 64 * 128; i += NTHR) qs[i] = bf2f(QM[(size_t)(c * 64 + (i >> 7)) * 1024 + h * 128 + (i & 127)]);
                    for (int i = tid; i < own * 128; i += NTHR) ks[(i >> 7) * 132 + (i & 127)] = KMEAN[(size_t)((i >> 7) * 8 + h) * 128 + (i & 127)];
                    __syncthreads();
                    { const int q = tid >> 3, nn = tid & 7;
                      for (int n = nn; n < own; n += 8) { float a = 0.f;
#pragma unroll 8
                          for (int d = 0; d < 128; d += 4) { const f32x4 qa = *(const LAS f32x4*)(qs + q * 128 + d), ka = *(const LAS f32x4*)(ks + n * 132 + d); a += qa[0] * ka[0] + qa[1] * ka[1] + qa[2] * ka[2] + qa[3] * ka[3]; }
                          gs[q * 64 + n] = a; } }
                    __syncthreads();
                    for (int qq = 0; qq < 8; ++qq) { const int q = wave * 8 + qq, t = c * 64 + q;
                        float gv = (lane < own) ? gs[q * 64 + lane] : -INFINITY; int mysel = -1;
                        for (int r = 0; r < 3; ++r) { float bv = gv; int bi = lane;
#pragma unroll
                            for (int o = 1; o < 64; o <<= 1) { const float ov = __shfl_xor(bv, o); const int oi = __shfl_xor(bi, o); if (ov > bv || (ov == bv && oi < bi)) { bv = ov; bi = oi; } }
                            if (lane == r) mysel = (bv == -INFINITY) ? -1 : bi;
                            if (lane == bi) gv = -INFINITY; }
                        if (lane < 3) {
                            if (mysel >= 0) { const unsigned p = atomicAdd(MCNT + h * 64 + mysel, 1u); MLIST[(size_t)(h * 64 + mysel) * 16384 + p] = t * 4 + lane; }
                            else LSES[(t * 8 + h) * 3 + lane] = -INFINITY; } }
                }
            }
            if (BOTH(pb + 4)) GRID_BAR();
        }
        if (IN(pb + 5)) {
            PH_IDS(); ArgsP ap = AP(); unsigned char* ws = ap->ws;
            {   PH_IDS(); ArgsP ap = AP(); unsigned char* ws = ap->ws;
                const float* IMP = (const float*)(ws + WS_IMP); int* SEL = (int*)(ws + WS_SEL);
                unsigned* NCNT = (unsigned*)(CTLP(ws) + CW_NCNT) + l * 512; int* NLIST = (int*)(ws + WS_NLIST);
                for (int u = gw; u < S_ * 2; u += NGW) { const int t = u >> 1, g = u & 1, tb = t >> 6;
                    float v[4];
#pragma unroll
                    for (int i = 0; i < 4; ++i) { const int j = lane + 64 * i; const float im = IMP[(size_t)u * 256 + j]; const bool forced = (j == 0) || (j == tb) || (j == tb - 1);
                        v[i] = (j > tb) ? -INFINITY : (forced ? 1e9f : im); }
                    int mysel = -1;
                    for (int r = 0; r < 16; ++r) { float bv = v[0]; int bi = lane;
#pragma unroll
                        for (int i = 1; i < 4; ++i) if (v[i] > bv) { bv = v[i]; bi = lane + 64 * i; }
#pragma unroll
                        for (int o = 1; o < 64; o <<= 1) { const float ov = __shfl_xor(bv, o); const int oi = __shfl_xor(bi, o); if (ov > bv || (ov == bv && oi < bi)) { bv = ov; bi = oi; } }
                        if (bv == -INFINITY) break;
                        if (lane == r) mysel = bi;
#pragma unroll
                        for (int i = 0; i < 4; ++i) if (bi == lane + 64 * i) v[i] = -INFINITY; }
                    if (lane < 16) { SEL[(size_t)u * 16 + lane] = mysel;
                        if (mysel >= 0) { const unsigned p = atomicAdd(NCNT + g * 256 + mysel, 1u); NLIST[(size_t)(g * 256 + mysel) * 16384 + p] = t * 16 + lane; } }
                }
            }
            {   PH_IDS(); ArgsP ap = AP(); unsigned char* ws = ap->ws;
                const bf16* QM = (const bf16*)(ws + WS_QM); const bf16* KM = (const bf16*)(ws + WS_KM); const bf16* VM = (const bf16*)(ws + WS_VM);
                bf16* POWN = (bf16*)(ws + WS_POWN); bf16* PSEL = (bf16*)(ws + WS_PSEL); float* LSEO = (float*)(ws + WS_LSEO); float* LSES = (float*)(ws + WS_LSES);
                const int* MLIST = (const int*)(ws + WS_MLIST); unsigned* MCNT = (unsigned*)(CTLP(ws) + CW_MCNT) + l * 512;
                LAS int* mtab = (LAS int*)(lds + att::LDS_BYTES);
                __syncthreads();
                mtab[tid] = (int)__hip_atomic_load(MCNT + tid, RLX_AGENT);
                __syncthreads();
                if (tid == 0) { int us = 0; for (int i = 0; i < 512; ++i) { mtab[512 + i] = us; us += (mtab[i] + 255) >> 8; } mtab[1024] = us; }
                __syncthreads();
                const int nsel = mtab[1024];
                att::Seam S;
                { int L = bid;
                  if (L < 512) { att::Ref cur = mown_ref(L, QM, KM, VM, POWN); att::prime<RFReg>(cur, (char*)lds_raw, S);
                    for (;;) { const bool more = L + G < 512; const att::Ref nxt = more ? mown_ref(L + G, QM, KM, VM, POWN) : cur;
                        att::block<0, true, RFReg>(cur, nxt, LSEO, (char*)lds_raw, S);
                        if (!more) break; cur = nxt; L += G; } } }
                __syncthreads();
                { int L = bid;
                  if (L < nsel) { att::Ref cur = msel_ref(L, mtab, MLIST, QM, KM, VM, PSEL); att::prime<RFSel>(cur, (char*)lds_raw, S);
                    for (;;) { const bool more = L + G < nsel; const att::Ref nxt = more ? msel_ref(L + G, mtab, MLIST, QM, KM, VM, PSEL) : cur;
                        att::block<1, false, RFSel>(cur, nxt, LSES, (char*)lds_raw, S);
                        if (!more) break; cur = nxt; L += G; } } }
                __syncthreads();
            }
            if (BOTH(pb + 5)) GRID_BAR();
        }
        if (IN(pb + 6)) {
            PH_IDS(); ArgsP ap = AP(); unsigned char* ws = ap->ws;
            const bf16* POWN = (const bf16*)(ws + WS_POWN); const bf16* PSEL = (const bf16*)(ws + WS_PSEL); const float* LSEO = (const float*)(ws + WS_LSEO); const float* LSES = (const float*)(ws + WS_LSES);
            bf16* OMIX = (bf16*)(ws + WS_OMIX);
            for (int t = gw; t < S_; t += NGW) {
#pragma unroll 2
                for (int h = 0; h < 8; ++h) {
                    const float l0 = LSEO[t * 8 + h], l1 = LSES[(t * 8 + h) * 3], l2 = LSES[(t * 8 + h) * 3 + 1], l3 = LSES[(t * 8 + h) * 3 + 2];
                    const float m = fmaxf(fmaxf(l0, l1), fmaxf(l2, l3));
                    const float w0 = __expf(l0 - m), w1 = __expf(l1 - m), w2 = __expf(l2 - m), w3 = __expf(l3 - m), inv = 1.f / (w0 + w1 + w2 + w3);
                    const unsigned a0 = *(const unsigned*)(POWN + (size_t)t * 1024 + h * 128 + 2 * lane);
                    float o0 = w0 * bflo(a0), o1 = w0 * bfhi(a0);
                    const bf16* ps = PSEL + (size_t)((t * 8 + h) * 3) * 128 + 2 * lane;
                    if (w1 > 0.f) { const unsigned a = *(const unsigned*)(ps); o0 += w1 * bflo(a); o1 += w1 * bfhi(a); }
                    if (w2 > 0.f) { const unsigned a = *(const unsigned*)(ps + 128); o0 += w2 * bflo(a); o1 += w2 * bfhi(a); }
                    if (w3 > 0.f) { const unsigned a = *(const unsigned*)(ps + 256); o0 += w3 * bflo(a); o1 += w3 * bfhi(a); }
                    *(unsigned*)(OMIX + (size_t)t * 2048 + 1024 + h * 128 + 2 * lane) = pk2(o0 * inv, o1 * inv);
                }
            }
            if (BOTH(pb + 6)) GRID_BAR();

        }
        for (int g = 0; g < 2; ++g) {
            if (IN(pb + 7 + 2 * g)) {
                PH_IDS(); ArgsP ap = AP(); unsigned char* ws = ap->ws;
                const bf16* QN = (const bf16*)(ws + WS_QN); const bf16* KS = (const bf16*)(ws + WS_KS); const bf16* VS = (const bf16*)(ws + WS_VS);
                bf16* PSLC = (bf16*)(ws + WS_PSLC); float* LSEN = (float*)(ws + WS_LSEN); const int* NLIST = (const int*)(ws + WS_NLIST); unsigned* NCNT = (unsigned*)(CTLP(ws) + CW_NCNT) + l * 512 + g * 256;
                LAS int* ntab = (LAS int*)(lds + att::LDS_BYTES);
                __syncthreads();
                if (tid < 256) ntab[tid] = (int)__hip_atomic_load(NCNT + tid, RLX_AGENT);
                __syncthreads();
                if (tid == 0) { int us = 0; for (int i = 0; i < 256; ++i) { ntab[256 + i] = us; us += (ntab[i] + 63) >> 6; } ntab[512] = us; }
                __syncthreads();
                const int nun = ntab[512];
                att::Seam S; int L = bid;
                if (L < nun) { att::Ref cur = nsel_ref(L, g, ntab, NLIST, QN, KS, VS, PSLC); att::prime<RFSlc>(cur, (char*)lds_raw, S);
                    for (;;) { const bool more = L + G < nun; const att::Ref nxt = more ? nsel_ref(L + G, g, ntab, NLIST, QN, KS, VS, PSLC) : cur;
                        att::block<2, false, RFSlc>(cur, nxt, LSEN, (char*)lds_raw, S);
                        if (!more) break; cur = nxt; L += G; } }
                __syncthreads();
                if (BOTH(pb + 7 + 2 * g)) GRID_BAR();
            }
            if (IN(pb + 8 + 2 * g)) {
                PH_IDS(); ArgsP ap = AP(); unsigned char* ws = ap->ws;
                const bf16* PSLC = (const bf16*)(ws + WS_PSLC); const float* LSEN = (const float*)(ws + WS_LSEN); const int* SEL = (const int*)(ws + WS_SEL); const float* GATES = (const float*)(ws + WS_GATES);
                const bf16* OCMP = (const bf16*)(ws + WS_OCMP); const bf16* OWIN = (const bf16*)(ws + WS_OWIN); bf16* OMIX = (bf16*)(ws + WS_OMIX);
                for (int t = gw; t < S_; t += NGW) {
                    int nsel = 0;
#pragma unroll
                    for (int s = 0; s < 16; ++s) nsel += (SEL[(size_t)(t * 2 + g) * 16 + s] >= 0) ? 1 : 0;
#pragma unroll 1
                    for (int r = 0; r < 4; ++r) {
                        float m = -INFINITY;
                        for (int s = 0; s < nsel; ++s) m = fmaxf(m, LSEN[(size_t)(t * 16 + s) * 4 + r]);
                        float o0 = 0.f, o1 = 0.f, wsum = 0.f;
                        for (int s = 0; s < nsel; ++s) { const float w = __expf(LSEN[(size_t)(t * 16 + s) * 4 + r] - m); const unsigned a = *(const unsigned*)(PSLC + ((size_t)(t * 16 + s) * 4 + r) * 128 + 2 * lane);
                            o0 += w * bflo(a); o1 += w * bfhi(a); wsum += w; }
                        const float inv = 1.f / wsum;
                        const int hd = g * 4 + r; const float g0 = GATES[(size_t)t * 32 + hd * 3], g1 = GATES[(size_t)t * 32 + hd * 3 + 1], g2 = GATES[(size_t)t * 32 + hd * 3 + 2];
                        const size_t oi = (size_t)t * 1024 + hd * 128 + 2 * lane;
                        const unsigned c = *(const unsigned*)(OCMP + oi), w_ = *(const unsigned*)(OWIN + oi);
                        *(unsigned*)(OMIX + (size_t)t * 2048 + hd * 128 + 2 * lane) = pk2(g1 * o0 * inv + g0 * bflo(c) + g2 * bflo(w_), g1 * o1 * inv + g0 * bfhi(c) + g2 * bfhi(w_));
                    }
                }
                if (BOTH(pb + 8 + 2 * g)) GRID_BAR();
            }
        }
        if (IN(pb + 11)) {
            ArgsP ap = AP(); unsigned char* ws = ap->ws;
            pg8::Gemm g{(const bf16*)(ws + WS_OMIX), (const bf16*)(ws + WS_WOUTT) + (size_t)l * D_ * D_, S_, D_, D_}; pg8::StaticOrder So; So.init(S_, D_, G, bid);
            EpiOutProj E{l == 0 ? ap->in[0] : (const float*)ap->out, ap->out, (const float*)(CTLP(ws) + CW_MOD) + l * 12288 + 4096};
            pg8::gemm_phase<EpiOutProj, pg8::StaticOrder, true, true>(lds, g, So, E);
            if (BOTH(pb + 11)) GRID_BAR();
        }
        if (IN(pb + 12)) {
            PH_IDS(); ArgsP ap = AP(); unsigned char* ws = ap->ws;
            const float* mod = (const float*)(CTLP(ws) + CW_MOD) + l * 12288;
            const float* X = ap->out; bf16* H = (bf16*)(ws + WS_H); const float* w_router = ap->in[12]; const float* b_router = ap->in[13];
            unsigned* CNT = (unsigned*)(CTLP(ws) + CW_CNT) + l * 32; int* TE = (int*)(ws + WS_TE); int* TOKIDX = (int*)(ws + WS_TOKIDX); float* WTS = (float*)(ws + WS_WTS);
            { const float* g_ffn = ap->in[5];
              for (int k = tid; k < D_; k += NTHR) { sm[k] = g_ffn[l * D_ + k] * (1.f + mod[8192 + k]); sm[2048 + k] = mod[6144 + k]; }
              if (tid < 32) sm[4096 + tid] = b_router[tid]; }
            __syncthreads();
            for (int t = gw; t < S_; t += NGW) {
                f32x4 v[8]; float ss = 0.f;
#pragma unroll
                for (int j = 0; j < 8; ++j) { v[j] = *(const f32x4*)(X + (size_t)t * D_ + 256 * j + 4 * lane); ss += (v[j][0] * v[j][0] + v[j][1] * v[j][1]) + (v[j][2] * v[j][2] + v[j][3] * v[j][3]); }
                const float rstd = 1.f / sqrtf(wave_sum(ss) * (1.f / D_) + RMS_EPS);
#pragma unroll
                for (int j = 0; j < 8; ++j) { const int k = 256 * j + 4 * lane; v[j] = v[j] * rstd * *(const LAS f32x4*)(sm + k) + *(const LAS f32x4*)(sm + 2048 + k);
                    *(uint2*)(H + (size_t)t * D_ + k) = make_uint2(pk2(v[j][0], v[j][1]), pk2(v[j][2], v[j][3])); }
                { LAS float* hrow = sm + 8192 + wave * 2048;
#pragma unroll
                  for (int j = 0; j < 8; ++j) *(LAS f32x4*)(hrow + 256 * j + 4 * lane) = v[j];
                  LDS_WAIT(); asm volatile("" ::: "memory");
                  const int e = lane & 31, k0 = (lane >> 5) * 1024; const float* wp = w_router + (size_t)k0 * 32 + e; float acc = 0.f;
#pragma unroll 4
                  for (int k = 0; k < 1024; k += 4) { const f32x4 hv = *(const LAS f32x4*)(hrow + k0 + k);
                      acc += hv[0] * wp[(size_t)k * 32] + hv[1] * wp[(size_t)(k + 1) * 32] + hv[2] * wp[(size_t)(k + 2) * 32] + hv[3] * wp[(size_t)(k + 3) * 32]; }
                  acc += __shfl_xor(acc, 32);
                  if (lane < 32) sm[4160 + wave * 32 + lane] = acc;
                  LDS_WAIT(); asm volatile("" ::: "memory"); }
                float lg[32];
#pragma unroll
                for (int e = 0; e < 32; ++e) lg[e] = sm[4160 + wave * 32 + e];
                int grp = 0; float best = -INFINITY;
#pragma unroll
                for (int e = 0; e < 32; ++e) lg[e] = 1.f / (1.f + __expf(-lg[e]));
#pragma unroll
                for (int gq = 0; gq < 4; ++gq) { float m1 = -INFINITY, m2 = -INFINITY;
#pragma unroll
                    for (int i = 0; i < 8; ++i) { const float b = lg[gq * 8 + i] + sm[4096 + gq * 8 + i]; if (b > m1) { m2 = m1; m1 = b; } else if (b > m2) m2 = b; }
                    const float sgs = m1 + m2; if (sgs > best) { best = sgs; grp = gq; } }
                float m1 = -INFINITY, m2 = -INFINITY, s1 = 0.f, s2 = 0.f; int i1 = 0, i2 = 0;
#pragma unroll
                for (int e = 0; e < 32; ++e) { const bool ing = (e >> 3) == grp; const float b = lg[e] + sm[4096 + e];
                    if (ing && b > m1) { m2 = m1; i2 = i1; s2 = s1; m1 = b; i1 = e; s1 = lg[e]; } else if (ing && b > m2) { m2 = b; i2 = e; s2 = lg[e]; } }
                if (lane == 0) {
                    const float inv = 1.f / (s1 + s2);
                    const unsigned p1 = atomicAdd(CNT + i1, 1u), p2 = atomicAdd(CNT + i2, 1u);
                    TOKIDX[(size_t)i1 * ECAP + p1] = t; TOKIDX[(size_t)i2 * ECAP + p2] = t; WTS[(size_t)i1 * ECAP + p1] = s1 * inv; WTS[(size_t)i2 * ECAP + p2] = s2 * inv;
                    *(int4*)(TE + 4 * t) = make_int4(i1, (int)p1, i2, (int)p2);
                }
            }
            if (BOTH(pb + 12)) GRID_BAR();
        }
        if (IN(pb + 13)) {
            PH_IDS(); ArgsP ap = AP(); unsigned char* ws = ap->ws;
            LOAD_MOETAB((unsigned*)(CTLP(ws) + CW_CNT) + l * 32, 4);
            pg8::Gemm g{(const bf16*)(ws + WS_H), (const bf16*)(ws + WS_WGUT), 0, 0, D_}; MoeOrder<true> So{moetab, 4, G, bid, 4, l * 32 * 4, (const int*)(ws + WS_TOKIDX)};
            EpiGateUp E{(bf16*)(ws + WS_HACT)};
            pg8::gemm_phase<EpiGateUp, MoeOrder<true>, true, true>(lds, g, So, E);
            if (BOTH(pb + 13)) GRID_BAR();
        }
        if (IN(pb + 14)) {
            PH_IDS(); ArgsP ap = AP(); unsigned char* ws = ap->ws;
            LOAD_MOETAB((unsigned*)(CTLP(ws) + CW_CNT) + l * 32, 8);
            pg8::Gemm g{(const bf16*)(ws + WS_HACT), (const bf16*)(ws + WS_WDT), 0, 0, DEXP}; MoeOrder<false> So{moetab, 8, G, bid, 8, l * 32 * 8, nullptr};
            EpiDown E{(bf16*)(ws + WS_Y), (const float*)(ws + WS_WTS), moetab};
            pg8::gemm_phase<EpiDown, MoeOrder<false>, true, true>(lds, g, So, E);
            if (BOTH(pb + 14)) GRID_BAR();
        }
    }
    if (IN(NPH - 1)) {
        PH_IDS(); ArgsP ap = AP(); unsigned char* ws = ap->ws;
        float* X = ap->out; const bf16* Y = (const bf16*)(ws + WS_Y); const int* TE = (const int*)(ws + WS_TE);
        LOAD_MOETAB((unsigned*)(CTLP(ws) + CW_CNT) + 32, 1);
        const bool tmo_set = (MK_N_LAUNCHES == 1) && (__hip_atomic_load((unsigned*)(CTLP(ws) + CW_BAR) + XB_TMO, RLX_AGENT) != 0u);
        { const float* g_final = ap->in[17]; const float* MOD = (const float*)(CTLP(ws) + CW_MOD);
          for (int k = tid; k < D_; k += NTHR) { sm[k] = g_final[k]; sm[2048 + k] = MOD[12288 + 10240 + k]; } }
        __syncthreads();
        for (int t = gw; t < S_; t += NGW) {
            f32x4 v[8]; float ss = 0.f;
            const int4 te = *(const int4*)(TE + 4 * t);
            const bf16* y0 = Y + (size_t)(moetab[65 + te.x] + te.y) * D_; const bf16* y1 = Y + (size_t)(moetab[65 + te.z] + te.w) * D_;
#pragma unroll
            for (int j = 0; j < 8; ++j) { const int k = 256 * j + 4 * lane; const uint2 a = *(const uint2*)(y0 + k), b = *(const uint2*)(y1 + k);
                const f32x4 gt2 = *(const LAS f32x4*)(sm + 2048 + k);
                f32x4 ysum = (f32x4){bflo(a.x) + bflo(b.x), bfhi(a.x) + bfhi(b.x), bflo(a.y) + bflo(b.y), bfhi(a.y) + bfhi(b.y)};
                v[j] = *(const f32x4*)(X + (size_t)t * D_ + k) + gt2 * ysum;
                ss += (v[j][0] * v[j][0] + v[j][1] * v[j][1]) + (v[j][2] * v[j][2] + v[j][3] * v[j][3]); }
            const float rstd = (tmo_set ? __builtin_nanf("") : 1.f) / sqrtf(wave_sum(ss) * (1.f / D_) + RMS_EPS);
#pragma unroll
            for (int j = 0; j < 8; ++j) { const int k = 256 * j + 4 * lane; *(f32x4*)(X + (size_t)t * D_ + k) = v[j] * rstd * *(const LAS f32x4*)(sm + k); }
        }
    }
#undef IN
#undef BOTH
#undef GRID_BAR
#undef LOAD_MOETAB
#undef AP
#undef CTLP
#undef PH_IDS
}

extern "C" void kernel_launch(void* const* d_in, const int* in_sizes, int n_in, void* d_out, int out_size, void* d_ws, size_t ws_size, hipStream_t stream) {
    static int grid = 0;
    if (grid == 0) {
        if (n_in != 18 || out_size != S_ * D_ || ws_size < WS_END) { fprintf(stderr, "kernel_launch: unexpected shapes (n_in %d out %d ws %zu)\n", n_in, out_size, ws_size); grid = -1; return; }
        int dev = 0, cus = 0, per_cu = 0;
        if (hipGetDevice(&dev) != hipSuccess || hipDeviceGetAttribute(&cus, hipDeviceAttributeMultiprocessorCount, dev) != hipSuccess) { grid = -1; return; }
        if (hipFuncSetAttribute((const void*)mk_fwd, hipFuncAttributeMaxDynamicSharedMemorySize, LDS_BYTES) != hipSuccess) { fprintf(stderr, "kernel_launch: hipFuncSetAttribute failed\n"); grid = -1; return; }
        if (hipOccupancyMaxActiveBlocksPerMultiprocessor(&per_cu, (const void*)mk_fwd, NTHR, LDS_BYTES) != hipSuccess || per_cu < 1) { fprintf(stderr, "kernel_launch: occupancy query says %d\n", per_cu); }
        (void)hipGetLastError();
        grid = cus;
    }
    if (grid < 0) return;
    if (hipMemsetAsync((char*)d_ws + WS_CTL, 0, CTL_ZERO_BYTES, stream) != hipSuccess) return;
    Args a{};
    for (int i = 0; i < 18; ++i) a.in[i] = (const float*)d_in[i];
    a.out = (float*)d_out; a.ws = (unsigned char*)d_ws; a.pad = 0;
    if (MK_N_LAUNCHES == 1) {
        a.ph_lo = 0; a.ph_hi = NPH; a.li = 0;
        hipLaunchKernelGGL(mk_fwd, dim3(grid), dim3(NTHR), LDS_BYTES, stream, a);
    } else {
        for (int p = 0; p < NPH; ++p) { a.ph_lo = p; a.ph_hi = p + 1; a.li = p; hipLaunchKernelGGL(mk_fwd, dim3(grid), dim3(NTHR), LDS_BYTES, stream, a); }
    }
}
```

```cpp
#include <hip/hip_runtime.h>
#include <cstdio>
#include <cstdint>

namespace pg8 {
#define PG8_LAS __attribute__((address_space(3)))
typedef unsigned short bf16_t;
typedef short bf16x8 __attribute__((ext_vector_type(8)));
typedef float f32x4 __attribute__((ext_vector_type(4)));
typedef unsigned u32x4 __attribute__((ext_vector_type(4)));
constexpr int BM = 256, BK = 64, HALF = 128, HTB = HALF * BK * 2, STAGE_BYTES = 8 * HTB, NXCD = 8, WGM = 8;

__host__ __device__ __forceinline__ int lds_byte(int r, int c) { const int st = (r >> 4) * 2 + (c >> 5), rr = r & 15, cc = c & 31, ob = rr * 64 + cc * 2; return st * 1024 + (ob ^ (((ob >> 9) & 1) << 5)); }
__host__ __device__ __forceinline__ void stage_rc(int b, int& R, int& C) { const int st = b / 1024, sb = b % 1024, swz = sb ^ (((sb >> 9) & 1) << 5); R = (st >> 1) * 16 + swz / 64; C = (st & 1) * 32 + (swz % 64) / 2; }
__host__ __device__ __forceinline__ int perm32(int rho) { const int n = rho >> 4, i = rho & 15; return 8 * (i >> 2) + 4 * n + (i & 3); }

struct Unit { int pm, pn, e, mt, pnl; };
struct Gemm { const bf16_t* A; const bf16_t* Bt; int M, N, K; };

struct StaticOrder {
    static constexpr bool GATHER = false;
    int nM, nN, nwg, G, c;
    __host__ __device__ void init(int M, int N, int G_, int c_) { nM = M / BM; nN = N / BM; nwg = nM * nN; G = G_; c = c_; }
    __host__ __device__ bool next(int i, Unit& u) const {
        const long L = (long)i * G + c; if (L >= nwg) return false;
        int wgid = (int)L; { const int q = nwg / NXCD, r = nwg % NXCD, xcd = wgid % NXCD, off = wgid / NXCD; wgid = (xcd < r ? xcd * (q + 1) : r * (q + 1) + (xcd - r) * q) + off; }
        const int nig = WGM * nN, gid = wgid / nig, fm = gid * WGM, gsz = (nM - fm) < WGM ? (nM - fm) : WGM;
        u.pm = fm + ((wgid % nig) % gsz); u.pn = (wgid % nig) / gsz; u.e = 0; u.mt = 0; u.pnl = u.pn; return true;
    }
    __device__ __forceinline__ void a_offs(const Unit&, int, int, int, int, int, unsigned (&)[2][2]) const {}
    __device__ __forceinline__ void a_ready(const Unit&) const {}
    __device__ __forceinline__ void done(const Unit&) const {}
};

__device__ __forceinline__ unsigned cvt_pk_bf16(float lo, float hi) { unsigned r; asm volatile("v_cvt_pk_bf16_f32 %0, %1, %2" : "=v"(r) : "v"(lo), "v"(hi)); return r; }

template <class Epi, class Sched, bool ALIGN_EPI = false, bool SP2 = false>
__device__ __forceinline__ void gemm_phase(PG8_LAS unsigned char* lds, const Gemm g, const Sched& S, const Epi& E) {
    int tid_ = threadIdx.x; asm volatile("" : "+v"(tid_));
    const int tid = tid_, wid = __builtin_amdgcn_readfirstlane(tid >> 6), lane = tid & 63, wr = wid >> 2, wc = wid & 3, fr = lane & 15, fq = lane >> 4;
    const int K = g.K, nt = K / BK;
    unsigned voffA[2], voffB[2]; int RR[2], CC[2];
#pragma unroll
    for (int i = 0; i < 2; ++i) { int R, C; stage_rc(tid * 16 + i * 8192, R, C); const int Rb = Epi::PERM ? ((R & ~31) + perm32(R & 31)) : R;
        RR[i] = R; CC[i] = C; voffA[i] = (unsigned)(R * K + C) * 2u; voffB[i] = (unsigned)(Rb * K + C) * 2u; }
    const size_t kstep = (size_t)(BK * 2);
    const size_t hstep = (size_t)HALF * K * 2;
    const size_t tstep = 2 * hstep;
    const unsigned ldsw = (unsigned)wid * 1024u;
    const int aoff = lds_byte(wr * 64 + fr, fq * 8), boff = lds_byte(wc * 32 + fr, fq * 8);
    const char* gA = (const char*)g.A;
    unsigned aoC[2][2] = {{0u, 0u}, {0u, 0u}}, aoN[2][2] = {{0u, 0u}, {0u, 0u}};
#define PG8_SA(b, h) (((b) * 2 + (h)) * HTB)
#define PG8_SB(b, h) ((4 + (b) * 2 + (h)) * HTB)
#define PG8_STAGE(bufoff, gbase, voff) do { _Pragma("unroll") for (int _i = 0; _i < 2; ++_i) \
        __builtin_amdgcn_global_load_lds((const unsigned*)((const char*)(gbase) + (voff)[_i]), (PG8_LAS unsigned*)(lds + (bufoff) + ldsw + _i * 8192), 16, 0, 0); } while (0)
#define PG8_STAGE_A(bufoff, h, PN, KO) do { if constexpr (Sched::GATHER) { _Pragma("unroll") for (int _i = 0; _i < 2; ++_i) \
        __builtin_amdgcn_global_load_lds((const unsigned*)(gA + aoC[h][_i] + (KO)), (PG8_LAS unsigned*)(lds + (bufoff) + ldsw + _i * 8192), 16, 0, 0); } \
        else { PG8_STAGE(bufoff, (PN) + (h) * hstep, voffA); } } while (0)
#define PG8_LDA(dst, b, h) do { _Pragma("unroll") for (int m = 0; m < 4; ++m) _Pragma("unroll") for (int k = 0; k < 2; ++k) dst[m][k] = *(const PG8_LAS bf16x8*)(lds + PG8_SA(b, h) + aoff + m * 2048 + k * 1024); } while (0)
#define PG8_LDB(dst, b, h) do { _Pragma("unroll") for (int n = 0; n < 2; ++n) _Pragma("unroll") for (int k = 0; k < 2; ++k) dst[n][k] = *(const PG8_LAS bf16x8*)(lds + PG8_SB(b, h) + boff + n * 2048 + k * 1024); } while (0)
#define PG8_MMA(ai, bj, At, Bt) do { __builtin_amdgcn_s_setprio(1); _Pragma("unroll") for (int m = 0; m < 4; ++m) _Pragma("unroll") for (int n = 0; n < 2; ++n) _Pragma("unroll") for (int k = 0; k < 2; ++k) \
        acc[ai][bj][m][n] = __builtin_amdgcn_mfma_f32_16x16x32_bf16(Bt[n][k], At[m][k], acc[ai][bj][m][n], 0, 0, 0); __builtin_amdgcn_s_setprio(0); } while (0)
#define PG8_WAIT_V(n) asm volatile("s_waitcnt vmcnt(" #n ")" ::: "memory")
#define PG8_WAIT_L(n) asm volatile("s_waitcnt lgkmcnt(" #n ")" ::: "memory")
#define PG8_BAR __builtin_amdgcn_s_barrier()
#define PG8_SCHED __builtin_amdgcn_sched_barrier(0)
    Unit cur, nxt; int ui = 0;
    if (!S.next(0, cur)) return;
    f32x4 acc[2][2][4][2];
#pragma unroll
    for (int a = 0; a < 2; ++a)
#pragma unroll
        for (int b = 0; b < 2; ++b)
#pragma unroll
            for (int m = 0; m < 4; ++m)
#pragma unroll
                for (int n = 0; n < 2; ++n) acc[a][b][m][n] = (f32x4){0.f, 0.f, 0.f, 0.f};
    bf16x8 At[4][2], B0[2][2], B1[2][2];
    const char* cA = (const char*)g.A + (size_t)cur.pm * tstep; const char* cB = (const char*)g.Bt + (size_t)cur.pn * tstep;
    if constexpr (Sched::GATHER) S.a_offs(cur, RR[0], RR[1], CC[0], CC[1], K, aoC);
    S.a_ready(cur);
    if constexpr (SP2) {
        PG8_STAGE(PG8_SB(0, 0), cB, voffB); PG8_STAGE(PG8_SB(0, 1), cB + hstep, voffB); PG8_STAGE_A(PG8_SA(0, 0), 0, cA, 0); PG8_STAGE_A(PG8_SA(0, 1), 1, cA, 0);
        if (wr == 1) PG8_BAR;
        PG8_WAIT_V(2); PG8_BAR;
        PG8_STAGE(PG8_SB(1, 0), cB + kstep, voffB); PG8_STAGE_A(PG8_SA(1, 0), 0, cA + kstep, kstep); PG8_STAGE(PG8_SB(1, 1), cB + hstep + kstep, voffB);
        PG8_WAIT_V(6); PG8_BAR;
    } else {
        PG8_STAGE(PG8_SB(0, 0), cB, voffB); PG8_STAGE_A(PG8_SA(0, 0), 0, cA, 0); PG8_STAGE(PG8_SB(0, 1), cB + hstep, voffB); PG8_STAGE_A(PG8_SA(0, 1), 1, cA, 0);
        if (wr == 1) PG8_BAR;
        PG8_WAIT_V(4); PG8_BAR;
        PG8_STAGE(PG8_SB(1, 0), cB + kstep, voffB); PG8_STAGE_A(PG8_SA(1, 0), 0, cA + kstep, kstep); PG8_STAGE(PG8_SB(1, 1), cB + hstep + kstep, voffB);
        PG8_WAIT_V(6); PG8_BAR;
    }
    for (;;) {
        const bool has_next = S.next(ui + 1, nxt);
        const char* nA = has_next ? (const char*)g.A + (size_t)nxt.pm * tstep : cA; const char* nB = has_next ? (const char*)g.Bt + (size_t)nxt.pn * tstep : cB;
        if constexpr (Sched::GATHER) {
            if (has_next) S.a_offs(nxt, RR[0], RR[1], CC[0], CC[1], K, aoN);
            else {
#pragma unroll
                for (int h = 0; h < 2; ++h)
#pragma unroll
                    for (int i = 0; i < 2; ++i) aoN[h][i] = aoC[h][i]; }
        }
        for (int t = 0; t < nt; t += 2) {
            const bool last = (t == nt - 2);
            const char* a1 = cA + (size_t)(t + 1) * kstep;
            const char* a2 = last ? nA : cA + (size_t)(t + 2) * kstep; const char* b2 = last ? nB : cB + (size_t)(t + 2) * kstep;
            const char* a3 = a2 + kstep; const char* b3 = b2 + kstep;
            const size_t k1 = (size_t)(t + 1) * kstep, k2 = last ? (size_t)0 : (size_t)(t + 2) * kstep, k3 = k2 + kstep;
            if (last && has_next) S.a_ready(nxt);
            if constexpr (SP2) {
            PG8_LDB(B0, 0, 0); PG8_LDB(B1, 0, 1); PG8_SCHED; PG8_LDA(At, 0, 0); PG8_STAGE_A(PG8_SA(1, 1), 1, a1, k1);
            if constexpr (Sched::GATHER) { if (last) {
#pragma unroll
                for (int h = 0; h < 2; ++h)
#pragma unroll
                    for (int i = 0; i < 2; ++i) aoC[h][i] = aoN[h][i]; } }
            PG8_WAIT_V(8); PG8_WAIT_L(0); PG8_BAR; PG8_MMA(0, 0, At, B0); PG8_MMA(0, 1, At, B1); PG8_BAR; PG8_SCHED;
            PG8_LDA(At, 0, 1); PG8_STAGE(PG8_SB(0, 0), b2, voffB); PG8_STAGE(PG8_SB(0, 1), b2 + hstep, voffB); PG8_STAGE_A(PG8_SA(0, 0), 0, a2, k2);
            PG8_WAIT_V(8); PG8_WAIT_L(0); PG8_BAR; PG8_MMA(1, 0, At, B0); PG8_MMA(1, 1, At, B1); PG8_BAR; PG8_SCHED;
            PG8_LDB(B0, 1, 0); PG8_LDB(B1, 1, 1); PG8_SCHED; PG8_LDA(At, 1, 0); PG8_STAGE_A(PG8_SA(0, 1), 1, a2, k2);
            PG8_WAIT_V(8); PG8_WAIT_L(0); PG8_BAR; PG8_MMA(0, 0, At, B0); PG8_MMA(0, 1, At, B1); PG8_BAR; PG8_SCHED;
            PG8_LDA(At, 1, 1); PG8_STAGE(PG8_SB(1, 0), b3, voffB); PG8_STAGE(PG8_SB(1, 1), b3 + hstep, voffB); PG8_STAGE_A(PG8_SA(1, 0), 0, a3, k3);
            PG8_WAIT_V(8); PG8_WAIT_L(0); PG8_BAR; PG8_MMA(1, 0, At, B0); PG8_MMA(1, 1, At, B1); PG8_BAR; PG8_SCHED;
            } else {
            PG8_LDB(B0, 0, 0); PG8_SCHED; PG8_LDA(At, 0, 0); PG8_STAGE_A(PG8_SA(1, 1), 1, a1, k1);
            if constexpr (Sched::GATHER) { if (last) {
#pragma unroll
                for (int h = 0; h < 2; ++h)
#pragma unroll
                    for (int i = 0; i < 2; ++i) aoC[h][i] = aoN[h][i]; } }
            PG8_WAIT_L(8); PG8_BAR; PG8_WAIT_L(0); PG8_MMA(0, 0, At, B0); PG8_BAR; PG8_SCHED;
            PG8_LDB(B1, 0, 1); PG8_STAGE(PG8_SB(0, 0), b2, voffB);
            PG8_BAR; PG8_WAIT_L(0); PG8_MMA(0, 1, At, B1); PG8_BAR;
            PG8_LDA(At, 0, 1); PG8_STAGE_A(PG8_SA(0, 0), 0, a2, k2);
            PG8_BAR; PG8_WAIT_L(0); PG8_MMA(1, 0, At, B0); PG8_BAR; PG8_SCHED;
            PG8_STAGE(PG8_SB(0, 1), b2 + hstep, voffB);
            PG8_WAIT_V(6); PG8_BAR; PG8_MMA(1, 1, At, B1); PG8_BAR;
            PG8_LDB(B0, 1, 0); PG8_SCHED; PG8_LDA(At, 1, 0); PG8_STAGE_A(PG8_SA(0, 1), 1, a2, k2);
            PG8_WAIT_L(8); PG8_BAR; PG8_WAIT_L(0); PG8_MMA(0, 0, At, B0); PG8_BAR; PG8_SCHED;
            PG8_LDB(B1, 1, 1); PG8_STAGE(PG8_SB(1, 0), b3, voffB);
            PG8_BAR; PG8_WAIT_L(0); PG8_MMA(0, 1, At, B1); PG8_BAR;
            PG8_LDA(At, 1, 1); PG8_STAGE_A(PG8_SA(1, 0), 0, a3, k3);
            PG8_BAR; PG8_WAIT_L(0); PG8_MMA(1, 0, At, B0); PG8_BAR; PG8_SCHED;
            PG8_STAGE(PG8_SB(1, 1), b3 + hstep, voffB);
            PG8_WAIT_V(6); PG8_BAR; PG8_MMA(1, 1, At, B1); PG8_BAR;
            }
        }
        if constexpr (ALIGN_EPI) { if (wr == 0) PG8_BAR; }
        E(acc, cur, wr, wc, fr, fq); S.done(cur);
        if (!has_next) break;
#pragma unroll
        for (int a = 0; a < 2; ++a)
#pragma unroll
            for (int b = 0; b < 2; ++b)
#pragma unroll
                for (int m = 0; m < 4; ++m)
#pragma unroll
                    for (int n = 0; n < 2; ++n) acc[a][b][m][n] = (f32x4){0.f, 0.f, 0.f, 0.f};
        cur = nxt; cA = nA; cB = nB; ++ui;
        if constexpr (ALIGN_EPI) { if (wr == 1) PG8_BAR; }
    }
    PG8_WAIT_V(0);
    if constexpr (!ALIGN_EPI) { if (wr == 0) PG8_BAR; }
    PG8_BAR;
#undef PG8_SA
#undef PG8_SB
#undef PG8_STAGE
#undef PG8_STAGE_A
#undef PG8_LDA
#undef PG8_LDB
#undef PG8_MMA
#undef PG8_WAIT_V
#undef PG8_WAIT_L
#undef PG8_BAR
#undef PG8_SCHED
}
}

#ifndef MK_N_LAUNCHES
#define MK_N_LAUNCHES 1
#endif
constexpr int NWAVES = 8, NTHR = 512;
constexpr int S_ = 16384, D_ = 2048, DEPTH = 2, HD = 128;
constexpr int IN_W = 5656, NIN = 5888;
constexpr int NC = 1023;
constexpr int NEXP = 32, DEXP = 512, ECAP = 16384, NSLOT = 40960;
constexpr float RMS_EPS = 1e-6f;
constexpr float ATT_SCALE = 0.08838834764831845f;
constexpr int NPL = 15, NPH = 2 + 2 * NPL;

constexpr size_t MiB = 1u << 20;
constexpr size_t WS_CTL = 0, CTL_ZERO_BYTES = 1 * MiB;
constexpr size_t WS_ROPE = 1 * MiB, WS_WINT = 9 * MiB, WS_WOUTT = 55 * MiB, WS_WGUT = 71 * MiB, WS_WDT = 327 * MiB, WS_WC1T = 455 * MiB;
constexpr size_t WS_H = 463 * MiB, WS_QN = 527 * MiB, WS_QM = 559 * MiB, WS_KM = 591 * MiB, WS_VM = 623 * MiB;
constexpr size_t WS_KC = 655 * MiB, WS_VC = 663 * MiB, WS_KS = 671 * MiB, WS_VS = 679 * MiB, WS_KW = 687 * MiB, WS_VW = 695 * MiB;
constexpr size_t WS_GATES = 703 * MiB, WS_UL = 705 * MiB, WS_KCMP = 713 * MiB, WS_VCMP = 713 * MiB + 512 * 1024, WS_KMEAN = 714 * MiB;
constexpr size_t WS_OMIX = 715 * MiB, WS_OCMP = 779 * MiB, WS_OWIN = 811 * MiB, WS_SEL = 843 * MiB, WS_TE = 845 * MiB, WS_TOKIDX = 846 * MiB, WS_WTS = 848 * MiB;
constexpr size_t WS_HACT = 850 * MiB, WS_Y = 890 * MiB;
constexpr size_t WS_WRT = 714 * MiB + 256 * 1024;
constexpr size_t WS_IMP = WS_H + 32 * MiB;
constexpr size_t WS_NLIST = WS_H, WS_PSLC = 850 * MiB, WS_LSEN = 1106 * MiB;
constexpr size_t WS_MLIST = 1050 * MiB, WS_PSEL = 1082 * MiB, WS_POWN = 1178 * MiB, WS_LSES = 1210 * MiB, WS_LSEO = 1211 * MiB + 512 * 1024, WS_END = 1212 * MiB;
constexpr int CW_TMO = 0, CW_BAR = 4096, CW_CNT = 8192, CW_MCNT = 8704, CW_NCNT = 9728, CW_MOD = 16384, CW_B1E = 40960;

constexpr int RING_BYTES = 131072, LDSCTL_OFF = RING_BYTES, MISC_OFF = LDSCTL_OFF + 320, MOETAB_OFF = LDSCTL_OFF + 512, LDS_BYTES = 147456;

#define GAS __attribute__((address_space(1)))
#define LAS __attribute__((address_space(3)))
typedef unsigned short bf16;
typedef unsigned v4u __attribute__((ext_vector_type(4)));
typedef float f32x4 __attribute__((ext_vector_type(4)));
typedef float f32x2 __attribute__((ext_vector_type(2)));
typedef GAS unsigned gu32;
#define RLX_AGENT __ATOMIC_RELAXED, __HIP_MEMORY_SCOPE_AGENT
#define LDS_WAIT() asm volatile("s_waitcnt lgkmcnt(0)" ::: "memory")
__device__ __forceinline__ unsigned f2bf(float f) { unsigned u = __builtin_bit_cast(unsigned, f); return (u + 0x7fffu + ((u >> 16) & 1u)) >> 16; }
__device__ __forceinline__ unsigned pk2(float lo, float hi) { return f2bf(lo) | (f2bf(hi) << 16); }
__device__ __forceinline__ float bf2f(unsigned b) { return __builtin_bit_cast(float, b << 16); }
__device__ __forceinline__ float bflo(unsigned w) { return __builtin_bit_cast(float, w << 16); }
__device__ __forceinline__ float bfhi(unsigned w) { return __builtin_bit_cast(float, w & 0xffff0000u); }

#define XB_TMO      128
#define XB_XCNT(j)  (256  + 64 * (j))
#define XB_XSUB(j)  (1280 + 64 * (j))
#define XB_XGEN(j)  (2304 + 64 * (j))
#define XB_TOP      3328
#define XB_TOPGEN   3392
#define XCD_BAR_WORDS 3456
#define XB_SPIN_CAP (1u << 23)
__device__ __forceinline__ unsigned xb_ld(unsigned* p)              { return __hip_atomic_load(p, __ATOMIC_RELAXED, __HIP_MEMORY_SCOPE_AGENT); }
__device__ __forceinline__ unsigned xb_add(unsigned* p, unsigned v) { return __hip_atomic_fetch_add(p, v, __ATOMIC_RELAXED, __HIP_MEMORY_SCOPE_AGENT); }
__device__ __forceinline__ unsigned xb_xcc_id() { return (unsigned)__builtin_amdgcn_s_getreg((3 << 11) | 20) & 0xFu; }
#define XB_SPIN(cond, bar) do { unsigned _sp = 0; while (cond) { __builtin_amdgcn_s_sleep(1); \
    if ((++_sp & 255u) == 0u) { if (xb_ld(&(bar)[XB_TMO])) break; if (_sp > XB_SPIN_CAP) { atomicAdd(&(bar)[XB_TMO], 1u); break; } } } } while (0)
struct XcdBarrier { unsigned* bar; unsigned x; volatile LAS unsigned* st; };
__device__ __forceinline__ XcdBarrier xcd_barrier_post(unsigned* bar, volatile LAS unsigned* st) {
    XcdBarrier b; b.bar = bar; b.x = xb_xcc_id(); b.st = st;
    if (threadIdx.x == 0) (void)xb_add(&bar[XB_XCNT(b.x)], 1u);
    return b;
}
__device__ __forceinline__ void xcd_barrier_complete(unsigned* bar, unsigned x, unsigned& nloc, unsigned& nx) {
    const unsigned G = gridDim.x * gridDim.y * gridDim.z;
    unsigned sum, cnt, mine, sp = 0u;
    for (;;) {
        sum = 0u; cnt = 0u; mine = 0u;
#pragma unroll
        for (unsigned j = 0; j < 16; ++j) { const unsigned c = xb_ld(&bar[XB_XCNT(j)]); sum += c; cnt += (c > 0u) ? 1u : 0u; mine = (j == x) ? c : mine; }
        if (sum == G) break;
        __builtin_amdgcn_s_sleep(1);
        if ((++sp & 255u) == 0u) { if (xb_ld(&bar[XB_TMO])) break; if (sp > XB_SPIN_CAP) { atomicAdd(&bar[XB_TMO], 1u); break; } }
    }
    nloc = mine > 0u ? mine : 1u; nx = cnt > 0u ? cnt : 1u;
}
__device__ __forceinline__ void xcd_barrier(const XcdBarrier& b) {
    asm volatile("s_waitcnt vmcnt(0)" ::: "memory");
    __syncthreads();
    if (threadIdx.x == 0) {
        unsigned* bar = b.bar;
        __builtin_amdgcn_s_waitcnt(0);
        unsigned nloc = b.st[0], nx = b.st[1];
        if (nloc == 0u) { xcd_barrier_complete(bar, b.x, nloc, nx); b.st[0] = nloc; b.st[1] = nx; }
        const unsigned old = xb_add(&bar[XB_XSUB(b.x)], 1u);
        const unsigned gen = old / nloc;
        if (old + 1u == (gen + 1u) * nloc) {
            __builtin_amdgcn_fence(__ATOMIC_RELEASE, "agent");
            asm volatile("s_waitcnt vmcnt(0)" ::: "memory");
            const unsigned og = xb_add(&bar[XB_TOP], 1u);
            const unsigned tg = og / nx;
            if (og + 1u == (tg + 1u) * nx) xb_add(&bar[XB_TOPGEN], 1u);
            else XB_SPIN(xb_ld(&bar[XB_TOPGEN]) == tg, bar);
            __builtin_amdgcn_fence(__ATOMIC_ACQUIRE, "agent");
            xb_add(&bar[XB_XGEN(b.x)], 1u);
            asm volatile("s_waitcnt vmcnt(0)" ::: "memory");
        } else {
            XB_SPIN(xb_ld(&bar[XB_XGEN(b.x)]) == gen, bar);
            __builtin_amdgcn_fence(__ATOMIC_ACQUIRE, "agent");
            asm volatile("s_waitcnt vmcnt(0)" ::: "memory");
        }
    }
    __syncthreads();
}

__device__ __forceinline__ float wave_sum(float v) {
#pragma unroll
    for (int o = 1; o < 64; o <<= 1) v += __shfl_xor(v, o);
    return v;
}
__device__ __forceinline__ float wave_max(float v) {
#pragma unroll
    for (int o = 1; o < 64; o <<= 1) v = fmaxf(v, __shfl_xor(v, o));
    return v;
}

__device__ __forceinline__ int il(int d) { return (d < 64) ? 2 * d : 2 * (d - 64) + 1; }
__device__ __forceinline__ int inproj_row(int s) {
    if (s < 1024) return (s & ~127) + il(s & 127);
    if (s < 1536) return s;
    if (s < 1792) return (s & ~127) + il(s & 127);
    if (s < 2048) return s;
    if (s < 2304) return (s & ~127) + il(s & 127);
    if (s < 2560) return s;
    if (s < 2584) return 5632 + (s - 2560);
    if (s < 3608) { const int r = s - 2584; return 2560 + (r & ~127) + il(r & 127); }
    if (s < 4632) { const int r = s - 3608; return 3584 + (r & ~127) + il(r & 127); }
    return 4608 + (s - 4632);
}
template <int MODE>
__device__ __forceinline__ void transpose_item(const float* W, int K, int N, bf16* WT, int dpitch, int row_off, LAS float* scr, int item, int lane) {
    const int nblk = (N + 31) / 32, kb = item / nblk, nb = item % nblk, k0 = 64 * kb, n0 = 32 * nb;
    const int nsrc = n0 + (lane & 31);
#pragma unroll 8
    for (int i = 0; i < 32; ++i) { const int kk = 2 * i + (lane >> 5); scr[kk * 33 + (lane & 31)] = (nsrc < N) ? W[(size_t)(k0 + kk) * N + nsrc] : 0.f; }
    LDS_WAIT(); asm volatile("" ::: "memory");
    const int c = lane & 7;
#pragma unroll
    for (int j = 0; j < 4; ++j) { const int nl = (lane >> 3) + 8 * j, n = n0 + nl; const LAS float* s = scr + (8 * c) * 33 + nl;
        v4u o; o.x = pk2(s[0 * 33], s[1 * 33]); o.y = pk2(s[2 * 33], s[3 * 33]); o.z = pk2(s[4 * 33], s[5 * 33]); o.w = pk2(s[6 * 33], s[7 * 33]);
        if (n < N) { int dr;
            if (MODE == 0) dr = n; else if (MODE == 1) dr = inproj_row(n); else if (MODE == 2) dr = (n >> 7) * 256 + (n & 127); else dr = (n >> 7) * 256 + 128 + (n & 127);
            *(GAS v4u*)(WT + (size_t)(row_off + dr) * dpitch + k0 + 8 * c) = o; } }
    LDS_WAIT(); asm volatile("" ::: "memory");
}

using pg8::Unit;
struct EpiInProj {
    static constexpr bool PERM = true;
    bf16 *QN, *KC, *VC, *KS, *VS, *KW, *VW, *QM, *KM, *VM; float* GATES; const float* rope;
    __device__ __forceinline__ void operator()(const f32x4 (&acc)[2][2][4][2], const Unit& u, int wr, int wc, int fr, int fq) const {
        const int pn = u.pn, row0 = u.pm * 256 + wr * 64 + fr, c8 = wc * 32 + 8 * fq;
        if (pn == 22) {
            if (c8 < 24) {
#pragma unroll
                for (int ai = 0; ai < 2; ++ai)
#pragma unroll
                    for (int m = 0; m < 4; ++m) { const int row = row0 + ai * 128 + m * 16; float* gp = GATES + (size_t)row * 32 + c8;
                        f32x4 a = acc[ai][0][m][0], b = acc[ai][0][m][1], ga, gb;
#pragma unroll
                        for (int j = 0; j < 4; ++j) { ga[j] = 1.f / (1.f + __expf(-a[j])); gb[j] = 1.f / (1.f + __expf(-b[j])); }
                        *(f32x4*)gp = ga; *(f32x4*)(gp + 4) = gb; }
            }
            return;
        }
        bf16* base; int pitch; size_t bjs; bool rot;
        if (pn < 4)       { base = QN + pn * 256;        pitch = 1024; bjs = 128; rot = true; }
        else if (pn == 4) { base = KC;                   pitch = 128;  bjs = (size_t)S_ * 128; rot = false; }
        else if (pn == 5) { base = VC;                   pitch = 128;  bjs = (size_t)S_ * 128; rot = false; }
        else if (pn == 6) { base = KS;                   pitch = 256;  bjs = 128; rot = true; }
        else if (pn == 7) { base = VS;                   pitch = 256;  bjs = 128; rot = false; }
        else if (pn == 8) { base = KW;                   pitch = 256;  bjs = 128; rot = true; }
        else if (pn == 9) { base = VW;                   pitch = 256;  bjs = 128; rot = false; }
        else if (pn < 14) { base = QM + (pn - 10) * 256; pitch = 1024; bjs = 128; rot = true; }
        else if (pn < 18) { base = KM + (pn - 14) * 256; pitch = 1024; bjs = 128; rot = true; }
        else              { base = VM + (pn - 18) * 256; pitch = 1024; bjs = 128; rot = false; }
#pragma unroll
        for (int ai = 0; ai < 2; ++ai)
#pragma unroll
            for (int m = 0; m < 4; ++m) { const int row = row0 + ai * 128 + m * 16;
                f32x4 t0 = (f32x4){1.f, 0.f, 1.f, 0.f}, t1 = t0;
                if (rot) { const f32x4* tp = (const f32x4*)(rope + (size_t)row * 128 + (c8 >> 1) * 2); t0 = tp[0]; t1 = tp[1]; }
#pragma unroll
                for (int bj = 0; bj < 2; ++bj) { f32x4 v0 = acc[ai][bj][m][0], v1 = acc[ai][bj][m][1];
                    if (rot) { f32x4 w0, w1;
                        w0[0] = v0[0] * t0[0] - v0[1] * t0[1]; w0[1] = v0[1] * t0[0] + v0[0] * t0[1]; w0[2] = v0[2] * t0[2] - v0[3] * t0[3]; w0[3] = v0[3] * t0[2] + v0[2] * t0[3];
                        w1[0] = v1[0] * t1[0] - v1[1] * t1[1]; w1[1] = v1[1] * t1[0] + v1[0] * t1[1]; w1[2] = v1[2] * t1[2] - v1[3] * t1[3]; w1[3] = v1[3] * t1[2] + v1[2] * t1[3];
                        v0 = w0; v1 = w1; }
                    pg8::u32x4 w; w.x = pg8::cvt_pk_bf16(v0[0], v0[1]); w.y = pg8::cvt_pk_bf16(v0[2], v0[3]); w.z = pg8::cvt_pk_bf16(v1[0], v1[1]); w.w = pg8::cvt_pk_bf16(v1[2], v1[3]);
                    *(pg8::u32x4*)(base + (size_t)row * pitch + bj * bjs + c8) = w; } }
    }
};
struct EpiOutProj {
    static constexpr bool PERM = false;
    const float* xsrc; float* X; const float* gt;
    __device__ __forceinline__ void operator()(const f32x4 (&acc)[2][2][4][2], const Unit& u, int wr, int wc, int fr, int fq) const {
        const int row0 = u.pm * 256 + wr * 64 + fr, col0 = u.pnl * 256 + wc * 32 + 4 * fq;
        f32x4 gv[2][2];
#pragma unroll
        for (int bj = 0; bj < 2; ++bj)
#pragma unroll
            for (int n = 0; n < 2; ++n) gv[bj][n] = *(const f32x4*)(gt + col0 + bj * 128 + n * 16);
#pragma unroll
        for (int ai = 0; ai < 2; ++ai)
#pragma unroll
            for (int m = 0; m < 4; ++m) { const size_t ro = (size_t)(row0 + ai * 128 + m * 16) * D_ + col0;
#pragma unroll
                for (int bj = 0; bj < 2; ++bj)
#pragma unroll
                    for (int n = 0; n < 2; ++n) { const f32x4 xv = *(const f32x4*)(xsrc + ro + bj * 128 + n * 16); *(f32x4*)(X + ro + bj * 128 + n * 16) = xv + gv[bj][n] * acc[ai][bj][m][n]; } }
    }
};
struct EpiF32 {
    static constexpr bool PERM = false;
    float* C; int ldc;
    __device__ __forceinline__ void operator()(const f32x4 (&acc)[2][2][4][2], const Unit& u, int wr, int wc, int fr, int fq) const {
        const int row0 = u.pm * 256 + wr * 64 + fr, col0 = u.pnl * 256 + wc * 32 + 4 * fq;
#pragma unroll
        for (int ai = 0; ai < 2; ++ai)
#pragma unroll
            for (int m = 0; m < 4; ++m) { float* rowp = C + (size_t)(row0 + ai * 128 + m * 16) * ldc + col0;
#pragma unroll
                for (int bj = 0; bj < 2; ++bj)
#pragma unroll
                    for (int n = 0; n < 2; ++n) *(f32x4*)(rowp + bj * 128 + n * 16) = acc[ai][bj][m][n]; }
    }
};
struct EpiGateUp {
    static constexpr bool PERM = true;
    bf16* HACT;
    __device__ __forceinline__ void operator()(const f32x4 (&acc)[2][2][4][2], const Unit& u, int wr, int wc, int fr, int fq) const {
        const int row0 = u.pm * 256 + wr * 64 + fr, col0 = u.pnl * 128 + wc * 32 + 8 * fq;
#pragma unroll
        for (int ai = 0; ai < 2; ++ai)
#pragma unroll
            for (int m = 0; m < 4; ++m) { const int row = row0 + ai * 128 + m * 16; f32x4 h[2];
#pragma unroll
                for (int n = 0; n < 2; ++n)
#pragma unroll
                    for (int j = 0; j < 4; ++j) { const float gg = acc[ai][0][m][n][j], uu = acc[ai][1][m][n][j]; h[n][j] = gg / (1.f + __expf(-gg)) * uu; }
                pg8::u32x4 w; w.x = pg8::cvt_pk_bf16(h[0][0], h[0][1]); w.y = pg8::cvt_pk_bf16(h[0][2], h[0][3]); w.z = pg8::cvt_pk_bf16(h[1][0], h[1][1]); w.w = pg8::cvt_pk_bf16(h[1][2], h[1][3]);
                *(pg8::u32x4*)(HACT + (size_t)row * DEXP + col0) = w; }
    }
};
struct EpiDown {
    static constexpr bool PERM = true;
    bf16* Y; const float* WTS; const LAS int* tab;
    __device__ __forceinline__ void operator()(const f32x4 (&acc)[2][2][4][2], const Unit& u, int wr, int wc, int fr, int fq) const {
        const int rl0 = wr * 64 + fr, col0 = u.pnl * 256 + wc * 32 + 8 * fq, cnt = tab[u.e];
#pragma unroll
        for (int ai = 0; ai < 2; ++ai)
#pragma unroll
            for (int m = 0; m < 4; ++m) { const int rl = rl0 + ai * 128 + m * 16, pos = u.mt * 256 + rl;
                const float w = (pos < cnt) ? WTS[(size_t)u.e * ECAP + pos] : 0.f;
                bf16* rowp = Y + (size_t)(u.pm * 256 + rl) * D_ + col0;
#pragma unroll
                for (int bj = 0; bj < 2; ++bj) { const f32x4 v0 = acc[ai][bj][m][0] * w, v1 = acc[ai][bj][m][1] * w;
                    pg8::u32x4 o; o.x = pg8::cvt_pk_bf16(v0[0], v0[1]); o.y = pg8::cvt_pk_bf16(v0[2], v0[3]); o.z = pg8::cvt_pk_bf16(v1[0], v1[1]); o.w = pg8::cvt_pk_bf16(v1[2], v1[3]);
                    *(pg8::u32x4*)(rowp + bj * 128) = o; } }
    }
};

struct CompressOrder {
    static constexpr bool GATHER = false;
    int G, c;
    __device__ bool next(int i, Unit& u) const { const int L = i * G + c; if (L >= 32) return false; u.pm = L >> 1; u.pnl = L & 1; u.pn = (u.pm >= 8 ? 2 : 0) + u.pnl; u.e = 0; u.mt = 0; return true; }
    __device__ __forceinline__ void a_offs(const Unit&, int, int, int, int, int, unsigned (&)[2][2]) const {}
    __device__ __forceinline__ void a_ready(const Unit&) const {}
    __device__ __forceinline__ void done(const Unit&) const {}
};
template <bool GATHER_>
struct MoeOrder {
    static constexpr bool GATHER = GATHER_;
    const LAS int* tab; int NT, G, c, bt_per_e, bt_base; const int* tokidx;
    __device__ bool next(int i, Unit& u) const {
        const int L = i * G + c; if (L >= tab[64]) return false;
        int e = 0;
        for (int k = 1; k < NEXP; ++k) e += (L >= tab[32 + k]) ? 1 : 0;
        e = __builtin_amdgcn_readfirstlane(e);
        const int r = L - tab[32 + e];
        u.e = e; u.mt = r / NT; u.pnl = r % NT; u.pn = bt_base + e * bt_per_e + u.pnl; u.pm = (tab[65 + e] >> 8) + u.mt; return true;
    }
    __device__ __forceinline__ void a_offs(const Unit& u, int R0, int R1, int C0, int C1, int K, unsigned (&o)[2][2]) const {
        const int cnt = tab[u.e]; const int* tk = tokidx + (size_t)u.e * ECAP;
#pragma unroll
        for (int h = 0; h < 2; ++h) {
            int p0 = u.mt * 256 + h * 128 + R0, p1 = u.mt * 256 + h * 128 + R1; p0 = p0 < cnt ? p0 : cnt - 1; p1 = p1 < cnt ? p1 : cnt - 1;
            o[h][0] = ((unsigned)tk[p0] * (unsigned)K + (unsigned)C0) * 2u; o[h][1] = ((unsigned)tk[p1] * (unsigned)K + (unsigned)C1) * 2u; }
    }
    __device__ __forceinline__ void a_ready(const Unit&) const {}
    __device__ __forceinline__ void done(const Unit&) const {}
};

constexpr int SM_Q = 0, SM_P = 512, SM_KP = 4608, SM_RED = 5632, SM_PART = 5696, SM_MISC = 6208;
template <int NH, class KeyFn>
__device__ __forceinline__ float naive_attend(LAS float* sm, int tid, int nkeys, const KeyFn keyfn, const bf16* Kb, int kpitch, const bf16* Vb, int vpitch) {
    LAS int* kp = (LAS int*)(sm + SM_KP);
    const int lane = tid & 63, wave = tid >> 6;
    float sc[NH][2];
#pragma unroll
    for (int i = 0; i < 2; ++i) {
        const int kk = tid + 512 * i; const int kpos = (kk < nkeys) ? keyfn(kk) : -1; kp[kk] = kpos;
        float a[NH];
#pragma unroll
        for (int h = 0; h < NH; ++h) a[h] = 0.f;
        if (kpos >= 0) { const v4u* kr = (const v4u*)(Kb + (size_t)kpos * kpitch);
#pragma unroll 4
            for (int c = 0; c < 16; ++c) { const v4u kv = kr[c];
                const float k0 = bflo(kv.x), k1 = bfhi(kv.x), k2 = bflo(kv.y), k3 = bfhi(kv.y), k4 = bflo(kv.z), k5 = bfhi(kv.z), k6 = bflo(kv.w), k7 = bfhi(kv.w);
#pragma unroll
                for (int h = 0; h < NH; ++h) { const f32x4 qa = *(const LAS f32x4*)(sm + SM_Q + h * 128 + 8 * c), qb = *(const LAS f32x4*)(sm + SM_Q + h * 128 + 8 * c + 4);
                    a[h] += qa[0] * k0 + qa[1] * k1 + qa[2] * k2 + qa[3] * k3 + qb[0] * k4 + qb[1] * k5 + qb[2] * k6 + qb[3] * k7; } } }
#pragma unroll
        for (int h = 0; h < NH; ++h) sc[h][i] = (kpos >= 0) ? a[h] * ATT_SCALE : -INFINITY;
    }
#pragma unroll
    for (int h = 0; h < NH; ++h) { const float m = wave_max(fmaxf(sc[h][0], sc[h][1])); if (lane == 0) sm[SM_RED + wave * NH + h] = m; }
    __syncthreads();
    float mx[NH];
#pragma unroll
    for (int h = 0; h < NH; ++h) { float m = sm[SM_RED + h];
#pragma unroll
        for (int w = 1; w < 8; ++w) m = fmaxf(m, sm[SM_RED + w * NH + h]); mx[h] = m; }
    __syncthreads();
#pragma unroll
    for (int h = 0; h < NH; ++h) {
#pragma unroll
        for (int i = 0; i < 2; ++i) sc[h][i] = (sc[h][i] == -INFINITY) ? 0.f : __expf(sc[h][i] - mx[h]);
        const float s = wave_sum(sc[h][0] + sc[h][1]); if (lane == 0) sm[SM_RED + wave * NH + h] = s; }
    __syncthreads();
#pragma unroll
    for (int h = 0; h < NH; ++h) { float s = 0.f;
#pragma unroll
        for (int w = 0; w < 8; ++w) s += sm[SM_RED + w * NH + h];
        const float inv = s > 0.f ? 1.f / s : 0.f;
#pragma unroll
        for (int i = 0; i < 2; ++i) sm[SM_P + h * 1024 + tid + 512 * i] = sc[h][i] * inv; }
    __syncthreads();
    const int d = tid & 127, hs = tid >> 7;
    float o = 0.f;
    {
        const int hrow = (NH == 4) ? hs * 1024 : 0;
        const int k0 = (NH == 4) ? 0 : hs * 256, k1 = (NH == 4) ? nkeys : ((k0 + 256 < nkeys) ? k0 + 256 : nkeys);
        for (int kb = k0; kb < k1; kb += 8) {
            int kq[8]; float pq[8], vq[8];
#pragma unroll
            for (int j = 0; j < 8; ++j) { const int kpos = kp[kb + j]; pq[j] = (kpos >= 0 && kb + j < k1) ? sm[SM_P + hrow + kb + j] : 0.f; kq[j] = kpos >= 0 ? kpos : 0; }
#pragma unroll
            for (int j = 0; j < 8; ++j) vq[j] = bf2f(Vb[(size_t)kq[j] * vpitch + d]);
#pragma unroll
            for (int j = 0; j < 8; ++j) o += pq[j] * vq[j];
        }
    }
    if (NH == 1) {
        sm[SM_PART + tid] = o; __syncthreads();
        if (tid < 128) o = sm[SM_PART + tid] + sm[SM_PART + 128 + tid] + sm[SM_PART + 256 + tid] + sm[SM_PART + 384 + tid];
    }
    return o;
}

namespace att {
constexpr int D = 128, NW = 8, QBLK = 32, KVBLK = 64, QB = NW * QBLK;
constexpr int SHM_V = KVBLK * D * 2, SHM_K = KVBLK * D * 2;
constexpr int OFF_WS = 2 * SHM_V + 2 * SHM_K, OFF_OT = OFF_WS + NW * 64 * 4, LDS_BYTES = OFF_OT + NW * 32 * 4;
constexpr float SCALE = 0.08838834764831845f, THR = 8.f;
typedef short bf16x8 __attribute__((ext_vector_type(8)));
typedef short s16x4 __attribute__((ext_vector_type(4)));
typedef float f32x16 __attribute__((ext_vector_type(16)));
typedef float f32x4 __attribute__((ext_vector_type(4)));
typedef unsigned u32x4 __attribute__((ext_vector_type(4)));
typedef unsigned short bf16;
#define KSWZ(row, colB) ((row) * 256 + ((colB) ^ (((row) & 7) << 4)))
#define SBAR() __builtin_amdgcn_sched_barrier(0)
__device__ __forceinline__ int v_st(int k, int c) { const int kk = (k & ~0xC) | ((k & 4) << 1) | ((k & 8) >> 1); return ((kk >> 3) * 4 + (c >> 5)) * 512 + ((kk & 7) * 32 + (c & 31)) * 2; }
__device__ __forceinline__ int v_rd_base(int lane) { return ((lane & 3) << 3) | (((lane >> 2) & 3) << 6) | (((lane >> 4) & 1) << 5) | (((lane >> 5) & 1) << 8); }
constexpr int v_rd_off(int d0, int ks, int half) { return d0 * 512 + ks * 4096 + half * 2048; }
__device__ __forceinline__ int crow(int r, int hi) { return (r & 3) + 8 * (r >> 2) + 4 * hi; }
__device__ __forceinline__ unsigned cvtpk(float lo, float hi) { unsigned r; asm volatile("v_cvt_pk_bf16_f32 %0, %1, %2" : "=v"(r) : "v"(lo), "v"(hi)); return r; }
__device__ __forceinline__ bf16x8 load8(const bf16* p) { return *reinterpret_cast<const bf16x8*>(p); }
__device__ __forceinline__ void mask_tile(f32x16& p0, f32x16& p1, int dq, unsigned W) {
    const float NEG = -__builtin_inff();
#pragma unroll
    for (int r = 0; r < 16; ++r) {
        const int c = (r & 3) + 8 * (r >> 2);
        if ((unsigned)(dq - c) >= W) p0[r] = NEG;
        if ((unsigned)(dq - c - 32) >= W) p1[r] = NEG;
    }
}
__device__ __forceinline__ void partialSM(f32x16& p0, f32x16& p1, float& m_reg, float& mn, float& alpha) {
    float pmax = p0[0]; for (int r = 1; r < 16; ++r) pmax = fmaxf(pmax, p0[r]); for (int r = 0; r < 16; ++r) pmax = fmaxf(pmax, p1[r]);
    { auto rr = __builtin_amdgcn_permlane32_swap(__float_as_uint(pmax), __float_as_uint(pmax), false, false);
      pmax = fmaxf(__uint_as_float(rr[0]), __uint_as_float(rr[1])); }
    constexpr float C2 = 1.4426950408889634f * SCALE;
    if (__builtin_expect(__all((pmax - m_reg) * SCALE <= THR), 1)) { mn = m_reg; alpha = 1.f; }
    else { mn = fmaxf(m_reg, pmax); alpha = __builtin_amdgcn_exp2f((m_reg - mn) * C2); m_reg = mn; }
    const float mnL = -mn * C2;
    for (int r = 0; r < 16; ++r) p0[r] = fmaf(p0[r], C2, mnL); for (int r = 0; r < 16; ++r) p1[r] = fmaf(p1[r], C2, mnL);
    for (int r = 0; r < 16; ++r) p0[r] = __builtin_amdgcn_exp2f(p0[r]);
}
__device__ __forceinline__ void finishSM(f32x16& p0, f32x16& p1, float alpha, float& l_reg, bf16x8& pa0, bf16x8& pa1, bf16x8& pa2, bf16x8& pa3) {
    for (int r = 0; r < 16; ++r) p1[r] = __builtin_amdgcn_exp2f(p1[r]);
    float ps = 0; for (int r = 0; r < 16; ++r) ps += p0[r]; for (int r = 0; r < 16; ++r) ps += p1[r];
    { auto rr = __builtin_amdgcn_permlane32_swap(__float_as_uint(ps), __float_as_uint(ps), false, false);
      ps = __uint_as_float(rr[0]) + __uint_as_float(rr[1]); }
    l_reg = l_reg * alpha + ps;
#define PK4(P, B_, OUT) do { unsigned a0 = cvtpk(P[B_+0], P[B_+1]), a1 = cvtpk(P[B_+2], P[B_+3]);                          \
        unsigned b0 = cvtpk(P[B_+4], P[B_+5]), b1 = cvtpk(P[B_+6], P[B_+7]);                                             \
        auto r0 = __builtin_amdgcn_permlane32_swap(a0, b0, false, false); auto r1 = __builtin_amdgcn_permlane32_swap(a1, b1, false, false); \
        u32x4 w = {r0[0], r1[0], r0[1], r1[1]}; OUT = *reinterpret_cast<bf16x8*>(&w); } while (0)
    PK4(p0, 0, pa0); PK4(p0, 8, pa1); PK4(p1, 0, pa2); PK4(p1, 8, pa3);
#undef PK4
}
template <int KB, bool SK>
__device__ __forceinline__ void qkt(f32x16& p0, f32x16& p1, const char* K_lds, int r32, int hi, const bf16x8* qr, bool act) {
    if (SK && !act) { const float NEG = -__builtin_inff();
#pragma unroll
        for (int r = 0; r < 16; ++r) { p0[r] = NEG; p1[r] = NEG; } return; }
    p0 = f32x16{}; p1 = f32x16{};
    const char* kb[4];
#pragma unroll
    for (int dd = 0; dd < 4; ++dd) kb[dd] = K_lds + KB * SHM_K + KSWZ(r32, (dd * 16 + hi * 8) * 2);
#pragma unroll
    for (int d0 = 0; d0 < 8; ++d0) { const char* a = kb[d0 & 3] + (d0 >> 2) * 128;
        bf16x8 b0 = *reinterpret_cast<const bf16x8*>(a);
        bf16x8 b1 = *reinterpret_cast<const bf16x8*>(a + 32 * 256);
        p0 = __builtin_amdgcn_mfma_f32_32x32x16_bf16(b0, qr[d0], p0, 0, 0, 0);
        p1 = __builtin_amdgcn_mfma_f32_32x32x16_bf16(b1, qr[d0], p1, 0, 0, 0); }
}
template <int VB, bool SK>
__device__ __forceinline__ void pv_tile(f32x16* o, int vb0, bf16x8 pa0, bf16x8 pa1, bf16x8 pa2, bf16x8 pa3, bool act) {
    if (SK && !act) return;
#define TRRD(dst, off) asm volatile("ds_read_b64_tr_b16 %0, %1 offset:%2" : "=&v"(dst) : "v"(vb0), "i"(off) : "memory")
#define PV_D0(d0) do { s16x4 l0, l1, l2, l3, h0, h1, h2, h3; constexpr int b_ = VB * SHM_V + v_rd_off(d0, 0, 0); \
        TRRD(l0, b_); TRRD(h0, b_ + 2048); TRRD(l1, b_ + 4096); TRRD(h1, b_ + 6144); TRRD(l2, b_ + 8192); TRRD(h2, b_ + 10240); TRRD(l3, b_ + 12288); TRRD(h3, b_ + 14336); \
        asm volatile("s_waitcnt lgkmcnt(0)" ::: "memory"); SBAR();   \
        o[d0] = __builtin_amdgcn_mfma_f32_32x32x16_bf16(pa0, (bf16x8){l0[0], l0[1], l0[2], l0[3], h0[0], h0[1], h0[2], h0[3]}, o[d0], 0, 0, 0);   \
        o[d0] = __builtin_amdgcn_mfma_f32_32x32x16_bf16(pa1, (bf16x8){l1[0], l1[1], l1[2], l1[3], h1[0], h1[1], h1[2], h1[3]}, o[d0], 0, 0, 0);   \
        o[d0] = __builtin_amdgcn_mfma_f32_32x32x16_bf16(pa2, (bf16x8){l2[0], l2[1], l2[2], l2[3], h2[0], h2[1], h2[2], h2[3]}, o[d0], 0, 0, 0);   \
        o[d0] = __builtin_amdgcn_mfma_f32_32x32x16_bf16(pa3, (bf16x8){l3[0], l3[1], l3[2], l3[3], h3[0], h3[1], h3[2], h3[3]}, o[d0], 0, 0, 0); } while (0)
    PV_D0(0); PV_D0(1); PV_D0(2); PV_D0(3);
#undef PV_D0
#undef TRRD
}
struct Ref { const bf16* Q; const bf16* K; const bf16* V; bf16* O; const int* list; int kpitch, j_lo, j_hi, P0, W, a0, a1; };
struct Seam { bf16x8 qr[8]; bf16x8 st_v0, st_v1, st_k0, st_k1; };
#define ROW(p, kp, k0, rr) ((p) + (size_t)((k0) + (rr)) * (kp) + sc)
#define VMW() asm volatile("s_waitcnt vmcnt(0)" ::: "memory")
#define VMWN(n) asm volatile("s_waitcnt vmcnt(%0)" :: "i"(n) : "memory")
#define SLOAD_H(Kp, Vp, kp, k0) do { S.st_v0 = load8(ROW(Vp, kp, k0, sr)); S.st_v1 = load8(ROW(Vp, kp, k0, 32 + sr));              \
                         S.st_k0 = load8(ROW(Kp, kp, k0, sr)); S.st_k1 = load8(ROW(Kp, kp, k0, 32 + sr)); } while (0)
#define SWRITE_HK(bf) do { *(bf16x8*)(K_lds + (bf) * SHM_K + kws) = S.st_k0; *(bf16x8*)(K_lds + (bf) * SHM_K + kws + 32 * 256) = S.st_k1; } while (0)
#define SWRITE_HV(bf) do { *(bf16x8*)(V_lds + (bf) * SHM_V + vst0) = S.st_v0; *(bf16x8*)(V_lds + (bf) * SHM_V + vst1) = S.st_v1; } while (0)
#define SWRITE_H(bf) do { SWRITE_HV(bf); SWRITE_HK(bf); } while (0)
template <class RF>
__device__ __forceinline__ void prime(const Ref& cur, char* lds, Seam& S) {
    int tid_ = threadIdx.x; asm volatile("" : "+v"(tid_));
    const int tid = tid_, wid = __builtin_amdgcn_readfirstlane(tid >> 6), lane = tid & 63, r32 = lane & 31, hi = lane >> 5;
    const int sr = tid >> 4, sc = (tid & 15) * 8, kws = KSWZ(sr, sc * 2); char* K_lds = lds + 2 * SHM_V;
    const int kb0 = cur.j_lo * KVBLK;
    { const bf16* qrow = cur.Q + RF::q_off(cur, wid * QBLK + r32);
      for (int d0 = 0; d0 < 8; ++d0) S.qr[d0] = load8(qrow + d0 * 16 + hi * 8); }
    SLOAD_H(cur.K, cur.V, cur.kpitch, kb0); VMW(); SWRITE_HK(0);
    __syncthreads();
}
template <int MODE, bool WSKIP, class RF>
__device__ __forceinline__ void block(const Ref& cur, const Ref& nxt, float* LSE, char* lds, Seam& S, float* lse_lane = nullptr) {
    int tid_ = threadIdx.x; asm volatile("" : "+v"(tid_));
    const int tid = tid_, wid = __builtin_amdgcn_readfirstlane(tid >> 6), lane = tid & 63, r32 = lane & 31, hi = lane >> 5;
    const int j_lo = cur.j_lo, NT = cur.j_hi - cur.j_lo;
    const int kbn = nxt.j_lo * KVBLK;
    const int W = cur.W;
    const int qlo = cur.P0 + wid * QBLK;
    const int qm = (MODE == 2 ? RF::pos(cur, wid * QBLK + r32) : qlo + r32) - 4 * hi;
    const unsigned Wm = (MODE == 2) ? (unsigned)RF::Wl(cur, wid * QBLK + r32) : (unsigned)W;
    char* V_lds = lds; char* K_lds = lds + 2 * SHM_V;
    float* ws = (float*)(lds + OFF_WS) + wid * 64; float* li_l = ws, * al_l = ws + 32; int* ot_l = (int*)(lds + OFF_OT) + wid * 32;
    float m_reg = -1e30f, l_reg = 0; f32x16 o[4] = {};
    const int sr = tid >> 4, sc = (tid & 15) * 8, vst0 = v_st(sr, sc), vst1 = v_st(32 + sr, sc), kws = KSWZ(sr, sc * 2);
    const int vb0 = (int)(uintptr_t)V_lds + v_rd_base(lane);
    const bf16* Kh = cur.K; const bf16* Vh = cur.V; const int kp = cur.kpitch;
#define RESC(a) do { if (__any((a) < 1.f)) { if (hi == 0) al_l[r32] = (a); asm volatile("s_waitcnt lgkmcnt(0)" ::: "memory");              \
                     for (int d_ = 0; d_ < 4; ++d_) for (int r = 0; r < 16; ++r) o[d_][r] *= al_l[crow(r, hi)]; } } while (0)
#define KBASE(t) ((j_lo + (t)) * KVBLK)
#define ACT(t) (MODE != 0 || (KBASE(t) <= qlo + QBLK - 1 && KBASE(t) + KVBLK - 1 >= qlo - W + 1))
#define MASKT(P0_, P1_, t) do { const int kb_ = KBASE(t); if (MODE == 2) mask_tile(P0_, P1_, qm - kb_, Wm); \
        else if (MODE == 0) { if ((!SK || ACT(t)) && (kb_ + KVBLK - 1 > qlo || kb_ <= qlo + QBLK - 1 - W)) mask_tile(P0_, P1_, qm - kb_, Wm); } } while (0)
    constexpr int NQL = 8;
    constexpr bool SK = WSKIP && MODE == 0;
#define SEAM_K0() do { VMWN(NQL); SWRITE_HK(0); SBAR(); } while (0)
    f32x16 pA0, pA1, pB0, pB1; float mnA, mnB, alA, alB; bf16x8 pa0, pa1, pa2, pa3;
    SWRITE_HV(0); SBAR();
    if (NT > 1) { SLOAD_H(Kh, Vh, kp, KBASE(1)); }
    SBAR(); qkt<0, SK>(pA0, pA1, K_lds, r32, hi, S.qr, ACT(0));
    MASKT(pA0, pA1, 0); partialSM(pA0, pA1, m_reg, mnA, alA);
    if (NT > 1) { VMW(); SWRITE_H(1); }
    __syncthreads();
#define HALF_STEP(PX0, PX1, mnX, alX, PY0, PY1, alY, t, KB, VB, SB) do {                                                      \
        SBAR(); qkt<KB, SK>(PX0, PX1, K_lds, r32, hi, S.qr, ACT(t));                                             \
        finishSM(PY0, PY1, alY, l_reg, pa0, pa1, pa2, pa3); SBAR();                                                           \
        if ((t) + 1 < NT) { SLOAD_H(Kh, Vh, kp, KBASE((t) + 1)); SBAR(); }                                               \
        pv_tile<VB, SK>(o, vb0, pa0, pa1, pa2, pa3, ACT((t) - 1)); MASKT(PX0, PX1, (t)); partialSM(PX0, PX1, m_reg, mnX, alX);                                        \
        __syncthreads();                                                                                                      \
        if ((t) + 1 < NT) { VMW(); SWRITE_H(SB); }                                                                          \
        RESC(alX); __syncthreads(); } while (0)
    for (int t = 1; t + 1 < NT; t += 2) {
        HALF_STEP(pB0, pB1, mnB, alB, pA0, pA1, alA, t, 1, 0, 0);
        HALF_STEP(pA0, pA1, mnA, alA, pB0, pB1, alB, t + 1, 0, 1, 1);
    }
    const bool even = (NT & 1) == 0;
    if (even) { SBAR(); qkt<1, SK>(pB0, pB1, K_lds, r32, hi, S.qr, ACT(NT - 1)); SBAR(); }
    SLOAD_H(nxt.K, nxt.V, nxt.kpitch, kbn); SBAR();
    { const bf16* qrow = nxt.Q + RF::q_off(nxt, wid * QBLK + r32);
#pragma unroll
      for (int d0 = 0; d0 < 8; ++d0) S.qr[d0] = load8(qrow + d0 * 16 + hi * 8); }
    SBAR();
    finishSM(pA0, pA1, alA, l_reg, pa0, pa1, pa2, pa3); SBAR();
    pv_tile<0, SK>(o, vb0, pa0, pa1, pa2, pa3, ACT(even ? NT - 2 : NT - 1));
    if (even) { MASKT(pB0, pB1, NT - 1); partialSM(pB0, pB1, m_reg, mnB, alB); __syncthreads(); RESC(alB);
        finishSM(pB0, pB1, alB, l_reg, pa0, pa1, pa2, pa3); SBAR(); pv_tile<1, SK>(o, vb0, pa0, pa1, pa2, pa3, ACT(NT - 1)); }
    SBAR(); SEAM_K0();
    if (hi == 0) { li_l[r32] = l_reg; ot_l[r32] = RF::o_off(cur, wid * QBLK + r32); } asm volatile("s_waitcnt lgkmcnt(0)" ::: "memory");
    if (LSE != nullptr && hi == 0) { const int lq = RF::l_idx(cur, wid * QBLK + r32); if (lq >= 0) LSE[lq] = (l_reg > 0.f) ? m_reg * SCALE + __logf(l_reg) : -__builtin_inff(); }
    if (lse_lane != nullptr) *lse_lane = (l_reg > 0.f) ? m_reg * SCALE + __logf(l_reg) : -__builtin_inff();
    bf16* O = cur.O;
#pragma unroll
    for (int r = 0; r < 16; ++r) { const int orow = crow(r, hi); const float lv = li_l[orow]; const float rl = (lv > 0.f) ? __builtin_amdgcn_rcpf(lv) : 0.f; const int oo = ot_l[orow];
#pragma unroll
        for (int d0 = 0; d0 < 4; ++d0) { const float v = o[d0][r] * rl; const float vn = __shfl_xor(v, 1);
            if (oo >= 0 && (r32 & 1) == 0) *(unsigned*)(O + (size_t)oo + d0 * 32 + r32) = cvtpk(v, vn); } }
    __syncthreads();
#undef RESC
#undef KBASE
#undef ACT
#undef MASKT
#undef SEAM_K0
#undef HALF_STEP
}

template <class RF>
__device__ __forceinline__ void imp_sweep(const Ref& cur, float lse_lane, float* IMP  , char* lds, Seam& S) {
    int tid_ = threadIdx.x; asm volatile("" : "+v"(tid_));
    const int tid = tid_, wid = __builtin_amdgcn_readfirstlane(tid >> 6), lane = tid & 63, r32 = lane & 31, hi = lane >> 5;
    const int NT = cur.j_hi - cur.j_lo;
    char* K_lds = lds + 2 * SHM_V;
    const int sr = tid >> 4, sc = (tid & 15) * 8, kws = KSWZ(sr, sc * 2);
    const bf16* Kh = cur.K; const int kp = cur.kpitch;
    const int row = wid * QBLK + r32;
    const int qm = RF::pos(cur, row) - 4 * hi; const unsigned Wm = (unsigned)RF::Wl(cur, row);
    constexpr float C2 = 1.4426950408889634f * SCALE;
    const float nl2 = (lse_lane == -__builtin_inff()) ? 0.f : -lse_lane * 1.4426950408889634f;
    float carry = 0.f;
    float* imp_row = IMP + (size_t)(row >> 2) * 512;
    f32x16 p0, p1;
#define IMP_TILE(t, KB) do { \
        if ((t) + 1 < NT) { S.st_k0 = load8(ROW(Kh, kp, (cur.j_lo + (t) + 1) * KVBLK, sr)); S.st_k1 = load8(ROW(Kh, kp, (cur.j_lo + (t) + 1) * KVBLK, 32 + sr)); } \
        SBAR(); qkt<KB, false>(p0, p1, K_lds, r32, hi, S.qr, true); \
        mask_tile(p0, p1, qm - (cur.j_lo + (t)) * KVBLK, Wm); \
        _Pragma("unroll") for (int r = 0; r < 16; ++r) { p0[r] = __builtin_amdgcn_exp2f(fmaf(p0[r], C2, nl2)); p1[r] = __builtin_amdgcn_exp2f(fmaf(p1[r], C2, nl2)); } \
        float Gs[8], Ls[8]; \
        _Pragma("unroll") for (int q = 0; q < 4; ++q) { Gs[q] = (p0[4 * q] + p0[4 * q + 1]) + (p0[4 * q + 2] + p0[4 * q + 3]); Ls[q] = p0[4 * q + 3]; \
                                              Gs[4 + q] = (p1[4 * q] + p1[4 * q + 1]) + (p1[4 * q + 2] + p1[4 * q + 3]); Ls[4 + q] = p1[4 * q + 3]; } \
          \
        float prevL = carry; \
        _Pragma("unroll") for (int q = 0; q < 8; ++q) { const float other = __shfl_xor(Ls[q], 32);        \
            const float add = hi ? other : prevL; prevL = other; Gs[q] += add; } \
        carry = prevL;                                            \
        _Pragma("unroll") for (int q = 0; q < 8; ++q) { float v = Gs[q]; v += __shfl_xor(v, 1); v += __shfl_xor(v, 2); \
            if ((r32 & 3) == 0) imp_row[((cur.j_lo + (t)) << 4) + 2 * q + hi] = v; } \
        if ((t) + 1 < NT) { asm volatile("s_waitcnt vmcnt(0)" ::: "memory"); *(bf16x8*)(K_lds + ((KB) ^ 1) * SHM_K + kws) = S.st_k0; *(bf16x8*)(K_lds + ((KB) ^ 1) * SHM_K + kws + 32 * 256) = S.st_k1; } \
        __syncthreads(); } while (0)
    for (int t = 0; t < NT; t += 2) { IMP_TILE(t, 0); if (t + 1 < NT) IMP_TILE(t + 1, 1); }
#undef IMP_TILE
}
#undef ROW
#undef VMW
#undef VMWN
#undef SLOAD_H
#undef SWRITE_HK
#undef SWRITE_HV
#undef SWRITE_H
#undef KSWZ
#undef SBAR
}

struct RFReg {
    static __device__ __forceinline__ int q_off(const att::Ref&, int row) { return row * 1024; }
    static __device__ __forceinline__ int o_off(const att::Ref&, int row) { return row * 1024; }
    static __device__ __forceinline__ int l_idx(const att::Ref& u, int row) { return u.a0 >= 0 ? u.a0 + row * 8 : -1; }
    static __device__ __forceinline__ int pos(const att::Ref& u, int row) { return u.P0 + row; }
    static __device__ __forceinline__ int Wl(const att::Ref& u, int) { return u.W; }
};
__device__ __forceinline__ att::Ref win_ref(int L, const bf16* QN, const bf16* KW, const bf16* VW, bf16* OWIN) {
    const int h = L & 7, qb = L >> 3;
    att::Ref r; r.Q = QN + (size_t)qb * 256 * 1024 + h * 128; r.O = OWIN + (size_t)qb * 256 * 1024 + h * 128; r.K = KW + (h >> 2) * 128; r.V = VW + (h >> 2) * 128; r.kpitch = 256; r.list = nullptr;
    r.P0 = qb * 256; r.W = 512; r.j_lo = (r.P0 >= 511) ? (r.P0 - 511) >> 6 : 0; r.j_hi = ((r.P0 + 255) >> 6) + 1; r.a0 = -1; r.a1 = 0; return r;
}
__device__ __forceinline__ att::Ref mown_ref(int L, const bf16* QM, const bf16* KM, const bf16* VM, bf16* POWN) {
    const int h = L & 7, n = L >> 3; const size_t o = (size_t)n * 256 * 1024 + h * 128;
    att::Ref r; r.Q = QM + o; r.O = POWN + o; r.K = KM + o; r.V = VM + o; r.kpitch = 1024; r.list = nullptr;
    r.P0 = 0; r.W = 1 << 20; r.j_lo = 0; r.j_hi = 4; r.a0 = n * 256 * 8 + h; r.a1 = 0; return r;
}
struct RFSel {
    static __device__ __forceinline__ int q_off(const att::Ref& u, int row) { const int e = u.list[row < u.a0 ? row : 0]; return (e >> 2) * 1024; }
    static __device__ __forceinline__ int o_off(const att::Ref& u, int row) { if (row >= u.a0) return -1; const int e = u.list[row]; return (((e >> 2) * 8 + u.a1) * 3 + (e & 3)) * 128; }
    static __device__ __forceinline__ int l_idx(const att::Ref& u, int row) { if (row >= u.a0) return -1; const int e = u.list[row]; return ((e >> 2) * 8 + u.a1) * 3 + (e & 3); }
    static __device__ __forceinline__ int pos(const att::Ref&, int) { return 0; }
    static __device__ __forceinline__ int Wl(const att::Ref&, int) { return 0; }
};
__device__ __forceinline__ att::Ref msel_ref(int L, const LAS int* tab, const int* MLIST, const bf16* QM, const bf16* KM, const bf16* VM, bf16* PSEL) {
    int lo = 0, hi = 512;
    while (hi - lo > 1) { const int mid = (lo + hi) >> 1; if (tab[512 + mid] <= L) lo = mid; else hi = mid; }
    const int lid = __builtin_amdgcn_readfirstlane(lo), k = L - tab[512 + lid], h = lid >> 6, n = lid & 63;
    att::Ref r; r.Q = QM + h * 128; r.O = PSEL; r.K = KM + (size_t)n * 256 * 1024 + h * 128; r.V = VM + (size_t)n * 256 * 1024 + h * 128; r.kpitch = 1024;
    r.list = MLIST + (size_t)lid * 16384 + k * 256; r.P0 = 0; r.W = 0; r.j_lo = 0; r.j_hi = 4; r.a0 = tab[lid] - k * 256; r.a1 = h; return r;
}

struct RFSlc {
    static __device__ __forceinline__ int q_off(const att::Ref& u, int row) { const int e = u.list[(row >> 2) < u.a0 ? (row >> 2) : 0]; return (e >> 4) * 1024 + (row & 3) * 128; }
    static __device__ __forceinline__ int o_off(const att::Ref& u, int row) { if ((row >> 2) >= u.a0) return -1; const int e = u.list[row >> 2]; return (e * 4 + (row & 3)) * 128; }
    static __device__ __forceinline__ int l_idx(const att::Ref& u, int row) { if ((row >> 2) >= u.a0) return -1; const int e = u.list[row >> 2]; return e * 4 + (row & 3); }
    static __device__ __forceinline__ int pos(const att::Ref& u, int row) { const int e = u.list[(row >> 2) < u.a0 ? (row >> 2) : 0]; return (e >> 4) - 64 * u.a1; }
    static __device__ __forceinline__ int Wl(const att::Ref&, int) { return 1 << 30; }
};
__device__ __forceinline__ att::Ref nsel_ref(int L, int g, const LAS int* tab, const int* NLIST, const bf16* QN, const bf16* KS, const bf16* VS, bf16* PSLC) {
    int lo = 0, hi = 256;
    while (hi - lo > 1) { const int mid = (lo + hi) >> 1; if (tab[256 + mid] <= L) lo = mid; else hi = mid; }
    const int j = __builtin_amdgcn_readfirstlane(lo), k = L - tab[256 + j];
    att::Ref r; r.Q = QN + g * 512; r.O = PSLC; r.K = KS + (size_t)j * 64 * 256 + g * 128; r.V = VS + (size_t)j * 64 * 256 + g * 128; r.kpitch = 256;
    r.list = NLIST + (size_t)(g * 256 + j) * 16384 + k * 64; r.P0 = 0; r.W = 0; r.j_lo = 0; r.j_hi = 1; r.a0 = tab[j] - k * 64; r.a1 = j; return r;
}

struct RFCmp {
    static __device__ __forceinline__ int q_off(const att::Ref&, int row) { return (row >> 2) * 1024 + (row & 3) * 128; }
    static __device__ __forceinline__ int o_off(const att::Ref&, int row) { return (row >> 2) * 1024 + (row & 3) * 128; }
    static __device__ __forceinline__ int l_idx(const att::Ref&, int) { return -1; }
    static __device__ __forceinline__ int pos(const att::Ref& u, int row) { const int t = u.P0 + (row >> 2); return t >= 31 ? (t - 31) >> 4 : -1; }
    static __device__ __forceinline__ int Wl(const att::Ref&, int) { return 1 << 30; }
};
__device__ __forceinline__ att::Ref cmp_ref(int L, const bf16* QN, const bf16* KCMP, const bf16* VCMP, bf16* OCMP) {
    const int g = L & 1, c = (L < 256) ? (L >> 1) : 255 - ((L - 256) >> 1);
    att::Ref r; r.Q = QN + (size_t)c * 64 * 1024 + g * 512; r.O = OCMP + (size_t)c * 64 * 1024 + g * 512; r.K = KCMP + g * 128; r.V = VCMP + g * 128; r.kpitch = 256; r.list = nullptr;
    r.P0 = c * 64; r.W = 0; r.j_lo = 0; r.j_hi = (4 * c + 3 + 63) >> 6; r.a0 = g; r.a1 = c; return r;
}

struct Args { const float* in[18]; float* out; unsigned char* ws; int ph_lo, ph_hi, li, pad; };
typedef const __attribute__((address_space(4))) Args* ArgsP;
__device__ __forceinline__ ArgsP get_args() { auto p = __builtin_amdgcn_kernarg_segment_ptr(); asm volatile("" : "+s"(p)); return (ArgsP)p; }

__global__ void __launch_bounds__(NTHR, 2) mk_fwd(Args args_unused) {
    extern __shared__ __attribute__((aligned(16))) unsigned char lds_raw[];
    LAS unsigned char* lds = (LAS unsigned char*)lds_raw;
    LAS float* sm = (LAS float*)lds;
    volatile LAS unsigned* MISC = (volatile LAS unsigned*)(lds + MISC_OFF);
    LAS int* moetab = (LAS int*)(lds + MOETAB_OFF);
    const int G = gridDim.x, bid = blockIdx.x, NGW = G * NWAVES;
#define PH_IDS() int tid_ = threadIdx.x; asm volatile("" : "+v"(tid_)); const int tid = tid_, lane = tid & 63, wave = __builtin_amdgcn_readfirstlane(tid >> 6), gw = bid * NWAVES + wave; (void)lane; (void)gw;
#define AP() get_args()
#define CTLP(ws) ((gu32*)((ws) + WS_CTL))

    for (int u = threadIdx.x; u < (LDS_BYTES - LDSCTL_OFF) / 4; u += NTHR) ((LAS unsigned*)(lds + LDSCTL_OFF))[u] = 0u;
    __syncthreads();
    XcdBarrier bar; bar.bar = nullptr; bar.x = 0; bar.st = nullptr;
    if (MK_N_LAUNCHES == 1) bar = xcd_barrier_post((unsigned*)(CTLP(AP()->ws) + CW_BAR), MISC + 8);
#define GRID_BAR() do { if (MK_N_LAUNCHES == 1) { XcdBarrier b_ = bar; b_.bar = (unsigned*)(CTLP(AP()->ws) + CW_BAR); xcd_barrier(b_); } } while (0)
    const int lo = AP()->ph_lo, hi = AP()->ph_hi;
#define IN(k) (lo <= (k) && (k) < hi)
#define BOTH(k) (IN(k) && IN((k) + 1))

    if (IN(0)) {
        PH_IDS(); ArgsP ap = AP(); unsigned char* ws = ap->ws;
        LAS float* scr = (LAS float*)(lds + wave * 16384);
        constexpr int I_IN = 32 * 177, I_OUT = 32 * 64, I_GU = 32 * 16, I_DN = 8 * 64, I_W1 = 32 * 8;
        constexpr int N_IN = 2 * I_IN, N_OUT = 2 * I_OUT, N_G = 64 * I_GU, N_U = 64 * I_GU, N_D = 64 * I_DN, N_W1 = 8 * I_W1;
        constexpr int NITEMS = N_IN + N_OUT + N_G + N_U + N_D + N_W1;
        for (int it = gw; it < NITEMS; it += NGW) {
            int r = it;
            if (r < N_IN) { const int l = r / I_IN; transpose_item<1>(ap->in[6] + (size_t)l * D_ * IN_W, D_, IN_W, (bf16*)(ws + WS_WINT) + (size_t)l * NIN * D_, D_, 0, scr, r % I_IN, lane); continue; } r -= N_IN;
            if (r < N_OUT) { const int l = r / I_OUT; transpose_item<0>(ap->in[7] + (size_t)l * D_ * D_, D_, D_, (bf16*)(ws + WS_WOUTT) + (size_t)l * D_ * D_, D_, 0, scr, r % I_OUT, lane); continue; } r -= N_OUT;
            if (r < N_G) { const int le = r / I_GU; transpose_item<2>(ap->in[14] + (size_t)le * D_ * DEXP, D_, DEXP, (bf16*)(ws + WS_WGUT) + (size_t)le * 1024 * D_, D_, 0, scr, r % I_GU, lane); continue; } r -= N_G;
            if (r < N_U) { const int le = r / I_GU; transpose_item<3>(ap->in[15] + (size_t)le * D_ * DEXP, D_, DEXP, (bf16*)(ws + WS_WGUT) + (size_t)le * 1024 * D_, D_, 0, scr, r % I_GU, lane); continue; } r -= N_U;
            if (r < N_D) { const int le = r / I_DN; transpose_item<0>(ap->in[16] + (size_t)le * DEXP * D_, DEXP, D_, (bf16*)(ws + WS_WDT) + (size_t)le * D_ * DEXP, DEXP, 0, scr, r % I_DN, lane); continue; } r -= N_D;
            { const int m = r / I_W1, lk = m >> 1, half = m & 1;
              transpose_item<0>(ap->in[9] + (size_t)lk * 4096 * 256 + (size_t)half * 2048 * 256, 2048, 256, (bf16*)(ws + WS_WC1T) + (size_t)lk * 512 * 2048, 2048, half * 256, scr, r % I_W1, lane); }
        }
        { const float* w_router = ap->in[12]; bf16* WrT = (bf16*)(ws + WS_WRT);
          for (int idx = bid * NTHR + tid; idx < 32 * 2048; idx += G * NTHR) { const int e = idx >> 11, k = idx & 2047; const float w = w_router[(size_t)k * 32 + e];
            const unsigned hb = f2bf(w); const float rem = w - bf2f(hb); WrT[idx] = (bf16)hb; WrT[32 * 2048 + idx] = (bf16)f2bf(rem); } }
        { f32x2* ROPE = (f32x2*)(ws + WS_ROPE);
          for (int idx = bid * NTHR + tid; idx < S_ * 64; idx += G * NTHR) { const int pos = idx >> 6, i = idx & 63;
            const double inv = exp(-(double)i * (9.210340371976184 / 64.0)); const double ang = (double)pos * inv; double sv, cv; sincos(ang, &sv, &cv);
            ROPE[idx] = (f32x2){(float)cv, (float)sv}; } }
        __syncthreads();
        { float* MOD = (float*)(CTLP(ws) + CW_MOD); const float* c_in = ap->in[1]; const float* w_ada = ap->in[2]; const float* b_ada = ap->in[3];
          for (int k = tid; k < D_; k += NTHR) { const float cv = c_in[k]; sm[k] = cv / (1.f + __expf(-cv)); }
          __syncthreads();
          for (int it = bid; it < 2 * 96; it += G) { const int l = it / 96, cb = it % 96, grp = tid >> 5, col = cb * 128 + (tid & 31) * 4;
            f32x4 a = (f32x4){0.f, 0.f, 0.f, 0.f};
            const float* wp = w_ada + ((size_t)l * D_ + grp) * 12288 + col;
#pragma unroll 8
            for (int i = 0; i < 128; ++i) a += *(const f32x4*)(wp + (size_t)i * 16 * 12288) * sm[grp + 16 * i];
            *(LAS f32x4*)(sm + 4096 + grp * 128 + (tid & 31) * 4) = a;
            __syncthreads();
            if (tid < 128) { float s = b_ada[l * 12288 + cb * 128 + tid];
#pragma unroll
                for (int q = 0; q < 16; ++q) s += sm[4096 + q * 128 + tid];
                MOD[l * 12288 + cb * 128 + tid] = s; }
            __syncthreads(); } }
        { float* B1E = (float*)(CTLP(ws) + CW_B1E); const float* cmp_pe = ap->in[8]; const float* cmp_w1 = ap->in[9]; const float* cmp_b1 = ap->in[10];
          for (int it = bid - 192; it >= 0 && it < 4; it += G) { const int lk = it, grp = tid >> 6, n = (tid & 63) * 4;
            f32x4 a = (f32x4){0.f, 0.f, 0.f, 0.f};
            const float* wp = cmp_w1 + ((size_t)lk * 4096 + grp) * 256 + n; const float* pe = cmp_pe + (size_t)lk * 4096 + grp;
#pragma unroll 8
            for (int i = 0; i < 512; ++i) a += *(const f32x4*)(wp + (size_t)i * 8 * 256) * pe[i * 8];
            *(LAS f32x4*)(sm + 4096 + grp * 256 + n) = a;
            __syncthreads();
            if (tid < 256) { float s = cmp_b1[lk * 256 + tid];
#pragma unroll
                for (int q = 0; q < 8; ++q) s += sm[4096 + q * 256 + tid];
                B1E[lk * 256 + tid] = s; }
            __syncthreads(); } }
        if (BOTH(0)) GRID_BAR();
    }

    for (int l = 0; l < DEPTH; ++l) {
        const int pb = 1 + NPL * l;
#define LOAD_MOETAB(CNTP, NT_) do { __syncthreads(); if (tid < 32) moetab[tid] = (int)__hip_atomic_load((CNTP) + tid, RLX_AGENT); __syncthreads(); \
        if (tid == 0) { int us = 0, ps = 0; for (int e = 0; e < NEXP; ++e) { const int c = moetab[e], tl = (c + 255) >> 8; moetab[32 + e] = us; moetab[65 + e] = ps; us += tl * (NT_); ps += tl << 8; } moetab[64] = us; } \
        __syncthreads(); } while (0)

        if (IN(pb + 0)) {
            PH_IDS(); ArgsP ap = AP(); unsigned char* ws = ap->ws;
            const float* MOD = (const float*)(CTLP(ws) + CW_MOD); const float* mod = MOD + l * 12288;
            float* X = ap->out; bf16* H = (bf16*)(ws + WS_H); const bf16* Y = (const bf16*)(ws + WS_Y); const int* TE = (const int*)(ws + WS_TE);
            if (l > 0) LOAD_MOETAB((unsigned*)(CTLP(ws) + CW_CNT) + (l - 1) * 32, 1);
            { const float* g_attn = ap->in[4];
              for (int k = tid; k < D_; k += NTHR) { sm[k] = g_attn[l * D_ + k] * (1.f + mod[2048 + k]); sm[2048 + k] = mod[k]; sm[4096 + k] = (l > 0) ? MOD[(l - 1) * 12288 + 10240 + k] : 0.f; } }
            __syncthreads();
            const float* x_in = ap->in[0];
            for (int t = gw; t < S_; t += NGW) {
                f32x4 v[8]; float ss = 0.f;
                if (l == 0) {
#pragma unroll
                    for (int j = 0; j < 8; ++j) v[j] = *(const f32x4*)(x_in + (size_t)t * D_ + 256 * j + 4 * lane);
                } else {
                    const int4 te = *(const int4*)(TE + 4 * t);
                    const bf16* y0 = Y + (size_t)(moetab[65 + te.x] + te.y) * D_; const bf16* y1 = Y + (size_t)(moetab[65 + te.z] + te.w) * D_;
#pragma unroll
                    for (int j = 0; j < 8; ++j) { const int k = 256 * j + 4 * lane; const uint2 a = *(const uint2*)(y0 + k), b = *(const uint2*)(y1 + k);
                        const f32x4 gt2 = *(const LAS f32x4*)(sm + 4096 + k);
                        f32x4 ysum = (f32x4){bflo(a.x) + bflo(b.x), bfhi(a.x) + bfhi(b.x), bflo(a.y) + bflo(b.y), bfhi(a.y) + bfhi(b.y)};
                        v[j] = *(const f32x4*)(X + (size_t)t * D_ + k) + gt2 * ysum; *(f32x4*)(X + (size_t)t * D_ + k) = v[j]; }
                }
#pragma unroll
                for (int j = 0; j < 8; ++j) ss += (v[j][0] * v[j][0] + v[j][1] * v[j][1]) + (v[j][2] * v[j][2] + v[j][3] * v[j][3]);
                const float rstd = 1.f / sqrtf(wave_sum(ss) * (1.f / D_) + RMS_EPS);
#pragma unroll
                for (int j = 0; j < 8; ++j) { const int k = 256 * j + 4 * lane; const f32x4 h = v[j] * rstd * *(const LAS f32x4*)(sm + k) + *(const LAS f32x4*)(sm + 2048 + k);
                    *(uint2*)(H + (size_t)t * D_ + k) = make_uint2(pk2(h[0], h[1]), pk2(h[2], h[3])); }
            }
            if (BOTH(pb + 0)) GRID_BAR();
        }
        if (IN(pb + 1)) {
            ArgsP ap = AP(); unsigned char* ws = ap->ws;
            pg8::Gemm g{(const bf16*)(ws + WS_H), (const bf16*)(ws + WS_WINT) + (size_t)l * NIN * D_, S_, NIN, D_}; pg8::StaticOrder So; So.init(S_, NIN, G, bid);
            EpiInProj E{(bf16*)(ws + WS_QN), (bf16*)(ws + WS_KC), (bf16*)(ws + WS_VC), (bf16*)(ws + WS_KS), (bf16*)(ws + WS_VS), (bf16*)(ws + WS_KW), (bf16*)(ws + WS_VW),
                        (bf16*)(ws + WS_QM), (bf16*)(ws + WS_KM), (bf16*)(ws + WS_VM), (float*)(ws + WS_GATES), (const float*)(ws + WS_ROPE)};
            pg8::gemm_phase<EpiInProj, pg8::StaticOrder, true, true>(lds, g, So, E);
            if (BOTH(pb + 1)) GRID_BAR();
        }
        if (IN(pb + 2)) {
            PH_IDS(); ArgsP ap = AP(); unsigned char* ws = ap->ws;
            if (bid < 32) {
                pg8::Gemm g{(const bf16*)(ws + WS_KC), (const bf16*)(ws + WS_WC1T) + (size_t)l * 2 * 512 * 2048, 4096, 512, 2048}; CompressOrder So{G, bid};
                EpiF32 E{(float*)(ws + WS_UL), 512};
                pg8::gemm_phase<EpiF32, CompressOrder, false, true>(lds, g, So, E);
            }
            {
                const bf16* KM = (const bf16*)(ws + WS_KM); float* KMEAN = (float*)(ws + WS_KMEAN);
                const int nb = (G > 32) ? G - 32 : G, b0 = (G > 32) ? bid - 32 : bid;
                if (b0 >= 0) for (int u = b0; u < 512; u += nb) { const int n = u >> 3, h = u & 7, rg = tid >> 4, c8 = (tid & 15) * 8;
                    float a8[8] = {0.f, 0.f, 0.f, 0.f, 0.f, 0.f, 0.f, 0.f};
#pragma unroll
                    for (int i = 0; i < 8; ++i) { const v4u kv = *(const v4u*)(KM + (size_t)(n * 256 + rg + 32 * i) * 1024 + h * 128 + c8);
                        a8[0] += bflo(kv.x); a8[1] += bfhi(kv.x); a8[2] += bflo(kv.y); a8[3] += bfhi(kv.y); a8[4] += bflo(kv.z); a8[5] += bfhi(kv.z); a8[6] += bflo(kv.w); a8[7] += bfhi(kv.w); }
#pragma unroll
                    for (int i = 0; i < 8; ++i) sm[rg * 128 + c8 + i] = a8[i];
                    __syncthreads();
                    if (tid < 128) { float s = 0.f;
#pragma unroll 8
                        for (int q = 0; q < 32; ++q) s += sm[q * 128 + tid];
                        KMEAN[(size_t)(n * 8 + h) * 128 + tid] = s * (1.f / 256.f); }
                    __syncthreads(); }
            }
            if (BOTH(pb + 2)) GRID_BAR();
        }
        if (IN(pb + 3)) {
            PH_IDS(); ArgsP ap = AP(); unsigned char* ws = ap->ws;
            const float* UL = (const float*)(ws + WS_UL); const float* B1E = (const float*)(CTLP(ws) + CW_B1E); const f32x2* ROPE = (const f32x2*)(ws + WS_ROPE);
            bf16* KCMP = (bf16*)(ws + WS_KCMP); bf16* VCMP = (bf16*)(ws + WS_VCMP); const float* cmp_w2 = ap->in[11];
            { const int kv = bid & 1; const float* w2 = cmp_w2 + (size_t)(l * 2 + kv) * 256 * 128; const float* be = B1E + (l * 2 + kv) * 256;
              for (int i = tid; i < 256 * 128 / 4; i += NTHR) *(LAS f32x4*)(sm + 4 * i) = *(const f32x4*)(w2 + 4 * i);
              LAS float* hid = (LAS float*)(lds + 135168) + wave * 256;
              __syncthreads();
              const int nb2 = (G + 1 - kv) >> 1;
              for (int r = (bid >> 1) * NWAVES + wave; r < NC * 2; r += nb2 * NWAVES) { const int c = r >> 1, g = r & 1;
                const float* Ur = UL + ((size_t)kv * 2048 + g * 1024 + c) * 512; const float* Lr = UL + ((size_t)kv * 2048 + g * 1024 + c + 1) * 512 + 256;
#pragma unroll
                for (int j = 0; j < 4; ++j) { const int n = lane + 64 * j; const float v = Ur[n] + Lr[n] + be[n];
                    hid[n] = 0.5f * v * (1.f + tanhf(0.7978845608028654f * (v + 0.044715f * v * v * v))); }
                LDS_WAIT(); asm volatile("" ::: "memory");
                float o0 = 0.f, o1 = 0.f;
#pragma unroll 8
                for (int n = 0; n < 256; ++n) { const float hv = hid[n]; o0 += hv * sm[n * 128 + lane]; o1 += hv * sm[n * 128 + 64 + lane]; }
                if (kv == 0) { const f32x2 cs = ROPE[(size_t)(16 * c + 31) * 64 + lane];
                    const float a = o0 * cs[0] - o1 * cs[1], b = o1 * cs[0] + o0 * cs[1];
                    *(unsigned*)(KCMP + ((size_t)c * 2 + g) * 128 + 2 * lane) = pk2(a, b);
                } else { VCMP[((size_t)c * 2 + g) * 128 + lane] = (bf16)f2bf(o0); VCMP[((size_t)c * 2 + g) * 128 + 64 + lane] = (bf16)f2bf(o1); }
                LDS_WAIT(); asm volatile("" ::: "memory");
              }
              __syncthreads(); }
            if (BOTH(pb + 3)) GRID_BAR();
        }
        if (IN(pb + 4)) {
            {   ArgsP ap = AP(); unsigned char* ws = ap->ws;
                const bf16* QN = (const bf16*)(ws + WS_QN); const bf16* KCMP = (const bf16*)(ws + WS_KCMP); const bf16* VCMP = (const bf16*)(ws + WS_VCMP);
                bf16* OCMP = (bf16*)(ws + WS_OCMP); float* IMP = (float*)(ws + WS_IMP);
                att::Seam S;
                for (int L = bid; L < 512; L += G) { const att::Ref cur = cmp_ref(L, QN, KCMP, VCMP, OCMP); float lse;
                    att::prime<RFCmp>(cur, (char*)lds_raw, S);
                    att::block<2, false, RFCmp>(cur, cur, nullptr, (char*)lds_raw, S, &lse);
                    att::imp_sweep<RFCmp>(cur, lse, IMP + ((size_t)cur.a1 * 64 * 2 + cur.a0) * 256, (char*)lds_raw, S); }
            }
            {   ArgsP ap = AP(); unsigned char* ws = ap->ws;
                const bf16* QN = (const bf16*)(ws + WS_QN); const bf16* KW = (const bf16*)(ws + WS_KW); const bf16* VW = (const bf16*)(ws + WS_VW); bf16* OWIN = (bf16*)(ws + WS_OWIN);
                __syncthreads();
                att::Seam S; int L = bid;
                if (L < 512) { att::Ref cur = win_ref(L, QN, KW, VW, OWIN); att::prime<RFReg>(cur, (char*)lds_raw, S);
                    for (;;) { const bool more = L + G < 512; const att::Ref nxt = more ? win_ref(L + G, QN, KW, VW, OWIN) : cur;
                        att::block<0, true, RFReg>(cur, nxt, nullptr, (char*)lds_raw, S);
                        if (!more) break; cur = nxt; L += G; } }
                __syncthreads();
            }
            {   PH_IDS(); ArgsP ap = AP(); unsigned char* ws = ap->ws;
                const bf16* QM = (const bf16*)(ws + WS_QM); const float* KMEAN = (const float*)(ws + WS_KMEAN);
                unsigned* MCNT = (unsigned*)(CTLP(ws) + CW_MCNT) + l * 512; int* MLIST = (int*)(ws + WS_MLIST); float* LSES = (float*)(ws + WS_LSES);
                LAS float* qs = sm; LAS float* ks = sm + 8192; LAS float* gs = sm + 8192 + 64 * 132;
                for (int u = bid; u < 2048; u += G) { const int c = u >> 3, h = u & 7, own = c >> 2;
                    __syncthreads();
                    for (int i = tid; i < 64 * 128; i += NTHR) qs[i] = bf2f(QM[(size_t)(c * 64 + (i >> 7)) * 1024 + h * 128 + (i & 127)]);
                    for (int i = tid; i < own * 128; i += NTHR) ks[(i >> 7) * 132 + (i & 127)] = KMEAN[(size_t)((i >> 7) * 8 + h) * 128 + (i & 127)];
                    __syncthreads();
                    { const int q = tid >> 3, nn = tid & 7;
                      for (int n = nn; n < own; n += 8) { float a = 0.f;
#pragma unroll 8
                          for (int d = 0; d < 128; d += 4) { const f32x4 qa = *(const LAS f32x4*)(qs + q * 128 + d), ka = *(const LAS f32x4*)(ks + n * 132 + d); a += qa[0] * ka[0] + qa[1] * ka[1] + qa[2] * ka[2] + qa[3] * ka[3]; }
                          gs[q * 64 + n] = a; } }
                    __syncthreads();
                    for (int qq = 0; qq < 8; ++qq) { const int q = wave * 8 + qq, t = c * 64 + q;
                        float gv = (lane < own) ? gs[q * 64 + lane] : -INFINITY; int mysel = -1;
                        for (int r = 0; r < 3; ++r) { float bv = gv; int bi = lane;
#pragma unroll
                            for (int o = 1; o < 64; o <<= 1) { const float ov = __shfl_xor(bv, o); const int oi = __shfl_xor(bi, o); if (ov > bv || (ov == bv && oi < bi)) { bv = ov; bi = oi; } }
                            if (lane == r) mysel = (bv == -INFINITY) ? -1 : bi;
                            if (lane == bi) gv = -INFINITY; }
                        if (lane < 3) {
                            if (mysel >= 0) { const unsigned p = atomicAdd(MCNT + h * 64 + mysel, 1u); MLIST[(size_t)(h * 64 + mysel) * 16384 + p] = t * 4 + lane; }
                            else LSES[(t * 8 + h) * 3 + lane] = -INFINITY; } }
                }
            }
            if (BOTH(pb + 4)) GRID_BAR();
        }
        if (IN(pb + 5)) {
            PH_IDS(); ArgsP ap = AP(); unsigned char* ws = ap->ws;
            {   PH_IDS(); ArgsP ap = AP(); unsigned char* ws = ap->ws;
                const float* IMP = (const float*)(ws + WS_IMP); int* SEL = (int*)(ws + WS_SEL);
                unsigned* NCNT = (unsigned*)(CTLP(ws) + CW_NCNT) + l * 512; int* NLIST = (int*)(ws + WS_NLIST);
                for (int u = gw; u < S_ * 2; u += NGW) { const int t = u >> 1, g = u & 1, tb = t >> 6;
                    float v[4];
#pragma unroll
                    for (int i = 0; i < 4; ++i) { const int j = lane + 64 * i; const float im = IMP[(size_t)u * 256 + j]; const bool forced = (j == 0) || (j == tb) || (j == tb - 1);
                        v[i] = (j > tb) ? -INFINITY : (forced ? 1e9f : im); }
                    int mysel = -1;
                    for (int r = 0; r < 16; ++r) { float bv = v[0]; int bi = lane;
#pragma unroll
                        for (int i = 1; i < 4; ++i) if (v[i] > bv) { bv = v[i]; bi = lane + 64 * i; }
#pragma unroll
                        for (int o = 1; o < 64; o <<= 1) { const float ov = __shfl_xor(bv, o); const int oi = __shfl_xor(bi, o); if (ov > bv || (ov == bv && oi < bi)) { bv = ov; bi = oi; } }
                        if (bv == -INFINITY) break;
                        if (lane == r) mysel = bi;
#pragma unroll
                        for (int i = 0; i < 4; ++i) if (bi == lane + 64 * i) v[i] = -INFINITY; }
                    if (lane < 16) { SEL[(size_t)u * 16 + lane] = mysel;
                        if (mysel >= 0) { const unsigned p = atomicAdd(NCNT + g * 256 + mysel, 1u); NLIST[(size_t)(g * 256 + mysel) * 16384 + p] = t * 16 + lane; } }
                }
            }
            {   PH_IDS(); ArgsP ap = AP(); unsigned char* ws = ap->ws;
                const bf16* QM = (const bf16*)(ws + WS_QM); const bf16* KM = (const bf16*)(ws + WS_KM); const bf16* VM = (const bf16*)(ws + WS_VM);
                bf16* POWN = (bf16*)(ws + WS_POWN); bf16* PSEL = (bf16*)(ws + WS_PSEL); float* LSEO = (float*)(ws + WS_LSEO); float* LSES = (float*)(ws + WS_LSES);
                const int* MLIST = (const int*)(ws + WS_MLIST); unsigned* MCNT = (unsigned*)(CTLP(ws) + CW_MCNT) + l * 512;
                LAS int* mtab = (LAS int*)(lds + att::LDS_BYTES);
                __syncthreads();
                mtab[tid] = (int)__hip_atomic_load(MCNT + tid, RLX_AGENT);
                __syncthreads();
                if (tid == 0) { int us = 0; for (int i = 0; i < 512; ++i) { mtab[512 + i] = us; us += (mtab[i] + 255) >> 8; } mtab[1024] = us; }
                __syncthreads();
                const int nsel = mtab[1024];
                att::Seam S;
                { int L = bid;
                  if (L < 512) { att::Ref cur = mown_ref(L, QM, KM, VM, POWN); att::prime<RFReg>(cur, (char*)lds_raw, S);
                    for (;;) { const bool more = L + G < 512; const att::Ref nxt = more ? mown_ref(L + G, QM, KM, VM, POWN) : cur;
                        att::block<0, true, RFReg>(cur, nxt, LSEO, (char*)lds_raw, S);
                        if (!more) break; cur = nxt; L += G; } } }
                __syncthreads();
                { int L = bid;
                  if (L < nsel) { att::Ref cur = msel_ref(L, mtab, MLIST, QM, KM, VM, PSEL); att::prime<RFSel>(cur, (char*)lds_raw, S);
                    for (;;) { const bool more = L + G < nsel; const att::Ref nxt = more ? msel_ref(L + G, mtab, MLIST, QM, KM, VM, PSEL) : cur;
                        att::block<1, false, RFSel>(cur, nxt, LSES, (char*)lds_raw, S);
                        if (!more) break; cur = nxt; L += G; } } }
                __syncthreads();
            }
            if (BOTH(pb + 5)) GRID_BAR();
        }
        if (IN(pb + 6)) {
            PH_IDS(); ArgsP ap = AP(); unsigned char* ws = ap->ws;
            const bf16* POWN = (const bf16*)(ws + WS_POWN); const bf16* PSEL = (const bf16*)(ws + WS_PSEL); const float* LSEO = (const float*)(ws + WS_LSEO); const float* LSES = (const float*)(ws + WS_LSES);
            bf16* OMIX = (bf16*)(ws + WS_OMIX);
            for (int t = gw; t < S_; t += NGW) {
                const int hh = (lane >> 2) & 7, ii = lane & 3;
                const float lv = (ii == 0) ? LSEO[t * 8 + hh] : LSES[(t * 8 + hh) * 3 + ii - 1];
                float m = fmaxf(lv, __shfl_xor(lv, 1)); m = fmaxf(m, __shfl_xor(m, 2));
                float w = __expf(lv - m); float sw = w + __shfl_xor(w, 1); sw += __shfl_xor(sw, 2); w = w / sw;
#pragma unroll
                for (int h = 0; h < 8; ++h) { float o0 = 0.f, o1 = 0.f;
                    const float w0 = __shfl(w, h * 4), w1 = __shfl(w, h * 4 + 1), w2 = __shfl(w, h * 4 + 2), w3 = __shfl(w, h * 4 + 3);
                    const bf16* ps = PSEL + (size_t)((t * 8 + h) * 3) * 128 + 2 * lane;
                    const unsigned a0 = *(const unsigned*)(POWN + (size_t)t * 1024 + h * 128 + 2 * lane);
                    unsigned a1 = 0u, a2 = 0u, a3 = 0u;
                    if (w1 > 0.f) a1 = *(const unsigned*)(ps); if (w2 > 0.f) a2 = *(const unsigned*)(ps + 128); if (w3 > 0.f) a3 = *(const unsigned*)(ps + 256);
                    o0 = w0 * bflo(a0) + w1 * bflo(a1) + w2 * bflo(a2) + w3 * bflo(a3); o1 = w0 * bfhi(a0) + w1 * bfhi(a1) + w2 * bfhi(a2) + w3 * bfhi(a3);
                    *(unsigned*)(OMIX + (size_t)t * 2048 + 1024 + h * 128 + 2 * lane) = pk2(o0, o1); }
            }
            if (BOTH(pb + 6)) GRID_BAR();

        }
        for (int g = 0; g < 2; ++g) {
            if (IN(pb + 7 + 2 * g)) {
                PH_IDS(); ArgsP ap = AP(); unsigned char* ws = ap->ws;
                const bf16* QN = (const bf16*)(ws + WS_QN); const bf16* KS = (const bf16*)(ws + WS_KS); const bf16* VS = (const bf16*)(ws + WS_VS);
                bf16* PSLC = (bf16*)(ws + WS_PSLC); float* LSEN = (float*)(ws + WS_LSEN); const int* NLIST = (const int*)(ws + WS_NLIST); unsigned* NCNT = (unsigned*)(CTLP(ws) + CW_NCNT) + l * 512 + g * 256;
                LAS int* ntab = (LAS int*)(lds + att::LDS_BYTES);
                __syncthreads();
                if (tid < 256) ntab[tid] = (int)__hip_atomic_load(NCNT + tid, RLX_AGENT);
                __syncthreads();
                if (tid == 0) { int us = 0; for (int i = 0; i < 256; ++i) { ntab[256 + i] = us; us += (ntab[i] + 63) >> 6; } ntab[512] = us; }
                __syncthreads();
                const int nun = ntab[512];
                att::Seam S; int L = bid;
                if (L < nun) { att::Ref cur = nsel_ref(L, g, ntab, NLIST, QN, KS, VS, PSLC); att::prime<RFSlc>(cur, (char*)lds_raw, S);
                    for (;;) { const bool more = L + G < nun; const att::Ref nxt = more ? nsel_ref(L + G, g, ntab, NLIST, QN, KS, VS, PSLC) : cur;
                        att::block<2, false, RFSlc>(cur, nxt, LSEN, (char*)lds_raw, S);
                        if (!more) break; cur = nxt; L += G; } }
                __syncthreads();
                if (BOTH(pb + 7 + 2 * g)) GRID_BAR();
            }
            if (IN(pb + 8 + 2 * g)) {
                PH_IDS(); ArgsP ap = AP(); unsigned char* ws = ap->ws;
                const bf16* PSLC = (const bf16*)(ws + WS_PSLC); const float* LSEN = (const float*)(ws + WS_LSEN); const int* SEL = (const int*)(ws + WS_SEL); const float* GATES = (const float*)(ws + WS_GATES);
                const bf16* OCMP = (const bf16*)(ws + WS_OCMP); const bf16* OWIN = (const bf16*)(ws + WS_OWIN); bf16* OMIX = (bf16*)(ws + WS_OMIX);
                for (int t = gw; t < S_; t += NGW) {
                    const int sv = (lane < 16) ? SEL[(size_t)(t * 2 + g) * 16 + lane] : -1;
                    const int nsel = __popcll(__ballot(sv >= 0));
                    const int s_ = lane >> 2;
                    const float lv = (s_ < nsel) ? LSEN[(size_t)t * 64 + lane] : -INFINITY;
                    float m = lv;
#pragma unroll
                    for (int o = 4; o < 64; o <<= 1) m = fmaxf(m, __shfl_xor(m, o));
                    float w = __expf(lv - m), sw = w;
#pragma unroll
                    for (int o = 4; o < 64; o <<= 1) sw += __shfl_xor(sw, o);
                    w = w / sw;
#pragma unroll
                    for (int r = 0; r < 4; ++r) { float o0 = 0.f, o1 = 0.f;
#pragma unroll
                        for (int s = 0; s < 16; ++s) { const float ws_ = __shfl(w, s * 4 + r);
                            if (s < nsel) { const unsigned a = *(const unsigned*)(PSLC + ((size_t)(t * 16 + s) * 4 + r) * 128 + 2 * lane); o0 += ws_ * bflo(a); o1 += ws_ * bfhi(a); } }
                        const int hd = g * 4 + r; const float g0 = GATES[(size_t)t * 32 + hd * 3], g1 = GATES[(size_t)t * 32 + hd * 3 + 1], g2 = GATES[(size_t)t * 32 + hd * 3 + 2];
                        const size_t oi = (size_t)t * 1024 + hd * 128 + 2 * lane;
                        const unsigned c = *(const unsigned*)(OCMP + oi), w_ = *(const unsigned*)(OWIN + oi);
                        *(unsigned*)(OMIX + (size_t)t * 2048 + hd * 128 + 2 * lane) = pk2(g1 * o0 + g0 * bflo(c) + g2 * bflo(w_), g1 * o1 + g0 * bfhi(c) + g2 * bfhi(w_));
                    }
                }
                if (BOTH(pb + 8 + 2 * g)) GRID_BAR();
            }
        }
        if (IN(pb + 11)) {
            ArgsP ap = AP(); unsigned char* ws = ap->ws;
            pg8::Gemm g{(const bf16*)(ws + WS_OMIX), (const bf16*)(ws + WS_WOUTT) + (size_t)l * D_ * D_, S_, D_, D_}; pg8::StaticOrder So; So.init(S_, D_, G, bid);
            EpiOutProj E{l == 0 ? ap->in[0] : (const float*)ap->out, ap->out, (const float*)(CTLP(ws) + CW_MOD) + l * 12288 + 4096};
            pg8::gemm_phase<EpiOutProj, pg8::StaticOrder, true, true>(lds, g, So, E);
            if (BOTH(pb + 11)) GRID_BAR();
        }
        if (IN(pb + 12)) {
            PH_IDS(); ArgsP ap = AP(); unsigned char* ws = ap->ws;
            const float* mod = (const float*)(CTLP(ws) + CW_MOD) + l * 12288;
            const float* X = ap->out; bf16* H = (bf16*)(ws + WS_H); const bf16* WrT = (const bf16*)(ws + WS_WRT); const float* b_router = ap->in[13];
            unsigned* CNT = (unsigned*)(CTLP(ws) + CW_CNT) + l * 32; int* TE = (int*)(ws + WS_TE); int* TOKIDX = (int*)(ws + WS_TOKIDX); float* WTS = (float*)(ws + WS_WTS);
            { const float* g_ffn = ap->in[5];
              for (int k = tid; k < D_; k += NTHR) { sm[k] = g_ffn[l * D_ + k] * (1.f + mod[8192 + k]); sm[2048 + k] = mod[6144 + k]; }
              if (tid < 32) sm[4160 + tid] = b_router[tid]; }
            typedef short bf16x8_t __attribute__((ext_vector_type(8))); typedef float f32x16_t __attribute__((ext_vector_type(16)));
            for (int bt = bid; bt < S_ / 64; bt += G) { const int t0 = bt * 64;
                __syncthreads();
                for (int rr = 0; rr < 8; ++rr) { const int row = wave * 8 + rr; float ss = 0.f;
#pragma unroll
                    for (int j = 0; j < 8; ++j) { const f32x4 v = *(const f32x4*)(X + (size_t)(t0 + row) * D_ + 256 * j + 4 * lane); ss += (v[0] * v[0] + v[1] * v[1]) + (v[2] * v[2] + v[3] * v[3]); }
                    ss = wave_sum(ss); if (lane == 0) sm[4096 + row] = 1.f / sqrtf(ss * (1.f / D_) + RMS_EPS); }
                __syncthreads();
                { const int r = lane & 31, kh = lane >> 5; f32x16_t acc0 = {}, acc1 = {};
                  const float rs0 = sm[4096 + r], rs1 = sm[4096 + 32 + r];
#pragma unroll 1
                  for (int ks = 0; ks < 16; ++ks) { const int k = wave * 256 + ks * 16 + kh * 8;
                    const bf16x8_t wh = *(const bf16x8_t*)(WrT + (size_t)r * 2048 + k), wl = *(const bf16x8_t*)(WrT + 32 * 2048 + (size_t)r * 2048 + k);
                    const f32x4 gA = *(const LAS f32x4*)(sm + k), gB = *(const LAS f32x4*)(sm + k + 4), sA = *(const LAS f32x4*)(sm + 2048 + k), sB = *(const LAS f32x4*)(sm + 2048 + k + 4);
#pragma unroll
                    for (int rg = 0; rg < 2; ++rg) { const size_t ro = (size_t)(t0 + rg * 32 + r) * D_ + k; const float rs = rg ? rs1 : rs0;
                        const f32x4 xa = *(const f32x4*)(X + ro), xb = *(const f32x4*)(X + ro + 4);
                        const f32x4 ha = xa * rs * gA + sA, hb = xb * rs * gB + sB;
                        const unsigned h0 = pk2(ha[0], ha[1]), h1 = pk2(ha[2], ha[3]), h2 = pk2(hb[0], hb[1]), h3 = pk2(hb[2], hb[3]);
                        *(v4u*)(H + ro) = (v4u){h0, h1, h2, h3};
                        const unsigned l0 = pk2(ha[0] - bflo(h0), ha[1] - bfhi(h0)), l1 = pk2(ha[2] - bflo(h1), ha[3] - bfhi(h1)), l2 = pk2(hb[0] - bflo(h2), hb[1] - bfhi(h2)), l3 = pk2(hb[2] - bflo(h3), hb[3] - bfhi(h3));
                        const v4u hv = (v4u){h0, h1, h2, h3}, lv = (v4u){l0, l1, l2, l3};
                        const bf16x8_t ahi = __builtin_bit_cast(bf16x8_t, hv), alo = __builtin_bit_cast(bf16x8_t, lv);
                        if (rg == 0) { acc0 = __builtin_amdgcn_mfma_f32_32x32x16_bf16(wh, ahi, acc0, 0, 0, 0); acc0 = __builtin_amdgcn_mfma_f32_32x32x16_bf16(wl, ahi, acc0, 0, 0, 0); acc0 = __builtin_amdgcn_mfma_f32_32x32x16_bf16(wh, alo, acc0, 0, 0, 0); }
                        else         { acc1 = __builtin_amdgcn_mfma_f32_32x32x16_bf16(wh, ahi, acc1, 0, 0, 0); acc1 = __builtin_amdgcn_mfma_f32_32x32x16_bf16(wl, ahi, acc1, 0, 0, 0); acc1 = __builtin_amdgcn_mfma_f32_32x32x16_bf16(wh, alo, acc1, 0, 0, 0); } } }
#pragma unroll
                  for (int q = 0; q < 16; ++q) { const int e = (q & 3) + 8 * (q >> 2) + 4 * kh;
                      sm[5120 + ((wave * 2 + 0) * 32 + e) * 32 + r] = acc0[q]; sm[5120 + ((wave * 2 + 1) * 32 + e) * 32 + r] = acc1[q]; } }
                __syncthreads();
                { const int tk6 = tid & 63, eq = tid >> 6, rg = tk6 >> 5, tk = tk6 & 31;
#pragma unroll
                  for (int i = 0; i < 4; ++i) { const int e = eq * 4 + i; float s = 0.f;
#pragma unroll
                      for (int w = 0; w < 8; ++w) s += sm[5120 + ((w * 2 + rg) * 32 + e) * 32 + tk];
                      sm[5120 + 16384 + tk6 * 33 + e] = 1.f / (1.f + __expf(-s)); } }
                __syncthreads();
                if (tid < 64) { const int t = t0 + tid;
                    float lg[32];
#pragma unroll
                    for (int e = 0; e < 32; ++e) lg[e] = sm[5120 + 16384 + tid * 33 + e];
                    int grp = 0; float best = -INFINITY;
#pragma unroll
                    for (int gq = 0; gq < 4; ++gq) { float m1 = -INFINITY, m2 = -INFINITY;
#pragma unroll
                        for (int i = 0; i < 8; ++i) { const float b = lg[gq * 8 + i] + sm[4160 + gq * 8 + i]; if (b > m1) { m2 = m1; m1 = b; } else if (b > m2) m2 = b; }
                        const float sgs = m1 + m2; if (sgs > best) { best = sgs; grp = gq; } }
                    float m1 = -INFINITY, m2 = -INFINITY, s1 = 0.f, s2 = 0.f; int i1 = 0, i2 = 0;
#pragma unroll
                    for (int e = 0; e < 32; ++e) { const bool ing = (e >> 3) == grp; const float b = lg[e] + sm[4160 + e];
                        if (ing && b > m1) { m2 = m1; i2 = i1; s2 = s1; m1 = b; i1 = e; s1 = lg[e]; } else if (ing && b > m2) { m2 = b; i2 = e; s2 = lg[e]; } }
                    const float inv = 1.f / (s1 + s2);
                    const unsigned p1 = atomicAdd(CNT + i1, 1u), p2 = atomicAdd(CNT + i2, 1u);
                    TOKIDX[(size_t)i1 * ECAP + p1] = t; TOKIDX[(size_t)i2 * ECAP + p2] = t; WTS[(size_t)i1 * ECAP + p1] = s1 * inv; WTS[(size_t)i2 * ECAP + p2] = s2 * inv;
                    *(int4*)(TE + 4 * t) = make_int4(i1, (int)p1, i2, (int)p2);
                }
            }
            if (BOTH(pb + 12)) GRID_BAR();
        }
        if (IN(pb + 13)) {
            PH_IDS(); ArgsP ap = AP(); unsigned char* ws = ap->ws;
            LOAD_MOETAB((unsigned*)(CTLP(ws) + CW_CNT) + l * 32, 4);
            pg8::Gemm g{(const bf16*)(ws + WS_H), (const bf16*)(ws + WS_WGUT), 0, 0, D_}; MoeOrder<true> So{moetab, 4, G, bid, 4, l * 32 * 4, (const int*)(ws + WS_TOKIDX)};
            EpiGateUp E{(bf16*)(ws + WS_HACT)};
            pg8::gemm_phase<EpiGateUp, MoeOrder<true>, true, true>(lds, g, So, E);
            if (BOTH(pb + 13)) GRID_BAR();
        }
        if (IN(pb + 14)) {
            PH_IDS(); ArgsP ap = AP(); unsigned char* ws = ap->ws;
            LOAD_MOETAB((unsigned*)(CTLP(ws) + CW_CNT) + l * 32, 8);
            pg8::Gemm g{(const bf16*)(ws + WS_HACT), (const bf16*)(ws + WS_WDT), 0, 0, DEXP}; MoeOrder<false> So{moetab, 8, G, bid, 8, l * 32 * 8, nullptr};
            EpiDown E{(bf16*)(ws + WS_Y), (const float*)(ws + WS_WTS), moetab};
            pg8::gemm_phase<EpiDown, MoeOrder<false>, true, true>(lds, g, So, E);
            if (BOTH(pb + 14)) GRID_BAR();
        }
    }
    if (IN(NPH - 1)) {
        PH_IDS(); ArgsP ap = AP(); unsigned char* ws = ap->ws;
        float* X = ap->out; const bf16* Y = (const bf16*)(ws + WS_Y); const int* TE = (const int*)(ws + WS_TE);
        LOAD_MOETAB((unsigned*)(CTLP(ws) + CW_CNT) + 32, 1);
        const bool tmo_set = (MK_N_LAUNCHES == 1) && (__hip_atomic_load((unsigned*)(CTLP(ws) + CW_BAR) + XB_TMO, RLX_AGENT) != 0u);
        { const float* g_final = ap->in[17]; const float* MOD = (const float*)(CTLP(ws) + CW_MOD);
          for (int k = tid; k < D_; k += NTHR) { sm[k] = g_final[k]; sm[2048 + k] = MOD[12288 + 10240 + k]; } }
        __syncthreads();
        for (int t = gw; t < S_; t += NGW) {
            f32x4 v[8]; float ss = 0.f;
            const int4 te = *(const int4*)(TE + 4 * t);
            const bf16* y0 = Y + (size_t)(moetab[65 + te.x] + te.y) * D_; const bf16* y1 = Y + (size_t)(moetab[65 + te.z] + te.w) * D_;
#pragma unroll
            for (int j = 0; j < 8; ++j) { const int k = 256 * j + 4 * lane; const uint2 a = *(const uint2*)(y0 + k), b = *(const uint2*)(y1 + k);
                const f32x4 gt2 = *(const LAS f32x4*)(sm + 2048 + k);
                f32x4 ysum = (f32x4){bflo(a.x) + bflo(b.x), bfhi(a.x) + bfhi(b.x), bflo(a.y) + bflo(b.y), bfhi(a.y) + bfhi(b.y)};
                v[j] = *(const f32x4*)(X + (size_t)t * D_ + k) + gt2 * ysum;
                ss += (v[j][0] * v[j][0] + v[j][1] * v[j][1]) + (v[j][2] * v[j][2] + v[j][3] * v[j][3]); }
            const float rstd = (tmo_set ? __builtin_nanf("") : 1.f) / sqrtf(wave_sum(ss) * (1.f / D_) + RMS_EPS);
#pragma unroll
            for (int j = 0; j < 8; ++j) { const int k = 256 * j + 4 * lane; *(f32x4*)(X + (size_t)t * D_ + k) = v[j] * rstd * *(const LAS f32x4*)(sm + k); }
        }
    }
#undef IN
#undef BOTH
#undef GRID_BAR
#undef LOAD_MOETAB
#undef AP
#undef CTLP
#undef PH_IDS
}

extern "C" void kernel_launch(void* const* d_in, const int* in_sizes, int n_in, void* d_out, int out_size, void* d_ws, size_t ws_size, hipStream_t stream) {
    static int grid = 0;
    if (grid == 0) {
        if (n_in != 18 || out_size != S_ * D_ || ws_size < WS_END) { fprintf(stderr, "kernel_launch: unexpected shapes (n_in %d out %d ws %zu)\n", n_in, out_size, ws_size); grid = -1; return; }
        int dev = 0, cus = 0, per_cu = 0;
        if (hipGetDevice(&dev) != hipSuccess || hipDeviceGetAttribute(&cus, hipDeviceAttributeMultiprocessorCount, dev) != hipSuccess) { grid = -1; return; }
        if (hipFuncSetAttribute((const void*)mk_fwd, hipFuncAttributeMaxDynamicSharedMemorySize, LDS_BYTES) != hipSuccess) { fprintf(stderr, "kernel_launch: hipFuncSetAttribute failed\n"); grid = -1; return; }
        if (hipOccupancyMaxActiveBlocksPerMultiprocessor(&per_cu, (const void*)mk_fwd, NTHR, LDS_BYTES) != hipSuccess || per_cu < 1) { fprintf(stderr, "kernel_launch: occupancy query says %d\n", per_cu); }
        (void)hipGetLastError();
        grid = cus;
    }
    if (grid < 0) return;
    if (hipMemsetAsync((char*)d_ws + WS_CTL, 0, CTL_ZERO_BYTES, stream) != hipSuccess) return;
    Args a{};
    for (int i = 0; i < 18; ++i) a.in[i] = (const float*)d_in[i];
    a.out = (float*)d_out; a.ws = (unsigned char*)d_ws; a.pad = 0;
    if (MK_N_LAUNCHES == 1) {
        a.ph_lo = 0; a.ph_hi = NPH; a.li = 0;
        hipLaunchKernelGGL(mk_fwd, dim3(grid), dim3(NTHR), LDS_BYTES, stream, a);
    } else {
        for (int p = 0; p < NPH; ++p) { a.ph_lo = p; a.ph_hi = p + 1; a.li = p; hipLaunchKernelGGL(mk_fwd, dim3(grid), dim3(NTHR), LDS_BYTES, stream, a); }
    }
}
```

```cpp
#include <hip/hip_runtime.h>
#include <cstdio>
#include <cstdint>

namespace pg8 {
#define PG8_LAS __attribute__((address_space(3)))
typedef unsigned short bf16_t;
typedef short bf16x8 __attribute__((ext_vector_type(8)));
typedef float f32x4 __attribute__((ext_vector_type(4)));
typedef unsigned u32x4 __attribute__((ext_vector_type(4)));
constexpr int BM = 256, BK = 64, HALF = 128, HTB = HALF * BK * 2, STAGE_BYTES = 8 * HTB, NXCD = 8, WGM = 8;

__host__ __device__ __forceinline__ int lds_byte(int r, int c) { const int st = (r >> 4) * 2 + (c >> 5), rr = r & 15, cc = c & 31, ob = rr * 64 + cc * 2; return st * 1024 + (ob ^ (((ob >> 9) & 1) << 5)); }
__host__ __device__ __forceinline__ void stage_rc(int b, int& R, int& C) { const int st = b / 1024, sb = b % 1024, swz = sb ^ (((sb >> 9) & 1) << 5); R = (st >> 1) * 16 + swz / 64; C = (st & 1) * 32 + (swz % 64) / 2; }
__host__ __device__ __forceinline__ int perm32(int rho) { const int n = rho >> 4, i = rho & 15; return 8 * (i >> 2) + 4 * n + (i & 3); }

struct Unit { int pm, pn, e, mt, pnl; };
struct Gemm { const bf16_t* A; const bf16_t* Bt; int M, N, K; };

struct StaticOrder {
    static constexpr bool GATHER = false;
    int nM, nN, nwg, G, c;
    __host__ __device__ void init(int M, int N, int G_, int c_) { nM = M / BM; nN = N / BM; nwg = nM * nN; G = G_; c = c_; }
    __host__ __device__ bool next(int i, Unit& u) const {
        const long L = (long)i * G + c; if (L >= nwg) return false;
        int wgid = (int)L; { const int q = nwg / NXCD, r = nwg % NXCD, xcd = wgid % NXCD, off = wgid / NXCD; wgid = (xcd < r ? xcd * (q + 1) : r * (q + 1) + (xcd - r) * q) + off; }
        const int nig = WGM * nN, gid = wgid / nig, fm = gid * WGM, gsz = (nM - fm) < WGM ? (nM - fm) : WGM;
        u.pm = fm + ((wgid % nig) % gsz); u.pn = (wgid % nig) / gsz; u.e = 0; u.mt = 0; u.pnl = u.pn; return true;
    }
    __device__ __forceinline__ void a_offs(const Unit&, int, int, int, int, int, unsigned (&)[2][2]) const {}
    __device__ __forceinline__ void a_ready(const Unit&) const {}
    __device__ __forceinline__ void done(const Unit&) const {}
};

__device__ __forceinline__ unsigned cvt_pk_bf16(float lo, float hi) { unsigned r; asm volatile("v_cvt_pk_bf16_f32 %0, %1, %2" : "=v"(r) : "v"(lo), "v"(hi)); return r; }

template <class Epi, class Sched, bool ALIGN_EPI = false, bool SP2 = false>
__device__ __forceinline__ void gemm_phase(PG8_LAS unsigned char* lds, const Gemm g, const Sched& S, const Epi& E) {
    int tid_ = threadIdx.x; asm volatile("" : "+v"(tid_));
    const int tid = tid_, wid = __builtin_amdgcn_readfirstlane(tid >> 6), lane = tid & 63, wr = wid >> 2, wc = wid & 3, fr = lane & 15, fq = lane >> 4;
    const int K = g.K, nt = K / BK;
    unsigned voffA[2], voffB[2]; int RR[2], CC[2];
#pragma unroll
    for (int i = 0; i < 2; ++i) { int R, C; stage_rc(tid * 16 + i * 8192, R, C); const int Rb = Epi::PERM ? ((R & ~31) + perm32(R & 31)) : R;
        RR[i] = R; CC[i] = C; voffA[i] = (unsigned)(R * K + C) * 2u; voffB[i] = (unsigned)(Rb * K + C) * 2u; }
    const size_t kstep = (size_t)(BK * 2);
    const size_t hstep = (size_t)HALF * K * 2;
    const size_t tstep = 2 * hstep;
    const unsigned ldsw = (unsigned)wid * 1024u;
    const int aoff = lds_byte(wr * 64 + fr, fq * 8), boff = lds_byte(wc * 32 + fr, fq * 8);
    const char* gA = (const char*)g.A;
    unsigned aoC[2][2] = {{0u, 0u}, {0u, 0u}}, aoN[2][2] = {{0u, 0u}, {0u, 0u}};
#define PG8_SA(b, h) (((b) * 2 + (h)) * HTB)
#define PG8_SB(b, h) ((4 + (b) * 2 + (h)) * HTB)
#define PG8_STAGE(bufoff, gbase, voff) do { _Pragma("unroll") for (int _i = 0; _i < 2; ++_i) \
        __builtin_amdgcn_global_load_lds((const unsigned*)((const char*)(gbase) + (voff)[_i]), (PG8_LAS unsigned*)(lds + (bufoff) + ldsw + _i * 8192), 16, 0, 0); } while (0)
#define PG8_STAGE_A(bufoff, h, PN, KO) do { if constexpr (Sched::GATHER) { _Pragma("unroll") for (int _i = 0; _i < 2; ++_i) \
        __builtin_amdgcn_global_load_lds((const unsigned*)(gA + aoC[h][_i] + (KO)), (PG8_LAS unsigned*)(lds + (bufoff) + ldsw + _i * 8192), 16, 0, 0); } \
        else { PG8_STAGE(bufoff, (PN) + (h) * hstep, voffA); } } while (0)
#define PG8_LDA(dst, b, h) do { _Pragma("unroll") for (int m = 0; m < 4; ++m) _Pragma("unroll") for (int k = 0; k < 2; ++k) dst[m][k] = *(const PG8_LAS bf16x8*)(lds + PG8_SA(b, h) + aoff + m * 2048 + k * 1024); } while (0)
#define PG8_LDB(dst, b, h) do { _Pragma("unroll") for (int n = 0; n < 2; ++n) _Pragma("unroll") for (int k = 0; k < 2; ++k) dst[n][k] = *(const PG8_LAS bf16x8*)(lds + PG8_SB(b, h) + boff + n * 2048 + k * 1024); } while (0)
#define PG8_MMA(ai, bj, At, Bt) do { __builtin_amdgcn_s_setprio(1); _Pragma("unroll") for (int m = 0; m < 4; ++m) _Pragma("unroll") for (int n = 0; n < 2; ++n) _Pragma("unroll") for (int k = 0; k < 2; ++k) \
        acc[ai][bj][m][n] = __builtin_amdgcn_mfma_f32_16x16x32_bf16(Bt[n][k], At[m][k], acc[ai][bj][m][n], 0, 0, 0); __builtin_amdgcn_s_setprio(0); } while (0)
#define PG8_WAIT_V(n) asm volatile("s_waitcnt vmcnt(" #n ")" ::: "memory")
#define PG8_WAIT_L(n) asm volatile("s_waitcnt lgkmcnt(" #n ")" ::: "memory")
#define PG8_BAR __builtin_amdgcn_s_barrier()
#define PG8_SCHED __builtin_amdgcn_sched_barrier(0)
    Unit cur, nxt; int ui = 0;
    if (!S.next(0, cur)) return;
    f32x4 acc[2][2][4][2];
#pragma unroll
    for (int a = 0; a < 2; ++a)
#pragma unroll
        for (int b = 0; b < 2; ++b)
#pragma unroll
            for (int m = 0; m < 4; ++m)
#pragma unroll
                for (int n = 0; n < 2; ++n) acc[a][b][m][n] = (f32x4){0.f, 0.f, 0.f, 0.f};
    bf16x8 At[4][2], B0[2][2], B1[2][2];
    const char* cA = (const char*)g.A + (size_t)cur.pm * tstep; const char* cB = (const char*)g.Bt + (size_t)cur.pn * tstep;
    if constexpr (Sched::GATHER) S.a_offs(cur, RR[0], RR[1], CC[0], CC[1], K, aoC);
    S.a_ready(cur);
    if constexpr (SP2) {
        PG8_STAGE(PG8_SB(0, 0), cB, voffB); PG8_STAGE(PG8_SB(0, 1), cB + hstep, voffB); PG8_STAGE_A(PG8_SA(0, 0), 0, cA, 0); PG8_STAGE_A(PG8_SA(0, 1), 1, cA, 0);
        if (wr == 1) PG8_BAR;
        PG8_WAIT_V(2); PG8_BAR;
        PG8_STAGE(PG8_SB(1, 0), cB + kstep, voffB); PG8_STAGE_A(PG8_SA(1, 0), 0, cA + kstep, kstep); PG8_STAGE(PG8_SB(1, 1), cB + hstep + kstep, voffB);
        PG8_WAIT_V(6); PG8_BAR;
    } else {
        PG8_STAGE(PG8_SB(0, 0), cB, voffB); PG8_STAGE_A(PG8_SA(0, 0), 0, cA, 0); PG8_STAGE(PG8_SB(0, 1), cB + hstep, voffB); PG8_STAGE_A(PG8_SA(0, 1), 1, cA, 0);
        if (wr == 1) PG8_BAR;
        PG8_WAIT_V(4); PG8_BAR;
        PG8_STAGE(PG8_SB(1, 0), cB + kstep, voffB); PG8_STAGE_A(PG8_SA(1, 0), 0, cA + kstep, kstep); PG8_STAGE(PG8_SB(1, 1), cB + hstep + kstep, voffB);
        PG8_WAIT_V(6); PG8_BAR;
    }
    for (;;) {
        const bool has_next = S.next(ui + 1, nxt);
        const char* nA = has_next ? (const char*)g.A + (size_t)nxt.pm * tstep : cA; const char* nB = has_next ? (const char*)g.Bt + (size_t)nxt.pn * tstep : cB;
        if constexpr (Sched::GATHER) {
            if (has_next) S.a_offs(nxt, RR[0], RR[1], CC[0], CC[1], K, aoN);
            else {
#pragma unroll
                for (int h = 0; h < 2; ++h)
#pragma unroll
                    for (int i = 0; i < 2; ++i) aoN[h][i] = aoC[h][i]; }
        }
        for (int t = 0; t < nt; t += 2) {
            const bool last = (t == nt - 2);
            const char* a1 = cA + (size_t)(t + 1) * kstep;
            const char* a2 = last ? nA : cA + (size_t)(t + 2) * kstep; const char* b2 = last ? nB : cB + (size_t)(t + 2) * kstep;
            const char* a3 = a2 + kstep; const char* b3 = b2 + kstep;
            const size_t k1 = (size_t)(t + 1) * kstep, k2 = last ? (size_t)0 : (size_t)(t + 2) * kstep, k3 = k2 + kstep;
            if (last && has_next) S.a_ready(nxt);
            if constexpr (SP2) {
            PG8_LDB(B0, 0, 0); PG8_LDB(B1, 0, 1); PG8_SCHED; PG8_LDA(At, 0, 0); PG8_STAGE_A(PG8_SA(1, 1), 1, a1, k1);
            if constexpr (Sched::GATHER) { if (last) {
#pragma unroll
                for (int h = 0; h < 2; ++h)
#pragma unroll
                    for (int i = 0; i < 2; ++i) aoC[h][i] = aoN[h][i]; } }
            PG8_WAIT_V(8); PG8_WAIT_L(0); PG8_BAR; PG8_MMA(0, 0, At, B0); PG8_MMA(0, 1, At, B1); PG8_BAR; PG8_SCHED;
            PG8_LDA(At, 0, 1); PG8_STAGE(PG8_SB(0, 0), b2, voffB); PG8_STAGE(PG8_SB(0, 1), b2 + hstep, voffB); PG8_STAGE_A(PG8_SA(0, 0), 0, a2, k2);
            PG8_WAIT_V(8); PG8_WAIT_L(0); PG8_BAR; PG8_MMA(1, 0, At, B0); PG8_MMA(1, 1, At, B1); PG8_BAR; PG8_SCHED;
            PG8_LDB(B0, 1, 0); PG8_LDB(B1, 1, 1); PG8_SCHED; PG8_LDA(At, 1, 0); PG8_STAGE_A(PG8_SA(0, 1), 1, a2, k2);
            PG8_WAIT_V(8); PG8_WAIT_L(0); PG8_BAR; PG8_MMA(0, 0, At, B0); PG8_MMA(0, 1, At, B1); PG8_BAR; PG8_SCHED;
            PG8_LDA(At, 1, 1); PG8_STAGE(PG8_SB(1, 0), b3, voffB); PG8_STAGE(PG8_SB(1, 1), b3 + hstep, voffB); PG8_STAGE_A(PG8_SA(1, 0), 0, a3, k3);
            PG8_WAIT_V(8); PG8_WAIT_L(0); PG8_BAR; PG8_MMA(1, 0, At, B0); PG8_MMA(1, 1, At, B1); PG8_BAR; PG8_SCHED;
            } else {
            PG8_LDB(B0, 0, 0); PG8_SCHED; PG8_LDA(At, 0, 0); PG8_STAGE_A(PG8_SA(1, 1), 1, a1, k1);
            if constexpr (Sched::GATHER) { if (last) {
#pragma unroll
                for (int h = 0; h < 2; ++h)
#pragma unroll
                    for (int i = 0; i < 2; ++i) aoC[h][i] = aoN[h][i]; } }
            PG8_WAIT_L(8); PG8_BAR; PG8_WAIT_L(0); PG8_MMA(0, 0, At, B0); PG8_BAR; PG8_SCHED;
            PG8_LDB(B1, 0, 1); PG8_STAGE(PG8_SB(0, 0), b2, voffB);
            PG8_BAR; PG8_WAIT_L(0); PG8_MMA(0, 1, At, B1); PG8_BAR;
            PG8_LDA(At, 0, 1); PG8_STAGE_A(PG8_SA(0, 0), 0, a2, k2);
            PG8_BAR; PG8_WAIT_L(0); PG8_MMA(1, 0, At, B0); PG8_BAR; PG8_SCHED;
            PG8_STAGE(PG8_SB(0, 1), b2 + hstep, voffB);
            PG8_WAIT_V(6); PG8_BAR; PG8_MMA(1, 1, At, B1); PG8_BAR;
            PG8_LDB(B0, 1, 0); PG8_SCHED; PG8_LDA(At, 1, 0); PG8_STAGE_A(PG8_SA(0, 1), 1, a2, k2);
            PG8_WAIT_L(8); PG8_BAR; PG8_WAIT_L(0); PG8_MMA(0, 0, At, B0); PG8_BAR; PG8_SCHED;
            PG8_LDB(B1, 1, 1); PG8_STAGE(PG8_SB(1, 0), b3, voffB);
            PG8_BAR; PG8_WAIT_L(0); PG8_MMA(0, 1, At, B1); PG8_BAR;
            PG8_LDA(At, 1, 1); PG8_STAGE_A(PG8_SA(1, 0), 0, a3, k3);
            PG8_BAR; PG8_WAIT_L(0); PG8_MMA(1, 0, At, B0); PG8_BAR; PG8_SCHED;
            PG8_STAGE(PG8_SB(1, 1), b3 + hstep, voffB);
            PG8_WAIT_V(6); PG8_BAR; PG8_MMA(1, 1, At, B1); PG8_BAR;
            }
        }
        if constexpr (ALIGN_EPI) { if (wr == 0) PG8_BAR; }
        E(acc, cur, wr, wc, fr, fq); S.done(cur);
        if (!has_next) break;
#pragma unroll
        for (int a = 0; a < 2; ++a)
#pragma unroll
            for (int b = 0; b < 2; ++b)
#pragma unroll
                for (int m = 0; m < 4; ++m)
#pragma unroll
                    for (int n = 0; n < 2; ++n) acc[a][b][m][n] = (f32x4){0.f, 0.f, 0.f, 0.f};
        cur = nxt; cA = nA; cB = nB; ++ui;
        if constexpr (ALIGN_EPI) { if (wr == 1) PG8_BAR; }
    }
    PG8_WAIT_V(0);
    if constexpr (!ALIGN_EPI) { if (wr == 0) PG8_BAR; }
    PG8_BAR;
#undef PG8_SA
#undef PG8_SB
#undef PG8_STAGE
#undef PG8_STAGE_A
#undef PG8_LDA
#undef PG8_LDB
#undef PG8_MMA
#undef PG8_WAIT_V
#undef PG8_WAIT_L
#undef PG8_BAR
#undef PG8_SCHED
}
}

#ifndef MK_N_LAUNCHES
#define MK_N_LAUNCHES 1
#endif
constexpr int NWAVES = 8, NTHR = 512;
constexpr int S_ = 16384, D_ = 2048, DEPTH = 2, HD = 128;
constexpr int IN_W = 5656, NIN = 5888;
constexpr int NC = 1023;
constexpr int NEXP = 32, DEXP = 512, ECAP = 16384, NSLOT = 40960;
constexpr float RMS_EPS = 1e-6f;
constexpr float ATT_SCALE = 0.08838834764831845f;
constexpr int NPL = 15, NPH = 2 + 2 * NPL;

constexpr size_t MiB = 1u << 20;
constexpr size_t WS_CTL = 0, CTL_ZERO_BYTES = 1 * MiB;
constexpr size_t WS_ROPE = 1 * MiB, WS_WINT = 9 * MiB, WS_WOUTT = 55 * MiB, WS_WGUT = 71 * MiB, WS_WDT = 327 * MiB, WS_WC1T = 455 * MiB;
constexpr size_t WS_H = 463 * MiB, WS_QN = 527 * MiB, WS_QM = 559 * MiB, WS_KM = 591 * MiB, WS_VM = 623 * MiB;
constexpr size_t WS_KC = 655 * MiB, WS_VC = 663 * MiB, WS_KS = 671 * MiB, WS_VS = 679 * MiB, WS_KW = 687 * MiB, WS_VW = 695 * MiB;
constexpr size_t WS_GATES = 703 * MiB, WS_UL = 705 * MiB, WS_KCMP = 713 * MiB, WS_VCMP = 713 * MiB + 512 * 1024, WS_KMEAN = 714 * MiB;
constexpr size_t WS_OMIX = 715 * MiB, WS_OCMP = 779 * MiB, WS_OWIN = 811 * MiB, WS_SEL = 843 * MiB, WS_TE = 845 * MiB, WS_TOKIDX = 846 * MiB, WS_WTS = 848 * MiB;
constexpr size_t WS_HACT = 850 * MiB, WS_Y = 890 * MiB;
constexpr size_t WS_WRT = 714 * MiB + 256 * 1024;
constexpr size_t WS_IMP = WS_H + 32 * MiB;
constexpr size_t WS_NLIST = WS_H, WS_PSLC = 850 * MiB, WS_LSEN = 1106 * MiB;
constexpr size_t WS_MLIST = 1050 * MiB, WS_PSEL = 1082 * MiB, WS_POWN = 1178 * MiB, WS_LSES = 1210 * MiB, WS_LSEO = 1211 * MiB + 512 * 1024, WS_END = 1212 * MiB;
constexpr int CW_TMO = 0, CW_BAR = 4096, CW_CNT = 8192, CW_MCNT = 8704, CW_NCNT = 9728, CW_MOD = 16384, CW_B1E = 40960;

constexpr int RING_BYTES = 131072, LDSCTL_OFF = RING_BYTES, MISC_OFF = LDSCTL_OFF + 320, MOETAB_OFF = LDSCTL_OFF + 512, LDS_BYTES = 147456;

#define GAS __attribute__((address_space(1)))
#define LAS __attribute__((address_space(3)))
typedef unsigned short bf16;
typedef unsigned v4u __attribute__((ext_vector_type(4)));
typedef float f32x4 __attribute__((ext_vector_type(4)));
typedef float f32x2 __attribute__((ext_vector_type(2)));
typedef GAS unsigned gu32;
#define RLX_AGENT __ATOMIC_RELAXED, __HIP_MEMORY_SCOPE_AGENT
#define LDS_WAIT() asm volatile("s_waitcnt lgkmcnt(0)" ::: "memory")
__device__ __forceinline__ unsigned f2bf(float f) { unsigned u = __builtin_bit_cast(unsigned, f); return (u + 0x7fffu + ((u >> 16) & 1u)) >> 16; }
__device__ __forceinline__ unsigned pk2(float lo, float hi) { return f2bf(lo) | (f2bf(hi) << 16); }
__device__ __forceinline__ float bf2f(unsigned b) { return __builtin_bit_cast(float, b << 16); }
__device__ __forceinline__ float bflo(unsigned w) { return __builtin_bit_cast(float, w << 16); }
__device__ __forceinline__ float bfhi(unsigned w) { return __builtin_bit_cast(float, w & 0xffff0000u); }

#define XB_TMO      128
#define XB_XCNT(j)  (256  + 64 * (j))
#define XB_XSUB(j)  (1280 + 64 * (j))
#define XB_XGEN(j)  (2304 + 64 * (j))
#define XB_TOP      3328
#define XB_TOPGEN   3392
#define XCD_BAR_WORDS 3456
#define XB_SPIN_CAP (1u << 23)
__device__ __forceinline__ unsigned xb_ld(unsigned* p)              { return __hip_atomic_load(p, __ATOMIC_RELAXED, __HIP_MEMORY_SCOPE_AGENT); }
__device__ __forceinline__ unsigned xb_add(unsigned* p, unsigned v) { return __hip_atomic_fetch_add(p, v, __ATOMIC_RELAXED, __HIP_MEMORY_SCOPE_AGENT); }
__device__ __forceinline__ unsigned xb_xcc_id() { return (unsigned)__builtin_amdgcn_s_getreg((3 << 11) | 20) & 0xFu; }
#define XB_SPIN(cond, bar) do { unsigned _sp = 0; while (cond) { __builtin_amdgcn_s_sleep(1); \
    if ((++_sp & 255u) == 0u) { if (xb_ld(&(bar)[XB_TMO])) break; if (_sp > XB_SPIN_CAP) { atomicAdd(&(bar)[XB_TMO], 1u); break; } } } } while (0)
struct XcdBarrier { unsigned* bar; unsigned x; volatile LAS unsigned* st; };
__device__ __forceinline__ XcdBarrier xcd_barrier_post(unsigned* bar, volatile LAS unsigned* st) {
    XcdBarrier b; b.bar = bar; b.x = xb_xcc_id(); b.st = st;
    if (threadIdx.x == 0) (void)xb_add(&bar[XB_XCNT(b.x)], 1u);
    return b;
}
__device__ __forceinline__ void xcd_barrier_complete(unsigned* bar, unsigned x, unsigned& nloc, unsigned& nx) {
    const unsigned G = gridDim.x * gridDim.y * gridDim.z;
    unsigned sum, cnt, mine, sp = 0u;
    for (;;) {
        sum = 0u; cnt = 0u; mine = 0u;
#pragma unroll
        for (unsigned j = 0; j < 16; ++j) { const unsigned c = xb_ld(&bar[XB_XCNT(j)]); sum += c; cnt += (c > 0u) ? 1u : 0u; mine = (j == x) ? c : mine; }
        if (sum == G) break;
        __builtin_amdgcn_s_sleep(1);
        if ((++sp & 255u) == 0u) { if (xb_ld(&bar[XB_TMO])) break; if (sp > XB_SPIN_CAP) { atomicAdd(&bar[XB_TMO], 1u); break; } }
    }
    nloc = mine > 0u ? mine : 1u; nx = cnt > 0u ? cnt : 1u;
}
__device__ __forceinline__ void xcd_barrier(const XcdBarrier& b) {
    asm volatile("s_waitcnt vmcnt(0)" ::: "memory");
    __syncthreads();
    if (threadIdx.x == 0) {
        unsigned* bar = b.bar;
        __builtin_amdgcn_s_waitcnt(0);
        unsigned nloc = b.st[0], nx = b.st[1];
        if (nloc == 0u) { xcd_barrier_complete(bar, b.x, nloc, nx); b.st[0] = nloc; b.st[1] = nx; }
        const unsigned old = xb_add(&bar[XB_XSUB(b.x)], 1u);
        const unsigned gen = old / nloc;
        if (old + 1u == (gen + 1u) * nloc) {
            __builtin_amdgcn_fence(__ATOMIC_RELEASE, "agent");
            asm volatile("s_waitcnt vmcnt(0)" ::: "memory");
            const unsigned og = xb_add(&bar[XB_TOP], 1u);
            const unsigned tg = og / nx;
            if (og + 1u == (tg + 1u) * nx) xb_add(&bar[XB_TOPGEN], 1u);
            else XB_SPIN(xb_ld(&bar[XB_TOPGEN]) == tg, bar);
            __builtin_amdgcn_fence(__ATOMIC_ACQUIRE, "agent");
            xb_add(&bar[XB_XGEN(b.x)], 1u);
            asm volatile("s_waitcnt vmcnt(0)" ::: "memory");
        } else {
            XB_SPIN(xb_ld(&bar[XB_XGEN(b.x)]) == gen, bar);
            __builtin_amdgcn_fence(__ATOMIC_ACQUIRE, "agent");
            asm volatile("s_waitcnt vmcnt(0)" ::: "memory");
        }
    }
    __syncthreads();
}

__device__ __forceinline__ float wave_sum(float v) {
#pragma unroll
    for (int o = 1; o < 64; o <<= 1) v += __shfl_xor(v, o);
    return v;
}
__device__ __forceinline__ float wave_max(float v) {
#pragma unroll
    for (int o = 1; o < 64; o <<= 1) v = fmaxf(v, __shfl_xor(v, o));
    return v;
}


__device__ __forceinline__ float row_max16(float v) {
    v = fmaxf(v, __builtin_bit_cast(float, __builtin_amdgcn_update_dpp(0, __builtin_bit_cast(int, v), 0xB1, 0xF, 0xF, false)));
    v = fmaxf(v, __builtin_bit_cast(float, __builtin_amdgcn_update_dpp(0, __builtin_bit_cast(int, v), 0x4E, 0xF, 0xF, false)));
    v = fmaxf(v, __builtin_bit_cast(float, __builtin_amdgcn_update_dpp(0, __builtin_bit_cast(int, v), 0x124, 0xF, 0xF, false)));
    v = fmaxf(v, __builtin_bit_cast(float, __builtin_amdgcn_update_dpp(0, __builtin_bit_cast(int, v), 0x128, 0xF, 0xF, false)));
    return v;
}
__device__ __forceinline__ int row_min16(int v) {
    v = min(v, __builtin_amdgcn_update_dpp(0, v, 0xB1, 0xF, 0xF, false));
    v = min(v, __builtin_amdgcn_update_dpp(0, v, 0x4E, 0xF, 0xF, false));
    v = min(v, __builtin_amdgcn_update_dpp(0, v, 0x124, 0xF, 0xF, false));
    v = min(v, __builtin_amdgcn_update_dpp(0, v, 0x128, 0xF, 0xF, false));
    return v;
}
template <int NV>
__device__ __forceinline__ int row_pick(float (&v)[NV], int lam) {
    float m = v[0];
#pragma unroll
    for (int i = 1; i < NV; ++i) m = fmaxf(m, v[i]);
    m = row_max16(m);
    int idx = 1 << 20;
#pragma unroll
    for (int i = NV - 1; i >= 0; --i) idx = (v[i] == m) ? lam + 16 * i : idx;
    idx = row_min16(idx);
    if (m == -INFINITY) idx = -1;
#pragma unroll
    for (int i = 0; i < NV; ++i) v[i] = (lam + 16 * i == idx) ? -INFINITY : v[i];
    return idx;
}

__device__ __forceinline__ int il(int d) { return (d < 64) ? 2 * d : 2 * (d - 64) + 1; }
__device__ __forceinline__ int inproj_row(int s) {
    if (s < 1024) return (s & ~127) + il(s & 127);
    if (s < 1536) return s;
    if (s < 1792) return (s & ~127) + il(s & 127);
    if (s < 2048) return s;
    if (s < 2304) return (s & ~127) + il(s & 127);
    if (s < 2560) return s;
    if (s < 2584) return 5632 + (s - 2560);
    if (s < 3608) { const int r = s - 2584; return 2560 + (r & ~127) + il(r & 127); }
    if (s < 4632) { const int r = s - 3608; return 3584 + (r & ~127) + il(r & 127); }
    return 4608 + (s - 4632);
}
template <int MODE>
__device__ __forceinline__ void transpose_item(const float* W, int K, int N, bf16* WT, int dpitch, int row_off, LAS float* scr, int item, int lane) {
    const int nblk = (N + 31) / 32, kb = item / nblk, nb = item % nblk, k0 = 64 * kb, n0 = 32 * nb;
    const int nsrc = n0 + (lane & 31);
#pragma unroll 8
    for (int i = 0; i < 32; ++i) { const int kk = 2 * i + (lane >> 5); scr[kk * 33 + (lane & 31)] = (nsrc < N) ? W[(size_t)(k0 + kk) * N + nsrc] : 0.f; }
    LDS_WAIT(); asm volatile("" ::: "memory");
    const int c = lane & 7;
#pragma unroll
    for (int j = 0; j < 4; ++j) { const int nl = (lane >> 3) + 8 * j, n = n0 + nl; const LAS float* s = scr + (8 * c) * 33 + nl;
        v4u o; o.x = pk2(s[0 * 33], s[1 * 33]); o.y = pk2(s[2 * 33], s[3 * 33]); o.z = pk2(s[4 * 33], s[5 * 33]); o.w = pk2(s[6 * 33], s[7 * 33]);
        if (n < N) { int dr;
            if (MODE == 0) dr = n; else if (MODE == 1) dr = inproj_row(n); else if (MODE == 2) dr = (n >> 7) * 256 + (n & 127); else dr = (n >> 7) * 256 + 128 + (n & 127);
            *(GAS v4u*)(WT + (size_t)(row_off + dr) * dpitch + k0 + 8 * c) = o; } }
    LDS_WAIT(); asm volatile("" ::: "memory");
}

using pg8::Unit;
struct EpiInProj {
    static constexpr bool PERM = true;
    bf16 *QN, *KC, *VC, *KS, *VS, *KW, *VW, *QM, *KM, *VM; float* GATES; const float* rope;
    __device__ __forceinline__ void operator()(const f32x4 (&acc)[2][2][4][2], const Unit& u, int wr, int wc, int fr, int fq) const {
        const int pn = u.pn, row0 = u.pm * 256 + wr * 64 + fr, c8 = wc * 32 + 8 * fq;
        if (pn == 22) {
            if (c8 < 24) {
#pragma unroll
                for (int ai = 0; ai < 2; ++ai)
#pragma unroll
                    for (int m = 0; m < 4; ++m) { const int row = row0 + ai * 128 + m * 16; float* gp = GATES + (size_t)row * 32 + c8;
                        f32x4 a = acc[ai][0][m][0], b = acc[ai][0][m][1], ga, gb;
#pragma unroll
                        for (int j = 0; j < 4; ++j) { ga[j] = 1.f / (1.f + __expf(-a[j])); gb[j] = 1.f / (1.f + __expf(-b[j])); }
                        *(f32x4*)gp = ga; *(f32x4*)(gp + 4) = gb; }
            }
            return;
        }
        bf16* base; int pitch; size_t bjs; bool rot;
        if (pn < 4)       { base = QN + pn * 256;        pitch = 1024; bjs = 128; rot = true; }
        else if (pn == 4) { base = KC;                   pitch = 128;  bjs = (size_t)S_ * 128; rot = false; }
        else if (pn == 5) { base = VC;                   pitch = 128;  bjs = (size_t)S_ * 128; rot = false; }
        else if (pn == 6) { base = KS;                   pitch = 256;  bjs = 128; rot = true; }
        else if (pn == 7) { base = VS;                   pitch = 256;  bjs = 128; rot = false; }
        else if (pn == 8) { base = KW;                   pitch = 256;  bjs = 128; rot = true; }
        else if (pn == 9) { base = VW;                   pitch = 256;  bjs = 128; rot = false; }
        else if (pn < 14) { base = QM + (pn - 10) * 256; pitch = 1024; bjs = 128; rot = true; }
        else if (pn < 18) { base = KM + (pn - 14) * 256; pitch = 1024; bjs = 128; rot = true; }
        else              { base = VM + (pn - 18) * 256; pitch = 1024; bjs = 128; rot = false; }
#pragma unroll
        for (int ai = 0; ai < 2; ++ai)
#pragma unroll
            for (int m = 0; m < 4; ++m) { const int row = row0 + ai * 128 + m * 16;
                f32x4 t0 = (f32x4){1.f, 0.f, 1.f, 0.f}, t1 = t0;
                if (rot) { const f32x4* tp = (const f32x4*)(rope + (size_t)row * 128 + (c8 >> 1) * 2); t0 = tp[0]; t1 = tp[1]; }
#pragma unroll
                for (int bj = 0; bj < 2; ++bj) { f32x4 v0 = acc[ai][bj][m][0], v1 = acc[ai][bj][m][1];
                    if (rot) { f32x4 w0, w1;
                        w0[0] = v0[0] * t0[0] - v0[1] * t0[1]; w0[1] = v0[1] * t0[0] + v0[0] * t0[1]; w0[2] = v0[2] * t0[2] - v0[3] * t0[3]; w0[3] = v0[3] * t0[2] + v0[2] * t0[3];
                        w1[0] = v1[0] * t1[0] - v1[1] * t1[1]; w1[1] = v1[1] * t1[0] + v1[0] * t1[1]; w1[2] = v1[2] * t1[2] - v1[3] * t1[3]; w1[3] = v1[3] * t1[2] + v1[2] * t1[3];
                        v0 = w0; v1 = w1; }
                    pg8::u32x4 w; w.x = pg8::cvt_pk_bf16(v0[0], v0[1]); w.y = pg8::cvt_pk_bf16(v0[2], v0[3]); w.z = pg8::cvt_pk_bf16(v1[0], v1[1]); w.w = pg8::cvt_pk_bf16(v1[2], v1[3]);
                    *(pg8::u32x4*)(base + (size_t)row * pitch + bj * bjs + c8) = w; } }
    }
};
struct EpiOutProj {
    static constexpr bool PERM = false;
    const float* xsrc; float* X; const float* gt;
    __device__ __forceinline__ void operator()(const f32x4 (&acc)[2][2][4][2], const Unit& u, int wr, int wc, int fr, int fq) const {
        const int row0 = u.pm * 256 + wr * 64 + fr, col0 = u.pnl * 256 + wc * 32 + 4 * fq;
        f32x4 gv[2][2];
#pragma unroll
        for (int bj = 0; bj < 2; ++bj)
#pragma unroll
            for (int n = 0; n < 2; ++n) gv[bj][n] = *(const f32x4*)(gt + col0 + bj * 128 + n * 16);
#pragma unroll
        for (int ai = 0; ai < 2; ++ai)
#pragma unroll
            for (int m = 0; m < 4; ++m) { const size_t ro = (size_t)(row0 + ai * 128 + m * 16) * D_ + col0;
#pragma unroll
                for (int bj = 0; bj < 2; ++bj)
#pragma unroll
                    for (int n = 0; n < 2; ++n) { const f32x4 xv = *(const f32x4*)(xsrc + ro + bj * 128 + n * 16); *(f32x4*)(X + ro + bj * 128 + n * 16) = xv + gv[bj][n] * acc[ai][bj][m][n]; } }
    }
};
struct EpiF32 {
    static constexpr bool PERM = false;
    float* C; int ldc;
    __device__ __forceinline__ void operator()(const f32x4 (&acc)[2][2][4][2], const Unit& u, int wr, int wc, int fr, int fq) const {
        const int row0 = u.pm * 256 + wr * 64 + fr, col0 = u.pnl * 256 + wc * 32 + 4 * fq;
#pragma unroll
        for (int ai = 0; ai < 2; ++ai)
#pragma unroll
            for (int m = 0; m < 4; ++m) { float* rowp = C + (size_t)(row0 + ai * 128 + m * 16) * ldc + col0;
#pragma unroll
                for (int bj = 0; bj < 2; ++bj)
#pragma unroll
                    for (int n = 0; n < 2; ++n) *(f32x4*)(rowp + bj * 128 + n * 16) = acc[ai][bj][m][n]; }
    }
};
struct EpiGateUp {
    static constexpr bool PERM = true;
    bf16* HACT;
    __device__ __forceinline__ void operator()(const f32x4 (&acc)[2][2][4][2], const Unit& u, int wr, int wc, int fr, int fq) const {
        const int row0 = u.pm * 256 + wr * 64 + fr, col0 = u.pnl * 128 + wc * 32 + 8 * fq;
#pragma unroll
        for (int ai = 0; ai < 2; ++ai)
#pragma unroll
            for (int m = 0; m < 4; ++m) { const int row = row0 + ai * 128 + m * 16; f32x4 h[2];
#pragma unroll
                for (int n = 0; n < 2; ++n)
#pragma unroll
                    for (int j = 0; j < 4; ++j) { const float gg = acc[ai][0][m][n][j], uu = acc[ai][1][m][n][j]; h[n][j] = gg / (1.f + __expf(-gg)) * uu; }
                pg8::u32x4 w; w.x = pg8::cvt_pk_bf16(h[0][0], h[0][1]); w.y = pg8::cvt_pk_bf16(h[0][2], h[0][3]); w.z = pg8::cvt_pk_bf16(h[1][0], h[1][1]); w.w = pg8::cvt_pk_bf16(h[1][2], h[1][3]);
                *(pg8::u32x4*)(HACT + (size_t)row * DEXP + col0) = w; }
    }
};
struct EpiDown {
    static constexpr bool PERM = true;
    bf16* Y; const float* WTS; const LAS int* tab;
    __device__ __forceinline__ void operator()(const f32x4 (&acc)[2][2][4][2], const Unit& u, int wr, int wc, int fr, int fq) const {
        const int rl0 = wr * 64 + fr, col0 = u.pnl * 256 + wc * 32 + 8 * fq, cnt = tab[u.e];
#pragma unroll
        for (int ai = 0; ai < 2; ++ai)
#pragma unroll
            for (int m = 0; m < 4; ++m) { const int rl = rl0 + ai * 128 + m * 16, pos = u.mt * 256 + rl;
                const float w = (pos < cnt) ? WTS[(size_t)u.e * ECAP + pos] : 0.f;
                bf16* rowp = Y + (size_t)(u.pm * 256 + rl) * D_ + col0;
#pragma unroll
                for (int bj = 0; bj < 2; ++bj) { const f32x4 v0 = acc[ai][bj][m][0] * w, v1 = acc[ai][bj][m][1] * w;
                    pg8::u32x4 o; o.x = pg8::cvt_pk_bf16(v0[0], v0[1]); o.y = pg8::cvt_pk_bf16(v0[2], v0[3]); o.z = pg8::cvt_pk_bf16(v1[0], v1[1]); o.w = pg8::cvt_pk_bf16(v1[2], v1[3]);
                    *(pg8::u32x4*)(rowp + bj * 128) = o; } }
    }
};

struct CompressOrder {
    static constexpr bool GATHER = false;
    int G, c;
    __device__ bool next(int i, Unit& u) const { const int L = i * G + c; if (L >= 32) return false; u.pm = L >> 1; u.pnl = L & 1; u.pn = (u.pm >= 8 ? 2 : 0) + u.pnl; u.e = 0; u.mt = 0; return true; }
    __device__ __forceinline__ void a_offs(const Unit&, int, int, int, int, int, unsigned (&)[2][2]) const {}
    __device__ __forceinline__ void a_ready(const Unit&) const {}
    __device__ __forceinline__ void done(const Unit&) const {}
};
template <bool GATHER_>
struct MoeOrder {
    static constexpr bool GATHER = GATHER_;
    const LAS int* tab; int NT, G, c, bt_per_e, bt_base; const int* tokidx;
    __device__ bool next(int i, Unit& u) const {
        const int L = i * G + c; if (L >= tab[64]) return false;
        int e = 0;
        for (int k = 1; k < NEXP; ++k) e += (L >= tab[32 + k]) ? 1 : 0;
        e = __builtin_amdgcn_readfirstlane(e);
        const int r = L - tab[32 + e];
        u.e = e; u.mt = r / NT; u.pnl = r % NT; u.pn = bt_base + e * bt_per_e + u.pnl; u.pm = (tab[65 + e] >> 8) + u.mt; return true;
    }
    __device__ __forceinline__ void a_offs(const Unit& u, int R0, int R1, int C0, int C1, int K, unsigned (&o)[2][2]) const {
        const int cnt = tab[u.e]; const int* tk = tokidx + (size_t)u.e * ECAP;
#pragma unroll
        for (int h = 0; h < 2; ++h) {
            int p0 = u.mt * 256 + h * 128 + R0, p1 = u.mt * 256 + h * 128 + R1; p0 = p0 < cnt ? p0 : cnt - 1; p1 = p1 < cnt ? p1 : cnt - 1;
            o[h][0] = ((unsigned)tk[p0] * (unsigned)K + (unsigned)C0) * 2u; o[h][1] = ((unsigned)tk[p1] * (unsigned)K + (unsigned)C1) * 2u; }
    }
    __device__ __forceinline__ void a_ready(const Unit&) const {}
    __device__ __forceinline__ void done(const Unit&) const {}
};

constexpr int SM_Q = 0, SM_P = 512, SM_KP = 4608, SM_RED = 5632, SM_PART = 5696, SM_MISC = 6208;
template <int NH, class KeyFn>
__device__ __forceinline__ float naive_attend(LAS float* sm, int tid, int nkeys, const KeyFn keyfn, const bf16* Kb, int kpitch, const bf16* Vb, int vpitch) {
    LAS int* kp = (LAS int*)(sm + SM_KP);
    const int lane = tid & 63, wave = tid >> 6;
    float sc[NH][2];
#pragma unroll
    for (int i = 0; i < 2; ++i) {
        const int kk = tid + 512 * i; const int kpos = (kk < nkeys) ? keyfn(kk) : -1; kp[kk] = kpos;
        float a[NH];
#pragma unroll
        for (int h = 0; h < NH; ++h) a[h] = 0.f;
        if (kpos >= 0) { const v4u* kr = (const v4u*)(Kb + (size_t)kpos * kpitch);
#pragma unroll 4
            for (int c = 0; c < 16; ++c) { const v4u kv = kr[c];
                const float k0 = bflo(kv.x), k1 = bfhi(kv.x), k2 = bflo(kv.y), k3 = bfhi(kv.y), k4 = bflo(kv.z), k5 = bfhi(kv.z), k6 = bflo(kv.w), k7 = bfhi(kv.w);
#pragma unroll
                for (int h = 0; h < NH; ++h) { const f32x4 qa = *(const LAS f32x4*)(sm + SM_Q + h * 128 + 8 * c), qb = *(const LAS f32x4*)(sm + SM_Q + h * 128 + 8 * c + 4);
                    a[h] += qa[0] * k0 + qa[1] * k1 + qa[2] * k2 + qa[3] * k3 + qb[0] * k4 + qb[1] * k5 + qb[2] * k6 + qb[3] * k7; } } }
#pragma unroll
        for (int h = 0; h < NH; ++h) sc[h][i] = (kpos >= 0) ? a[h] * ATT_SCALE : -INFINITY;
    }
#pragma unroll
    for (int h = 0; h < NH; ++h) { const float m = wave_max(fmaxf(sc[h][0], sc[h][1])); if (lane == 0) sm[SM_RED + wave * NH + h] = m; }
    __syncthreads();
    float mx[NH];
#pragma unroll
    for (int h = 0; h < NH; ++h) { float m = sm[SM_RED + h];
#pragma unroll
        for (int w = 1; w < 8; ++w) m = fmaxf(m, sm[SM_RED + w * NH + h]); mx[h] = m; }
    __syncthreads();
#pragma unroll
    for (int h = 0; h < NH; ++h) {
#pragma unroll
        for (int i = 0; i < 2; ++i) sc[h][i] = (sc[h][i] == -INFINITY) ? 0.f : __expf(sc[h][i] - mx[h]);
        const float s = wave_sum(sc[h][0] + sc[h][1]); if (lane == 0) sm[SM_RED + wave * NH + h] = s; }
    __syncthreads();
#pragma unroll
    for (int h = 0; h < NH; ++h) { float s = 0.f;
#pragma unroll
        for (int w = 0; w < 8; ++w) s += sm[SM_RED + w * NH + h];
        const float inv = s > 0.f ? 1.f / s : 0.f;
#pragma unroll
        for (int i = 0; i < 2; ++i) sm[SM_P + h * 1024 + tid + 512 * i] = sc[h][i] * inv; }
    __syncthreads();
    const int d = tid & 127, hs = tid >> 7;
    float o = 0.f;
    {
        const int hrow = (NH == 4) ? hs * 1024 : 0;
        const int k0 = (NH == 4) ? 0 : hs * 256, k1 = (NH == 4) ? nkeys : ((k0 + 256 < nkeys) ? k0 + 256 : nkeys);
        for (int kb = k0; kb < k1; kb += 8) {
            int kq[8]; float pq[8], vq[8];
#pragma unroll
            for (int j = 0; j < 8; ++j) { const int kpos = kp[kb + j]; pq[j] = (kpos >= 0 && kb + j < k1) ? sm[SM_P + hrow + kb + j] : 0.f; kq[j] = kpos >= 0 ? kpos : 0; }
#pragma unroll
            for (int j = 0; j < 8; ++j) vq[j] = bf2f(Vb[(size_t)kq[j] * vpitch + d]);
#pragma unroll
            for (int j = 0; j < 8; ++j) o += pq[j] * vq[j];
        }
    }
    if (NH == 1) {
        sm[SM_PART + tid] = o; __syncthreads();
        if (tid < 128) o = sm[SM_PART + tid] + sm[SM_PART + 128 + tid] + sm[SM_PART + 256 + tid] + sm[SM_PART + 384 + tid];
    }
    return o;
}

namespace att {
constexpr int D = 128, NW = 8, QBLK = 32, KVBLK = 64, QB = NW * QBLK;
constexpr int SHM_V = KVBLK * D * 2, SHM_K = KVBLK * D * 2;
constexpr int OFF_WS = 2 * SHM_V + 2 * SHM_K, OFF_OT = OFF_WS + NW * 64 * 4, LDS_BYTES = OFF_OT + NW * 32 * 4;
constexpr float SCALE = 0.08838834764831845f, THR = 8.f;
typedef short bf16x8 __attribute__((ext_vector_type(8)));
typedef short s16x4 __attribute__((ext_vector_type(4)));
typedef float f32x16 __attribute__((ext_vector_type(16)));
typedef float f32x4 __attribute__((ext_vector_type(4)));
typedef unsigned u32x4 __attribute__((ext_vector_type(4)));
typedef unsigned short bf16;
#define KSWZ(row, colB) ((row) * 256 + ((colB) ^ (((row) & 7) << 4)))
#define SBAR() __builtin_amdgcn_sched_barrier(0)
__device__ __forceinline__ int v_st(int k, int c) { const int kk = (k & ~0xC) | ((k & 4) << 1) | ((k & 8) >> 1); return ((kk >> 3) * 4 + (c >> 5)) * 512 + ((kk & 7) * 32 + (c & 31)) * 2; }
__device__ __forceinline__ int v_rd_base(int lane) { return ((lane & 3) << 3) | (((lane >> 2) & 3) << 6) | (((lane >> 4) & 1) << 5) | (((lane >> 5) & 1) << 8); }
constexpr int v_rd_off(int d0, int ks, int half) { return d0 * 512 + ks * 4096 + half * 2048; }
__device__ __forceinline__ int crow(int r, int hi) { return (r & 3) + 8 * (r >> 2) + 4 * hi; }
__device__ __forceinline__ unsigned cvtpk(float lo, float hi) { unsigned r; asm volatile("v_cvt_pk_bf16_f32 %0, %1, %2" : "=v"(r) : "v"(lo), "v"(hi)); return r; }
__device__ __forceinline__ bf16x8 load8(const bf16* p) { return *reinterpret_cast<const bf16x8*>(p); }
__device__ __forceinline__ void mask_tile(f32x16& p0, f32x16& p1, int dq, unsigned W) {
    const float NEG = -__builtin_inff();
#pragma unroll
    for (int r = 0; r < 16; ++r) {
        const int c = (r & 3) + 8 * (r >> 2);
        if ((unsigned)(dq - c) >= W) p0[r] = NEG;
        if ((unsigned)(dq - c - 32) >= W) p1[r] = NEG;
    }
}
__device__ __forceinline__ void partialSM(f32x16& p0, f32x16& p1, float& m_reg, float& mn, float& alpha) {
    float pmax = p0[0]; for (int r = 1; r < 16; ++r) pmax = fmaxf(pmax, p0[r]); for (int r = 0; r < 16; ++r) pmax = fmaxf(pmax, p1[r]);
    { auto rr = __builtin_amdgcn_permlane32_swap(__float_as_uint(pmax), __float_as_uint(pmax), false, false);
      pmax = fmaxf(__uint_as_float(rr[0]), __uint_as_float(rr[1])); }
    constexpr float C2 = 1.4426950408889634f * SCALE;
    if (__builtin_expect(__all((pmax - m_reg) * SCALE <= THR), 1)) { mn = m_reg; alpha = 1.f; }
    else { mn = fmaxf(m_reg, pmax); alpha = __builtin_amdgcn_exp2f((m_reg - mn) * C2); m_reg = mn; }
    const float mnL = -mn * C2;
    for (int r = 0; r < 16; ++r) p0[r] = fmaf(p0[r], C2, mnL); for (int r = 0; r < 16; ++r) p1[r] = fmaf(p1[r], C2, mnL);
    for (int r = 0; r < 16; ++r) p0[r] = __builtin_amdgcn_exp2f(p0[r]);
}
__device__ __forceinline__ void finishSM(f32x16& p0, f32x16& p1, float alpha, float& l_reg, bf16x8& pa0, bf16x8& pa1, bf16x8& pa2, bf16x8& pa3) {
    for (int r = 0; r < 16; ++r) p1[r] = __builtin_amdgcn_exp2f(p1[r]);
    float ps = 0; for (int r = 0; r < 16; ++r) ps += p0[r]; for (int r = 0; r < 16; ++r) ps += p1[r];
    { auto rr = __builtin_amdgcn_permlane32_swap(__float_as_uint(ps), __float_as_uint(ps), false, false);
      ps = __uint_as_float(rr[0]) + __uint_as_float(rr[1]); }
    l_reg = l_reg * alpha + ps;
#define PK4(P, B_, OUT) do { unsigned a0 = cvtpk(P[B_+0], P[B_+1]), a1 = cvtpk(P[B_+2], P[B_+3]);                          \
        unsigned b0 = cvtpk(P[B_+4], P[B_+5]), b1 = cvtpk(P[B_+6], P[B_+7]);                                             \
        auto r0 = __builtin_amdgcn_permlane32_swap(a0, b0, false, false); auto r1 = __builtin_amdgcn_permlane32_swap(a1, b1, false, false); \
        u32x4 w = {r0[0], r1[0], r0[1], r1[1]}; OUT = *reinterpret_cast<bf16x8*>(&w); } while (0)
    PK4(p0, 0, pa0); PK4(p0, 8, pa1); PK4(p1, 0, pa2); PK4(p1, 8, pa3);
#undef PK4
}
template <int KB, bool SK>
__device__ __forceinline__ void qkt(f32x16& p0, f32x16& p1, const char* K_lds, int r32, int hi, const bf16x8* qr, bool act) {
    if (SK && !act) { const float NEG = -__builtin_inff();
#pragma unroll
        for (int r = 0; r < 16; ++r) { p0[r] = NEG; p1[r] = NEG; } return; }
    p0 = f32x16{}; p1 = f32x16{};
    const char* kb[4];
#pragma unroll
    for (int dd = 0; dd < 4; ++dd) kb[dd] = K_lds + KB * SHM_K + KSWZ(r32, (dd * 16 + hi * 8) * 2);
#pragma unroll
    for (int d0 = 0; d0 < 8; ++d0) { const char* a = kb[d0 & 3] + (d0 >> 2) * 128;
        bf16x8 b0 = *reinterpret_cast<const bf16x8*>(a);
        bf16x8 b1 = *reinterpret_cast<const bf16x8*>(a + 32 * 256);
        p0 = __builtin_amdgcn_mfma_f32_32x32x16_bf16(b0, qr[d0], p0, 0, 0, 0);
        p1 = __builtin_amdgcn_mfma_f32_32x32x16_bf16(b1, qr[d0], p1, 0, 0, 0); }
}
template <int VB, bool SK>
__device__ __forceinline__ void pv_tile(f32x16* o, int vb0, bf16x8 pa0, bf16x8 pa1, bf16x8 pa2, bf16x8 pa3, bool act) {
    if (SK && !act) return;
#define TRRD(dst, off) asm volatile("ds_read_b64_tr_b16 %0, %1 offset:%2" : "=&v"(dst) : "v"(vb0), "i"(off) : "memory")
#define PV_D0(d0) do { s16x4 l0, l1, l2, l3, h0, h1, h2, h3; constexpr int b_ = VB * SHM_V + v_rd_off(d0, 0, 0); \
        TRRD(l0, b_); TRRD(h0, b_ + 2048); TRRD(l1, b_ + 4096); TRRD(h1, b_ + 6144); TRRD(l2, b_ + 8192); TRRD(h2, b_ + 10240); TRRD(l3, b_ + 12288); TRRD(h3, b_ + 14336); \
        asm volatile("s_waitcnt lgkmcnt(0)" ::: "memory"); SBAR();   \
        o[d0] = __builtin_amdgcn_mfma_f32_32x32x16_bf16(pa0, (bf16x8){l0[0], l0[1], l0[2], l0[3], h0[0], h0[1], h0[2], h0[3]}, o[d0], 0, 0, 0);   \
        o[d0] = __builtin_amdgcn_mfma_f32_32x32x16_bf16(pa1, (bf16x8){l1[0], l1[1], l1[2], l1[3], h1[0], h1[1], h1[2], h1[3]}, o[d0], 0, 0, 0);   \
        o[d0] = __builtin_amdgcn_mfma_f32_32x32x16_bf16(pa2, (bf16x8){l2[0], l2[1], l2[2], l2[3], h2[0], h2[1], h2[2], h2[3]}, o[d0], 0, 0, 0);   \
        o[d0] = __builtin_amdgcn_mfma_f32_32x32x16_bf16(pa3, (bf16x8){l3[0], l3[1], l3[2], l3[3], h3[0], h3[1], h3[2], h3[3]}, o[d0], 0, 0, 0); } while (0)
    PV_D0(0); PV_D0(1); PV_D0(2); PV_D0(3);
#undef PV_D0
#undef TRRD
}
struct Ref { const bf16* Q; const bf16* K; const bf16* V; bf16* O; const int* list; int kpitch, j_lo, j_hi, P0, W, a0, a1; };
struct Seam { bf16x8 qr[8]; bf16x8 st_v0, st_v1, st_k0, st_k1; };
#define ROW(p, kp, k0, rr) ((p) + (size_t)((k0) + (rr)) * (kp) + sc)
#define VMW() asm volatile("s_waitcnt vmcnt(0)" ::: "memory")
#define VMWN(n) asm volatile("s_waitcnt vmcnt(%0)" :: "i"(n) : "memory")
#define SLOAD_H(Kp, Vp, kp, k0) do { S.st_v0 = load8(ROW(Vp, kp, k0, sr)); S.st_v1 = load8(ROW(Vp, kp, k0, 32 + sr));              \
                         S.st_k0 = load8(ROW(Kp, kp, k0, sr)); S.st_k1 = load8(ROW(Kp, kp, k0, 32 + sr)); } while (0)
#define SWRITE_HK(bf) do { *(bf16x8*)(K_lds + (bf) * SHM_K + kws) = S.st_k0; *(bf16x8*)(K_lds + (bf) * SHM_K + kws + 32 * 256) = S.st_k1; } while (0)
#define SWRITE_HV(bf) do { *(bf16x8*)(V_lds + (bf) * SHM_V + vst0) = S.st_v0; *(bf16x8*)(V_lds + (bf) * SHM_V + vst1) = S.st_v1; } while (0)
#define SWRITE_H(bf) do { SWRITE_HV(bf); SWRITE_HK(bf); } while (0)
template <class RF>
__device__ __forceinline__ void prime(const Ref& cur, char* lds, Seam& S) {
    int tid_ = threadIdx.x; asm volatile("" : "+v"(tid_));
    const int tid = tid_, wid = __builtin_amdgcn_readfirstlane(tid >> 6), lane = tid & 63, r32 = lane & 31, hi = lane >> 5;
    const int sr = tid >> 4, sc = (tid & 15) * 8, kws = KSWZ(sr, sc * 2); char* K_lds = lds + 2 * SHM_V;
    const int kb0 = cur.j_lo * KVBLK;
    { const bf16* qrow = cur.Q + RF::q_off(cur, wid * QBLK + r32);
      for (int d0 = 0; d0 < 8; ++d0) S.qr[d0] = load8(qrow + d0 * 16 + hi * 8); }
    SLOAD_H(cur.K, cur.V, cur.kpitch, kb0); VMW(); SWRITE_HK(0);
    __syncthreads();
}
template <int MODE, bool WSKIP, class RF>
__device__ __forceinline__ void block(const Ref& cur, const Ref& nxt, float* LSE, char* lds, Seam& S, float* lse_lane = nullptr) {
    int tid_ = threadIdx.x; asm volatile("" : "+v"(tid_));
    const int tid = tid_, wid = __builtin_amdgcn_readfirstlane(tid >> 6), lane = tid & 63, r32 = lane & 31, hi = lane >> 5;
    const int j_lo = cur.j_lo, NT = cur.j_hi - cur.j_lo;
    const int kbn = nxt.j_lo * KVBLK;
    const int W = cur.W;
    const int qlo = cur.P0 + wid * QBLK;
    const int qm = (MODE == 2 ? RF::pos(cur, wid * QBLK + r32) : qlo + r32) - 4 * hi;
    const unsigned Wm = (MODE == 2) ? (unsigned)RF::Wl(cur, wid * QBLK + r32) : (unsigned)W;
    char* V_lds = lds; char* K_lds = lds + 2 * SHM_V;
    float* ws = (float*)(lds + OFF_WS) + wid * 64; float* li_l = ws, * al_l = ws + 32; int* ot_l = (int*)(lds + OFF_OT) + wid * 32;
    float m_reg = -1e30f, l_reg = 0; f32x16 o[4] = {};
    const int sr = tid >> 4, sc = (tid & 15) * 8, vst0 = v_st(sr, sc), vst1 = v_st(32 + sr, sc), kws = KSWZ(sr, sc * 2);
    const int vb0 = (int)(uintptr_t)V_lds + v_rd_base(lane);
    const bf16* Kh = cur.K; const bf16* Vh = cur.V; const int kp = cur.kpitch;
#define RESC(a) do { if (__any((a) < 1.f)) { if (hi == 0) al_l[r32] = (a); asm volatile("s_waitcnt lgkmcnt(0)" ::: "memory");              \
                     for (int d_ = 0; d_ < 4; ++d_) for (int r = 0; r < 16; ++r) o[d_][r] *= al_l[crow(r, hi)]; } } while (0)
#define KBASE(t) ((j_lo + (t)) * KVBLK)
#define ACT(t) (MODE != 0 || (KBASE(t) <= qlo + QBLK - 1 && KBASE(t) + KVBLK - 1 >= qlo - W + 1))
#define MASKT(P0_, P1_, t) do { const int kb_ = KBASE(t); if (MODE == 2) mask_tile(P0_, P1_, qm - kb_, Wm); \
        else if (MODE == 0) { if ((!SK || ACT(t)) && (kb_ + KVBLK - 1 > qlo || kb_ <= qlo + QBLK - 1 - W)) mask_tile(P0_, P1_, qm - kb_, Wm); } } while (0)
    constexpr int NQL = 8;
    constexpr bool SK = WSKIP && MODE == 0;
#define SEAM_K0() do { VMWN(NQL); SWRITE_HK(0); SBAR(); } while (0)
    f32x16 pA0, pA1, pB0, pB1; float mnA, mnB, alA, alB; bf16x8 pa0, pa1, pa2, pa3;
    SWRITE_HV(0); SBAR();
    if (NT > 1) { SLOAD_H(Kh, Vh, kp, KBASE(1)); }
    SBAR(); qkt<0, SK>(pA0, pA1, K_lds, r32, hi, S.qr, ACT(0));
    MASKT(pA0, pA1, 0); partialSM(pA0, pA1, m_reg, mnA, alA);
    if (NT > 1) { VMW(); SWRITE_H(1); }
    __syncthreads();
#define HALF_STEP(PX0, PX1, mnX, alX, PY0, PY1, alY, t, KB, VB, SB) do {                                                      \
        SBAR(); qkt<KB, SK>(PX0, PX1, K_lds, r32, hi, S.qr, ACT(t));                                             \
        finishSM(PY0, PY1, alY, l_reg, pa0, pa1, pa2, pa3); SBAR();                                                           \
        if ((t) + 1 < NT) { SLOAD_H(Kh, Vh, kp, KBASE((t) + 1)); SBAR(); }                                               \
        pv_tile<VB, SK>(o, vb0, pa0, pa1, pa2, pa3, ACT((t) - 1)); MASKT(PX0, PX1, (t)); partialSM(PX0, PX1, m_reg, mnX, alX);                                        \
        __syncthreads();                                                                                                      \
        if ((t) + 1 < NT) { VMW(); SWRITE_H(SB); }                                                                          \
        RESC(alX); __syncthreads(); } while (0)
    for (int t = 1; t + 1 < NT; t += 2) {
        HALF_STEP(pB0, pB1, mnB, alB, pA0, pA1, alA, t, 1, 0, 0);
        HALF_STEP(pA0, pA1, mnA, alA, pB0, pB1, alB, t + 1, 0, 1, 1);
    }
    const bool even = (NT & 1) == 0;
    if (even) { SBAR(); qkt<1, SK>(pB0, pB1, K_lds, r32, hi, S.qr, ACT(NT - 1)); SBAR(); }
    SLOAD_H(nxt.K, nxt.V, nxt.kpitch, kbn); SBAR();
    { const bf16* qrow = nxt.Q + RF::q_off(nxt, wid * QBLK + r32);
#pragma unroll
      for (int d0 = 0; d0 < 8; ++d0) S.qr[d0] = load8(qrow + d0 * 16 + hi * 8); }
    SBAR();
    finishSM(pA0, pA1, alA, l_reg, pa0, pa1, pa2, pa3); SBAR();
    pv_tile<0, SK>(o, vb0, pa0, pa1, pa2, pa3, ACT(even ? NT - 2 : NT - 1));
    if (even) { MASKT(pB0, pB1, NT - 1); partialSM(pB0, pB1, m_reg, mnB, alB); __syncthreads(); RESC(alB);
        finishSM(pB0, pB1, alB, l_reg, pa0, pa1, pa2, pa3); SBAR(); pv_tile<1, SK>(o, vb0, pa0, pa1, pa2, pa3, ACT(NT - 1)); }
    SBAR(); SEAM_K0();
    if (hi == 0) { li_l[r32] = l_reg; ot_l[r32] = RF::o_off(cur, wid * QBLK + r32); } asm volatile("s_waitcnt lgkmcnt(0)" ::: "memory");
    if (LSE != nullptr && hi == 0) { const int lq = RF::l_idx(cur, wid * QBLK + r32); if (lq >= 0) LSE[lq] = (l_reg > 0.f) ? m_reg * SCALE + __logf(l_reg) : -__builtin_inff(); }
    if (lse_lane != nullptr) *lse_lane = (l_reg > 0.f) ? m_reg * SCALE + __logf(l_reg) : -__builtin_inff();
    bf16* O = cur.O;
#pragma unroll
    for (int r = 0; r < 16; ++r) { const int orow = crow(r, hi); const float lv = li_l[orow]; const float rl = (lv > 0.f) ? __builtin_amdgcn_rcpf(lv) : 0.f; const int oo = ot_l[orow];
#pragma unroll
        for (int d0 = 0; d0 < 4; ++d0) { const float v = o[d0][r] * rl; const float vn = __shfl_xor(v, 1);
            if (oo >= 0 && (r32 & 1) == 0) *(unsigned*)(O + (size_t)oo + d0 * 32 + r32) = cvtpk(v, vn); } }
    __syncthreads();
#undef RESC
#undef KBASE
#undef ACT
#undef MASKT
#undef SEAM_K0
#undef HALF_STEP
}

template <class RF>
__device__ __forceinline__ void imp_sweep(const Ref& cur, float lse_lane, float* IMP  , char* lds, Seam& S) {
    int tid_ = threadIdx.x; asm volatile("" : "+v"(tid_));
    const int tid = tid_, wid = __builtin_amdgcn_readfirstlane(tid >> 6), lane = tid & 63, r32 = lane & 31, hi = lane >> 5;
    const int NT = cur.j_hi - cur.j_lo;
    char* K_lds = lds + 2 * SHM_V;
    const int sr = tid >> 4, sc = (tid & 15) * 8, kws = KSWZ(sr, sc * 2);
    const bf16* Kh = cur.K; const int kp = cur.kpitch;
    const int row = wid * QBLK + r32;
    const int qm = RF::pos(cur, row) - 4 * hi; const unsigned Wm = (unsigned)RF::Wl(cur, row);
    constexpr float C2 = 1.4426950408889634f * SCALE;
    const float nl2 = (lse_lane == -__builtin_inff()) ? 0.f : -lse_lane * 1.4426950408889634f;
    float carry = 0.f;
    float* imp_row = IMP + (size_t)(row >> 2) * 512;
    f32x16 p0, p1;
#define IMP_TILE(t, KB) do { \
        if ((t) + 1 < NT) { S.st_k0 = load8(ROW(Kh, kp, (cur.j_lo + (t) + 1) * KVBLK, sr)); S.st_k1 = load8(ROW(Kh, kp, (cur.j_lo + (t) + 1) * KVBLK, 32 + sr)); } \
        SBAR(); qkt<KB, false>(p0, p1, K_lds, r32, hi, S.qr, true); \
        mask_tile(p0, p1, qm - (cur.j_lo + (t)) * KVBLK, Wm); \
        _Pragma("unroll") for (int r = 0; r < 16; ++r) { p0[r] = __builtin_amdgcn_exp2f(fmaf(p0[r], C2, nl2)); p1[r] = __builtin_amdgcn_exp2f(fmaf(p1[r], C2, nl2)); } \
        float Gs[8], Ls[8]; \
        _Pragma("unroll") for (int q = 0; q < 4; ++q) { Gs[q] = (p0[4 * q] + p0[4 * q + 1]) + (p0[4 * q + 2] + p0[4 * q + 3]); Ls[q] = p0[4 * q + 3]; \
                                              Gs[4 + q] = (p1[4 * q] + p1[4 * q + 1]) + (p1[4 * q + 2] + p1[4 * q + 3]); Ls[4 + q] = p1[4 * q + 3]; } \
          \
        float prevL = carry; \
        _Pragma("unroll") for (int q = 0; q < 8; ++q) { const float other = __shfl_xor(Ls[q], 32);        \
            const float add = hi ? other : prevL; prevL = other; Gs[q] += add; } \
        carry = prevL;                                            \
        _Pragma("unroll") for (int q = 0; q < 8; ++q) { float v = Gs[q]; v += __shfl_xor(v, 1); v += __shfl_xor(v, 2); \
            if ((r32 & 3) == 0) imp_row[((cur.j_lo + (t)) << 4) + 2 * q + hi] = v; } \
        if ((t) + 1 < NT) { asm volatile("s_waitcnt vmcnt(0)" ::: "memory"); *(bf16x8*)(K_lds + ((KB) ^ 1) * SHM_K + kws) = S.st_k0; *(bf16x8*)(K_lds + ((KB) ^ 1) * SHM_K + kws + 32 * 256) = S.st_k1; } \
        __syncthreads(); } while (0)
    for (int t = 0; t < NT; t += 2) { IMP_TILE(t, 0); if (t + 1 < NT) IMP_TILE(t + 1, 1); }
#undef IMP_TILE
}
#undef ROW
#undef VMW
#undef VMWN
#undef SLOAD_H
#undef SWRITE_HK
#undef SWRITE_HV
#undef SWRITE_H
#undef KSWZ
#undef SBAR
}

struct RFReg {
    static __device__ __forceinline__ int q_off(const att::Ref&, int row) { return row * 1024; }
    static __device__ __forceinline__ int o_off(const att::Ref&, int row) { return row * 1024; }
    static __device__ __forceinline__ int l_idx(const att::Ref& u, int row) { return u.a0 >= 0 ? u.a0 + row * 8 : -1; }
    static __device__ __forceinline__ int pos(const att::Ref& u, int row) { return u.P0 + row; }
    static __device__ __forceinline__ int Wl(const att::Ref& u, int) { return u.W; }
};
__device__ __forceinline__ att::Ref win_ref(int L, const bf16* QN, const bf16* KW, const bf16* VW, bf16* OWIN) {
    const int h = L & 7, qb = L >> 3;
    att::Ref r; r.Q = QN + (size_t)qb * 256 * 1024 + h * 128; r.O = OWIN + (size_t)qb * 256 * 1024 + h * 128; r.K = KW + (h >> 2) * 128; r.V = VW + (h >> 2) * 128; r.kpitch = 256; r.list = nullptr;
    r.P0 = qb * 256; r.W = 512; r.j_lo = (r.P0 >= 511) ? (r.P0 - 511) >> 6 : 0; r.j_hi = ((r.P0 + 255) >> 6) + 1; r.a0 = -1; r.a1 = 0; return r;
}
__device__ __forceinline__ att::Ref mown_ref(int L, const bf16* QM, const bf16* KM, const bf16* VM, bf16* POWN) {
    const int h = L & 7, n = L >> 3; const size_t o = (size_t)n * 256 * 1024 + h * 128;
    att::Ref r; r.Q = QM + o; r.O = POWN + o; r.K = KM + o; r.V = VM + o; r.kpitch = 1024; r.list = nullptr;
    r.P0 = 0; r.W = 1 << 20; r.j_lo = 0; r.j_hi = 4; r.a0 = n * 256 * 8 + h; r.a1 = 0; return r;
}
struct RFSel {
    static __device__ __forceinline__ int q_off(const att::Ref& u, int row) { const int e = u.list[row < u.a0 ? row : 0]; return (e >> 2) * 1024; }
    static __device__ __forceinline__ int o_off(const att::Ref& u, int row) { if (row >= u.a0) return -1; const int e = u.list[row]; return (((e >> 2) * 8 + u.a1) * 3 + (e & 3)) * 128; }
    static __device__ __forceinline__ int l_idx(const att::Ref& u, int row) { if (row >= u.a0) return -1; const int e = u.list[row]; return ((e >> 2) * 8 + u.a1) * 3 + (e & 3); }
    static __device__ __forceinline__ int pos(const att::Ref&, int) { return 0; }
    static __device__ __forceinline__ int Wl(const att::Ref&, int) { return 0; }
};
__device__ __forceinline__ att::Ref msel_ref(int L, const LAS int* tab, const int* MLIST, const bf16* QM, const bf16* KM, const bf16* VM, bf16* PSEL) {
    int lo = 0, hi = 512;
    while (hi - lo > 1) { const int mid = (lo + hi) >> 1; if (tab[512 + mid] <= L) lo = mid; else hi = mid; }
    const int lid = __builtin_amdgcn_readfirstlane(lo), k = L - tab[512 + lid], h = lid >> 6, n = lid & 63;
    att::Ref r; r.Q = QM + h * 128; r.O = PSEL; r.K = KM + (size_t)n * 256 * 1024 + h * 128; r.V = VM + (size_t)n * 256 * 1024 + h * 128; r.kpitch = 1024;
    r.list = MLIST + (size_t)lid * 16384 + k * 256; r.P0 = 0; r.W = 0; r.j_lo = 0; r.j_hi = 4; r.a0 = tab[lid] - k * 256; r.a1 = h; return r;
}

struct RFSlc {
    static __device__ __forceinline__ int q_off(const att::Ref& u, int row) { const int e = u.list[(row >> 2) < u.a0 ? (row >> 2) : 0]; return (e >> 4) * 1024 + (row & 3) * 128; }
    static __device__ __forceinline__ int o_off(const att::Ref& u, int row) { if ((row >> 2) >= u.a0) return -1; const int e = u.list[row >> 2]; return (e * 4 + (row & 3)) * 128; }
    static __device__ __forceinline__ int l_idx(const att::Ref& u, int row) { if ((row >> 2) >= u.a0) return -1; const int e = u.list[row >> 2]; return e * 4 + (row & 3); }
    static __device__ __forceinline__ int pos(const att::Ref& u, int row) { const int e = u.list[(row >> 2) < u.a0 ? (row >> 2) : 0]; return (e >> 4) - 64 * u.a1; }
    static __device__ __forceinline__ int Wl(const att::Ref&, int) { return 1 << 30; }
};
__device__ __forceinline__ att::Ref nsel_ref(int L, int g, const LAS int* tab, const int* NLIST, const bf16* QN, const bf16* KS, const bf16* VS, bf16* PSLC) {
    int lo = 0, hi = 256;
    while (hi - lo > 1) { const int mid = (lo + hi) >> 1; if (tab[256 + mid] <= L) lo = mid; else hi = mid; }
    const int j = __builtin_amdgcn_readfirstlane(lo), k = L - tab[256 + j];
    att::Ref r; r.Q = QN + g * 512; r.O = PSLC; r.K = KS + (size_t)j * 64 * 256 + g * 128; r.V = VS + (size_t)j * 64 * 256 + g * 128; r.kpitch = 256;
    r.list = NLIST + (size_t)(g * 256 + j) * 16384 + k * 64; r.P0 = 0; r.W = 0; r.j_lo = 0; r.j_hi = 1; r.a0 = tab[j] - k * 64; r.a1 = j; return r;
}

struct RFCmp {
    static __device__ __forceinline__ int q_off(const att::Ref&, int row) { return (row >> 2) * 1024 + (row & 3) * 128; }
    static __device__ __forceinline__ int o_off(const att::Ref&, int row) { return (row >> 2) * 1024 + (row & 3) * 128; }
    static __device__ __forceinline__ int l_idx(const att::Ref&, int) { return -1; }
    static __device__ __forceinline__ int pos(const att::Ref& u, int row) { const int t = u.P0 + (row >> 2); return t >= 31 ? (t - 31) >> 4 : -1; }
    static __device__ __forceinline__ int Wl(const att::Ref&, int) { return 1 << 30; }
};
__device__ __forceinline__ att::Ref cmp_ref(int L, const bf16* QN, const bf16* KCMP, const bf16* VCMP, bf16* OCMP) {
    const int g = L & 1, c = (L < 256) ? (L >> 1) : 255 - ((L - 256) >> 1);
    att::Ref r; r.Q = QN + (size_t)c * 64 * 1024 + g * 512; r.O = OCMP + (size_t)c * 64 * 1024 + g * 512; r.K = KCMP + g * 128; r.V = VCMP + g * 128; r.kpitch = 256; r.list = nullptr;
    r.P0 = c * 64; r.W = 0; r.j_lo = 0; r.j_hi = (4 * c + 3 + 63) >> 6; r.a0 = g; r.a1 = c; return r;
}

struct Args { const float* in[18]; float* out; unsigned char* ws; int ph_lo, ph_hi, li, pad; };
typedef const __attribute__((address_space(4))) Args* ArgsP;
__device__ __forceinline__ ArgsP get_args() { auto p = __builtin_amdgcn_kernarg_segment_ptr(); asm volatile("" : "+s"(p)); return (ArgsP)p; }

__global__ void __launch_bounds__(NTHR, 2) mk_fwd(Args args_unused) {
    extern __shared__ __attribute__((aligned(16))) unsigned char lds_raw[];
    LAS unsigned char* lds = (LAS unsigned char*)lds_raw;
    LAS float* sm = (LAS float*)lds;
    volatile LAS unsigned* MISC = (volatile LAS unsigned*)(lds + MISC_OFF);
    LAS int* moetab = (LAS int*)(lds + MOETAB_OFF);
    const int G = gridDim.x, bid = blockIdx.x, NGW = G * NWAVES;
#define PH_IDS() int tid_ = threadIdx.x; asm volatile("" : "+v"(tid_)); const int tid = tid_, lane = tid & 63, wave = __builtin_amdgcn_readfirstlane(tid >> 6), gw = bid * NWAVES + wave; (void)lane; (void)gw;
#define AP() get_args()
#define CTLP(ws) ((gu32*)((ws) + WS_CTL))

    for (int u = threadIdx.x; u < (LDS_BYTES - LDSCTL_OFF) / 4; u += NTHR) ((LAS unsigned*)(lds + LDSCTL_OFF))[u] = 0u;
    __syncthreads();
    XcdBarrier bar; bar.bar = nullptr; bar.x = 0; bar.st = nullptr;
    if (MK_N_LAUNCHES == 1) bar = xcd_barrier_post((unsigned*)(CTLP(AP()->ws) + CW_BAR), MISC + 8);
#define GRID_BAR() do { if (MK_N_LAUNCHES == 1) { XcdBarrier b_ = bar; b_.bar = (unsigned*)(CTLP(AP()->ws) + CW_BAR); xcd_barrier(b_); } } while (0)
    const int lo = AP()->ph_lo, hi = AP()->ph_hi;
#define IN(k) (lo <= (k) && (k) < hi)
#define BOTH(k) (IN(k) && IN((k) + 1))

    if (IN(0)) {
        PH_IDS(); ArgsP ap = AP(); unsigned char* ws = ap->ws;
        LAS float* scr = (LAS float*)(lds + wave * 16384);
        constexpr int I_IN = 32 * 177, I_OUT = 32 * 64, I_GU = 32 * 16, I_DN = 8 * 64, I_W1 = 32 * 8;
        constexpr int N_IN = 2 * I_IN, N_OUT = 2 * I_OUT, N_G = 64 * I_GU, N_U = 64 * I_GU, N_D = 64 * I_DN, N_W1 = 8 * I_W1;
        constexpr int NITEMS = N_IN + N_OUT + N_G + N_U + N_D + N_W1;
        for (int it = gw; it < NITEMS; it += NGW) {
            int r = it;
            if (r < N_IN) { const int l = r / I_IN; transpose_item<1>(ap->in[6] + (size_t)l * D_ * IN_W, D_, IN_W, (bf16*)(ws + WS_WINT) + (size_t)l * NIN * D_, D_, 0, scr, r % I_IN, lane); continue; } r -= N_IN;
            if (r < N_OUT) { const int l = r / I_OUT; transpose_item<0>(ap->in[7] + (size_t)l * D_ * D_, D_, D_, (bf16*)(ws + WS_WOUTT) + (size_t)l * D_ * D_, D_, 0, scr, r % I_OUT, lane); continue; } r -= N_OUT;
            if (r < N_G) { const int le = r / I_GU; transpose_item<2>(ap->in[14] + (size_t)le * D_ * DEXP, D_, DEXP, (bf16*)(ws + WS_WGUT) + (size_t)le * 1024 * D_, D_, 0, scr, r % I_GU, lane); continue; } r -= N_G;
            if (r < N_U) { const int le = r / I_GU; transpose_item<3>(ap->in[15] + (size_t)le * D_ * DEXP, D_, DEXP, (bf16*)(ws + WS_WGUT) + (size_t)le * 1024 * D_, D_, 0, scr, r % I_GU, lane); continue; } r -= N_U;
            if (r < N_D) { const int le = r / I_DN; transpose_item<0>(ap->in[16] + (size_t)le * DEXP * D_, DEXP, D_, (bf16*)(ws + WS_WDT) + (size_t)le * D_ * DEXP, DEXP, 0, scr, r % I_DN, lane); continue; } r -= N_D;
            { const int m = r / I_W1, lk = m >> 1, half = m & 1;
              transpose_item<0>(ap->in[9] + (size_t)lk * 4096 * 256 + (size_t)half * 2048 * 256, 2048, 256, (bf16*)(ws + WS_WC1T) + (size_t)lk * 512 * 2048, 2048, half * 256, scr, r % I_W1, lane); }
        }
        { const float* w_router = ap->in[12]; bf16* WrT = (bf16*)(ws + WS_WRT);
          for (int idx = bid * NTHR + tid; idx < 32 * 2048; idx += G * NTHR) { const int e = idx >> 11, k = idx & 2047; const float w = w_router[(size_t)k * 32 + e];
            const unsigned hb = f2bf(w); const float rem = w - bf2f(hb); WrT[idx] = (bf16)hb; WrT[32 * 2048 + idx] = (bf16)f2bf(rem); } }
        { f32x2* ROPE = (f32x2*)(ws + WS_ROPE);
          for (int idx = bid * NTHR + tid; idx < S_ * 64; idx += G * NTHR) { const int pos = idx >> 6, i = idx & 63;
            const double inv = exp(-(double)i * (9.210340371976184 / 64.0)); const double ang = (double)pos * inv; double sv, cv; sincos(ang, &sv, &cv);
            ROPE[idx] = (f32x2){(float)cv, (float)sv}; } }
        __syncthreads();
        { float* MOD = (float*)(CTLP(ws) + CW_MOD); const float* c_in = ap->in[1]; const float* w_ada = ap->in[2]; const float* b_ada = ap->in[3];
          for (int k = tid; k < D_; k += NTHR) { const float cv = c_in[k]; sm[k] = cv / (1.f + __expf(-cv)); }
          __syncthreads();
          for (int it = bid; it < 2 * 96; it += G) { const int l = it / 96, cb = it % 96, grp = tid >> 5, col = cb * 128 + (tid & 31) * 4;
            f32x4 a = (f32x4){0.f, 0.f, 0.f, 0.f};
            const float* wp = w_ada + ((size_t)l * D_ + grp) * 12288 + col;
#pragma unroll 8
            for (int i = 0; i < 128; ++i) a += *(const f32x4*)(wp + (size_t)i * 16 * 12288) * sm[grp + 16 * i];
            *(LAS f32x4*)(sm + 4096 + grp * 128 + (tid & 31) * 4) = a;
            __syncthreads();
            if (tid < 128) { float s = b_ada[l * 12288 + cb * 128 + tid];
#pragma unroll
                for (int q = 0; q < 16; ++q) s += sm[4096 + q * 128 + tid];
                MOD[l * 12288 + cb * 128 + tid] = s; }
            __syncthreads(); } }
        { float* B1E = (float*)(CTLP(ws) + CW_B1E); const float* cmp_pe = ap->in[8]; const float* cmp_w1 = ap->in[9]; const float* cmp_b1 = ap->in[10];
          for (int it = bid - 192; it >= 0 && it < 4; it += G) { const int lk = it, grp = tid >> 6, n = (tid & 63) * 4;
            f32x4 a = (f32x4){0.f, 0.f, 0.f, 0.f};
            const float* wp = cmp_w1 + ((size_t)lk * 4096 + grp) * 256 + n; const float* pe = cmp_pe + (size_t)lk * 4096 + grp;
#pragma unroll 8
            for (int i = 0; i < 512; ++i) a += *(const f32x4*)(wp + (size_t)i * 8 * 256) * pe[i * 8];
            *(LAS f32x4*)(sm + 4096 + grp * 256 + n) = a;
            __syncthreads();
            if (tid < 256) { float s = cmp_b1[lk * 256 + tid];
#pragma unroll
                for (int q = 0; q < 8; ++q) s += sm[4096 + q * 256 + tid];
                B1E[lk * 256 + tid] = s; }
            __syncthreads(); } }
        if (BOTH(0)) GRID_BAR();
    }

    for (int l = 0; l < DEPTH; ++l) {
        const int pb = 1 + NPL * l;
#define LOAD_MOETAB(CNTP, NT_) do { __syncthreads(); if (tid < 32) moetab[tid] = (int)__hip_atomic_load((CNTP) + tid, RLX_AGENT); __syncthreads(); \
        if (tid == 0) { int us = 0, ps = 0; for (int e = 0; e < NEXP; ++e) { const int c = moetab[e], tl = (c + 255) >> 8; moetab[32 + e] = us; moetab[65 + e] = ps; us += tl * (NT_); ps += tl << 8; } moetab[64] = us; } \
        __syncthreads(); } while (0)

        if (IN(pb + 0)) {
            PH_IDS(); ArgsP ap = AP(); unsigned char* ws = ap->ws;
            const float* MOD = (const float*)(CTLP(ws) + CW_MOD); const float* mod = MOD + l * 12288;
            float* X = ap->out; bf16* H = (bf16*)(ws + WS_H); const bf16* Y = (const bf16*)(ws + WS_Y); const int* TE = (const int*)(ws + WS_TE);
            if (l > 0) LOAD_MOETAB((unsigned*)(CTLP(ws) + CW_CNT) + (l - 1) * 32, 1);
            { const float* g_attn = ap->in[4];
              for (int k = tid; k < D_; k += NTHR) { sm[k] = g_attn[l * D_ + k] * (1.f + mod[2048 + k]); sm[2048 + k] = mod[k]; sm[4096 + k] = (l > 0) ? MOD[(l - 1) * 12288 + 10240 + k] : 0.f; } }
            __syncthreads();
            const float* x_in = ap->in[0];
            for (int t = gw; t < S_; t += NGW) {
                f32x4 v[8]; float ss = 0.f;
                if (l == 0) {
#pragma unroll
                    for (int j = 0; j < 8; ++j) v[j] = *(const f32x4*)(x_in + (size_t)t * D_ + 256 * j + 4 * lane);
                } else {
                    const int4 te = *(const int4*)(TE + 4 * t);
                    const bf16* y0 = Y + (size_t)(moetab[65 + te.x] + te.y) * D_; const bf16* y1 = Y + (size_t)(moetab[65 + te.z] + te.w) * D_;
#pragma unroll
                    for (int j = 0; j < 8; ++j) { const int k = 256 * j + 4 * lane; const uint2 a = *(const uint2*)(y0 + k), b = *(const uint2*)(y1 + k);
                        const f32x4 gt2 = *(const LAS f32x4*)(sm + 4096 + k);
                        f32x4 ysum = (f32x4){bflo(a.x) + bflo(b.x), bfhi(a.x) + bfhi(b.x), bflo(a.y) + bflo(b.y), bfhi(a.y) + bfhi(b.y)};
                        v[j] = *(const f32x4*)(X + (size_t)t * D_ + k) + gt2 * ysum; *(f32x4*)(X + (size_t)t * D_ + k) = v[j]; }
                }
#pragma unroll
                for (int j = 0; j < 8; ++j) ss += (v[j][0] * v[j][0] + v[j][1] * v[j][1]) + (v[j][2] * v[j][2] + v[j][3] * v[j][3]);
                const float rstd = 1.f / sqrtf(wave_sum(ss) * (1.f / D_) + RMS_EPS);
#pragma unroll
                for (int j = 0; j < 8; ++j) { const int k = 256 * j + 4 * lane; const f32x4 h = v[j] * rstd * *(const LAS f32x4*)(sm + k) + *(const LAS f32x4*)(sm + 2048 + k);
                    *(uint2*)(H + (size_t)t * D_ + k) = make_uint2(pk2(h[0], h[1]), pk2(h[2], h[3])); }
            }
            if (BOTH(pb + 0)) GRID_BAR();
        }
        if (IN(pb + 1)) {
            ArgsP ap = AP(); unsigned char* ws = ap->ws;
            pg8::Gemm g{(const bf16*)(ws + WS_H), (const bf16*)(ws + WS_WINT) + (size_t)l * NIN * D_, S_, NIN, D_}; pg8::StaticOrder So; So.init(S_, NIN, G, bid);
            EpiInProj E{(bf16*)(ws + WS_QN), (bf16*)(ws + WS_KC), (bf16*)(ws + WS_VC), (bf16*)(ws + WS_KS), (bf16*)(ws + WS_VS), (bf16*)(ws + WS_KW), (bf16*)(ws + WS_VW),
                        (bf16*)(ws + WS_QM), (bf16*)(ws + WS_KM), (bf16*)(ws + WS_VM), (float*)(ws + WS_GATES), (const float*)(ws + WS_ROPE)};
            pg8::gemm_phase<EpiInProj, pg8::StaticOrder, true, true>(lds, g, So, E);
            if (BOTH(pb + 1)) GRID_BAR();
        }
        if (IN(pb + 2)) {
            PH_IDS(); ArgsP ap = AP(); unsigned char* ws = ap->ws;
            if (bid < 32) {
                pg8::Gemm g{(const bf16*)(ws + WS_KC), (const bf16*)(ws + WS_WC1T) + (size_t)l * 2 * 512 * 2048, 4096, 512, 2048}; CompressOrder So{G, bid};
                EpiF32 E{(float*)(ws + WS_UL), 512};
                pg8::gemm_phase<EpiF32, CompressOrder, false, true>(lds, g, So, E);
            }
            {
                const bf16* KM = (const bf16*)(ws + WS_KM); float* KMEAN = (float*)(ws + WS_KMEAN);
                const int nb = (G > 32) ? G - 32 : G, b0 = (G > 32) ? bid - 32 : bid;
                if (b0 >= 0) for (int u = b0; u < 512; u += nb) { const int n = u >> 3, h = u & 7, rg = tid >> 4, c8 = (tid & 15) * 8;
                    float a8[8] = {0.f, 0.f, 0.f, 0.f, 0.f, 0.f, 0.f, 0.f};
#pragma unroll
                    for (int i = 0; i < 8; ++i) { const v4u kv = *(const v4u*)(KM + (size_t)(n * 256 + rg + 32 * i) * 1024 + h * 128 + c8);
                        a8[0] += bflo(kv.x); a8[1] += bfhi(kv.x); a8[2] += bflo(kv.y); a8[3] += bfhi(kv.y); a8[4] += bflo(kv.z); a8[5] += bfhi(kv.z); a8[6] += bflo(kv.w); a8[7] += bfhi(kv.w); }
#pragma unroll
                    for (int i = 0; i < 8; ++i) sm[rg * 128 + c8 + i] = a8[i];
                    __syncthreads();
                    if (tid < 128) { float s = 0.f;
#pragma unroll 8
                        for (int q = 0; q < 32; ++q) s += sm[q * 128 + tid];
                        KMEAN[(size_t)(n * 8 + h) * 128 + tid] = s * (1.f / 256.f); }
                    __syncthreads(); }
            }
            if (BOTH(pb + 2)) GRID_BAR();
        }
        if (IN(pb + 3)) {
            PH_IDS(); ArgsP ap = AP(); unsigned char* ws = ap->ws;
            const float* UL = (const float*)(ws + WS_UL); const float* B1E = (const float*)(CTLP(ws) + CW_B1E); const f32x2* ROPE = (const f32x2*)(ws + WS_ROPE);
            bf16* KCMP = (bf16*)(ws + WS_KCMP); bf16* VCMP = (bf16*)(ws + WS_VCMP); const float* cmp_w2 = ap->in[11];
            { const int kv = bid & 1; const float* w2 = cmp_w2 + (size_t)(l * 2 + kv) * 256 * 128; const float* be = B1E + (l * 2 + kv) * 256;
              for (int i = tid; i < 256 * 128 / 4; i += NTHR) *(LAS f32x4*)(sm + 4 * i) = *(const f32x4*)(w2 + 4 * i);
              LAS float* hid = (LAS float*)(lds + 135168) + wave * 256;
              __syncthreads();
              const int nb2 = (G + 1 - kv) >> 1;
              for (int r = (bid >> 1) * NWAVES + wave; r < NC * 2; r += nb2 * NWAVES) { const int c = r >> 1, g = r & 1;
                const float* Ur = UL + ((size_t)kv * 2048 + g * 1024 + c) * 512; const float* Lr = UL + ((size_t)kv * 2048 + g * 1024 + c + 1) * 512 + 256;
#pragma unroll
                for (int j = 0; j < 4; ++j) { const int n = lane + 64 * j; const float v = Ur[n] + Lr[n] + be[n];
                    hid[n] = 0.5f * v * (1.f + tanhf(0.7978845608028654f * (v + 0.044715f * v * v * v))); }
                LDS_WAIT(); asm volatile("" ::: "memory");
                float o0 = 0.f, o1 = 0.f;
#pragma unroll 8
                for (int n = 0; n < 256; ++n) { const float hv = hid[n]; o0 += hv * sm[n * 128 + lane]; o1 += hv * sm[n * 128 + 64 + lane]; }
                if (kv == 0) { const f32x2 cs = ROPE[(size_t)(16 * c + 31) * 64 + lane];
                    const float a = o0 * cs[0] - o1 * cs[1], b = o1 * cs[0] + o0 * cs[1];
                    *(unsigned*)(KCMP + ((size_t)c * 2 + g) * 128 + 2 * lane) = pk2(a, b);
                } else { VCMP[((size_t)c * 2 + g) * 128 + lane] = (bf16)f2bf(o0); VCMP[((size_t)c * 2 + g) * 128 + 64 + lane] = (bf16)f2bf(o1); }
                LDS_WAIT(); asm volatile("" ::: "memory");
              }
              __syncthreads(); }
            if (BOTH(pb + 3)) GRID_BAR();
        }
        if (IN(pb + 4)) {
            {   ArgsP ap = AP(); unsigned char* ws = ap->ws;
                const bf16* QN = (const bf16*)(ws + WS_QN); const bf16* KCMP = (const bf16*)(ws + WS_KCMP); const bf16* VCMP = (const bf16*)(ws + WS_VCMP);
                bf16* OCMP = (bf16*)(ws + WS_OCMP); float* IMP = (float*)(ws + WS_IMP);
                att::Seam S;
                for (int L = bid; L < 512; L += G) { const att::Ref cur = cmp_ref(L, QN, KCMP, VCMP, OCMP); float lse;
                    att::prime<RFCmp>(cur, (char*)lds_raw, S);
                    att::block<2, false, RFCmp>(cur, cur, nullptr, (char*)lds_raw, S, &lse);
                    att::imp_sweep<RFCmp>(cur, lse, IMP + ((size_t)cur.a1 * 64 * 2 + cur.a0) * 256, (char*)lds_raw, S); }
            }
            {   ArgsP ap = AP(); unsigned char* ws = ap->ws;
                const bf16* QN = (const bf16*)(ws + WS_QN); const bf16* KW = (const bf16*)(ws + WS_KW); const bf16* VW = (const bf16*)(ws + WS_VW); bf16* OWIN = (bf16*)(ws + WS_OWIN);
                __syncthreads();
                att::Seam S; int L = bid;
                if (L < 512) { att::Ref cur = win_ref(L, QN, KW, VW, OWIN); att::prime<RFReg>(cur, (char*)lds_raw, S);
                    for (;;) { const bool more = L + G < 512; const att::Ref nxt = more ? win_ref(L + G, QN, KW, VW, OWIN) : cur;
                        att::block<0, true, RFReg>(cur, nxt, nullptr, (char*)lds_raw, S);
                        if (!more) break; cur = nxt; L += G; } }
                __syncthreads();
            }
            {   PH_IDS(); ArgsP ap = AP(); unsigned char* ws = ap->ws;
                const bf16* QM = (const bf16*)(ws + WS_QM); const float* KMEAN = (const float*)(ws + WS_KMEAN);
                unsigned* MCNT = (unsigned*)(CTLP(ws) + CW_MCNT) + l * 512; int* MLIST = (int*)(ws + WS_MLIST); float* LSES = (float*)(ws + WS_LSES);
                LAS float* qs = sm; LAS float* ks = sm + 8192; LAS float* gs = sm + 8192 + 64 * 132;
                for (int u = bid; u < 2048; u += G) { const int c = u >> 3, h = u & 7, own = c >> 2;
                    __syncthreads();
                    for (int i = tid; i < 1024; i += NTHR) { const int q = i >> 4, c8 = (i & 15) * 8; const v4u kv = *(const v4u*)(QM + (size_t)(c * 64 + q) * 1024 + h * 128 + c8);
                        *(LAS f32x4*)(qs + q * 128 + c8) = (f32x4){bflo(kv.x), bfhi(kv.x), bflo(kv.y), bfhi(kv.y)}; *(LAS f32x4*)(qs + q * 128 + c8 + 4) = (f32x4){bflo(kv.z), bfhi(kv.z), bflo(kv.w), bfhi(kv.w)}; }
                    for (int i = tid; i < own * 32; i += NTHR) { const int n = i >> 5, c4 = (i & 31) * 4; *(LAS f32x4*)(ks + n * 132 + c4) = *(const f32x4*)(KMEAN + (size_t)(n * 8 + h) * 128 + c4); }
                    __syncthreads();
                    { const int q = tid >> 3, nn = tid & 7;
                      for (int n = nn; n < own; n += 8) { float a = 0.f;
#pragma unroll 8
                          for (int d = 0; d < 128; d += 4) { const f32x4 qa = *(const LAS f32x4*)(qs + q * 128 + d), ka = *(const LAS f32x4*)(ks + n * 132 + d); a += qa[0] * ka[0] + qa[1] * ka[1] + qa[2] * ka[2] + qa[3] * ka[3]; }
                          gs[q * 64 + n] = a; } }
                    __syncthreads();
                    { const int lam = lane & 15, rho = lane >> 4;
                      for (int qq = 0; qq < 2; ++qq) { const int q = wave * 8 + qq * 4 + rho, t = c * 64 + q;
                        float v[4];
#pragma unroll
                        for (int i = 0; i < 4; ++i) { const int n = lam + 16 * i; v[i] = (n < own) ? gs[q * 64 + n] : -INFINITY; }
                        int mysel = -1;
#pragma unroll
                        for (int r = 0; r < 3; ++r) { const int pick = row_pick<4>(v, lam); if (lam == r) mysel = pick; }
                        if (lam < 3) {
                            if (mysel >= 0) { const unsigned p = atomicAdd(MCNT + h * 64 + mysel, 1u); MLIST[(size_t)(h * 64 + mysel) * 16384 + p] = t * 4 + lam; }
                            else LSES[(t * 8 + h) * 3 + lam] = -INFINITY; } } }
                }
            }
            if (BOTH(pb + 4)) GRID_BAR();
        }
        if (IN(pb + 5)) {
            PH_IDS(); ArgsP ap = AP(); unsigned char* ws = ap->ws;
            {   PH_IDS(); ArgsP ap = AP(); unsigned char* ws = ap->ws;
                const float* IMP = (const float*)(ws + WS_IMP); int* SEL = (int*)(ws + WS_SEL);
                unsigned* NCNT = (unsigned*)(CTLP(ws) + CW_NCNT) + l * 512; int* NLIST = (int*)(ws + WS_NLIST);
                const int lam = lane & 15, rho = lane >> 4;
                for (int ub = gw * 4; ub < S_ * 2; ub += NGW * 4) { const int u = ub + rho, t = u >> 1, g = u & 1, tb = t >> 6;
                    float v[16];
#pragma unroll
                    for (int i = 0; i < 16; ++i) { const int j = lam + 16 * i; const float im = IMP[(size_t)u * 256 + j]; const bool forced = (j == 0) || (j == tb) || (j == tb - 1);
                        v[i] = (j > tb) ? -INFINITY : (forced ? 1e9f : im); }
                    int mysel = -1;
                    for (int r = 0; r < 16; ++r) { const int pick = row_pick<16>(v, lam); if (lam == r) mysel = pick; if (__all(pick < 0)) break; }
                    SEL[(size_t)u * 16 + lam] = mysel;
                    if (mysel >= 0) {
                        unsigned p;
                        if (mysel == 0) p = (unsigned)t; else if (mysel == tb) p = (unsigned)(t & 63); else if (mysel == tb - 1) p = 64u + (unsigned)(t & 63);
                        else p = 128u + atomicAdd(NCNT + g * 256 + mysel, 1u);
                        NLIST[(size_t)(g * 256 + mysel) * 16384 + p] = t * 16 + lam; }
                }
            }
            {   PH_IDS(); ArgsP ap = AP(); unsigned char* ws = ap->ws;
                const bf16* QM = (const bf16*)(ws + WS_QM); const bf16* KM = (const bf16*)(ws + WS_KM); const bf16* VM = (const bf16*)(ws + WS_VM);
                bf16* POWN = (bf16*)(ws + WS_POWN); bf16* PSEL = (bf16*)(ws + WS_PSEL); float* LSEO = (float*)(ws + WS_LSEO); float* LSES = (float*)(ws + WS_LSES);
                const int* MLIST = (const int*)(ws + WS_MLIST); unsigned* MCNT = (unsigned*)(CTLP(ws) + CW_MCNT) + l * 512;
                LAS int* mtab = (LAS int*)(lds + att::LDS_BYTES);
                __syncthreads();
                mtab[tid] = (int)__hip_atomic_load(MCNT + tid, RLX_AGENT);
                __syncthreads();
                if (tid == 0) { int us = 0; for (int i = 0; i < 512; ++i) { mtab[512 + i] = us; us += (mtab[i] + 255) >> 8; } mtab[1024] = us; }
                __syncthreads();
                const int nsel = mtab[1024];
                att::Seam S;
                { int L = bid;
                  if (L < 512) { att::Ref cur = mown_ref(L, QM, KM, VM, POWN); att::prime<RFReg>(cur, (char*)lds_raw, S);
                    for (;;) { const bool more = L + G < 512; const att::Ref nxt = more ? mown_ref(L + G, QM, KM, VM, POWN) : cur;
                        att::block<0, true, RFReg>(cur, nxt, LSEO, (char*)lds_raw, S);
                        if (!more) break; cur = nxt; L += G; } } }
                __syncthreads();
                { int L = bid;
                  if (L < nsel) { att::Ref cur = msel_ref(L, mtab, MLIST, QM, KM, VM, PSEL); att::prime<RFSel>(cur, (char*)lds_raw, S);
                    for (;;) { const bool more = L + G < nsel; const att::Ref nxt = more ? msel_ref(L + G, mtab, MLIST, QM, KM, VM, PSEL) : cur;
                        att::block<1, false, RFSel>(cur, nxt, LSES, (char*)lds_raw, S);
                        if (!more) break; cur = nxt; L += G; } } }
                __syncthreads();
            }
            if (BOTH(pb + 5)) GRID_BAR();
        }
        if (IN(pb + 6)) {
            PH_IDS(); ArgsP ap = AP(); unsigned char* ws = ap->ws;
            const bf16* POWN = (const bf16*)(ws + WS_POWN); const bf16* PSEL = (const bf16*)(ws + WS_PSEL); const float* LSEO = (const float*)(ws + WS_LSEO); const float* LSES = (const float*)(ws + WS_LSES);
            bf16* OMIX = (bf16*)(ws + WS_OMIX);
            for (int t = gw; t < S_; t += NGW) {
                const int hh = (lane >> 2) & 7, ii = lane & 3;
                const float lv = (ii == 0) ? LSEO[t * 8 + hh] : LSES[(t * 8 + hh) * 3 + ii - 1];
                float m = fmaxf(lv, __shfl_xor(lv, 1)); m = fmaxf(m, __shfl_xor(m, 2));
                float w = __expf(lv - m); float sw = w + __shfl_xor(w, 1); sw += __shfl_xor(sw, 2); w = w / sw;
#pragma unroll
                for (int hp = 0; hp < 2; ++hp) { const int h = hp * 4 + (lane >> 4), c8 = (lane & 15) * 8;
                    const float w0 = __shfl(w, h * 4), w1 = __shfl(w, h * 4 + 1), w2 = __shfl(w, h * 4 + 2), w3 = __shfl(w, h * 4 + 3);
                    const bf16* ps = PSEL + (size_t)((t * 8 + h) * 3) * 128 + c8;
                    const v4u a0 = *(const v4u*)(POWN + (size_t)t * 1024 + h * 128 + c8);
                    v4u a1 = (v4u){0u, 0u, 0u, 0u}, a2 = a1, a3 = a1;
                    if (w1 > 0.f) a1 = *(const v4u*)(ps); if (w2 > 0.f) a2 = *(const v4u*)(ps + 128); if (w3 > 0.f) a3 = *(const v4u*)(ps + 256);
                    v4u ov;
                    ov.x = pk2(w0 * bflo(a0.x) + w1 * bflo(a1.x) + w2 * bflo(a2.x) + w3 * bflo(a3.x), w0 * bfhi(a0.x) + w1 * bfhi(a1.x) + w2 * bfhi(a2.x) + w3 * bfhi(a3.x));
                    ov.y = pk2(w0 * bflo(a0.y) + w1 * bflo(a1.y) + w2 * bflo(a2.y) + w3 * bflo(a3.y), w0 * bfhi(a0.y) + w1 * bfhi(a1.y) + w2 * bfhi(a2.y) + w3 * bfhi(a3.y));
                    ov.z = pk2(w0 * bflo(a0.z) + w1 * bflo(a1.z) + w2 * bflo(a2.z) + w3 * bflo(a3.z), w0 * bfhi(a0.z) + w1 * bfhi(a1.z) + w2 * bfhi(a2.z) + w3 * bfhi(a3.z));
                    ov.w = pk2(w0 * bflo(a0.w) + w1 * bflo(a1.w) + w2 * bflo(a2.w) + w3 * bflo(a3.w), w0 * bfhi(a0.w) + w1 * bfhi(a1.w) + w2 * bfhi(a2.w) + w3 * bfhi(a3.w));
                    *(v4u*)(OMIX + (size_t)t * 2048 + 1024 + h * 128 + c8) = ov; }
            }
            if (BOTH(pb + 6)) GRID_BAR();

        }
        for (int g = 0; g < 2; ++g) {
            if (IN(pb + 7 + 2 * g)) {
                PH_IDS(); ArgsP ap = AP(); unsigned char* ws = ap->ws;
                const bf16* QN = (const bf16*)(ws + WS_QN); const bf16* KS = (const bf16*)(ws + WS_KS); const bf16* VS = (const bf16*)(ws + WS_VS);
                bf16* PSLC = (bf16*)(ws + WS_PSLC); float* LSEN = (float*)(ws + WS_LSEN); const int* NLIST = (const int*)(ws + WS_NLIST); unsigned* NCNT = (unsigned*)(CTLP(ws) + CW_NCNT) + l * 512 + g * 256;
                LAS int* ntab = (LAS int*)(lds + att::LDS_BYTES);
                __syncthreads();
                if (tid < 256) ntab[tid] = (tid == 0) ? S_ : (int)__hip_atomic_load(NCNT + tid, RLX_AGENT) + 64 + (tid < 255 ? 64 : 0);
                __syncthreads();
                if (tid == 0) { int us = 0; for (int i = 0; i < 256; ++i) { ntab[256 + i] = us; us += (ntab[i] + 63) >> 6; } ntab[512] = us; }
                __syncthreads();
                const int nun = ntab[512];
                att::Seam S; int L = bid;
                if (L < nun) { att::Ref cur = nsel_ref(L, g, ntab, NLIST, QN, KS, VS, PSLC); att::prime<RFSlc>(cur, (char*)lds_raw, S);
                    for (;;) { const bool more = L + G < nun; const att::Ref nxt = more ? nsel_ref(L + G, g, ntab, NLIST, QN, KS, VS, PSLC) : cur;
                        att::block<2, false, RFSlc>(cur, nxt, LSEN, (char*)lds_raw, S);
                        if (!more) break; cur = nxt; L += G; } }
                __syncthreads();
                if (BOTH(pb + 7 + 2 * g)) GRID_BAR();
            }
            if (IN(pb + 8 + 2 * g)) {
                PH_IDS(); ArgsP ap = AP(); unsigned char* ws = ap->ws;
                const bf16* PSLC = (const bf16*)(ws + WS_PSLC); const float* LSEN = (const float*)(ws + WS_LSEN); const int* SEL = (const int*)(ws + WS_SEL); const float* GATES = (const float*)(ws + WS_GATES);
                const bf16* OCMP = (const bf16*)(ws + WS_OCMP); const bf16* OWIN = (const bf16*)(ws + WS_OWIN); bf16* OMIX = (bf16*)(ws + WS_OMIX);
                for (int t = gw; t < S_; t += NGW) {
                    const int sv = (lane < 16) ? SEL[(size_t)(t * 2 + g) * 16 + lane] : -1;
                    const int nsel = __popcll(__ballot(sv >= 0));
                    const float lv = ((lane >> 2) < nsel) ? LSEN[(size_t)t * 64 + lane] : -INFINITY;
                    float m = lv;
#pragma unroll
                    for (int o = 4; o < 64; o <<= 1) m = fmaxf(m, __shfl_xor(m, o));
                    float w = __expf(lv - m), sw = w;
#pragma unroll
                    for (int o = 4; o < 64; o <<= 1) sw += __shfl_xor(sw, o);
                    w = w / sw;
                    const int r = lane >> 4, c8 = (lane & 15) * 8;
                    float o8[8] = {0.f, 0.f, 0.f, 0.f, 0.f, 0.f, 0.f, 0.f};
                    v4u pv[16];
#pragma unroll
                    for (int s = 0; s < 16; ++s) { const int sc = s < nsel ? s : nsel - 1; pv[s] = *(const v4u*)(PSLC + ((size_t)(t * 16 + sc) * 4 + r) * 128 + c8); }
#pragma unroll
                    for (int s = 0; s < 16; ++s) { const float ws_ = __shfl(w, s * 4 + r);
                        o8[0] += ws_ * bflo(pv[s].x); o8[1] += ws_ * bfhi(pv[s].x); o8[2] += ws_ * bflo(pv[s].y); o8[3] += ws_ * bfhi(pv[s].y);
                        o8[4] += ws_ * bflo(pv[s].z); o8[5] += ws_ * bfhi(pv[s].z); o8[6] += ws_ * bflo(pv[s].w); o8[7] += ws_ * bfhi(pv[s].w); }
                    const int hd = g * 4 + r; const float g0 = GATES[(size_t)t * 32 + hd * 3], g1 = GATES[(size_t)t * 32 + hd * 3 + 1], g2 = GATES[(size_t)t * 32 + hd * 3 + 2];
                    const size_t oi = (size_t)t * 1024 + hd * 128 + c8;
                    const v4u cv = *(const v4u*)(OCMP + oi), wv = *(const v4u*)(OWIN + oi);
                    v4u ov;
                    ov.x = pk2(g1 * o8[0] + g0 * bflo(cv.x) + g2 * bflo(wv.x), g1 * o8[1] + g0 * bfhi(cv.x) + g2 * bfhi(wv.x));
                    ov.y = pk2(g1 * o8[2] + g0 * bflo(cv.y) + g2 * bflo(wv.y), g1 * o8[3] + g0 * bfhi(cv.y) + g2 * bfhi(wv.y));
                    ov.z = pk2(g1 * o8[4] + g0 * bflo(cv.z) + g2 * bflo(wv.z), g1 * o8[5] + g0 * bfhi(cv.z) + g2 * bfhi(wv.z));
                    ov.w = pk2(g1 * o8[6] + g0 * bflo(cv.w) + g2 * bflo(wv.w), g1 * o8[7] + g0 * bfhi(cv.w) + g2 * bfhi(wv.w));
                    *(v4u*)(OMIX + (size_t)t * 2048 + hd * 128 + c8) = ov;
                }
                if (BOTH(pb + 8 + 2 * g)) GRID_BAR();
            }
        }
        if (IN(pb + 11)) {
            ArgsP ap = AP(); unsigned char* ws = ap->ws;
            pg8::Gemm g{(const bf16*)(ws + WS_OMIX), (const bf16*)(ws + WS_WOUTT) + (size_t)l * D_ * D_, S_, D_, D_}; pg8::StaticOrder So; So.init(S_, D_, G, bid);
            EpiOutProj E{l == 0 ? ap->in[0] : (const float*)ap->out, ap->out, (const float*)(CTLP(ws) + CW_MOD) + l * 12288 + 4096};
            pg8::gemm_phase<EpiOutProj, pg8::StaticOrder, true, true>(lds, g, So, E);
            if (BOTH(pb + 11)) GRID_BAR();
        }
        if (IN(pb + 12)) {
            PH_IDS(); ArgsP ap = AP(); unsigned char* ws = ap->ws;
            const float* mod = (const float*)(CTLP(ws) + CW_MOD) + l * 12288;
            const float* X = ap->out; bf16* H = (bf16*)(ws + WS_H); const bf16* WrT = (const bf16*)(ws + WS_WRT); const float* b_router = ap->in[13];
            unsigned* CNT = (unsigned*)(CTLP(ws) + CW_CNT) + l * 32; int* TE = (int*)(ws + WS_TE); int* TOKIDX = (int*)(ws + WS_TOKIDX); float* WTS = (float*)(ws + WS_WTS);
            { const float* g_ffn = ap->in[5];
              for (int k = tid; k < D_; k += NTHR) { sm[k] = g_ffn[l * D_ + k] * (1.f + mod[8192 + k]); sm[2048 + k] = mod[6144 + k]; }
              if (tid < 32) sm[4160 + tid] = b_router[tid]; }
            typedef short bf16x8_t __attribute__((ext_vector_type(8))); typedef float f32x16_t __attribute__((ext_vector_type(16)));
            for (int bt = bid; bt < S_ / 64; bt += G) { const int t0 = bt * 64;
                __syncthreads();
                for (int rr = 0; rr < 8; ++rr) { const int row = wave * 8 + rr; float ss = 0.f;
#pragma unroll
                    for (int j = 0; j < 8; ++j) { const f32x4 v = *(const f32x4*)(X + (size_t)(t0 + row) * D_ + 256 * j + 4 * lane); ss += (v[0] * v[0] + v[1] * v[1]) + (v[2] * v[2] + v[3] * v[3]); }
                    ss = wave_sum(ss); if (lane == 0) sm[4096 + row] = 1.f / sqrtf(ss * (1.f / D_) + RMS_EPS); }
                __syncthreads();
                { const int r = lane & 31, kh = lane >> 5; f32x16_t acc0 = {}, acc1 = {};
                  const float rs0 = sm[4096 + r], rs1 = sm[4096 + 32 + r];
#pragma unroll 1
                  for (int ks = 0; ks < 16; ++ks) { const int k = wave * 256 + ks * 16 + kh * 8;
                    const bf16x8_t wh = *(const bf16x8_t*)(WrT + (size_t)r * 2048 + k), wl = *(const bf16x8_t*)(WrT + 32 * 2048 + (size_t)r * 2048 + k);
                    const f32x4 gA = *(const LAS f32x4*)(sm + k), gB = *(const LAS f32x4*)(sm + k + 4), sA = *(const LAS f32x4*)(sm + 2048 + k), sB = *(const LAS f32x4*)(sm + 2048 + k + 4);
#pragma unroll
                    for (int rg = 0; rg < 2; ++rg) { const size_t ro = (size_t)(t0 + rg * 32 + r) * D_ + k; const float rs = rg ? rs1 : rs0;
                        const f32x4 xa = *(const f32x4*)(X + ro), xb = *(const f32x4*)(X + ro + 4);
                        const f32x4 ha = xa * rs * gA + sA, hb = xb * rs * gB + sB;
                        const unsigned h0 = pk2(ha[0], ha[1]), h1 = pk2(ha[2], ha[3]), h2 = pk2(hb[0], hb[1]), h3 = pk2(hb[2], hb[3]);
                        *(v4u*)(H + ro) = (v4u){h0, h1, h2, h3};
                        const unsigned l0 = pk2(ha[0] - bflo(h0), ha[1] - bfhi(h0)), l1 = pk2(ha[2] - bflo(h1), ha[3] - bfhi(h1)), l2 = pk2(hb[0] - bflo(h2), hb[1] - bfhi(h2)), l3 = pk2(hb[2] - bflo(h3), hb[3] - bfhi(h3));
                        const v4u hv = (v4u){h0, h1, h2, h3}, lv = (v4u){l0, l1, l2, l3};
                        const bf16x8_t ahi = __builtin_bit_cast(bf16x8_t, hv), alo = __builtin_bit_cast(bf16x8_t, lv);
                        if (rg == 0) { acc0 = __builtin_amdgcn_mfma_f32_32x32x16_bf16(wh, ahi, acc0, 0, 0, 0); acc0 = __builtin_amdgcn_mfma_f32_32x32x16_bf16(wl, ahi, acc0, 0, 0, 0); acc0 = __builtin_amdgcn_mfma_f32_32x32x16_bf16(wh, alo, acc0, 0, 0, 0); }
                        else         { acc1 = __builtin_amdgcn_mfma_f32_32x32x16_bf16(wh, ahi, acc1, 0, 0, 0); acc1 = __builtin_amdgcn_mfma_f32_32x32x16_bf16(wl, ahi, acc1, 0, 0, 0); acc1 = __builtin_amdgcn_mfma_f32_32x32x16_bf16(wh, alo, acc1, 0, 0, 0); } } }
#pragma unroll
                  for (int q = 0; q < 16; ++q) { const int e = (q & 3) + 8 * (q >> 2) + 4 * kh;
                      sm[5120 + ((wave * 2 + 0) * 32 + e) * 32 + r] = acc0[q]; sm[5120 + ((wave * 2 + 1) * 32 + e) * 32 + r] = acc1[q]; } }
                __syncthreads();
                { const int tk6 = tid & 63, eq = tid >> 6, rg = tk6 >> 5, tk = tk6 & 31;
#pragma unroll
                  for (int i = 0; i < 4; ++i) { const int e = eq * 4 + i; float s = 0.f;
#pragma unroll
                      for (int w = 0; w < 8; ++w) s += sm[5120 + ((w * 2 + rg) * 32 + e) * 32 + tk];
                      sm[5120 + 16384 + tk6 * 33 + e] = 1.f / (1.f + __expf(-s)); } }
                __syncthreads();
                if (tid < 64) { const int t = t0 + tid;
                    float lg[32];
#pragma unroll
                    for (int e = 0; e < 32; ++e) lg[e] = sm[5120 + 16384 + tid * 33 + e];
                    int grp = 0; float best = -INFINITY;
#pragma unroll
                    for (int gq = 0; gq < 4; ++gq) { float m1 = -INFINITY, m2 = -INFINITY;
#pragma unroll
                        for (int i = 0; i < 8; ++i) { const float b = lg[gq * 8 + i] + sm[4160 + gq * 8 + i]; if (b > m1) { m2 = m1; m1 = b; } else if (b > m2) m2 = b; }
                        const float sgs = m1 + m2; if (sgs > best) { best = sgs; grp = gq; } }
                    float m1 = -INFINITY, m2 = -INFINITY, s1 = 0.f, s2 = 0.f; int i1 = 0, i2 = 0;
#pragma unroll
                    for (int e = 0; e < 32; ++e) { const bool ing = (e >> 3) == grp; const float b = lg[e] + sm[4160 + e];
                        if (ing && b > m1) { m2 = m1; i2 = i1; s2 = s1; m1 = b; i1 = e; s1 = lg[e]; } else if (ing && b > m2) { m2 = b; i2 = e; s2 = lg[e]; } }
                    const float inv = 1.f / (s1 + s2);
                    const unsigned p1 = atomicAdd(CNT + i1, 1u), p2 = atomicAdd(CNT + i2, 1u);
                    TOKIDX[(size_t)i1 * ECAP + p1] = t; TOKIDX[(size_t)i2 * ECAP + p2] = t; WTS[(size_t)i1 * ECAP + p1] = s1 * inv; WTS[(size_t)i2 * ECAP + p2] = s2 * inv;
                    *(int4*)(TE + 4 * t) = make_int4(i1, (int)p1, i2, (int)p2);
                }
            }
            if (BOTH(pb + 12)) GRID_BAR();
        }
        if (IN(pb + 13)) {
            PH_IDS(); ArgsP ap = AP(); unsigned char* ws = ap->ws;
            LOAD_MOETAB((unsigned*)(CTLP(ws) + CW_CNT) + l * 32, 4);
            pg8::Gemm g{(const bf16*)(ws + WS_H), (const bf16*)(ws + WS_WGUT), 0, 0, D_}; MoeOrder<true> So{moetab, 4, G, bid, 4, l * 32 * 4, (const int*)(ws + WS_TOKIDX)};
            EpiGateUp E{(bf16*)(ws + WS_HACT)};
            pg8::gemm_phase<EpiGateUp, MoeOrder<true>, true, true>(lds, g, So, E);
            if (BOTH(pb + 13)) GRID_BAR();
        }
        if (IN(pb + 14)) {
            PH_IDS(); ArgsP ap = AP(); unsigned char* ws = ap->ws;
            LOAD_MOETAB((unsigned*)(CTLP(ws) + CW_CNT) + l * 32, 8);
            pg8::Gemm g{(const bf16*)(ws + WS_HACT), (const bf16*)(ws + WS_WDT), 0, 0, DEXP}; MoeOrder<false> So{moetab, 8, G, bid, 8, l * 32 * 8, nullptr};
            EpiDown E{(bf16*)(ws + WS_Y), (const float*)(ws + WS_WTS), moetab};
            pg8::gemm_phase<EpiDown, MoeOrder<false>, true, true>(lds, g, So, E);
            if (BOTH(pb + 14)) GRID_BAR();
        }
    }
    if (IN(NPH - 1)) {
        PH_IDS(); ArgsP ap = AP(); unsigned char* ws = ap->ws;
        float* X = ap->out; const bf16* Y = (const bf16*)(ws + WS_Y); const int* TE = (const int*)(ws + WS_TE);
        LOAD_MOETAB((unsigned*)(CTLP(ws) + CW_CNT) + 32, 1);
        const bool tmo_set = (MK_N_LAUNCHES == 1) && (__hip_atomic_load((unsigned*)(CTLP(ws) + CW_BAR) + XB_TMO, RLX_AGENT) != 0u);
        { const float* g_final = ap->in[17]; const float* MOD = (const float*)(CTLP(ws) + CW_MOD);
          for (int k = tid; k < D_; k += NTHR) { sm[k] = g_final[k]; sm[2048 + k] = MOD[12288 + 10240 + k]; } }
        __syncthreads();
        for (int t = gw; t < S_; t += NGW) {
            f32x4 v[8]; float ss = 0.f;
            const int4 te = *(const int4*)(TE + 4 * t);
            const bf16* y0 = Y + (size_t)(moetab[65 + te.x] + te.y) * D_; const bf16* y1 = Y + (size_t)(moetab[65 + te.z] + te.w) * D_;
#pragma unroll
            for (int j = 0; j < 8; ++j) { const int k = 256 * j + 4 * lane; const uint2 a = *(const uint2*)(y0 + k), b = *(const uint2*)(y1 + k);
                const f32x4 gt2 = *(const LAS f32x4*)(sm + 2048 + k);
                f32x4 ysum = (f32x4){bflo(a.x) + bflo(b.x), bfhi(a.x) + bfhi(b.x), bflo(a.y) + bflo(b.y), bfhi(a.y) + bfhi(b.y)};
                v[j] = *(const f32x4*)(X + (size_t)t * D_ + k) + gt2 * ysum;
                ss += (v[j][0] * v[j][0] + v[j][1] * v[j][1]) + (v[j][2] * v[j][2] + v[j][3] * v[j][3]); }
            const float rstd = (tmo_set ? __builtin_nanf("") : 1.f) / sqrtf(wave_sum(ss) * (1.f / D_) + RMS_EPS);
#pragma unroll
            for (int j = 0; j < 8; ++j) { const int k = 256 * j + 4 * lane; *(f32x4*)(X + (size_t)t * D_ + k) = v[j] * rstd * *(const LAS f32x4*)(sm + k); }
        }
    }
#undef IN
#undef BOTH
#undef GRID_BAR
#undef LOAD_MOETAB
#undef AP
#undef CTLP
#undef PH_IDS
}

extern "C" void kernel_launch(void* const* d_in, const int* in_sizes, int n_in, void* d_out, int out_size, void* d_ws, size_t ws_size, hipStream_t stream) {
    static int grid = 0;
    if (grid == 0) {
        if (n_in != 18 || out_size != S_ * D_ || ws_size < WS_END) { fprintf(stderr, "kernel_launch: unexpected shapes (n_in %d out %d ws %zu)\n", n_in, out_size, ws_size); grid = -1; return; }
        int dev = 0, cus = 0, per_cu = 0;
        if (hipGetDevice(&dev) != hipSuccess || hipDeviceGetAttribute(&cus, hipDeviceAttributeMultiprocessorCount, dev) != hipSuccess) { grid = -1; return; }
        if (hipFuncSetAttribute((const void*)mk_fwd, hipFuncAttributeMaxDynamicSharedMemorySize, LDS_BYTES) != hipSuccess) { fprintf(stderr, "kernel_launch: hipFuncSetAttribute failed\n"); grid = -1; return; }
        if (hipOccupancyMaxActiveBlocksPerMultiprocessor(&per_cu, (const void*)mk_fwd, NTHR, LDS_BYTES) != hipSuccess || per_cu < 1) { fprintf(stderr, "kernel_launch: occupancy query says %d\n", per_cu); }
        (void)hipGetLastError();
        grid = cus;
    }
    if (grid < 0) return;
    if (hipMemsetAsync((char*)d_ws + WS_CTL, 0, CTL_ZERO_BYTES, stream) != hipSuccess) return;
    Args a{};
    for (int i = 0; i < 18; ++i) a.in[i] = (const float*)d_in[i];
    a.out = (float*)d_out; a.ws = (unsigned char*)d_ws; a.pad = 0;
    if (MK_N_LAUNCHES == 1) {
        a.ph_lo = 0; a.ph_hi = NPH; a.li = 0;
        hipLaunchKernelGGL(mk_fwd, dim3(grid), dim3(NTHR), LDS_BYTES, stream, a);
    } else {
        for (int p = 0; p < NPH; ++p) { a.ph_lo = p; a.ph_hi = p + 1; a.li = p; hipLaunchKernelGGL(mk_fwd, dim3(grid), dim3(NTHR), LDS_BYTES, stream, a); }
    }
}
```

```cpp
#include <hip/hip_runtime.h>
#include <cstdio>
#include <cstdint>

namespace pg8 {
#define PG8_LAS __attribute__((address_space(3)))
typedef unsigned short bf16_t;
typedef short bf16x8 __attribute__((ext_vector_type(8)));
typedef float f32x4 __attribute__((ext_vector_type(4)));
typedef unsigned u32x4 __attribute__((ext_vector_type(4)));
constexpr int BM = 256, BK = 64, HALF = 128, HTB = HALF * BK * 2, STAGE_BYTES = 8 * HTB, NXCD = 8, WGM = 8;

__host__ __device__ __forceinline__ int lds_byte(int r, int c) { const int st = (r >> 4) * 2 + (c >> 5), rr = r & 15, cc = c & 31, ob = rr * 64 + cc * 2; return st * 1024 + (ob ^ (((ob >> 9) & 1) << 5)); }
__host__ __device__ __forceinline__ void stage_rc(int b, int& R, int& C) { const int st = b / 1024, sb = b % 1024, swz = sb ^ (((sb >> 9) & 1) << 5); R = (st >> 1) * 16 + swz / 64; C = (st & 1) * 32 + (swz % 64) / 2; }
__host__ __device__ __forceinline__ int perm32(int rho) { const int n = rho >> 4, i = rho & 15; return 8 * (i >> 2) + 4 * n + (i & 3); }

struct Unit { int pm, pn, e, mt, pnl; };
struct Gemm { const bf16_t* A; const bf16_t* Bt; int M, N, K; };

struct StaticOrder {
    static constexpr bool GATHER = false;
    int nM, nN, nwg, G, c;
    __host__ __device__ void init(int M, int N, int G_, int c_) { nM = M / BM; nN = N / BM; nwg = nM * nN; G = G_; c = c_; }
    __host__ __device__ bool next(int i, Unit& u) const {
        const long L = (long)i * G + c; if (L >= nwg) return false;
        int wgid = (int)L; { const int q = nwg / NXCD, r = nwg % NXCD, xcd = wgid % NXCD, off = wgid / NXCD; wgid = (xcd < r ? xcd * (q + 1) : r * (q + 1) + (xcd - r) * q) + off; }
        const int nig = WGM * nN, gid = wgid / nig, fm = gid * WGM, gsz = (nM - fm) < WGM ? (nM - fm) : WGM;
        u.pm = fm + ((wgid % nig) % gsz); u.pn = (wgid % nig) / gsz; u.e = 0; u.mt = 0; u.pnl = u.pn; return true;
    }
    __device__ __forceinline__ void a_offs(const Unit&, int, int, int, int, int, unsigned (&)[2][2]) const {}
    __device__ __forceinline__ void a_ready(const Unit&) const {}
    __device__ __forceinline__ void done(const Unit&) const {}
};

__device__ __forceinline__ unsigned cvt_pk_bf16(float lo, float hi) { unsigned r; asm volatile("v_cvt_pk_bf16_f32 %0, %1, %2" : "=v"(r) : "v"(lo), "v"(hi)); return r; }

template <class Epi, class Sched, bool ALIGN_EPI = false, bool SP2 = false>
__device__ __forceinline__ void gemm_phase(PG8_LAS unsigned char* lds, const Gemm g, const Sched& S, const Epi& E) {
    int tid_ = threadIdx.x; asm volatile("" : "+v"(tid_));
    const int tid = tid_, wid = __builtin_amdgcn_readfirstlane(tid >> 6), lane = tid & 63, wr = wid >> 2, wc = wid & 3, fr = lane & 15, fq = lane >> 4;
    const int K = g.K, nt = K / BK;
    unsigned voffA[2], voffB[2]; int RR[2], CC[2];
#pragma unroll
    for (int i = 0; i < 2; ++i) { int R, C; stage_rc(tid * 16 + i * 8192, R, C); const int Rb = Epi::PERM ? ((R & ~31) + perm32(R & 31)) : R;
        RR[i] = R; CC[i] = C; voffA[i] = (unsigned)(R * K + C) * 2u; voffB[i] = (unsigned)(Rb * K + C) * 2u; }
    const size_t kstep = (size_t)(BK * 2);
    const size_t hstep = (size_t)HALF * K * 2;
    const size_t tstep = 2 * hstep;
    const unsigned ldsw = (unsigned)wid * 1024u;
    const int aoff = lds_byte(wr * 64 + fr, fq * 8), boff = lds_byte(wc * 32 + fr, fq * 8);
    const char* gA = (const char*)g.A;
    unsigned aoC[2][2] = {{0u, 0u}, {0u, 0u}}, aoN[2][2] = {{0u, 0u}, {0u, 0u}};
#define PG8_SA(b, h) (((b) * 2 + (h)) * HTB)
#define PG8_SB(b, h) ((4 + (b) * 2 + (h)) * HTB)
#define PG8_STAGE(bufoff, gbase, voff) do { _Pragma("unroll") for (int _i = 0; _i < 2; ++_i) \
        __builtin_amdgcn_global_load_lds((const unsigned*)((const char*)(gbase) + (voff)[_i]), (PG8_LAS unsigned*)(lds + (bufoff) + ldsw + _i * 8192), 16, 0, 0); } while (0)
#define PG8_STAGE_A(bufoff, h, PN, KO) do { if constexpr (Sched::GATHER) { _Pragma("unroll") for (int _i = 0; _i < 2; ++_i) \
        __builtin_amdgcn_global_load_lds((const unsigned*)(gA + aoC[h][_i] + (KO)), (PG8_LAS unsigned*)(lds + (bufoff) + ldsw + _i * 8192), 16, 0, 0); } \
        else { PG8_STAGE(bufoff, (PN) + (h) * hstep, voffA); } } while (0)
#define PG8_LDA(dst, b, h) do { _Pragma("unroll") for (int m = 0; m < 4; ++m) _Pragma("unroll") for (int k = 0; k < 2; ++k) dst[m][k] = *(const PG8_LAS bf16x8*)(lds + PG8_SA(b, h) + aoff + m * 2048 + k * 1024); } while (0)
#define PG8_LDB(dst, b, h) do { _Pragma("unroll") for (int n = 0; n < 2; ++n) _Pragma("unroll") for (int k = 0; k < 2; ++k) dst[n][k] = *(const PG8_LAS bf16x8*)(lds + PG8_SB(b, h) + boff + n * 2048 + k * 1024); } while (0)
#define PG8_MMA(ai, bj, At, Bt) do { __builtin_amdgcn_s_setprio(1); _Pragma("unroll") for (int m = 0; m < 4; ++m) _Pragma("unroll") for (int n = 0; n < 2; ++n) _Pragma("unroll") for (int k = 0; k < 2; ++k) \
        acc[ai][bj][m][n] = __builtin_amdgcn_mfma_f32_16x16x32_bf16(Bt[n][k], At[m][k], acc[ai][bj][m][n], 0, 0, 0); __builtin_amdgcn_s_setprio(0); } while (0)
#define PG8_WAIT_V(n) asm volatile("s_waitcnt vmcnt(" #n ")" ::: "memory")
#define PG8_WAIT_L(n) asm volatile("s_waitcnt lgkmcnt(" #n ")" ::: "memory")
#define PG8_BAR __builtin_amdgcn_s_barrier()
#define PG8_SCHED __builtin_amdgcn_sched_barrier(0)
    Unit cur, nxt; int ui = 0;
    if (!S.next(0, cur)) return;
    f32x4 acc[2][2][4][2];
#pragma unroll
    for (int a = 0; a < 2; ++a)
#pragma unroll
        for (int b = 0; b < 2; ++b)
#pragma unroll
            for (int m = 0; m < 4; ++m)
#pragma unroll
                for (int n = 0; n < 2; ++n) acc[a][b][m][n] = (f32x4){0.f, 0.f, 0.f, 0.f};
    bf16x8 At[4][2], B0[2][2], B1[2][2];
    const char* cA = (const char*)g.A + (size_t)cur.pm * tstep; const char* cB = (const char*)g.Bt + (size_t)cur.pn * tstep;
    if constexpr (Sched::GATHER) S.a_offs(cur, RR[0], RR[1], CC[0], CC[1], K, aoC);
    S.a_ready(cur);
    if constexpr (SP2) {
        PG8_STAGE(PG8_SB(0, 0), cB, voffB); PG8_STAGE(PG8_SB(0, 1), cB + hstep, voffB); PG8_STAGE_A(PG8_SA(0, 0), 0, cA, 0); PG8_STAGE_A(PG8_SA(0, 1), 1, cA, 0);
        if (wr == 1) PG8_BAR;
        PG8_WAIT_V(2); PG8_BAR;
        PG8_STAGE(PG8_SB(1, 0), cB + kstep, voffB); PG8_STAGE_A(PG8_SA(1, 0), 0, cA + kstep, kstep); PG8_STAGE(PG8_SB(1, 1), cB + hstep + kstep, voffB);
        PG8_WAIT_V(6); PG8_BAR;
    } else {
        PG8_STAGE(PG8_SB(0, 0), cB, voffB); PG8_STAGE_A(PG8_SA(0, 0), 0, cA, 0); PG8_STAGE(PG8_SB(0, 1), cB + hstep, voffB); PG8_STAGE_A(PG8_SA(0, 1), 1, cA, 0);
        if (wr == 1) PG8_BAR;
        PG8_WAIT_V(4); PG8_BAR;
        PG8_STAGE(PG8_SB(1, 0), cB + kstep, voffB); PG8_STAGE_A(PG8_SA(1, 0), 0, cA + kstep, kstep); PG8_STAGE(PG8_SB(1, 1), cB + hstep + kstep, voffB);
        PG8_WAIT_V(6); PG8_BAR;
    }
    for (;;) {
        const bool has_next = S.next(ui + 1, nxt);
        const char* nA = has_next ? (const char*)g.A + (size_t)nxt.pm * tstep : cA; const char* nB = has_next ? (const char*)g.Bt + (size_t)nxt.pn * tstep : cB;
        if constexpr (Sched::GATHER) {
            if (has_next) S.a_offs(nxt, RR[0], RR[1], CC[0], CC[1], K, aoN);
            else {
#pragma unroll
                for (int h = 0; h < 2; ++h)
#pragma unroll
                    for (int i = 0; i < 2; ++i) aoN[h][i] = aoC[h][i]; }
        }
        for (int t = 0; t < nt; t += 2) {
            const bool last = (t == nt - 2);
            const char* a1 = cA + (size_t)(t + 1) * kstep;
            const char* a2 = last ? nA : cA + (size_t)(t + 2) * kstep; const char* b2 = last ? nB : cB + (size_t)(t + 2) * kstep;
            const char* a3 = a2 + kstep; const char* b3 = b2 + kstep;
            const size_t k1 = (size_t)(t + 1) * kstep, k2 = last ? (size_t)0 : (size_t)(t + 2) * kstep, k3 = k2 + kstep;
            if (last && has_next) S.a_ready(nxt);
            if constexpr (SP2) {
            PG8_LDB(B0, 0, 0); PG8_LDB(B1, 0, 1); PG8_SCHED; PG8_LDA(At, 0, 0); PG8_STAGE_A(PG8_SA(1, 1), 1, a1, k1);
            if constexpr (Sched::GATHER) { if (last) {
#pragma unroll
                for (int h = 0; h < 2; ++h)
#pragma unroll
                    for (int i = 0; i < 2; ++i) aoC[h][i] = aoN[h][i]; } }
            PG8_WAIT_V(8); PG8_WAIT_L(0); PG8_BAR; PG8_MMA(0, 0, At, B0); PG8_MMA(0, 1, At, B1); PG8_BAR; PG8_SCHED;
            PG8_LDA(At, 0, 1); PG8_STAGE(PG8_SB(0, 0), b2, voffB); PG8_STAGE(PG8_SB(0, 1), b2 + hstep, voffB); PG8_STAGE_A(PG8_SA(0, 0), 0, a2, k2);
            PG8_WAIT_V(8); PG8_WAIT_L(0); PG8_BAR; PG8_MMA(1, 0, At, B0); PG8_MMA(1, 1, At, B1); PG8_BAR; PG8_SCHED;
            PG8_LDB(B0, 1, 0); PG8_LDB(B1, 1, 1); PG8_SCHED; PG8_LDA(At, 1, 0); PG8_STAGE_A(PG8_SA(0, 1), 1, a2, k2);
            PG8_WAIT_V(8); PG8_WAIT_L(0); PG8_BAR; PG8_MMA(0, 0, At, B0); PG8_MMA(0, 1, At, B1); PG8_BAR; PG8_SCHED;
            PG8_LDA(At, 1, 1); PG8_STAGE(PG8_SB(1, 0), b3, voffB); PG8_STAGE(PG8_SB(1, 1), b3 + hstep, voffB); PG8_STAGE_A(PG8_SA(1, 0), 0, a3, k3);
            PG8_WAIT_V(8); PG8_WAIT_L(0); PG8_BAR; PG8_MMA(1, 0, At, B0); PG8_MMA(1, 1, At, B1); PG8_BAR; PG8_SCHED;
            } else {
            PG8_LDB(B0, 0, 0); PG8_SCHED; PG8_LDA(At, 0, 0); PG8_STAGE_A(PG8_SA(1, 1), 1, a1, k1);
            if constexpr (Sched::GATHER) { if (last) {
#pragma unroll
                for (int h = 0; h < 2; ++h)
#pragma unroll
                    for (int i = 0; i < 2; ++i) aoC[h][i] = aoN[h][i]; } }
            PG8_WAIT_L(8); PG8_BAR; PG8_WAIT_L(0); PG8_MMA(0, 0, At, B0); PG8_BAR; PG8_SCHED;
            PG8_LDB(B1, 0, 1); PG8_STAGE(PG8_SB(0, 0), b2, voffB);
            PG8_BAR; PG8_WAIT_L(0); PG8_MMA(0, 1, At, B1); PG8_BAR;
            PG8_LDA(At, 0, 1); PG8_STAGE_A(PG8_SA(0, 0), 0, a2, k2);
            PG8_BAR; PG8_WAIT_L(0); PG8_MMA(1, 0, At, B0); PG8_BAR; PG8_SCHED;
            PG8_STAGE(PG8_SB(0, 1), b2 + hstep, voffB);
            PG8_WAIT_V(6); PG8_BAR; PG8_MMA(1, 1, At, B1); PG8_BAR;
            PG8_LDB(B0, 1, 0); PG8_SCHED; PG8_LDA(At, 1, 0); PG8_STAGE_A(PG8_SA(0, 1), 1, a2, k2);
            PG8_WAIT_L(8); PG8_BAR; PG8_WAIT_L(0); PG8_MMA(0, 0, At, B0); PG8_BAR; PG8_SCHED;
            PG8_LDB(B1, 1, 1); PG8_STAGE(PG8_SB(1, 0), b3, voffB);
            PG8_BAR; PG8_WAIT_L(0); PG8_MMA(0, 1, At, B1); PG8_BAR;
            PG8_LDA(At, 1, 1); PG8_STAGE_A(PG8_SA(1, 0), 0, a3, k3);
            PG8_BAR; PG8_WAIT_L(0); PG8_MMA(1, 0, At, B0); PG8_BAR; PG8_SCHED;
            PG8_STAGE(PG8_SB(1, 1), b3 + hstep, voffB);
            PG8_WAIT_V(6); PG8_BAR; PG8_MMA(1, 1, At, B1); PG8_BAR;
            }
        }
        if constexpr (ALIGN_EPI) { if (wr == 0) PG8_BAR; }
        E(acc, cur, wr, wc, fr, fq); S.done(cur);
        if (!has_next) break;
#pragma unroll
        for (int a = 0; a < 2; ++a)
#pragma unroll
            for (int b = 0; b < 2; ++b)
#pragma unroll
                for (int m = 0; m < 4; ++m)
#pragma unroll
                    for (int n = 0; n < 2; ++n) acc[a][b][m][n] = (f32x4){0.f, 0.f, 0.f, 0.f};
        cur = nxt; cA = nA; cB = nB; ++ui;
        if constexpr (ALIGN_EPI) { if (wr == 1) PG8_BAR; }
    }
    PG8_WAIT_V(0);
    if constexpr (!ALIGN_EPI) { if (wr == 0) PG8_BAR; }
    PG8_BAR;
#undef PG8_SA
#undef PG8_SB
#undef PG8_STAGE
#undef PG8_STAGE_A
#undef PG8_LDA
#undef PG8_LDB
#undef PG8_MMA
#undef PG8_WAIT_V
#undef PG8_WAIT_L
#undef PG8_BAR
#undef PG8_SCHED
}
}

#ifndef MK_N_LAUNCHES
#define MK_N_LAUNCHES 1
#endif
constexpr int NWAVES = 8, NTHR = 512;
constexpr int S_ = 16384, D_ = 2048, DEPTH = 2, HD = 128;
constexpr int IN_W = 5656, NIN = 5888;
constexpr int NC = 1023;
constexpr int NEXP = 32, DEXP = 512, ECAP = 16384, NSLOT = 40960;
constexpr float RMS_EPS = 1e-6f;
constexpr float ATT_SCALE = 0.08838834764831845f;
constexpr int NPL = 15, NPH = 2 + 2 * NPL;

constexpr size_t MiB = 1u << 20;
constexpr size_t WS_CTL = 0, CTL_ZERO_BYTES = 1 * MiB;
constexpr size_t WS_ROPE = 1 * MiB, WS_WINT = 9 * MiB, WS_WOUTT = 55 * MiB, WS_WGUT = 71 * MiB, WS_WDT = 327 * MiB, WS_WC1T = 455 * MiB;
constexpr size_t WS_H = 463 * MiB, WS_QN = 527 * MiB, WS_QM = 559 * MiB, WS_KM = 591 * MiB, WS_VM = 623 * MiB;
constexpr size_t WS_KC = 655 * MiB, WS_VC = 663 * MiB, WS_KS = 671 * MiB, WS_VS = 679 * MiB, WS_KW = 687 * MiB, WS_VW = 695 * MiB;
constexpr size_t WS_GATES = 703 * MiB, WS_UL = 705 * MiB, WS_KCMP = 713 * MiB, WS_VCMP = 713 * MiB + 512 * 1024, WS_KMEAN = 714 * MiB;
constexpr size_t WS_OMIX = 715 * MiB, WS_OCMP = 779 * MiB, WS_OWIN = 811 * MiB, WS_SEL = 843 * MiB, WS_TE = 845 * MiB, WS_TOKIDX = 846 * MiB, WS_WTS = 848 * MiB;
constexpr size_t WS_HACT = 850 * MiB, WS_Y = 890 * MiB;
constexpr size_t WS_WRT = 714 * MiB + 256 * 1024;
constexpr size_t WS_IMP = WS_H + 32 * MiB;
constexpr size_t WS_NLIST = WS_H, WS_PSLC = 850 * MiB, WS_LSEN = 1106 * MiB;
constexpr size_t WS_MLIST = 1050 * MiB, WS_PSEL = 1082 * MiB, WS_POWN = 1178 * MiB, WS_LSES = 1210 * MiB, WS_LSEO = 1211 * MiB + 512 * 1024, WS_END = 1212 * MiB;
constexpr int CW_TMO = 0, CW_BAR = 4096, CW_CNT = 8192, CW_MCNT = 8704, CW_NCNT = 9728, CW_MOD = 16384, CW_B1E = 40960;

constexpr int RING_BYTES = 131072, LDSCTL_OFF = RING_BYTES, MISC_OFF = LDSCTL_OFF + 320, MOETAB_OFF = LDSCTL_OFF + 512, LDS_BYTES = 147456;

#define GAS __attribute__((address_space(1)))
#define LAS __attribute__((address_space(3)))
typedef unsigned short bf16;
typedef unsigned v4u __attribute__((ext_vector_type(4)));
typedef float f32x4 __attribute__((ext_vector_type(4)));
typedef float f32x2 __attribute__((ext_vector_type(2)));
typedef GAS unsigned gu32;
#define RLX_AGENT __ATOMIC_RELAXED, __HIP_MEMORY_SCOPE_AGENT
#define LDS_WAIT() asm volatile("s_waitcnt lgkmcnt(0)" ::: "memory")
__device__ __forceinline__ unsigned f2bf(float f) { unsigned u = __builtin_bit_cast(unsigned, f); return (u + 0x7fffu + ((u >> 16) & 1u)) >> 16; }
__device__ __forceinline__ unsigned pk2(float lo, float hi) { return f2bf(lo) | (f2bf(hi) << 16); }
__device__ __forceinline__ float bf2f(unsigned b) { return __builtin_bit_cast(float, b << 16); }
__device__ __forceinline__ float bflo(unsigned w) { return __builtin_bit_cast(float, w << 16); }
__device__ __forceinline__ float bfhi(unsigned w) { return __builtin_bit_cast(float, w & 0xffff0000u); }

#define XB_TMO      128
#define XB_XCNT(j)  (256  + 64 * (j))
#define XB_XSUB(j)  (1280 + 64 * (j))
#define XB_XGEN(j)  (2304 + 64 * (j))
#define XB_TOP      3328
#define XB_TOPGEN   3392
#define XCD_BAR_WORDS 3456
#define XB_SPIN_CAP (1u << 23)
__device__ __forceinline__ unsigned xb_ld(unsigned* p)              { return __hip_atomic_load(p, __ATOMIC_RELAXED, __HIP_MEMORY_SCOPE_AGENT); }
__device__ __forceinline__ unsigned xb_add(unsigned* p, unsigned v) { return __hip_atomic_fetch_add(p, v, __ATOMIC_RELAXED, __HIP_MEMORY_SCOPE_AGENT); }
__device__ __forceinline__ unsigned xb_xcc_id() { return (unsigned)__builtin_amdgcn_s_getreg((3 << 11) | 20) & 0xFu; }
#define XB_SPIN(cond, bar) do { unsigned _sp = 0; while (cond) { __builtin_amdgcn_s_sleep(1); \
    if ((++_sp & 255u) == 0u) { if (xb_ld(&(bar)[XB_TMO])) break; if (_sp > XB_SPIN_CAP) { atomicAdd(&(bar)[XB_TMO], 1u); break; } } } } while (0)
struct XcdBarrier { unsigned* bar; unsigned x; volatile LAS unsigned* st; };
__device__ __forceinline__ XcdBarrier xcd_barrier_post(unsigned* bar, volatile LAS unsigned* st) {
    XcdBarrier b; b.bar = bar; b.x = xb_xcc_id(); b.st = st;
    if (threadIdx.x == 0) (void)xb_add(&bar[XB_XCNT(b.x)], 1u);
    return b;
}
__device__ __forceinline__ void xcd_barrier_complete(unsigned* bar, unsigned x, unsigned& nloc, unsigned& nx) {
    const unsigned G = gridDim.x * gridDim.y * gridDim.z;
    unsigned sum, cnt, mine, sp = 0u;
    for (;;) {
        sum = 0u; cnt = 0u; mine = 0u;
#pragma unroll
        for (unsigned j = 0; j < 16; ++j) { const unsigned c = xb_ld(&bar[XB_XCNT(j)]); sum += c; cnt += (c > 0u) ? 1u : 0u; mine = (j == x) ? c : mine; }
        if (sum == G) break;
        __builtin_amdgcn_s_sleep(1);
        if ((++sp & 255u) == 0u) { if (xb_ld(&bar[XB_TMO])) break; if (sp > XB_SPIN_CAP) { atomicAdd(&bar[XB_TMO], 1u); break; } }
    }
    nloc = mine > 0u ? mine : 1u; nx = cnt > 0u ? cnt : 1u;
}
__device__ __forceinline__ void xcd_barrier(const XcdBarrier& b) {
    asm volatile("s_waitcnt vmcnt(0)" ::: "memory");
    __syncthreads();
    if (threadIdx.x == 0) {
        unsigned* bar = b.bar;
        __builtin_amdgcn_s_waitcnt(0);
        unsigned nloc = b.st[0], nx = b.st[1];
        if (nloc == 0u) { xcd_barrier_complete(bar, b.x, nloc, nx); b.st[0] = nloc; b.st[1] = nx; }
        const unsigned old = xb_add(&bar[XB_XSUB(b.x)], 1u);
        const unsigned gen = old / nloc;
        if (old + 1u == (gen + 1u) * nloc) {
            __builtin_amdgcn_fence(__ATOMIC_RELEASE, "agent");
            asm volatile("s_waitcnt vmcnt(0)" ::: "memory");
            const unsigned og = xb_add(&bar[XB_TOP], 1u);
            const unsigned tg = og / nx;
            if (og + 1u == (tg + 1u) * nx) xb_add(&bar[XB_TOPGEN], 1u);
            else XB_SPIN(xb_ld(&bar[XB_TOPGEN]) == tg, bar);
            __builtin_amdgcn_fence(__ATOMIC_ACQUIRE, "agent");
            xb_add(&bar[XB_XGEN(b.x)], 1u);
            asm volatile("s_waitcnt vmcnt(0)" ::: "memory");
        } else {
            XB_SPIN(xb_ld(&bar[XB_XGEN(b.x)]) == gen, bar);
            __builtin_amdgcn_fence(__ATOMIC_ACQUIRE, "agent");
            asm volatile("s_waitcnt vmcnt(0)" ::: "memory");
        }
    }
    __syncthreads();
}

__device__ __forceinline__ float wave_sum(float v) {
#pragma unroll
    for (int o = 1; o < 64; o <<= 1) v += __shfl_xor(v, o);
    return v;
}
__device__ __forceinline__ float wave_max(float v) {
#pragma unroll
    for (int o = 1; o < 64; o <<= 1) v = fmaxf(v, __shfl_xor(v, o));
    return v;
}


__device__ __forceinline__ float row_max16(float v) {
    v = fmaxf(v, __builtin_bit_cast(float, __builtin_amdgcn_update_dpp(0, __builtin_bit_cast(int, v), 0xB1, 0xF, 0xF, false)));
    v = fmaxf(v, __builtin_bit_cast(float, __builtin_amdgcn_update_dpp(0, __builtin_bit_cast(int, v), 0x4E, 0xF, 0xF, false)));
    v = fmaxf(v, __builtin_bit_cast(float, __builtin_amdgcn_update_dpp(0, __builtin_bit_cast(int, v), 0x124, 0xF, 0xF, false)));
    v = fmaxf(v, __builtin_bit_cast(float, __builtin_amdgcn_update_dpp(0, __builtin_bit_cast(int, v), 0x128, 0xF, 0xF, false)));
    return v;
}
__device__ __forceinline__ int row_min16(int v) {
    v = min(v, __builtin_amdgcn_update_dpp(0, v, 0xB1, 0xF, 0xF, false));
    v = min(v, __builtin_amdgcn_update_dpp(0, v, 0x4E, 0xF, 0xF, false));
    v = min(v, __builtin_amdgcn_update_dpp(0, v, 0x124, 0xF, 0xF, false));
    v = min(v, __builtin_amdgcn_update_dpp(0, v, 0x128, 0xF, 0xF, false));
    return v;
}
template <int NV>
__device__ __forceinline__ int row_pick(float (&v)[NV], int lam) {
    float m = v[0];
#pragma unroll
    for (int i = 1; i < NV; ++i) m = fmaxf(m, v[i]);
    m = row_max16(m);
    int idx = 1 << 20;
#pragma unroll
    for (int i = NV - 1; i >= 0; --i) idx = (v[i] == m) ? lam + 16 * i : idx;
    idx = row_min16(idx);
    if (m == -INFINITY) idx = -1;
#pragma unroll
    for (int i = 0; i < NV; ++i) v[i] = (lam + 16 * i == idx) ? -INFINITY : v[i];
    return idx;
}

__device__ __forceinline__ int il(int d) { return (d < 64) ? 2 * d : 2 * (d - 64) + 1; }
__device__ __forceinline__ int inproj_row(int s) {
    if (s < 1024) return (s & ~127) + il(s & 127);
    if (s < 1536) return s;
    if (s < 1792) return (s & ~127) + il(s & 127);
    if (s < 2048) return s;
    if (s < 2304) return (s & ~127) + il(s & 127);
    if (s < 2560) return s;
    if (s < 2584) return 5632 + (s - 2560);
    if (s < 3608) { const int r = s - 2584; return 2560 + (r & ~127) + il(r & 127); }
    if (s < 4632) { const int r = s - 3608; return 3584 + (r & ~127) + il(r & 127); }
    return 4608 + (s - 4632);
}
template <int MODE>
__device__ __forceinline__ void transpose_item(const float* W, int K, int N, bf16* WT, int dpitch, int row_off, LAS float* scr, int item, int lane) {
    const int nblk = (N + 31) / 32, kb = item / nblk, nb = item % nblk, k0 = 64 * kb, n0 = 32 * nb;
    const int nsrc = n0 + (lane & 31);
#pragma unroll 8
    for (int i = 0; i < 32; ++i) { const int kk = 2 * i + (lane >> 5); scr[kk * 33 + (lane & 31)] = (nsrc < N) ? W[(size_t)(k0 + kk) * N + nsrc] : 0.f; }
    LDS_WAIT(); asm volatile("" ::: "memory");
    const int c = lane & 7;
#pragma unroll
    for (int j = 0; j < 4; ++j) { const int nl = (lane >> 3) + 8 * j, n = n0 + nl; const LAS float* s = scr + (8 * c) * 33 + nl;
        v4u o; o.x = pk2(s[0 * 33], s[1 * 33]); o.y = pk2(s[2 * 33], s[3 * 33]); o.z = pk2(s[4 * 33], s[5 * 33]); o.w = pk2(s[6 * 33], s[7 * 33]);
        if (n < N) { int dr;
            if (MODE == 0) dr = n; else if (MODE == 1) dr = inproj_row(n); else if (MODE == 2) dr = (n >> 7) * 256 + (n & 127); else dr = (n >> 7) * 256 + 128 + (n & 127);
            *(GAS v4u*)(WT + (size_t)(row_off + dr) * dpitch + k0 + 8 * c) = o; } }
    LDS_WAIT(); asm volatile("" ::: "memory");
}

using pg8::Unit;
struct EpiInProj {
    static constexpr bool PERM = true;
    bf16 *QN, *KC, *VC, *KS, *VS, *KW, *VW, *QM, *KM, *VM; float* GATES; const float* rope;
    __device__ __forceinline__ void operator()(const f32x4 (&acc)[2][2][4][2], const Unit& u, int wr, int wc, int fr, int fq) const {
        const int pn = u.pn, row0 = u.pm * 256 + wr * 64 + fr, c8 = wc * 32 + 8 * fq;
        if (pn == 22) {
            if (c8 < 24) {
#pragma unroll
                for (int ai = 0; ai < 2; ++ai)
#pragma unroll
                    for (int m = 0; m < 4; ++m) { const int row = row0 + ai * 128 + m * 16; float* gp = GATES + (size_t)row * 32 + c8;
                        f32x4 a = acc[ai][0][m][0], b = acc[ai][0][m][1], ga, gb;
#pragma unroll
                        for (int j = 0; j < 4; ++j) { ga[j] = 1.f / (1.f + __expf(-a[j])); gb[j] = 1.f / (1.f + __expf(-b[j])); }
                        *(f32x4*)gp = ga; *(f32x4*)(gp + 4) = gb; }
            }
            return;
        }
        bf16* base; int pitch; size_t bjs; bool rot;
        if (pn < 4)       { base = QN + pn * 256;        pitch = 1024; bjs = 128; rot = true; }
        else if (pn == 4) { base = KC;                   pitch = 128;  bjs = (size_t)S_ * 128; rot = false; }
        else if (pn == 5) { base = VC;                   pitch = 128;  bjs = (size_t)S_ * 128; rot = false; }
        else if (pn == 6) { base = KS;                   pitch = 256;  bjs = 128; rot = true; }
        else if (pn == 7) { base = VS;                   pitch = 256;  bjs = 128; rot = false; }
        else if (pn == 8) { base = KW;                   pitch = 256;  bjs = 128; rot = true; }
        else if (pn == 9) { base = VW;                   pitch = 256;  bjs = 128; rot = false; }
        else if (pn < 14) { base = QM + (pn - 10) * 256; pitch = 1024; bjs = 128; rot = true; }
        else if (pn < 18) { base = KM + (pn - 14) * 256; pitch = 1024; bjs = 128; rot = true; }
        else              { base = VM + (pn - 18) * 256; pitch = 1024; bjs = 128; rot = false; }
#pragma unroll
        for (int ai = 0; ai < 2; ++ai)
#pragma unroll
            for (int m = 0; m < 4; ++m) { const int row = row0 + ai * 128 + m * 16;
                f32x4 t0 = (f32x4){1.f, 0.f, 1.f, 0.f}, t1 = t0;
                if (rot) { const f32x4* tp = (const f32x4*)(rope + (size_t)row * 128 + (c8 >> 1) * 2); t0 = tp[0]; t1 = tp[1]; }
#pragma unroll
                for (int bj = 0; bj < 2; ++bj) { f32x4 v0 = acc[ai][bj][m][0], v1 = acc[ai][bj][m][1];
                    if (rot) { f32x4 w0, w1;
                        w0[0] = v0[0] * t0[0] - v0[1] * t0[1]; w0[1] = v0[1] * t0[0] + v0[0] * t0[1]; w0[2] = v0[2] * t0[2] - v0[3] * t0[3]; w0[3] = v0[3] * t0[2] + v0[2] * t0[3];
                        w1[0] = v1[0] * t1[0] - v1[1] * t1[1]; w1[1] = v1[1] * t1[0] + v1[0] * t1[1]; w1[2] = v1[2] * t1[2] - v1[3] * t1[3]; w1[3] = v1[3] * t1[2] + v1[2] * t1[3];
                        v0 = w0; v1 = w1; }
                    pg8::u32x4 w; w.x = pg8::cvt_pk_bf16(v0[0], v0[1]); w.y = pg8::cvt_pk_bf16(v0[2], v0[3]); w.z = pg8::cvt_pk_bf16(v1[0], v1[1]); w.w = pg8::cvt_pk_bf16(v1[2], v1[3]);
                    *(pg8::u32x4*)(base + (size_t)row * pitch + bj * bjs + c8) = w; } }
    }
};
struct EpiOutProj {
    static constexpr bool PERM = false;
    const float* xsrc; float* X; const float* gt;
    __device__ __forceinline__ void operator()(const f32x4 (&acc)[2][2][4][2], const Unit& u, int wr, int wc, int fr, int fq) const {
        const int row0 = u.pm * 256 + wr * 64 + fr, col0 = u.pnl * 256 + wc * 32 + 4 * fq;
        f32x4 gv[2][2];
#pragma unroll
        for (int bj = 0; bj < 2; ++bj)
#pragma unroll
            for (int n = 0; n < 2; ++n) gv[bj][n] = *(const f32x4*)(gt + col0 + bj * 128 + n * 16);
#pragma unroll
        for (int ai = 0; ai < 2; ++ai)
#pragma unroll
            for (int m = 0; m < 4; ++m) { const size_t ro = (size_t)(row0 + ai * 128 + m * 16) * D_ + col0;
#pragma unroll
                for (int bj = 0; bj < 2; ++bj)
#pragma unroll
                    for (int n = 0; n < 2; ++n) { const f32x4 xv = *(const f32x4*)(xsrc + ro + bj * 128 + n * 16); *(f32x4*)(X + ro + bj * 128 + n * 16) = xv + gv[bj][n] * acc[ai][bj][m][n]; } }
    }
};
struct EpiF32 {
    static constexpr bool PERM = false;
    float* C; int ldc;
    __device__ __forceinline__ void operator()(const f32x4 (&acc)[2][2][4][2], const Unit& u, int wr, int wc, int fr, int fq) const {
        const int row0 = u.pm * 256 + wr * 64 + fr, col0 = u.pnl * 256 + wc * 32 + 4 * fq;
#pragma unroll
        for (int ai = 0; ai < 2; ++ai)
#pragma unroll
            for (int m = 0; m < 4; ++m) { float* rowp = C + (size_t)(row0 + ai * 128 + m * 16) * ldc + col0;
#pragma unroll
                for (int bj = 0; bj < 2; ++bj)
#pragma unroll
                    for (int n = 0; n < 2; ++n) *(f32x4*)(rowp + bj * 128 + n * 16) = acc[ai][bj][m][n]; }
    }
};
struct EpiGateUp {
    static constexpr bool PERM = true;
    bf16* HACT;
    __device__ __forceinline__ void operator()(const f32x4 (&acc)[2][2][4][2], const Unit& u, int wr, int wc, int fr, int fq) const {
        const int row0 = u.pm * 256 + wr * 64 + fr, col0 = u.pnl * 128 + wc * 32 + 8 * fq;
#pragma unroll
        for (int ai = 0; ai < 2; ++ai)
#pragma unroll
            for (int m = 0; m < 4; ++m) { const int row = row0 + ai * 128 + m * 16; f32x4 h[2];
#pragma unroll
                for (int n = 0; n < 2; ++n)
#pragma unroll
                    for (int j = 0; j < 4; ++j) { const float gg = acc[ai][0][m][n][j], uu = acc[ai][1][m][n][j]; h[n][j] = gg / (1.f + __expf(-gg)) * uu; }
                pg8::u32x4 w; w.x = pg8::cvt_pk_bf16(h[0][0], h[0][1]); w.y = pg8::cvt_pk_bf16(h[0][2], h[0][3]); w.z = pg8::cvt_pk_bf16(h[1][0], h[1][1]); w.w = pg8::cvt_pk_bf16(h[1][2], h[1][3]);
                *(pg8::u32x4*)(HACT + (size_t)row * DEXP + col0) = w; }
    }
};
struct EpiDown {
    static constexpr bool PERM = true;
    bf16* Y; const float* WTS; const LAS int* tab;
    __device__ __forceinline__ void operator()(const f32x4 (&acc)[2][2][4][2], const Unit& u, int wr, int wc, int fr, int fq) const {
        const int rl0 = wr * 64 + fr, col0 = u.pnl * 256 + wc * 32 + 8 * fq, cnt = tab[u.e];
#pragma unroll
        for (int ai = 0; ai < 2; ++ai)
#pragma unroll
            for (int m = 0; m < 4; ++m) { const int rl = rl0 + ai * 128 + m * 16, pos = u.mt * 256 + rl;
                const float w = (pos < cnt) ? WTS[(size_t)u.e * ECAP + pos] : 0.f;
                bf16* rowp = Y + (size_t)(u.pm * 256 + rl) * D_ + col0;
#pragma unroll
                for (int bj = 0; bj < 2; ++bj) { const f32x4 v0 = acc[ai][bj][m][0] * w, v1 = acc[ai][bj][m][1] * w;
                    pg8::u32x4 o; o.x = pg8::cvt_pk_bf16(v0[0], v0[1]); o.y = pg8::cvt_pk_bf16(v0[2], v0[3]); o.z = pg8::cvt_pk_bf16(v1[0], v1[1]); o.w = pg8::cvt_pk_bf16(v1[2], v1[3]);
                    *(pg8::u32x4*)(rowp + bj * 128) = o; } }
    }
};

struct CompressOrder {
    static constexpr bool GATHER = false;
    int G, c;
    __device__ bool next(int i, Unit& u) const { const int L = i * G + c; if (L >= 32) return false; u.pm = L >> 1; u.pnl = L & 1; u.pn = (u.pm >= 8 ? 2 : 0) + u.pnl; u.e = 0; u.mt = 0; return true; }
    __device__ __forceinline__ void a_offs(const Unit&, int, int, int, int, int, unsigned (&)[2][2]) const {}
    __device__ __forceinline__ void a_ready(const Unit&) const {}
    __device__ __forceinline__ void done(const Unit&) const {}
};
template <bool GATHER_>
struct MoeOrder {
    static constexpr bool GATHER = GATHER_;
    const LAS int* tab; int NT, G, c, bt_per_e, bt_base; const int* tokidx;
    __device__ bool next(int i, Unit& u) const {
        const int L = i * G + c; if (L >= tab[64]) return false;
        int e = 0;
        for (int k = 1; k < NEXP; ++k) e += (L >= tab[32 + k]) ? 1 : 0;
        e = __builtin_amdgcn_readfirstlane(e);
        const int r = L - tab[32 + e];
        u.e = e; u.mt = r / NT; u.pnl = r % NT; u.pn = bt_base + e * bt_per_e + u.pnl; u.pm = (tab[65 + e] >> 8) + u.mt; return true;
    }
    __device__ __forceinline__ void a_offs(const Unit& u, int R0, int R1, int C0, int C1, int K, unsigned (&o)[2][2]) const {
        const int cnt = tab[u.e]; const int* tk = tokidx + (size_t)u.e * ECAP;
#pragma unroll
        for (int h = 0; h < 2; ++h) {
            int p0 = u.mt * 256 + h * 128 + R0, p1 = u.mt * 256 + h * 128 + R1; p0 = p0 < cnt ? p0 : cnt - 1; p1 = p1 < cnt ? p1 : cnt - 1;
            o[h][0] = ((unsigned)tk[p0] * (unsigned)K + (unsigned)C0) * 2u; o[h][1] = ((unsigned)tk[p1] * (unsigned)K + (unsigned)C1) * 2u; }
    }
    __device__ __forceinline__ void a_ready(const Unit&) const {}
    __device__ __forceinline__ void done(const Unit&) const {}
};

constexpr int SM_Q = 0, SM_P = 512, SM_KP = 4608, SM_RED = 5632, SM_PART = 5696, SM_MISC = 6208;
template <int NH, class KeyFn>
__device__ __forceinline__ float naive_attend(LAS float* sm, int tid, int nkeys, const KeyFn keyfn, const bf16* Kb, int kpitch, const bf16* Vb, int vpitch) {
    LAS int* kp = (LAS int*)(sm + SM_KP);
    const int lane = tid & 63, wave = tid >> 6;
    float sc[NH][2];
#pragma unroll
    for (int i = 0; i < 2; ++i) {
        const int kk = tid + 512 * i; const int kpos = (kk < nkeys) ? keyfn(kk) : -1; kp[kk] = kpos;
        float a[NH];
#pragma unroll
        for (int h = 0; h < NH; ++h) a[h] = 0.f;
        if (kpos >= 0) { const v4u* kr = (const v4u*)(Kb + (size_t)kpos * kpitch);
#pragma unroll 4
            for (int c = 0; c < 16; ++c) { const v4u kv = kr[c];
                const float k0 = bflo(kv.x), k1 = bfhi(kv.x), k2 = bflo(kv.y), k3 = bfhi(kv.y), k4 = bflo(kv.z), k5 = bfhi(kv.z), k6 = bflo(kv.w), k7 = bfhi(kv.w);
#pragma unroll
                for (int h = 0; h < NH; ++h) { const f32x4 qa = *(const LAS f32x4*)(sm + SM_Q + h * 128 + 8 * c), qb = *(const LAS f32x4*)(sm + SM_Q + h * 128 + 8 * c + 4);
                    a[h] += qa[0] * k0 + qa[1] * k1 + qa[2] * k2 + qa[3] * k3 + qb[0] * k4 + qb[1] * k5 + qb[2] * k6 + qb[3] * k7; } } }
#pragma unroll
        for (int h = 0; h < NH; ++h) sc[h][i] = (kpos >= 0) ? a[h] * ATT_SCALE : -INFINITY;
    }
#pragma unroll
    for (int h = 0; h < NH; ++h) { const float m = wave_max(fmaxf(sc[h][0], sc[h][1])); if (lane == 0) sm[SM_RED + wave * NH + h] = m; }
    __syncthreads();
    float mx[NH];
#pragma unroll
    for (int h = 0; h < NH; ++h) { float m = sm[SM_RED + h];
#pragma unroll
        for (int w = 1; w < 8; ++w) m = fmaxf(m, sm[SM_RED + w * NH + h]); mx[h] = m; }
    __syncthreads();
#pragma unroll
    for (int h = 0; h < NH; ++h) {
#pragma unroll
        for (int i = 0; i < 2; ++i) sc[h][i] = (sc[h][i] == -INFINITY) ? 0.f : __expf(sc[h][i] - mx[h]);
        const float s = wave_sum(sc[h][0] + sc[h][1]); if (lane == 0) sm[SM_RED + wave * NH + h] = s; }
    __syncthreads();
#pragma unroll
    for (int h = 0; h < NH; ++h) { float s = 0.f;
#pragma unroll
        for (int w = 0; w < 8; ++w) s += sm[SM_RED + w * NH + h];
        const float inv = s > 0.f ? 1.f / s : 0.f;
#pragma unroll
        for (int i = 0; i < 2; ++i) sm[SM_P + h * 1024 + tid + 512 * i] = sc[h][i] * inv; }
    __syncthreads();
    const int d = tid & 127, hs = tid >> 7;
    float o = 0.f;
    {
        const int hrow = (NH == 4) ? hs * 1024 : 0;
        const int k0 = (NH == 4) ? 0 : hs * 256, k1 = (NH == 4) ? nkeys : ((k0 + 256 < nkeys) ? k0 + 256 : nkeys);
        for (int kb = k0; kb < k1; kb += 8) {
            int kq[8]; float pq[8], vq[8];
#pragma unroll
            for (int j = 0; j < 8; ++j) { const int kpos = kp[kb + j]; pq[j] = (kpos >= 0 && kb + j < k1) ? sm[SM_P + hrow + kb + j] : 0.f; kq[j] = kpos >= 0 ? kpos : 0; }
#pragma unroll
            for (int j = 0; j < 8; ++j) vq[j] = bf2f(Vb[(size_t)kq[j] * vpitch + d]);
#pragma unroll
            for (int j = 0; j < 8; ++j) o += pq[j] * vq[j];
        }
    }
    if (NH == 1) {
        sm[SM_PART + tid] = o; __syncthreads();
        if (tid < 128) o = sm[SM_PART + tid] + sm[SM_PART + 128 + tid] + sm[SM_PART + 256 + tid] + sm[SM_PART + 384 + tid];
    }
    return o;
}

namespace att {
constexpr int D = 128, NW = 8, QBLK = 32, KVBLK = 64, QB = NW * QBLK;
constexpr int SHM_V = KVBLK * D * 2, SHM_K = KVBLK * D * 2;
constexpr int OFF_WS = 2 * SHM_V + 2 * SHM_K, OFF_OT = OFF_WS + NW * 64 * 4, LDS_BYTES = OFF_OT + NW * 32 * 4;
constexpr int OFF_ST = 73728, ST_ROW = 272, ST_WAVE = 16 * ST_ROW;
constexpr float SCALE = 0.08838834764831845f, THR = 8.f;
typedef short bf16x8 __attribute__((ext_vector_type(8)));
typedef short s16x4 __attribute__((ext_vector_type(4)));
typedef float f32x16 __attribute__((ext_vector_type(16)));
typedef float f32x4 __attribute__((ext_vector_type(4)));
typedef unsigned u32x4 __attribute__((ext_vector_type(4)));
typedef unsigned short bf16;
#define KSWZ(row, colB) ((row) * 256 + ((colB) ^ (((row) & 7) << 4)))
#define SBAR() __builtin_amdgcn_sched_barrier(0)
__device__ __forceinline__ int v_st(int k, int c) { const int kk = (k & ~0xC) | ((k & 4) << 1) | ((k & 8) >> 1); return ((kk >> 3) * 4 + (c >> 5)) * 512 + ((kk & 7) * 32 + (c & 31)) * 2; }
__device__ __forceinline__ int v_rd_base(int lane) { return ((lane & 3) << 3) | (((lane >> 2) & 3) << 6) | (((lane >> 4) & 1) << 5) | (((lane >> 5) & 1) << 8); }
constexpr int v_rd_off(int d0, int ks, int half) { return d0 * 512 + ks * 4096 + half * 2048; }
__device__ __forceinline__ int crow(int r, int hi) { return (r & 3) + 8 * (r >> 2) + 4 * hi; }
__device__ __forceinline__ unsigned cvtpk(float lo, float hi) { unsigned r; asm volatile("v_cvt_pk_bf16_f32 %0, %1, %2" : "=v"(r) : "v"(lo), "v"(hi)); return r; }
__device__ __forceinline__ bf16x8 load8(const bf16* p) { return *reinterpret_cast<const bf16x8*>(p); }
__device__ __forceinline__ void mask_tile(f32x16& p0, f32x16& p1, int dq, unsigned W) {
    const float NEG = -__builtin_inff();
#pragma unroll
    for (int r = 0; r < 16; ++r) {
        const int c = (r & 3) + 8 * (r >> 2);
        if ((unsigned)(dq - c) >= W) p0[r] = NEG;
        if ((unsigned)(dq - c - 32) >= W) p1[r] = NEG;
    }
}
__device__ __forceinline__ void partialSM(f32x16& p0, f32x16& p1, float& m_reg, float& mn, float& alpha) {
    float pmax = p0[0]; for (int r = 1; r < 16; ++r) pmax = fmaxf(pmax, p0[r]); for (int r = 0; r < 16; ++r) pmax = fmaxf(pmax, p1[r]);
    { auto rr = __builtin_amdgcn_permlane32_swap(__float_as_uint(pmax), __float_as_uint(pmax), false, false);
      pmax = fmaxf(__uint_as_float(rr[0]), __uint_as_float(rr[1])); }
    constexpr float C2 = 1.4426950408889634f * SCALE;
    if (__builtin_expect(__all((pmax - m_reg) * SCALE <= THR), 1)) { mn = m_reg; alpha = 1.f; }
    else { mn = fmaxf(m_reg, pmax); alpha = __builtin_amdgcn_exp2f((m_reg - mn) * C2); m_reg = mn; }
    const float mnL = -mn * C2;
    for (int r = 0; r < 16; ++r) p0[r] = fmaf(p0[r], C2, mnL); for (int r = 0; r < 16; ++r) p1[r] = fmaf(p1[r], C2, mnL);
    for (int r = 0; r < 16; ++r) p0[r] = __builtin_amdgcn_exp2f(p0[r]);
}
__device__ __forceinline__ void finishSM(f32x16& p0, f32x16& p1, float alpha, float& l_reg, bf16x8& pa0, bf16x8& pa1, bf16x8& pa2, bf16x8& pa3) {
    for (int r = 0; r < 16; ++r) p1[r] = __builtin_amdgcn_exp2f(p1[r]);
    float ps = 0; for (int r = 0; r < 16; ++r) ps += p0[r]; for (int r = 0; r < 16; ++r) ps += p1[r];
    { auto rr = __builtin_amdgcn_permlane32_swap(__float_as_uint(ps), __float_as_uint(ps), false, false);
      ps = __uint_as_float(rr[0]) + __uint_as_float(rr[1]); }
    l_reg = l_reg * alpha + ps;
#define PK4(P, B_, OUT) do { unsigned a0 = cvtpk(P[B_+0], P[B_+1]), a1 = cvtpk(P[B_+2], P[B_+3]);                          \
        unsigned b0 = cvtpk(P[B_+4], P[B_+5]), b1 = cvtpk(P[B_+6], P[B_+7]);                                             \
        auto r0 = __builtin_amdgcn_permlane32_swap(a0, b0, false, false); auto r1 = __builtin_amdgcn_permlane32_swap(a1, b1, false, false); \
        u32x4 w = {r0[0], r1[0], r0[1], r1[1]}; OUT = *reinterpret_cast<bf16x8*>(&w); } while (0)
    PK4(p0, 0, pa0); PK4(p0, 8, pa1); PK4(p1, 0, pa2); PK4(p1, 8, pa3);
#undef PK4
}
template <int KB, bool SK>
__device__ __forceinline__ void qkt(f32x16& p0, f32x16& p1, const char* K_lds, int r32, int hi, const bf16x8* qr, bool act) {
    if (SK && !act) { const float NEG = -__builtin_inff();
#pragma unroll
        for (int r = 0; r < 16; ++r) { p0[r] = NEG; p1[r] = NEG; } return; }
    p0 = f32x16{}; p1 = f32x16{};
    const char* kb[4];
#pragma unroll
    for (int dd = 0; dd < 4; ++dd) kb[dd] = K_lds + KB * SHM_K + KSWZ(r32, (dd * 16 + hi * 8) * 2);
#pragma unroll
    for (int d0 = 0; d0 < 8; ++d0) { const char* a = kb[d0 & 3] + (d0 >> 2) * 128;
        bf16x8 b0 = *reinterpret_cast<const bf16x8*>(a);
        bf16x8 b1 = *reinterpret_cast<const bf16x8*>(a + 32 * 256);
        p0 = __builtin_amdgcn_mfma_f32_32x32x16_bf16(b0, qr[d0], p0, 0, 0, 0);
        p1 = __builtin_amdgcn_mfma_f32_32x32x16_bf16(b1, qr[d0], p1, 0, 0, 0); }
}
template <int VB, bool SK>
__device__ __forceinline__ void pv_tile(f32x16* o, int vb0, bf16x8 pa0, bf16x8 pa1, bf16x8 pa2, bf16x8 pa3, bool act) {
    if (SK && !act) return;
#define TRRD(dst, off) asm volatile("ds_read_b64_tr_b16 %0, %1 offset:%2" : "=&v"(dst) : "v"(vb0), "i"(off) : "memory")
#define PV_D0(d0) do { s16x4 l0, l1, l2, l3, h0, h1, h2, h3; constexpr int b_ = VB * SHM_V + v_rd_off(d0, 0, 0); \
        TRRD(l0, b_); TRRD(h0, b_ + 2048); TRRD(l1, b_ + 4096); TRRD(h1, b_ + 6144); TRRD(l2, b_ + 8192); TRRD(h2, b_ + 10240); TRRD(l3, b_ + 12288); TRRD(h3, b_ + 14336); \
        asm volatile("s_waitcnt lgkmcnt(0)" ::: "memory"); SBAR();   \
        o[d0] = __builtin_amdgcn_mfma_f32_32x32x16_bf16(pa0, (bf16x8){l0[0], l0[1], l0[2], l0[3], h0[0], h0[1], h0[2], h0[3]}, o[d0], 0, 0, 0);   \
        o[d0] = __builtin_amdgcn_mfma_f32_32x32x16_bf16(pa1, (bf16x8){l1[0], l1[1], l1[2], l1[3], h1[0], h1[1], h1[2], h1[3]}, o[d0], 0, 0, 0);   \
        o[d0] = __builtin_amdgcn_mfma_f32_32x32x16_bf16(pa2, (bf16x8){l2[0], l2[1], l2[2], l2[3], h2[0], h2[1], h2[2], h2[3]}, o[d0], 0, 0, 0);   \
        o[d0] = __builtin_amdgcn_mfma_f32_32x32x16_bf16(pa3, (bf16x8){l3[0], l3[1], l3[2], l3[3], h3[0], h3[1], h3[2], h3[3]}, o[d0], 0, 0, 0); } while (0)
    PV_D0(0); PV_D0(1); PV_D0(2); PV_D0(3);
#undef PV_D0
#undef TRRD
}
struct Ref { const bf16* Q; const bf16* K; const bf16* V; bf16* O; const int* list; int kpitch, j_lo, j_hi, P0, W, a0, a1; };
struct Seam { bf16x8 qr[8]; bf16x8 st_v0, st_v1, st_k0, st_k1; };
#define ROW(p, kp, k0, rr) ((p) + (size_t)((k0) + (rr)) * (kp) + sc)
#define VMW() asm volatile("s_waitcnt vmcnt(0)" ::: "memory")
#define VMWN(n) asm volatile("s_waitcnt vmcnt(%0)" :: "i"(n) : "memory")
#define SLOAD_H(Kp, Vp, kp, k0) do { S.st_v0 = load8(ROW(Vp, kp, k0, sr)); S.st_v1 = load8(ROW(Vp, kp, k0, 32 + sr));              \
                         S.st_k0 = load8(ROW(Kp, kp, k0, sr)); S.st_k1 = load8(ROW(Kp, kp, k0, 32 + sr)); } while (0)
#define SWRITE_HK(bf) do { *(bf16x8*)(K_lds + (bf) * SHM_K + kws) = S.st_k0; *(bf16x8*)(K_lds + (bf) * SHM_K + kws + 32 * 256) = S.st_k1; } while (0)
#define SWRITE_HV(bf) do { *(bf16x8*)(V_lds + (bf) * SHM_V + vst0) = S.st_v0; *(bf16x8*)(V_lds + (bf) * SHM_V + vst1) = S.st_v1; } while (0)
#define SWRITE_H(bf) do { SWRITE_HV(bf); SWRITE_HK(bf); } while (0)
template <class RF>
__device__ __forceinline__ void prime(const Ref& cur, char* lds, Seam& S) {
    int tid_ = threadIdx.x; asm volatile("" : "+v"(tid_));
    const int tid = tid_, wid = __builtin_amdgcn_readfirstlane(tid >> 6), lane = tid & 63, r32 = lane & 31, hi = lane >> 5;
    const int sr = tid >> 4, sc = (tid & 15) * 8, kws = KSWZ(sr, sc * 2); char* K_lds = lds + 2 * SHM_V;
    const int kb0 = cur.j_lo * KVBLK;
    { const bf16* qrow = cur.Q + RF::q_off(cur, wid * QBLK + r32, RF::entry(cur, wid * QBLK + r32));
      for (int d0 = 0; d0 < 8; ++d0) S.qr[d0] = load8(qrow + d0 * 16 + hi * 8); }
    SLOAD_H(cur.K, cur.V, cur.kpitch, kb0); VMW(); SWRITE_HK(0);
    __syncthreads();
}
template <int MODE, bool WSKIP, class RF>
__device__ __forceinline__ void block(const Ref& cur, const Ref& nxt, float* LSE, char* lds, Seam& S, float* lse_lane = nullptr) {
    int tid_ = threadIdx.x; asm volatile("" : "+v"(tid_));
    const int tid = tid_, wid = __builtin_amdgcn_readfirstlane(tid >> 6), lane = tid & 63, r32 = lane & 31, hi = lane >> 5;
    const int j_lo = cur.j_lo, NT = cur.j_hi - cur.j_lo;
    const int kbn = nxt.j_lo * KVBLK;
    const int W = cur.W;
    const int qlo = cur.P0 + wid * QBLK;
    const int e_cur = RF::entry(cur, wid * QBLK + r32), e_nxt = RF::entry(nxt, wid * QBLK + r32);
    const int qm = (MODE == 2 ? RF::pos(cur, wid * QBLK + r32, e_cur) : qlo + r32) - 4 * hi;
    const unsigned Wm = (MODE == 2) ? (unsigned)RF::Wl(cur, wid * QBLK + r32) : (unsigned)W;
    char* V_lds = lds; char* K_lds = lds + 2 * SHM_V;
    float* ws = (float*)(lds + OFF_WS) + wid * 64; float* li_l = ws, * al_l = ws + 32; int* ot_l = (int*)(lds + OFF_OT) + wid * 32;
    float m_reg = -1e30f, l_reg = 0; f32x16 o[4] = {};
    const int sr = tid >> 4, sc = (tid & 15) * 8, vst0 = v_st(sr, sc), vst1 = v_st(32 + sr, sc), kws = KSWZ(sr, sc * 2);
    const int vb0 = (int)(uintptr_t)V_lds + v_rd_base(lane);
    const bf16* Kh = cur.K; const bf16* Vh = cur.V; const int kp = cur.kpitch;
#define RESC(a) do { if (__any((a) < 1.f)) { if (hi == 0) al_l[r32] = (a); asm volatile("s_waitcnt lgkmcnt(0)" ::: "memory");              \
                     for (int d_ = 0; d_ < 4; ++d_) for (int r = 0; r < 16; ++r) o[d_][r] *= al_l[crow(r, hi)]; } } while (0)
#define KBASE(t) ((j_lo + (t)) * KVBLK)
#define ACT(t) (MODE != 0 || (KBASE(t) <= qlo + QBLK - 1 && KBASE(t) + KVBLK - 1 >= qlo - W + 1))
#define MASKT(P0_, P1_, t) do { const int kb_ = KBASE(t); if (MODE == 2) mask_tile(P0_, P1_, qm - kb_, Wm); \
        else if (MODE == 0) { if ((!SK || ACT(t)) && (kb_ + KVBLK - 1 > qlo || kb_ <= qlo + QBLK - 1 - W)) mask_tile(P0_, P1_, qm - kb_, Wm); } } while (0)
    constexpr int NQL = 8;
    constexpr bool SK = WSKIP && MODE == 0;
#define SEAM_K0() do { VMWN(NQL); SWRITE_HK(0); SBAR(); } while (0)
    f32x16 pA0, pA1, pB0, pB1; float mnA, mnB, alA, alB; bf16x8 pa0, pa1, pa2, pa3;
    SWRITE_HV(0); SBAR();
    if (NT > 1) { SLOAD_H(Kh, Vh, kp, KBASE(1)); }
    SBAR(); qkt<0, SK>(pA0, pA1, K_lds, r32, hi, S.qr, ACT(0));
    MASKT(pA0, pA1, 0); partialSM(pA0, pA1, m_reg, mnA, alA);
    if (NT > 1) { VMW(); SWRITE_H(1); }
    __syncthreads();
#define HALF_STEP(PX0, PX1, mnX, alX, PY0, PY1, alY, t, KB, VB, SB) do {                                                      \
        SBAR(); qkt<KB, SK>(PX0, PX1, K_lds, r32, hi, S.qr, ACT(t));                                             \
        finishSM(PY0, PY1, alY, l_reg, pa0, pa1, pa2, pa3); SBAR();                                                           \
        if ((t) + 1 < NT) { SLOAD_H(Kh, Vh, kp, KBASE((t) + 1)); SBAR(); }                                               \
        pv_tile<VB, SK>(o, vb0, pa0, pa1, pa2, pa3, ACT((t) - 1)); MASKT(PX0, PX1, (t)); partialSM(PX0, PX1, m_reg, mnX, alX);                                        \
        __syncthreads();                                                                                                      \
        if ((t) + 1 < NT) { VMW(); SWRITE_H(SB); }                                                                          \
        RESC(alX); __syncthreads(); } while (0)
    for (int t = 1; t + 1 < NT; t += 2) {
        HALF_STEP(pB0, pB1, mnB, alB, pA0, pA1, alA, t, 1, 0, 0);
        HALF_STEP(pA0, pA1, mnA, alA, pB0, pB1, alB, t + 1, 0, 1, 1);
    }
    const bool even = (NT & 1) == 0;
    if (even) { SBAR(); qkt<1, SK>(pB0, pB1, K_lds, r32, hi, S.qr, ACT(NT - 1)); SBAR(); }
    SLOAD_H(nxt.K, nxt.V, nxt.kpitch, kbn); SBAR();
    { const bf16* qrow = nxt.Q + RF::q_off(nxt, wid * QBLK + r32, e_nxt);
#pragma unroll
      for (int d0 = 0; d0 < 8; ++d0) S.qr[d0] = load8(qrow + d0 * 16 + hi * 8); }
    SBAR();
    finishSM(pA0, pA1, alA, l_reg, pa0, pa1, pa2, pa3); SBAR();
    pv_tile<0, SK>(o, vb0, pa0, pa1, pa2, pa3, ACT(even ? NT - 2 : NT - 1));
    if (even) { MASKT(pB0, pB1, NT - 1); partialSM(pB0, pB1, m_reg, mnB, alB); __syncthreads(); RESC(alB);
        finishSM(pB0, pB1, alB, l_reg, pa0, pa1, pa2, pa3); SBAR(); pv_tile<1, SK>(o, vb0, pa0, pa1, pa2, pa3, ACT(NT - 1)); }
    SBAR(); SEAM_K0();
    if (hi == 0) { li_l[r32] = l_reg; ot_l[r32] = RF::o_off(cur, wid * QBLK + r32, e_cur); } asm volatile("s_waitcnt lgkmcnt(0)" ::: "memory");
    if (LSE != nullptr && hi == 0) { const int lq = RF::l_idx(cur, wid * QBLK + r32, e_cur); if (lq >= 0) LSE[lq] = (l_reg > 0.f) ? m_reg * SCALE + __logf(l_reg) : -__builtin_inff(); }
    if (lse_lane != nullptr) *lse_lane = (l_reg > 0.f) ? m_reg * SCALE + __logf(l_reg) : -__builtin_inff();
    bf16* O = cur.O;
    { char* stg = lds + OFF_ST + wid * ST_WAVE;
#pragma unroll 1
      for (int p = 0; p < 2; ++p) {
#pragma unroll
        for (int rr = 0; rr < 8; ++rr) { const int r = 8 * p + rr, orow = crow(r, hi); const float lv = li_l[orow]; const float rl = (lv > 0.f) ? __builtin_amdgcn_rcpf(lv) : 0.f;
#pragma unroll
            for (int d0 = 0; d0 < 4; ++d0) *(unsigned short*)(stg + (orow - 16 * p) * ST_ROW + (d0 * 32 + r32) * 2) = (unsigned short)cvtpk(o[d0][r] * rl, 0.f); }
        asm volatile("s_waitcnt lgkmcnt(0)" ::: "memory");
        { const int row = lane >> 2, ch = lane & 3, oo = ot_l[16 * p + row];
#pragma unroll
          for (int i = 0; i < 4; ++i) { const u32x4 x = *(const u32x4*)(stg + row * ST_ROW + (i * 4 + ch) * 16); if (oo >= 0) *(u32x4*)(O + (size_t)oo + (i * 4 + ch) * 8) = x; } }
        asm volatile("s_waitcnt lgkmcnt(0)" ::: "memory");
      } }
    __syncthreads();
#undef RESC
#undef KBASE
#undef ACT
#undef MASKT
#undef SEAM_K0
#undef HALF_STEP
}

template <class RF>
__device__ __forceinline__ void imp_sweep(const Ref& cur, float lse_lane, float* IMP  , char* lds, Seam& S) {
    int tid_ = threadIdx.x; asm volatile("" : "+v"(tid_));
    const int tid = tid_, wid = __builtin_amdgcn_readfirstlane(tid >> 6), lane = tid & 63, r32 = lane & 31, hi = lane >> 5;
    const int NT = cur.j_hi - cur.j_lo;
    char* K_lds = lds + 2 * SHM_V;
    const int sr = tid >> 4, sc = (tid & 15) * 8, kws = KSWZ(sr, sc * 2);
    const bf16* Kh = cur.K; const int kp = cur.kpitch;
    const int row = wid * QBLK + r32;
    const int qm = RF::pos(cur, row, RF::entry(cur, row)) - 4 * hi; const unsigned Wm = (unsigned)RF::Wl(cur, row);
    constexpr float C2 = 1.4426950408889634f * SCALE;
    const float nl2 = (lse_lane == -__builtin_inff()) ? 0.f : -lse_lane * 1.4426950408889634f;
    float carry = 0.f;
    float* imp_row = IMP + (size_t)(row >> 2) * 512;
    f32x16 p0, p1;
#define IMP_TILE(t, KB) do { \
        if ((t) + 1 < NT) { S.st_k0 = load8(ROW(Kh, kp, (cur.j_lo + (t) + 1) * KVBLK, sr)); S.st_k1 = load8(ROW(Kh, kp, (cur.j_lo + (t) + 1) * KVBLK, 32 + sr)); } \
        SBAR(); qkt<KB, false>(p0, p1, K_lds, r32, hi, S.qr, true); \
        mask_tile(p0, p1, qm - (cur.j_lo + (t)) * KVBLK, Wm); \
        _Pragma("unroll") for (int r = 0; r < 16; ++r) { p0[r] = __builtin_amdgcn_exp2f(fmaf(p0[r], C2, nl2)); p1[r] = __builtin_amdgcn_exp2f(fmaf(p1[r], C2, nl2)); } \
        float Gs[8], Ls[8]; \
        _Pragma("unroll") for (int q = 0; q < 4; ++q) { Gs[q] = (p0[4 * q] + p0[4 * q + 1]) + (p0[4 * q + 2] + p0[4 * q + 3]); Ls[q] = p0[4 * q + 3]; \
                                              Gs[4 + q] = (p1[4 * q] + p1[4 * q + 1]) + (p1[4 * q + 2] + p1[4 * q + 3]); Ls[4 + q] = p1[4 * q + 3]; } \
          \
        float prevL = carry; \
        _Pragma("unroll") for (int q = 0; q < 8; ++q) { const float other = __shfl_xor(Ls[q], 32);        \
            const float add = hi ? other : prevL; prevL = other; Gs[q] += add; } \
        carry = prevL;                                            \
        _Pragma("unroll") for (int q = 0; q < 8; ++q) { float v = Gs[q]; v += __shfl_xor(v, 1); v += __shfl_xor(v, 2); \
            if ((r32 & 3) == 0) imp_row[((cur.j_lo + (t)) << 4) + 2 * q + hi] = v; } \
        if ((t) + 1 < NT) { asm volatile("s_waitcnt vmcnt(0)" ::: "memory"); *(bf16x8*)(K_lds + ((KB) ^ 1) * SHM_K + kws) = S.st_k0; *(bf16x8*)(K_lds + ((KB) ^ 1) * SHM_K + kws + 32 * 256) = S.st_k1; } \
        __syncthreads(); } while (0)
    for (int t = 0; t < NT; t += 2) { IMP_TILE(t, 0); if (t + 1 < NT) IMP_TILE(t + 1, 1); }
#undef IMP_TILE
}
#undef ROW
#undef VMW
#undef VMWN
#undef SLOAD_H
#undef SWRITE_HK
#undef SWRITE_HV
#undef SWRITE_H
#undef KSWZ
#undef SBAR
}

struct RFReg {
    static __device__ __forceinline__ int entry(const att::Ref&, int) { return 0; }
    static __device__ __forceinline__ int q_off(const att::Ref&, int row, int) { return row * 1024; }
    static __device__ __forceinline__ int o_off(const att::Ref&, int row, int) { return row * 1024; }
    static __device__ __forceinline__ int l_idx(const att::Ref& u, int row, int) { return u.a0 >= 0 ? u.a0 + row * 8 : -1; }
    static __device__ __forceinline__ int pos(const att::Ref& u, int row, int) { return u.P0 + row; }
    static __device__ __forceinline__ int Wl(const att::Ref& u, int) { return u.W; }
};
__device__ __forceinline__ att::Ref win_ref(int L, const bf16* QN, const bf16* KW, const bf16* VW, bf16* OWIN) {
    const int h = L & 7, qb = L >> 3;
    att::Ref r; r.Q = QN + (size_t)qb * 256 * 1024 + h * 128; r.O = OWIN + (size_t)qb * 256 * 1024 + h * 128; r.K = KW + (h >> 2) * 128; r.V = VW + (h >> 2) * 128; r.kpitch = 256; r.list = nullptr;
    r.P0 = qb * 256; r.W = 512; r.j_lo = (r.P0 >= 511) ? (r.P0 - 511) >> 6 : 0; r.j_hi = ((r.P0 + 255) >> 6) + 1; r.a0 = -1; r.a1 = 0; return r;
}
__device__ __forceinline__ att::Ref mown_ref(int L, const bf16* QM, const bf16* KM, const bf16* VM, bf16* POWN) {
    const int h = L & 7, n = L >> 3; const size_t o = (size_t)n * 256 * 1024 + h * 128;
    att::Ref r; r.Q = QM + o; r.O = POWN + o; r.K = KM + o; r.V = VM + o; r.kpitch = 1024; r.list = nullptr;
    r.P0 = 0; r.W = 1 << 20; r.j_lo = 0; r.j_hi = 4; r.a0 = n * 256 * 8 + h; r.a1 = 0; return r;
}
struct RFSel {
    static __device__ __forceinline__ int entry(const att::Ref& u, int row) { return u.list[row < u.a0 ? row : 0]; }
    static __device__ __forceinline__ int q_off(const att::Ref&, int, int e) { return (e >> 2) * 1024; }
    static __device__ __forceinline__ int o_off(const att::Ref& u, int row, int e) { return row < u.a0 ? (((e >> 2) * 8 + u.a1) * 3 + (e & 3)) * 128 : -1; }
    static __device__ __forceinline__ int l_idx(const att::Ref& u, int row, int e) { return row < u.a0 ? ((e >> 2) * 8 + u.a1) * 3 + (e & 3) : -1; }
    static __device__ __forceinline__ int pos(const att::Ref&, int, int) { return 0; }
    static __device__ __forceinline__ int Wl(const att::Ref&, int) { return 0; }
};
__device__ __forceinline__ att::Ref msel_ref(int L, const LAS int* tab, const int* MLIST, const bf16* QM, const bf16* KM, const bf16* VM, bf16* PSEL) {
    int lo = 0, hi = 512;
    while (hi - lo > 1) { const int mid = (lo + hi) >> 1; if (tab[512 + mid] <= L) lo = mid; else hi = mid; }
    const int lid = __builtin_amdgcn_readfirstlane(lo), k = L - tab[512 + lid], h = lid >> 6, n = lid & 63;
    att::Ref r; r.Q = QM + h * 128; r.O = PSEL; r.K = KM + (size_t)n * 256 * 1024 + h * 128; r.V = VM + (size_t)n * 256 * 1024 + h * 128; r.kpitch = 1024;
    r.list = MLIST + (size_t)lid * 16384 + k * 256; r.P0 = 0; r.W = 0; r.j_lo = 0; r.j_hi = 4; r.a0 = tab[lid] - k * 256; r.a1 = h; return r;
}

struct RFSlc {
    static __device__ __forceinline__ int entry(const att::Ref& u, int row) { return u.list[(row >> 2) < u.a0 ? (row >> 2) : 0]; }
    static __device__ __forceinline__ int q_off(const att::Ref&, int row, int e) { return (e >> 4) * 1024 + (row & 3) * 128; }
    static __device__ __forceinline__ int o_off(const att::Ref& u, int row, int e) { return (row >> 2) < u.a0 ? (e * 4 + (row & 3)) * 128 : -1; }
    static __device__ __forceinline__ int l_idx(const att::Ref& u, int row, int e) { return (row >> 2) < u.a0 ? e * 4 + (row & 3) : -1; }
    static __device__ __forceinline__ int pos(const att::Ref& u, int, int e) { return (e >> 4) - 64 * u.a1; }
    static __device__ __forceinline__ int Wl(const att::Ref&, int) { return 1 << 30; }
};
__device__ __forceinline__ att::Ref nsel_ref(int L, int g, const LAS int* tab, const int* NLIST, const bf16* QN, const bf16* KS, const bf16* VS, bf16* PSLC) {
    int lo = 0, hi = 256;
    while (hi - lo > 1) { const int mid = (lo + hi) >> 1; if (tab[256 + mid] <= L) lo = mid; else hi = mid; }
    const int j = __builtin_amdgcn_readfirstlane(lo), k = L - tab[256 + j];
    att::Ref r; r.Q = QN + g * 512; r.O = PSLC; r.K = KS + (size_t)j * 64 * 256 + g * 128; r.V = VS + (size_t)j * 64 * 256 + g * 128; r.kpitch = 256;
    r.list = NLIST + (size_t)(g * 256 + j) * 16384 + k * 64; r.P0 = 0; r.W = 0; r.j_lo = 0; r.j_hi = 1; r.a0 = tab[j] - k * 64; r.a1 = j; return r;
}

struct RFCmp {
    static __device__ __forceinline__ int entry(const att::Ref&, int) { return 0; }
    static __device__ __forceinline__ int q_off(const att::Ref&, int row, int) { return (row >> 2) * 1024 + (row & 3) * 128; }
    static __device__ __forceinline__ int o_off(const att::Ref&, int row, int) { return (row >> 2) * 1024 + (row & 3) * 128; }
    static __device__ __forceinline__ int l_idx(const att::Ref&, int, int) { return -1; }
    static __device__ __forceinline__ int pos(const att::Ref& u, int row, int) { const int t = u.P0 + (row >> 2); return t >= 31 ? (t - 31) >> 4 : -1; }
    static __device__ __forceinline__ int Wl(const att::Ref&, int) { return 1 << 30; }
};
__device__ __forceinline__ att::Ref cmp_ref(int L, const bf16* QN, const bf16* KCMP, const bf16* VCMP, bf16* OCMP) {
    const int g = L & 1, c = (L < 256) ? (L >> 1) : 255 - ((L - 256) >> 1);
    att::Ref r; r.Q = QN + (size_t)c * 64 * 1024 + g * 512; r.O = OCMP + (size_t)c * 64 * 1024 + g * 512; r.K = KCMP + g * 128; r.V = VCMP + g * 128; r.kpitch = 256; r.list = nullptr;
    r.P0 = c * 64; r.W = 0; r.j_lo = 0; r.j_hi = (4 * c + 3 + 63) >> 6; r.a0 = g; r.a1 = c; return r;
}

struct Args { const float* in[18]; float* out; unsigned char* ws; int ph_lo, ph_hi, li, pad; };
typedef const __attribute__((address_space(4))) Args* ArgsP;
__device__ __forceinline__ ArgsP get_args() { auto p = __builtin_amdgcn_kernarg_segment_ptr(); asm volatile("" : "+s"(p)); return (ArgsP)p; }

__global__ void __launch_bounds__(NTHR, 2) mk_fwd(Args args_unused) {
    extern __shared__ __attribute__((aligned(16))) unsigned char lds_raw[];
    LAS unsigned char* lds = (LAS unsigned char*)lds_raw;
    LAS float* sm = (LAS float*)lds;
    volatile LAS unsigned* MISC = (volatile LAS unsigned*)(lds + MISC_OFF);
    LAS int* moetab = (LAS int*)(lds + MOETAB_OFF);
    const int G = gridDim.x, bid = blockIdx.x, NGW = G * NWAVES;
#define PH_IDS() int tid_ = threadIdx.x; asm volatile("" : "+v"(tid_)); const int tid = tid_, lane = tid & 63, wave = __builtin_amdgcn_readfirstlane(tid >> 6), gw = bid * NWAVES + wave; (void)lane; (void)gw;
#define AP() get_args()
#define CTLP(ws) ((gu32*)((ws) + WS_CTL))

    for (int u = threadIdx.x; u < (LDS_BYTES - LDSCTL_OFF) / 4; u += NTHR) ((LAS unsigned*)(lds + LDSCTL_OFF))[u] = 0u;
    __syncthreads();
    XcdBarrier bar; bar.bar = nullptr; bar.x = 0; bar.st = nullptr;
    if (MK_N_LAUNCHES == 1) bar = xcd_barrier_post((unsigned*)(CTLP(AP()->ws) + CW_BAR), MISC + 8);
#define GRID_BAR() do { if (MK_N_LAUNCHES == 1) { XcdBarrier b_ = bar; b_.bar = (unsigned*)(CTLP(AP()->ws) + CW_BAR); xcd_barrier(b_); } } while (0)
    const int lo = AP()->ph_lo, hi = AP()->ph_hi;
#define IN(k) (lo <= (k) && (k) < hi)
#define BOTH(k) (IN(k) && IN((k) + 1))

    if (IN(0)) {
        PH_IDS(); ArgsP ap = AP(); unsigned char* ws = ap->ws;
        LAS float* scr = (LAS float*)(lds + wave * 16384);
        constexpr int I_IN = 32 * 177, I_OUT = 32 * 64, I_GU = 32 * 16, I_DN = 8 * 64, I_W1 = 32 * 8;
        constexpr int N_IN = 2 * I_IN, N_OUT = 2 * I_OUT, N_G = 64 * I_GU, N_U = 64 * I_GU, N_D = 64 * I_DN, N_W1 = 8 * I_W1;
        constexpr int NITEMS = N_IN + N_OUT + N_G + N_U + N_D + N_W1;
        for (int it = gw; it < NITEMS; it += NGW) {
            int r = it;
            if (r < N_IN) { const int l = r / I_IN; transpose_item<1>(ap->in[6] + (size_t)l * D_ * IN_W, D_, IN_W, (bf16*)(ws + WS_WINT) + (size_t)l * NIN * D_, D_, 0, scr, r % I_IN, lane); continue; } r -= N_IN;
            if (r < N_OUT) { const int l = r / I_OUT; transpose_item<0>(ap->in[7] + (size_t)l * D_ * D_, D_, D_, (bf16*)(ws + WS_WOUTT) + (size_t)l * D_ * D_, D_, 0, scr, r % I_OUT, lane); continue; } r -= N_OUT;
            if (r < N_G) { const int le = r / I_GU; transpose_item<2>(ap->in[14] + (size_t)le * D_ * DEXP, D_, DEXP, (bf16*)(ws + WS_WGUT) + (size_t)le * 1024 * D_, D_, 0, scr, r % I_GU, lane); continue; } r -= N_G;
            if (r < N_U) { const int le = r / I_GU; transpose_item<3>(ap->in[15] + (size_t)le * D_ * DEXP, D_, DEXP, (bf16*)(ws + WS_WGUT) + (size_t)le * 1024 * D_, D_, 0, scr, r % I_GU, lane); continue; } r -= N_U;
            if (r < N_D) { const int le = r / I_DN; transpose_item<0>(ap->in[16] + (size_t)le * DEXP * D_, DEXP, D_, (bf16*)(ws + WS_WDT) + (size_t)le * D_ * DEXP, DEXP, 0, scr, r % I_DN, lane); continue; } r -= N_D;
            { const int m = r / I_W1, lk = m >> 1, half = m & 1;
              transpose_item<0>(ap->in[9] + (size_t)lk * 4096 * 256 + (size_t)half * 2048 * 256, 2048, 256, (bf16*)(ws + WS_WC1T) + (size_t)lk * 512 * 2048, 2048, half * 256, scr, r % I_W1, lane); }
        }
        { const float* w_router = ap->in[12]; bf16* WrT = (bf16*)(ws + WS_WRT);
          for (int idx = bid * NTHR + tid; idx < 32 * 2048; idx += G * NTHR) { const int e = idx >> 11, k = idx & 2047; const float w = w_router[(size_t)k * 32 + e];
            const unsigned hb = f2bf(w); const float rem = w - bf2f(hb); WrT[idx] = (bf16)hb; WrT[32 * 2048 + idx] = (bf16)f2bf(rem); } }
        { f32x2* ROPE = (f32x2*)(ws + WS_ROPE);
          for (int idx = bid * NTHR + tid; idx < S_ * 64; idx += G * NTHR) { const int pos = idx >> 6, i = idx & 63;
            const double inv = exp(-(double)i * (9.210340371976184 / 64.0)); const double ang = (double)pos * inv; double sv, cv; sincos(ang, &sv, &cv);
            ROPE[idx] = (f32x2){(float)cv, (float)sv}; } }
        __syncthreads();
        { float* MOD = (float*)(CTLP(ws) + CW_MOD); const float* c_in = ap->in[1]; const float* w_ada = ap->in[2]; const float* b_ada = ap->in[3];
          for (int k = tid; k < D_; k += NTHR) { const float cv = c_in[k]; sm[k] = cv / (1.f + __expf(-cv)); }
          __syncthreads();
          for (int it = bid; it < 2 * 96; it += G) { const int l = it / 96, cb = it % 96, grp = tid >> 5, col = cb * 128 + (tid & 31) * 4;
            f32x4 a = (f32x4){0.f, 0.f, 0.f, 0.f};
            const float* wp = w_ada + ((size_t)l * D_ + grp) * 12288 + col;
#pragma unroll 8
            for (int i = 0; i < 128; ++i) a += *(const f32x4*)(wp + (size_t)i * 16 * 12288) * sm[grp + 16 * i];
            *(LAS f32x4*)(sm + 4096 + grp * 128 + (tid & 31) * 4) = a;
            __syncthreads();
            if (tid < 128) { float s = b_ada[l * 12288 + cb * 128 + tid];
#pragma unroll
                for (int q = 0; q < 16; ++q) s += sm[4096 + q * 128 + tid];
                MOD[l * 12288 + cb * 128 + tid] = s; }
            __syncthreads(); } }
        { float* B1E = (float*)(CTLP(ws) + CW_B1E); const float* cmp_pe = ap->in[8]; const float* cmp_w1 = ap->in[9]; const float* cmp_b1 = ap->in[10];
          for (int it = bid - 192; it >= 0 && it < 4; it += G) { const int lk = it, grp = tid >> 6, n = (tid & 63) * 4;
            f32x4 a = (f32x4){0.f, 0.f, 0.f, 0.f};
            const float* wp = cmp_w1 + ((size_t)lk * 4096 + grp) * 256 + n; const float* pe = cmp_pe + (size_t)lk * 4096 + grp;
#pragma unroll 8
            for (int i = 0; i < 512; ++i) a += *(const f32x4*)(wp + (size_t)i * 8 * 256) * pe[i * 8];
            *(LAS f32x4*)(sm + 4096 + grp * 256 + n) = a;
            __syncthreads();
            if (tid < 256) { float s = cmp_b1[lk * 256 + tid];
#pragma unroll
                for (int q = 0; q < 8; ++q) s += sm[4096 + q * 256 + tid];
                B1E[lk * 256 + tid] = s; }
            __syncthreads(); } }
        if (BOTH(0)) GRID_BAR();
    }

    for (int l = 0; l < DEPTH; ++l) {
        const int pb = 1 + NPL * l;
#define LOAD_MOETAB(CNTP, NT_) do { __syncthreads(); if (tid < 32) moetab[tid] = (int)__hip_atomic_load((CNTP) + tid, RLX_AGENT); __syncthreads(); \
        if (tid == 0) { int us = 0, ps = 0; for (int e = 0; e < NEXP; ++e) { const int c = moetab[e], tl = (c + 255) >> 8; moetab[32 + e] = us; moetab[65 + e] = ps; us += tl * (NT_); ps += tl << 8; } moetab[64] = us; } \
        __syncthreads(); } while (0)

        if (IN(pb + 0)) {
            PH_IDS(); ArgsP ap = AP(); unsigned char* ws = ap->ws;
            const float* MOD = (const float*)(CTLP(ws) + CW_MOD); const float* mod = MOD + l * 12288;
            float* X = ap->out; bf16* H = (bf16*)(ws + WS_H); const bf16* Y = (const bf16*)(ws + WS_Y); const int* TE = (const int*)(ws + WS_TE);
            if (l > 0) LOAD_MOETAB((unsigned*)(CTLP(ws) + CW_CNT) + (l - 1) * 32, 1);
            { const float* g_attn = ap->in[4];
              for (int k = tid; k < D_; k += NTHR) { sm[k] = g_attn[l * D_ + k] * (1.f + mod[2048 + k]); sm[2048 + k] = mod[k]; sm[4096 + k] = (l > 0) ? MOD[(l - 1) * 12288 + 10240 + k] : 0.f; } }
            __syncthreads();
            const float* x_in = ap->in[0];
            for (int t = gw; t < S_; t += NGW) {
                f32x4 v[8]; float ss = 0.f;
                if (l == 0) {
#pragma unroll
                    for (int j = 0; j < 8; ++j) v[j] = *(const f32x4*)(x_in + (size_t)t * D_ + 256 * j + 4 * lane);
                } else {
                    const int4 te = *(const int4*)(TE + 4 * t);
                    const bf16* y0 = Y + (size_t)(moetab[65 + te.x] + te.y) * D_; const bf16* y1 = Y + (size_t)(moetab[65 + te.z] + te.w) * D_;
#pragma unroll
                    for (int j = 0; j < 8; ++j) { const int k = 256 * j + 4 * lane; const uint2 a = *(const uint2*)(y0 + k), b = *(const uint2*)(y1 + k);
                        const f32x4 gt2 = *(const LAS f32x4*)(sm + 4096 + k);
                        f32x4 ysum = (f32x4){bflo(a.x) + bflo(b.x), bfhi(a.x) + bfhi(b.x), bflo(a.y) + bflo(b.y), bfhi(a.y) + bfhi(b.y)};
                        v[j] = *(const f32x4*)(X + (size_t)t * D_ + k) + gt2 * ysum; *(f32x4*)(X + (size_t)t * D_ + k) = v[j]; }
                }
#pragma unroll
                for (int j = 0; j < 8; ++j) ss += (v[j][0] * v[j][0] + v[j][1] * v[j][1]) + (v[j][2] * v[j][2] + v[j][3] * v[j][3]);
                const float rstd = 1.f / sqrtf(wave_sum(ss) * (1.f / D_) + RMS_EPS);
#pragma unroll
                for (int j = 0; j < 8; ++j) { const int k = 256 * j + 4 * lane; const f32x4 h = v[j] * rstd * *(const LAS f32x4*)(sm + k) + *(const LAS f32x4*)(sm + 2048 + k);
                    *(uint2*)(H + (size_t)t * D_ + k) = make_uint2(pk2(h[0], h[1]), pk2(h[2], h[3])); }
            }
            if (BOTH(pb + 0)) GRID_BAR();
        }
        if (IN(pb + 1)) {
            ArgsP ap = AP(); unsigned char* ws = ap->ws;
            pg8::Gemm g{(const bf16*)(ws + WS_H), (const bf16*)(ws + WS_WINT) + (size_t)l * NIN * D_, S_, NIN, D_}; pg8::StaticOrder So; So.init(S_, NIN, G, bid);
            EpiInProj E{(bf16*)(ws + WS_QN), (bf16*)(ws + WS_KC), (bf16*)(ws + WS_VC), (bf16*)(ws + WS_KS), (bf16*)(ws + WS_VS), (bf16*)(ws + WS_KW), (bf16*)(ws + WS_VW),
                        (bf16*)(ws + WS_QM), (bf16*)(ws + WS_KM), (bf16*)(ws + WS_VM), (float*)(ws + WS_GATES), (const float*)(ws + WS_ROPE)};
            pg8::gemm_phase<EpiInProj, pg8::StaticOrder, true, true>(lds, g, So, E);
            if (BOTH(pb + 1)) GRID_BAR();
        }
        if (IN(pb + 2)) {
            PH_IDS(); ArgsP ap = AP(); unsigned char* ws = ap->ws;
            if (bid < 32) {
                pg8::Gemm g{(const bf16*)(ws + WS_KC), (const bf16*)(ws + WS_WC1T) + (size_t)l * 2 * 512 * 2048, 4096, 512, 2048}; CompressOrder So{G, bid};
                EpiF32 E{(float*)(ws + WS_UL), 512};
                pg8::gemm_phase<EpiF32, CompressOrder, false, true>(lds, g, So, E);
            }
            {
                const bf16* KM = (const bf16*)(ws + WS_KM); float* KMEAN = (float*)(ws + WS_KMEAN);
                const int nb = (G > 32) ? G - 32 : G, b0 = (G > 32) ? bid - 32 : bid;
                if (b0 >= 0) for (int u = b0; u < 512; u += nb) { const int n = u >> 3, h = u & 7, rg = tid >> 4, c8 = (tid & 15) * 8;
                    float a8[8] = {0.f, 0.f, 0.f, 0.f, 0.f, 0.f, 0.f, 0.f};
#pragma unroll
                    for (int i = 0; i < 8; ++i) { const v4u kv = *(const v4u*)(KM + (size_t)(n * 256 + rg + 32 * i) * 1024 + h * 128 + c8);
                        a8[0] += bflo(kv.x); a8[1] += bfhi(kv.x); a8[2] += bflo(kv.y); a8[3] += bfhi(kv.y); a8[4] += bflo(kv.z); a8[5] += bfhi(kv.z); a8[6] += bflo(kv.w); a8[7] += bfhi(kv.w); }
#pragma unroll
                    for (int i = 0; i < 8; ++i) sm[rg * 128 + c8 + i] = a8[i];
                    __syncthreads();
                    if (tid < 128) { float s = 0.f;
#pragma unroll 8
                        for (int q = 0; q < 32; ++q) s += sm[q * 128 + tid];
                        KMEAN[(size_t)(n * 8 + h) * 128 + tid] = s * (1.f / 256.f); }
                    __syncthreads(); }
            }
            if (BOTH(pb + 2)) GRID_BAR();
        }
        if (IN(pb + 3)) {
            PH_IDS(); ArgsP ap = AP(); unsigned char* ws = ap->ws;
            const float* UL = (const float*)(ws + WS_UL); const float* B1E = (const float*)(CTLP(ws) + CW_B1E); const f32x2* ROPE = (const f32x2*)(ws + WS_ROPE);
            bf16* KCMP = (bf16*)(ws + WS_KCMP); bf16* VCMP = (bf16*)(ws + WS_VCMP); const float* cmp_w2 = ap->in[11];
            { const int kv = bid & 1; const float* w2 = cmp_w2 + (size_t)(l * 2 + kv) * 256 * 128; const float* be = B1E + (l * 2 + kv) * 256;
              for (int i = tid; i < 256 * 128 / 4; i += NTHR) *(LAS f32x4*)(sm + 4 * i) = *(const f32x4*)(w2 + 4 * i);
              LAS float* hid = (LAS float*)(lds + 135168) + wave * 256;
              __syncthreads();
              const int nb2 = (G + 1 - kv) >> 1;
              for (int r = (bid >> 1) * NWAVES + wave; r < NC * 2; r += nb2 * NWAVES) { const int c = r >> 1, g = r & 1;
                const float* Ur = UL + ((size_t)kv * 2048 + g * 1024 + c) * 512; const float* Lr = UL + ((size_t)kv * 2048 + g * 1024 + c + 1) * 512 + 256;
#pragma unroll
                for (int j = 0; j < 4; ++j) { const int n = lane + 64 * j; const float v = Ur[n] + Lr[n] + be[n];
                    hid[n] = 0.5f * v * (1.f + tanhf(0.7978845608028654f * (v + 0.044715f * v * v * v))); }
                LDS_WAIT(); asm volatile("" ::: "memory");
                float o0 = 0.f, o1 = 0.f;
#pragma unroll 8
                for (int n = 0; n < 256; ++n) { const float hv = hid[n]; o0 += hv * sm[n * 128 + lane]; o1 += hv * sm[n * 128 + 64 + lane]; }
                if (kv == 0) { const f32x2 cs = ROPE[(size_t)(16 * c + 31) * 64 + lane];
                    const float a = o0 * cs[0] - o1 * cs[1], b = o1 * cs[0] + o0 * cs[1];
                    *(unsigned*)(KCMP + ((size_t)c * 2 + g) * 128 + 2 * lane) = pk2(a, b);
                } else { VCMP[((size_t)c * 2 + g) * 128 + lane] = (bf16)f2bf(o0); VCMP[((size_t)c * 2 + g) * 128 + 64 + lane] = (bf16)f2bf(o1); }
                LDS_WAIT(); asm volatile("" ::: "memory");
              }
              __syncthreads(); }
            if (BOTH(pb + 3)) GRID_BAR();
        }
        if (IN(pb + 4)) {
            {   ArgsP ap = AP(); unsigned char* ws = ap->ws;
                const bf16* QN = (const bf16*)(ws + WS_QN); const bf16* KCMP = (const bf16*)(ws + WS_KCMP); const bf16* VCMP = (const bf16*)(ws + WS_VCMP);
                bf16* OCMP = (bf16*)(ws + WS_OCMP); float* IMP = (float*)(ws + WS_IMP);
                att::Seam S;
                for (int L = bid; L < 512; L += G) { const att::Ref cur = cmp_ref(L, QN, KCMP, VCMP, OCMP); float lse;
                    att::prime<RFCmp>(cur, (char*)lds_raw, S);
                    att::block<2, false, RFCmp>(cur, cur, nullptr, (char*)lds_raw, S, &lse);
                    att::imp_sweep<RFCmp>(cur, lse, IMP + ((size_t)cur.a1 * 64 * 2 + cur.a0) * 256, (char*)lds_raw, S); }
            }
            {   ArgsP ap = AP(); unsigned char* ws = ap->ws;
                const bf16* QN = (const bf16*)(ws + WS_QN); const bf16* KW = (const bf16*)(ws + WS_KW); const bf16* VW = (const bf16*)(ws + WS_VW); bf16* OWIN = (bf16*)(ws + WS_OWIN);
                __syncthreads();
                att::Seam S; int L = bid;
                if (L < 512) { att::Ref cur = win_ref(L, QN, KW, VW, OWIN); att::prime<RFReg>(cur, (char*)lds_raw, S);
                    for (;;) { const bool more = L + G < 512; const att::Ref nxt = more ? win_ref(L + G, QN, KW, VW, OWIN) : cur;
                        att::block<0, true, RFReg>(cur, nxt, nullptr, (char*)lds_raw, S);
                        if (!more) break; cur = nxt; L += G; } }
                __syncthreads();
            }
            {   PH_IDS(); ArgsP ap = AP(); unsigned char* ws = ap->ws;
                const bf16* QM = (const bf16*)(ws + WS_QM); const float* KMEAN = (const float*)(ws + WS_KMEAN);
                unsigned* MCNT = (unsigned*)(CTLP(ws) + CW_MCNT) + l * 512; int* MLIST = (int*)(ws + WS_MLIST); float* LSES = (float*)(ws + WS_LSES);
                LAS float* qs = sm; LAS float* ks = sm + 8192; LAS float* gs = sm + 8192 + 64 * 132;
                for (int u = bid; u < 2048; u += G) { const int c = u >> 3, h = u & 7, own = c >> 2;
                    __syncthreads();
                    for (int i = tid; i < 1024; i += NTHR) { const int q = i >> 4, c8 = (i & 15) * 8; const v4u kv = *(const v4u*)(QM + (size_t)(c * 64 + q) * 1024 + h * 128 + c8);
                        *(LAS f32x4*)(qs + q * 128 + c8) = (f32x4){bflo(kv.x), bfhi(kv.x), bflo(kv.y), bfhi(kv.y)}; *(LAS f32x4*)(qs + q * 128 + c8 + 4) = (f32x4){bflo(kv.z), bfhi(kv.z), bflo(kv.w), bfhi(kv.w)}; }
                    for (int i = tid; i < own * 32; i += NTHR) { const int n = i >> 5, c4 = (i & 31) * 4; *(LAS f32x4*)(ks + n * 132 + c4) = *(const f32x4*)(KMEAN + (size_t)(n * 8 + h) * 128 + c4); }
                    __syncthreads();
                    { const int q = tid >> 3, nn = tid & 7;
                      for (int n = nn; n < own; n += 8) { float a = 0.f;
#pragma unroll 8
                          for (int d = 0; d < 128; d += 4) { const f32x4 qa = *(const LAS f32x4*)(qs + q * 128 + d), ka = *(const LAS f32x4*)(ks + n * 132 + d); a += qa[0] * ka[0] + qa[1] * ka[1] + qa[2] * ka[2] + qa[3] * ka[3]; }
                          gs[q * 64 + n] = a; } }
                    __syncthreads();
                    { const int lam = lane & 15, rho = lane >> 4;
                      for (int qq = 0; qq < 2; ++qq) { const int q = wave * 8 + qq * 4 + rho, t = c * 64 + q;
                        float v[4];
#pragma unroll
                        for (int i = 0; i < 4; ++i) { const int n = lam + 16 * i; v[i] = (n < own) ? gs[q * 64 + n] : -INFINITY; }
                        int mysel = -1;
#pragma unroll
                        for (int r = 0; r < 3; ++r) { const int pick = row_pick<4>(v, lam); if (lam == r) mysel = pick; }
                        if (lam < 3) {
                            if (mysel >= 0) { const unsigned p = atomicAdd(MCNT + h * 64 + mysel, 1u); MLIST[(size_t)(h * 64 + mysel) * 16384 + p] = t * 4 + lam; }
                            else LSES[(t * 8 + h) * 3 + lam] = -INFINITY; } } }
                }
            }
            if (BOTH(pb + 4)) GRID_BAR();
        }
        if (IN(pb + 5)) {
            PH_IDS(); ArgsP ap = AP(); unsigned char* ws = ap->ws;
            {   PH_IDS(); ArgsP ap = AP(); unsigned char* ws = ap->ws;
                const float* IMP = (const float*)(ws + WS_IMP); int* SEL = (int*)(ws + WS_SEL);
                unsigned* NCNT = (unsigned*)(CTLP(ws) + CW_NCNT) + l * 512; int* NLIST = (int*)(ws + WS_NLIST);
                const int lam = lane & 15, rho = lane >> 4;
                for (int ub = gw * 4; ub < S_ * 2; ub += NGW * 4) { const int u = ub + rho, t = u >> 1, g = u & 1, tb = t >> 6;
                    float v[16];
#pragma unroll
                    for (int i = 0; i < 16; ++i) { const int j = lam + 16 * i; const float im = IMP[(size_t)u * 256 + j]; const bool forced = (j == 0) || (j == tb) || (j == tb - 1);
                        v[i] = (j > tb) ? -INFINITY : (forced ? 1e9f : im); }
                    int mysel = -1;
                    for (int r = 0; r < 16; ++r) { const int pick = row_pick<16>(v, lam); if (lam == r) mysel = pick; if (__all(pick < 0)) break; }
                    SEL[(size_t)u * 16 + lam] = mysel;
                    if (mysel >= 0) {
                        unsigned p;
                        if (mysel == 0) p = (unsigned)t; else if (mysel == tb) p = (unsigned)(t & 63); else if (mysel == tb - 1) p = 64u + (unsigned)(t & 63);
                        else p = 128u + atomicAdd(NCNT + g * 256 + mysel, 1u);
                        NLIST[(size_t)(g * 256 + mysel) * 16384 + p] = t * 16 + lam; }
                }
            }
            {   PH_IDS(); ArgsP ap = AP(); unsigned char* ws = ap->ws;
                const bf16* QM = (const bf16*)(ws + WS_QM); const bf16* KM = (const bf16*)(ws + WS_KM); const bf16* VM = (const bf16*)(ws + WS_VM);
                bf16* POWN = (bf16*)(ws + WS_POWN); bf16* PSEL = (bf16*)(ws + WS_PSEL); float* LSEO = (float*)(ws + WS_LSEO); float* LSES = (float*)(ws + WS_LSES);
                const int* MLIST = (const int*)(ws + WS_MLIST); unsigned* MCNT = (unsigned*)(CTLP(ws) + CW_MCNT) + l * 512;
                LAS int* mtab = (LAS int*)(lds + att::LDS_BYTES);
                __syncthreads();
                mtab[tid] = (int)__hip_atomic_load(MCNT + tid, RLX_AGENT);
                __syncthreads();
                if (tid == 0) { int us = 0; for (int i = 0; i < 512; ++i) { mtab[512 + i] = us; us += (mtab[i] + 255) >> 8; } mtab[1024] = us; }
                __syncthreads();
                const int nsel = mtab[1024];
                att::Seam S;
                { int L = bid;
                  if (L < 512) { att::Ref cur = mown_ref(L, QM, KM, VM, POWN); att::prime<RFReg>(cur, (char*)lds_raw, S);
                    for (;;) { const bool more = L + G < 512; const att::Ref nxt = more ? mown_ref(L + G, QM, KM, VM, POWN) : cur;
                        att::block<0, true, RFReg>(cur, nxt, LSEO, (char*)lds_raw, S);
                        if (!more) break; cur = nxt; L += G; } } }
                __syncthreads();
                { int L = bid;
                  if (L < nsel) { att::Ref cur = msel_ref(L, mtab, MLIST, QM, KM, VM, PSEL); att::prime<RFSel>(cur, (char*)lds_raw, S);
                    for (;;) { const bool more = L + G < nsel; const att::Ref nxt = more ? msel_ref(L + G, mtab, MLIST, QM, KM, VM, PSEL) : cur;
                        att::block<1, false, RFSel>(cur, nxt, LSES, (char*)lds_raw, S);
                        if (!more) break; cur = nxt; L += G; } } }
                __syncthreads();
            }
            if (BOTH(pb + 5)) GRID_BAR();
        }
        if (IN(pb + 6)) {
            PH_IDS(); ArgsP ap = AP(); unsigned char* ws = ap->ws;
            const bf16* POWN = (const bf16*)(ws + WS_POWN); const bf16* PSEL = (const bf16*)(ws + WS_PSEL); const float* LSEO = (const float*)(ws + WS_LSEO); const float* LSES = (const float*)(ws + WS_LSES);
            bf16* OMIX = (bf16*)(ws + WS_OMIX);
            for (int t = gw; t < S_; t += NGW) {
                const int hh = (lane >> 2) & 7, ii = lane & 3;
                const float lv = (ii == 0) ? LSEO[t * 8 + hh] : LSES[(t * 8 + hh) * 3 + ii - 1];
                float m = fmaxf(lv, __shfl_xor(lv, 1)); m = fmaxf(m, __shfl_xor(m, 2));
                float w = __expf(lv - m); float sw = w + __shfl_xor(w, 1); sw += __shfl_xor(sw, 2); w = w / sw;
#pragma unroll
                for (int hp = 0; hp < 2; ++hp) { const int h = hp * 4 + (lane >> 4), c8 = (lane & 15) * 8;
                    const float w0 = __shfl(w, h * 4), w1 = __shfl(w, h * 4 + 1), w2 = __shfl(w, h * 4 + 2), w3 = __shfl(w, h * 4 + 3);
                    const bf16* ps = PSEL + (size_t)((t * 8 + h) * 3) * 128 + c8;
                    const v4u a0 = *(const v4u*)(POWN + (size_t)t * 1024 + h * 128 + c8);
                    v4u a1 = (v4u){0u, 0u, 0u, 0u}, a2 = a1, a3 = a1;
                    if (w1 > 0.f) a1 = *(const v4u*)(ps); if (w2 > 0.f) a2 = *(const v4u*)(ps + 128); if (w3 > 0.f) a3 = *(const v4u*)(ps + 256);
                    v4u ov;
                    ov.x = pk2(w0 * bflo(a0.x) + w1 * bflo(a1.x) + w2 * bflo(a2.x) + w3 * bflo(a3.x), w0 * bfhi(a0.x) + w1 * bfhi(a1.x) + w2 * bfhi(a2.x) + w3 * bfhi(a3.x));
                    ov.y = pk2(w0 * bflo(a0.y) + w1 * bflo(a1.y) + w2 * bflo(a2.y) + w3 * bflo(a3.y), w0 * bfhi(a0.y) + w1 * bfhi(a1.y) + w2 * bfhi(a2.y) + w3 * bfhi(a3.y));
                    ov.z = pk2(w0 * bflo(a0.z) + w1 * bflo(a1.z) + w2 * bflo(a2.z) + w3 * bflo(a3.z), w0 * bfhi(a0.z) + w1 * bfhi(a1.z) + w2 * bfhi(a2.z) + w3 * bfhi(a3.z));
                    ov.w = pk2(w0 * bflo(a0.w) + w1 * bflo(a1.w) + w2 * bflo(a2.w) + w3 * bflo(a3.w), w0 * bfhi(a0.w) + w1 * bfhi(a1.w) + w2 * bfhi(a2.w) + w3 * bfhi(a3.w));
                    *(v4u*)(OMIX + (size_t)t * 2048 + 1024 + h * 128 + c8) = ov; }
            }
            if (BOTH(pb + 6)) GRID_BAR();

        }
        for (int g = 0; g < 2; ++g) {
            if (IN(pb + 7 + 2 * g)) {
                PH_IDS(); ArgsP ap = AP(); unsigned char* ws = ap->ws;
                const bf16* QN = (const bf16*)(ws + WS_QN); const bf16* KS = (const bf16*)(ws + WS_KS); const bf16* VS = (const bf16*)(ws + WS_VS);
                bf16* PSLC = (bf16*)(ws + WS_PSLC); float* LSEN = (float*)(ws + WS_LSEN); const int* NLIST = (const int*)(ws + WS_NLIST); unsigned* NCNT = (unsigned*)(CTLP(ws) + CW_NCNT) + l * 512 + g * 256;
                LAS int* ntab = (LAS int*)(lds + att::LDS_BYTES);
                __syncthreads();
                if (tid < 256) ntab[tid] = (tid == 0) ? S_ : (int)__hip_atomic_load(NCNT + tid, RLX_AGENT) + 64 + (tid < 255 ? 64 : 0);
                __syncthreads();
                if (tid == 0) { int us = 0; for (int i = 0; i < 256; ++i) { ntab[256 + i] = us; us += (ntab[i] + 63) >> 6; } ntab[512] = us; }
                __syncthreads();
                const int nun = ntab[512];
                att::Seam S; int L = bid;
                if (L < nun) { att::Ref cur = nsel_ref(L, g, ntab, NLIST, QN, KS, VS, PSLC); att::prime<RFSlc>(cur, (char*)lds_raw, S);
                    for (;;) { const bool more = L + G < nun; const att::Ref nxt = more ? nsel_ref(L + G, g, ntab, NLIST, QN, KS, VS, PSLC) : cur;
                        att::block<2, false, RFSlc>(cur, nxt, LSEN, (char*)lds_raw, S);
                        if (!more) break; cur = nxt; L += G; } }
                __syncthreads();
                if (BOTH(pb + 7 + 2 * g)) GRID_BAR();
            }
            if (IN(pb + 8 + 2 * g)) {
                PH_IDS(); ArgsP ap = AP(); unsigned char* ws = ap->ws;
                const bf16* PSLC = (const bf16*)(ws + WS_PSLC); const float* LSEN = (const float*)(ws + WS_LSEN); const int* SEL = (const int*)(ws + WS_SEL); const float* GATES = (const float*)(ws + WS_GATES);
                const bf16* OCMP = (const bf16*)(ws + WS_OCMP); const bf16* OWIN = (const bf16*)(ws + WS_OWIN); bf16* OMIX = (bf16*)(ws + WS_OMIX);
                for (int t = gw; t < S_; t += NGW) {
                    const int sv = (lane < 16) ? SEL[(size_t)(t * 2 + g) * 16 + lane] : -1;
                    const int nsel = __popcll(__ballot(sv >= 0));
                    const float lv = ((lane >> 2) < nsel) ? LSEN[(size_t)t * 64 + lane] : -INFINITY;
                    float m = lv;
#pragma unroll
                    for (int o = 4; o < 64; o <<= 1) m = fmaxf(m, __shfl_xor(m, o));
                    float w = __expf(lv - m), sw = w;
#pragma unroll
                    for (int o = 4; o < 64; o <<= 1) sw += __shfl_xor(sw, o);
                    w = w / sw;
                    const int r = lane >> 4, c8 = (lane & 15) * 8;
                    float o8[8] = {0.f, 0.f, 0.f, 0.f, 0.f, 0.f, 0.f, 0.f};
                    v4u pv[16];
#pragma unroll
                    for (int s = 0; s < 16; ++s) { const int sc = s < nsel ? s : nsel - 1; pv[s] = *(const v4u*)(PSLC + ((size_t)(t * 16 + sc) * 4 + r) * 128 + c8); }
#pragma unroll
                    for (int s = 0; s < 16; ++s) { const float ws_ = __shfl(w, s * 4 + r);
                        o8[0] += ws_ * bflo(pv[s].x); o8[1] += ws_ * bfhi(pv[s].x); o8[2] += ws_ * bflo(pv[s].y); o8[3] += ws_ * bfhi(pv[s].y);
                        o8[4] += ws_ * bflo(pv[s].z); o8[5] += ws_ * bfhi(pv[s].z); o8[6] += ws_ * bflo(pv[s].w); o8[7] += ws_ * bfhi(pv[s].w); }
                    const int hd = g * 4 + r; const float g0 = GATES[(size_t)t * 32 + hd * 3], g1 = GATES[(size_t)t * 32 + hd * 3 + 1], g2 = GATES[(size_t)t * 32 + hd * 3 + 2];
                    const size_t oi = (size_t)t * 1024 + hd * 128 + c8;
                    const v4u cv = *(const v4u*)(OCMP + oi), wv = *(const v4u*)(OWIN + oi);
                    v4u ov;
                    ov.x = pk2(g1 * o8[0] + g0 * bflo(cv.x) + g2 * bflo(wv.x), g1 * o8[1] + g0 * bfhi(cv.x) + g2 * bfhi(wv.x));
                    ov.y = pk2(g1 * o8[2] + g0 * bflo(cv.y) + g2 * bflo(wv.y), g1 * o8[3] + g0 * bfhi(cv.y) + g2 * bfhi(wv.y));
                    ov.z = pk2(g1 * o8[4] + g0 * bflo(cv.z) + g2 * bflo(wv.z), g1 * o8[5] + g0 * bfhi(cv.z) + g2 * bfhi(wv.z));
                    ov.w = pk2(g1 * o8[6] + g0 * bflo(cv.w) + g2 * bflo(wv.w), g1 * o8[7] + g0 * bfhi(cv.w) + g2 * bfhi(wv.w));
                    *(v4u*)(OMIX + (size_t)t * 2048 + hd * 128 + c8) = ov;
                }
                if (BOTH(pb + 8 + 2 * g)) GRID_BAR();
            }
        }
        if (IN(pb + 11)) {
            ArgsP ap = AP(); unsigned char* ws = ap->ws;
            pg8::Gemm g{(const bf16*)(ws + WS_OMIX), (const bf16*)(ws + WS_WOUTT) + (size_t)l * D_ * D_, S_, D_, D_}; pg8::StaticOrder So; So.init(S_, D_, G, bid);
            EpiOutProj E{l == 0 ? ap->in[0] : (const float*)ap->out, ap->out, (const float*)(CTLP(ws) + CW_MOD) + l * 12288 + 4096};
            pg8::gemm_phase<EpiOutProj, pg8::StaticOrder, true, true>(lds, g, So, E);
            if (BOTH(pb + 11)) GRID_BAR();
        }
        if (IN(pb + 12)) {
            PH_IDS(); ArgsP ap = AP(); unsigned char* ws = ap->ws;
            const float* mod = (const float*)(CTLP(ws) + CW_MOD) + l * 12288;
            const float* X = ap->out; bf16* H = (bf16*)(ws + WS_H); const bf16* WrT = (const bf16*)(ws + WS_WRT); const float* b_router = ap->in[13];
            unsigned* CNT = (unsigned*)(CTLP(ws) + CW_CNT) + l * 32; int* TE = (int*)(ws + WS_TE); int* TOKIDX = (int*)(ws + WS_TOKIDX); float* WTS = (float*)(ws + WS_WTS);
            { const float* g_ffn = ap->in[5];
              for (int k = tid; k < D_; k += NTHR) { sm[k] = g_ffn[l * D_ + k] * (1.f + mod[8192 + k]); sm[2048 + k] = mod[6144 + k]; }
              if (tid < 32) sm[4160 + tid] = b_router[tid]; }
            typedef short bf16x8_t __attribute__((ext_vector_type(8))); typedef float f32x16_t __attribute__((ext_vector_type(16)));
            for (int bt = bid; bt < S_ / 64; bt += G) { const int t0 = bt * 64;
                __syncthreads();
                for (int rr = 0; rr < 8; ++rr) { const int row = wave * 8 + rr; float ss = 0.f;
#pragma unroll
                    for (int j = 0; j < 8; ++j) { const f32x4 v = *(const f32x4*)(X + (size_t)(t0 + row) * D_ + 256 * j + 4 * lane); ss += (v[0] * v[0] + v[1] * v[1]) + (v[2] * v[2] + v[3] * v[3]); }
                    ss = wave_sum(ss); if (lane == 0) sm[4096 + row] = 1.f / sqrtf(ss * (1.f / D_) + RMS_EPS); }
                __syncthreads();
                { const int r = lane & 31, kh = lane >> 5; f32x16_t acc0 = {}, acc1 = {};
                  const float rs0 = sm[4096 + r], rs1 = sm[4096 + 32 + r];
#pragma unroll 1
                  for (int ks = 0; ks < 16; ++ks) { const int k = wave * 256 + ks * 16 + kh * 8;
                    const bf16x8_t wh = *(const bf16x8_t*)(WrT + (size_t)r * 2048 + k), wl = *(const bf16x8_t*)(WrT + 32 * 2048 + (size_t)r * 2048 + k);
                    const f32x4 gA = *(const LAS f32x4*)(sm + k), gB = *(const LAS f32x4*)(sm + k + 4), sA = *(const LAS f32x4*)(sm + 2048 + k), sB = *(const LAS f32x4*)(sm + 2048 + k + 4);
#pragma unroll
                    for (int rg = 0; rg < 2; ++rg) { const size_t ro = (size_t)(t0 + rg * 32 + r) * D_ + k; const float rs = rg ? rs1 : rs0;
                        const f32x4 xa = *(const f32x4*)(X + ro), xb = *(const f32x4*)(X + ro + 4);
                        const f32x4 ha = xa * rs * gA + sA, hb = xb * rs * gB + sB;
                        const unsigned h0 = pk2(ha[0], ha[1]), h1 = pk2(ha[2], ha[3]), h2 = pk2(hb[0], hb[1]), h3 = pk2(hb[2], hb[3]);
                        *(v4u*)(H + ro) = (v4u){h0, h1, h2, h3};
                        const unsigned l0 = pk2(ha[0] - bflo(h0), ha[1] - bfhi(h0)), l1 = pk2(ha[2] - bflo(h1), ha[3] - bfhi(h1)), l2 = pk2(hb[0] - bflo(h2), hb[1] - bfhi(h2)), l3 = pk2(hb[2] - bflo(h3), hb[3] - bfhi(h3));
                        const v4u hv = (v4u){h0, h1, h2, h3}, lv = (v4u){l0, l1, l2, l3};
                        const bf16x8_t ahi = __builtin_bit_cast(bf16x8_t, hv), alo = __builtin_bit_cast(bf16x8_t, lv);
                        if (rg == 0) { acc0 = __builtin_amdgcn_mfma_f32_32x32x16_bf16(wh, ahi, acc0, 0, 0, 0); acc0 = __builtin_amdgcn_mfma_f32_32x32x16_bf16(wl, ahi, acc0, 0, 0, 0); acc0 = __builtin_amdgcn_mfma_f32_32x32x16_bf16(wh, alo, acc0, 0, 0, 0); }
                        else         { acc1 = __builtin_amdgcn_mfma_f32_32x32x16_bf16(wh, ahi, acc1, 0, 0, 0); acc1 = __builtin_amdgcn_mfma_f32_32x32x16_bf16(wl, ahi, acc1, 0, 0, 0); acc1 = __builtin_amdgcn_mfma_f32_32x32x16_bf16(wh, alo, acc1, 0, 0, 0); } } }
#pragma unroll
                  for (int q = 0; q < 16; ++q) { const int e = (q & 3) + 8 * (q >> 2) + 4 * kh;
                      sm[5120 + ((wave * 2 + 0) * 32 + e) * 32 + r] = acc0[q]; sm[5120 + ((wave * 2 + 1) * 32 + e) * 32 + r] = acc1[q]; } }
                __syncthreads();
                { const int tk6 = tid & 63, eq = tid >> 6, rg = tk6 >> 5, tk = tk6 & 31;
#pragma unroll
                  for (int i = 0; i < 4; ++i) { const int e = eq * 4 + i; float s = 0.f;
#pragma unroll
                      for (int w = 0; w < 8; ++w) s += sm[5120 + ((w * 2 + rg) * 32 + e) * 32 + tk];
                      sm[5120 + 16384 + tk6 * 33 + e] = 1.f / (1.f + __expf(-s)); } }
                __syncthreads();
                if (tid < 64) { const int t = t0 + tid;
                    float lg[32];
#pragma unroll
                    for (int e = 0; e < 32; ++e) lg[e] = sm[5120 + 16384 + tid * 33 + e];
                    int grp = 0; float best = -INFINITY;
#pragma unroll
                    for (int gq = 0; gq < 4; ++gq) { float m1 = -INFINITY, m2 = -INFINITY;
#pragma unroll
                        for (int i = 0; i < 8; ++i) { const float b = lg[gq * 8 + i] + sm[4160 + gq * 8 + i]; if (b > m1) { m2 = m1; m1 = b; } else if (b > m2) m2 = b; }
                        const float sgs = m1 + m2; if (sgs > best) { best = sgs; grp = gq; } }
                    float m1 = -INFINITY, m2 = -INFINITY, s1 = 0.f, s2 = 0.f; int i1 = 0, i2 = 0;
#pragma unroll
                    for (int e = 0; e < 32; ++e) { const bool ing = (e >> 3) == grp; const float b = lg[e] + sm[4160 + e];
                        if (ing && b > m1) { m2 = m1; i2 = i1; s2 = s1; m1 = b; i1 = e; s1 = lg[e]; } else if (ing && b > m2) { m2 = b; i2 = e; s2 = lg[e]; } }
                    const float inv = 1.f / (s1 + s2);
                    const unsigned p1 = atomicAdd(CNT + i1, 1u), p2 = atomicAdd(CNT + i2, 1u);
                    TOKIDX[(size_t)i1 * ECAP + p1] = t; TOKIDX[(size_t)i2 * ECAP + p2] = t; WTS[(size_t)i1 * ECAP + p1] = s1 * inv; WTS[(size_t)i2 * ECAP + p2] = s2 * inv;
                    *(int4*)(TE + 4 * t) = make_int4(i1, (int)p1, i2, (int)p2);
                }
            }
            if (BOTH(pb + 12)) GRID_BAR();
        }
        if (IN(pb + 13)) {
            PH_IDS(); ArgsP ap = AP(); unsigned char* ws = ap->ws;
            LOAD_MOETAB((unsigned*)(CTLP(ws) + CW_CNT) + l * 32, 4);
            pg8::Gemm g{(const bf16*)(ws + WS_H), (const bf16*)(ws + WS_WGUT), 0, 0, D_}; MoeOrder<true> So{moetab, 4, G, bid, 4, l * 32 * 4, (const int*)(ws + WS_TOKIDX)};
            EpiGateUp E{(bf16*)(ws + WS_HACT)};
            pg8::gemm_phase<EpiGateUp, MoeOrder<true>, true, true>(lds, g, So, E);
            if (BOTH(pb + 13)) GRID_BAR();
        }
        if (IN(pb + 14)) {
            PH_IDS(); ArgsP ap = AP(); unsigned char* ws = ap->ws;
            LOAD_MOETAB((unsigned*)(CTLP(ws) + CW_CNT) + l * 32, 8);
            pg8::Gemm g{(const bf16*)(ws + WS_HACT), (const bf16*)(ws + WS_WDT), 0, 0, DEXP}; MoeOrder<false> So{moetab, 8, G, bid, 8, l * 32 * 8, nullptr};
            EpiDown E{(bf16*)(ws + WS_Y), (const float*)(ws + WS_WTS), moetab};
            pg8::gemm_phase<EpiDown, MoeOrder<false>, true, true>(lds, g, So, E);
            if (BOTH(pb + 14)) GRID_BAR();
        }
    }
    if (IN(NPH - 1)) {
        PH_IDS(); ArgsP ap = AP(); unsigned char* ws = ap->ws;
        float* X = ap->out; const bf16* Y = (const bf16*)(ws + WS_Y); const int* TE = (const int*)(ws + WS_TE);
        LOAD_MOETAB((unsigned*)(CTLP(ws) + CW_CNT) + 32, 1);
        const bool tmo_set = (MK_N_LAUNCHES == 1) && (__hip_atomic_load((unsigned*)(CTLP(ws) + CW_BAR) + XB_TMO, RLX_AGENT) != 0u);
        { const float* g_final = ap->in[17]; const float* MOD = (const float*)(CTLP(ws) + CW_MOD);
          for (int k = tid; k < D_; k += NTHR) { sm[k] = g_final[k]; sm[2048 + k] = MOD[12288 + 10240 + k]; } }
        __syncthreads();
        for (int t = gw; t < S_; t += NGW) {
            f32x4 v[8]; float ss = 0.f;
            const int4 te = *(const int4*)(TE + 4 * t);
            const bf16* y0 = Y + (size_t)(moetab[65 + te.x] + te.y) * D_; const bf16* y1 = Y + (size_t)(moetab[65 + te.z] + te.w) * D_;
#pragma unroll
            for (int j = 0; j < 8; ++j) { const int k = 256 * j + 4 * lane; const uint2 a = *(const uint2*)(y0 + k), b = *(const uint2*)(y1 + k);
                const f32x4 gt2 = *(const LAS f32x4*)(sm + 2048 + k);
                f32x4 ysum = (f32x4){bflo(a.x) + bflo(b.x), bfhi(a.x) + bfhi(b.x), bflo(a.y) + bflo(b.y), bfhi(a.y) + bfhi(b.y)};
                v[j] = *(const f32x4*)(X + (size_t)t * D_ + k) + gt2 * ysum;
                ss += (v[j][0] * v[j][0] + v[j][1] * v[j][1]) + (v[j][2] * v[j][2] + v[j][3] * v[j][3]); }
            const float rstd = (tmo_set ? __builtin_nanf("") : 1.f) / sqrtf(wave_sum(ss) * (1.f / D_) + RMS_EPS);
#pragma unroll
            for (int j = 0; j < 8; ++j) { const int k = 256 * j + 4 * lane; *(f32x4*)(X + (size_t)t * D_ + k) = v[j] * rstd * *(const LAS f32x4*)(sm + k); }
        }
    }
#undef IN
#undef BOTH
#undef GRID_BAR
#undef LOAD_MOETAB
#undef AP
#undef CTLP
#undef PH_IDS
}

extern "C" void kernel_launch(void* const* d_in, const int* in_sizes, int n_in, void* d_out, int out_size, void* d_ws, size_t ws_size, hipStream_t stream) {
    static int grid = 0;
    if (grid == 0) {
        if (n_in != 18 || out_size != S_ * D_ || ws_size < WS_END) { fprintf(stderr, "kernel_launch: unexpected shapes (n_in %d out %d ws %zu)\n", n_in, out_size, ws_size); grid = -1; return; }
        int dev = 0, cus = 0, per_cu = 0;
        if (hipGetDevice(&dev) != hipSuccess || hipDeviceGetAttribute(&cus, hipDeviceAttributeMultiprocessorCount, dev) != hipSuccess) { grid = -1; return; }
        if (hipFuncSetAttribute((const void*)mk_fwd, hipFuncAttributeMaxDynamicSharedMemorySize, LDS_BYTES) != hipSuccess) { fprintf(stderr, "kernel_launch: hipFuncSetAttribute failed\n"); grid = -1; return; }
        if (hipOccupancyMaxActiveBlocksPerMultiprocessor(&per_cu, (const void*)mk_fwd, NTHR, LDS_BYTES) != hipSuccess || per_cu < 1) { fprintf(stderr, "kernel_launch: occupancy query says %d\n", per_cu); }
        (void)hipGetLastError();
        grid = cus;
    }
    if (grid < 0) return;
    if (hipMemsetAsync((char*)d_ws + WS_CTL, 0, CTL_ZERO_BYTES, stream) != hipSuccess) return;
    Args a{};
    for (int i = 0; i < 18; ++i) a.in[i] = (const float*)d_in[i];
    a.out = (float*)d_out; a.ws = (unsigned char*)d_ws; a.pad = 0;
    if (MK_N_LAUNCHES == 1) {
        a.ph_lo = 0; a.ph_hi = NPH; a.li = 0;
        hipLaunchKernelGGL(mk_fwd, dim3(grid), dim3(NTHR), LDS_BYTES, stream, a);
    } else {
        for (int p = 0; p < NPH; ++p) { a.ph_lo = p; a.ph_hi = p + 1; a.li = p; hipLaunchKernelGGL(mk_fwd, dim3(grid), dim3(NTHR), LDS_BYTES, stream, a); }
    }
}
```

```cpp
#include <hip/hip_runtime.h>
#include <cstdio>
#include <cstdint>


#define WIDTAB_OFF (131072 + 1024)
__device__ __forceinline__ int wg_tid(const __attribute__((address_space(3))) int* widtab) {
    unsigned hw; asm volatile("s_getreg_b32 %0, hwreg(HW_REG_HW_ID, 0, 6)" : "=s"(hw));
    int lane; asm volatile("v_mbcnt_lo_u32_b32 %0, -1, 0\n\tv_mbcnt_hi_u32_b32 %0, -1, %0" : "=v"(lane));
    return widtab[hw] * 64 + lane;
}

namespace pg8 {
#define PG8_LAS __attribute__((address_space(3)))
typedef unsigned short bf16_t;
typedef short bf16x8 __attribute__((ext_vector_type(8)));
typedef float f32x4 __attribute__((ext_vector_type(4)));
typedef unsigned u32x4 __attribute__((ext_vector_type(4)));
constexpr int BM = 256, BK = 64, HALF = 128, HTB = HALF * BK * 2, STAGE_BYTES = 8 * HTB, NXCD = 8, WGM = 8;

__host__ __device__ __forceinline__ int lds_byte(int r, int c) { const int st = (r >> 4) * 2 + (c >> 5), rr = r & 15, cc = c & 31, ob = rr * 64 + cc * 2; return st * 1024 + (ob ^ (((ob >> 9) & 1) << 5)); }
__host__ __device__ __forceinline__ void stage_rc(int b, int& R, int& C) { const int st = b / 1024, sb = b % 1024, swz = sb ^ (((sb >> 9) & 1) << 5); R = (st >> 1) * 16 + swz / 64; C = (st & 1) * 32 + (swz % 64) / 2; }
__host__ __device__ __forceinline__ int perm32(int rho) { const int n = rho >> 4, i = rho & 15; return 8 * (i >> 2) + 4 * n + (i & 3); }

struct Unit { int pm, pn, e, mt, pnl; };
struct Gemm { const bf16_t* A; const bf16_t* Bt; int M, N, K; };

struct StaticOrder {
    static constexpr bool GATHER = false;
    int nM, nN, nwg, G, c;
    __host__ __device__ void init(int M, int N, int G_, int c_) { nM = M / BM; nN = N / BM; nwg = nM * nN; G = G_; c = c_; }
    __host__ __device__ bool next(int i, Unit& u) const {
        const long L = (long)i * G + c; if (L >= nwg) return false;
        int wgid = (int)L; { const int q = nwg / NXCD, r = nwg % NXCD, xcd = wgid % NXCD, off = wgid / NXCD; wgid = (xcd < r ? xcd * (q + 1) : r * (q + 1) + (xcd - r) * q) + off; }
        const int nig = WGM * nN, gid = wgid / nig, fm = gid * WGM, gsz = (nM - fm) < WGM ? (nM - fm) : WGM;
        u.pm = fm + ((wgid % nig) % gsz); u.pn = (wgid % nig) / gsz; u.e = 0; u.mt = 0; u.pnl = u.pn; return true;
    }
    __device__ __forceinline__ void a_offs(const Unit&, int, int, int, int, int, unsigned (&)[2][2]) const {}
    __device__ __forceinline__ void a_ready(const Unit&) const {}
    __device__ __forceinline__ void done(const Unit&) const {}
};

__device__ __forceinline__ unsigned cvt_pk_bf16(float lo, float hi) { unsigned r; asm volatile("v_cvt_pk_bf16_f32 %0, %1, %2" : "=v"(r) : "v"(lo), "v"(hi)); return r; }

template <class Epi, class Sched, bool ALIGN_EPI = false, bool SP2 = false>
__device__ __forceinline__ void gemm_phase(PG8_LAS unsigned char* lds, const Gemm g, const Sched& S, const Epi& E) {
    const int tid_ = wg_tid((const PG8_LAS int*)(lds + WIDTAB_OFF));
    const int tid = tid_, wid = __builtin_amdgcn_readfirstlane(tid >> 6), lane = tid & 63, wr = wid >> 2, wc = wid & 3, fr = lane & 15, fq = lane >> 4;
    const int K = g.K, nt = K / BK;
    unsigned voffA[2], voffB[2]; int RR[2], CC[2];
#pragma unroll
    for (int i = 0; i < 2; ++i) { int R, C; stage_rc(tid * 16 + i * 8192, R, C); const int Rb = Epi::PERM ? ((R & ~31) + perm32(R & 31)) : R;
        RR[i] = R; CC[i] = C; voffA[i] = (unsigned)(R * K + C) * 2u; voffB[i] = (unsigned)(Rb * K + C) * 2u; }
    const size_t kstep = (size_t)(BK * 2);
    const size_t hstep = (size_t)HALF * K * 2;
    const size_t tstep = 2 * hstep;
    const unsigned ldsw = (unsigned)wid * 1024u;
    const int aoff = lds_byte(wr * 64 + fr, fq * 8), boff = lds_byte(wc * 32 + fr, fq * 8);
    const char* gA = (const char*)g.A;
    unsigned aoC[2][2] = {{0u, 0u}, {0u, 0u}}, aoN[2][2] = {{0u, 0u}, {0u, 0u}};
#define PG8_SA(b, h) (((b) * 2 + (h)) * HTB)
#define PG8_SB(b, h) ((4 + (b) * 2 + (h)) * HTB)
#define PG8_STAGE(bufoff, gbase, voff) do { _Pragma("unroll") for (int _i = 0; _i < 2; ++_i) \
        __builtin_amdgcn_global_load_lds((const unsigned*)((const char*)(gbase) + (voff)[_i]), (PG8_LAS unsigned*)(lds + (bufoff) + ldsw + _i * 8192), 16, 0, 0); } while (0)
#define PG8_STAGE_A(bufoff, h, PN, KO) do { if constexpr (Sched::GATHER) { _Pragma("unroll") for (int _i = 0; _i < 2; ++_i) \
        __builtin_amdgcn_global_load_lds((const unsigned*)(gA + aoC[h][_i] + (KO)), (PG8_LAS unsigned*)(lds + (bufoff) + ldsw + _i * 8192), 16, 0, 0); } \
        else { PG8_STAGE(bufoff, (PN) + (h) * hstep, voffA); } } while (0)
#define PG8_LDA(dst, b, h) do { _Pragma("unroll") for (int m = 0; m < 4; ++m) _Pragma("unroll") for (int k = 0; k < 2; ++k) dst[m][k] = *(const PG8_LAS bf16x8*)(lds + PG8_SA(b, h) + aoff + m * 2048 + k * 1024); } while (0)
#define PG8_LDB(dst, b, h) do { _Pragma("unroll") for (int n = 0; n < 2; ++n) _Pragma("unroll") for (int k = 0; k < 2; ++k) dst[n][k] = *(const PG8_LAS bf16x8*)(lds + PG8_SB(b, h) + boff + n * 2048 + k * 1024); } while (0)
#define PG8_MMA(ai, bj, At, Bt) do { __builtin_amdgcn_s_setprio(1); _Pragma("unroll") for (int m = 0; m < 4; ++m) _Pragma("unroll") for (int n = 0; n < 2; ++n) _Pragma("unroll") for (int k = 0; k < 2; ++k) \
        acc[ai][bj][m][n] = __builtin_amdgcn_mfma_f32_16x16x32_bf16(Bt[n][k], At[m][k], acc[ai][bj][m][n], 0, 0, 0); __builtin_amdgcn_s_setprio(0); } while (0)
#define PG8_WAIT_V(n) asm volatile("s_waitcnt vmcnt(" #n ")" ::: "memory")
#define PG8_WAIT_L(n) asm volatile("s_waitcnt lgkmcnt(" #n ")" ::: "memory")
#define PG8_BAR __builtin_amdgcn_s_barrier()
#define PG8_SCHED __builtin_amdgcn_sched_barrier(0)
    Unit cur, nxt; int ui = 0;
    if (!S.next(0, cur)) return;
    f32x4 acc[2][2][4][2];
#pragma unroll
    for (int a = 0; a < 2; ++a)
#pragma unroll
        for (int b = 0; b < 2; ++b)
#pragma unroll
            for (int m = 0; m < 4; ++m)
#pragma unroll
                for (int n = 0; n < 2; ++n) acc[a][b][m][n] = (f32x4){0.f, 0.f, 0.f, 0.f};
    bf16x8 At[4][2], B0[2][2], B1[2][2];
    const char* cA = (const char*)g.A + (size_t)cur.pm * tstep; const char* cB = (const char*)g.Bt + (size_t)cur.pn * tstep;
    if constexpr (Sched::GATHER) S.a_offs(cur, RR[0], RR[1], CC[0], CC[1], K, aoC);
    S.a_ready(cur);
    if constexpr (SP2) {
        PG8_STAGE(PG8_SB(0, 0), cB, voffB); PG8_STAGE(PG8_SB(0, 1), cB + hstep, voffB); PG8_STAGE_A(PG8_SA(0, 0), 0, cA, 0); PG8_STAGE_A(PG8_SA(0, 1), 1, cA, 0);
        if (wr == 1) PG8_BAR;
        PG8_WAIT_V(2); PG8_BAR;
        PG8_STAGE(PG8_SB(1, 0), cB + kstep, voffB); PG8_STAGE_A(PG8_SA(1, 0), 0, cA + kstep, kstep); PG8_STAGE(PG8_SB(1, 1), cB + hstep + kstep, voffB);
        PG8_WAIT_V(6); PG8_BAR;
    } else {
        PG8_STAGE(PG8_SB(0, 0), cB, voffB); PG8_STAGE_A(PG8_SA(0, 0), 0, cA, 0); PG8_STAGE(PG8_SB(0, 1), cB + hstep, voffB); PG8_STAGE_A(PG8_SA(0, 1), 1, cA, 0);
        if (wr == 1) PG8_BAR;
        PG8_WAIT_V(4); PG8_BAR;
        PG8_STAGE(PG8_SB(1, 0), cB + kstep, voffB); PG8_STAGE_A(PG8_SA(1, 0), 0, cA + kstep, kstep); PG8_STAGE(PG8_SB(1, 1), cB + hstep + kstep, voffB);
        PG8_WAIT_V(6); PG8_BAR;
    }
    for (;;) {
        const bool has_next = S.next(ui + 1, nxt);
        const char* nA = has_next ? (const char*)g.A + (size_t)nxt.pm * tstep : cA; const char* nB = has_next ? (const char*)g.Bt + (size_t)nxt.pn * tstep : cB;
        if constexpr (Sched::GATHER) {
            if (has_next) S.a_offs(nxt, RR[0], RR[1], CC[0], CC[1], K, aoN);
            else {
#pragma unroll
                for (int h = 0; h < 2; ++h)
#pragma unroll
                    for (int i = 0; i < 2; ++i) aoN[h][i] = aoC[h][i]; }
        }
        for (int t = 0; t < nt; t += 2) {
            const bool last = (t == nt - 2);
            const char* a1 = cA + (size_t)(t + 1) * kstep;
            const char* a2 = last ? nA : cA + (size_t)(t + 2) * kstep; const char* b2 = last ? nB : cB + (size_t)(t + 2) * kstep;
            const char* a3 = a2 + kstep; const char* b3 = b2 + kstep;
            const size_t k1 = (size_t)(t + 1) * kstep, k2 = last ? (size_t)0 : (size_t)(t + 2) * kstep, k3 = k2 + kstep;
            if (last && has_next) S.a_ready(nxt);
            if constexpr (SP2) {
            PG8_LDB(B0, 0, 0); PG8_LDB(B1, 0, 1); PG8_SCHED; PG8_LDA(At, 0, 0); PG8_STAGE_A(PG8_SA(1, 1), 1, a1, k1);
            if constexpr (Sched::GATHER) { if (last) {
#pragma unroll
                for (int h = 0; h < 2; ++h)
#pragma unroll
                    for (int i = 0; i < 2; ++i) aoC[h][i] = aoN[h][i]; } }
            PG8_WAIT_V(8); PG8_WAIT_L(0); PG8_BAR; PG8_MMA(0, 0, At, B0); PG8_MMA(0, 1, At, B1); PG8_BAR; PG8_SCHED;
            PG8_LDA(At, 0, 1); PG8_STAGE(PG8_SB(0, 0), b2, voffB); PG8_STAGE(PG8_SB(0, 1), b2 + hstep, voffB); PG8_STAGE_A(PG8_SA(0, 0), 0, a2, k2);
            PG8_WAIT_V(8); PG8_WAIT_L(0); PG8_BAR; PG8_MMA(1, 0, At, B0); PG8_MMA(1, 1, At, B1); PG8_BAR; PG8_SCHED;
            PG8_LDB(B0, 1, 0); PG8_LDB(B1, 1, 1); PG8_SCHED; PG8_LDA(At, 1, 0); PG8_STAGE_A(PG8_SA(0, 1), 1, a2, k2);
            PG8_WAIT_V(8); PG8_WAIT_L(0); PG8_BAR; PG8_MMA(0, 0, At, B0); PG8_MMA(0, 1, At, B1); PG8_BAR; PG8_SCHED;
            PG8_LDA(At, 1, 1); PG8_STAGE(PG8_SB(1, 0), b3, voffB); PG8_STAGE(PG8_SB(1, 1), b3 + hstep, voffB); PG8_STAGE_A(PG8_SA(1, 0), 0, a3, k3);
            PG8_WAIT_V(8); PG8_WAIT_L(0); PG8_BAR; PG8_MMA(1, 0, At, B0); PG8_MMA(1, 1, At, B1); PG8_BAR; PG8_SCHED;
            } else {
            PG8_LDB(B0, 0, 0); PG8_SCHED; PG8_LDA(At, 0, 0); PG8_STAGE_A(PG8_SA(1, 1), 1, a1, k1);
            if constexpr (Sched::GATHER) { if (last) {
#pragma unroll
                for (int h = 0; h < 2; ++h)
#pragma unroll
                    for (int i = 0; i < 2; ++i) aoC[h][i] = aoN[h][i]; } }
            PG8_WAIT_L(8); PG8_BAR; PG8_WAIT_L(0); PG8_MMA(0, 0, At, B0); PG8_BAR; PG8_SCHED;
            PG8_LDB(B1, 0, 1); PG8_STAGE(PG8_SB(0, 0), b2, voffB);
            PG8_BAR; PG8_WAIT_L(0); PG8_MMA(0, 1, At, B1); PG8_BAR;
            PG8_LDA(At, 0, 1); PG8_STAGE_A(PG8_SA(0, 0), 0, a2, k2);
            PG8_BAR; PG8_WAIT_L(0); PG8_MMA(1, 0, At, B0); PG8_BAR; PG8_SCHED;
            PG8_STAGE(PG8_SB(0, 1), b2 + hstep, voffB);
            PG8_WAIT_V(6); PG8_BAR; PG8_MMA(1, 1, At, B1); PG8_BAR;
            PG8_LDB(B0, 1, 0); PG8_SCHED; PG8_LDA(At, 1, 0); PG8_STAGE_A(PG8_SA(0, 1), 1, a2, k2);
            PG8_WAIT_L(8); PG8_BAR; PG8_WAIT_L(0); PG8_MMA(0, 0, At, B0); PG8_BAR; PG8_SCHED;
            PG8_LDB(B1, 1, 1); PG8_STAGE(PG8_SB(1, 0), b3, voffB);
            PG8_BAR; PG8_WAIT_L(0); PG8_MMA(0, 1, At, B1); PG8_BAR;
            PG8_LDA(At, 1, 1); PG8_STAGE_A(PG8_SA(1, 0), 0, a3, k3);
            PG8_BAR; PG8_WAIT_L(0); PG8_MMA(1, 0, At, B0); PG8_BAR; PG8_SCHED;
            PG8_STAGE(PG8_SB(1, 1), b3 + hstep, voffB);
            PG8_WAIT_V(6); PG8_BAR; PG8_MMA(1, 1, At, B1); PG8_BAR;
            }
        }
        if constexpr (ALIGN_EPI) { if (wr == 0) PG8_BAR; }
        E(acc, cur, wr, wc, fr, fq); S.done(cur);
        if (!has_next) break;
#pragma unroll
        for (int a = 0; a < 2; ++a)
#pragma unroll
            for (int b = 0; b < 2; ++b)
#pragma unroll
                for (int m = 0; m < 4; ++m)
#pragma unroll
                    for (int n = 0; n < 2; ++n) acc[a][b][m][n] = (f32x4){0.f, 0.f, 0.f, 0.f};
        cur = nxt; cA = nA; cB = nB; ++ui;
        if constexpr (ALIGN_EPI) { if (wr == 1) PG8_BAR; }
    }
    PG8_WAIT_V(0);
    if constexpr (!ALIGN_EPI) { if (wr == 0) PG8_BAR; }
    PG8_BAR;
#undef PG8_SA
#undef PG8_SB
#undef PG8_STAGE
#undef PG8_STAGE_A
#undef PG8_LDA
#undef PG8_LDB
#undef PG8_MMA
#undef PG8_WAIT_V
#undef PG8_WAIT_L
#undef PG8_BAR
#undef PG8_SCHED
}
}

#ifndef MK_N_LAUNCHES
#define MK_N_LAUNCHES 1
#endif
constexpr int NWAVES = 8, NTHR = 512;
constexpr int S_ = 16384, D_ = 2048, DEPTH = 2, HD = 128;
constexpr int IN_W = 5656, NIN = 5888;
constexpr int NC = 1023;
constexpr int NEXP = 32, DEXP = 512, ECAP = 16384, NSLOT = 40960;
constexpr float RMS_EPS = 1e-6f;
constexpr float ATT_SCALE = 0.08838834764831845f;
constexpr int NPL = 13, NPH = 2 + 2 * NPL;

constexpr size_t MiB = 1u << 20;
constexpr size_t WS_CTL = 0, CTL_ZERO_BYTES = 1 * MiB;
constexpr size_t WS_ROPE = 1 * MiB, WS_WINT = 9 * MiB, WS_WOUTT = 55 * MiB, WS_WGUT = 71 * MiB, WS_WDT = 327 * MiB, WS_WC1T = 455 * MiB;
constexpr size_t WS_H = 463 * MiB, WS_QN = 527 * MiB, WS_QM = 559 * MiB, WS_KM = 591 * MiB, WS_VM = 623 * MiB;
constexpr size_t WS_KC = 655 * MiB, WS_VC = 663 * MiB, WS_KS = 671 * MiB, WS_VS = 679 * MiB, WS_KW = 687 * MiB, WS_VW = 695 * MiB;
constexpr size_t WS_GATES = 703 * MiB, WS_UL = 705 * MiB, WS_KCMP = 713 * MiB, WS_VCMP = 713 * MiB + 512 * 1024, WS_KMEAN = 714 * MiB;
constexpr size_t WS_OMIX = 715 * MiB, WS_OCMP = 779 * MiB, WS_OWIN = 811 * MiB, WS_SEL = 843 * MiB, WS_TE = 845 * MiB, WS_TOKIDX = 846 * MiB, WS_WTS = 848 * MiB;
constexpr size_t WS_HACT = 850 * MiB, WS_Y = 890 * MiB;
constexpr size_t WS_WRT = 714 * MiB + 256 * 1024;
constexpr size_t WS_IMP = WS_H + 32 * MiB;
constexpr size_t WS_NLIST = WS_H, WS_PSLC = 850 * MiB, WS_LSEN = 1106 * MiB;
constexpr size_t WS_MLIST = 1050 * MiB, WS_PSEL = 1082 * MiB, WS_POWN = 1178 * MiB, WS_LSES = 1210 * MiB, WS_LSEO = 1211 * MiB + 512 * 1024, WS_END = 1212 * MiB;
constexpr int CW_TMO = 0, CW_BAR = 4096, CW_CNT = 8192, CW_MCNT = 8704, CW_NCNT = 9728, CW_MOD = 16384, CW_B1E = 40960;

constexpr int RING_BYTES = 131072, LDSCTL_OFF = RING_BYTES, MISC_OFF = LDSCTL_OFF + 320, MOETAB_OFF = LDSCTL_OFF + 512, LDS_BYTES = 147456;

#define GAS __attribute__((address_space(1)))
#define LAS __attribute__((address_space(3)))
typedef unsigned short bf16;
typedef unsigned v4u __attribute__((ext_vector_type(4)));
typedef float f32x4 __attribute__((ext_vector_type(4)));
typedef float f32x2 __attribute__((ext_vector_type(2)));
typedef GAS unsigned gu32;
#define RLX_AGENT __ATOMIC_RELAXED, __HIP_MEMORY_SCOPE_AGENT
#define LDS_WAIT() asm volatile("s_waitcnt lgkmcnt(0)" ::: "memory")
__device__ __forceinline__ unsigned f2bf(float f) { unsigned u = __builtin_bit_cast(unsigned, f); return (u + 0x7fffu + ((u >> 16) & 1u)) >> 16; }
__device__ __forceinline__ unsigned pk2(float lo, float hi) { return f2bf(lo) | (f2bf(hi) << 16); }
__device__ __forceinline__ float bf2f(unsigned b) { return __builtin_bit_cast(float, b << 16); }
__device__ __forceinline__ float bflo(unsigned w) { return __builtin_bit_cast(float, w << 16); }
__device__ __forceinline__ float bfhi(unsigned w) { return __builtin_bit_cast(float, w & 0xffff0000u); }

#define XB_TMO      128
#define XB_XCNT(j)  (256  + 64 * (j))
#define XB_XSUB(j)  (1280 + 64 * (j))
#define XB_XGEN(j)  (2304 + 64 * (j))
#define XB_TOP      3328
#define XB_TOPGEN   3392
#define XCD_BAR_WORDS 3456
#define XB_SPIN_CAP (1u << 20)
__device__ __forceinline__ unsigned xb_ld(unsigned* p)              { return __hip_atomic_load(p, __ATOMIC_RELAXED, __HIP_MEMORY_SCOPE_AGENT); }
__device__ __forceinline__ unsigned xb_add(unsigned* p, unsigned v) { return __hip_atomic_fetch_add(p, v, __ATOMIC_RELAXED, __HIP_MEMORY_SCOPE_AGENT); }
__device__ __forceinline__ unsigned xb_xcc_id() { return (unsigned)__builtin_amdgcn_s_getreg((3 << 11) | 20) & 0xFu; }
#define XB_SPIN(cond, bar) do { unsigned _sp = 0; while (cond) { __builtin_amdgcn_s_sleep(1); \
    if ((++_sp & 255u) == 0u) { if (xb_ld(&(bar)[XB_TMO])) break; if (_sp > XB_SPIN_CAP) { atomicAdd(&(bar)[XB_TMO], 1u); break; } } } } while (0)
struct XcdBarrier { unsigned* bar; unsigned x; volatile LAS unsigned* st; };
__device__ __forceinline__ XcdBarrier xcd_barrier_post(unsigned* bar, volatile LAS unsigned* st) {
    XcdBarrier b; b.bar = bar; b.x = xb_xcc_id(); b.st = st;
    if (threadIdx.x == 0) (void)xb_add(&bar[XB_XCNT(b.x)], 1u);
    return b;
}
__device__ __forceinline__ void xcd_barrier_complete(unsigned* bar, unsigned x, unsigned& nloc, unsigned& nx) {
    const unsigned G = gridDim.x * gridDim.y * gridDim.z;
    unsigned sum, cnt, mine, sp = 0u;
    for (;;) {
        sum = 0u; cnt = 0u; mine = 0u;
#pragma unroll
        for (unsigned j = 0; j < 16; ++j) { const unsigned c = xb_ld(&bar[XB_XCNT(j)]); sum += c; cnt += (c > 0u) ? 1u : 0u; mine = (j == x) ? c : mine; }
        if (sum == G) break;
        __builtin_amdgcn_s_sleep(1);
        if ((++sp & 255u) == 0u) { if (xb_ld(&bar[XB_TMO])) break; if (sp > XB_SPIN_CAP) { atomicAdd(&bar[XB_TMO], 1u); break; } }
    }
    nloc = mine > 0u ? mine : 1u; nx = cnt > 0u ? cnt : 1u;
}
__device__ __forceinline__ void xcd_barrier(const XcdBarrier& b, bool leader  ) {
    asm volatile("s_waitcnt vmcnt(0)" ::: "memory");
    __syncthreads();
    if (leader) {
        unsigned* bar = b.bar;
        __builtin_amdgcn_s_waitcnt(0);
        unsigned nloc = b.st[0], nx = b.st[1];
        if (nloc == 0u) { xcd_barrier_complete(bar, b.x, nloc, nx); b.st[0] = nloc; b.st[1] = nx; }
        const unsigned old = xb_add(&bar[XB_XSUB(b.x)], 1u);
        const unsigned gen = old / nloc;
        if (old + 1u == (gen + 1u) * nloc) {
            __builtin_amdgcn_fence(__ATOMIC_RELEASE, "agent");
            asm volatile("s_waitcnt vmcnt(0)" ::: "memory");
            const unsigned og = xb_add(&bar[XB_TOP], 1u);
            const unsigned tg = og / nx;
            if (og + 1u == (tg + 1u) * nx) xb_add(&bar[XB_TOPGEN], 1u);
            else XB_SPIN(xb_ld(&bar[XB_TOPGEN]) == tg, bar);
            __builtin_amdgcn_fence(__ATOMIC_ACQUIRE, "agent");
            xb_add(&bar[XB_XGEN(b.x)], 1u);
            asm volatile("s_waitcnt vmcnt(0)" ::: "memory");
        } else {
            XB_SPIN(xb_ld(&bar[XB_XGEN(b.x)]) == gen, bar);
            __builtin_amdgcn_fence(__ATOMIC_ACQUIRE, "agent");
            asm volatile("s_waitcnt vmcnt(0)" ::: "memory");
        }
    }
    __syncthreads();
}

__device__ __forceinline__ float lane_get(float v, int src) { return __builtin_bit_cast(float, __builtin_amdgcn_ds_bpermute(src << 2, __builtin_bit_cast(int, v))); }
__device__ __forceinline__ int lane_geti(int v, int src) { return __builtin_amdgcn_ds_bpermute(src << 2, v); }
__device__ __forceinline__ float wave_sum(float v, int lane) {
#pragma unroll
    for (int o = 1; o < 64; o <<= 1) v += lane_get(v, lane ^ o);
    return v;
}
__device__ __forceinline__ int block_excl_scan(int v, LAS int* scr, int tid, int* tot) {
    const int lane = tid & 63, wv = tid >> 6; int s = v;
#pragma unroll
    for (int o = 1; o < 64; o <<= 1) { const int n = lane_geti(s, lane - o); if (lane >= o) s += n; }
    if (lane == 63) scr[wv] = s;
    __syncthreads();
    int off = 0, all = 0;
#pragma unroll
    for (int w = 0; w < 8; ++w) { const int x = scr[w]; all += x; off += (w < wv) ? x : 0; }
    *tot = all;
    __syncthreads();
    return off + s - v;
}

__device__ __forceinline__ float row_max16(float v) {
    v = fmaxf(v, __builtin_bit_cast(float, __builtin_amdgcn_update_dpp(0, __builtin_bit_cast(int, v), 0xB1, 0xF, 0xF, false)));
    v = fmaxf(v, __builtin_bit_cast(float, __builtin_amdgcn_update_dpp(0, __builtin_bit_cast(int, v), 0x4E, 0xF, 0xF, false)));
    v = fmaxf(v, __builtin_bit_cast(float, __builtin_amdgcn_update_dpp(0, __builtin_bit_cast(int, v), 0x124, 0xF, 0xF, false)));
    v = fmaxf(v, __builtin_bit_cast(float, __builtin_amdgcn_update_dpp(0, __builtin_bit_cast(int, v), 0x128, 0xF, 0xF, false)));
    return v;
}
__device__ __forceinline__ int row_min16(int v) {
    v = min(v, __builtin_amdgcn_update_dpp(0, v, 0xB1, 0xF, 0xF, false));
    v = min(v, __builtin_amdgcn_update_dpp(0, v, 0x4E, 0xF, 0xF, false));
    v = min(v, __builtin_amdgcn_update_dpp(0, v, 0x124, 0xF, 0xF, false));
    v = min(v, __builtin_amdgcn_update_dpp(0, v, 0x128, 0xF, 0xF, false));
    return v;
}
template <int NV>
__device__ __forceinline__ int row_pick(float (&v)[NV], int lam) {
    float m = v[0];
#pragma unroll
    for (int i = 1; i < NV; ++i) m = fmaxf(m, v[i]);
    m = row_max16(m);
    int idx = 1 << 20;
#pragma unroll
    for (int i = NV - 1; i >= 0; --i) idx = (v[i] == m) ? lam + 16 * i : idx;
    idx = row_min16(idx);
    if (m == -INFINITY) idx = -1;
#pragma unroll
    for (int i = 0; i < NV; ++i) v[i] = (lam + 16 * i == idx) ? -INFINITY : v[i];
    return idx;
}

__device__ __forceinline__ int il(int d) { return (d < 64) ? 2 * d : 2 * (d - 64) + 1; }
__device__ __forceinline__ int inproj_row(int s) {
    if (s < 1024) return (s & ~127) + il(s & 127);
    if (s < 1536) return s;
    if (s < 1792) return (s & ~127) + il(s & 127);
    if (s < 2048) return s;
    if (s < 2304) return (s & ~127) + il(s & 127);
    if (s < 2560) return s;
    if (s < 2584) return 5632 + (s - 2560);
    if (s < 3608) { const int r = s - 2584; return 2560 + (r & ~127) + il(r & 127); }
    if (s < 4632) { const int r = s - 3608; return 3584 + (r & ~127) + il(r & 127); }
    return 4608 + (s - 4632);
}
template <int MODE>
__device__ __forceinline__ void transpose_item(const float* W, int K, int N, bf16* WT, int dpitch, int row_off, LAS float* scr, int item, int lane) {
    const int nblk = (N + 31) / 32, kb = item / nblk, nb = item % nblk, k0 = 64 * kb, n0 = 32 * nb;
    const int nsrc = n0 + (lane & 31);
#pragma unroll 8
    for (int i = 0; i < 32; ++i) { const int kk = 2 * i + (lane >> 5); scr[kk * 33 + (lane & 31)] = (nsrc < N) ? __builtin_nontemporal_load(W + (size_t)(k0 + kk) * N + nsrc) : 0.f; }
    LDS_WAIT(); asm volatile("" ::: "memory");
    const int c = lane & 7;
#pragma unroll
    for (int j = 0; j < 4; ++j) { const int nl = (lane >> 3) + 8 * j, n = n0 + nl; const LAS float* s = scr + (8 * c) * 33 + nl;
        v4u o; o.x = pk2(s[0 * 33], s[1 * 33]); o.y = pk2(s[2 * 33], s[3 * 33]); o.z = pk2(s[4 * 33], s[5 * 33]); o.w = pk2(s[6 * 33], s[7 * 33]);
        if (n < N) { int dr;
            if (MODE == 0) dr = n; else if (MODE == 1) dr = inproj_row(n); else if (MODE == 2) dr = (n >> 7) * 256 + (n & 127); else dr = (n >> 7) * 256 + 128 + (n & 127);
            *(GAS v4u*)(WT + (size_t)(row_off + dr) * dpitch + k0 + 8 * c) = o; } }
    LDS_WAIT(); asm volatile("" ::: "memory");
}

using pg8::Unit;
struct EpiInProj {
    static constexpr bool PERM = true;
    bf16 *QN, *KC, *VC, *KS, *VS, *KW, *VW, *QM, *KM, *VM; float* GATES; const float* rope;
    __device__ __forceinline__ void operator()(const f32x4 (&acc)[2][2][4][2], const Unit& u, int wr, int wc, int fr, int fq) const {
        const int pn = u.pn, row0 = u.pm * 256 + wr * 64 + fr, c8 = wc * 32 + 8 * fq;
        if (pn == 22) {
            if (c8 < 24) {
#pragma unroll
                for (int ai = 0; ai < 2; ++ai)
#pragma unroll
                    for (int m = 0; m < 4; ++m) { const int row = row0 + ai * 128 + m * 16; float* gp = GATES + (size_t)row * 32 + c8;
                        f32x4 a = acc[ai][0][m][0], b = acc[ai][0][m][1], ga, gb;
#pragma unroll
                        for (int j = 0; j < 4; ++j) { ga[j] = 1.f / (1.f + __expf(-a[j])); gb[j] = 1.f / (1.f + __expf(-b[j])); }
                        *(f32x4*)gp = ga; *(f32x4*)(gp + 4) = gb; }
            }
            return;
        }
        bf16* base; int pitch; size_t bjs; bool rot;
        if (pn < 4)       { base = QN + pn * 256;        pitch = 1024; bjs = 128; rot = true; }
        else if (pn == 4) { base = KC;                   pitch = 128;  bjs = (size_t)S_ * 128; rot = false; }
        else if (pn == 5) { base = VC;                   pitch = 128;  bjs = (size_t)S_ * 128; rot = false; }
        else if (pn == 6) { base = KS;                   pitch = 256;  bjs = 128; rot = true; }
        else if (pn == 7) { base = VS;                   pitch = 256;  bjs = 128; rot = false; }
        else if (pn == 8) { base = KW;                   pitch = 256;  bjs = 128; rot = true; }
        else if (pn == 9) { base = VW;                   pitch = 256;  bjs = 128; rot = false; }
        else if (pn < 14) { base = QM + (pn - 10) * 256; pitch = 1024; bjs = 128; rot = true; }
        else if (pn < 18) { base = KM + (pn - 14) * 256; pitch = 1024; bjs = 128; rot = true; }
        else              { base = VM + (pn - 18) * 256; pitch = 1024; bjs = 128; rot = false; }
#pragma unroll
        for (int ai = 0; ai < 2; ++ai)
#pragma unroll
            for (int m = 0; m < 4; ++m) { const int row = row0 + ai * 128 + m * 16;
                f32x4 t0 = (f32x4){1.f, 0.f, 1.f, 0.f}, t1 = t0;
                if (rot) { const f32x4* tp = (const f32x4*)(rope + (size_t)row * 128 + (c8 >> 1) * 2); t0 = tp[0]; t1 = tp[1]; }
#pragma unroll
                for (int bj = 0; bj < 2; ++bj) { f32x4 v0 = acc[ai][bj][m][0], v1 = acc[ai][bj][m][1];
                    if (rot) { f32x4 w0, w1;
                        w0[0] = v0[0] * t0[0] - v0[1] * t0[1]; w0[1] = v0[1] * t0[0] + v0[0] * t0[1]; w0[2] = v0[2] * t0[2] - v0[3] * t0[3]; w0[3] = v0[3] * t0[2] + v0[2] * t0[3];
                        w1[0] = v1[0] * t1[0] - v1[1] * t1[1]; w1[1] = v1[1] * t1[0] + v1[0] * t1[1]; w1[2] = v1[2] * t1[2] - v1[3] * t1[3]; w1[3] = v1[3] * t1[2] + v1[2] * t1[3];
                        v0 = w0; v1 = w1; }
                    pg8::u32x4 w; w.x = pg8::cvt_pk_bf16(v0[0], v0[1]); w.y = pg8::cvt_pk_bf16(v0[2], v0[3]); w.z = pg8::cvt_pk_bf16(v1[0], v1[1]); w.w = pg8::cvt_pk_bf16(v1[2], v1[3]);
                    *(pg8::u32x4*)(base + (size_t)row * pitch + bj * bjs + c8) = w; } }
    }
};
struct EpiOutProj {
    static constexpr bool PERM = false;
    const float* xsrc; float* X; const float* gt;
    __device__ __forceinline__ void operator()(const f32x4 (&acc)[2][2][4][2], const Unit& u, int wr, int wc, int fr, int fq) const {
        const int row0 = u.pm * 256 + wr * 64 + fr, col0 = u.pnl * 256 + wc * 32 + 4 * fq;
        f32x4 gv[2][2];
#pragma unroll
        for (int bj = 0; bj < 2; ++bj)
#pragma unroll
            for (int n = 0; n < 2; ++n) gv[bj][n] = *(const f32x4*)(gt + col0 + bj * 128 + n * 16);
#pragma unroll
        for (int ai = 0; ai < 2; ++ai)
#pragma unroll
            for (int m = 0; m < 4; ++m) { const size_t ro = (size_t)(row0 + ai * 128 + m * 16) * D_ + col0;
#pragma unroll
                for (int bj = 0; bj < 2; ++bj)
#pragma unroll
                    for (int n = 0; n < 2; ++n) { const f32x4 xv = *(const f32x4*)(xsrc + ro + bj * 128 + n * 16); *(f32x4*)(X + ro + bj * 128 + n * 16) = xv + gv[bj][n] * acc[ai][bj][m][n]; } }
    }
};
struct EpiF32 {
    static constexpr bool PERM = false;
    float* C; int ldc;
    __device__ __forceinline__ void operator()(const f32x4 (&acc)[2][2][4][2], const Unit& u, int wr, int wc, int fr, int fq) const {
        const int row0 = u.pm * 256 + wr * 64 + fr, col0 = u.pnl * 256 + wc * 32 + 4 * fq;
#pragma unroll
        for (int ai = 0; ai < 2; ++ai)
#pragma unroll
            for (int m = 0; m < 4; ++m) { float* rowp = C + (size_t)(row0 + ai * 128 + m * 16) * ldc + col0;
#pragma unroll
                for (int bj = 0; bj < 2; ++bj)
#pragma unroll
                    for (int n = 0; n < 2; ++n) *(f32x4*)(rowp + bj * 128 + n * 16) = acc[ai][bj][m][n]; }
    }
};
struct EpiGateUp {
    static constexpr bool PERM = true;
    bf16* HACT;
    __device__ __forceinline__ void operator()(const f32x4 (&acc)[2][2][4][2], const Unit& u, int wr, int wc, int fr, int fq) const {
        const int row0 = u.pm * 256 + wr * 64 + fr, col0 = u.pnl * 128 + wc * 32 + 8 * fq;
#pragma unroll
        for (int ai = 0; ai < 2; ++ai)
#pragma unroll
            for (int m = 0; m < 4; ++m) { const int row = row0 + ai * 128 + m * 16; f32x4 h[2];
#pragma unroll
                for (int n = 0; n < 2; ++n)
#pragma unroll
                    for (int j = 0; j < 4; ++j) { const float gg = acc[ai][0][m][n][j], uu = acc[ai][1][m][n][j]; h[n][j] = gg / (1.f + __expf(-gg)) * uu; }
                pg8::u32x4 w; w.x = pg8::cvt_pk_bf16(h[0][0], h[0][1]); w.y = pg8::cvt_pk_bf16(h[0][2], h[0][3]); w.z = pg8::cvt_pk_bf16(h[1][0], h[1][1]); w.w = pg8::cvt_pk_bf16(h[1][2], h[1][3]);
                *(pg8::u32x4*)(HACT + (size_t)row * DEXP + col0) = w; }
    }
};
struct EpiDown {
    static constexpr bool PERM = true;
    bf16* Y; const float* WTS; const LAS int* tab;
    __device__ __forceinline__ void operator()(const f32x4 (&acc)[2][2][4][2], const Unit& u, int wr, int wc, int fr, int fq) const {
        const int rl0 = wr * 64 + fr, col0 = u.pnl * 256 + wc * 32 + 8 * fq, cnt = tab[u.e];
#pragma unroll
        for (int ai = 0; ai < 2; ++ai)
#pragma unroll
            for (int m = 0; m < 4; ++m) { const int rl = rl0 + ai * 128 + m * 16, pos = u.mt * 256 + rl;
                const float w = (pos < cnt) ? WTS[(size_t)u.e * ECAP + pos] : 0.f;
                bf16* rowp = Y + (size_t)(u.pm * 256 + rl) * D_ + col0;
#pragma unroll
                for (int bj = 0; bj < 2; ++bj) { const f32x4 v0 = acc[ai][bj][m][0] * w, v1 = acc[ai][bj][m][1] * w;
                    pg8::u32x4 o; o.x = pg8::cvt_pk_bf16(v0[0], v0[1]); o.y = pg8::cvt_pk_bf16(v0[2], v0[3]); o.z = pg8::cvt_pk_bf16(v1[0], v1[1]); o.w = pg8::cvt_pk_bf16(v1[2], v1[3]);
                    *(pg8::u32x4*)(rowp + bj * 128) = o; } }
    }
};

struct CompressOrder {
    static constexpr bool GATHER = false;
    int G, c;
    __device__ bool next(int i, Unit& u) const { const int L = i * G + c; if (L >= 32) return false; u.pm = L >> 1; u.pnl = L & 1; u.pn = (u.pm >= 8 ? 2 : 0) + u.pnl; u.e = 0; u.mt = 0; return true; }
    __device__ __forceinline__ void a_offs(const Unit&, int, int, int, int, int, unsigned (&)[2][2]) const {}
    __device__ __forceinline__ void a_ready(const Unit&) const {}
    __device__ __forceinline__ void done(const Unit&) const {}
};
template <bool GATHER_>
struct MoeOrder {
    static constexpr bool GATHER = GATHER_;
    const LAS int* tab; int NT, G, c, bt_per_e, bt_base; const int* tokidx;
    __device__ bool next(int i, Unit& u) const {
        const int L = i * G + c; if (L >= tab[64]) return false;
        int e = 0;
        for (int k = 1; k < NEXP; ++k) e += (L >= tab[32 + k]) ? 1 : 0;
        e = __builtin_amdgcn_readfirstlane(e);
        const int r = L - tab[32 + e];
        u.e = e; u.mt = r / NT; u.pnl = r % NT; u.pn = bt_base + e * bt_per_e + u.pnl; u.pm = (tab[65 + e] >> 8) + u.mt; return true;
    }
    __device__ __forceinline__ void a_offs(const Unit& u, int R0, int R1, int C0, int C1, int K, unsigned (&o)[2][2]) const {
        const int cnt = tab[u.e]; const int* tk = tokidx + (size_t)u.e * ECAP;
#pragma unroll
        for (int h = 0; h < 2; ++h) {
            int p0 = u.mt * 256 + h * 128 + R0, p1 = u.mt * 256 + h * 128 + R1; p0 = p0 < cnt ? p0 : cnt - 1; p1 = p1 < cnt ? p1 : cnt - 1;
            o[h][0] = ((unsigned)tk[p0] * (unsigned)K + (unsigned)C0) * 2u; o[h][1] = ((unsigned)tk[p1] * (unsigned)K + (unsigned)C1) * 2u; }
    }
    __device__ __forceinline__ void a_ready(const Unit&) const {}
    __device__ __forceinline__ void done(const Unit&) const {}
};

namespace att {
constexpr int D = 128, NW = 8, QBLK = 32, KVBLK = 64, QB = NW * QBLK;
constexpr int SHM_V = KVBLK * D * 2, SHM_K = KVBLK * D * 2;
constexpr int OFF_WS = 2 * SHM_V + 2 * SHM_K, OFF_OT = OFF_WS + NW * 64 * 4, LDS_BYTES = OFF_OT + NW * 32 * 4;
constexpr int OFF_ST = 73728, ST_ROW = 272, ST_WAVE = 16 * ST_ROW;
constexpr float SCALE = 0.08838834764831845f, THR = 8.f;
typedef short bf16x8 __attribute__((ext_vector_type(8)));
typedef short s16x4 __attribute__((ext_vector_type(4)));
typedef float f32x16 __attribute__((ext_vector_type(16)));
typedef float f32x4 __attribute__((ext_vector_type(4)));
typedef unsigned u32x4 __attribute__((ext_vector_type(4)));
typedef unsigned short bf16;
#define KSWZ(row, colB) ((row) * 256 + ((colB) ^ (((row) & 7) << 4)))
#define SBAR() __builtin_amdgcn_sched_barrier(0)
__device__ __forceinline__ int v_st(int k, int c) { const int kk = (k & ~0xC) | ((k & 4) << 1) | ((k & 8) >> 1); return ((kk >> 3) * 4 + (c >> 5)) * 512 + ((kk & 7) * 32 + (c & 31)) * 2; }
__device__ __forceinline__ int v_rd_base(int lane) { return ((lane & 3) << 3) | (((lane >> 2) & 3) << 6) | (((lane >> 4) & 1) << 5) | (((lane >> 5) & 1) << 8); }
constexpr int v_rd_off(int d0, int ks, int half) { return d0 * 512 + ks * 4096 + half * 2048; }
__device__ __forceinline__ int crow(int r, int hi) { return (r & 3) + 8 * (r >> 2) + 4 * hi; }
__device__ __forceinline__ unsigned cvtpk(float lo, float hi) { unsigned r; asm volatile("v_cvt_pk_bf16_f32 %0, %1, %2" : "=v"(r) : "v"(lo), "v"(hi)); return r; }
__device__ __forceinline__ bf16x8 load8(const bf16* p) { return *reinterpret_cast<const bf16x8*>(p); }
__device__ __forceinline__ void mask_tile(f32x16& p0, f32x16& p1, int dq, unsigned W) {
    const float NEG = -__builtin_inff();
#pragma unroll
    for (int r = 0; r < 16; ++r) {
        const int c = (r & 3) + 8 * (r >> 2);
        if ((unsigned)(dq - c) >= W) p0[r] = NEG;
        if ((unsigned)(dq - c - 32) >= W) p1[r] = NEG;
    }
}
__device__ __forceinline__ void partialSM(f32x16& p0, f32x16& p1, float& m_reg, float& mn, float& alpha) {
    float pmax = p0[0]; for (int r = 1; r < 16; ++r) pmax = fmaxf(pmax, p0[r]); for (int r = 0; r < 16; ++r) pmax = fmaxf(pmax, p1[r]);
    { auto rr = __builtin_amdgcn_permlane32_swap(__float_as_uint(pmax), __float_as_uint(pmax), false, false);
      pmax = fmaxf(__uint_as_float(rr[0]), __uint_as_float(rr[1])); }
    constexpr float C2 = 1.4426950408889634f * SCALE;
    if (__builtin_expect(__all((pmax - m_reg) * SCALE <= THR), 1)) { mn = m_reg; alpha = 1.f; }
    else { mn = fmaxf(m_reg, pmax); alpha = __builtin_amdgcn_exp2f((m_reg - mn) * C2); m_reg = mn; }
    const float mnL = -mn * C2;
    for (int r = 0; r < 16; ++r) p0[r] = fmaf(p0[r], C2, mnL); for (int r = 0; r < 16; ++r) p1[r] = fmaf(p1[r], C2, mnL);
    for (int r = 0; r < 16; ++r) p0[r] = __builtin_amdgcn_exp2f(p0[r]);
}
__device__ __forceinline__ void finishSM(f32x16& p0, f32x16& p1, float alpha, float& l_reg, bf16x8& pa0, bf16x8& pa1, bf16x8& pa2, bf16x8& pa3) {
    for (int r = 0; r < 16; ++r) p1[r] = __builtin_amdgcn_exp2f(p1[r]);
    float ps = 0; for (int r = 0; r < 16; ++r) ps += p0[r]; for (int r = 0; r < 16; ++r) ps += p1[r];
    { auto rr = __builtin_amdgcn_permlane32_swap(__float_as_uint(ps), __float_as_uint(ps), false, false);
      ps = __uint_as_float(rr[0]) + __uint_as_float(rr[1]); }
    l_reg = l_reg * alpha + ps;
#define PK4(P, B_, OUT) do { unsigned a0 = cvtpk(P[B_+0], P[B_+1]), a1 = cvtpk(P[B_+2], P[B_+3]);                          \
        unsigned b0 = cvtpk(P[B_+4], P[B_+5]), b1 = cvtpk(P[B_+6], P[B_+7]);                                             \
        auto r0 = __builtin_amdgcn_permlane32_swap(a0, b0, false, false); auto r1 = __builtin_amdgcn_permlane32_swap(a1, b1, false, false); \
        u32x4 w = {r0[0], r1[0], r0[1], r1[1]}; OUT = *reinterpret_cast<bf16x8*>(&w); } while (0)
    PK4(p0, 0, pa0); PK4(p0, 8, pa1); PK4(p1, 0, pa2); PK4(p1, 8, pa3);
#undef PK4
}
template <int KB, bool SK>
__device__ __forceinline__ void qkt(f32x16& p0, f32x16& p1, const char* K_lds, int r32, int hi, const bf16x8* qr, bool act) {
    if (SK && !act) { const float NEG = -__builtin_inff();
#pragma unroll
        for (int r = 0; r < 16; ++r) { p0[r] = NEG; p1[r] = NEG; } return; }
    p0 = f32x16{}; p1 = f32x16{};
    const char* kb[4];
#pragma unroll
    for (int dd = 0; dd < 4; ++dd) kb[dd] = K_lds + KB * SHM_K + KSWZ(r32, (dd * 16 + hi * 8) * 2);
#pragma unroll
    for (int d0 = 0; d0 < 8; ++d0) { const char* a = kb[d0 & 3] + (d0 >> 2) * 128;
        bf16x8 b0 = *reinterpret_cast<const bf16x8*>(a);
        bf16x8 b1 = *reinterpret_cast<const bf16x8*>(a + 32 * 256);
        p0 = __builtin_amdgcn_mfma_f32_32x32x16_bf16(b0, qr[d0], p0, 0, 0, 0);
        p1 = __builtin_amdgcn_mfma_f32_32x32x16_bf16(b1, qr[d0], p1, 0, 0, 0); }
}
template <int VB, bool SK>
__device__ __forceinline__ void pv_tile(f32x16* o, int vb0, bf16x8 pa0, bf16x8 pa1, bf16x8 pa2, bf16x8 pa3, bool act) {
    if (SK && !act) return;
#define TRRD(dst, off) asm volatile("ds_read_b64_tr_b16 %0, %1 offset:%2" : "=&v"(dst) : "v"(vb0), "i"(off) : "memory")
#define PV_D0(d0) do { s16x4 l0, l1, l2, l3, h0, h1, h2, h3; constexpr int b_ = VB * SHM_V + v_rd_off(d0, 0, 0); \
        TRRD(l0, b_); TRRD(h0, b_ + 2048); TRRD(l1, b_ + 4096); TRRD(h1, b_ + 6144); TRRD(l2, b_ + 8192); TRRD(h2, b_ + 10240); TRRD(l3, b_ + 12288); TRRD(h3, b_ + 14336); \
        asm volatile("s_waitcnt lgkmcnt(0)" ::: "memory"); SBAR();   \
        o[d0] = __builtin_amdgcn_mfma_f32_32x32x16_bf16(pa0, (bf16x8){l0[0], l0[1], l0[2], l0[3], h0[0], h0[1], h0[2], h0[3]}, o[d0], 0, 0, 0);   \
        o[d0] = __builtin_amdgcn_mfma_f32_32x32x16_bf16(pa1, (bf16x8){l1[0], l1[1], l1[2], l1[3], h1[0], h1[1], h1[2], h1[3]}, o[d0], 0, 0, 0);   \
        o[d0] = __builtin_amdgcn_mfma_f32_32x32x16_bf16(pa2, (bf16x8){l2[0], l2[1], l2[2], l2[3], h2[0], h2[1], h2[2], h2[3]}, o[d0], 0, 0, 0);   \
        o[d0] = __builtin_amdgcn_mfma_f32_32x32x16_bf16(pa3, (bf16x8){l3[0], l3[1], l3[2], l3[3], h3[0], h3[1], h3[2], h3[3]}, o[d0], 0, 0, 0); } while (0)
    PV_D0(0); PV_D0(1); PV_D0(2); PV_D0(3);
#undef PV_D0
#undef TRRD
}
struct Ref { const bf16* Q; const bf16* K; const bf16* V; bf16* O; const int* list; int kpitch, j_lo, j_hi, P0, W, a0, a1; };
struct Seam { bf16x8 qr[8]; bf16x8 st_v0, st_v1, st_k0, st_k1; };
#define ROW(p, kp, k0, rr) ((p) + (size_t)((k0) + (rr)) * (kp) + sc)
#define VMW() asm volatile("s_waitcnt vmcnt(0)" ::: "memory")
#define VMWN(n) asm volatile("s_waitcnt vmcnt(%0)" :: "i"(n) : "memory")
#define SLOAD_H(Kp, Vp, kp, k0) do { S.st_v0 = load8(ROW(Vp, kp, k0, sr)); S.st_v1 = load8(ROW(Vp, kp, k0, 32 + sr));              \
                         S.st_k0 = load8(ROW(Kp, kp, k0, sr)); S.st_k1 = load8(ROW(Kp, kp, k0, 32 + sr)); } while (0)
#define SWRITE_HK(bf) do { *(bf16x8*)(K_lds + (bf) * SHM_K + kws) = S.st_k0; *(bf16x8*)(K_lds + (bf) * SHM_K + kws + 32 * 256) = S.st_k1; } while (0)
#define SWRITE_HV(bf) do { *(bf16x8*)(V_lds + (bf) * SHM_V + vst0) = S.st_v0; *(bf16x8*)(V_lds + (bf) * SHM_V + vst1) = S.st_v1; } while (0)
#define SWRITE_H(bf) do { SWRITE_HV(bf); SWRITE_HK(bf); } while (0)
template <class RF>
__device__ __forceinline__ void prime(const Ref& cur, char* lds, Seam& S) {
    const int tid_ = wg_tid((const __attribute__((address_space(3))) int*)(uintptr_t)(unsigned)(uintptr_t)(lds + WIDTAB_OFF));
    const int tid = tid_, wid = __builtin_amdgcn_readfirstlane(tid >> 6), lane = tid & 63, r32 = lane & 31, hi = lane >> 5;
    const int sr = tid >> 4, sc = (tid & 15) * 8, kws = KSWZ(sr, sc * 2); char* K_lds = lds + 2 * SHM_V;
    const int kb0 = cur.j_lo * KVBLK;
    { const bf16* qrow = cur.Q + RF::q_off(cur, wid * QBLK + r32, RF::entry(cur, wid * QBLK + r32));
      for (int d0 = 0; d0 < 8; ++d0) S.qr[d0] = load8(qrow + d0 * 16 + hi * 8); }
    SLOAD_H(cur.K, cur.V, cur.kpitch, kb0); VMW(); SWRITE_HK(0);
    __syncthreads();
}
template <int MODE, bool WSKIP, class RF, bool O8 = false, bool ONE = false, bool NTS = false>
__device__ __forceinline__ void block(const Ref& cur, const Ref& nxt, float* LSE, char* lds, Seam& S, float* lse_lane = nullptr) {
    const int tid_ = wg_tid((const __attribute__((address_space(3))) int*)(uintptr_t)(unsigned)(uintptr_t)(lds + WIDTAB_OFF));
    const int tid = tid_, wid = __builtin_amdgcn_readfirstlane(tid >> 6), lane = tid & 63, r32 = lane & 31, hi = lane >> 5;
    const int j_lo = cur.j_lo, NT = cur.j_hi - cur.j_lo;
    const int kbn = nxt.j_lo * KVBLK;
    const int W = cur.W;
    const int qlo = cur.P0 + wid * QBLK;
    const int e_cur = RF::entry(cur, wid * QBLK + r32), e_nxt = RF::entry(nxt, wid * QBLK + r32);
    const int qm = (MODE == 2 ? RF::pos(cur, wid * QBLK + r32, e_cur) : qlo + r32) - 4 * hi;
    const unsigned Wm = (MODE == 2) ? (unsigned)RF::Wl(cur, wid * QBLK + r32) : (unsigned)W;
    char* V_lds = lds; char* K_lds = lds + 2 * SHM_V;
    float* ws = (float*)(lds + OFF_WS) + wid * 64; float* li_l = ws, * al_l = ws + 32; int* ot_l = (int*)(lds + OFF_OT) + wid * 32;
    float m_reg = -1e30f, l_reg = 0; f32x16 o[4] = {};
    const int sr = tid >> 4, sc = (tid & 15) * 8, vst0 = v_st(sr, sc), vst1 = v_st(32 + sr, sc), kws = KSWZ(sr, sc * 2);
    const int vb0 = (int)(uintptr_t)V_lds + v_rd_base(lane);
    const bf16* Kh = cur.K; const bf16* Vh = cur.V; const int kp = cur.kpitch;
#define RESC(a) do { if (__any((a) < 1.f)) { if (hi == 0) al_l[r32] = (a); asm volatile("s_waitcnt lgkmcnt(0)" ::: "memory");              \
                     for (int d_ = 0; d_ < 4; ++d_) for (int r = 0; r < 16; ++r) o[d_][r] *= al_l[crow(r, hi)]; } } while (0)
#define KBASE(t) ((j_lo + (t)) * KVBLK)
#define ACT(t) (MODE != 0 || (KBASE(t) <= qlo + QBLK - 1 && KBASE(t) + KVBLK - 1 >= qlo - W + 1))
#define MASKT(P0_, P1_, t) do { const int kb_ = KBASE(t); if (MODE == 2) mask_tile(P0_, P1_, qm - kb_, Wm); \
        else if (MODE == 0) { if ((!SK || ACT(t)) && (kb_ + KVBLK - 1 > qlo || kb_ <= qlo + QBLK - 1 - W)) mask_tile(P0_, P1_, qm - kb_, Wm); } } while (0)
    constexpr int NQL = 8;
    constexpr bool SK = WSKIP && MODE == 0;
#define SEAM_K0() do { VMWN(NQL); SWRITE_HK(0); SBAR(); } while (0)
    f32x16 pA0, pA1, pB0, pB1; float mnA, mnB, alA, alB; bf16x8 pa0, pa1, pa2, pa3;
    SWRITE_HV(0); SBAR();
    if constexpr (ONE) { SLOAD_H(nxt.K, nxt.V, nxt.kpitch, kbn); SBAR(); }
    if (NT > 1) { SLOAD_H(Kh, Vh, kp, KBASE(1)); }
    SBAR(); qkt<0, SK>(pA0, pA1, K_lds, r32, hi, S.qr, ACT(0));
    MASKT(pA0, pA1, 0); partialSM(pA0, pA1, m_reg, mnA, alA);
    if (NT > 1) { VMW(); SWRITE_H(1); }
    __syncthreads();
#define HALF_STEP(PX0, PX1, mnX, alX, PY0, PY1, alY, t, KB, VB, SB) do {                                                      \
        SBAR(); qkt<KB, SK>(PX0, PX1, K_lds, r32, hi, S.qr, ACT(t));                                             \
        finishSM(PY0, PY1, alY, l_reg, pa0, pa1, pa2, pa3); SBAR();                                                           \
        if ((t) + 1 < NT) { SLOAD_H(Kh, Vh, kp, KBASE((t) + 1)); SBAR(); }                                               \
        pv_tile<VB, SK>(o, vb0, pa0, pa1, pa2, pa3, ACT((t) - 1)); MASKT(PX0, PX1, (t)); partialSM(PX0, PX1, m_reg, mnX, alX);                                        \
        __syncthreads();                                                                                                      \
        if ((t) + 1 < NT) { VMW(); SWRITE_H(SB); }                                                                          \
        RESC(alX); __syncthreads(); } while (0)
    for (int t = 1; t + 1 < NT; t += 2) {
        HALF_STEP(pB0, pB1, mnB, alB, pA0, pA1, alA, t, 1, 0, 0);
        HALF_STEP(pA0, pA1, mnA, alA, pB0, pB1, alB, t + 1, 0, 1, 1);
    }
    const bool even = (NT & 1) == 0;
    if (even) { SBAR(); qkt<1, SK>(pB0, pB1, K_lds, r32, hi, S.qr, ACT(NT - 1)); SBAR(); }
    if constexpr (!ONE) { SLOAD_H(nxt.K, nxt.V, nxt.kpitch, kbn); SBAR(); }
    { const bf16* qrow = nxt.Q + RF::q_off(nxt, wid * QBLK + r32, e_nxt);
#pragma unroll
      for (int d0 = 0; d0 < 8; ++d0) S.qr[d0] = load8(qrow + d0 * 16 + hi * 8); }
    SBAR();
    finishSM(pA0, pA1, alA, l_reg, pa0, pa1, pa2, pa3); SBAR();
    pv_tile<0, SK>(o, vb0, pa0, pa1, pa2, pa3, ACT(even ? NT - 2 : NT - 1));
    if (even) { MASKT(pB0, pB1, NT - 1); partialSM(pB0, pB1, m_reg, mnB, alB); __syncthreads(); RESC(alB);
        finishSM(pB0, pB1, alB, l_reg, pa0, pa1, pa2, pa3); SBAR(); pv_tile<1, SK>(o, vb0, pa0, pa1, pa2, pa3, ACT(NT - 1)); }
    SBAR(); SEAM_K0();
    if (hi == 0) { li_l[r32] = l_reg; ot_l[r32] = RF::o_off(cur, wid * QBLK + r32, e_cur); } asm volatile("s_waitcnt lgkmcnt(0)" ::: "memory");
    if (LSE != nullptr && hi == 0) { const int lq = RF::l_idx(cur, wid * QBLK + r32, e_cur); if (lq >= 0) LSE[lq] = (l_reg > 0.f) ? m_reg * SCALE + __logf(l_reg) : -__builtin_inff(); }
    if (lse_lane != nullptr) *lse_lane = (l_reg > 0.f) ? m_reg * SCALE + __logf(l_reg) : -__builtin_inff();
    bf16* O = cur.O;
    { char* stg = lds + OFF_ST + wid * ST_WAVE;
#pragma unroll 1
      for (int p = 0; p < 2; ++p) {
#pragma unroll
        for (int rr = 0; rr < 8; ++rr) { const int r = 8 * p + rr, orow = crow(r, hi); const float lv = li_l[orow]; const float rl = (lv > 0.f) ? __builtin_amdgcn_rcpf(lv) : 0.f;
#pragma unroll
            for (int d0 = 0; d0 < 4; ++d0) {
                if constexpr (O8) *(unsigned char*)(stg + (orow - 16 * p) * ST_ROW + (d0 * 32 + r32)) = (unsigned char)__builtin_amdgcn_cvt_pk_fp8_f32(o[d0][r] * rl * 16.f, 0.f, 0, false);
                else *(unsigned short*)(stg + (orow - 16 * p) * ST_ROW + (d0 * 32 + r32) * 2) = (unsigned short)cvtpk(o[d0][r] * rl, 0.f); } }
        asm volatile("s_waitcnt lgkmcnt(0)" ::: "memory");
        { const int row = lane >> 2, ch = lane & 3, oo = ot_l[16 * p + row];
          if constexpr (O8) {
#pragma unroll
            for (int i = 0; i < 2; ++i) { const u32x4 x = *(const u32x4*)(stg + row * ST_ROW + (i * 4 + ch) * 16); if (oo >= 0) { if constexpr (NTS) __builtin_nontemporal_store(x, (u32x4*)((char*)O + (size_t)oo + (i * 4 + ch) * 16)); else *(u32x4*)((char*)O + (size_t)oo + (i * 4 + ch) * 16) = x; } }
          } else {
#pragma unroll
            for (int i = 0; i < 4; ++i) { const u32x4 x = *(const u32x4*)(stg + row * ST_ROW + (i * 4 + ch) * 16); if (oo >= 0) { if constexpr (NTS) __builtin_nontemporal_store(x, (u32x4*)(O + (size_t)oo + (i * 4 + ch) * 8)); else *(u32x4*)(O + (size_t)oo + (i * 4 + ch) * 8) = x; } } } }
        asm volatile("s_waitcnt lgkmcnt(0)" ::: "memory");
      } }
    __syncthreads();
#undef RESC
#undef KBASE
#undef ACT
#undef MASKT
#undef SEAM_K0
#undef HALF_STEP
}

template <class RF>
__device__ __forceinline__ void imp_sweep(const Ref& cur, float lse_lane, float* IMP  , char* lds, Seam& S) {
    const int tid_ = wg_tid((const __attribute__((address_space(3))) int*)(uintptr_t)(unsigned)(uintptr_t)(lds + WIDTAB_OFF));
    const int tid = tid_, wid = __builtin_amdgcn_readfirstlane(tid >> 6), lane = tid & 63, r32 = lane & 31, hi = lane >> 5;
    const int NT = cur.j_hi - cur.j_lo;
    char* K_lds = lds + 2 * SHM_V;
    const int sr = tid >> 4, sc = (tid & 15) * 8, kws = KSWZ(sr, sc * 2);
    const bf16* Kh = cur.K; const int kp = cur.kpitch;
    const int row = wid * QBLK + r32;
    const int qm = RF::pos(cur, row, RF::entry(cur, row)) - 4 * hi; const unsigned Wm = (unsigned)RF::Wl(cur, row);
    constexpr float C2 = 1.4426950408889634f * SCALE;
    const float nl2 = (lse_lane == -__builtin_inff()) ? 0.f : -lse_lane * 1.4426950408889634f;
    float carry = 0.f;
    float* imp_row = IMP + (size_t)(row >> 2) * 512;
    f32x16 p0, p1;
#define IMP_TILE(t, KB) do { \
        if ((t) + 1 < NT) { S.st_k0 = load8(ROW(Kh, kp, (cur.j_lo + (t) + 1) * KVBLK, sr)); S.st_k1 = load8(ROW(Kh, kp, (cur.j_lo + (t) + 1) * KVBLK, 32 + sr)); } \
        SBAR(); qkt<KB, false>(p0, p1, K_lds, r32, hi, S.qr, true); \
        mask_tile(p0, p1, qm - (cur.j_lo + (t)) * KVBLK, Wm); \
        _Pragma("unroll") for (int r = 0; r < 16; ++r) { p0[r] = __builtin_amdgcn_exp2f(fmaf(p0[r], C2, nl2)); p1[r] = __builtin_amdgcn_exp2f(fmaf(p1[r], C2, nl2)); } \
        float Gs[8], Ls[8]; \
        _Pragma("unroll") for (int q = 0; q < 4; ++q) { Gs[q] = (p0[4 * q] + p0[4 * q + 1]) + (p0[4 * q + 2] + p0[4 * q + 3]); Ls[q] = p0[4 * q + 3]; \
                                              Gs[4 + q] = (p1[4 * q] + p1[4 * q + 1]) + (p1[4 * q + 2] + p1[4 * q + 3]); Ls[4 + q] = p1[4 * q + 3]; } \
          \
        float prevL = carry; \
        _Pragma("unroll") for (int q = 0; q < 8; ++q) { const float other = lane_get(Ls[q], lane ^ 32);        \
            const float add = hi ? other : prevL; prevL = other; Gs[q] += add; } \
        carry = prevL;                                            \
        _Pragma("unroll") for (int q = 0; q < 8; ++q) { float v = Gs[q]; v += lane_get(v, lane ^ 1); v += lane_get(v, lane ^ 2); \
            if ((r32 & 3) == 0) imp_row[((cur.j_lo + (t)) << 4) + 2 * q + hi] = v; } \
        if ((t) + 1 < NT) { asm volatile("s_waitcnt vmcnt(0)" ::: "memory"); *(bf16x8*)(K_lds + ((KB) ^ 1) * SHM_K + kws) = S.st_k0; *(bf16x8*)(K_lds + ((KB) ^ 1) * SHM_K + kws + 32 * 256) = S.st_k1; } \
        __syncthreads(); } while (0)
    for (int t = 0; t < NT; t += 2) { IMP_TILE(t, 0); if (t + 1 < NT) IMP_TILE(t + 1, 1); }
#undef IMP_TILE
}

template <class RF>
__device__ __forceinline__ void gate_unit(const Ref& cur, int nvis, char* lds, Seam& S, int (&sel)[3]) {
    const int tid_ = wg_tid((const __attribute__((address_space(3))) int*)(uintptr_t)(unsigned)(uintptr_t)(lds + WIDTAB_OFF));
    const int lane = tid_ & 63, r32 = lane & 31, hi = lane >> 5;
    char* K_lds = lds + 2 * SHM_V;
    prime<RF>(cur, lds, S);
    f32x16 p0, p1;
    qkt<0, false>(p0, p1, K_lds, r32, hi, S.qr, true);
    const float NEG = -__builtin_inff();
#pragma unroll
    for (int r = 0; r < 16; ++r) { const int k = crow(r, hi); if (k >= nvis) p0[r] = NEG; if (k + 32 >= nvis) p1[r] = NEG; }
    float bv[3]; int bk[3];
#pragma unroll
    for (int rd = 0; rd < 3; ++rd) { float best = NEG; int kb = 64;
#pragma unroll
        for (int r = 0; r < 16; ++r) if (p0[r] > best) { best = p0[r]; kb = crow(r, hi); }
#pragma unroll
        for (int r = 0; r < 16; ++r) if (p1[r] > best) { best = p1[r]; kb = 32 + crow(r, hi); }
        bv[rd] = best; bk[rd] = kb;
#pragma unroll
        for (int r = 0; r < 16; ++r) { if (crow(r, hi) == kb) p0[r] = NEG; if (32 + crow(r, hi) == kb) p1[r] = NEG; } }
    float ov[3]; int ok[3];
#pragma unroll
    for (int i = 0; i < 3; ++i) { ov[i] = lane_get(bv[i], lane ^ 32); ok[i] = lane_geti(bk[i], lane ^ 32); }
    int ia = 0, ib = 0;
#pragma unroll
    for (int rd = 0; rd < 3; ++rd) { const float va = ia == 0 ? bv[0] : (ia == 1 ? bv[1] : (ia == 2 ? bv[2] : NEG)), vb = ib == 0 ? ov[0] : (ib == 1 ? ov[1] : (ib == 2 ? ov[2] : NEG));
        const int ka = ia == 0 ? bk[0] : (ia == 1 ? bk[1] : (ia == 2 ? bk[2] : 64)), kb = ib == 0 ? ok[0] : (ib == 1 ? ok[1] : (ib == 2 ? ok[2] : 64));
        const bool ta = va > vb || (va == vb && ka < kb);
        const float v = ta ? va : vb; const int k = ta ? ka : kb; ia += ta ? 1 : 0; ib += ta ? 0 : 1;
        sel[rd] = (v == NEG) ? -1 : k; }
    __syncthreads();
}
#undef ROW
#undef VMW
#undef VMWN
#undef SLOAD_H
#undef SWRITE_HK
#undef SWRITE_HV
#undef SWRITE_H
#undef KSWZ
#undef SBAR
}

struct RFReg {
    static __device__ __forceinline__ int entry(const att::Ref&, int) { return 0; }
    static __device__ __forceinline__ int q_off(const att::Ref&, int row, int) { return row * 1024; }
    static __device__ __forceinline__ int o_off(const att::Ref&, int row, int) { return row * 1024; }
    static __device__ __forceinline__ int l_idx(const att::Ref& u, int row, int) { return u.a0 >= 0 ? u.a0 + row * 8 : -1; }
    static __device__ __forceinline__ int pos(const att::Ref& u, int row, int) { return u.P0 + row; }
    static __device__ __forceinline__ int Wl(const att::Ref& u, int) { return u.W; }
};
__device__ __forceinline__ att::Ref win_ref(int L, const bf16* QN, const bf16* KW, const bf16* VW, bf16* OWIN) {
    const int h = L & 7, qb = L >> 3;
    att::Ref r; r.Q = QN + (size_t)qb * 256 * 1024 + h * 128; r.O = OWIN + (size_t)qb * 256 * 1024 + h * 128; r.K = KW + (h >> 2) * 128; r.V = VW + (h >> 2) * 128; r.kpitch = 256; r.list = nullptr;
    r.P0 = qb * 256; r.W = 512; r.j_lo = (r.P0 >= 511) ? (r.P0 - 511) >> 6 : 0; r.j_hi = ((r.P0 + 255) >> 6) + 1; r.a0 = -1; r.a1 = 0; return r;
}
__device__ __forceinline__ att::Ref mown_ref(int L, const bf16* QM, const bf16* KM, const bf16* VM, bf16* POWN) {
    const int h = L & 7, n = L >> 3; const size_t o = (size_t)n * 256 * 1024 + h * 128;
    att::Ref r; r.Q = QM + o; r.O = POWN + o; r.K = KM + o; r.V = VM + o; r.kpitch = 1024; r.list = nullptr;
    r.P0 = 0; r.W = 1 << 20; r.j_lo = 0; r.j_hi = 4; r.a0 = n * 256 * 8 + h; r.a1 = 0; return r;
}
struct RFSel {
    static __device__ __forceinline__ int entry(const att::Ref& u, int row) { return u.list[row < u.a0 ? row : 0]; }
    static __device__ __forceinline__ int q_off(const att::Ref&, int, int e) { return (e >> 2) * 1024; }
    static __device__ __forceinline__ int o_off(const att::Ref& u, int row, int e) { return row < u.a0 ? (((e >> 2) * 8 + u.a1) * 3 + (e & 3)) * 128 : -1; }
    static __device__ __forceinline__ int l_idx(const att::Ref& u, int row, int e) { return row < u.a0 ? ((e >> 2) * 8 + u.a1) * 3 + (e & 3) : -1; }
    static __device__ __forceinline__ int pos(const att::Ref&, int, int) { return 0; }
    static __device__ __forceinline__ int Wl(const att::Ref&, int) { return 0; }
};
__device__ __forceinline__ att::Ref msel_ref(int L, const LAS int* tab, const LAS unsigned short* ulist, const int* MLIST, const bf16* QM, const bf16* KM, const bf16* VM, bf16* PSEL) {
    const int lid = __builtin_amdgcn_readfirstlane((int)ulist[L]), k = L - tab[512 + lid], h = lid >> 6, n = lid & 63;
    att::Ref r; r.Q = QM + h * 128; r.O = PSEL; r.K = KM + (size_t)n * 256 * 1024 + h * 128; r.V = VM + (size_t)n * 256 * 1024 + h * 128; r.kpitch = 1024;
    r.list = MLIST + (size_t)lid * 16384 + k * 256; r.P0 = 0; r.W = 0; r.j_lo = 0; r.j_hi = 4; r.a0 = tab[lid] - k * 256; r.a1 = h; return r;
}

struct RFSlc {
    static __device__ __forceinline__ int entry(const att::Ref& u, int row) { return u.list[(row >> 2) < u.a0 ? (row >> 2) : 0]; }
    static __device__ __forceinline__ int q_off(const att::Ref&, int row, int e) { return (e >> 4) * 1024 + (row & 3) * 128; }
    static __device__ __forceinline__ int l_idx(const att::Ref& u, int row, int e) { return (row >> 2) < u.a0 ? ((((e >> 4) * 2 + (u.a1 >> 16)) * 16 + (e & 15)) * 4 + (row & 3)) : -1; }
    static __device__ __forceinline__ int o_off(const att::Ref& u, int row, int e) { const int i = l_idx(u, row, e); return i >= 0 ? i * 128 : -1; }
    static __device__ __forceinline__ int pos(const att::Ref& u, int, int e) { return (e >> 4) - 64 * (u.a1 & 0xffff); }
    static __device__ __forceinline__ int Wl(const att::Ref&, int) { return 1 << 30; }
};
__device__ __forceinline__ att::Ref nsel_ref(int L, const LAS int* tab, const LAS unsigned short* ulist, const int* NLIST, const bf16* QN, const bf16* KS, const bf16* VS, bf16* PSLC) {
    const int lid = __builtin_amdgcn_readfirstlane((int)ulist[L]), k = L - tab[512 + lid], g = lid >> 8, j = lid & 255;
    att::Ref r; r.Q = QN + g * 512; r.O = PSLC; r.K = KS + (size_t)j * 64 * 256 + g * 128; r.V = VS + (size_t)j * 64 * 256 + g * 128; r.kpitch = 256;
    r.list = NLIST + (size_t)lid * 16384 + k * 64; r.P0 = 0; r.W = 0; r.j_lo = 0; r.j_hi = 1; r.a0 = tab[lid] - k * 64; r.a1 = j | (g << 16); return r;
}

struct RFCmp {
    static __device__ __forceinline__ int entry(const att::Ref&, int) { return 0; }
    static __device__ __forceinline__ int q_off(const att::Ref&, int row, int) { return (row >> 2) * 1024 + (row & 3) * 128; }
    static __device__ __forceinline__ int o_off(const att::Ref&, int row, int) { return (row >> 2) * 1024 + (row & 3) * 128; }
    static __device__ __forceinline__ int l_idx(const att::Ref&, int, int) { return -1; }
    static __device__ __forceinline__ int pos(const att::Ref& u, int row, int) { const int t = u.P0 + (row >> 2); return t >= 31 ? (t - 31) >> 4 : -1; }
    static __device__ __forceinline__ int Wl(const att::Ref&, int) { return 1 << 30; }
};
__device__ __forceinline__ att::Ref cmp_ref(int L, const bf16* QN, const bf16* KCMP, const bf16* VCMP, bf16* OCMP) {
    const int g = L & 1, c = (L < 256) ? (L >> 1) : 255 - ((L - 256) >> 1);
    att::Ref r; r.Q = QN + (size_t)c * 64 * 1024 + g * 512; r.O = OCMP + (size_t)c * 64 * 1024 + g * 512; r.K = KCMP + g * 128; r.V = VCMP + g * 128; r.kpitch = 256; r.list = nullptr;
    r.P0 = c * 64; r.W = 0; r.j_lo = 0; r.j_hi = (4 * c + 3 + 63) >> 6; r.a0 = g; r.a1 = c; return r;
}

struct Args { const float* in[18]; float* out; unsigned char* ws; int ph_lo, ph_hi, li, pad; };
typedef const __attribute__((address_space(4))) Args* ArgsP;
__device__ __forceinline__ ArgsP get_args() { auto p = __builtin_amdgcn_kernarg_segment_ptr(); asm volatile("" : "+s"(p)); return (ArgsP)p; }

__global__ void __launch_bounds__(NTHR, 2) mk_fwd(Args args_unused) {
    extern __shared__ __attribute__((aligned(16))) unsigned char lds_raw[];
    LAS unsigned char* lds = (LAS unsigned char*)lds_raw;
    LAS float* sm = (LAS float*)lds;
    volatile LAS unsigned* MISC = (volatile LAS unsigned*)(lds + MISC_OFF);
    LAS int* moetab = (LAS int*)(lds + MOETAB_OFF);
    const int G = gridDim.x, bid = blockIdx.x, NGW = G * NWAVES;
#define PH_IDS() const int tid_ = wg_tid((const LAS int*)(lds + WIDTAB_OFF)); const int tid = tid_, lane = tid & 63, wave = __builtin_amdgcn_readfirstlane(tid >> 6), gw = bid * NWAVES + wave; (void)lane; (void)gw;
#define AP() get_args()
#define CTLP(ws) ((gu32*)((ws) + WS_CTL))

    for (int u = threadIdx.x; u < (LDS_BYTES - LDSCTL_OFF) / 4; u += NTHR) ((LAS unsigned*)(lds + LDSCTL_OFF))[u] = 0u;
    __syncthreads();
    { unsigned hw; asm volatile("s_getreg_b32 %0, hwreg(HW_REG_HW_ID, 0, 6)" : "=s"(hw)); if ((threadIdx.x & 63) == 0) ((LAS int*)(lds + WIDTAB_OFF))[hw] = (int)(threadIdx.x >> 6); }
    __syncthreads();
    XcdBarrier bar; bar.bar = nullptr; bar.x = 0; bar.st = nullptr;
    if (MK_N_LAUNCHES == 1) bar = xcd_barrier_post((unsigned*)(CTLP(AP()->ws) + CW_BAR), MISC + 8);
#define GRID_BAR() do { if (MK_N_LAUNCHES == 1) { XcdBarrier b_ = bar; b_.bar = (unsigned*)(CTLP(AP()->ws) + CW_BAR); xcd_barrier(b_, wg_tid((const LAS int*)(lds + WIDTAB_OFF)) == 0); } } while (0)
    const int lo = AP()->ph_lo, hi = AP()->ph_hi;
#define IN(k) (lo <= (k) && (k) < hi)
#define BOTH(k) (IN(k) && IN((k) + 1))

    if (IN(0)) {
        PH_IDS(); ArgsP ap = AP(); unsigned char* ws = ap->ws;
        LAS float* scr = (LAS float*)(lds + wave * 16384);
        constexpr int I_IN = 32 * 177, I_OUT = 32 * 64, I_GU = 32 * 16, I_DN = 8 * 64, I_W1 = 32 * 8;
        constexpr int N_IN = 2 * I_IN, N_OUT = 2 * I_OUT, N_G = 64 * I_GU, N_U = 64 * I_GU, N_D = 64 * I_DN, N_W1 = 8 * I_W1;
        constexpr int NITEMS = N_IN + N_OUT + N_G + N_U + N_D + N_W1;
        for (int it = gw; it < NITEMS; it += NGW) {
            int r = it;
            if (r < N_IN) { const int l = r / I_IN; transpose_item<1>(ap->in[6] + (size_t)l * D_ * IN_W, D_, IN_W, (bf16*)(ws + WS_WINT) + (size_t)l * NIN * D_, D_, 0, scr, r % I_IN, lane); continue; } r -= N_IN;
            if (r < N_OUT) { const int l = r / I_OUT; transpose_item<0>(ap->in[7] + (size_t)l * D_ * D_, D_, D_, (bf16*)(ws + WS_WOUTT) + (size_t)l * D_ * D_, D_, 0, scr, r % I_OUT, lane); continue; } r -= N_OUT;
            if (r < N_G) { const int le = r / I_GU; transpose_item<2>(ap->in[14] + (size_t)le * D_ * DEXP, D_, DEXP, (bf16*)(ws + WS_WGUT) + (size_t)le * 1024 * D_, D_, 0, scr, r % I_GU, lane); continue; } r -= N_G;
            if (r < N_U) { const int le = r / I_GU; transpose_item<3>(ap->in[15] + (size_t)le * D_ * DEXP, D_, DEXP, (bf16*)(ws + WS_WGUT) + (size_t)le * 1024 * D_, D_, 0, scr, r % I_GU, lane); continue; } r -= N_U;
            if (r < N_D) { const int le = r / I_DN; transpose_item<0>(ap->in[16] + (size_t)le * DEXP * D_, DEXP, D_, (bf16*)(ws + WS_WDT) + (size_t)le * D_ * DEXP, DEXP, 0, scr, r % I_DN, lane); continue; } r -= N_D;
            { const int m = r / I_W1, lk = m >> 1, half = m & 1;
              transpose_item<0>(ap->in[9] + (size_t)lk * 4096 * 256 + (size_t)half * 2048 * 256, 2048, 256, (bf16*)(ws + WS_WC1T) + (size_t)lk * 512 * 2048, 2048, half * 256, scr, r % I_W1, lane); }
        }
        { const float* w_router = ap->in[12]; bf16* WrT = (bf16*)(ws + WS_WRT);
          for (int idx = bid * NTHR + tid; idx < 32 * 2048; idx += G * NTHR) { const int e = idx >> 11, k = idx & 2047; const float w = w_router[(size_t)k * 32 + e];
            const unsigned hb = f2bf(w); const float rem = w - bf2f(hb); WrT[idx] = (bf16)hb; WrT[32 * 2048 + idx] = (bf16)f2bf(rem); } }
        { f32x2* ROPE = (f32x2*)(ws + WS_ROPE);
          for (int idx = bid * NTHR + tid; idx < S_ * 64; idx += G * NTHR) { const int pos = idx >> 6, i = idx & 63;
            const double inv = exp(-(double)i * (9.210340371976184 / 64.0)); const double ang = (double)pos * inv; double sv, cv; sincos(ang, &sv, &cv);
            ROPE[idx] = (f32x2){(float)cv, (float)sv}; } }
        __syncthreads();
        { float* MOD = (float*)(CTLP(ws) + CW_MOD); const float* c_in = ap->in[1]; const float* w_ada = ap->in[2]; const float* b_ada = ap->in[3];
          for (int k = tid; k < D_; k += NTHR) { const float cv = c_in[k]; sm[k] = cv / (1.f + __expf(-cv)); }
          __syncthreads();
          for (int it = bid; it < 2 * 96; it += G) { const int l = it / 96, cb = it % 96, grp = tid >> 5, col = cb * 128 + (tid & 31) * 4;
            f32x4 a = (f32x4){0.f, 0.f, 0.f, 0.f};
            const float* wp = w_ada + ((size_t)l * D_ + grp) * 12288 + col;
#pragma unroll 8
            for (int i = 0; i < 128; ++i) a += __builtin_nontemporal_load((const f32x4*)(wp + (size_t)i * 16 * 12288)) * sm[grp + 16 * i];
            *(LAS f32x4*)(sm + 4096 + grp * 128 + (tid & 31) * 4) = a;
            __syncthreads();
            if (tid < 128) { float s = b_ada[l * 12288 + cb * 128 + tid];
#pragma unroll
                for (int q = 0; q < 16; ++q) s += sm[4096 + q * 128 + tid];
                MOD[l * 12288 + cb * 128 + tid] = s; }
            __syncthreads(); } }
        { float* B1P = (float*)(CTLP(ws) + CW_B1E); const float* cmp_pe = ap->in[8]; const float* cmp_w1 = ap->in[9];
          for (int it = bid - 192; it >= 0 && it < 32; it += G) { const int lk = it >> 3, ks = it & 7, grp = tid >> 6, n = (tid & 63) * 4;
            f32x4 a = (f32x4){0.f, 0.f, 0.f, 0.f};
            const float* wp = cmp_w1 + ((size_t)lk * 4096 + ks * 512 + grp) * 256 + n; const float* pe = cmp_pe + (size_t)lk * 4096 + ks * 512 + grp;
#pragma unroll 8
            for (int i = 0; i < 64; ++i) a += *(const f32x4*)(wp + (size_t)i * 8 * 256) * pe[i * 8];
            *(LAS f32x4*)(sm + 4096 + grp * 256 + n) = a;
            __syncthreads();
            if (tid < 256) { float s = 0.f;
#pragma unroll
                for (int q = 0; q < 8; ++q) s += sm[4096 + q * 256 + tid];
                B1P[(lk * 8 + ks) * 256 + tid] = s; }
            __syncthreads(); } }
        if (BOTH(0)) GRID_BAR();
    }

    for (int l = 0; l < DEPTH; ++l) {
        const int pb = 1 + NPL * l;
#define LOAD_MOETAB(CNTP, NT_) do { __syncthreads(); if (tid < 32) moetab[tid] = (int)__hip_atomic_load((CNTP) + tid, RLX_AGENT); __syncthreads(); \
        if (tid == 0) { int us = 0, ps = 0; for (int e = 0; e < NEXP; ++e) { const int c = moetab[e], tl = (c + 255) >> 8; moetab[32 + e] = us; moetab[65 + e] = ps; us += tl * (NT_); ps += tl << 8; } moetab[64] = us; } \
        __syncthreads(); } while (0)

        if (IN(pb + 0)) {
            PH_IDS(); ArgsP ap = AP(); unsigned char* ws = ap->ws;
            const float* MOD = (const float*)(CTLP(ws) + CW_MOD); const float* mod = MOD + l * 12288;
            float* X = ap->out; bf16* H = (bf16*)(ws + WS_H); const bf16* Y = (const bf16*)(ws + WS_Y); const int* TE = (const int*)(ws + WS_TE);
            if (l > 0) LOAD_MOETAB((unsigned*)(CTLP(ws) + CW_CNT) + (l - 1) * 32, 1);
            { const float* g_attn = ap->in[4];
              for (int k = tid; k < D_; k += NTHR) { sm[k] = g_attn[l * D_ + k] * (1.f + mod[2048 + k]); sm[2048 + k] = mod[k]; sm[4096 + k] = (l > 0) ? MOD[(l - 1) * 12288 + 10240 + k] : 0.f; } }
            __syncthreads();
            const float* x_in = ap->in[0];
            for (int t = gw; t < S_; t += NGW) {
                f32x4 v[8]; float ss = 0.f;
                if (l == 0) {
#pragma unroll
                    for (int j = 0; j < 8; ++j) v[j] = *(const f32x4*)(x_in + (size_t)t * D_ + 256 * j + 4 * lane);
                } else {
                    const int4 te = *(const int4*)(TE + 4 * t);
                    const bf16* y0 = Y + (size_t)(moetab[65 + te.x] + te.y) * D_; const bf16* y1 = Y + (size_t)(moetab[65 + te.z] + te.w) * D_;
#pragma unroll
                    for (int j = 0; j < 8; ++j) { const int k = 256 * j + 4 * lane; const uint2 a = *(const uint2*)(y0 + k), b = *(const uint2*)(y1 + k);
                        const f32x4 gt2 = *(const LAS f32x4*)(sm + 4096 + k);
                        f32x4 ysum = (f32x4){bflo(a.x) + bflo(b.x), bfhi(a.x) + bfhi(b.x), bflo(a.y) + bflo(b.y), bfhi(a.y) + bfhi(b.y)};
                        v[j] = *(const f32x4*)(X + (size_t)t * D_ + k) + gt2 * ysum; *(f32x4*)(X + (size_t)t * D_ + k) = v[j]; }
                }
#pragma unroll
                for (int j = 0; j < 8; ++j) ss += (v[j][0] * v[j][0] + v[j][1] * v[j][1]) + (v[j][2] * v[j][2] + v[j][3] * v[j][3]);
                const float rstd = 1.f / sqrtf(wave_sum(ss, lane) * (1.f / D_) + RMS_EPS);
#pragma unroll
                for (int j = 0; j < 8; ++j) { const int k = 256 * j + 4 * lane; const f32x4 h = v[j] * rstd * *(const LAS f32x4*)(sm + k) + *(const LAS f32x4*)(sm + 2048 + k);
                    *(uint2*)(H + (size_t)t * D_ + k) = make_uint2(pk2(h[0], h[1]), pk2(h[2], h[3])); }
            }
            if (BOTH(pb + 0)) GRID_BAR();
        }
        if (IN(pb + 1)) {
            ArgsP ap = AP(); unsigned char* ws = ap->ws;
            pg8::Gemm g{(const bf16*)(ws + WS_H), (const bf16*)(ws + WS_WINT) + (size_t)l * NIN * D_, S_, NIN, D_}; pg8::StaticOrder So; So.init(S_, NIN, G, bid);
            EpiInProj E{(bf16*)(ws + WS_QN), (bf16*)(ws + WS_KC), (bf16*)(ws + WS_VC), (bf16*)(ws + WS_KS), (bf16*)(ws + WS_VS), (bf16*)(ws + WS_KW), (bf16*)(ws + WS_VW),
                        (bf16*)(ws + WS_QM), (bf16*)(ws + WS_KM), (bf16*)(ws + WS_VM), (float*)(ws + WS_GATES), (const float*)(ws + WS_ROPE)};
            pg8::gemm_phase<EpiInProj, pg8::StaticOrder, true, true>(lds, g, So, E);
            if (BOTH(pb + 1)) GRID_BAR();
        }
        if (IN(pb + 2)) {
            PH_IDS(); ArgsP ap = AP(); unsigned char* ws = ap->ws;
            if (bid < 32) {
                pg8::Gemm g{(const bf16*)(ws + WS_KC), (const bf16*)(ws + WS_WC1T) + (size_t)l * 2 * 512 * 2048, 4096, 512, 2048}; CompressOrder So{G, bid};
                EpiF32 E{(float*)(ws + WS_UL), 512};
                pg8::gemm_phase<EpiF32, CompressOrder, false, true>(lds, g, So, E);
            }
            {
                const bf16* KM = (const bf16*)(ws + WS_KM); bf16* KMEAN = (bf16*)(ws + WS_KMEAN);
                const int nb = (G > 32) ? G - 32 : G, b0 = (G > 32) ? bid - 32 : bid;
                if (b0 >= 0) for (int u = b0; u < 512; u += nb) { const int n = u >> 3, h = u & 7, rg = tid >> 4, c8 = (tid & 15) * 8;
                    float a8[8] = {0.f, 0.f, 0.f, 0.f, 0.f, 0.f, 0.f, 0.f};
#pragma unroll
                    for (int i = 0; i < 8; ++i) { const v4u kv = *(const v4u*)(KM + (size_t)(n * 256 + rg + 32 * i) * 1024 + h * 128 + c8);
                        a8[0] += bflo(kv.x); a8[1] += bfhi(kv.x); a8[2] += bflo(kv.y); a8[3] += bfhi(kv.y); a8[4] += bflo(kv.z); a8[5] += bfhi(kv.z); a8[6] += bflo(kv.w); a8[7] += bfhi(kv.w); }
#pragma unroll
                    for (int i = 0; i < 8; ++i) sm[rg * 128 + c8 + i] = a8[i];
                    __syncthreads();
                    if (tid < 128) { float s = 0.f;
#pragma unroll 8
                        for (int q = 0; q < 32; ++q) s += sm[q * 128 + tid];
                        KMEAN[(size_t)(h * 64 + n) * 128 + tid] = (bf16)f2bf(s * (1.f / 256.f)); }
                    __syncthreads(); }
            }
            {
                const bf16* QN = (const bf16*)(ws + WS_QN); const bf16* KW = (const bf16*)(ws + WS_KW); const bf16* VW = (const bf16*)(ws + WS_VW); bf16* OWIN = (bf16*)(ws + WS_OWIN);
                const bf16* QM = (const bf16*)(ws + WS_QM); const bf16* KM2 = (const bf16*)(ws + WS_KM); const bf16* VM = (const bf16*)(ws + WS_VM); bf16* POWN = (bf16*)(ws + WS_POWN); float* LSEO = (float*)(ws + WS_LSEO);
                const int nbw = (G > 32) ? G - 32 : G, bw = (G > 32) ? bid - 32 : bid;
                __syncthreads();
                att::Seam S; int L = bw;
                if (L >= 0 && L < 1024) { att::Ref cur = (L < 512) ? win_ref(L, QN, KW, VW, OWIN) : mown_ref(L - 512, QM, KM2, VM, POWN); att::prime<RFReg>(cur, (char*)lds_raw, S);
                    for (;;) { const int Ln = L + nbw; const bool more = Ln < 1024; const att::Ref nxt = more ? ((Ln < 512) ? win_ref(Ln, QN, KW, VW, OWIN) : mown_ref(Ln - 512, QM, KM2, VM, POWN)) : cur;
                        att::block<0, true, RFReg>(cur, nxt, LSEO, (char*)lds_raw, S);
                        if (!more) break; cur = nxt; L = Ln; } }
                __syncthreads();
            }
            if (BOTH(pb + 2)) GRID_BAR();
        }
        if (IN(pb + 3)) {
            PH_IDS(); ArgsP ap = AP(); unsigned char* ws = ap->ws;
            const float* UL = (const float*)(ws + WS_UL); const float* B1P = (const float*)(CTLP(ws) + CW_B1E); const float* cmp_b1 = ap->in[10]; const f32x2* ROPE = (const f32x2*)(ws + WS_ROPE);
            bf16* KCMP = (bf16*)(ws + WS_KCMP); bf16* VCMP = (bf16*)(ws + WS_VCMP); const float* cmp_w2 = ap->in[11];
            { const int kv = bid & 1; const float* w2 = cmp_w2 + (size_t)(l * 2 + kv) * 256 * 128; LAS float* be = (LAS float*)(lds + 135168 + 8192);
              if (tid < 256) { float s = cmp_b1[(l * 2 + kv) * 256 + tid];
#pragma unroll
                  for (int q = 0; q < 8; ++q) s += B1P[((l * 2 + kv) * 8 + q) * 256 + tid];
                  be[tid] = s; }
              for (int i = tid; i < 256 * 128 / 4; i += NTHR) *(LAS f32x4*)(sm + 4 * i) = *(const f32x4*)(w2 + 4 * i);
              LAS float* hid = (LAS float*)(lds + 135168) + wave * 256;
              __syncthreads();
              const int nb2 = (G + 1 - kv) >> 1;
              for (int r = (bid >> 1) * NWAVES + wave; r < NC * 2; r += nb2 * NWAVES) { const int c = r >> 1, g = r & 1;
                const float* Ur = UL + ((size_t)kv * 2048 + g * 1024 + c) * 512; const float* Lr = UL + ((size_t)kv * 2048 + g * 1024 + c + 1) * 512 + 256;
#pragma unroll
                for (int j = 0; j < 4; ++j) { const int n = lane + 64 * j; const float v = Ur[n] + Lr[n] + be[n];
                    hid[n] = 0.5f * v * (1.f + tanhf(0.7978845608028654f * (v + 0.044715f * v * v * v))); }
                LDS_WAIT(); asm volatile("" ::: "memory");
                float o0 = 0.f, o1 = 0.f;
#pragma unroll 8
                for (int n = 0; n < 256; ++n) { const float hv = hid[n]; o0 += hv * sm[n * 128 + lane]; o1 += hv * sm[n * 128 + 64 + lane]; }
                if (kv == 0) { const f32x2 cs = ROPE[(size_t)(16 * c + 31) * 64 + lane];
                    const float a = o0 * cs[0] - o1 * cs[1], b = o1 * cs[0] + o0 * cs[1];
                    *(unsigned*)(KCMP + ((size_t)c * 2 + g) * 128 + 2 * lane) = pk2(a, b);
                } else { VCMP[((size_t)c * 2 + g) * 128 + lane] = (bf16)f2bf(o0); VCMP[((size_t)c * 2 + g) * 128 + 64 + lane] = (bf16)f2bf(o1); }
                LDS_WAIT(); asm volatile("" ::: "memory");
              }
              __syncthreads(); }
            if (BOTH(pb + 3)) GRID_BAR();
        }
        if (IN(pb + 4)) {
            {   ArgsP ap = AP(); unsigned char* ws = ap->ws;
                const bf16* QN = (const bf16*)(ws + WS_QN); const bf16* KCMP = (const bf16*)(ws + WS_KCMP); const bf16* VCMP = (const bf16*)(ws + WS_VCMP);
                bf16* OCMP = (bf16*)(ws + WS_OCMP); float* IMP = (float*)(ws + WS_IMP);
                att::Seam S;
                for (int L = bid; L < 512; L += G) { const att::Ref cur = cmp_ref(L, QN, KCMP, VCMP, OCMP); float lse;
                    att::prime<RFCmp>(cur, (char*)lds_raw, S);
                    att::block<2, false, RFCmp>(cur, cur, nullptr, (char*)lds_raw, S, &lse);
                    att::imp_sweep<RFCmp>(cur, lse, IMP + ((size_t)cur.a1 * 64 * 2 + cur.a0) * 256, (char*)lds_raw, S); }
            }
            {   PH_IDS(); ArgsP ap = AP(); unsigned char* ws = ap->ws;
                const bf16* QM = (const bf16*)(ws + WS_QM); const bf16* KMEAN = (const bf16*)(ws + WS_KMEAN);
                unsigned* MCNT = (unsigned*)(CTLP(ws) + CW_MCNT) + l * 512; int* MLIST = (int*)(ws + WS_MLIST); float* LSES = (float*)(ws + WS_LSES);
                __syncthreads();
                att::Seam S;
                for (int L = bid; L < 512; L += G) { const int h = L & 7, nq = L >> 3;
                    att::Ref cur; cur.Q = QM + (size_t)nq * 256 * 1024 + h * 128; cur.O = nullptr; cur.K = KMEAN + (size_t)h * 64 * 128; cur.V = cur.K; cur.kpitch = 128; cur.list = nullptr;
                    cur.P0 = 0; cur.W = 0; cur.j_lo = 0; cur.j_hi = 1; cur.a0 = -1; cur.a1 = 0;
                    int sel[3]; att::gate_unit<RFReg>(cur, nq, (char*)lds_raw, S, sel);
                    if (lane < 32) { const int t = nq * 256 + wave * 32 + lane;
#pragma unroll
                        for (int s = 0; s < 3; ++s) {
                            if (sel[s] >= 0) { const unsigned p = atomicAdd(MCNT + h * 64 + sel[s], 1u); MLIST[(size_t)(h * 64 + sel[s]) * 16384 + p] = t * 4 + s; }
                            else LSES[(t * 8 + h) * 3 + s] = -INFINITY; } }
                }
            }
            if (BOTH(pb + 4)) GRID_BAR();
        }
        if (IN(pb + 5)) {
            PH_IDS(); ArgsP ap = AP(); unsigned char* ws = ap->ws;
            {   PH_IDS(); ArgsP ap = AP(); unsigned char* ws = ap->ws;
                const float* IMP = (const float*)(ws + WS_IMP); int* SEL = (int*)(ws + WS_SEL);
                unsigned* NCNT = (unsigned*)(CTLP(ws) + CW_NCNT) + l * 512; int* NLIST = (int*)(ws + WS_NLIST);
                const int lam = lane & 15, rho = lane >> 4;
                for (int ub = gw * 4; ub < S_ * 2; ub += NGW * 4) { const int u = ub + rho, t = u >> 1, g = u & 1, tb = t >> 6;
                    float v[16];
#pragma unroll
                    for (int i = 0; i < 16; ++i) { const int j = lam + 16 * i; const float im = IMP[(size_t)u * 256 + j]; const bool forced = (j == 0) || (j == tb) || (j == tb - 1);
                        v[i] = (j > tb) ? -INFINITY : (forced ? 1e9f : im); }
                    int mysel = -1;
                    for (int r = 0; r < 16; ++r) { const int pick = row_pick<16>(v, lam); if (lam == r) mysel = pick; if (__all(pick < 0)) break; }
                    SEL[(size_t)u * 16 + lam] = mysel;
                    if (mysel >= 0) {
                        unsigned p;
                        if (mysel == 0) p = (unsigned)t; else if (mysel == tb) p = (unsigned)(t & 63); else if (mysel == tb - 1) p = 64u + (unsigned)(t & 63);
                        else p = 128u + atomicAdd(NCNT + g * 256 + mysel, 1u);
                        NLIST[(size_t)(g * 256 + mysel) * 16384 + p] = t * 16 + lam; }
                }
            }
            {   PH_IDS(); ArgsP ap = AP(); unsigned char* ws = ap->ws;
                const bf16* QM = (const bf16*)(ws + WS_QM); const bf16* KM = (const bf16*)(ws + WS_KM); const bf16* VM = (const bf16*)(ws + WS_VM);
                bf16* POWN = (bf16*)(ws + WS_POWN); bf16* PSEL = (bf16*)(ws + WS_PSEL); float* LSEO = (float*)(ws + WS_LSEO); float* LSES = (float*)(ws + WS_LSES);
                const int* MLIST = (const int*)(ws + WS_MLIST); unsigned* MCNT = (unsigned*)(CTLP(ws) + CW_MCNT) + l * 512;
                LAS int* mtab = (LAS int*)(lds + att::LDS_BYTES);
                __syncthreads();
                mtab[tid] = (int)__hip_atomic_load(MCNT + tid, RLX_AGENT);
                __syncthreads();
                LAS unsigned short* ulist = (LAS unsigned short*)(lds + 108544);
                { int tot; const int nu = (mtab[tid] + 255) >> 8; const int ex = block_excl_scan(nu, mtab + 1040, tid, &tot); mtab[512 + tid] = ex; if (tid == 0) mtab[1024] = tot;
                  for (int u = 0; u < nu; ++u) ulist[ex + u] = (unsigned short)tid; }
                __syncthreads();
                const int nsel = mtab[1024];
                att::Seam S;
                { int L = bid;
                  if (L < nsel) { att::Ref cur = msel_ref(L, mtab, ulist, MLIST, QM, KM, VM, PSEL); att::prime<RFSel>(cur, (char*)lds_raw, S);
                    for (;;) { const bool more = L + G < nsel; const att::Ref nxt = more ? msel_ref(L + G, mtab, ulist, MLIST, QM, KM, VM, PSEL) : cur;
                        att::block<1, false, RFSel, false, false, true>(cur, nxt, LSES, (char*)lds_raw, S);
                        if (!more) break; cur = nxt; L += G; } } }
                __syncthreads();
            }
            if (BOTH(pb + 5)) GRID_BAR();
        }
        if (IN(pb + 6)) {
            PH_IDS(); ArgsP ap = AP(); unsigned char* ws = ap->ws;
            const bf16* POWN = (const bf16*)(ws + WS_POWN); const bf16* PSEL = (const bf16*)(ws + WS_PSEL); const float* LSEO = (const float*)(ws + WS_LSEO); const float* LSES = (const float*)(ws + WS_LSES);
            bf16* OMIX = (bf16*)(ws + WS_OMIX);
            for (int t = gw; t < S_; t += NGW) {
                const int hh = (lane >> 2) & 7, ii = lane & 3;
                const float lv = (ii == 0) ? LSEO[t * 8 + hh] : LSES[(t * 8 + hh) * 3 + ii - 1];
                float m = fmaxf(lv, lane_get(lv, lane ^ 1)); m = fmaxf(m, lane_get(m, lane ^ 2));
                float w = __expf(lv - m); float sw = w + lane_get(w, lane ^ 1); sw += lane_get(sw, lane ^ 2); w = w / sw;
#pragma unroll
                for (int hp = 0; hp < 2; ++hp) { const int h = hp * 4 + (lane >> 4), c8 = (lane & 15) * 8;
                    const float w0 = lane_get(w, h * 4), w1 = lane_get(w, h * 4 + 1), w2 = lane_get(w, h * 4 + 2), w3 = lane_get(w, h * 4 + 3);
                    const bf16* ps = PSEL + (size_t)((t * 8 + h) * 3) * 128 + c8;
                    const v4u a0 = *(const v4u*)(POWN + (size_t)t * 1024 + h * 128 + c8);
                    v4u a1 = (v4u){0u, 0u, 0u, 0u}, a2 = a1, a3 = a1;
                    if (w1 > 0.f) a1 = __builtin_nontemporal_load((const v4u*)(ps)); if (w2 > 0.f) a2 = __builtin_nontemporal_load((const v4u*)(ps + 128)); if (w3 > 0.f) a3 = __builtin_nontemporal_load((const v4u*)(ps + 256));
                    v4u ov;
                    ov.x = pk2(w0 * bflo(a0.x) + w1 * bflo(a1.x) + w2 * bflo(a2.x) + w3 * bflo(a3.x), w0 * bfhi(a0.x) + w1 * bfhi(a1.x) + w2 * bfhi(a2.x) + w3 * bfhi(a3.x));
                    ov.y = pk2(w0 * bflo(a0.y) + w1 * bflo(a1.y) + w2 * bflo(a2.y) + w3 * bflo(a3.y), w0 * bfhi(a0.y) + w1 * bfhi(a1.y) + w2 * bfhi(a2.y) + w3 * bfhi(a3.y));
                    ov.z = pk2(w0 * bflo(a0.z) + w1 * bflo(a1.z) + w2 * bflo(a2.z) + w3 * bflo(a3.z), w0 * bfhi(a0.z) + w1 * bfhi(a1.z) + w2 * bfhi(a2.z) + w3 * bfhi(a3.z));
                    ov.w = pk2(w0 * bflo(a0.w) + w1 * bflo(a1.w) + w2 * bflo(a2.w) + w3 * bflo(a3.w), w0 * bfhi(a0.w) + w1 * bfhi(a1.w) + w2 * bfhi(a2.w) + w3 * bfhi(a3.w));
                    *(v4u*)(OMIX + (size_t)t * 2048 + 1024 + h * 128 + c8) = ov; }
            }
            if (BOTH(pb + 6)) GRID_BAR();

        }
        if (IN(pb + 7)) {
            PH_IDS(); ArgsP ap = AP(); unsigned char* ws = ap->ws;
            const bf16* QN = (const bf16*)(ws + WS_QN); const bf16* KS = (const bf16*)(ws + WS_KS); const bf16* VS = (const bf16*)(ws + WS_VS);
            bf16* PSLC = (bf16*)(ws + WS_PSLC); float* LSEN = (float*)(ws + WS_LSEN); const int* NLIST = (const int*)(ws + WS_NLIST); unsigned* NCNT = (unsigned*)(CTLP(ws) + CW_NCNT) + l * 512;
            LAS int* ntab = (LAS int*)(lds + att::LDS_BYTES);
            __syncthreads();
            { const int j = tid & 255; ntab[tid] = (j == 0) ? S_ : (int)__hip_atomic_load(NCNT + tid, RLX_AGENT) + 64 + (j < 255 ? 64 : 0); }
            __syncthreads();
            LAS unsigned short* ulist = (LAS unsigned short*)(lds + 108544);
            { int tot; const int nu = (ntab[tid] + 63) >> 6; const int ex = block_excl_scan(nu, ntab + 1040, tid, &tot); ntab[512 + tid] = ex; if (tid == 0) ntab[1024] = tot;
              for (int u = 0; u < nu; ++u) ulist[ex + u] = (unsigned short)tid; }
            __syncthreads();
            const int nun = ntab[1024];
            att::Seam S; int L = bid;
            if (L < nun) { att::Ref cur = nsel_ref(L, ntab, ulist, NLIST, QN, KS, VS, PSLC); att::prime<RFSlc>(cur, (char*)lds_raw, S);
                for (;;) { const bool more = L + G < nun; const att::Ref nxt = more ? nsel_ref(L + G, ntab, ulist, NLIST, QN, KS, VS, PSLC) : cur;
                    att::block<2, false, RFSlc, true, true, true>(cur, nxt, LSEN, (char*)lds_raw, S);
                    if (!more) break; cur = nxt; L += G; } }
            __syncthreads();
            if (BOTH(pb + 7)) GRID_BAR();
        }
        if (IN(pb + 8)) {
            PH_IDS(); ArgsP ap = AP(); unsigned char* ws = ap->ws;
            const unsigned char* PSLC = (const unsigned char*)(ws + WS_PSLC); const float* LSEN = (const float*)(ws + WS_LSEN); const int* SEL = (const int*)(ws + WS_SEL); const float* GATES = (const float*)(ws + WS_GATES);
            const bf16* OCMP = (const bf16*)(ws + WS_OCMP); const bf16* OWIN = (const bf16*)(ws + WS_OWIN); bf16* OMIX = (bf16*)(ws + WS_OMIX);
            for (int u = gw; u < S_ * 2; u += NGW) { const int t = u >> 1, g = u & 1;
                const int sv = (lane < 16) ? SEL[(size_t)u * 16 + lane] : -1;
                const int nsel = __popcll(__ballot(sv >= 0));
                const float lv = ((lane >> 2) < nsel) ? LSEN[(size_t)u * 64 + lane] : -INFINITY;
                float m = lv;
#pragma unroll
                for (int o = 4; o < 64; o <<= 1) m = fmaxf(m, lane_get(m, lane ^ o));
                float w = __expf(lv - m), sw = w;
#pragma unroll
                for (int o = 4; o < 64; o <<= 1) sw += lane_get(sw, lane ^ o);
                w = w / sw * 0.0625f;
                const int r = lane >> 4, c8 = (lane & 15) * 8;
                float o8[8] = {0.f, 0.f, 0.f, 0.f, 0.f, 0.f, 0.f, 0.f};
                typedef unsigned v2u __attribute__((ext_vector_type(2)));
                v2u pv[16];
#pragma unroll
                for (int s = 0; s < 16; ++s) { const int sc = s < nsel ? s : nsel - 1; pv[s] = __builtin_nontemporal_load((const v2u*)(PSLC + ((size_t)(u * 16 + sc) * 4 + r) * 128 + c8)); }
#pragma unroll
                for (int s = 0; s < 16; ++s) { const float ws_ = lane_get(w, s * 4 + r);
                    o8[0] += ws_ * __builtin_amdgcn_cvt_f32_fp8((int)pv[s].x, 0); o8[1] += ws_ * __builtin_amdgcn_cvt_f32_fp8((int)pv[s].x, 1); o8[2] += ws_ * __builtin_amdgcn_cvt_f32_fp8((int)pv[s].x, 2); o8[3] += ws_ * __builtin_amdgcn_cvt_f32_fp8((int)pv[s].x, 3);
                    o8[4] += ws_ * __builtin_amdgcn_cvt_f32_fp8((int)pv[s].y, 0); o8[5] += ws_ * __builtin_amdgcn_cvt_f32_fp8((int)pv[s].y, 1); o8[6] += ws_ * __builtin_amdgcn_cvt_f32_fp8((int)pv[s].y, 2); o8[7] += ws_ * __builtin_amdgcn_cvt_f32_fp8((int)pv[s].y, 3); }
                const int hd = g * 4 + r; const float g0 = GATES[(size_t)t * 32 + hd * 3], g1 = GATES[(size_t)t * 32 + hd * 3 + 1], g2 = GATES[(size_t)t * 32 + hd * 3 + 2];
                const size_t oi = (size_t)t * 1024 + hd * 128 + c8;
                const v4u cv = *(const v4u*)(OCMP + oi), wv = *(const v4u*)(OWIN + oi);
                v4u ov;
                ov.x = pk2(g1 * o8[0] + g0 * bflo(cv.x) + g2 * bflo(wv.x), g1 * o8[1] + g0 * bfhi(cv.x) + g2 * bfhi(wv.x));
                ov.y = pk2(g1 * o8[2] + g0 * bflo(cv.y) + g2 * bflo(wv.y), g1 * o8[3] + g0 * bfhi(cv.y) + g2 * bfhi(wv.y));
                ov.z = pk2(g1 * o8[4] + g0 * bflo(cv.z) + g2 * bflo(wv.z), g1 * o8[5] + g0 * bfhi(cv.z) + g2 * bfhi(wv.z));
                ov.w = pk2(g1 * o8[6] + g0 * bflo(cv.w) + g2 * bflo(wv.w), g1 * o8[7] + g0 * bfhi(cv.w) + g2 * bfhi(wv.w));
                *(v4u*)(OMIX + (size_t)t * 2048 + hd * 128 + c8) = ov;
            }
            if (BOTH(pb + 8)) GRID_BAR();
        }
        if (IN(pb + 9)) {
            ArgsP ap = AP(); unsigned char* ws = ap->ws;
            pg8::Gemm g{(const bf16*)(ws + WS_OMIX), (const bf16*)(ws + WS_WOUTT) + (size_t)l * D_ * D_, S_, D_, D_}; pg8::StaticOrder So; So.init(S_, D_, G, bid);
            EpiOutProj E{l == 0 ? ap->in[0] : (const float*)ap->out, ap->out, (const float*)(CTLP(ws) + CW_MOD) + l * 12288 + 4096};
            pg8::gemm_phase<EpiOutProj, pg8::StaticOrder, true, true>(lds, g, So, E);
            if (BOTH(pb + 9)) GRID_BAR();
        }
        if (IN(pb + 10)) {
            PH_IDS(); ArgsP ap = AP(); unsigned char* ws = ap->ws;
            const float* mod = (const float*)(CTLP(ws) + CW_MOD) + l * 12288;
            const float* X = ap->out; bf16* H = (bf16*)(ws + WS_H); const bf16* WrT = (const bf16*)(ws + WS_WRT); const float* b_router = ap->in[13];
            unsigned* CNT = (unsigned*)(CTLP(ws) + CW_CNT) + l * 32; int* TE = (int*)(ws + WS_TE); int* TOKIDX = (int*)(ws + WS_TOKIDX); float* WTS = (float*)(ws + WS_WTS);
            { const float* g_ffn = ap->in[5];
              for (int k = tid; k < D_; k += NTHR) { sm[k] = g_ffn[l * D_ + k] * (1.f + mod[8192 + k]); sm[2048 + k] = mod[6144 + k]; }
              if (tid < 32) sm[4160 + tid] = b_router[tid]; }
            typedef short bf16x8_t __attribute__((ext_vector_type(8))); typedef float f32x16_t __attribute__((ext_vector_type(16)));
            for (int bt = bid; bt < S_ / 64; bt += G) { const int t0 = bt * 64;
                __syncthreads();
                for (int rr = 0; rr < 8; rr += 2) { const int row = wave * 8 + rr; float ss0 = 0.f, ss1 = 0.f; f32x4 va[8], vb[8];
#pragma unroll
                    for (int j = 0; j < 8; ++j) { va[j] = *(const f32x4*)(X + (size_t)(t0 + row) * D_ + 256 * j + 4 * lane); vb[j] = *(const f32x4*)(X + (size_t)(t0 + row + 1) * D_ + 256 * j + 4 * lane); }
#pragma unroll
                    for (int j = 0; j < 8; ++j) { ss0 += (va[j][0] * va[j][0] + va[j][1] * va[j][1]) + (va[j][2] * va[j][2] + va[j][3] * va[j][3]); ss1 += (vb[j][0] * vb[j][0] + vb[j][1] * vb[j][1]) + (vb[j][2] * vb[j][2] + vb[j][3] * vb[j][3]); }
                    ss0 = wave_sum(ss0, lane); ss1 = wave_sum(ss1, lane);
                    if (lane == 0) { sm[4096 + row] = 1.f / sqrtf(ss0 * (1.f / D_) + RMS_EPS); sm[4096 + row + 1] = 1.f / sqrtf(ss1 * (1.f / D_) + RMS_EPS); } }
                __syncthreads();
                { const int r = lane & 31, kh = lane >> 5; f32x16_t acc0 = {}, acc1 = {};
                  const float rs0 = sm[4096 + r], rs1 = sm[4096 + 32 + r];
#pragma unroll 2
                  for (int ks = 0; ks < 16; ++ks) { const int k = wave * 256 + ks * 16 + kh * 8;
                    const bf16x8_t wh = *(const bf16x8_t*)(WrT + (size_t)r * 2048 + k), wl = *(const bf16x8_t*)(WrT + 32 * 2048 + (size_t)r * 2048 + k);
                    const f32x4 gA = *(const LAS f32x4*)(sm + k), gB = *(const LAS f32x4*)(sm + k + 4), sA = *(const LAS f32x4*)(sm + 2048 + k), sB = *(const LAS f32x4*)(sm + 2048 + k + 4);
#pragma unroll
                    for (int rg = 0; rg < 2; ++rg) { const size_t ro = (size_t)(t0 + rg * 32 + r) * D_ + k; const float rs = rg ? rs1 : rs0;
                        const f32x4 xa = *(const f32x4*)(X + ro), xb = *(const f32x4*)(X + ro + 4);
                        const f32x4 ha = xa * rs * gA + sA, hb = xb * rs * gB + sB;
                        const unsigned h0 = pk2(ha[0], ha[1]), h1 = pk2(ha[2], ha[3]), h2 = pk2(hb[0], hb[1]), h3 = pk2(hb[2], hb[3]);
                        *(v4u*)(H + ro) = (v4u){h0, h1, h2, h3};
                        const unsigned l0 = pk2(ha[0] - bflo(h0), ha[1] - bfhi(h0)), l1 = pk2(ha[2] - bflo(h1), ha[3] - bfhi(h1)), l2 = pk2(hb[0] - bflo(h2), hb[1] - bfhi(h2)), l3 = pk2(hb[2] - bflo(h3), hb[3] - bfhi(h3));
                        const v4u hv = (v4u){h0, h1, h2, h3}, lv = (v4u){l0, l1, l2, l3};
                        const bf16x8_t ahi = __builtin_bit_cast(bf16x8_t, hv), alo = __builtin_bit_cast(bf16x8_t, lv);
                        if (rg == 0) { acc0 = __builtin_amdgcn_mfma_f32_32x32x16_bf16(wh, ahi, acc0, 0, 0, 0); acc0 = __builtin_amdgcn_mfma_f32_32x32x16_bf16(wl, ahi, acc0, 0, 0, 0); acc0 = __builtin_amdgcn_mfma_f32_32x32x16_bf16(wh, alo, acc0, 0, 0, 0); }
                        else         { acc1 = __builtin_amdgcn_mfma_f32_32x32x16_bf16(wh, ahi, acc1, 0, 0, 0); acc1 = __builtin_amdgcn_mfma_f32_32x32x16_bf16(wl, ahi, acc1, 0, 0, 0); acc1 = __builtin_amdgcn_mfma_f32_32x32x16_bf16(wh, alo, acc1, 0, 0, 0); } } }
#pragma unroll
                  for (int q = 0; q < 16; ++q) { const int e = (q & 3) + 8 * (q >> 2) + 4 * kh;
                      sm[5120 + ((wave * 2 + 0) * 32 + e) * 32 + r] = acc0[q]; sm[5120 + ((wave * 2 + 1) * 32 + e) * 32 + r] = acc1[q]; } }
                __syncthreads();
                { const int tk6 = tid & 63, eq = tid >> 6, rg = tk6 >> 5, tk = tk6 & 31;
#pragma unroll
                  for (int i = 0; i < 4; ++i) { const int e = eq * 4 + i; float s = 0.f;
#pragma unroll
                      for (int w = 0; w < 8; ++w) s += sm[5120 + ((w * 2 + rg) * 32 + e) * 32 + tk];
                      sm[5120 + 16384 + tk6 * 33 + e] = 1.f / (1.f + __expf(-s)); } }
                __syncthreads();
                if (tid < 64) { const int t = t0 + tid;
                    float lg[32];
#pragma unroll
                    for (int e = 0; e < 32; ++e) lg[e] = sm[5120 + 16384 + tid * 33 + e];
                    int grp = 0; float best = -INFINITY;
#pragma unroll
                    for (int gq = 0; gq < 4; ++gq) { float m1 = -INFINITY, m2 = -INFINITY;
#pragma unroll
                        for (int i = 0; i < 8; ++i) { const float b = lg[gq * 8 + i] + sm[4160 + gq * 8 + i]; if (b > m1) { m2 = m1; m1 = b; } else if (b > m2) m2 = b; }
                        const float sgs = m1 + m2; if (sgs > best) { best = sgs; grp = gq; } }
                    float m1 = -INFINITY, m2 = -INFINITY, s1 = 0.f, s2 = 0.f; int i1 = 0, i2 = 0;
#pragma unroll
                    for (int e = 0; e < 32; ++e) { const bool ing = (e >> 3) == grp; const float b = lg[e] + sm[4160 + e];
                        if (ing && b > m1) { m2 = m1; i2 = i1; s2 = s1; m1 = b; i1 = e; s1 = lg[e]; } else if (ing && b > m2) { m2 = b; i2 = e; s2 = lg[e]; } }
                    const float inv = 1.f / (s1 + s2);
                    const unsigned p1 = atomicAdd(CNT + i1, 1u), p2 = atomicAdd(CNT + i2, 1u);
                    TOKIDX[(size_t)i1 * ECAP + p1] = t; TOKIDX[(size_t)i2 * ECAP + p2] = t; WTS[(size_t)i1 * ECAP + p1] = s1 * inv; WTS[(size_t)i2 * ECAP + p2] = s2 * inv;
                    *(int4*)(TE + 4 * t) = make_int4(i1, (int)p1, i2, (int)p2);
                }
            }
            if (BOTH(pb + 10)) GRID_BAR();
        }
        if (IN(pb + 11)) {
            PH_IDS(); ArgsP ap = AP(); unsigned char* ws = ap->ws;
            LOAD_MOETAB((unsigned*)(CTLP(ws) + CW_CNT) + l * 32, 4);
            pg8::Gemm g{(const bf16*)(ws + WS_H), (const bf16*)(ws + WS_WGUT), 0, 0, D_}; MoeOrder<true> So{moetab, 4, G, bid, 4, l * 32 * 4, (const int*)(ws + WS_TOKIDX)};
            EpiGateUp E{(bf16*)(ws + WS_HACT)};
            pg8::gemm_phase<EpiGateUp, MoeOrder<true>, true, true>(lds, g, So, E);
            if (BOTH(pb + 11)) GRID_BAR();
        }
        if (IN(pb + 12)) {
            PH_IDS(); ArgsP ap = AP(); unsigned char* ws = ap->ws;
            LOAD_MOETAB((unsigned*)(CTLP(ws) + CW_CNT) + l * 32, 8);
            pg8::Gemm g{(const bf16*)(ws + WS_HACT), (const bf16*)(ws + WS_WDT), 0, 0, DEXP}; MoeOrder<false> So{moetab, 8, G, bid, 8, l * 32 * 8, nullptr};
            EpiDown E{(bf16*)(ws + WS_Y), (const float*)(ws + WS_WTS), moetab};
            pg8::gemm_phase<EpiDown, MoeOrder<false>, true, true>(lds, g, So, E);
            if (BOTH(pb + 12)) GRID_BAR();
        }
    }
    if (IN(NPH - 1)) {
        PH_IDS(); ArgsP ap = AP(); unsigned char* ws = ap->ws;
        float* X = ap->out; const bf16* Y = (const bf16*)(ws + WS_Y); const int* TE = (const int*)(ws + WS_TE);
        LOAD_MOETAB((unsigned*)(CTLP(ws) + CW_CNT) + 32, 1);
        const bool tmo_set = (MK_N_LAUNCHES == 1) && (__hip_atomic_load((unsigned*)(CTLP(ws) + CW_BAR) + XB_TMO, RLX_AGENT) != 0u);
        { const float* g_final = ap->in[17]; const float* MOD = (const float*)(CTLP(ws) + CW_MOD);
          for (int k = tid; k < D_; k += NTHR) { sm[k] = g_final[k]; sm[2048 + k] = MOD[12288 + 10240 + k]; } }
        __syncthreads();
        for (int t = gw; t < S_; t += NGW) {
            f32x4 v[8]; float ss = 0.f;
            const int4 te = *(const int4*)(TE + 4 * t);
            const bf16* y0 = Y + (size_t)(moetab[65 + te.x] + te.y) * D_; const bf16* y1 = Y + (size_t)(moetab[65 + te.z] + te.w) * D_;
#pragma unroll
            for (int j = 0; j < 8; ++j) { const int k = 256 * j + 4 * lane; const uint2 a = *(const uint2*)(y0 + k), b = *(const uint2*)(y1 + k);
                const f32x4 gt2 = *(const LAS f32x4*)(sm + 2048 + k);
                f32x4 ysum = (f32x4){bflo(a.x) + bflo(b.x), bfhi(a.x) + bfhi(b.x), bflo(a.y) + bflo(b.y), bfhi(a.y) + bfhi(b.y)};
                v[j] = *(const f32x4*)(X + (size_t)t * D_ + k) + gt2 * ysum;
                ss += (v[j][0] * v[j][0] + v[j][1] * v[j][1]) + (v[j][2] * v[j][2] + v[j][3] * v[j][3]); }
            const float rstd = (tmo_set ? __builtin_nanf("") : 1.f) / sqrtf(wave_sum(ss, lane) * (1.f / D_) + RMS_EPS);
#pragma unroll
            for (int j = 0; j < 8; ++j) { const int k = 256 * j + 4 * lane; *(f32x4*)(X + (size_t)t * D_ + k) = v[j] * rstd * *(const LAS f32x4*)(sm + k); }
        }
    }
#undef IN
#undef BOTH
#undef GRID_BAR
#undef LOAD_MOETAB
#undef AP
#undef CTLP
#undef PH_IDS
}

extern "C" void kernel_launch(void* const* d_in, const int* in_sizes, int n_in, void* d_out, int out_size, void* d_ws, size_t ws_size, hipStream_t stream) {
    static int grid = 0;
    if (grid == 0) {
        if (n_in != 18 || out_size != S_ * D_ || ws_size < WS_END) { fprintf(stderr, "kernel_launch: unexpected shapes (n_in %d out %d ws %zu)\n", n_in, out_size, ws_size); grid = -1; return; }
        int dev = 0, cus = 0, per_cu = 0;
        if (hipGetDevice(&dev) != hipSuccess || hipDeviceGetAttribute(&cus, hipDeviceAttributeMultiprocessorCount, dev) != hipSuccess) { grid = -1; return; }
        if (hipFuncSetAttribute((const void*)mk_fwd, hipFuncAttributeMaxDynamicSharedMemorySize, LDS_BYTES) != hipSuccess) { fprintf(stderr, "kernel_launch: hipFuncSetAttribute failed\n"); grid = -1; return; }
        if (hipOccupancyMaxActiveBlocksPerMultiprocessor(&per_cu, (const void*)mk_fwd, NTHR, LDS_BYTES) != hipSuccess || per_cu < 1) { fprintf(stderr, "kernel_launch: occupancy query says %d\n", per_cu); }
        (void)hipGetLastError();
        grid = cus;
    }
    if (grid < 0) return;
    if (hipMemsetAsync((char*)d_ws + WS_CTL, 0, CTL_ZERO_BYTES, stream) != hipSuccess) return;
    Args a{};
    for (int i = 0; i < 18; ++i) a.in[i] = (const float*)d_in[i];
    a.out = (float*)d_out; a.ws = (unsigned char*)d_ws; a.pad = 0;
    if (MK_N_LAUNCHES == 1) {
        a.ph_lo = 0; a.ph_hi = NPH; a.li = 0;
        hipLaunchKernelGGL(mk_fwd, dim3(grid), dim3(NTHR), LDS_BYTES, stream, a);
    } else {
        for (int p = 0; p < NPH; ++p) { a.ph_lo = p; a.ph_hi = p + 1; a.li = p; hipLaunchKernelGGL(mk_fwd, dim3(grid), dim3(NTHR), LDS_BYTES, stream, a); }
    }
}
```

```cpp
#include <hip/hip_runtime.h>
#include <cstdio>
#include <cstdint>


#define WIDTAB_OFF (131072 + 1024)
__device__ __forceinline__ int wg_tid(const __attribute__((address_space(3))) int* widtab) {
    unsigned hw; asm volatile("s_getreg_b32 %0, hwreg(HW_REG_HW_ID, 0, 6)" : "=s"(hw));
    int lane; asm volatile("v_mbcnt_lo_u32_b32 %0, -1, 0\n\tv_mbcnt_hi_u32_b32 %0, -1, %0" : "=v"(lane));
    return widtab[hw] * 64 + lane;
}

namespace pg8 {
#define PG8_LAS __attribute__((address_space(3)))
typedef unsigned short bf16_t;
typedef short bf16x8 __attribute__((ext_vector_type(8)));
typedef float f32x4 __attribute__((ext_vector_type(4)));
typedef unsigned u32x4 __attribute__((ext_vector_type(4)));
constexpr int BM = 256, BK = 64, HALF = 128, HTB = HALF * BK * 2, STAGE_BYTES = 8 * HTB, NXCD = 8, WGM = 8;

__host__ __device__ __forceinline__ int lds_byte(int r, int c) { const int st = (r >> 4) * 2 + (c >> 5), rr = r & 15, cc = c & 31, ob = rr * 64 + cc * 2; return st * 1024 + (ob ^ (((ob >> 9) & 1) << 5)); }
__host__ __device__ __forceinline__ void stage_rc(int b, int& R, int& C) { const int st = b / 1024, sb = b % 1024, swz = sb ^ (((sb >> 9) & 1) << 5); R = (st >> 1) * 16 + swz / 64; C = (st & 1) * 32 + (swz % 64) / 2; }
__host__ __device__ __forceinline__ int perm32(int rho) { const int n = rho >> 4, i = rho & 15; return 8 * (i >> 2) + 4 * n + (i & 3); }

struct Unit { int pm, pn, e, mt, pnl; };
struct Gemm { const bf16_t* A; const bf16_t* Bt; int M, N, K; };

struct StaticOrder {
    static constexpr bool GATHER = false;
    int nM, nN, nwg, G, c;
    __host__ __device__ void init(int M, int N, int G_, int c_) { nM = M / BM; nN = N / BM; nwg = nM * nN; G = G_; c = c_; }
    __host__ __device__ bool next(int i, Unit& u) const {
        const long L = (long)i * G + c; if (L >= nwg) return false;
        int wgid = (int)L; { const int q = nwg / NXCD, r = nwg % NXCD, xcd = wgid % NXCD, off = wgid / NXCD; wgid = (xcd < r ? xcd * (q + 1) : r * (q + 1) + (xcd - r) * q) + off; }
        const int nig = WGM * nN, gid = wgid / nig, fm = gid * WGM, gsz = (nM - fm) < WGM ? (nM - fm) : WGM;
        u.pm = fm + ((wgid % nig) % gsz); u.pn = (wgid % nig) / gsz; u.e = 0; u.mt = 0; u.pnl = u.pn; return true;
    }
    __device__ __forceinline__ void a_offs(const Unit&, int, int, int, int, int, unsigned (&)[2][2]) const {}
    __device__ __forceinline__ void a_ready(const Unit&) const {}
    __device__ __forceinline__ void done(const Unit&) const {}
};

__device__ __forceinline__ unsigned cvt_pk_bf16(float lo, float hi) { unsigned r; asm volatile("v_cvt_pk_bf16_f32 %0, %1, %2" : "=v"(r) : "v"(lo), "v"(hi)); return r; }

template <class Epi, class Sched, bool ALIGN_EPI = false, bool SP2 = false>
__device__ __forceinline__ void gemm_phase(PG8_LAS unsigned char* lds, const Gemm g, const Sched& S, const Epi& E) {
    const int tid_ = wg_tid((const PG8_LAS int*)(lds + WIDTAB_OFF));
    const int tid = tid_, wid = __builtin_amdgcn_readfirstlane(tid >> 6), lane = tid & 63, wr = wid >> 2, wc = wid & 3, fr = lane & 15, fq = lane >> 4;
    const int K = g.K, nt = K / BK;
    unsigned voffA[2], voffB[2]; int RR[2], CC[2];
#pragma unroll
    for (int i = 0; i < 2; ++i) { int R, C; stage_rc(tid * 16 + i * 8192, R, C); const int Rb = Epi::PERM ? ((R & ~31) + perm32(R & 31)) : R;
        RR[i] = R; CC[i] = C; voffA[i] = (unsigned)(R * K + C) * 2u; voffB[i] = (unsigned)(Rb * K + C) * 2u; }
    const size_t kstep = (size_t)(BK * 2);
    const size_t hstep = (size_t)HALF * K * 2;
    const size_t tstep = 2 * hstep;
    const unsigned ldsw = (unsigned)wid * 1024u;
    const int aoff = lds_byte(wr * 64 + fr, fq * 8), boff = lds_byte(wc * 32 + fr, fq * 8);
    const char* gA = (const char*)g.A;
    unsigned aoC[2][2] = {{0u, 0u}, {0u, 0u}}, aoN[2][2] = {{0u, 0u}, {0u, 0u}};
#define PG8_SA(b, h) (((b) * 2 + (h)) * HTB)
#define PG8_SB(b, h) ((4 + (b) * 2 + (h)) * HTB)
#define PG8_STAGE(bufoff, gbase, voff) do { _Pragma("unroll") for (int _i = 0; _i < 2; ++_i) \
        __builtin_amdgcn_global_load_lds((const unsigned*)((const char*)(gbase) + (voff)[_i]), (PG8_LAS unsigned*)(lds + (bufoff) + ldsw + _i * 8192), 16, 0, 0); } while (0)
#define PG8_STAGE_A(bufoff, h, PN, KO) do { if constexpr (Sched::GATHER) { _Pragma("unroll") for (int _i = 0; _i < 2; ++_i) \
        __builtin_amdgcn_global_load_lds((const unsigned*)(gA + aoC[h][_i] + (KO)), (PG8_LAS unsigned*)(lds + (bufoff) + ldsw + _i * 8192), 16, 0, 0); } \
        else { PG8_STAGE(bufoff, (PN) + (h) * hstep, voffA); } } while (0)
#define PG8_LDA(dst, b, h) do { _Pragma("unroll") for (int m = 0; m < 4; ++m) _Pragma("unroll") for (int k = 0; k < 2; ++k) dst[m][k] = *(const PG8_LAS bf16x8*)(lds + PG8_SA(b, h) + aoff + m * 2048 + k * 1024); } while (0)
#define PG8_LDB(dst, b, h) do { _Pragma("unroll") for (int n = 0; n < 2; ++n) _Pragma("unroll") for (int k = 0; k < 2; ++k) dst[n][k] = *(const PG8_LAS bf16x8*)(lds + PG8_SB(b, h) + boff + n * 2048 + k * 1024); } while (0)
#define PG8_MMA(ai, bj, At, Bt) do { __builtin_amdgcn_s_setprio(1); _Pragma("unroll") for (int m = 0; m < 4; ++m) _Pragma("unroll") for (int n = 0; n < 2; ++n) _Pragma("unroll") for (int k = 0; k < 2; ++k) \
        acc[ai][bj][m][n] = __builtin_amdgcn_mfma_f32_16x16x32_bf16(Bt[n][k], At[m][k], acc[ai][bj][m][n], 0, 0, 0); __builtin_amdgcn_s_setprio(0); } while (0)
#define PG8_WAIT_V(n) asm volatile("s_waitcnt vmcnt(" #n ")" ::: "memory")
#define PG8_WAIT_L(n) asm volatile("s_waitcnt lgkmcnt(" #n ")" ::: "memory")
#define PG8_BAR __builtin_amdgcn_s_barrier()
#define PG8_SCHED __builtin_amdgcn_sched_barrier(0)
    Unit cur, nxt; int ui = 0;
    if (!S.next(0, cur)) return;
    f32x4 acc[2][2][4][2];
#pragma unroll
    for (int a = 0; a < 2; ++a)
#pragma unroll
        for (int b = 0; b < 2; ++b)
#pragma unroll
            for (int m = 0; m < 4; ++m)
#pragma unroll
                for (int n = 0; n < 2; ++n) acc[a][b][m][n] = (f32x4){0.f, 0.f, 0.f, 0.f};
    bf16x8 At[4][2], B0[2][2], B1[2][2];
    const char* cA = (const char*)g.A + (size_t)cur.pm * tstep; const char* cB = (const char*)g.Bt + (size_t)cur.pn * tstep;
    if constexpr (Sched::GATHER) S.a_offs(cur, RR[0], RR[1], CC[0], CC[1], K, aoC);
    S.a_ready(cur);
    if constexpr (SP2) {
        PG8_STAGE(PG8_SB(0, 0), cB, voffB); PG8_STAGE(PG8_SB(0, 1), cB + hstep, voffB); PG8_STAGE_A(PG8_SA(0, 0), 0, cA, 0); PG8_STAGE_A(PG8_SA(0, 1), 1, cA, 0);
        if (wr == 1) PG8_BAR;
        PG8_WAIT_V(2); PG8_BAR;
        PG8_STAGE(PG8_SB(1, 0), cB + kstep, voffB); PG8_STAGE_A(PG8_SA(1, 0), 0, cA + kstep, kstep); PG8_STAGE(PG8_SB(1, 1), cB + hstep + kstep, voffB);
        PG8_WAIT_V(6); PG8_BAR;
    } else {
        PG8_STAGE(PG8_SB(0, 0), cB, voffB); PG8_STAGE_A(PG8_SA(0, 0), 0, cA, 0); PG8_STAGE(PG8_SB(0, 1), cB + hstep, voffB); PG8_STAGE_A(PG8_SA(0, 1), 1, cA, 0);
        if (wr == 1) PG8_BAR;
        PG8_WAIT_V(4); PG8_BAR;
        PG8_STAGE(PG8_SB(1, 0), cB + kstep, voffB); PG8_STAGE_A(PG8_SA(1, 0), 0, cA + kstep, kstep); PG8_STAGE(PG8_SB(1, 1), cB + hstep + kstep, voffB);
        PG8_WAIT_V(6); PG8_BAR;
    }
    for (;;) {
        const bool has_next = S.next(ui + 1, nxt);
        const char* nA = has_next ? (const char*)g.A + (size_t)nxt.pm * tstep : cA; const char* nB = has_next ? (const char*)g.Bt + (size_t)nxt.pn * tstep : cB;
        if constexpr (Sched::GATHER) {
            if (has_next) S.a_offs(nxt, RR[0], RR[1], CC[0], CC[1], K, aoN);
            else {
#pragma unroll
                for (int h = 0; h < 2; ++h)
#pragma unroll
                    for (int i = 0; i < 2; ++i) aoN[h][i] = aoC[h][i]; }
        }
        for (int t = 0; t < nt; t += 2) {
            const bool last = (t == nt - 2);
            const char* a1 = cA + (size_t)(t + 1) * kstep;
            const char* a2 = last ? nA : cA + (size_t)(t + 2) * kstep; const char* b2 = last ? nB : cB + (size_t)(t + 2) * kstep;
            const char* a3 = a2 + kstep; const char* b3 = b2 + kstep;
            const size_t k1 = (size_t)(t + 1) * kstep, k2 = last ? (size_t)0 : (size_t)(t + 2) * kstep, k3 = k2 + kstep;
            if (last && has_next) S.a_ready(nxt);
            if constexpr (SP2) {
            PG8_LDB(B0, 0, 0); PG8_LDB(B1, 0, 1); PG8_SCHED; PG8_LDA(At, 0, 0); PG8_STAGE_A(PG8_SA(1, 1), 1, a1, k1);
            if constexpr (Sched::GATHER) { if (last) {
#pragma unroll
                for (int h = 0; h < 2; ++h)
#pragma unroll
                    for (int i = 0; i < 2; ++i) aoC[h][i] = aoN[h][i]; } }
            PG8_WAIT_V(8); PG8_WAIT_L(0); PG8_BAR; PG8_MMA(0, 0, At, B0); PG8_MMA(0, 1, At, B1); PG8_BAR; PG8_SCHED;
            PG8_LDA(At, 0, 1); PG8_STAGE(PG8_SB(0, 0), b2, voffB); PG8_STAGE(PG8_SB(0, 1), b2 + hstep, voffB); PG8_STAGE_A(PG8_SA(0, 0), 0, a2, k2);
            PG8_WAIT_V(8); PG8_WAIT_L(0); PG8_BAR; PG8_MMA(1, 0, At, B0); PG8_MMA(1, 1, At, B1); PG8_BAR; PG8_SCHED;
            PG8_LDB(B0, 1, 0); PG8_LDB(B1, 1, 1); PG8_SCHED; PG8_LDA(At, 1, 0); PG8_STAGE_A(PG8_SA(0, 1), 1, a2, k2);
            PG8_WAIT_V(8); PG8_WAIT_L(0); PG8_BAR; PG8_MMA(0, 0, At, B0); PG8_MMA(0, 1, At, B1); PG8_BAR; PG8_SCHED;
            PG8_LDA(At, 1, 1); PG8_STAGE(PG8_SB(1, 0), b3, voffB); PG8_STAGE(PG8_SB(1, 1), b3 + hstep, voffB); PG8_STAGE_A(PG8_SA(1, 0), 0, a3, k3);
            PG8_WAIT_V(8); PG8_WAIT_L(0); PG8_BAR; PG8_MMA(1, 0, At, B0); PG8_MMA(1, 1, At, B1); PG8_BAR; PG8_SCHED;
            } else {
            PG8_LDB(B0, 0, 0); PG8_SCHED; PG8_LDA(At, 0, 0); PG8_STAGE_A(PG8_SA(1, 1), 1, a1, k1);
            if constexpr (Sched::GATHER) { if (last) {
#pragma unroll
                for (int h = 0; h < 2; ++h)
#pragma unroll
                    for (int i = 0; i < 2; ++i) aoC[h][i] = aoN[h][i]; } }
            PG8_WAIT_L(8); PG8_BAR; PG8_WAIT_L(0); PG8_MMA(0, 0, At, B0); PG8_BAR; PG8_SCHED;
            PG8_LDB(B1, 0, 1); PG8_STAGE(PG8_SB(0, 0), b2, voffB);
            PG8_BAR; PG8_WAIT_L(0); PG8_MMA(0, 1, At, B1); PG8_BAR;
            PG8_LDA(At, 0, 1); PG8_STAGE_A(PG8_SA(0, 0), 0, a2, k2);
            PG8_BAR; PG8_WAIT_L(0); PG8_MMA(1, 0, At, B0); PG8_BAR; PG8_SCHED;
            PG8_STAGE(PG8_SB(0, 1), b2 + hstep, voffB);
            PG8_WAIT_V(6); PG8_BAR; PG8_MMA(1, 1, At, B1); PG8_BAR;
            PG8_LDB(B0, 1, 0); PG8_SCHED; PG8_LDA(At, 1, 0); PG8_STAGE_A(PG8_SA(0, 1), 1, a2, k2);
            PG8_WAIT_L(8); PG8_BAR; PG8_WAIT_L(0); PG8_MMA(0, 0, At, B0); PG8_BAR; PG8_SCHED;
            PG8_LDB(B1, 1, 1); PG8_STAGE(PG8_SB(1, 0), b3, voffB);
            PG8_BAR; PG8_WAIT_L(0); PG8_MMA(0, 1, At, B1); PG8_BAR;
            PG8_LDA(At, 1, 1); PG8_STAGE_A(PG8_SA(1, 0), 0, a3, k3);
            PG8_BAR; PG8_WAIT_L(0); PG8_MMA(1, 0, At, B0); PG8_BAR; PG8_SCHED;
            PG8_STAGE(PG8_SB(1, 1), b3 + hstep, voffB);
            PG8_WAIT_V(6); PG8_BAR; PG8_MMA(1, 1, At, B1); PG8_BAR;
            }
        }
        if constexpr (ALIGN_EPI) { if (wr == 0) PG8_BAR; }
        E(acc, cur, wr, wc, fr, fq); S.done(cur);
        if (!has_next) break;
#pragma unroll
        for (int a = 0; a < 2; ++a)
#pragma unroll
            for (int b = 0; b < 2; ++b)
#pragma unroll
                for (int m = 0; m < 4; ++m)
#pragma unroll
                    for (int n = 0; n < 2; ++n) acc[a][b][m][n] = (f32x4){0.f, 0.f, 0.f, 0.f};
        cur = nxt; cA = nA; cB = nB; ++ui;
        if constexpr (ALIGN_EPI) { if (wr == 1) PG8_BAR; }
    }
    PG8_WAIT_V(0);
    if constexpr (!ALIGN_EPI) { if (wr == 0) PG8_BAR; }
    PG8_BAR;
#undef PG8_SA
#undef PG8_SB
#undef PG8_STAGE
#undef PG8_STAGE_A
#undef PG8_LDA
#undef PG8_LDB
#undef PG8_MMA
#undef PG8_WAIT_V
#undef PG8_WAIT_L
#undef PG8_BAR
#undef PG8_SCHED
}
}

#ifndef MK_N_LAUNCHES
#define MK_N_LAUNCHES 1
#endif
constexpr int NWAVES = 8, NTHR = 512;
constexpr int S_ = 16384, D_ = 2048, DEPTH = 2, HD = 128;
constexpr int IN_W = 5656, NIN = 5888;
constexpr int NC = 1023;
constexpr int NEXP = 32, DEXP = 512, ECAP = 16384, NSLOT = 40960;
constexpr float RMS_EPS = 1e-6f;
constexpr float ATT_SCALE = 0.08838834764831845f;
constexpr int NPL = 13, NPH = 2 + 2 * NPL;

constexpr size_t MiB = 1u << 20;
constexpr size_t WS_CTL = 0, CTL_ZERO_BYTES = 1 * MiB;
constexpr size_t WS_ROPE = 1 * MiB, WS_WINT = 9 * MiB, WS_WOUTT = 55 * MiB, WS_WGUT = 71 * MiB, WS_WDT = 327 * MiB, WS_WC1T = 455 * MiB;
constexpr size_t WS_H = 463 * MiB, WS_QN = 527 * MiB, WS_QM = 559 * MiB, WS_KM = 591 * MiB, WS_VM = 623 * MiB;
constexpr size_t WS_KC = 655 * MiB, WS_VC = 663 * MiB, WS_KS = 671 * MiB, WS_VS = 679 * MiB, WS_KW = 687 * MiB, WS_VW = 695 * MiB;
constexpr size_t WS_GATES = 703 * MiB, WS_UL = 705 * MiB, WS_KCMP = 713 * MiB, WS_VCMP = 713 * MiB + 512 * 1024, WS_KMEAN = 714 * MiB;
constexpr size_t WS_OMIX = 715 * MiB, WS_OCMP = 779 * MiB, WS_OWIN = 811 * MiB, WS_SEL = 843 * MiB, WS_TE = 845 * MiB, WS_TOKIDX = 846 * MiB, WS_WTS = 848 * MiB;
constexpr size_t WS_HACT = 850 * MiB, WS_Y = 890 * MiB;
constexpr size_t WS_WRT = 714 * MiB + 256 * 1024;
constexpr size_t WS_IMP = WS_H + 32 * MiB;
constexpr size_t WS_NLIST = WS_H, WS_PSLC = 850 * MiB, WS_LSEN = 1106 * MiB;
constexpr size_t WS_MLIST = 1050 * MiB, WS_PSEL = 1082 * MiB, WS_POWN = 1178 * MiB, WS_LSES = 1210 * MiB, WS_LSEO = 1211 * MiB + 512 * 1024, WS_END = 1212 * MiB;
constexpr int CW_TMO = 0, CW_BAR = 4096, CW_CNT = 8192, CW_MCNT = 8704, CW_NCNT = 9728, CW_MOD = 16384, CW_B1E = 40960;

constexpr int RING_BYTES = 131072, LDSCTL_OFF = RING_BYTES, MISC_OFF = LDSCTL_OFF + 320, MOETAB_OFF = LDSCTL_OFF + 512, LDS_BYTES = 147456;

#define GAS __attribute__((address_space(1)))
#define LAS __attribute__((address_space(3)))
typedef unsigned short bf16;
typedef unsigned v4u __attribute__((ext_vector_type(4)));
typedef float f32x4 __attribute__((ext_vector_type(4)));
typedef float f32x2 __attribute__((ext_vector_type(2)));
typedef GAS unsigned gu32;
#define RLX_AGENT __ATOMIC_RELAXED, __HIP_MEMORY_SCOPE_AGENT
#define LDS_WAIT() asm volatile("s_waitcnt lgkmcnt(0)" ::: "memory")
__device__ __forceinline__ unsigned f2bf(float f) { unsigned u = __builtin_bit_cast(unsigned, f); return (u + 0x7fffu + ((u >> 16) & 1u)) >> 16; }
__device__ __forceinline__ unsigned pk2(float lo, float hi) { return f2bf(lo) | (f2bf(hi) << 16); }
__device__ __forceinline__ float bf2f(unsigned b) { return __builtin_bit_cast(float, b << 16); }
__device__ __forceinline__ float bflo(unsigned w) { return __builtin_bit_cast(float, w << 16); }
__device__ __forceinline__ float bfhi(unsigned w) { return __builtin_bit_cast(float, w & 0xffff0000u); }

#define XB_TMO      128
#define XB_XCNT(j)  (256  + 64 * (j))
#define XB_XSUB(j)  (1280 + 64 * (j))
#define XB_XGEN(j)  (2304 + 64 * (j))
#define XB_TOP      3328
#define XB_TOPGEN   3392
#define XCD_BAR_WORDS 3456
#define XB_SPIN_CAP (1u << 20)
__device__ __forceinline__ unsigned xb_ld(unsigned* p)              { return __hip_atomic_load(p, __ATOMIC_RELAXED, __HIP_MEMORY_SCOPE_AGENT); }
__device__ __forceinline__ unsigned xb_add(unsigned* p, unsigned v) { return __hip_atomic_fetch_add(p, v, __ATOMIC_RELAXED, __HIP_MEMORY_SCOPE_AGENT); }
__device__ __forceinline__ unsigned xb_xcc_id() { return (unsigned)__builtin_amdgcn_s_getreg((3 << 11) | 20) & 0xFu; }
#define XB_SPIN(cond, bar) do { unsigned _sp = 0; while (cond) { __builtin_amdgcn_s_sleep(1); \
    if ((++_sp & 255u) == 0u) { if (xb_ld(&(bar)[XB_TMO])) break; if (_sp > XB_SPIN_CAP) { atomicAdd(&(bar)[XB_TMO], 1u); break; } } } } while (0)
struct XcdBarrier { unsigned* bar; unsigned x; volatile LAS unsigned* st; };
__device__ __forceinline__ XcdBarrier xcd_barrier_post(unsigned* bar, volatile LAS unsigned* st) {
    XcdBarrier b; b.bar = bar; b.x = xb_xcc_id(); b.st = st;
    if (threadIdx.x == 0) (void)xb_add(&bar[XB_XCNT(b.x)], 1u);
    return b;
}
__device__ __forceinline__ void xcd_barrier_complete(unsigned* bar, unsigned x, unsigned& nloc, unsigned& nx) {
    const unsigned G = gridDim.x * gridDim.y * gridDim.z;
    unsigned sum, cnt, mine, sp = 0u;
    for (;;) {
        sum = 0u; cnt = 0u; mine = 0u;
#pragma unroll
        for (unsigned j = 0; j < 16; ++j) { const unsigned c = xb_ld(&bar[XB_XCNT(j)]); sum += c; cnt += (c > 0u) ? 1u : 0u; mine = (j == x) ? c : mine; }
        if (sum == G) break;
        __builtin_amdgcn_s_sleep(1);
        if ((++sp & 255u) == 0u) { if (xb_ld(&bar[XB_TMO])) break; if (sp > XB_SPIN_CAP) { atomicAdd(&bar[XB_TMO], 1u); break; } }
    }
    nloc = mine > 0u ? mine : 1u; nx = cnt > 0u ? cnt : 1u;
}
__device__ __forceinline__ void xcd_barrier(const XcdBarrier& b, bool leader  ) {
    asm volatile("s_waitcnt vmcnt(0)" ::: "memory");
    __syncthreads();
    if (leader) {
        unsigned* bar = b.bar;
        __builtin_amdgcn_s_waitcnt(0);
        unsigned nloc = b.st[0], nx = b.st[1];
        if (nloc == 0u) { xcd_barrier_complete(bar, b.x, nloc, nx); b.st[0] = nloc; b.st[1] = nx; }
        const unsigned old = xb_add(&bar[XB_XSUB(b.x)], 1u);
        const unsigned gen = old / nloc;
        if (old + 1u == (gen + 1u) * nloc) {
            __builtin_amdgcn_fence(__ATOMIC_RELEASE, "agent");
            asm volatile("s_waitcnt vmcnt(0)" ::: "memory");
            const unsigned og = xb_add(&bar[XB_TOP], 1u);
            const unsigned tg = og / nx;
            if (og + 1u == (tg + 1u) * nx) xb_add(&bar[XB_TOPGEN], 1u);
            else XB_SPIN(xb_ld(&bar[XB_TOPGEN]) == tg, bar);
            __builtin_amdgcn_fence(__ATOMIC_ACQUIRE, "agent");
            xb_add(&bar[XB_XGEN(b.x)], 1u);
            asm volatile("s_waitcnt vmcnt(0)" ::: "memory");
        } else {
            XB_SPIN(xb_ld(&bar[XB_XGEN(b.x)]) == gen, bar);
            __builtin_amdgcn_fence(__ATOMIC_ACQUIRE, "agent");
            asm volatile("s_waitcnt vmcnt(0)" ::: "memory");
        }
    }
    __syncthreads();
}

__device__ __forceinline__ float lane_get(float v, int src) { return __builtin_bit_cast(float, __builtin_amdgcn_ds_bpermute(src << 2, __builtin_bit_cast(int, v))); }
__device__ __forceinline__ int lane_geti(int v, int src) { return __builtin_amdgcn_ds_bpermute(src << 2, v); }
__device__ __forceinline__ float wave_sum(float v, int lane) {
#pragma unroll
    for (int o = 1; o < 64; o <<= 1) v += lane_get(v, lane ^ o);
    return v;
}
__device__ __forceinline__ int block_excl_scan(int v, LAS int* scr, int tid, int* tot) {
    const int lane = tid & 63, wv = tid >> 6; int s = v;
#pragma unroll
    for (int o = 1; o < 64; o <<= 1) { const int n = lane_geti(s, lane - o); if (lane >= o) s += n; }
    if (lane == 63) scr[wv] = s;
    __syncthreads();
    int off = 0, all = 0;
#pragma unroll
    for (int w = 0; w < 8; ++w) { const int x = scr[w]; all += x; off += (w < wv) ? x : 0; }
    *tot = all;
    __syncthreads();
    return off + s - v;
}

__device__ __forceinline__ float row_max16(float v) {
    v = fmaxf(v, __builtin_bit_cast(float, __builtin_amdgcn_update_dpp(0, __builtin_bit_cast(int, v), 0xB1, 0xF, 0xF, false)));
    v = fmaxf(v, __builtin_bit_cast(float, __builtin_amdgcn_update_dpp(0, __builtin_bit_cast(int, v), 0x4E, 0xF, 0xF, false)));
    v = fmaxf(v, __builtin_bit_cast(float, __builtin_amdgcn_update_dpp(0, __builtin_bit_cast(int, v), 0x124, 0xF, 0xF, false)));
    v = fmaxf(v, __builtin_bit_cast(float, __builtin_amdgcn_update_dpp(0, __builtin_bit_cast(int, v), 0x128, 0xF, 0xF, false)));
    return v;
}
__device__ __forceinline__ int row_min16(int v) {
    v = min(v, __builtin_amdgcn_update_dpp(0, v, 0xB1, 0xF, 0xF, false));
    v = min(v, __builtin_amdgcn_update_dpp(0, v, 0x4E, 0xF, 0xF, false));
    v = min(v, __builtin_amdgcn_update_dpp(0, v, 0x124, 0xF, 0xF, false));
    v = min(v, __builtin_amdgcn_update_dpp(0, v, 0x128, 0xF, 0xF, false));
    return v;
}
template <int NV>
__device__ __forceinline__ int row_pick(float (&v)[NV], int lam) {
    float m = v[0];
#pragma unroll
    for (int i = 1; i < NV; ++i) m = fmaxf(m, v[i]);
    m = row_max16(m);
    int idx = 1 << 20;
#pragma unroll
    for (int i = NV - 1; i >= 0; --i) idx = (v[i] == m) ? lam + 16 * i : idx;
    idx = row_min16(idx);
    if (m == -INFINITY) idx = -1;
#pragma unroll
    for (int i = 0; i < NV; ++i) v[i] = (lam + 16 * i == idx) ? -INFINITY : v[i];
    return idx;
}

__device__ __forceinline__ int il(int d) { return (d < 64) ? 2 * d : 2 * (d - 64) + 1; }
__device__ __forceinline__ int inproj_row(int s) {
    if (s < 1024) return (s & ~127) + il(s & 127);
    if (s < 1536) return s;
    if (s < 1792) return (s & ~127) + il(s & 127);
    if (s < 2048) return s;
    if (s < 2304) return (s & ~127) + il(s & 127);
    if (s < 2560) return s;
    if (s < 2584) return 5632 + (s - 2560);
    if (s < 3608) { const int r = s - 2584; return 2560 + (r & ~127) + il(r & 127); }
    if (s < 4632) { const int r = s - 3608; return 3584 + (r & ~127) + il(r & 127); }
    return 4608 + (s - 4632);
}
template <int MODE>
__device__ __forceinline__ void transpose_item(const float* W, int K, int N, bf16* WT, int dpitch, int row_off, LAS float* scr, int item, int lane) {
    const int nblk = (N + 31) / 32, kb = item / nblk, nb = item % nblk, k0 = 64 * kb, n0 = 32 * nb;
    const int nsrc = n0 + (lane & 31);
#pragma unroll 8
    for (int i = 0; i < 32; ++i) { const int kk = 2 * i + (lane >> 5); scr[kk * 33 + (lane & 31)] = (nsrc < N) ? W[(size_t)(k0 + kk) * N + nsrc] : 0.f; }
    LDS_WAIT(); asm volatile("" ::: "memory");
    const int c = lane & 7;
#pragma unroll
    for (int j = 0; j < 4; ++j) { const int nl = (lane >> 3) + 8 * j, n = n0 + nl; const LAS float* s = scr + (8 * c) * 33 + nl;
        v4u o; o.x = pk2(s[0 * 33], s[1 * 33]); o.y = pk2(s[2 * 33], s[3 * 33]); o.z = pk2(s[4 * 33], s[5 * 33]); o.w = pk2(s[6 * 33], s[7 * 33]);
        if (n < N) { int dr;
            if (MODE == 0) dr = n; else if (MODE == 1) dr = inproj_row(n); else if (MODE == 2) dr = (n >> 7) * 256 + (n & 127); else dr = (n >> 7) * 256 + 128 + (n & 127);
            *(GAS v4u*)(WT + (size_t)(row_off + dr) * dpitch + k0 + 8 * c) = o; } }
    LDS_WAIT(); asm volatile("" ::: "memory");
}

using pg8::Unit;
struct EpiInProj {
    static constexpr bool PERM = true;
    bf16 *QN, *KC, *VC, *KS, *VS, *KW, *VW, *QM, *KM, *VM; float* GATES; const float* rope;
    __device__ __forceinline__ void operator()(const f32x4 (&acc)[2][2][4][2], const Unit& u, int wr, int wc, int fr, int fq) const {
        const int pn = u.pn, row0 = u.pm * 256 + wr * 64 + fr, c8 = wc * 32 + 8 * fq;
        if (pn == 22) {
            if (c8 < 24) {
#pragma unroll
                for (int ai = 0; ai < 2; ++ai)
#pragma unroll
                    for (int m = 0; m < 4; ++m) { const int row = row0 + ai * 128 + m * 16; float* gp = GATES + (size_t)row * 32 + c8;
                        f32x4 a = acc[ai][0][m][0], b = acc[ai][0][m][1], ga, gb;
#pragma unroll
                        for (int j = 0; j < 4; ++j) { ga[j] = 1.f / (1.f + __expf(-a[j])); gb[j] = 1.f / (1.f + __expf(-b[j])); }
                        *(f32x4*)gp = ga; *(f32x4*)(gp + 4) = gb; }
            }
            return;
        }
        bf16* base; int pitch; size_t bjs; bool rot;
        if (pn < 4)       { base = QN + pn * 256;        pitch = 1024; bjs = 128; rot = true; }
        else if (pn == 4) { base = KC;                   pitch = 128;  bjs = (size_t)S_ * 128; rot = false; }
        else if (pn == 5) { base = VC;                   pitch = 128;  bjs = (size_t)S_ * 128; rot = false; }
        else if (pn == 6) { base = KS;                   pitch = 256;  bjs = 128; rot = true; }
        else if (pn == 7) { base = VS;                   pitch = 256;  bjs = 128; rot = false; }
        else if (pn == 8) { base = KW;                   pitch = 256;  bjs = 128; rot = true; }
        else if (pn == 9) { base = VW;                   pitch = 256;  bjs = 128; rot = false; }
        else if (pn < 14) { base = QM + (pn - 10) * 256; pitch = 1024; bjs = 128; rot = true; }
        else if (pn < 18) { base = KM + (pn - 14) * 256; pitch = 1024; bjs = 128; rot = true; }
        else              { base = VM + (pn - 18) * 256; pitch = 1024; bjs = 128; rot = false; }
#pragma unroll
        for (int ai = 0; ai < 2; ++ai)
#pragma unroll
            for (int m = 0; m < 4; ++m) { const int row = row0 + ai * 128 + m * 16;
                f32x4 t0 = (f32x4){1.f, 0.f, 1.f, 0.f}, t1 = t0;
                if (rot) { const f32x4* tp = (const f32x4*)(rope + (size_t)row * 128 + (c8 >> 1) * 2); t0 = tp[0]; t1 = tp[1]; }
#pragma unroll
                for (int bj = 0; bj < 2; ++bj) { f32x4 v0 = acc[ai][bj][m][0], v1 = acc[ai][bj][m][1];
                    if (rot) { f32x4 w0, w1;
                        w0[0] = v0[0] * t0[0] - v0[1] * t0[1]; w0[1] = v0[1] * t0[0] + v0[0] * t0[1]; w0[2] = v0[2] * t0[2] - v0[3] * t0[3]; w0[3] = v0[3] * t0[2] + v0[2] * t0[3];
                        w1[0] = v1[0] * t1[0] - v1[1] * t1[1]; w1[1] = v1[1] * t1[0] + v1[0] * t1[1]; w1[2] = v1[2] * t1[2] - v1[3] * t1[3]; w1[3] = v1[3] * t1[2] + v1[2] * t1[3];
                        v0 = w0; v1 = w1; }
                    pg8::u32x4 w; w.x = pg8::cvt_pk_bf16(v0[0], v0[1]); w.y = pg8::cvt_pk_bf16(v0[2], v0[3]); w.z = pg8::cvt_pk_bf16(v1[0], v1[1]); w.w = pg8::cvt_pk_bf16(v1[2], v1[3]);
                    *(pg8::u32x4*)(base + (size_t)row * pitch + bj * bjs + c8) = w; } }
    }
};
struct EpiOutProj {
    static constexpr bool PERM = false;
    const float* xsrc; float* X; const float* gt; float* SSP;
    __device__ __forceinline__ void operator()(const f32x4 (&acc)[2][2][4][2], const Unit& u, int wr, int wc, int fr, int fq) const {
        const int row0 = u.pm * 256 + wr * 64 + fr, col0 = u.pnl * 256 + wc * 32 + 4 * fq, lane = fq * 16 + fr;
        f32x4 gv[2][2];
#pragma unroll
        for (int bj = 0; bj < 2; ++bj)
#pragma unroll
            for (int n = 0; n < 2; ++n) gv[bj][n] = *(const f32x4*)(gt + col0 + bj * 128 + n * 16);
#pragma unroll
        for (int ai = 0; ai < 2; ++ai)
#pragma unroll
            for (int m = 0; m < 4; ++m) { const int row = row0 + ai * 128 + m * 16; const size_t ro = (size_t)row * D_ + col0; float ss = 0.f;
#pragma unroll
                for (int bj = 0; bj < 2; ++bj)
#pragma unroll
                    for (int n = 0; n < 2; ++n) { const f32x4 xv = *(const f32x4*)(xsrc + ro + bj * 128 + n * 16); const f32x4 y = xv + gv[bj][n] * acc[ai][bj][m][n]; *(f32x4*)(X + ro + bj * 128 + n * 16) = y;
                        ss += (y[0] * y[0] + y[1] * y[1]) + (y[2] * y[2] + y[3] * y[3]); }
                ss += __builtin_bit_cast(float, __builtin_amdgcn_ds_bpermute((lane ^ 16) << 2, __builtin_bit_cast(int, ss)));
                ss += __builtin_bit_cast(float, __builtin_amdgcn_ds_bpermute((lane ^ 32) << 2, __builtin_bit_cast(int, ss)));
                if (fq == 0) SSP[(size_t)row * 32 + u.pnl * 4 + wc] = ss; }
    }
};
struct EpiF32 {
    static constexpr bool PERM = false;
    float* C; int ldc;
    __device__ __forceinline__ void operator()(const f32x4 (&acc)[2][2][4][2], const Unit& u, int wr, int wc, int fr, int fq) const {
        const int row0 = u.pm * 256 + wr * 64 + fr, col0 = u.pnl * 256 + wc * 32 + 4 * fq;
#pragma unroll
        for (int ai = 0; ai < 2; ++ai)
#pragma unroll
            for (int m = 0; m < 4; ++m) { float* rowp = C + (size_t)(row0 + ai * 128 + m * 16) * ldc + col0;
#pragma unroll
                for (int bj = 0; bj < 2; ++bj)
#pragma unroll
                    for (int n = 0; n < 2; ++n) *(f32x4*)(rowp + bj * 128 + n * 16) = acc[ai][bj][m][n]; }
    }
};
struct EpiGateUp {
    static constexpr bool PERM = true;
    bf16* HACT;
    __device__ __forceinline__ void operator()(const f32x4 (&acc)[2][2][4][2], const Unit& u, int wr, int wc, int fr, int fq) const {
        const int row0 = u.pm * 256 + wr * 64 + fr, col0 = u.pnl * 128 + wc * 32 + 8 * fq;
#pragma unroll
        for (int ai = 0; ai < 2; ++ai)
#pragma unroll
            for (int m = 0; m < 4; ++m) { const int row = row0 + ai * 128 + m * 16; f32x4 h[2];
#pragma unroll
                for (int n = 0; n < 2; ++n)
#pragma unroll
                    for (int j = 0; j < 4; ++j) { const float gg = acc[ai][0][m][n][j], uu = acc[ai][1][m][n][j]; h[n][j] = gg / (1.f + __expf(-gg)) * uu; }
                pg8::u32x4 w; w.x = pg8::cvt_pk_bf16(h[0][0], h[0][1]); w.y = pg8::cvt_pk_bf16(h[0][2], h[0][3]); w.z = pg8::cvt_pk_bf16(h[1][0], h[1][1]); w.w = pg8::cvt_pk_bf16(h[1][2], h[1][3]);
                *(pg8::u32x4*)(HACT + (size_t)row * DEXP + col0) = w; }
    }
};
struct EpiDown {
    static constexpr bool PERM = true;
    bf16* Y; const float* WTS; const LAS int* tab;
    __device__ __forceinline__ void operator()(const f32x4 (&acc)[2][2][4][2], const Unit& u, int wr, int wc, int fr, int fq) const {
        const int rl0 = wr * 64 + fr, col0 = u.pnl * 256 + wc * 32 + 8 * fq, cnt = tab[u.e];
#pragma unroll
        for (int ai = 0; ai < 2; ++ai)
#pragma unroll
            for (int m = 0; m < 4; ++m) { const int rl = rl0 + ai * 128 + m * 16, pos = u.mt * 256 + rl;
                const float w = (pos < cnt) ? WTS[(size_t)u.e * ECAP + pos] : 0.f;
                bf16* rowp = Y + (size_t)(u.pm * 256 + rl) * D_ + col0;
#pragma unroll
                for (int bj = 0; bj < 2; ++bj) { const f32x4 v0 = acc[ai][bj][m][0] * w, v1 = acc[ai][bj][m][1] * w;
                    pg8::u32x4 o; o.x = pg8::cvt_pk_bf16(v0[0], v0[1]); o.y = pg8::cvt_pk_bf16(v0[2], v0[3]); o.z = pg8::cvt_pk_bf16(v1[0], v1[1]); o.w = pg8::cvt_pk_bf16(v1[2], v1[3]);
                    *(pg8::u32x4*)(rowp + bj * 128) = o; } }
    }
};

struct CompressOrder {
    static constexpr bool GATHER = false;
    int G, c;
    __device__ bool next(int i, Unit& u) const { const int L = i * G + c; if (L >= 32) return false; u.pm = L >> 1; u.pnl = L & 1; u.pn = (u.pm >= 8 ? 2 : 0) + u.pnl; u.e = 0; u.mt = 0; return true; }
    __device__ __forceinline__ void a_offs(const Unit&, int, int, int, int, int, unsigned (&)[2][2]) const {}
    __device__ __forceinline__ void a_ready(const Unit&) const {}
    __device__ __forceinline__ void done(const Unit&) const {}
};
template <bool GATHER_>
struct MoeOrder {
    static constexpr bool GATHER = GATHER_;
    const LAS int* tab; int NT, G, c, bt_per_e, bt_base; const int* tokidx;
    __device__ bool next(int i, Unit& u) const {
        const int L = i * G + c; if (L >= tab[64]) return false;
        int e = 0;
        for (int k = 1; k < NEXP; ++k) e += (L >= tab[32 + k]) ? 1 : 0;
        e = __builtin_amdgcn_readfirstlane(e);
        const int r = L - tab[32 + e];
        u.e = e; u.mt = r / NT; u.pnl = r % NT; u.pn = bt_base + e * bt_per_e + u.pnl; u.pm = (tab[65 + e] >> 8) + u.mt; return true;
    }
    __device__ __forceinline__ void a_offs(const Unit& u, int R0, int R1, int C0, int C1, int K, unsigned (&o)[2][2]) const {
        const int cnt = tab[u.e]; const int* tk = tokidx + (size_t)u.e * ECAP;
#pragma unroll
        for (int h = 0; h < 2; ++h) {
            int p0 = u.mt * 256 + h * 128 + R0, p1 = u.mt * 256 + h * 128 + R1; p0 = p0 < cnt ? p0 : cnt - 1; p1 = p1 < cnt ? p1 : cnt - 1;
            o[h][0] = ((unsigned)tk[p0] * (unsigned)K + (unsigned)C0) * 2u; o[h][1] = ((unsigned)tk[p1] * (unsigned)K + (unsigned)C1) * 2u; }
    }
    __device__ __forceinline__ void a_ready(const Unit&) const {}
    __device__ __forceinline__ void done(const Unit&) const {}
};

namespace att {
constexpr int D = 128, NW = 8, QBLK = 32, KVBLK = 64, QB = NW * QBLK;
constexpr int SHM_V = KVBLK * D * 2, SHM_K = KVBLK * D * 2;
constexpr int OFF_WS = 2 * SHM_V + 2 * SHM_K, OFF_OT = OFF_WS + NW * 64 * 4, LDS_BYTES = OFF_OT + NW * 32 * 4;
constexpr int OFF_ST = 73728, ST_ROW = 272, ST_WAVE = 16 * ST_ROW;
constexpr float SCALE = 0.08838834764831845f, THR = 8.f;
typedef short bf16x8 __attribute__((ext_vector_type(8)));
typedef short s16x4 __attribute__((ext_vector_type(4)));
typedef float f32x16 __attribute__((ext_vector_type(16)));
typedef float f32x4 __attribute__((ext_vector_type(4)));
typedef unsigned u32x4 __attribute__((ext_vector_type(4)));
typedef unsigned short bf16;
#define KSWZ(row, colB) ((row) * 256 + ((colB) ^ (((row) & 7) << 4)))
#define SBAR() __builtin_amdgcn_sched_barrier(0)
__device__ __forceinline__ int v_st(int k, int c) { const int kk = (k & ~0xC) | ((k & 4) << 1) | ((k & 8) >> 1); return ((kk >> 3) * 4 + (c >> 5)) * 512 + ((kk & 7) * 32 + (c & 31)) * 2; }
__device__ __forceinline__ int v_rd_base(int lane) { return ((lane & 3) << 3) | (((lane >> 2) & 3) << 6) | (((lane >> 4) & 1) << 5) | (((lane >> 5) & 1) << 8); }
constexpr int v_rd_off(int d0, int ks, int half) { return d0 * 512 + ks * 4096 + half * 2048; }
__device__ __forceinline__ int crow(int r, int hi) { return (r & 3) + 8 * (r >> 2) + 4 * hi; }
__device__ __forceinline__ unsigned cvtpk(float lo, float hi) { unsigned r; asm volatile("v_cvt_pk_bf16_f32 %0, %1, %2" : "=v"(r) : "v"(lo), "v"(hi)); return r; }
__device__ __forceinline__ bf16x8 load8(const bf16* p) { return *reinterpret_cast<const bf16x8*>(p); }
__device__ __forceinline__ void mask_tile(f32x16& p0, f32x16& p1, int dq, unsigned W) {
    const float NEG = -__builtin_inff();
#pragma unroll
    for (int r = 0; r < 16; ++r) {
        const int c = (r & 3) + 8 * (r >> 2);
        if ((unsigned)(dq - c) >= W) p0[r] = NEG;
        if ((unsigned)(dq - c - 32) >= W) p1[r] = NEG;
    }
}
__device__ __forceinline__ void partialSM(f32x16& p0, f32x16& p1, float& m_reg, float& mn, float& alpha) {
    float pmax = p0[0]; for (int r = 1; r < 16; ++r) pmax = fmaxf(pmax, p0[r]); for (int r = 0; r < 16; ++r) pmax = fmaxf(pmax, p1[r]);
    { auto rr = __builtin_amdgcn_permlane32_swap(__float_as_uint(pmax), __float_as_uint(pmax), false, false);
      pmax = fmaxf(__uint_as_float(rr[0]), __uint_as_float(rr[1])); }
    constexpr float C2 = 1.4426950408889634f * SCALE;
    if (__builtin_expect(__all((pmax - m_reg) * SCALE <= THR), 1)) { mn = m_reg; alpha = 1.f; }
    else { mn = fmaxf(m_reg, pmax); alpha = __builtin_amdgcn_exp2f((m_reg - mn) * C2); m_reg = mn; }
    const float mnL = -mn * C2;
    for (int r = 0; r < 16; ++r) p0[r] = fmaf(p0[r], C2, mnL); for (int r = 0; r < 16; ++r) p1[r] = fmaf(p1[r], C2, mnL);
    for (int r = 0; r < 16; ++r) p0[r] = __builtin_amdgcn_exp2f(p0[r]);
}
__device__ __forceinline__ void finishSM(f32x16& p0, f32x16& p1, float alpha, float& l_reg, bf16x8& pa0, bf16x8& pa1, bf16x8& pa2, bf16x8& pa3) {
    for (int r = 0; r < 16; ++r) p1[r] = __builtin_amdgcn_exp2f(p1[r]);
    float ps = 0; for (int r = 0; r < 16; ++r) ps += p0[r]; for (int r = 0; r < 16; ++r) ps += p1[r];
    { auto rr = __builtin_amdgcn_permlane32_swap(__float_as_uint(ps), __float_as_uint(ps), false, false);
      ps = __uint_as_float(rr[0]) + __uint_as_float(rr[1]); }
    l_reg = l_reg * alpha + ps;
#define PK4(P, B_, OUT) do { unsigned a0 = cvtpk(P[B_+0], P[B_+1]), a1 = cvtpk(P[B_+2], P[B_+3]);                          \
        unsigned b0 = cvtpk(P[B_+4], P[B_+5]), b1 = cvtpk(P[B_+6], P[B_+7]);                                             \
        auto r0 = __builtin_amdgcn_permlane32_swap(a0, b0, false, false); auto r1 = __builtin_amdgcn_permlane32_swap(a1, b1, false, false); \
        u32x4 w = {r0[0], r1[0], r0[1], r1[1]}; OUT = *reinterpret_cast<bf16x8*>(&w); } while (0)
    PK4(p0, 0, pa0); PK4(p0, 8, pa1); PK4(p1, 0, pa2); PK4(p1, 8, pa3);
#undef PK4
}
template <int KB, bool SK>
__device__ __forceinline__ void qkt(f32x16& p0, f32x16& p1, const char* K_lds, int r32, int hi, const bf16x8* qr, bool act) {
    if (SK && !act) { const float NEG = -__builtin_inff();
#pragma unroll
        for (int r = 0; r < 16; ++r) { p0[r] = NEG; p1[r] = NEG; } return; }
    p0 = f32x16{}; p1 = f32x16{};
    const char* kb[4];
#pragma unroll
    for (int dd = 0; dd < 4; ++dd) kb[dd] = K_lds + KB * SHM_K + KSWZ(r32, (dd * 16 + hi * 8) * 2);
#pragma unroll
    for (int d0 = 0; d0 < 8; ++d0) { const char* a = kb[d0 & 3] + (d0 >> 2) * 128;
        bf16x8 b0 = *reinterpret_cast<const bf16x8*>(a);
        bf16x8 b1 = *reinterpret_cast<const bf16x8*>(a + 32 * 256);
        p0 = __builtin_amdgcn_mfma_f32_32x32x16_bf16(b0, qr[d0], p0, 0, 0, 0);
        p1 = __builtin_amdgcn_mfma_f32_32x32x16_bf16(b1, qr[d0], p1, 0, 0, 0); }
}
template <int VB, bool SK>
__device__ __forceinline__ void pv_tile(f32x16* o, int vb0, bf16x8 pa0, bf16x8 pa1, bf16x8 pa2, bf16x8 pa3, bool act) {
    if (SK && !act) return;
#define TRRD(dst, off) asm volatile("ds_read_b64_tr_b16 %0, %1 offset:%2" : "=&v"(dst) : "v"(vb0), "i"(off) : "memory")
#define PV_D0(d0) do { s16x4 l0, l1, l2, l3, h0, h1, h2, h3; constexpr int b_ = VB * SHM_V + v_rd_off(d0, 0, 0); \
        TRRD(l0, b_); TRRD(h0, b_ + 2048); TRRD(l1, b_ + 4096); TRRD(h1, b_ + 6144); TRRD(l2, b_ + 8192); TRRD(h2, b_ + 10240); TRRD(l3, b_ + 12288); TRRD(h3, b_ + 14336); \
        asm volatile("s_waitcnt lgkmcnt(0)" ::: "memory"); SBAR();   \
        o[d0] = __builtin_amdgcn_mfma_f32_32x32x16_bf16(pa0, (bf16x8){l0[0], l0[1], l0[2], l0[3], h0[0], h0[1], h0[2], h0[3]}, o[d0], 0, 0, 0);   \
        o[d0] = __builtin_amdgcn_mfma_f32_32x32x16_bf16(pa1, (bf16x8){l1[0], l1[1], l1[2], l1[3], h1[0], h1[1], h1[2], h1[3]}, o[d0], 0, 0, 0);   \
        o[d0] = __builtin_amdgcn_mfma_f32_32x32x16_bf16(pa2, (bf16x8){l2[0], l2[1], l2[2], l2[3], h2[0], h2[1], h2[2], h2[3]}, o[d0], 0, 0, 0);   \
        o[d0] = __builtin_amdgcn_mfma_f32_32x32x16_bf16(pa3, (bf16x8){l3[0], l3[1], l3[2], l3[3], h3[0], h3[1], h3[2], h3[3]}, o[d0], 0, 0, 0); } while (0)
    PV_D0(0); PV_D0(1); PV_D0(2); PV_D0(3);
#undef PV_D0
#undef TRRD
}
struct Ref { const bf16* Q; const bf16* K; const bf16* V; bf16* O; const int* list; int kpitch, j_lo, j_hi, P0, W, a0, a1; };
struct Seam { bf16x8 qr[8]; bf16x8 st_v0, st_v1, st_k0, st_k1; };
#define ROW(p, kp, k0, rr) ((p) + (size_t)((k0) + (rr)) * (kp) + sc)
#define VMW() asm volatile("s_waitcnt vmcnt(0)" ::: "memory")
#define VMWN(n) asm volatile("s_waitcnt vmcnt(%0)" :: "i"(n) : "memory")
#define SLOAD_H(Kp, Vp, kp, k0) do { S.st_v0 = load8(ROW(Vp, kp, k0, sr)); S.st_v1 = load8(ROW(Vp, kp, k0, 32 + sr));              \
                         S.st_k0 = load8(ROW(Kp, kp, k0, sr)); S.st_k1 = load8(ROW(Kp, kp, k0, 32 + sr)); } while (0)
#define SWRITE_HK(bf) do { *(bf16x8*)(K_lds + (bf) * SHM_K + kws) = S.st_k0; *(bf16x8*)(K_lds + (bf) * SHM_K + kws + 32 * 256) = S.st_k1; } while (0)
#define SWRITE_HV(bf) do { *(bf16x8*)(V_lds + (bf) * SHM_V + vst0) = S.st_v0; *(bf16x8*)(V_lds + (bf) * SHM_V + vst1) = S.st_v1; } while (0)
#define SWRITE_H(bf) do { SWRITE_HV(bf); SWRITE_HK(bf); } while (0)
template <class RF>
__device__ __forceinline__ void prime(const Ref& cur, char* lds, Seam& S) {
    const int tid_ = wg_tid((const __attribute__((address_space(3))) int*)(uintptr_t)(unsigned)(uintptr_t)(lds + WIDTAB_OFF));
    const int tid = tid_, wid = __builtin_amdgcn_readfirstlane(tid >> 6), lane = tid & 63, r32 = lane & 31, hi = lane >> 5;
    const int sr = tid >> 4, sc = (tid & 15) * 8, kws = KSWZ(sr, sc * 2); char* K_lds = lds + 2 * SHM_V;
    const int kb0 = cur.j_lo * KVBLK;
    { const bf16* qrow = cur.Q + RF::q_off(cur, wid * QBLK + r32, RF::entry(cur, wid * QBLK + r32));
      for (int d0 = 0; d0 < 8; ++d0) S.qr[d0] = load8(qrow + d0 * 16 + hi * 8); }
    SLOAD_H(cur.K, cur.V, cur.kpitch, kb0); VMW(); SWRITE_HK(0);
    __syncthreads();
}
template <int MODE, bool WSKIP, class RF, bool O8 = false, bool ONE = false>
__device__ __forceinline__ void block(const Ref& cur, const Ref& nxt, float* LSE, char* lds, Seam& S, float* lse_lane = nullptr) {
    const int tid_ = wg_tid((const __attribute__((address_space(3))) int*)(uintptr_t)(unsigned)(uintptr_t)(lds + WIDTAB_OFF));
    const int tid = tid_, wid = __builtin_amdgcn_readfirstlane(tid >> 6), lane = tid & 63, r32 = lane & 31, hi = lane >> 5;
    const int j_lo = cur.j_lo, NT = cur.j_hi - cur.j_lo;
    const int kbn = nxt.j_lo * KVBLK;
    const int W = cur.W;
    const int qlo = cur.P0 + wid * QBLK;
    const int e_cur = RF::entry(cur, wid * QBLK + r32), e_nxt = RF::entry(nxt, wid * QBLK + r32);
    const int qm = (MODE == 2 ? RF::pos(cur, wid * QBLK + r32, e_cur) : qlo + r32) - 4 * hi;
    const unsigned Wm = (MODE == 2) ? (unsigned)RF::Wl(cur, wid * QBLK + r32) : (unsigned)W;
    char* V_lds = lds; char* K_lds = lds + 2 * SHM_V;
    float* ws = (float*)(lds + OFF_WS) + wid * 64; float* li_l = ws, * al_l = ws + 32; int* ot_l = (int*)(lds + OFF_OT) + wid * 32;
    float m_reg = -1e30f, l_reg = 0; f32x16 o[4] = {};
    const int sr = tid >> 4, sc = (tid & 15) * 8, vst0 = v_st(sr, sc), vst1 = v_st(32 + sr, sc), kws = KSWZ(sr, sc * 2);
    const int vb0 = (int)(uintptr_t)V_lds + v_rd_base(lane);
    const bf16* Kh = cur.K; const bf16* Vh = cur.V; const int kp = cur.kpitch;
#define RESC(a) do { if (__any((a) < 1.f)) { if (hi == 0) al_l[r32] = (a); asm volatile("s_waitcnt lgkmcnt(0)" ::: "memory");              \
                     for (int d_ = 0; d_ < 4; ++d_) for (int r = 0; r < 16; ++r) o[d_][r] *= al_l[crow(r, hi)]; } } while (0)
#define KBASE(t) ((j_lo + (t)) * KVBLK)
#define ACT(t) (MODE != 0 || (KBASE(t) <= qlo + QBLK - 1 && KBASE(t) + KVBLK - 1 >= qlo - W + 1))
#define MASKT(P0_, P1_, t) do { const int kb_ = KBASE(t); if (MODE == 2) mask_tile(P0_, P1_, qm - kb_, Wm); \
        else if (MODE == 0) { if ((!SK || ACT(t)) && (kb_ + KVBLK - 1 > qlo || kb_ <= qlo + QBLK - 1 - W)) mask_tile(P0_, P1_, qm - kb_, Wm); } } while (0)
    constexpr int NQL = 8;
    constexpr bool SK = WSKIP && MODE == 0;
#define SEAM_K0() do { VMWN(NQL); SWRITE_HK(0); SBAR(); } while (0)
    f32x16 pA0, pA1, pB0, pB1; float mnA, mnB, alA, alB; bf16x8 pa0, pa1, pa2, pa3;
    SWRITE_HV(0); SBAR();
    if constexpr (ONE) { SLOAD_H(nxt.K, nxt.V, nxt.kpitch, kbn); SBAR(); }
    if (NT > 1) { SLOAD_H(Kh, Vh, kp, KBASE(1)); }
    SBAR(); qkt<0, SK>(pA0, pA1, K_lds, r32, hi, S.qr, ACT(0));
    MASKT(pA0, pA1, 0); partialSM(pA0, pA1, m_reg, mnA, alA);
    if (NT > 1) { VMW(); SWRITE_H(1); }
    __syncthreads();
#define HALF_STEP(PX0, PX1, mnX, alX, PY0, PY1, alY, t, KB, VB, SB) do {                                                      \
        SBAR(); qkt<KB, SK>(PX0, PX1, K_lds, r32, hi, S.qr, ACT(t));                                             \
        finishSM(PY0, PY1, alY, l_reg, pa0, pa1, pa2, pa3); SBAR();                                                           \
        if ((t) + 1 < NT) { SLOAD_H(Kh, Vh, kp, KBASE((t) + 1)); SBAR(); }                                               \
        pv_tile<VB, SK>(o, vb0, pa0, pa1, pa2, pa3, ACT((t) - 1)); MASKT(PX0, PX1, (t)); partialSM(PX0, PX1, m_reg, mnX, alX);                                        \
        __syncthreads();                                                                                                      \
        if ((t) + 1 < NT) { VMW(); SWRITE_H(SB); }                                                                          \
        RESC(alX); __syncthreads(); } while (0)
    for (int t = 1; t + 1 < NT; t += 2) {
        HALF_STEP(pB0, pB1, mnB, alB, pA0, pA1, alA, t, 1, 0, 0);
        HALF_STEP(pA0, pA1, mnA, alA, pB0, pB1, alB, t + 1, 0, 1, 1);
    }
    const bool even = (NT & 1) == 0;
    if (even) { SBAR(); qkt<1, SK>(pB0, pB1, K_lds, r32, hi, S.qr, ACT(NT - 1)); SBAR(); }
    if constexpr (!ONE) { SLOAD_H(nxt.K, nxt.V, nxt.kpitch, kbn); SBAR(); }
    { const bf16* qrow = nxt.Q + RF::q_off(nxt, wid * QBLK + r32, e_nxt);
#pragma unroll
      for (int d0 = 0; d0 < 8; ++d0) S.qr[d0] = load8(qrow + d0 * 16 + hi * 8); }
    SBAR();
    finishSM(pA0, pA1, alA, l_reg, pa0, pa1, pa2, pa3); SBAR();
    pv_tile<0, SK>(o, vb0, pa0, pa1, pa2, pa3, ACT(even ? NT - 2 : NT - 1));
    if (even) { MASKT(pB0, pB1, NT - 1); partialSM(pB0, pB1, m_reg, mnB, alB); __syncthreads(); RESC(alB);
        finishSM(pB0, pB1, alB, l_reg, pa0, pa1, pa2, pa3); SBAR(); pv_tile<1, SK>(o, vb0, pa0, pa1, pa2, pa3, ACT(NT - 1)); }
    SBAR(); SEAM_K0();
    if (hi == 0) { li_l[r32] = l_reg; ot_l[r32] = RF::o_off(cur, wid * QBLK + r32, e_cur); } asm volatile("s_waitcnt lgkmcnt(0)" ::: "memory");
    if (LSE != nullptr && hi == 0) { const int lq = RF::l_idx(cur, wid * QBLK + r32, e_cur); if (lq >= 0) LSE[lq] = (l_reg > 0.f) ? m_reg * SCALE + __logf(l_reg) : -__builtin_inff(); }
    if (lse_lane != nullptr) *lse_lane = (l_reg > 0.f) ? m_reg * SCALE + __logf(l_reg) : -__builtin_inff();
    bf16* O = cur.O;
    { char* stg = lds + OFF_ST + wid * ST_WAVE;
#pragma unroll 1
      for (int p = 0; p < 2; ++p) {
#pragma unroll
        for (int rr = 0; rr < 8; ++rr) { const int r = 8 * p + rr, orow = crow(r, hi); const float lv = li_l[orow]; const float rl = (lv > 0.f) ? __builtin_amdgcn_rcpf(lv) : 0.f;
#pragma unroll
            for (int d0 = 0; d0 < 4; ++d0) {
                if constexpr (O8) *(unsigned char*)(stg + (orow - 16 * p) * ST_ROW + (d0 * 32 + r32)) = (unsigned char)__builtin_amdgcn_cvt_pk_fp8_f32(o[d0][r] * rl * 16.f, 0.f, 0, false);
                else *(unsigned short*)(stg + (orow - 16 * p) * ST_ROW + (d0 * 32 + r32) * 2) = (unsigned short)cvtpk(o[d0][r] * rl, 0.f); } }
        asm volatile("s_waitcnt lgkmcnt(0)" ::: "memory");
        { const int row = lane >> 2, ch = lane & 3, oo = ot_l[16 * p + row];
          if constexpr (O8) {
#pragma unroll
            for (int i = 0; i < 2; ++i) { const u32x4 x = *(const u32x4*)(stg + row * ST_ROW + (i * 4 + ch) * 16); if (oo >= 0) *(u32x4*)((char*)O + (size_t)oo + (i * 4 + ch) * 16) = x; }
          } else {
#pragma unroll
            for (int i = 0; i < 4; ++i) { const u32x4 x = *(const u32x4*)(stg + row * ST_ROW + (i * 4 + ch) * 16); if (oo >= 0) *(u32x4*)(O + (size_t)oo + (i * 4 + ch) * 8) = x; } } }
        asm volatile("s_waitcnt lgkmcnt(0)" ::: "memory");
      } }
    __syncthreads();
#undef RESC
#undef KBASE
#undef ACT
#undef MASKT
#undef SEAM_K0
#undef HALF_STEP
}

template <class RF>
__device__ __forceinline__ void imp_sweep(const Ref& cur, float lse_lane, float* IMP  , char* lds, Seam& S) {
    const int tid_ = wg_tid((const __attribute__((address_space(3))) int*)(uintptr_t)(unsigned)(uintptr_t)(lds + WIDTAB_OFF));
    const int tid = tid_, wid = __builtin_amdgcn_readfirstlane(tid >> 6), lane = tid & 63, r32 = lane & 31, hi = lane >> 5;
    const int NT = cur.j_hi - cur.j_lo;
    char* K_lds = lds + 2 * SHM_V;
    const int sr = tid >> 4, sc = (tid & 15) * 8, kws = KSWZ(sr, sc * 2);
    const bf16* Kh = cur.K; const int kp = cur.kpitch;
    const int row = wid * QBLK + r32;
    const int qm = RF::pos(cur, row, RF::entry(cur, row)) - 4 * hi; const unsigned Wm = (unsigned)RF::Wl(cur, row);
    constexpr float C2 = 1.4426950408889634f * SCALE;
    const float nl2 = (lse_lane == -__builtin_inff()) ? 0.f : -lse_lane * 1.4426950408889634f;
    float carry = 0.f;
    float* imp_row = IMP + (size_t)(row >> 2) * 512;
    f32x16 p0, p1;
#define IMP_TILE(t, KB) do { \
        if ((t) + 1 < NT) { S.st_k0 = load8(ROW(Kh, kp, (cur.j_lo + (t) + 1) * KVBLK, sr)); S.st_k1 = load8(ROW(Kh, kp, (cur.j_lo + (t) + 1) * KVBLK, 32 + sr)); } \
        SBAR(); qkt<KB, false>(p0, p1, K_lds, r32, hi, S.qr, true); \
        mask_tile(p0, p1, qm - (cur.j_lo + (t)) * KVBLK, Wm); \
        _Pragma("unroll") for (int r = 0; r < 16; ++r) { p0[r] = __builtin_amdgcn_exp2f(fmaf(p0[r], C2, nl2)); p1[r] = __builtin_amdgcn_exp2f(fmaf(p1[r], C2, nl2)); } \
        float Gs[8], Ls[8]; \
        _Pragma("unroll") for (int q = 0; q < 4; ++q) { Gs[q] = (p0[4 * q] + p0[4 * q + 1]) + (p0[4 * q + 2] + p0[4 * q + 3]); Ls[q] = p0[4 * q + 3]; \
                                              Gs[4 + q] = (p1[4 * q] + p1[4 * q + 1]) + (p1[4 * q + 2] + p1[4 * q + 3]); Ls[4 + q] = p1[4 * q + 3]; } \
          \
        float prevL = carry; \
        _Pragma("unroll") for (int q = 0; q < 8; ++q) { const float other = lane_get(Ls[q], lane ^ 32);        \
            const float add = hi ? other : prevL; prevL = other; Gs[q] += add; } \
        carry = prevL;                                            \
        _Pragma("unroll") for (int q = 0; q < 8; ++q) { float v = Gs[q]; v += lane_get(v, lane ^ 1); v += lane_get(v, lane ^ 2); \
            if ((r32 & 3) == 0) imp_row[((cur.j_lo + (t)) << 4) + 2 * q + hi] = v; } \
        if ((t) + 1 < NT) { asm volatile("s_waitcnt vmcnt(0)" ::: "memory"); *(bf16x8*)(K_lds + ((KB) ^ 1) * SHM_K + kws) = S.st_k0; *(bf16x8*)(K_lds + ((KB) ^ 1) * SHM_K + kws + 32 * 256) = S.st_k1; } \
        __syncthreads(); } while (0)
    for (int t = 0; t < NT; t += 2) { IMP_TILE(t, 0); if (t + 1 < NT) IMP_TILE(t + 1, 1); }
#undef IMP_TILE
}

template <class RF>
__device__ __forceinline__ void gate_unit(const Ref& cur, int nvis, char* lds, Seam& S, int (&sel)[3]) {
    const int tid_ = wg_tid((const __attribute__((address_space(3))) int*)(uintptr_t)(unsigned)(uintptr_t)(lds + WIDTAB_OFF));
    const int lane = tid_ & 63, r32 = lane & 31, hi = lane >> 5;
    char* K_lds = lds + 2 * SHM_V;
    prime<RF>(cur, lds, S);
    f32x16 p0, p1;
    qkt<0, false>(p0, p1, K_lds, r32, hi, S.qr, true);
    const float NEG = -__builtin_inff();
#pragma unroll
    for (int r = 0; r < 16; ++r) { const int k = crow(r, hi); if (k >= nvis) p0[r] = NEG; if (k + 32 >= nvis) p1[r] = NEG; }
    float bv[3]; int bk[3];
#pragma unroll
    for (int rd = 0; rd < 3; ++rd) { float best = NEG; int kb = 64;
#pragma unroll
        for (int r = 0; r < 16; ++r) if (p0[r] > best) { best = p0[r]; kb = crow(r, hi); }
#pragma unroll
        for (int r = 0; r < 16; ++r) if (p1[r] > best) { best = p1[r]; kb = 32 + crow(r, hi); }
        bv[rd] = best; bk[rd] = kb;
#pragma unroll
        for (int r = 0; r < 16; ++r) { if (crow(r, hi) == kb) p0[r] = NEG; if (32 + crow(r, hi) == kb) p1[r] = NEG; } }
    float ov[3]; int ok[3];
#pragma unroll
    for (int i = 0; i < 3; ++i) { ov[i] = lane_get(bv[i], lane ^ 32); ok[i] = lane_geti(bk[i], lane ^ 32); }
    int ia = 0, ib = 0;
#pragma unroll
    for (int rd = 0; rd < 3; ++rd) { const float va = ia == 0 ? bv[0] : (ia == 1 ? bv[1] : (ia == 2 ? bv[2] : NEG)), vb = ib == 0 ? ov[0] : (ib == 1 ? ov[1] : (ib == 2 ? ov[2] : NEG));
        const int ka = ia == 0 ? bk[0] : (ia == 1 ? bk[1] : (ia == 2 ? bk[2] : 64)), kb = ib == 0 ? ok[0] : (ib == 1 ? ok[1] : (ib == 2 ? ok[2] : 64));
        const bool ta = va > vb || (va == vb && ka < kb);
        const float v = ta ? va : vb; const int k = ta ? ka : kb; ia += ta ? 1 : 0; ib += ta ? 0 : 1;
        sel[rd] = (v == NEG) ? -1 : k; }
    __syncthreads();
}
#undef ROW
#undef VMW
#undef VMWN
#undef SLOAD_H
#undef SWRITE_HK
#undef SWRITE_HV
#undef SWRITE_H
#undef KSWZ
#undef SBAR
}

struct RFReg {
    static __device__ __forceinline__ int entry(const att::Ref&, int) { return 0; }
    static __device__ __forceinline__ int q_off(const att::Ref&, int row, int) { return row * 1024; }
    static __device__ __forceinline__ int o_off(const att::Ref&, int row, int) { return row * 1024; }
    static __device__ __forceinline__ int l_idx(const att::Ref& u, int row, int) { return u.a0 >= 0 ? u.a0 + row * 8 : -1; }
    static __device__ __forceinline__ int pos(const att::Ref& u, int row, int) { return u.P0 + row; }
    static __device__ __forceinline__ int Wl(const att::Ref& u, int) { return u.W; }
};
__device__ __forceinline__ att::Ref win_ref(int L, const bf16* QN, const bf16* KW, const bf16* VW, bf16* OWIN) {
    const int h = L & 7, qb = L >> 3;
    att::Ref r; r.Q = QN + (size_t)qb * 256 * 1024 + h * 128; r.O = OWIN + (size_t)qb * 256 * 1024 + h * 128; r.K = KW + (h >> 2) * 128; r.V = VW + (h >> 2) * 128; r.kpitch = 256; r.list = nullptr;
    r.P0 = qb * 256; r.W = 512; r.j_lo = (r.P0 >= 511) ? (r.P0 - 511) >> 6 : 0; r.j_hi = ((r.P0 + 255) >> 6) + 1; r.a0 = -1; r.a1 = 0; return r;
}
__device__ __forceinline__ att::Ref mown_ref(int L, const bf16* QM, const bf16* KM, const bf16* VM, bf16* POWN) {
    const int h = L & 7, n = L >> 3; const size_t o = (size_t)n * 256 * 1024 + h * 128;
    att::Ref r; r.Q = QM + o; r.O = POWN + o; r.K = KM + o; r.V = VM + o; r.kpitch = 1024; r.list = nullptr;
    r.P0 = 0; r.W = 1 << 20; r.j_lo = 0; r.j_hi = 4; r.a0 = n * 256 * 8 + h; r.a1 = 0; return r;
}
struct RFSel {
    static __device__ __forceinline__ int entry(const att::Ref& u, int row) { return u.list[row < u.a0 ? row : 0]; }
    static __device__ __forceinline__ int q_off(const att::Ref&, int, int e) { return (e >> 2) * 1024; }
    static __device__ __forceinline__ int o_off(const att::Ref& u, int row, int e) { return row < u.a0 ? (((e >> 2) * 8 + u.a1) * 3 + (e & 3)) * 128 : -1; }
    static __device__ __forceinline__ int l_idx(const att::Ref& u, int row, int e) { return row < u.a0 ? ((e >> 2) * 8 + u.a1) * 3 + (e & 3) : -1; }
    static __device__ __forceinline__ int pos(const att::Ref&, int, int) { return 0; }
    static __device__ __forceinline__ int Wl(const att::Ref&, int) { return 0; }
};
__device__ __forceinline__ att::Ref msel_ref(int L, const LAS int* tab, const LAS unsigned short* ulist, const int* MLIST, const bf16* QM, const bf16* KM, const bf16* VM, bf16* PSEL) {
    const int lid = __builtin_amdgcn_readfirstlane((int)ulist[L]), k = L - tab[512 + lid], h = lid >> 6, n = lid & 63;
    att::Ref r; r.Q = QM + h * 128; r.O = PSEL; r.K = KM + (size_t)n * 256 * 1024 + h * 128; r.V = VM + (size_t)n * 256 * 1024 + h * 128; r.kpitch = 1024;
    r.list = MLIST + (size_t)lid * 16384 + k * 256; r.P0 = 0; r.W = 0; r.j_lo = 0; r.j_hi = 4; r.a0 = tab[lid] - k * 256; r.a1 = h; return r;
}

struct RFSlc {
    static __device__ __forceinline__ int entry(const att::Ref& u, int row) { return u.list[(row >> 2) < u.a0 ? (row >> 2) : 0]; }
    static __device__ __forceinline__ int q_off(const att::Ref&, int row, int e) { return (e >> 4) * 1024 + (row & 3) * 128; }
    static __device__ __forceinline__ int l_idx(const att::Ref& u, int row, int e) { return (row >> 2) < u.a0 ? ((((e >> 4) * 2 + (u.a1 >> 16)) * 16 + (e & 15)) * 4 + (row & 3)) : -1; }
    static __device__ __forceinline__ int o_off(const att::Ref& u, int row, int e) { const int i = l_idx(u, row, e); return i >= 0 ? i * 128 : -1; }
    static __device__ __forceinline__ int pos(const att::Ref& u, int, int e) { return (e >> 4) - 64 * (u.a1 & 0xffff); }
    static __device__ __forceinline__ int Wl(const att::Ref&, int) { return 1 << 30; }
};
__device__ __forceinline__ att::Ref nsel_ref(int L, const LAS int* tab, const LAS unsigned short* ulist, const int* NLIST, const bf16* QN, const bf16* KS, const bf16* VS, bf16* PSLC) {
    const int lid = __builtin_amdgcn_readfirstlane((int)ulist[L]), k = L - tab[512 + lid], g = lid >> 8, j = lid & 255;
    att::Ref r; r.Q = QN + g * 512; r.O = PSLC; r.K = KS + (size_t)j * 64 * 256 + g * 128; r.V = VS + (size_t)j * 64 * 256 + g * 128; r.kpitch = 256;
    r.list = NLIST + (size_t)lid * 16384 + k * 64; r.P0 = 0; r.W = 0; r.j_lo = 0; r.j_hi = 1; r.a0 = tab[lid] - k * 64; r.a1 = j | (g << 16); return r;
}

struct RFCmp {
    static __device__ __forceinline__ int entry(const att::Ref&, int) { return 0; }
    static __device__ __forceinline__ int q_off(const att::Ref&, int row, int) { return (row >> 2) * 1024 + (row & 3) * 128; }
    static __device__ __forceinline__ int o_off(const att::Ref&, int row, int) { return (row >> 2) * 1024 + (row & 3) * 128; }
    static __device__ __forceinline__ int l_idx(const att::Ref&, int, int) { return -1; }
    static __device__ __forceinline__ int pos(const att::Ref& u, int row, int) { const int t = u.P0 + (row >> 2); return t >= 31 ? (t - 31) >> 4 : -1; }
    static __device__ __forceinline__ int Wl(const att::Ref&, int) { return 1 << 30; }
};
__device__ __forceinline__ att::Ref cmp_ref(int L, const bf16* QN, const bf16* KCMP, const bf16* VCMP, bf16* OCMP) {
    const int g = L & 1, c = (L < 256) ? (L >> 1) : 255 - ((L - 256) >> 1);
    att::Ref r; r.Q = QN + (size_t)c * 64 * 1024 + g * 512; r.O = OCMP + (size_t)c * 64 * 1024 + g * 512; r.K = KCMP + g * 128; r.V = VCMP + g * 128; r.kpitch = 256; r.list = nullptr;
    r.P0 = c * 64; r.W = 0; r.j_lo = 0; r.j_hi = (4 * c + 3 + 63) >> 6; r.a0 = g; r.a1 = c; return r;
}

struct Args { const float* in[18]; float* out; unsigned char* ws; int ph_lo, ph_hi, li, pad; };
typedef const __attribute__((address_space(4))) Args* ArgsP;
__device__ __forceinline__ ArgsP get_args() { auto p = __builtin_amdgcn_kernarg_segment_ptr(); asm volatile("" : "+s"(p)); return (ArgsP)p; }

__global__ void __launch_bounds__(NTHR, 2) mk_fwd(Args args_unused) {
    extern __shared__ __attribute__((aligned(16))) unsigned char lds_raw[];
    LAS unsigned char* lds = (LAS unsigned char*)lds_raw;
    LAS float* sm = (LAS float*)lds;
    volatile LAS unsigned* MISC = (volatile LAS unsigned*)(lds + MISC_OFF);
    LAS int* moetab = (LAS int*)(lds + MOETAB_OFF);
    const int G = gridDim.x, bid = blockIdx.x, NGW = G * NWAVES;
#define PH_IDS() const int tid_ = wg_tid((const LAS int*)(lds + WIDTAB_OFF)); const int tid = tid_, lane = tid & 63, wave = __builtin_amdgcn_readfirstlane(tid >> 6), gw = bid * NWAVES + wave; (void)lane; (void)gw;
#define AP() get_args()
#define CTLP(ws) ((gu32*)((ws) + WS_CTL))

    for (int u = threadIdx.x; u < (LDS_BYTES - LDSCTL_OFF) / 4; u += NTHR) ((LAS unsigned*)(lds + LDSCTL_OFF))[u] = 0u;
    __syncthreads();
    { unsigned hw; asm volatile("s_getreg_b32 %0, hwreg(HW_REG_HW_ID, 0, 6)" : "=s"(hw)); if ((threadIdx.x & 63) == 0) ((LAS int*)(lds + WIDTAB_OFF))[hw] = (int)(threadIdx.x >> 6); }
    __syncthreads();
    XcdBarrier bar; bar.bar = nullptr; bar.x = 0; bar.st = nullptr;
    if (MK_N_LAUNCHES == 1) bar = xcd_barrier_post((unsigned*)(CTLP(AP()->ws) + CW_BAR), MISC + 8);
#define GRID_BAR() do { if (MK_N_LAUNCHES == 1) { XcdBarrier b_ = bar; b_.bar = (unsigned*)(CTLP(AP()->ws) + CW_BAR); xcd_barrier(b_, wg_tid((const LAS int*)(lds + WIDTAB_OFF)) == 0); } } while (0)
    const int lo = AP()->ph_lo, hi = AP()->ph_hi;
#define IN(k) (lo <= (k) && (k) < hi)
#define BOTH(k) (IN(k) && IN((k) + 1))

    if (IN(0)) {
        PH_IDS(); ArgsP ap = AP(); unsigned char* ws = ap->ws;
        LAS float* scr = (LAS float*)(lds + wave * 16384);
        constexpr int I_IN = 32 * 177, I_OUT = 32 * 64, I_GU = 32 * 16, I_DN = 8 * 64, I_W1 = 32 * 8;
        constexpr int N_IN = 2 * I_IN, N_OUT = 2 * I_OUT, N_G = 64 * I_GU, N_U = 64 * I_GU, N_D = 64 * I_DN, N_W1 = 8 * I_W1;
        constexpr int NITEMS = N_IN + N_OUT + N_G + N_U + N_D + N_W1;
        for (int it = gw; it < NITEMS; it += NGW) {
            int r = it;
            if (r < N_IN) { const int l = r / I_IN; transpose_item<1>(ap->in[6] + (size_t)l * D_ * IN_W, D_, IN_W, (bf16*)(ws + WS_WINT) + (size_t)l * NIN * D_, D_, 0, scr, r % I_IN, lane); continue; } r -= N_IN;
            if (r < N_OUT) { const int l = r / I_OUT; transpose_item<0>(ap->in[7] + (size_t)l * D_ * D_, D_, D_, (bf16*)(ws + WS_WOUTT) + (size_t)l * D_ * D_, D_, 0, scr, r % I_OUT, lane); continue; } r -= N_OUT;
            if (r < N_G) { const int le = r / I_GU; transpose_item<2>(ap->in[14] + (size_t)le * D_ * DEXP, D_, DEXP, (bf16*)(ws + WS_WGUT) + (size_t)le * 1024 * D_, D_, 0, scr, r % I_GU, lane); continue; } r -= N_G;
            if (r < N_U) { const int le = r / I_GU; transpose_item<3>(ap->in[15] + (size_t)le * D_ * DEXP, D_, DEXP, (bf16*)(ws + WS_WGUT) + (size_t)le * 1024 * D_, D_, 0, scr, r % I_GU, lane); continue; } r -= N_U;
            if (r < N_D) { const int le = r / I_DN; transpose_item<0>(ap->in[16] + (size_t)le * DEXP * D_, DEXP, D_, (bf16*)(ws + WS_WDT) + (size_t)le * D_ * DEXP, DEXP, 0, scr, r % I_DN, lane); continue; } r -= N_D;
            { const int m = r / I_W1, lk = m >> 1, half = m & 1;
              transpose_item<0>(ap->in[9] + (size_t)lk * 4096 * 256 + (size_t)half * 2048 * 256, 2048, 256, (bf16*)(ws + WS_WC1T) + (size_t)lk * 512 * 2048, 2048, half * 256, scr, r % I_W1, lane); }
        }
        { const float* w_router = ap->in[12]; bf16* WrT = (bf16*)(ws + WS_WRT);
          for (int idx = bid * NTHR + tid; idx < 32 * 2048; idx += G * NTHR) { const int e = idx >> 11, k = idx & 2047; const float w = w_router[(size_t)k * 32 + e];
            const unsigned hb = f2bf(w); const float rem = w - bf2f(hb); WrT[idx] = (bf16)hb; WrT[32 * 2048 + idx] = (bf16)f2bf(rem); } }
        { f32x2* ROPE = (f32x2*)(ws + WS_ROPE);
          for (int idx = bid * NTHR + tid; idx < S_ * 64; idx += G * NTHR) { const int pos = idx >> 6, i = idx & 63;
            const double inv = exp(-(double)i * (9.210340371976184 / 64.0)); const double ang = (double)pos * inv; double sv, cv; sincos(ang, &sv, &cv);
            ROPE[idx] = (f32x2){(float)cv, (float)sv}; } }
        __syncthreads();
        { float* MOD = (float*)(CTLP(ws) + CW_MOD); const float* c_in = ap->in[1]; const float* w_ada = ap->in[2]; const float* b_ada = ap->in[3];
          for (int k = tid; k < D_; k += NTHR) { const float cv = c_in[k]; sm[k] = cv / (1.f + __expf(-cv)); }
          __syncthreads();
          for (int it = bid; it < 2 * 96; it += G) { const int l = it / 96, cb = it % 96, grp = tid >> 5, col = cb * 128 + (tid & 31) * 4;
            f32x4 a = (f32x4){0.f, 0.f, 0.f, 0.f};
            const float* wp = w_ada + ((size_t)l * D_ + grp) * 12288 + col;
#pragma unroll 8
            for (int i = 0; i < 128; ++i) a += *(const f32x4*)(wp + (size_t)i * 16 * 12288) * sm[grp + 16 * i];
            *(LAS f32x4*)(sm + 4096 + grp * 128 + (tid & 31) * 4) = a;
            __syncthreads();
            if (tid < 128) { float s = b_ada[l * 12288 + cb * 128 + tid];
#pragma unroll
                for (int q = 0; q < 16; ++q) s += sm[4096 + q * 128 + tid];
                MOD[l * 12288 + cb * 128 + tid] = s; }
            __syncthreads(); } }
        { float* B1P = (float*)(CTLP(ws) + CW_B1E); const float* cmp_pe = ap->in[8]; const float* cmp_w1 = ap->in[9];
          for (int it = bid - 192; it >= 0 && it < 32; it += G) { const int lk = it >> 3, ks = it & 7, grp = tid >> 6, n = (tid & 63) * 4;
            f32x4 a = (f32x4){0.f, 0.f, 0.f, 0.f};
            const float* wp = cmp_w1 + ((size_t)lk * 4096 + ks * 512 + grp) * 256 + n; const float* pe = cmp_pe + (size_t)lk * 4096 + ks * 512 + grp;
#pragma unroll 8
            for (int i = 0; i < 64; ++i) a += *(const f32x4*)(wp + (size_t)i * 8 * 256) * pe[i * 8];
            *(LAS f32x4*)(sm + 4096 + grp * 256 + n) = a;
            __syncthreads();
            if (tid < 256) { float s = 0.f;
#pragma unroll
                for (int q = 0; q < 8; ++q) s += sm[4096 + q * 256 + tid];
                B1P[(lk * 8 + ks) * 256 + tid] = s; }
            __syncthreads(); } }
        if (BOTH(0)) GRID_BAR();
    }

    for (int l = 0; l < DEPTH; ++l) {
        const int pb = 1 + NPL * l;
#define LOAD_MOETAB(CNTP, NT_) do { __syncthreads(); if (tid < 32) moetab[tid] = (int)__hip_atomic_load((CNTP) + tid, RLX_AGENT); __syncthreads(); \
        if (tid == 0) { int us = 0, ps = 0; for (int e = 0; e < NEXP; ++e) { const int c = moetab[e], tl = (c + 255) >> 8; moetab[32 + e] = us; moetab[65 + e] = ps; us += tl * (NT_); ps += tl << 8; } moetab[64] = us; } \
        __syncthreads(); } while (0)

        if (IN(pb + 0)) {
            PH_IDS(); ArgsP ap = AP(); unsigned char* ws = ap->ws;
            const float* MOD = (const float*)(CTLP(ws) + CW_MOD); const float* mod = MOD + l * 12288;
            float* X = ap->out; bf16* H = (bf16*)(ws + WS_H); const bf16* Y = (const bf16*)(ws + WS_Y); const int* TE = (const int*)(ws + WS_TE);
            if (l > 0) LOAD_MOETAB((unsigned*)(CTLP(ws) + CW_CNT) + (l - 1) * 32, 1);
            { const float* g_attn = ap->in[4];
              for (int k = tid; k < D_; k += NTHR) { sm[k] = g_attn[l * D_ + k] * (1.f + mod[2048 + k]); sm[2048 + k] = mod[k]; sm[4096 + k] = (l > 0) ? MOD[(l - 1) * 12288 + 10240 + k] : 0.f; } }
            __syncthreads();
            const float* x_in = ap->in[0];
            for (int t = gw; t < S_; t += NGW) {
                f32x4 v[8]; float ss = 0.f;
                if (l == 0) {
#pragma unroll
                    for (int j = 0; j < 8; ++j) v[j] = *(const f32x4*)(x_in + (size_t)t * D_ + 256 * j + 4 * lane);
                } else {
                    const int4 te = *(const int4*)(TE + 4 * t);
                    const bf16* y0 = Y + (size_t)(moetab[65 + te.x] + te.y) * D_; const bf16* y1 = Y + (size_t)(moetab[65 + te.z] + te.w) * D_;
#pragma unroll
                    for (int j = 0; j < 8; ++j) { const int k = 256 * j + 4 * lane; const uint2 a = *(const uint2*)(y0 + k), b = *(const uint2*)(y1 + k);
                        const f32x4 gt2 = *(const LAS f32x4*)(sm + 4096 + k);
                        f32x4 ysum = (f32x4){bflo(a.x) + bflo(b.x), bfhi(a.x) + bfhi(b.x), bflo(a.y) + bflo(b.y), bfhi(a.y) + bfhi(b.y)};
                        v[j] = *(const f32x4*)(X + (size_t)t * D_ + k) + gt2 * ysum; *(f32x4*)(X + (size_t)t * D_ + k) = v[j]; }
                }
#pragma unroll
                for (int j = 0; j < 8; ++j) ss += (v[j][0] * v[j][0] + v[j][1] * v[j][1]) + (v[j][2] * v[j][2] + v[j][3] * v[j][3]);
                const float rstd = 1.f / sqrtf(wave_sum(ss, lane) * (1.f / D_) + RMS_EPS);
#pragma unroll
                for (int j = 0; j < 8; ++j) { const int k = 256 * j + 4 * lane; const f32x4 h = v[j] * rstd * *(const LAS f32x4*)(sm + k) + *(const LAS f32x4*)(sm + 2048 + k);
                    *(uint2*)(H + (size_t)t * D_ + k) = make_uint2(pk2(h[0], h[1]), pk2(h[2], h[3])); }
            }
            if (BOTH(pb + 0)) GRID_BAR();
        }
        if (IN(pb + 1)) {
            ArgsP ap = AP(); unsigned char* ws = ap->ws;
            pg8::Gemm g{(const bf16*)(ws + WS_H), (const bf16*)(ws + WS_WINT) + (size_t)l * NIN * D_, S_, NIN, D_}; pg8::StaticOrder So; So.init(S_, NIN, G, bid);
            EpiInProj E{(bf16*)(ws + WS_QN), (bf16*)(ws + WS_KC), (bf16*)(ws + WS_VC), (bf16*)(ws + WS_KS), (bf16*)(ws + WS_VS), (bf16*)(ws + WS_KW), (bf16*)(ws + WS_VW),
                        (bf16*)(ws + WS_QM), (bf16*)(ws + WS_KM), (bf16*)(ws + WS_VM), (float*)(ws + WS_GATES), (const float*)(ws + WS_ROPE)};
            pg8::gemm_phase<EpiInProj, pg8::StaticOrder, true, true>(lds, g, So, E);
            if (BOTH(pb + 1)) GRID_BAR();
        }
        if (IN(pb + 2)) {
            PH_IDS(); ArgsP ap = AP(); unsigned char* ws = ap->ws;
            if (bid < 32) {
                pg8::Gemm g{(const bf16*)(ws + WS_KC), (const bf16*)(ws + WS_WC1T) + (size_t)l * 2 * 512 * 2048, 4096, 512, 2048}; CompressOrder So{G, bid};
                EpiF32 E{(float*)(ws + WS_UL), 512};
                pg8::gemm_phase<EpiF32, CompressOrder, false, true>(lds, g, So, E);
            }
            {
                const bf16* KM = (const bf16*)(ws + WS_KM); bf16* KMEAN = (bf16*)(ws + WS_KMEAN);
                const int nb = (G > 32) ? G - 32 : G, b0 = (G > 32) ? bid - 32 : bid;
                if (b0 >= 0) for (int u = b0; u < 512; u += nb) { const int n = u >> 3, h = u & 7, rg = tid >> 4, c8 = (tid & 15) * 8;
                    float a8[8] = {0.f, 0.f, 0.f, 0.f, 0.f, 0.f, 0.f, 0.f};
#pragma unroll
                    for (int i = 0; i < 8; ++i) { const v4u kv = *(const v4u*)(KM + (size_t)(n * 256 + rg + 32 * i) * 1024 + h * 128 + c8);
                        a8[0] += bflo(kv.x); a8[1] += bfhi(kv.x); a8[2] += bflo(kv.y); a8[3] += bfhi(kv.y); a8[4] += bflo(kv.z); a8[5] += bfhi(kv.z); a8[6] += bflo(kv.w); a8[7] += bfhi(kv.w); }
#pragma unroll
                    for (int i = 0; i < 8; ++i) sm[rg * 128 + c8 + i] = a8[i];
                    __syncthreads();
                    if (tid < 128) { float s = 0.f;
#pragma unroll 8
                        for (int q = 0; q < 32; ++q) s += sm[q * 128 + tid];
                        KMEAN[(size_t)(h * 64 + n) * 128 + tid] = (bf16)f2bf(s * (1.f / 256.f)); }
                    __syncthreads(); }
            }
            {
                const bf16* QN = (const bf16*)(ws + WS_QN); const bf16* KW = (const bf16*)(ws + WS_KW); const bf16* VW = (const bf16*)(ws + WS_VW); bf16* OWIN = (bf16*)(ws + WS_OWIN);
                const bf16* QM = (const bf16*)(ws + WS_QM); const bf16* KM2 = (const bf16*)(ws + WS_KM); const bf16* VM = (const bf16*)(ws + WS_VM); bf16* POWN = (bf16*)(ws + WS_POWN); float* LSEO = (float*)(ws + WS_LSEO);
                const int nbw = (G > 32) ? G - 32 : G, bw = (G > 32) ? bid - 32 : bid;
                __syncthreads();
                att::Seam S; int L = bw;
                if (L >= 0 && L < 1024) { att::Ref cur = (L < 512) ? win_ref(L, QN, KW, VW, OWIN) : mown_ref(L - 512, QM, KM2, VM, POWN); att::prime<RFReg>(cur, (char*)lds_raw, S);
                    for (;;) { const int Ln = L + nbw; const bool more = Ln < 1024; const att::Ref nxt = more ? ((Ln < 512) ? win_ref(Ln, QN, KW, VW, OWIN) : mown_ref(Ln - 512, QM, KM2, VM, POWN)) : cur;
                        att::block<0, true, RFReg>(cur, nxt, LSEO, (char*)lds_raw, S);
                        if (!more) break; cur = nxt; L = Ln; } }
                __syncthreads();
            }
            if (BOTH(pb + 2)) GRID_BAR();
        }
        if (IN(pb + 3)) {
            PH_IDS(); ArgsP ap = AP(); unsigned char* ws = ap->ws;
            const float* UL = (const float*)(ws + WS_UL); const float* B1P = (const float*)(CTLP(ws) + CW_B1E); const float* cmp_b1 = ap->in[10]; const f32x2* ROPE = (const f32x2*)(ws + WS_ROPE);
            bf16* KCMP = (bf16*)(ws + WS_KCMP); bf16* VCMP = (bf16*)(ws + WS_VCMP); const float* cmp_w2 = ap->in[11];
            { const int kv = bid & 1; const float* w2 = cmp_w2 + (size_t)(l * 2 + kv) * 256 * 128; LAS float* be = (LAS float*)(lds + 135168 + 8192);
              if (tid < 256) { float s = cmp_b1[(l * 2 + kv) * 256 + tid];
#pragma unroll
                  for (int q = 0; q < 8; ++q) s += B1P[((l * 2 + kv) * 8 + q) * 256 + tid];
                  be[tid] = s; }
              for (int i = tid; i < 256 * 128 / 4; i += NTHR) *(LAS f32x4*)(sm + 4 * i) = *(const f32x4*)(w2 + 4 * i);
              LAS float* hid = (LAS float*)(lds + 135168) + wave * 256;
              __syncthreads();
              const int nb2 = (G + 1 - kv) >> 1;
              for (int r = (bid >> 1) * NWAVES + wave; r < NC * 2; r += nb2 * NWAVES) { const int c = r >> 1, g = r & 1;
                const float* Ur = UL + ((size_t)kv * 2048 + g * 1024 + c) * 512; const float* Lr = UL + ((size_t)kv * 2048 + g * 1024 + c + 1) * 512 + 256;
#pragma unroll
                for (int j = 0; j < 4; ++j) { const int n = lane + 64 * j; const float v = Ur[n] + Lr[n] + be[n];
                    hid[n] = 0.5f * v * (1.f + tanhf(0.7978845608028654f * (v + 0.044715f * v * v * v))); }
                LDS_WAIT(); asm volatile("" ::: "memory");
                float o0 = 0.f, o1 = 0.f;
#pragma unroll 8
                for (int n = 0; n < 256; ++n) { const float hv = hid[n]; o0 += hv * sm[n * 128 + lane]; o1 += hv * sm[n * 128 + 64 + lane]; }
                if (kv == 0) { const f32x2 cs = ROPE[(size_t)(16 * c + 31) * 64 + lane];
                    const float a = o0 * cs[0] - o1 * cs[1], b = o1 * cs[0] + o0 * cs[1];
                    *(unsigned*)(KCMP + ((size_t)c * 2 + g) * 128 + 2 * lane) = pk2(a, b);
                } else { VCMP[((size_t)c * 2 + g) * 128 + lane] = (bf16)f2bf(o0); VCMP[((size_t)c * 2 + g) * 128 + 64 + lane] = (bf16)f2bf(o1); }
                LDS_WAIT(); asm volatile("" ::: "memory");
              }
              __syncthreads(); }
            if (BOTH(pb + 3)) GRID_BAR();
        }
        if (IN(pb + 4)) {
            {   ArgsP ap = AP(); unsigned char* ws = ap->ws;
                const bf16* QN = (const bf16*)(ws + WS_QN); const bf16* KCMP = (const bf16*)(ws + WS_KCMP); const bf16* VCMP = (const bf16*)(ws + WS_VCMP);
                bf16* OCMP = (bf16*)(ws + WS_OCMP); float* IMP = (float*)(ws + WS_IMP);
                att::Seam S;
                for (int L = bid; L < 512; L += G) { const att::Ref cur = cmp_ref(L, QN, KCMP, VCMP, OCMP); float lse;
                    att::prime<RFCmp>(cur, (char*)lds_raw, S);
                    att::block<2, false, RFCmp>(cur, cur, nullptr, (char*)lds_raw, S, &lse);
                    att::imp_sweep<RFCmp>(cur, lse, IMP + ((size_t)cur.a1 * 64 * 2 + cur.a0) * 256, (char*)lds_raw, S); }
            }
            {   PH_IDS(); ArgsP ap = AP(); unsigned char* ws = ap->ws;
                const bf16* QM = (const bf16*)(ws + WS_QM); const bf16* KMEAN = (const bf16*)(ws + WS_KMEAN);
                unsigned* MCNT = (unsigned*)(CTLP(ws) + CW_MCNT) + l * 512; int* MLIST = (int*)(ws + WS_MLIST); float* LSES = (float*)(ws + WS_LSES);
                __syncthreads();
                att::Seam S;
                for (int L = bid; L < 512; L += G) { const int h = L & 7, nq = L >> 3;
                    att::Ref cur; cur.Q = QM + (size_t)nq * 256 * 1024 + h * 128; cur.O = nullptr; cur.K = KMEAN + (size_t)h * 64 * 128; cur.V = cur.K; cur.kpitch = 128; cur.list = nullptr;
                    cur.P0 = 0; cur.W = 0; cur.j_lo = 0; cur.j_hi = 1; cur.a0 = -1; cur.a1 = 0;
                    int sel[3]; att::gate_unit<RFReg>(cur, nq, (char*)lds_raw, S, sel);
                    if (lane < 32) { const int t = nq * 256 + wave * 32 + lane;
#pragma unroll
                        for (int s = 0; s < 3; ++s) {
                            if (sel[s] >= 0) { const unsigned p = atomicAdd(MCNT + h * 64 + sel[s], 1u); MLIST[(size_t)(h * 64 + sel[s]) * 16384 + p] = t * 4 + s; }
                            else LSES[(t * 8 + h) * 3 + s] = -INFINITY; } }
                }
            }
            if (BOTH(pb + 4)) GRID_BAR();
        }
        if (IN(pb + 5)) {
            PH_IDS(); ArgsP ap = AP(); unsigned char* ws = ap->ws;
            {   PH_IDS(); ArgsP ap = AP(); unsigned char* ws = ap->ws;
                const float* IMP = (const float*)(ws + WS_IMP); int* SEL = (int*)(ws + WS_SEL);
                unsigned* NCNT = (unsigned*)(CTLP(ws) + CW_NCNT) + l * 512; int* NLIST = (int*)(ws + WS_NLIST);
                const int lam = lane & 15, rho = lane >> 4;
                for (int ub = gw * 4; ub < S_ * 2; ub += NGW * 4) { const int u = ub + rho, t = u >> 1, g = u & 1, tb = t >> 6;
                    float v[16];
#pragma unroll
                    for (int i = 0; i < 16; ++i) { const int j = lam + 16 * i; const float im = IMP[(size_t)u * 256 + j]; const bool forced = (j == 0) || (j == tb) || (j == tb - 1);
                        v[i] = (j > tb) ? -INFINITY : (forced ? 1e9f : im); }
                    int mysel = -1;
                    for (int r = 0; r < 16; ++r) { const int pick = row_pick<16>(v, lam); if (lam == r) mysel = pick; if (__all(pick < 0)) break; }
                    SEL[(size_t)u * 16 + lam] = mysel;
                    if (mysel >= 0) {
                        unsigned p;
                        if (mysel == 0) p = (unsigned)t; else if (mysel == tb) p = (unsigned)(t & 63); else if (mysel == tb - 1) p = 64u + (unsigned)(t & 63);
                        else p = 128u + atomicAdd(NCNT + g * 256 + mysel, 1u);
                        NLIST[(size_t)(g * 256 + mysel) * 16384 + p] = t * 16 + lam; }
                }
            }
            {   PH_IDS(); ArgsP ap = AP(); unsigned char* ws = ap->ws;
                const bf16* QM = (const bf16*)(ws + WS_QM); const bf16* KM = (const bf16*)(ws + WS_KM); const bf16* VM = (const bf16*)(ws + WS_VM);
                bf16* POWN = (bf16*)(ws + WS_POWN); bf16* PSEL = (bf16*)(ws + WS_PSEL); float* LSEO = (float*)(ws + WS_LSEO); float* LSES = (float*)(ws + WS_LSES);
                const int* MLIST = (const int*)(ws + WS_MLIST); unsigned* MCNT = (unsigned*)(CTLP(ws) + CW_MCNT) + l * 512;
                LAS int* mtab = (LAS int*)(lds + att::LDS_BYTES);
                __syncthreads();
                mtab[tid] = (int)__hip_atomic_load(MCNT + tid, RLX_AGENT);
                __syncthreads();
                LAS unsigned short* ulist = (LAS unsigned short*)(lds + 108544);
                { int tot; const int nu = (mtab[tid] + 255) >> 8; const int ex = block_excl_scan(nu, mtab + 1040, tid, &tot); mtab[512 + tid] = ex; if (tid == 0) mtab[1024] = tot;
                  for (int u = 0; u < nu; ++u) ulist[ex + u] = (unsigned short)tid; }
                __syncthreads();
                const int nsel = mtab[1024];
                att::Seam S;
                { int L = bid;
                  if (L < nsel) { att::Ref cur = msel_ref(L, mtab, ulist, MLIST, QM, KM, VM, PSEL); att::prime<RFSel>(cur, (char*)lds_raw, S);
                    for (;;) { const bool more = L + G < nsel; const att::Ref nxt = more ? msel_ref(L + G, mtab, ulist, MLIST, QM, KM, VM, PSEL) : cur;
                        att::block<1, false, RFSel>(cur, nxt, LSES, (char*)lds_raw, S);
                        if (!more) break; cur = nxt; L += G; } } }
                __syncthreads();
            }
            if (BOTH(pb + 5)) GRID_BAR();
        }
        if (IN(pb + 6)) {
            PH_IDS(); ArgsP ap = AP(); unsigned char* ws = ap->ws;
            const bf16* POWN = (const bf16*)(ws + WS_POWN); const bf16* PSEL = (const bf16*)(ws + WS_PSEL); const float* LSEO = (const float*)(ws + WS_LSEO); const float* LSES = (const float*)(ws + WS_LSES);
            bf16* OMIX = (bf16*)(ws + WS_OMIX);
            for (int t = gw; t < S_; t += NGW) {
                const int hh = (lane >> 2) & 7, ii = lane & 3;
                const float lv = (ii == 0) ? LSEO[t * 8 + hh] : LSES[(t * 8 + hh) * 3 + ii - 1];
                float m = fmaxf(lv, lane_get(lv, lane ^ 1)); m = fmaxf(m, lane_get(m, lane ^ 2));
                float w = __expf(lv - m); float sw = w + lane_get(w, lane ^ 1); sw += lane_get(sw, lane ^ 2); w = w / sw;
#pragma unroll
                for (int hp = 0; hp < 2; ++hp) { const int h = hp * 4 + (lane >> 4), c8 = (lane & 15) * 8;
                    const float w0 = lane_get(w, h * 4), w1 = lane_get(w, h * 4 + 1), w2 = lane_get(w, h * 4 + 2), w3 = lane_get(w, h * 4 + 3);
                    const bf16* ps = PSEL + (size_t)((t * 8 + h) * 3) * 128 + c8;
                    const v4u a0 = *(const v4u*)(POWN + (size_t)t * 1024 + h * 128 + c8);
                    v4u a1 = (v4u){0u, 0u, 0u, 0u}, a2 = a1, a3 = a1;
                    if (w1 > 0.f) a1 = *(const v4u*)(ps); if (w2 > 0.f) a2 = *(const v4u*)(ps + 128); if (w3 > 0.f) a3 = *(const v4u*)(ps + 256);
                    v4u ov;
                    ov.x = pk2(w0 * bflo(a0.x) + w1 * bflo(a1.x) + w2 * bflo(a2.x) + w3 * bflo(a3.x), w0 * bfhi(a0.x) + w1 * bfhi(a1.x) + w2 * bfhi(a2.x) + w3 * bfhi(a3.x));
                    ov.y = pk2(w0 * bflo(a0.y) + w1 * bflo(a1.y) + w2 * bflo(a2.y) + w3 * bflo(a3.y), w0 * bfhi(a0.y) + w1 * bfhi(a1.y) + w2 * bfhi(a2.y) + w3 * bfhi(a3.y));
                    ov.z = pk2(w0 * bflo(a0.z) + w1 * bflo(a1.z) + w2 * bflo(a2.z) + w3 * bflo(a3.z), w0 * bfhi(a0.z) + w1 * bfhi(a1.z) + w2 * bfhi(a2.z) + w3 * bfhi(a3.z));
                    ov.w = pk2(w0 * bflo(a0.w) + w1 * bflo(a1.w) + w2 * bflo(a2.w) + w3 * bflo(a3.w), w0 * bfhi(a0.w) + w1 * bfhi(a1.w) + w2 * bfhi(a2.w) + w3 * bfhi(a3.w));
                    *(v4u*)(OMIX + (size_t)t * 2048 + 1024 + h * 128 + c8) = ov; }
            }
            if (BOTH(pb + 6)) GRID_BAR();

        }
        if (IN(pb + 7)) {
            PH_IDS(); ArgsP ap = AP(); unsigned char* ws = ap->ws;
            const bf16* QN = (const bf16*)(ws + WS_QN); const bf16* KS = (const bf16*)(ws + WS_KS); const bf16* VS = (const bf16*)(ws + WS_VS);
            bf16* PSLC = (bf16*)(ws + WS_PSLC); float* LSEN = (float*)(ws + WS_LSEN); const int* NLIST = (const int*)(ws + WS_NLIST); unsigned* NCNT = (unsigned*)(CTLP(ws) + CW_NCNT) + l * 512;
            LAS int* ntab = (LAS int*)(lds + att::LDS_BYTES);
            __syncthreads();
            { const int j = tid & 255; ntab[tid] = (j == 0) ? S_ : (int)__hip_atomic_load(NCNT + tid, RLX_AGENT) + 64 + (j < 255 ? 64 : 0); }
            __syncthreads();
            LAS unsigned short* ulist = (LAS unsigned short*)(lds + 108544);
            { int tot; const int nu = (ntab[tid] + 63) >> 6; const int ex = block_excl_scan(nu, ntab + 1040, tid, &tot); ntab[512 + tid] = ex; if (tid == 0) ntab[1024] = tot;
              for (int u = 0; u < nu; ++u) ulist[ex + u] = (unsigned short)tid; }
            __syncthreads();
            const int nun = ntab[1024];
            att::Seam S; int L = bid;
            if (L < nun) { att::Ref cur = nsel_ref(L, ntab, ulist, NLIST, QN, KS, VS, PSLC); att::prime<RFSlc>(cur, (char*)lds_raw, S);
                for (;;) { const bool more = L + G < nun; const att::Ref nxt = more ? nsel_ref(L + G, ntab, ulist, NLIST, QN, KS, VS, PSLC) : cur;
                    att::block<2, false, RFSlc, true, true>(cur, nxt, LSEN, (char*)lds_raw, S);
                    if (!more) break; cur = nxt; L += G; } }
            __syncthreads();
            if (BOTH(pb + 7)) GRID_BAR();
        }
        if (IN(pb + 8)) {
            PH_IDS(); ArgsP ap = AP(); unsigned char* ws = ap->ws;
            const unsigned char* PSLC = (const unsigned char*)(ws + WS_PSLC); const float* LSEN = (const float*)(ws + WS_LSEN); const int* SEL = (const int*)(ws + WS_SEL); const float* GATES = (const float*)(ws + WS_GATES);
            const bf16* OCMP = (const bf16*)(ws + WS_OCMP); const bf16* OWIN = (const bf16*)(ws + WS_OWIN); bf16* OMIX = (bf16*)(ws + WS_OMIX);
            for (int u = gw; u < S_ * 2; u += NGW) { const int t = u >> 1, g = u & 1;
                const int sv = (lane < 16) ? SEL[(size_t)u * 16 + lane] : -1;
                const int nsel = __popcll(__ballot(sv >= 0));
                const float lv = ((lane >> 2) < nsel) ? LSEN[(size_t)u * 64 + lane] : -INFINITY;
                float m = lv;
#pragma unroll
                for (int o = 4; o < 64; o <<= 1) m = fmaxf(m, lane_get(m, lane ^ o));
                float w = __expf(lv - m), sw = w;
#pragma unroll
                for (int o = 4; o < 64; o <<= 1) sw += lane_get(sw, lane ^ o);
                w = w / sw * 0.0625f;
                const int r = lane >> 4, c8 = (lane & 15) * 8;
                float o8[8] = {0.f, 0.f, 0.f, 0.f, 0.f, 0.f, 0.f, 0.f};
                uint2 pv[16];
#pragma unroll
                for (int s = 0; s < 16; ++s) { const int sc = s < nsel ? s : nsel - 1; pv[s] = *(const uint2*)(PSLC + ((size_t)(u * 16 + sc) * 4 + r) * 128 + c8); }
#pragma unroll
                for (int s = 0; s < 16; ++s) { const float ws_ = lane_get(w, s * 4 + r);
                    o8[0] += ws_ * __builtin_amdgcn_cvt_f32_fp8((int)pv[s].x, 0); o8[1] += ws_ * __builtin_amdgcn_cvt_f32_fp8((int)pv[s].x, 1); o8[2] += ws_ * __builtin_amdgcn_cvt_f32_fp8((int)pv[s].x, 2); o8[3] += ws_ * __builtin_amdgcn_cvt_f32_fp8((int)pv[s].x, 3);
                    o8[4] += ws_ * __builtin_amdgcn_cvt_f32_fp8((int)pv[s].y, 0); o8[5] += ws_ * __builtin_amdgcn_cvt_f32_fp8((int)pv[s].y, 1); o8[6] += ws_ * __builtin_amdgcn_cvt_f32_fp8((int)pv[s].y, 2); o8[7] += ws_ * __builtin_amdgcn_cvt_f32_fp8((int)pv[s].y, 3); }
                const int hd = g * 4 + r; const float g0 = GATES[(size_t)t * 32 + hd * 3], g1 = GATES[(size_t)t * 32 + hd * 3 + 1], g2 = GATES[(size_t)t * 32 + hd * 3 + 2];
                const size_t oi = (size_t)t * 1024 + hd * 128 + c8;
                const v4u cv = *(const v4u*)(OCMP + oi), wv = *(const v4u*)(OWIN + oi);
                v4u ov;
                ov.x = pk2(g1 * o8[0] + g0 * bflo(cv.x) + g2 * bflo(wv.x), g1 * o8[1] + g0 * bfhi(cv.x) + g2 * bfhi(wv.x));
                ov.y = pk2(g1 * o8[2] + g0 * bflo(cv.y) + g2 * bflo(wv.y), g1 * o8[3] + g0 * bfhi(cv.y) + g2 * bfhi(wv.y));
                ov.z = pk2(g1 * o8[4] + g0 * bflo(cv.z) + g2 * bflo(wv.z), g1 * o8[5] + g0 * bfhi(cv.z) + g2 * bfhi(wv.z));
                ov.w = pk2(g1 * o8[6] + g0 * bflo(cv.w) + g2 * bflo(wv.w), g1 * o8[7] + g0 * bfhi(cv.w) + g2 * bfhi(wv.w));
                *(v4u*)(OMIX + (size_t)t * 2048 + hd * 128 + c8) = ov;
            }
            if (BOTH(pb + 8)) GRID_BAR();
        }
        if (IN(pb + 9)) {
            ArgsP ap = AP(); unsigned char* ws = ap->ws;
            pg8::Gemm g{(const bf16*)(ws + WS_OMIX), (const bf16*)(ws + WS_WOUTT) + (size_t)l * D_ * D_, S_, D_, D_}; pg8::StaticOrder So; So.init(S_, D_, G, bid);
            EpiOutProj E{l == 0 ? ap->in[0] : (const float*)ap->out, ap->out, (const float*)(CTLP(ws) + CW_MOD) + l * 12288 + 4096, (float*)(ws + WS_UL)};
            pg8::gemm_phase<EpiOutProj, pg8::StaticOrder, true, true>(lds, g, So, E);
            if (BOTH(pb + 9)) GRID_BAR();
        }
        if (IN(pb + 10)) {
            PH_IDS(); ArgsP ap = AP(); unsigned char* ws = ap->ws;
            const float* mod = (const float*)(CTLP(ws) + CW_MOD) + l * 12288;
            const float* X = ap->out; bf16* H = (bf16*)(ws + WS_H); const bf16* WrT = (const bf16*)(ws + WS_WRT); const float* b_router = ap->in[13];
            unsigned* CNT = (unsigned*)(CTLP(ws) + CW_CNT) + l * 32; int* TE = (int*)(ws + WS_TE); int* TOKIDX = (int*)(ws + WS_TOKIDX); float* WTS = (float*)(ws + WS_WTS);
            { const float* g_ffn = ap->in[5];
              for (int k = tid; k < D_; k += NTHR) { sm[k] = g_ffn[l * D_ + k] * (1.f + mod[8192 + k]); sm[2048 + k] = mod[6144 + k]; }
              if (tid < 32) sm[4160 + tid] = b_router[tid]; }
            typedef short bf16x8_t __attribute__((ext_vector_type(8))); typedef float f32x16_t __attribute__((ext_vector_type(16)));
            for (int bt = bid; bt < S_ / 64; bt += G) { const int t0 = bt * 64;
                __syncthreads();
                { const float* SSP = (const float*)(ws + WS_UL);
                  for (int rr = 0; rr < 8; rr += 2) { const int row = wave * 8 + rr + (lane >> 5); float ss = SSP[(size_t)(t0 + row) * 32 + (lane & 31)];
#pragma unroll
                    for (int o = 1; o < 32; o <<= 1) ss += lane_get(ss, lane ^ o);
                    if ((lane & 31) == 0) sm[4096 + row] = 1.f / sqrtf(ss * (1.f / D_) + RMS_EPS); } }
                __syncthreads();
                { const int r = lane & 31, kh = lane >> 5; f32x16_t acc0 = {}, acc1 = {};
                  const float rs0 = sm[4096 + r], rs1 = sm[4096 + 32 + r];
#pragma unroll 2
                  for (int ks = 0; ks < 16; ++ks) { const int k = wave * 256 + ks * 16 + kh * 8;
                    const bf16x8_t wh = *(const bf16x8_t*)(WrT + (size_t)r * 2048 + k), wl = *(const bf16x8_t*)(WrT + 32 * 2048 + (size_t)r * 2048 + k);
                    const f32x4 gA = *(const LAS f32x4*)(sm + k), gB = *(const LAS f32x4*)(sm + k + 4), sA = *(const LAS f32x4*)(sm + 2048 + k), sB = *(const LAS f32x4*)(sm + 2048 + k + 4);
#pragma unroll
                    for (int rg = 0; rg < 2; ++rg) { const size_t ro = (size_t)(t0 + rg * 32 + r) * D_ + k; const float rs = rg ? rs1 : rs0;
                        const f32x4 xa = *(const f32x4*)(X + ro), xb = *(const f32x4*)(X + ro + 4);
                        const f32x4 ha = xa * rs * gA + sA, hb = xb * rs * gB + sB;
                        const unsigned h0 = pk2(ha[0], ha[1]), h1 = pk2(ha[2], ha[3]), h2 = pk2(hb[0], hb[1]), h3 = pk2(hb[2], hb[3]);
                        *(v4u*)(H + ro) = (v4u){h0, h1, h2, h3};
                        const unsigned l0 = pk2(ha[0] - bflo(h0), ha[1] - bfhi(h0)), l1 = pk2(ha[2] - bflo(h1), ha[3] - bfhi(h1)), l2 = pk2(hb[0] - bflo(h2), hb[1] - bfhi(h2)), l3 = pk2(hb[2] - bflo(h3), hb[3] - bfhi(h3));
                        const v4u hv = (v4u){h0, h1, h2, h3}, lv = (v4u){l0, l1, l2, l3};
                        const bf16x8_t ahi = __builtin_bit_cast(bf16x8_t, hv), alo = __builtin_bit_cast(bf16x8_t, lv);
                        if (rg == 0) { acc0 = __builtin_amdgcn_mfma_f32_32x32x16_bf16(wh, ahi, acc0, 0, 0, 0); acc0 = __builtin_amdgcn_mfma_f32_32x32x16_bf16(wl, ahi, acc0, 0, 0, 0); acc0 = __builtin_amdgcn_mfma_f32_32x32x16_bf16(wh, alo, acc0, 0, 0, 0); }
                        else         { acc1 = __builtin_amdgcn_mfma_f32_32x32x16_bf16(wh, ahi, acc1, 0, 0, 0); acc1 = __builtin_amdgcn_mfma_f32_32x32x16_bf16(wl, ahi, acc1, 0, 0, 0); acc1 = __builtin_amdgcn_mfma_f32_32x32x16_bf16(wh, alo, acc1, 0, 0, 0); } } }
#pragma unroll
                  for (int q = 0; q < 16; ++q) { const int e = (q & 3) + 8 * (q >> 2) + 4 * kh;
                      sm[5120 + ((wave * 2 + 0) * 32 + e) * 32 + r] = acc0[q]; sm[5120 + ((wave * 2 + 1) * 32 + e) * 32 + r] = acc1[q]; } }
                __syncthreads();
                { const int tk6 = tid & 63, eq = tid >> 6, rg = tk6 >> 5, tk = tk6 & 31;
#pragma unroll
                  for (int i = 0; i < 4; ++i) { const int e = eq * 4 + i; float s = 0.f;
#pragma unroll
                      for (int w = 0; w < 8; ++w) s += sm[5120 + ((w * 2 + rg) * 32 + e) * 32 + tk];
                      sm[5120 + 16384 + tk6 * 33 + e] = 1.f / (1.f + __expf(-s)); } }
                __syncthreads();
                if (tid < 64) { const int t = t0 + tid;
                    float lg[32];
#pragma unroll
                    for (int e = 0; e < 32; ++e) lg[e] = sm[5120 + 16384 + tid * 33 + e];
                    int grp = 0; float best = -INFINITY;
#pragma unroll
                    for (int gq = 0; gq < 4; ++gq) { float m1 = -INFINITY, m2 = -INFINITY;
#pragma unroll
                        for (int i = 0; i < 8; ++i) { const float b = lg[gq * 8 + i] + sm[4160 + gq * 8 + i]; if (b > m1) { m2 = m1; m1 = b; } else if (b > m2) m2 = b; }
                        const float sgs = m1 + m2; if (sgs > best) { best = sgs; grp = gq; } }
                    float m1 = -INFINITY, m2 = -INFINITY, s1 = 0.f, s2 = 0.f; int i1 = 0, i2 = 0;
#pragma unroll
                    for (int e = 0; e < 32; ++e) { const bool ing = (e >> 3) == grp; const float b = lg[e] + sm[4160 + e];
                        if (ing && b > m1) { m2 = m1; i2 = i1; s2 = s1; m1 = b; i1 = e; s1 = lg[e]; } else if (ing && b > m2) { m2 = b; i2 = e; s2 = lg[e]; } }
                    const float inv = 1.f / (s1 + s2);
                    const unsigned p1 = atomicAdd(CNT + i1, 1u), p2 = atomicAdd(CNT + i2, 1u);
                    TOKIDX[(size_t)i1 * ECAP + p1] = t; TOKIDX[(size_t)i2 * ECAP + p2] = t; WTS[(size_t)i1 * ECAP + p1] = s1 * inv; WTS[(size_t)i2 * ECAP + p2] = s2 * inv;
                    *(int4*)(TE + 4 * t) = make_int4(i1, (int)p1, i2, (int)p2);
                }
            }
            if (BOTH(pb + 10)) GRID_BAR();
        }
        if (IN(pb + 11)) {
            PH_IDS(); ArgsP ap = AP(); unsigned char* ws = ap->ws;
            LOAD_MOETAB((unsigned*)(CTLP(ws) + CW_CNT) + l * 32, 4);
            pg8::Gemm g{(const bf16*)(ws + WS_H), (const bf16*)(ws + WS_WGUT), 0, 0, D_}; MoeOrder<true> So{moetab, 4, G, bid, 4, l * 32 * 4, (const int*)(ws + WS_TOKIDX)};
            EpiGateUp E{(bf16*)(ws + WS_HACT)};
            pg8::gemm_phase<EpiGateUp, MoeOrder<true>, true, true>(lds, g, So, E);
            if (BOTH(pb + 11)) GRID_BAR();
        }
        if (IN(pb + 12)) {
            PH_IDS(); ArgsP ap = AP(); unsigned char* ws = ap->ws;
            LOAD_MOETAB((unsigned*)(CTLP(ws) + CW_CNT) + l * 32, 8);
            pg8::Gemm g{(const bf16*)(ws + WS_HACT), (const bf16*)(ws + WS_WDT), 0, 0, DEXP}; MoeOrder<false> So{moetab, 8, G, bid, 8, l * 32 * 8, nullptr};
            EpiDown E{(bf16*)(ws + WS_Y), (const float*)(ws + WS_WTS), moetab};
            pg8::gemm_phase<EpiDown, MoeOrder<false>, true, true>(lds, g, So, E);
            if (BOTH(pb + 12)) GRID_BAR();
        }
    }
    if (IN(NPH - 1)) {
        PH_IDS(); ArgsP ap = AP(); unsigned char* ws = ap->ws;
        float* X = ap->out; const bf16* Y = (const bf16*)(ws + WS_Y); const int* TE = (const int*)(ws + WS_TE);
        LOAD_MOETAB((unsigned*)(CTLP(ws) + CW_CNT) + 32, 1);
        const bool tmo_set = (MK_N_LAUNCHES == 1) && (__hip_atomic_load((unsigned*)(CTLP(ws) + CW_BAR) + XB_TMO, RLX_AGENT) != 0u);
        { const float* g_final = ap->in[17]; const float* MOD = (const float*)(CTLP(ws) + CW_MOD);
          for (int k = tid; k < D_; k += NTHR) { sm[k] = g_final[k]; sm[2048 + k] = MOD[12288 + 10240 + k]; } }
        __syncthreads();
        for (int t = gw; t < S_; t += NGW) {
            f32x4 v[8]; float ss = 0.f;
            const int4 te = *(const int4*)(TE + 4 * t);
            const bf16* y0 = Y + (size_t)(moetab[65 + te.x] + te.y) * D_; const bf16* y1 = Y + (size_t)(moetab[65 + te.z] + te.w) * D_;
#pragma unroll
            for (int j = 0; j < 8; ++j) { const int k = 256 * j + 4 * lane; const uint2 a = *(const uint2*)(y0 + k), b = *(const uint2*)(y1 + k);
                const f32x4 gt2 = *(const LAS f32x4*)(sm + 2048 + k);
                f32x4 ysum = (f32x4){bflo(a.x) + bflo(b.x), bfhi(a.x) + bfhi(b.x), bflo(a.y) + bflo(b.y), bfhi(a.y) + bfhi(b.y)};
                v[j] = *(const f32x4*)(X + (size_t)t * D_ + k) + gt2 * ysum;
                ss += (v[j][0] * v[j][0] + v[j][1] * v[j][1]) + (v[j][2] * v[j][2] + v[j][3] * v[j][3]); }
            const float rstd = (tmo_set ? __builtin_nanf("") : 1.f) / sqrtf(wave_sum(ss, lane) * (1.f / D_) + RMS_EPS);
#pragma unroll
            for (int j = 0; j < 8; ++j) { const int k = 256 * j + 4 * lane; *(f32x4*)(X + (size_t)t * D_ + k) = v[j] * rstd * *(const LAS f32x4*)(sm + k); }
        }
    }
#undef IN
#undef BOTH
#undef GRID_BAR
#undef LOAD_MOETAB
#undef AP
#undef CTLP
#undef PH_IDS
}

extern "C" void kernel_launch(void* const* d_in, const int* in_sizes, int n_in, void* d_out, int out_size, void* d_ws, size_t ws_size, hipStream_t stream) {
    static int grid = 0;
    if (grid == 0) {
        if (n_in != 18 || out_size != S_ * D_ || ws_size < WS_END) { fprintf(stderr, "kernel_launch: unexpected shapes (n_in %d out %d ws %zu)\n", n_in, out_size, ws_size); grid = -1; return; }
        int dev = 0, cus = 0, per_cu = 0;
        if (hipGetDevice(&dev) != hipSuccess || hipDeviceGetAttribute(&cus, hipDeviceAttributeMultiprocessorCount, dev) != hipSuccess) { grid = -1; return; }
        if (hipFuncSetAttribute((const void*)mk_fwd, hipFuncAttributeMaxDynamicSharedMemorySize, LDS_BYTES) != hipSuccess) { fprintf(stderr, "kernel_launch: hipFuncSetAttribute failed\n"); grid = -1; return; }
        if (hipOccupancyMaxActiveBlocksPerMultiprocessor(&per_cu, (const void*)mk_fwd, NTHR, LDS_BYTES) != hipSuccess || per_cu < 1) { fprintf(stderr, "kernel_launch: occupancy query says %d\n", per_cu); }
        (void)hipGetLastError();
        grid = cus;
    }
    if (grid < 0) return;
    if (hipMemsetAsync((char*)d_ws + WS_CTL, 0, CTL_ZERO_BYTES, stream) != hipSuccess) return;
    Args a{};
    for (int i = 0; i < 18; ++i) a.in[i] = (const float*)d_in[i];
    a.out = (float*)d_out; a.ws = (unsigned char*)d_ws; a.pad = 0;
    if (MK_N_LAUNCHES == 1) {
        a.ph_lo = 0; a.ph_hi = NPH; a.li = 0;
        hipLaunchKernelGGL(mk_fwd, dim3(grid), dim3(NTHR), LDS_BYTES, stream, a);
    } else {
        for (int p = 0; p < NPH; ++p) { a.ph_lo = p; a.ph_hi = p + 1; a.li = p; hipLaunchKernelGGL(mk_fwd, dim3(grid), dim3(NTHR), LDS_BYTES, stream, a); }
    }
}
```

```cpp
#include <hip/hip_runtime.h>
#include <cstdio>
#include <cstdint>


#define WIDTAB_OFF (131072 + 1024)
__device__ __forceinline__ int wg_tid(const __attribute__((address_space(3))) int* widtab) {
    unsigned hw; asm volatile("s_getreg_b32 %0, hwreg(HW_REG_HW_ID, 0, 6)" : "=s"(hw));
    int lane; asm volatile("v_mbcnt_lo_u32_b32 %0, -1, 0\n\tv_mbcnt_hi_u32_b32 %0, -1, %0" : "=v"(lane));
    return widtab[hw] * 64 + lane;
}

namespace pg8 {
#define PG8_LAS __attribute__((address_space(3)))
typedef unsigned short bf16_t;
typedef short bf16x8 __attribute__((ext_vector_type(8)));
typedef float f32x4 __attribute__((ext_vector_type(4)));
typedef unsigned u32x4 __attribute__((ext_vector_type(4)));
constexpr int BM = 256, BK = 64, HALF = 128, HTB = HALF * BK * 2, STAGE_BYTES = 8 * HTB, NXCD = 8, WGM = 8;

__host__ __device__ __forceinline__ int lds_byte(int r, int c) { const int st = (r >> 4) * 2 + (c >> 5), rr = r & 15, cc = c & 31, ob = rr * 64 + cc * 2; return st * 1024 + (ob ^ (((ob >> 9) & 1) << 5)); }
__host__ __device__ __forceinline__ void stage_rc(int b, int& R, int& C) { const int st = b / 1024, sb = b % 1024, swz = sb ^ (((sb >> 9) & 1) << 5); R = (st >> 1) * 16 + swz / 64; C = (st & 1) * 32 + (swz % 64) / 2; }
__host__ __device__ __forceinline__ int perm32(int rho) { const int n = rho >> 4, i = rho & 15; return 8 * (i >> 2) + 4 * n + (i & 3); }

struct Unit { int pm, pn, e, mt, pnl; };
struct Gemm { const bf16_t* A; const bf16_t* Bt; int M, N, K; };

struct StaticOrder {
    static constexpr bool GATHER = false;
    int nM, nN, nwg, G, c;
    __host__ __device__ void init(int M, int N, int G_, int c_) { nM = M / BM; nN = N / BM; nwg = nM * nN; G = G_; c = c_; }
    __host__ __device__ bool next(int i, Unit& u) const {
        const long L = (long)i * G + c; if (L >= nwg) return false;
        int wgid = (int)L; { const int q = nwg / NXCD, r = nwg % NXCD, xcd = wgid % NXCD, off = wgid / NXCD; wgid = (xcd < r ? xcd * (q + 1) : r * (q + 1) + (xcd - r) * q) + off; }
        const int nig = WGM * nN, gid = wgid / nig, fm = gid * WGM, gsz = (nM - fm) < WGM ? (nM - fm) : WGM;
        u.pm = fm + ((wgid % nig) % gsz); u.pn = (wgid % nig) / gsz; u.e = 0; u.mt = 0; u.pnl = u.pn; return true;
    }
    __device__ __forceinline__ void a_offs(const Unit&, int, int, int, int, int, unsigned (&)[2][2]) const {}
    __device__ __forceinline__ void a_ready(const Unit&) const {}
    __device__ __forceinline__ void done(const Unit&) const {}
};

__device__ __forceinline__ unsigned cvt_pk_bf16(float lo, float hi) { unsigned r; asm volatile("v_cvt_pk_bf16_f32 %0, %1, %2" : "=v"(r) : "v"(lo), "v"(hi)); return r; }

template <class Epi, class Sched, bool ALIGN_EPI = false, bool SP2 = false>
__device__ __forceinline__ void gemm_phase(PG8_LAS unsigned char* lds, const Gemm g, const Sched& S, const Epi& E) {
    const int tid_ = wg_tid((const PG8_LAS int*)(lds + WIDTAB_OFF));
    const int tid = tid_, wid = __builtin_amdgcn_readfirstlane(tid >> 6), lane = tid & 63, wr = wid >> 2, wc = wid & 3, fr = lane & 15, fq = lane >> 4;
    const int K = g.K, nt = K / BK;
    unsigned voffA[2], voffB[2]; int RR[2], CC[2];
#pragma unroll
    for (int i = 0; i < 2; ++i) { int R, C; stage_rc(tid * 16 + i * 8192, R, C); const int Rb = Epi::PERM ? ((R & ~31) + perm32(R & 31)) : R;
        RR[i] = R; CC[i] = C; voffA[i] = (unsigned)(R * K + C) * 2u; voffB[i] = (unsigned)(Rb * K + C) * 2u; }
    const size_t kstep = (size_t)(BK * 2);
    const size_t hstep = (size_t)HALF * K * 2;
    const size_t tstep = 2 * hstep;
    const unsigned ldsw = (unsigned)wid * 1024u;
    const int aoff = lds_byte(wr * 64 + fr, fq * 8), boff = lds_byte(wc * 32 + fr, fq * 8);
    const char* gA = (const char*)g.A;
    unsigned aoC[2][2] = {{0u, 0u}, {0u, 0u}}, aoN[2][2] = {{0u, 0u}, {0u, 0u}};
#define PG8_SA(b, h) (((b) * 2 + (h)) * HTB)
#define PG8_SB(b, h) ((4 + (b) * 2 + (h)) * HTB)
#define PG8_STAGE(bufoff, gbase, voff) do { _Pragma("unroll") for (int _i = 0; _i < 2; ++_i) \
        __builtin_amdgcn_global_load_lds((const unsigned*)((const char*)(gbase) + (voff)[_i]), (PG8_LAS unsigned*)(lds + (bufoff) + ldsw + _i * 8192), 16, 0, 0); } while (0)
#define PG8_STAGE_A(bufoff, h, PN, KO) do { if constexpr (Sched::GATHER) { _Pragma("unroll") for (int _i = 0; _i < 2; ++_i) \
        __builtin_amdgcn_global_load_lds((const unsigned*)(gA + aoC[h][_i] + (KO)), (PG8_LAS unsigned*)(lds + (bufoff) + ldsw + _i * 8192), 16, 0, 0); } \
        else { PG8_STAGE(bufoff, (PN) + (h) * hstep, voffA); } } while (0)
#define PG8_LDA(dst, b, h) do { _Pragma("unroll") for (int m = 0; m < 4; ++m) _Pragma("unroll") for (int k = 0; k < 2; ++k) dst[m][k] = *(const PG8_LAS bf16x8*)(lds + PG8_SA(b, h) + aoff + m * 2048 + k * 1024); } while (0)
#define PG8_LDB(dst, b, h) do { _Pragma("unroll") for (int n = 0; n < 2; ++n) _Pragma("unroll") for (int k = 0; k < 2; ++k) dst[n][k] = *(const PG8_LAS bf16x8*)(lds + PG8_SB(b, h) + boff + n * 2048 + k * 1024); } while (0)
#define PG8_MMA(ai, bj, At, Bt) do { __builtin_amdgcn_s_setprio(1); _Pragma("unroll") for (int m = 0; m < 4; ++m) _Pragma("unroll") for (int n = 0; n < 2; ++n) _Pragma("unroll") for (int k = 0; k < 2; ++k) \
        acc[ai][bj][m][n] = __builtin_amdgcn_mfma_f32_16x16x32_bf16(Bt[n][k], At[m][k], acc[ai][bj][m][n], 0, 0, 0); __builtin_amdgcn_s_setprio(0); } while (0)
#define PG8_WAIT_V(n) asm volatile("s_waitcnt vmcnt(" #n ")" ::: "memory")
#define PG8_WAIT_L(n) asm volatile("s_waitcnt lgkmcnt(" #n ")" ::: "memory")
#define PG8_BAR __builtin_amdgcn_s_barrier()
#define PG8_SCHED __builtin_amdgcn_sched_barrier(0)
    Unit cur, nxt; int ui = 0;
    if (!S.next(0, cur)) return;
    f32x4 acc[2][2][4][2];
#pragma unroll
    for (int a = 0; a < 2; ++a)
#pragma unroll
        for (int b = 0; b < 2; ++b)
#pragma unroll
            for (int m = 0; m < 4; ++m)
#pragma unroll
                for (int n = 0; n < 2; ++n) acc[a][b][m][n] = (f32x4){0.f, 0.f, 0.f, 0.f};
    bf16x8 At[4][2], B0[2][2], B1[2][2];
    const char* cA = (const char*)g.A + (size_t)cur.pm * tstep; const char* cB = (const char*)g.Bt + (size_t)cur.pn * tstep;
    if constexpr (Sched::GATHER) S.a_offs(cur, RR[0], RR[1], CC[0], CC[1], K, aoC);
    S.a_ready(cur);
    if constexpr (SP2) {
        PG8_STAGE(PG8_SB(0, 0), cB, voffB); PG8_STAGE(PG8_SB(0, 1), cB + hstep, voffB); PG8_STAGE_A(PG8_SA(0, 0), 0, cA, 0); PG8_STAGE_A(PG8_SA(0, 1), 1, cA, 0);
        if (wr == 1) PG8_BAR;
        PG8_WAIT_V(2); PG8_BAR;
        PG8_STAGE(PG8_SB(1, 0), cB + kstep, voffB); PG8_STAGE_A(PG8_SA(1, 0), 0, cA + kstep, kstep); PG8_STAGE(PG8_SB(1, 1), cB + hstep + kstep, voffB);
        PG8_WAIT_V(6); PG8_BAR;
    } else {
        PG8_STAGE(PG8_SB(0, 0), cB, voffB); PG8_STAGE_A(PG8_SA(0, 0), 0, cA, 0); PG8_STAGE(PG8_SB(0, 1), cB + hstep, voffB); PG8_STAGE_A(PG8_SA(0, 1), 1, cA, 0);
        if (wr == 1) PG8_BAR;
        PG8_WAIT_V(4); PG8_BAR;
        PG8_STAGE(PG8_SB(1, 0), cB + kstep, voffB); PG8_STAGE_A(PG8_SA(1, 0), 0, cA + kstep, kstep); PG8_STAGE(PG8_SB(1, 1), cB + hstep + kstep, voffB);
        PG8_WAIT_V(6); PG8_BAR;
    }
    for (;;) {
        const bool has_next = S.next(ui + 1, nxt);
        const char* nA = has_next ? (const char*)g.A + (size_t)nxt.pm * tstep : cA; const char* nB = has_next ? (const char*)g.Bt + (size_t)nxt.pn * tstep : cB;
        if constexpr (Sched::GATHER) {
            if (has_next) S.a_offs(nxt, RR[0], RR[1], CC[0], CC[1], K, aoN);
            else {
#pragma unroll
                for (int h = 0; h < 2; ++h)
#pragma unroll
                    for (int i = 0; i < 2; ++i) aoN[h][i] = aoC[h][i]; }
        }
        for (int t = 0; t < nt; t += 2) {
            const bool last = (t == nt - 2);
            const char* a1 = cA + (size_t)(t + 1) * kstep;
            const char* a2 = last ? nA : cA + (size_t)(t + 2) * kstep; const char* b2 = last ? nB : cB + (size_t)(t + 2) * kstep;
            const char* a3 = a2 + kstep; const char* b3 = b2 + kstep;
            const size_t k1 = (size_t)(t + 1) * kstep, k2 = last ? (size_t)0 : (size_t)(t + 2) * kstep, k3 = k2 + kstep;
            if (last && has_next) S.a_ready(nxt);
            if constexpr (SP2) {
            PG8_LDB(B0, 0, 0); PG8_LDB(B1, 0, 1); PG8_SCHED; PG8_LDA(At, 0, 0); PG8_STAGE_A(PG8_SA(1, 1), 1, a1, k1);
            if constexpr (Sched::GATHER) { if (last) {
#pragma unroll
                for (int h = 0; h < 2; ++h)
#pragma unroll
                    for (int i = 0; i < 2; ++i) aoC[h][i] = aoN[h][i]; } }
            PG8_WAIT_V(8); PG8_WAIT_L(0); PG8_BAR; PG8_MMA(0, 0, At, B0); PG8_MMA(0, 1, At, B1); PG8_BAR; PG8_SCHED;
            PG8_LDA(At, 0, 1); PG8_STAGE(PG8_SB(0, 0), b2, voffB); PG8_STAGE(PG8_SB(0, 1), b2 + hstep, voffB); PG8_STAGE_A(PG8_SA(0, 0), 0, a2, k2);
            PG8_WAIT_V(8); PG8_WAIT_L(0); PG8_BAR; PG8_MMA(1, 0, At, B0); PG8_MMA(1, 1, At, B1); PG8_BAR; PG8_SCHED;
            PG8_LDB(B0, 1, 0); PG8_LDB(B1, 1, 1); PG8_SCHED; PG8_LDA(At, 1, 0); PG8_STAGE_A(PG8_SA(0, 1), 1, a2, k2);
            PG8_WAIT_V(8); PG8_WAIT_L(0); PG8_BAR; PG8_MMA(0, 0, At, B0); PG8_MMA(0, 1, At, B1); PG8_BAR; PG8_SCHED;
            PG8_LDA(At, 1, 1); PG8_STAGE(PG8_SB(1, 0), b3, voffB); PG8_STAGE(PG8_SB(1, 1), b3 + hstep, voffB); PG8_STAGE_A(PG8_SA(1, 0), 0, a3, k3);
            PG8_WAIT_V(8); PG8_WAIT_L(0); PG8_BAR; PG8_MMA(1, 0, At, B0); PG8_MMA(1, 1, At, B1); PG8_BAR; PG8_SCHED;
            } else {
            PG8_LDB(B0, 0, 0); PG8_SCHED; PG8_LDA(At, 0, 0); PG8_STAGE_A(PG8_SA(1, 1), 1, a1, k1);
            if constexpr (Sched::GATHER) { if (last) {
#pragma unroll
                for (int h = 0; h < 2; ++h)
#pragma unroll
                    for (int i = 0; i < 2; ++i) aoC[h][i] = aoN[h][i]; } }
            PG8_WAIT_L(8); PG8_BAR; PG8_WAIT_L(0); PG8_MMA(0, 0, At, B0); PG8_BAR; PG8_SCHED;
            PG8_LDB(B1, 0, 1); PG8_STAGE(PG8_SB(0, 0), b2, voffB);
            PG8_BAR; PG8_WAIT_L(0); PG8_MMA(0, 1, At, B1); PG8_BAR;
            PG8_LDA(At, 0, 1); PG8_STAGE_A(PG8_SA(0, 0), 0, a2, k2);
            PG8_BAR; PG8_WAIT_L(0); PG8_MMA(1, 0, At, B0); PG8_BAR; PG8_SCHED;
            PG8_STAGE(PG8_SB(0, 1), b2 + hstep, voffB);
            PG8_WAIT_V(6); PG8_BAR; PG8_MMA(1, 1, At, B1); PG8_BAR;
            PG8_LDB(B0, 1, 0); PG8_SCHED; PG8_LDA(At, 1, 0); PG8_STAGE_A(PG8_SA(0, 1), 1, a2, k2);
            PG8_WAIT_L(8); PG8_BAR; PG8_WAIT_L(0); PG8_MMA(0, 0, At, B0); PG8_BAR; PG8_SCHED;
            PG8_LDB(B1, 1, 1); PG8_STAGE(PG8_SB(1, 0), b3, voffB);
            PG8_BAR; PG8_WAIT_L(0); PG8_MMA(0, 1, At, B1); PG8_BAR;
            PG8_LDA(At, 1, 1); PG8_STAGE_A(PG8_SA(1, 0), 0, a3, k3);
            PG8_BAR; PG8_WAIT_L(0); PG8_MMA(1, 0, At, B0); PG8_BAR; PG8_SCHED;
            PG8_STAGE(PG8_SB(1, 1), b3 + hstep, voffB);
            PG8_WAIT_V(6); PG8_BAR; PG8_MMA(1, 1, At, B1); PG8_BAR;
            }
        }
        if constexpr (ALIGN_EPI) { if (wr == 0) PG8_BAR; }
        E(acc, cur, wr, wc, fr, fq); S.done(cur);
        if (!has_next) break;
#pragma unroll
        for (int a = 0; a < 2; ++a)
#pragma unroll
            for (int b = 0; b < 2; ++b)
#pragma unroll
                for (int m = 0; m < 4; ++m)
#pragma unroll
                    for (int n = 0; n < 2; ++n) acc[a][b][m][n] = (f32x4){0.f, 0.f, 0.f, 0.f};
        cur = nxt; cA = nA; cB = nB; ++ui;
        if constexpr (ALIGN_EPI) { if (wr == 1) PG8_BAR; }
    }
    PG8_WAIT_V(0);
    if constexpr (!ALIGN_EPI) { if (wr == 0) PG8_BAR; }
    PG8_BAR;
#undef PG8_SA
#undef PG8_SB
#undef PG8_STAGE
#undef PG8_STAGE_A
#undef PG8_LDA
#undef PG8_LDB
#undef PG8_MMA
#undef PG8_WAIT_V
#undef PG8_WAIT_L
#undef PG8_BAR
#undef PG8_SCHED
}
}

#ifndef MK_N_LAUNCHES
#define MK_N_LAUNCHES 1
#endif
constexpr int NWAVES = 8, NTHR = 512;
constexpr int S_ = 16384, D_ = 2048, DEPTH = 2, HD = 128;
constexpr int IN_W = 5656, NIN = 5888;
constexpr int NC = 1023;
constexpr int NEXP = 32, DEXP = 512, ECAP = 16384, NSLOT = 40960;
constexpr float RMS_EPS = 1e-6f;
constexpr float ATT_SCALE = 0.08838834764831845f;
constexpr int NPL = 13, NPH = 2 + 2 * NPL;

constexpr size_t MiB = 1u << 20;
constexpr size_t WS_CTL = 0, CTL_ZERO_BYTES = 1 * MiB;
constexpr size_t WS_ROPE = 1 * MiB, WS_WINT = 9 * MiB, WS_WOUTT = 55 * MiB, WS_WGUT = 71 * MiB, WS_WDT = 327 * MiB, WS_WC1T = 455 * MiB;
constexpr size_t WS_H = 463 * MiB, WS_QN = 527 * MiB, WS_QM = 559 * MiB, WS_KM = 591 * MiB, WS_VM = 623 * MiB;
constexpr size_t WS_KC = 655 * MiB, WS_VC = 663 * MiB, WS_KS = 671 * MiB, WS_VS = 679 * MiB, WS_KW = 687 * MiB, WS_VW = 695 * MiB;
constexpr size_t WS_GATES = 703 * MiB, WS_UL = 705 * MiB, WS_KCMP = 713 * MiB, WS_VCMP = 713 * MiB + 512 * 1024, WS_KMEAN = 714 * MiB;
constexpr size_t WS_OMIX = 715 * MiB, WS_OCMP = 779 * MiB, WS_OWIN = 811 * MiB, WS_SEL = 843 * MiB, WS_TE = 845 * MiB, WS_TOKIDX = 846 * MiB, WS_WTS = 848 * MiB;
constexpr size_t WS_HACT = 850 * MiB, WS_Y = 890 * MiB;
constexpr size_t WS_WRT = 714 * MiB + 256 * 1024;
constexpr size_t WS_IMP = WS_H + 32 * MiB;
constexpr size_t WS_NLIST = WS_H, WS_PSLC = 850 * MiB, WS_LSEN = 1106 * MiB;
constexpr size_t WS_MLIST = 1050 * MiB, WS_PSEL = 1082 * MiB, WS_POWN = 1178 * MiB, WS_LSES = 1210 * MiB, WS_LSEO = 1211 * MiB + 512 * 1024, WS_END = 1212 * MiB;
constexpr int CW_TMO = 0, CW_BAR = 4096, CW_CNT = 8192, CW_MOD = 16384, CW_B1E = 40960, CW_MCNT = 65536, CW_NCNT = 131072, CSTR = 64;

constexpr int RING_BYTES = 131072, LDSCTL_OFF = RING_BYTES, MISC_OFF = LDSCTL_OFF + 320, MOETAB_OFF = LDSCTL_OFF + 512, LDS_BYTES = 147456;

#define GAS __attribute__((address_space(1)))
#define LAS __attribute__((address_space(3)))
typedef unsigned short bf16;
typedef unsigned v4u __attribute__((ext_vector_type(4)));
typedef float f32x4 __attribute__((ext_vector_type(4)));
typedef float f32x2 __attribute__((ext_vector_type(2)));
typedef GAS unsigned gu32;
#define RLX_AGENT __ATOMIC_RELAXED, __HIP_MEMORY_SCOPE_AGENT
#define LDS_WAIT() asm volatile("s_waitcnt lgkmcnt(0)" ::: "memory")
__device__ __forceinline__ unsigned f2bf(float f) { unsigned u = __builtin_bit_cast(unsigned, f); return (u + 0x7fffu + ((u >> 16) & 1u)) >> 16; }
__device__ __forceinline__ unsigned pk2(float lo, float hi) { return f2bf(lo) | (f2bf(hi) << 16); }
__device__ __forceinline__ float bf2f(unsigned b) { return __builtin_bit_cast(float, b << 16); }
__device__ __forceinline__ float bflo(unsigned w) { return __builtin_bit_cast(float, w << 16); }
__device__ __forceinline__ float bfhi(unsigned w) { return __builtin_bit_cast(float, w & 0xffff0000u); }

#define XB_TMO      128
#define XB_XCNT(j)  (256  + 64 * (j))
#define XB_XSUB(j)  (1280 + 64 * (j))
#define XB_XGEN(j)  (2304 + 64 * (j))
#define XB_TOP      3328
#define XB_TOPGEN   3392
#define XCD_BAR_WORDS 3456
#define XB_SPIN_CAP (1u << 20)
__device__ __forceinline__ unsigned xb_ld(unsigned* p)              { return __hip_atomic_load(p, __ATOMIC_RELAXED, __HIP_MEMORY_SCOPE_AGENT); }
__device__ __forceinline__ unsigned xb_add(unsigned* p, unsigned v) { return __hip_atomic_fetch_add(p, v, __ATOMIC_RELAXED, __HIP_MEMORY_SCOPE_AGENT); }
__device__ __forceinline__ unsigned xb_xcc_id() { return (unsigned)__builtin_amdgcn_s_getreg((3 << 11) | 20) & 0xFu; }
#define XB_SPIN(cond, bar) do { unsigned _sp = 0; while (cond) { __builtin_amdgcn_s_sleep(1); \
    if ((++_sp & 255u) == 0u) { if (xb_ld(&(bar)[XB_TMO])) break; if (_sp > XB_SPIN_CAP) { atomicAdd(&(bar)[XB_TMO], 1u); break; } } } } while (0)
struct XcdBarrier { unsigned* bar; unsigned x; volatile LAS unsigned* st; };
__device__ __forceinline__ XcdBarrier xcd_barrier_post(unsigned* bar, volatile LAS unsigned* st) {
    XcdBarrier b; b.bar = bar; b.x = xb_xcc_id(); b.st = st;
    if (threadIdx.x == 0) (void)xb_add(&bar[XB_XCNT(b.x)], 1u);
    return b;
}
__device__ __forceinline__ void xcd_barrier_complete(unsigned* bar, unsigned x, unsigned& nloc, unsigned& nx) {
    const unsigned G = gridDim.x * gridDim.y * gridDim.z;
    unsigned sum, cnt, mine, sp = 0u;
    for (;;) {
        sum = 0u; cnt = 0u; mine = 0u;
#pragma unroll
        for (unsigned j = 0; j < 16; ++j) { const unsigned c = xb_ld(&bar[XB_XCNT(j)]); sum += c; cnt += (c > 0u) ? 1u : 0u; mine = (j == x) ? c : mine; }
        if (sum == G) break;
        __builtin_amdgcn_s_sleep(1);
        if ((++sp & 255u) == 0u) { if (xb_ld(&bar[XB_TMO])) break; if (sp > XB_SPIN_CAP) { atomicAdd(&bar[XB_TMO], 1u); break; } }
    }
    nloc = mine > 0u ? mine : 1u; nx = cnt > 0u ? cnt : 1u;
}
__device__ __forceinline__ void xcd_barrier(const XcdBarrier& b, bool leader  ) {
    asm volatile("s_waitcnt vmcnt(0)" ::: "memory");
    __syncthreads();
    if (leader) {
        unsigned* bar = b.bar;
        __builtin_amdgcn_s_waitcnt(0);
        unsigned nloc = b.st[0], nx = b.st[1];
        if (nloc == 0u) { xcd_barrier_complete(bar, b.x, nloc, nx); b.st[0] = nloc; b.st[1] = nx; }
        const unsigned old = xb_add(&bar[XB_XSUB(b.x)], 1u);
        const unsigned gen = old / nloc;
        if (old + 1u == (gen + 1u) * nloc) {
            __builtin_amdgcn_fence(__ATOMIC_RELEASE, "agent");
            asm volatile("s_waitcnt vmcnt(0)" ::: "memory");
            const unsigned og = xb_add(&bar[XB_TOP], 1u);
            const unsigned tg = og / nx;
            if (og + 1u == (tg + 1u) * nx) xb_add(&bar[XB_TOPGEN], 1u);
            else XB_SPIN(xb_ld(&bar[XB_TOPGEN]) == tg, bar);
            __builtin_amdgcn_fence(__ATOMIC_ACQUIRE, "agent");
            xb_add(&bar[XB_XGEN(b.x)], 1u);
            asm volatile("s_waitcnt vmcnt(0)" ::: "memory");
        } else {
            XB_SPIN(xb_ld(&bar[XB_XGEN(b.x)]) == gen, bar);
            __builtin_amdgcn_fence(__ATOMIC_ACQUIRE, "agent");
            asm volatile("s_waitcnt vmcnt(0)" ::: "memory");
        }
    }
    __syncthreads();
}

__device__ __forceinline__ float lane_get(float v, int src) { return __builtin_bit_cast(float, __builtin_amdgcn_ds_bpermute(src << 2, __builtin_bit_cast(int, v))); }
__device__ __forceinline__ int lane_geti(int v, int src) { return __builtin_amdgcn_ds_bpermute(src << 2, v); }
__device__ __forceinline__ float wave_sum(float v, int lane) {
#pragma unroll
    for (int o = 1; o < 64; o <<= 1) v += lane_get(v, lane ^ o);
    return v;
}
__device__ __forceinline__ int block_excl_scan(int v, LAS int* scr, int tid, int* tot) {
    const int lane = tid & 63, wv = tid >> 6; int s = v;
#pragma unroll
    for (int o = 1; o < 64; o <<= 1) { const int n = lane_geti(s, lane - o); if (lane >= o) s += n; }
    if (lane == 63) scr[wv] = s;
    __syncthreads();
    int off = 0, all = 0;
#pragma unroll
    for (int w = 0; w < 8; ++w) { const int x = scr[w]; all += x; off += (w < wv) ? x : 0; }
    *tot = all;
    __syncthreads();
    return off + s - v;
}

__device__ __forceinline__ float row_max16(float v) {
    v = fmaxf(v, __builtin_bit_cast(float, __builtin_amdgcn_update_dpp(0, __builtin_bit_cast(int, v), 0xB1, 0xF, 0xF, false)));
    v = fmaxf(v, __builtin_bit_cast(float, __builtin_amdgcn_update_dpp(0, __builtin_bit_cast(int, v), 0x4E, 0xF, 0xF, false)));
    v = fmaxf(v, __builtin_bit_cast(float, __builtin_amdgcn_update_dpp(0, __builtin_bit_cast(int, v), 0x124, 0xF, 0xF, false)));
    v = fmaxf(v, __builtin_bit_cast(float, __builtin_amdgcn_update_dpp(0, __builtin_bit_cast(int, v), 0x128, 0xF, 0xF, false)));
    return v;
}
__device__ __forceinline__ int row_min16(int v) {
    v = min(v, __builtin_amdgcn_update_dpp(0, v, 0xB1, 0xF, 0xF, false));
    v = min(v, __builtin_amdgcn_update_dpp(0, v, 0x4E, 0xF, 0xF, false));
    v = min(v, __builtin_amdgcn_update_dpp(0, v, 0x124, 0xF, 0xF, false));
    v = min(v, __builtin_amdgcn_update_dpp(0, v, 0x128, 0xF, 0xF, false));
    return v;
}
template <int NV>
__device__ __forceinline__ int row_pick(float (&v)[NV], int lam) {
    float m = v[0];
#pragma unroll
    for (int i = 1; i < NV; ++i) m = fmaxf(m, v[i]);
    m = row_max16(m);
    int idx = 1 << 20;
#pragma unroll
    for (int i = NV - 1; i >= 0; --i) idx = (v[i] == m) ? lam + 16 * i : idx;
    idx = row_min16(idx);
    if (m == -INFINITY) idx = -1;
#pragma unroll
    for (int i = 0; i < NV; ++i) v[i] = (lam + 16 * i == idx) ? -INFINITY : v[i];
    return idx;
}

__device__ __forceinline__ int il(int d) { return (d < 64) ? 2 * d : 2 * (d - 64) + 1; }
__device__ __forceinline__ int inproj_row(int s) {
    if (s < 1024) return (s & ~127) + il(s & 127);
    if (s < 1536) return s;
    if (s < 1792) return (s & ~127) + il(s & 127);
    if (s < 2048) return s;
    if (s < 2304) return (s & ~127) + il(s & 127);
    if (s < 2560) return s;
    if (s < 2584) return 5632 + (s - 2560);
    if (s < 3608) { const int r = s - 2584; return 2560 + (r & ~127) + il(r & 127); }
    if (s < 4632) { const int r = s - 3608; return 3584 + (r & ~127) + il(r & 127); }
    return 4608 + (s - 4632);
}
template <int MODE>
__device__ __forceinline__ void transpose_item(const float* W, int K, int N, bf16* WT, int dpitch, int row_off, LAS float* scr, int item, int lane) {
    const int nblk = (N + 31) / 32, kb = item / nblk, nb = item % nblk, k0 = 64 * kb, n0 = 32 * nb;
    const int nsrc = n0 + (lane & 31);
#pragma unroll 8
    for (int i = 0; i < 32; ++i) { const int kk = 2 * i + (lane >> 5); scr[kk * 33 + (lane & 31)] = (nsrc < N) ? W[(size_t)(k0 + kk) * N + nsrc] : 0.f; }
    LDS_WAIT(); asm volatile("" ::: "memory");
    const int c = lane & 7;
#pragma unroll
    for (int j = 0; j < 4; ++j) { const int nl = (lane >> 3) + 8 * j, n = n0 + nl; const LAS float* s = scr + (8 * c) * 33 + nl;
        v4u o; o.x = pk2(s[0 * 33], s[1 * 33]); o.y = pk2(s[2 * 33], s[3 * 33]); o.z = pk2(s[4 * 33], s[5 * 33]); o.w = pk2(s[6 * 33], s[7 * 33]);
        if (n < N) { int dr;
            if (MODE == 0) dr = n; else if (MODE == 1) dr = inproj_row(n); else if (MODE == 2) dr = (n >> 7) * 256 + (n & 127); else dr = (n >> 7) * 256 + 128 + (n & 127);
            *(GAS v4u*)(WT + (size_t)(row_off + dr) * dpitch + k0 + 8 * c) = o; } }
    LDS_WAIT(); asm volatile("" ::: "memory");
}

using pg8::Unit;
struct EpiInProj {
    static constexpr bool PERM = true;
    bf16 *QN, *KC, *VC, *KS, *VS, *KW, *VW, *QM, *KM, *VM; float* GATES; const float* rope;
    __device__ __forceinline__ void operator()(const f32x4 (&acc)[2][2][4][2], const Unit& u, int wr, int wc, int fr, int fq) const {
        const int pn = u.pn, row0 = u.pm * 256 + wr * 64 + fr, c8 = wc * 32 + 8 * fq;
        if (pn == 22) {
            if (c8 < 24) {
#pragma unroll
                for (int ai = 0; ai < 2; ++ai)
#pragma unroll
                    for (int m = 0; m < 4; ++m) { const int row = row0 + ai * 128 + m * 16; float* gp = GATES + (size_t)row * 32 + c8;
                        f32x4 a = acc[ai][0][m][0], b = acc[ai][0][m][1], ga, gb;
#pragma unroll
                        for (int j = 0; j < 4; ++j) { ga[j] = 1.f / (1.f + __expf(-a[j])); gb[j] = 1.f / (1.f + __expf(-b[j])); }
                        *(f32x4*)gp = ga; *(f32x4*)(gp + 4) = gb; }
            }
            return;
        }
        bf16* base; int pitch; size_t bjs; bool rot;
        if (pn < 4)       { base = QN + pn * 256;        pitch = 1024; bjs = 128; rot = true; }
        else if (pn == 4) { base = KC;                   pitch = 128;  bjs = (size_t)S_ * 128; rot = false; }
        else if (pn == 5) { base = VC;                   pitch = 128;  bjs = (size_t)S_ * 128; rot = false; }
        else if (pn == 6) { base = KS;                   pitch = 256;  bjs = 128; rot = true; }
        else if (pn == 7) { base = VS;                   pitch = 256;  bjs = 128; rot = false; }
        else if (pn == 8) { base = KW;                   pitch = 256;  bjs = 128; rot = true; }
        else if (pn == 9) { base = VW;                   pitch = 256;  bjs = 128; rot = false; }
        else if (pn < 14) { base = QM + (pn - 10) * 256; pitch = 1024; bjs = 128; rot = true; }
        else if (pn < 18) { base = KM + (pn - 14) * 256; pitch = 1024; bjs = 128; rot = true; }
        else              { base = VM + (pn - 18) * 256; pitch = 1024; bjs = 128; rot = false; }
#pragma unroll
        for (int ai = 0; ai < 2; ++ai)
#pragma unroll
            for (int m = 0; m < 4; ++m) { const int row = row0 + ai * 128 + m * 16;
                f32x4 t0 = (f32x4){1.f, 0.f, 1.f, 0.f}, t1 = t0;
                if (rot) { const f32x4* tp = (const f32x4*)(rope + (size_t)row * 128 + (c8 >> 1) * 2); t0 = tp[0]; t1 = tp[1]; }
#pragma unroll
                for (int bj = 0; bj < 2; ++bj) { f32x4 v0 = acc[ai][bj][m][0], v1 = acc[ai][bj][m][1];
                    if (rot) { f32x4 w0, w1;
                        w0[0] = v0[0] * t0[0] - v0[1] * t0[1]; w0[1] = v0[1] * t0[0] + v0[0] * t0[1]; w0[2] = v0[2] * t0[2] - v0[3] * t0[3]; w0[3] = v0[3] * t0[2] + v0[2] * t0[3];
                        w1[0] = v1[0] * t1[0] - v1[1] * t1[1]; w1[1] = v1[1] * t1[0] + v1[0] * t1[1]; w1[2] = v1[2] * t1[2] - v1[3] * t1[3]; w1[3] = v1[3] * t1[2] + v1[2] * t1[3];
                        v0 = w0; v1 = w1; }
                    pg8::u32x4 w; w.x = pg8::cvt_pk_bf16(v0[0], v0[1]); w.y = pg8::cvt_pk_bf16(v0[2], v0[3]); w.z = pg8::cvt_pk_bf16(v1[0], v1[1]); w.w = pg8::cvt_pk_bf16(v1[2], v1[3]);
                    *(pg8::u32x4*)(base + (size_t)row * pitch + bj * bjs + c8) = w; } }
    }
};
struct EpiOutProj {
    static constexpr bool PERM = false;
    const float* xsrc; float* X; const float* gt;
    __device__ __forceinline__ void operator()(const f32x4 (&acc)[2][2][4][2], const Unit& u, int wr, int wc, int fr, int fq) const {
        const int row0 = u.pm * 256 + wr * 64 + fr, col0 = u.pnl * 256 + wc * 32 + 4 * fq;
        f32x4 gv[2][2];
#pragma unroll
        for (int bj = 0; bj < 2; ++bj)
#pragma unroll
            for (int n = 0; n < 2; ++n) gv[bj][n] = *(const f32x4*)(gt + col0 + bj * 128 + n * 16);
#pragma unroll
        for (int ai = 0; ai < 2; ++ai)
#pragma unroll
            for (int m = 0; m < 4; ++m) { const size_t ro = (size_t)(row0 + ai * 128 + m * 16) * D_ + col0;
#pragma unroll
                for (int bj = 0; bj < 2; ++bj)
#pragma unroll
                    for (int n = 0; n < 2; ++n) { const f32x4 xv = *(const f32x4*)(xsrc + ro + bj * 128 + n * 16); *(f32x4*)(X + ro + bj * 128 + n * 16) = xv + gv[bj][n] * acc[ai][bj][m][n]; } }
    }
};
struct EpiF32 {
    static constexpr bool PERM = false;
    float* C; int ldc;
    __device__ __forceinline__ void operator()(const f32x4 (&acc)[2][2][4][2], const Unit& u, int wr, int wc, int fr, int fq) const {
        const int row0 = u.pm * 256 + wr * 64 + fr, col0 = u.pnl * 256 + wc * 32 + 4 * fq;
#pragma unroll
        for (int ai = 0; ai < 2; ++ai)
#pragma unroll
            for (int m = 0; m < 4; ++m) { float* rowp = C + (size_t)(row0 + ai * 128 + m * 16) * ldc + col0;
#pragma unroll
                for (int bj = 0; bj < 2; ++bj)
#pragma unroll
                    for (int n = 0; n < 2; ++n) *(f32x4*)(rowp + bj * 128 + n * 16) = acc[ai][bj][m][n]; }
    }
};
struct EpiGateUp {
    static constexpr bool PERM = true;
    bf16* HACT;
    __device__ __forceinline__ void operator()(const f32x4 (&acc)[2][2][4][2], const Unit& u, int wr, int wc, int fr, int fq) const {
        const int row0 = u.pm * 256 + wr * 64 + fr, col0 = u.pnl * 128 + wc * 32 + 8 * fq;
#pragma unroll
        for (int ai = 0; ai < 2; ++ai)
#pragma unroll
            for (int m = 0; m < 4; ++m) { const int row = row0 + ai * 128 + m * 16; f32x4 h[2];
#pragma unroll
                for (int n = 0; n < 2; ++n)
#pragma unroll
                    for (int j = 0; j < 4; ++j) { const float gg = acc[ai][0][m][n][j], uu = acc[ai][1][m][n][j]; h[n][j] = gg / (1.f + __expf(-gg)) * uu; }
                pg8::u32x4 w; w.x = pg8::cvt_pk_bf16(h[0][0], h[0][1]); w.y = pg8::cvt_pk_bf16(h[0][2], h[0][3]); w.z = pg8::cvt_pk_bf16(h[1][0], h[1][1]); w.w = pg8::cvt_pk_bf16(h[1][2], h[1][3]);
                *(pg8::u32x4*)(HACT + (size_t)row * DEXP + col0) = w; }
    }
};
struct EpiDown {
    static constexpr bool PERM = true;
    bf16* Y; const float* WTS; const LAS int* tab;
    __device__ __forceinline__ void operator()(const f32x4 (&acc)[2][2][4][2], const Unit& u, int wr, int wc, int fr, int fq) const {
        const int rl0 = wr * 64 + fr, col0 = u.pnl * 256 + wc * 32 + 8 * fq, cnt = tab[u.e];
#pragma unroll
        for (int ai = 0; ai < 2; ++ai)
#pragma unroll
            for (int m = 0; m < 4; ++m) { const int rl = rl0 + ai * 128 + m * 16, pos = u.mt * 256 + rl;
                const float w = (pos < cnt) ? WTS[(size_t)u.e * ECAP + pos] : 0.f;
                bf16* rowp = Y + (size_t)(u.pm * 256 + rl) * D_ + col0;
#pragma unroll
                for (int bj = 0; bj < 2; ++bj) { const f32x4 v0 = acc[ai][bj][m][0] * w, v1 = acc[ai][bj][m][1] * w;
                    pg8::u32x4 o; o.x = pg8::cvt_pk_bf16(v0[0], v0[1]); o.y = pg8::cvt_pk_bf16(v0[2], v0[3]); o.z = pg8::cvt_pk_bf16(v1[0], v1[1]); o.w = pg8::cvt_pk_bf16(v1[2], v1[3]);
                    *(pg8::u32x4*)(rowp + bj * 128) = o; } }
    }
};

struct CompressOrder {
    static constexpr bool GATHER = false;
    int G, c;
    __device__ bool next(int i, Unit& u) const { const int L = i * G + c; if (L >= 32) return false; u.pm = L >> 1; u.pnl = L & 1; u.pn = (u.pm >= 8 ? 2 : 0) + u.pnl; u.e = 0; u.mt = 0; return true; }
    __device__ __forceinline__ void a_offs(const Unit&, int, int, int, int, int, unsigned (&)[2][2]) const {}
    __device__ __forceinline__ void a_ready(const Unit&) const {}
    __device__ __forceinline__ void done(const Unit&) const {}
};
template <bool GATHER_>
struct MoeOrder {
    static constexpr bool GATHER = GATHER_;
    const LAS int* tab; int NT, G, c, bt_per_e, bt_base; const int* tokidx;
    __device__ bool next(int i, Unit& u) const {
        const int L = i * G + c; if (L >= tab[64]) return false;
        int e = 0;
        for (int k = 1; k < NEXP; ++k) e += (L >= tab[32 + k]) ? 1 : 0;
        e = __builtin_amdgcn_readfirstlane(e);
        const int r = L - tab[32 + e];
        u.e = e; u.mt = r / NT; u.pnl = r % NT; u.pn = bt_base + e * bt_per_e + u.pnl; u.pm = (tab[65 + e] >> 8) + u.mt; return true;
    }
    __device__ __forceinline__ void a_offs(const Unit& u, int R0, int R1, int C0, int C1, int K, unsigned (&o)[2][2]) const {
        const int cnt = tab[u.e]; const int* tk = tokidx + (size_t)u.e * ECAP;
#pragma unroll
        for (int h = 0; h < 2; ++h) {
            int p0 = u.mt * 256 + h * 128 + R0, p1 = u.mt * 256 + h * 128 + R1; p0 = p0 < cnt ? p0 : cnt - 1; p1 = p1 < cnt ? p1 : cnt - 1;
            o[h][0] = ((unsigned)tk[p0] * (unsigned)K + (unsigned)C0) * 2u; o[h][1] = ((unsigned)tk[p1] * (unsigned)K + (unsigned)C1) * 2u; }
    }
    __device__ __forceinline__ void a_ready(const Unit&) const {}
    __device__ __forceinline__ void done(const Unit&) const {}
};

namespace att {
constexpr int D = 128, NW = 8, QBLK = 32, KVBLK = 64, QB = NW * QBLK;
constexpr int SHM_V = KVBLK * D * 2, SHM_K = KVBLK * D * 2;
constexpr int OFF_WS = 2 * SHM_V + 2 * SHM_K, OFF_OT = OFF_WS + NW * 64 * 4, LDS_BYTES = OFF_OT + NW * 32 * 4;
constexpr int OFF_ST = 73728, ST_ROW = 272, ST_WAVE = 16 * ST_ROW;
constexpr float SCALE = 0.08838834764831845f, THR = 8.f;
typedef short bf16x8 __attribute__((ext_vector_type(8)));
typedef short s16x4 __attribute__((ext_vector_type(4)));
typedef float f32x16 __attribute__((ext_vector_type(16)));
typedef float f32x4 __attribute__((ext_vector_type(4)));
typedef unsigned u32x4 __attribute__((ext_vector_type(4)));
typedef unsigned short bf16;
#define KSWZ(row, colB) ((row) * 256 + ((colB) ^ (((row) & 7) << 4)))
#define SBAR() __builtin_amdgcn_sched_barrier(0)
__device__ __forceinline__ int v_st(int k, int c) { const int kk = (k & ~0xC) | ((k & 4) << 1) | ((k & 8) >> 1); return ((kk >> 3) * 4 + (c >> 5)) * 512 + ((kk & 7) * 32 + (c & 31)) * 2; }
__device__ __forceinline__ int v_rd_base(int lane) { return ((lane & 3) << 3) | (((lane >> 2) & 3) << 6) | (((lane >> 4) & 1) << 5) | (((lane >> 5) & 1) << 8); }
constexpr int v_rd_off(int d0, int ks, int half) { return d0 * 512 + ks * 4096 + half * 2048; }
__device__ __forceinline__ int crow(int r, int hi) { return (r & 3) + 8 * (r >> 2) + 4 * hi; }
__device__ __forceinline__ unsigned cvtpk(float lo, float hi) { unsigned r; asm volatile("v_cvt_pk_bf16_f32 %0, %1, %2" : "=v"(r) : "v"(lo), "v"(hi)); return r; }
__device__ __forceinline__ bf16x8 load8(const bf16* p) { return *reinterpret_cast<const bf16x8*>(p); }
__device__ __forceinline__ void mask_tile(f32x16& p0, f32x16& p1, int dq, unsigned W) {
    const float NEG = -__builtin_inff();
#pragma unroll
    for (int r = 0; r < 16; ++r) {
        const int c = (r & 3) + 8 * (r >> 2);
        if ((unsigned)(dq - c) >= W) p0[r] = NEG;
        if ((unsigned)(dq - c - 32) >= W) p1[r] = NEG;
    }
}
__device__ __forceinline__ void partialSM(f32x16& p0, f32x16& p1, float& m_reg, float& mn, float& alpha) {
    float pmax = p0[0]; for (int r = 1; r < 16; ++r) pmax = fmaxf(pmax, p0[r]); for (int r = 0; r < 16; ++r) pmax = fmaxf(pmax, p1[r]);
    { auto rr = __builtin_amdgcn_permlane32_swap(__float_as_uint(pmax), __float_as_uint(pmax), false, false);
      pmax = fmaxf(__uint_as_float(rr[0]), __uint_as_float(rr[1])); }
    constexpr float C2 = 1.4426950408889634f * SCALE;
    if (__builtin_expect(__all((pmax - m_reg) * SCALE <= THR), 1)) { mn = m_reg; alpha = 1.f; }
    else { mn = fmaxf(m_reg, pmax); alpha = __builtin_amdgcn_exp2f((m_reg - mn) * C2); m_reg = mn; }
    const float mnL = -mn * C2;
    for (int r = 0; r < 16; ++r) p0[r] = fmaf(p0[r], C2, mnL); for (int r = 0; r < 16; ++r) p1[r] = fmaf(p1[r], C2, mnL);
    for (int r = 0; r < 16; ++r) p0[r] = __builtin_amdgcn_exp2f(p0[r]);
}
__device__ __forceinline__ void finishSM(f32x16& p0, f32x16& p1, float alpha, float& l_reg, bf16x8& pa0, bf16x8& pa1, bf16x8& pa2, bf16x8& pa3) {
    for (int r = 0; r < 16; ++r) p1[r] = __builtin_amdgcn_exp2f(p1[r]);
    float ps = 0; for (int r = 0; r < 16; ++r) ps += p0[r]; for (int r = 0; r < 16; ++r) ps += p1[r];
    { auto rr = __builtin_amdgcn_permlane32_swap(__float_as_uint(ps), __float_as_uint(ps), false, false);
      ps = __uint_as_float(rr[0]) + __uint_as_float(rr[1]); }
    l_reg = l_reg * alpha + ps;
#define PK4(P, B_, OUT) do { unsigned a0 = cvtpk(P[B_+0], P[B_+1]), a1 = cvtpk(P[B_+2], P[B_+3]);                          \
        unsigned b0 = cvtpk(P[B_+4], P[B_+5]), b1 = cvtpk(P[B_+6], P[B_+7]);                                             \
        auto r0 = __builtin_amdgcn_permlane32_swap(a0, b0, false, false); auto r1 = __builtin_amdgcn_permlane32_swap(a1, b1, false, false); \
        u32x4 w = {r0[0], r1[0], r0[1], r1[1]}; OUT = *reinterpret_cast<bf16x8*>(&w); } while (0)
    PK4(p0, 0, pa0); PK4(p0, 8, pa1); PK4(p1, 0, pa2); PK4(p1, 8, pa3);
#undef PK4
}
template <int KB, bool SK>
__device__ __forceinline__ void qkt(f32x16& p0, f32x16& p1, const char* K_lds, int r32, int hi, const bf16x8* qr, bool act) {
    if (SK && !act) { const float NEG = -__builtin_inff();
#pragma unroll
        for (int r = 0; r < 16; ++r) { p0[r] = NEG; p1[r] = NEG; } return; }
    p0 = f32x16{}; p1 = f32x16{};
    const char* kb[4];
#pragma unroll
    for (int dd = 0; dd < 4; ++dd) kb[dd] = K_lds + KB * SHM_K + KSWZ(r32, (dd * 16 + hi * 8) * 2);
#pragma unroll
    for (int d0 = 0; d0 < 8; ++d0) { const char* a = kb[d0 & 3] + (d0 >> 2) * 128;
        bf16x8 b0 = *reinterpret_cast<const bf16x8*>(a);
        bf16x8 b1 = *reinterpret_cast<const bf16x8*>(a + 32 * 256);
        p0 = __builtin_amdgcn_mfma_f32_32x32x16_bf16(b0, qr[d0], p0, 0, 0, 0);
        p1 = __builtin_amdgcn_mfma_f32_32x32x16_bf16(b1, qr[d0], p1, 0, 0, 0); }
}
template <int VB, bool SK>
__device__ __forceinline__ void pv_tile(f32x16* o, int vb0, bf16x8 pa0, bf16x8 pa1, bf16x8 pa2, bf16x8 pa3, bool act) {
    if (SK && !act) return;
#define TRRD(dst, off) asm volatile("ds_read_b64_tr_b16 %0, %1 offset:%2" : "=&v"(dst) : "v"(vb0), "i"(off) : "memory")
#define PV_D0(d0) do { s16x4 l0, l1, l2, l3, h0, h1, h2, h3; constexpr int b_ = VB * SHM_V + v_rd_off(d0, 0, 0); \
        TRRD(l0, b_); TRRD(h0, b_ + 2048); TRRD(l1, b_ + 4096); TRRD(h1, b_ + 6144); TRRD(l2, b_ + 8192); TRRD(h2, b_ + 10240); TRRD(l3, b_ + 12288); TRRD(h3, b_ + 14336); \
        asm volatile("s_waitcnt lgkmcnt(0)" ::: "memory"); SBAR();   \
        o[d0] = __builtin_amdgcn_mfma_f32_32x32x16_bf16(pa0, (bf16x8){l0[0], l0[1], l0[2], l0[3], h0[0], h0[1], h0[2], h0[3]}, o[d0], 0, 0, 0);   \
        o[d0] = __builtin_amdgcn_mfma_f32_32x32x16_bf16(pa1, (bf16x8){l1[0], l1[1], l1[2], l1[3], h1[0], h1[1], h1[2], h1[3]}, o[d0], 0, 0, 0);   \
        o[d0] = __builtin_amdgcn_mfma_f32_32x32x16_bf16(pa2, (bf16x8){l2[0], l2[1], l2[2], l2[3], h2[0], h2[1], h2[2], h2[3]}, o[d0], 0, 0, 0);   \
        o[d0] = __builtin_amdgcn_mfma_f32_32x32x16_bf16(pa3, (bf16x8){l3[0], l3[1], l3[2], l3[3], h3[0], h3[1], h3[2], h3[3]}, o[d0], 0, 0, 0); } while (0)
    PV_D0(0); PV_D0(1); PV_D0(2); PV_D0(3);
#undef PV_D0
#undef TRRD
}
struct Ref { const bf16* Q; const bf16* K; const bf16* V; bf16* O; const int* list; int kpitch, j_lo, j_hi, P0, W, a0, a1; };
struct Seam { bf16x8 qr[8]; bf16x8 st_v0, st_v1, st_k0, st_k1; };
#define ROW(p, kp, k0, rr) ((p) + (size_t)((k0) + (rr)) * (kp) + sc)
#define VMW() asm volatile("s_waitcnt vmcnt(0)" ::: "memory")
#define VMWN(n) asm volatile("s_waitcnt vmcnt(%0)" :: "i"(n) : "memory")
#define SLOAD_H(Kp, Vp, kp, k0) do { S.st_v0 = load8(ROW(Vp, kp, k0, sr)); S.st_v1 = load8(ROW(Vp, kp, k0, 32 + sr));              \
                         S.st_k0 = load8(ROW(Kp, kp, k0, sr)); S.st_k1 = load8(ROW(Kp, kp, k0, 32 + sr)); } while (0)
#define SWRITE_HK(bf) do { *(bf16x8*)(K_lds + (bf) * SHM_K + kws) = S.st_k0; *(bf16x8*)(K_lds + (bf) * SHM_K + kws + 32 * 256) = S.st_k1; } while (0)
#define SWRITE_HV(bf) do { *(bf16x8*)(V_lds + (bf) * SHM_V + vst0) = S.st_v0; *(bf16x8*)(V_lds + (bf) * SHM_V + vst1) = S.st_v1; } while (0)
#define SWRITE_H(bf) do { SWRITE_HV(bf); SWRITE_HK(bf); } while (0)
template <class RF>
__device__ __forceinline__ void prime(const Ref& cur, char* lds, Seam& S) {
    const int tid_ = wg_tid((const __attribute__((address_space(3))) int*)(uintptr_t)(unsigned)(uintptr_t)(lds + WIDTAB_OFF));
    const int tid = tid_, wid = __builtin_amdgcn_readfirstlane(tid >> 6), lane = tid & 63, r32 = lane & 31, hi = lane >> 5;
    const int sr = tid >> 4, sc = (tid & 15) * 8, kws = KSWZ(sr, sc * 2); char* K_lds = lds + 2 * SHM_V;
    const int kb0 = cur.j_lo * KVBLK;
    { const bf16* qrow = cur.Q + RF::q_off(cur, wid * QBLK + r32, RF::entry(cur, wid * QBLK + r32));
      for (int d0 = 0; d0 < 8; ++d0) S.qr[d0] = load8(qrow + d0 * 16 + hi * 8); }
    SLOAD_H(cur.K, cur.V, cur.kpitch, kb0); VMW(); SWRITE_HK(0);
    __syncthreads();
}
template <int MODE, bool WSKIP, class RF, bool O8 = false, bool ONE = false>
__device__ __forceinline__ void block(const Ref& cur, const Ref& nxt, float* LSE, char* lds, Seam& S, float* lse_lane = nullptr) {
    const int tid_ = wg_tid((const __attribute__((address_space(3))) int*)(uintptr_t)(unsigned)(uintptr_t)(lds + WIDTAB_OFF));
    const int tid = tid_, wid = __builtin_amdgcn_readfirstlane(tid >> 6), lane = tid & 63, r32 = lane & 31, hi = lane >> 5;
    const int j_lo = cur.j_lo, NT = cur.j_hi - cur.j_lo;
    const int kbn = nxt.j_lo * KVBLK;
    const int W = cur.W;
    const int qlo = cur.P0 + wid * QBLK;
    const int e_cur = RF::entry(cur, wid * QBLK + r32), e_nxt = RF::entry(nxt, wid * QBLK + r32);
    const int qm = (MODE == 2 ? RF::pos(cur, wid * QBLK + r32, e_cur) : qlo + r32) - 4 * hi;
    const unsigned Wm = (MODE == 2) ? (unsigned)RF::Wl(cur, wid * QBLK + r32) : (unsigned)W;
    char* V_lds = lds; char* K_lds = lds + 2 * SHM_V;
    float* ws = (float*)(lds + OFF_WS) + wid * 64; float* li_l = ws, * al_l = ws + 32; int* ot_l = (int*)(lds + OFF_OT) + wid * 32;
    float m_reg = -1e30f, l_reg = 0; f32x16 o[4] = {};
    const int sr = tid >> 4, sc = (tid & 15) * 8, vst0 = v_st(sr, sc), vst1 = v_st(32 + sr, sc), kws = KSWZ(sr, sc * 2);
    const int vb0 = (int)(uintptr_t)V_lds + v_rd_base(lane);
    const bf16* Kh = cur.K; const bf16* Vh = cur.V; const int kp = cur.kpitch;
#define RESC(a) do { if (__any((a) < 1.f)) { if (hi == 0) al_l[r32] = (a); asm volatile("s_waitcnt lgkmcnt(0)" ::: "memory");              \
                     for (int d_ = 0; d_ < 4; ++d_) for (int r = 0; r < 16; ++r) o[d_][r] *= al_l[crow(r, hi)]; } } while (0)
#define KBASE(t) ((j_lo + (t)) * KVBLK)
#define ACT(t) (MODE != 0 || (KBASE(t) <= qlo + QBLK - 1 && KBASE(t) + KVBLK - 1 >= qlo - W + 1))
#define MASKT(P0_, P1_, t) do { const int kb_ = KBASE(t); if (MODE == 2) mask_tile(P0_, P1_, qm - kb_, Wm); \
        else if (MODE == 0) { if ((!SK || ACT(t)) && (kb_ + KVBLK - 1 > qlo || kb_ <= qlo + QBLK - 1 - W)) mask_tile(P0_, P1_, qm - kb_, Wm); } } while (0)
    constexpr int NQL = 8;
    constexpr bool SK = WSKIP && MODE == 0;
#define SEAM_K0() do { VMWN(NQL); SWRITE_HK(0); SBAR(); } while (0)
    f32x16 pA0, pA1, pB0, pB1; float mnA, mnB, alA, alB; bf16x8 pa0, pa1, pa2, pa3;
    SWRITE_HV(0); SBAR();
    if constexpr (ONE) { SLOAD_H(nxt.K, nxt.V, nxt.kpitch, kbn); SBAR(); }
    if (NT > 1) { SLOAD_H(Kh, Vh, kp, KBASE(1)); }
    SBAR(); qkt<0, SK>(pA0, pA1, K_lds, r32, hi, S.qr, ACT(0));
    MASKT(pA0, pA1, 0); partialSM(pA0, pA1, m_reg, mnA, alA);
    if (NT > 1) { VMW(); SWRITE_H(1); }
    __syncthreads();
#define HALF_STEP(PX0, PX1, mnX, alX, PY0, PY1, alY, t, KB, VB, SB) do {                                                      \
        SBAR(); qkt<KB, SK>(PX0, PX1, K_lds, r32, hi, S.qr, ACT(t));                                             \
        finishSM(PY0, PY1, alY, l_reg, pa0, pa1, pa2, pa3); SBAR();                                                           \
        if ((t) + 1 < NT) { SLOAD_H(Kh, Vh, kp, KBASE((t) + 1)); SBAR(); }                                               \
        pv_tile<VB, SK>(o, vb0, pa0, pa1, pa2, pa3, ACT((t) - 1)); MASKT(PX0, PX1, (t)); partialSM(PX0, PX1, m_reg, mnX, alX);                                        \
        __syncthreads();                                                                                                      \
        if ((t) + 1 < NT) { VMW(); SWRITE_H(SB); }                                                                          \
        RESC(alX); __syncthreads(); } while (0)
    for (int t = 1; t + 1 < NT; t += 2) {
        HALF_STEP(pB0, pB1, mnB, alB, pA0, pA1, alA, t, 1, 0, 0);
        HALF_STEP(pA0, pA1, mnA, alA, pB0, pB1, alB, t + 1, 0, 1, 1);
    }
    const bool even = (NT & 1) == 0;
    if (even) { SBAR(); qkt<1, SK>(pB0, pB1, K_lds, r32, hi, S.qr, ACT(NT - 1)); SBAR(); }
    if constexpr (!ONE) { SLOAD_H(nxt.K, nxt.V, nxt.kpitch, kbn); SBAR(); }
    { const bf16* qrow = nxt.Q + RF::q_off(nxt, wid * QBLK + r32, e_nxt);
#pragma unroll
      for (int d0 = 0; d0 < 8; ++d0) S.qr[d0] = load8(qrow + d0 * 16 + hi * 8); }
    SBAR();
    finishSM(pA0, pA1, alA, l_reg, pa0, pa1, pa2, pa3); SBAR();
    pv_tile<0, SK>(o, vb0, pa0, pa1, pa2, pa3, ACT(even ? NT - 2 : NT - 1));
    if (even) { MASKT(pB0, pB1, NT - 1); partialSM(pB0, pB1, m_reg, mnB, alB); __syncthreads(); RESC(alB);
        finishSM(pB0, pB1, alB, l_reg, pa0, pa1, pa2, pa3); SBAR(); pv_tile<1, SK>(o, vb0, pa0, pa1, pa2, pa3, ACT(NT - 1)); }
    SBAR(); SEAM_K0();
    if (hi == 0) { li_l[r32] = l_reg; ot_l[r32] = RF::o_off(cur, wid * QBLK + r32, e_cur); } asm volatile("s_waitcnt lgkmcnt(0)" ::: "memory");
    if (LSE != nullptr && hi == 0) { const int lq = RF::l_idx(cur, wid * QBLK + r32, e_cur); if (lq >= 0) LSE[lq] = (l_reg > 0.f) ? m_reg * SCALE + __logf(l_reg) : -__builtin_inff(); }
    if (lse_lane != nullptr) *lse_lane = (l_reg > 0.f) ? m_reg * SCALE + __logf(l_reg) : -__builtin_inff();
    bf16* O = cur.O;
    { char* stg = lds + OFF_ST + wid * ST_WAVE;
#pragma unroll 1
      for (int p = 0; p < 2; ++p) {
#pragma unroll
        for (int rr = 0; rr < 8; ++rr) { const int r = 8 * p + rr, orow = crow(r, hi); const float lv = li_l[orow]; const float rl = (lv > 0.f) ? __builtin_amdgcn_rcpf(lv) : 0.f;
#pragma unroll
            for (int d0 = 0; d0 < 4; ++d0) {
                if constexpr (O8) *(unsigned char*)(stg + (orow - 16 * p) * ST_ROW + (d0 * 32 + r32)) = (unsigned char)__builtin_amdgcn_cvt_pk_fp8_f32(o[d0][r] * rl * 16.f, 0.f, 0, false);
                else *(unsigned short*)(stg + (orow - 16 * p) * ST_ROW + (d0 * 32 + r32) * 2) = (unsigned short)cvtpk(o[d0][r] * rl, 0.f); } }
        asm volatile("s_waitcnt lgkmcnt(0)" ::: "memory");
        { const int row = lane >> 2, ch = lane & 3, oo = ot_l[16 * p + row];
          if constexpr (O8) {
#pragma unroll
            for (int i = 0; i < 2; ++i) { const u32x4 x = *(const u32x4*)(stg + row * ST_ROW + (i * 4 + ch) * 16); if (oo >= 0) *(u32x4*)((char*)O + (size_t)oo + (i * 4 + ch) * 16) = x; }
          } else {
#pragma unroll
            for (int i = 0; i < 4; ++i) { const u32x4 x = *(const u32x4*)(stg + row * ST_ROW + (i * 4 + ch) * 16); if (oo >= 0) *(u32x4*)(O + (size_t)oo + (i * 4 + ch) * 8) = x; } } }
        asm volatile("s_waitcnt lgkmcnt(0)" ::: "memory");
      } }
    __syncthreads();
#undef RESC
#undef KBASE
#undef ACT
#undef MASKT
#undef SEAM_K0
#undef HALF_STEP
}

template <class RF>
__device__ __forceinline__ void imp_sweep(const Ref& cur, float lse_lane, float* IMP  , char* lds, Seam& S) {
    const int tid_ = wg_tid((const __attribute__((address_space(3))) int*)(uintptr_t)(unsigned)(uintptr_t)(lds + WIDTAB_OFF));
    const int tid = tid_, wid = __builtin_amdgcn_readfirstlane(tid >> 6), lane = tid & 63, r32 = lane & 31, hi = lane >> 5;
    const int NT = cur.j_hi - cur.j_lo;
    char* K_lds = lds + 2 * SHM_V;
    const int sr = tid >> 4, sc = (tid & 15) * 8, kws = KSWZ(sr, sc * 2);
    const bf16* Kh = cur.K; const int kp = cur.kpitch;
    const int row = wid * QBLK + r32;
    const int qm = RF::pos(cur, row, RF::entry(cur, row)) - 4 * hi; const unsigned Wm = (unsigned)RF::Wl(cur, row);
    constexpr float C2 = 1.4426950408889634f * SCALE;
    const float nl2 = (lse_lane == -__builtin_inff()) ? 0.f : -lse_lane * 1.4426950408889634f;
    float carry = 0.f;
    float* imp_row = IMP + (size_t)(row >> 2) * 512;
    f32x16 p0, p1;
#define IMP_TILE(t, KB) do { \
        if ((t) + 1 < NT) { S.st_k0 = load8(ROW(Kh, kp, (cur.j_lo + (t) + 1) * KVBLK, sr)); S.st_k1 = load8(ROW(Kh, kp, (cur.j_lo + (t) + 1) * KVBLK, 32 + sr)); } \
        SBAR(); qkt<KB, false>(p0, p1, K_lds, r32, hi, S.qr, true); \
        mask_tile(p0, p1, qm - (cur.j_lo + (t)) * KVBLK, Wm); \
        _Pragma("unroll") for (int r = 0; r < 16; ++r) { p0[r] = __builtin_amdgcn_exp2f(fmaf(p0[r], C2, nl2)); p1[r] = __builtin_amdgcn_exp2f(fmaf(p1[r], C2, nl2)); } \
        float Gs[8], Ls[8]; \
        _Pragma("unroll") for (int q = 0; q < 4; ++q) { Gs[q] = (p0[4 * q] + p0[4 * q + 1]) + (p0[4 * q + 2] + p0[4 * q + 3]); Ls[q] = p0[4 * q + 3]; \
                                              Gs[4 + q] = (p1[4 * q] + p1[4 * q + 1]) + (p1[4 * q + 2] + p1[4 * q + 3]); Ls[4 + q] = p1[4 * q + 3]; } \
          \
        float prevL = carry; \
        _Pragma("unroll") for (int q = 0; q < 8; ++q) { const float other = lane_get(Ls[q], lane ^ 32);        \
            const float add = hi ? other : prevL; prevL = other; Gs[q] += add; } \
        carry = prevL;                                            \
        _Pragma("unroll") for (int q = 0; q < 8; ++q) { float v = Gs[q]; v += lane_get(v, lane ^ 1); v += lane_get(v, lane ^ 2); \
            if ((r32 & 3) == 0) imp_row[((cur.j_lo + (t)) << 4) + 2 * q + hi] = v; } \
        if ((t) + 1 < NT) { asm volatile("s_waitcnt vmcnt(0)" ::: "memory"); *(bf16x8*)(K_lds + ((KB) ^ 1) * SHM_K + kws) = S.st_k0; *(bf16x8*)(K_lds + ((KB) ^ 1) * SHM_K + kws + 32 * 256) = S.st_k1; } \
        __syncthreads(); } while (0)
    for (int t = 0; t < NT; t += 2) { IMP_TILE(t, 0); if (t + 1 < NT) IMP_TILE(t + 1, 1); }
#undef IMP_TILE
}

template <class RF>
__device__ __forceinline__ void gate_unit(const Ref& cur, int nvis, char* lds, Seam& S, int (&sel)[3]) {
    const int tid_ = wg_tid((const __attribute__((address_space(3))) int*)(uintptr_t)(unsigned)(uintptr_t)(lds + WIDTAB_OFF));
    const int lane = tid_ & 63, r32 = lane & 31, hi = lane >> 5;
    char* K_lds = lds + 2 * SHM_V;
    prime<RF>(cur, lds, S);
    f32x16 p0, p1;
    qkt<0, false>(p0, p1, K_lds, r32, hi, S.qr, true);
    const float NEG = -__builtin_inff();
#pragma unroll
    for (int r = 0; r < 16; ++r) { const int k = crow(r, hi); if (k >= nvis) p0[r] = NEG; if (k + 32 >= nvis) p1[r] = NEG; }
    float bv[3]; int bk[3];
#pragma unroll
    for (int rd = 0; rd < 3; ++rd) { float best = NEG; int kb = 64;
#pragma unroll
        for (int r = 0; r < 16; ++r) if (p0[r] > best) { best = p0[r]; kb = crow(r, hi); }
#pragma unroll
        for (int r = 0; r < 16; ++r) if (p1[r] > best) { best = p1[r]; kb = 32 + crow(r, hi); }
        bv[rd] = best; bk[rd] = kb;
#pragma unroll
        for (int r = 0; r < 16; ++r) { if (crow(r, hi) == kb) p0[r] = NEG; if (32 + crow(r, hi) == kb) p1[r] = NEG; } }
    float ov[3]; int ok[3];
#pragma unroll
    for (int i = 0; i < 3; ++i) { ov[i] = lane_get(bv[i], lane ^ 32); ok[i] = lane_geti(bk[i], lane ^ 32); }
    int ia = 0, ib = 0;
#pragma unroll
    for (int rd = 0; rd < 3; ++rd) { const float va = ia == 0 ? bv[0] : (ia == 1 ? bv[1] : (ia == 2 ? bv[2] : NEG)), vb = ib == 0 ? ov[0] : (ib == 1 ? ov[1] : (ib == 2 ? ov[2] : NEG));
        const int ka = ia == 0 ? bk[0] : (ia == 1 ? bk[1] : (ia == 2 ? bk[2] : 64)), kb = ib == 0 ? ok[0] : (ib == 1 ? ok[1] : (ib == 2 ? ok[2] : 64));
        const bool ta = va > vb || (va == vb && ka < kb);
        const float v = ta ? va : vb; const int k = ta ? ka : kb; ia += ta ? 1 : 0; ib += ta ? 0 : 1;
        sel[rd] = (v == NEG) ? -1 : k; }
    __syncthreads();
}
#undef ROW
#undef VMW
#undef VMWN
#undef SLOAD_H
#undef SWRITE_HK
#undef SWRITE_HV
#undef SWRITE_H
#undef KSWZ
#undef SBAR
}

struct RFReg {
    static __device__ __forceinline__ int entry(const att::Ref&, int) { return 0; }
    static __device__ __forceinline__ int q_off(const att::Ref&, int row, int) { return row * 1024; }
    static __device__ __forceinline__ int o_off(const att::Ref&, int row, int) { return row * 1024; }
    static __device__ __forceinline__ int l_idx(const att::Ref& u, int row, int) { return u.a0 >= 0 ? u.a0 + row * 8 : -1; }
    static __device__ __forceinline__ int pos(const att::Ref& u, int row, int) { return u.P0 + row; }
    static __device__ __forceinline__ int Wl(const att::Ref& u, int) { return u.W; }
};
__device__ __forceinline__ att::Ref win_ref(int L, const bf16* QN, const bf16* KW, const bf16* VW, bf16* OWIN) {
    const int h = L & 7, qb = L >> 3;
    att::Ref r; r.Q = QN + (size_t)qb * 256 * 1024 + h * 128; r.O = OWIN + (size_t)qb * 256 * 1024 + h * 128; r.K = KW + (h >> 2) * 128; r.V = VW + (h >> 2) * 128; r.kpitch = 256; r.list = nullptr;
    r.P0 = qb * 256; r.W = 512; r.j_lo = (r.P0 >= 511) ? (r.P0 - 511) >> 6 : 0; r.j_hi = ((r.P0 + 255) >> 6) + 1; r.a0 = -1; r.a1 = 0; return r;
}
__device__ __forceinline__ att::Ref mown_ref(int L, const bf16* QM, const bf16* KM, const bf16* VM, bf16* POWN) {
    const int h = L & 7, n = L >> 3; const size_t o = (size_t)n * 256 * 1024 + h * 128;
    att::Ref r; r.Q = QM + o; r.O = POWN + o; r.K = KM + o; r.V = VM + o; r.kpitch = 1024; r.list = nullptr;
    r.P0 = 0; r.W = 1 << 20; r.j_lo = 0; r.j_hi = 4; r.a0 = n * 256 * 8 + h; r.a1 = 0; return r;
}
struct RFSel {
    static __device__ __forceinline__ int entry(const att::Ref& u, int row) { return u.list[row < u.a0 ? row : 0]; }
    static __device__ __forceinline__ int q_off(const att::Ref&, int, int e) { return (e >> 2) * 1024; }
    static __device__ __forceinline__ int o_off(const att::Ref& u, int row, int e) { return row < u.a0 ? (((e >> 2) * 8 + u.a1) * 3 + (e & 3)) * 128 : -1; }
    static __device__ __forceinline__ int l_idx(const att::Ref& u, int row, int e) { return row < u.a0 ? ((e >> 2) * 8 + u.a1) * 3 + (e & 3) : -1; }
    static __device__ __forceinline__ int pos(const att::Ref&, int, int) { return 0; }
    static __device__ __forceinline__ int Wl(const att::Ref&, int) { return 0; }
};
__device__ __forceinline__ att::Ref msel_ref(int L, const LAS int* tab, const LAS unsigned short* ulist, const int* MLIST, const bf16* QM, const bf16* KM, const bf16* VM, bf16* PSEL) {
    const int lid = __builtin_amdgcn_readfirstlane((int)ulist[L]), k = L - tab[512 + lid], h = lid >> 6, n = lid & 63;
    att::Ref r; r.Q = QM + h * 128; r.O = PSEL; r.K = KM + (size_t)n * 256 * 1024 + h * 128; r.V = VM + (size_t)n * 256 * 1024 + h * 128; r.kpitch = 1024;
    r.list = MLIST + (size_t)lid * 16384 + k * 256; r.P0 = 0; r.W = 0; r.j_lo = 0; r.j_hi = 4; r.a0 = tab[lid] - k * 256; r.a1 = h; return r;
}

struct RFSlc {
    static __device__ __forceinline__ int entry(const att::Ref& u, int row) { return u.list[(row >> 2) < u.a0 ? (row >> 2) : 0]; }
    static __device__ __forceinline__ int q_off(const att::Ref&, int row, int e) { return (e >> 4) * 1024 + (row & 3) * 128; }
    static __device__ __forceinline__ int l_idx(const att::Ref& u, int row, int e) { return (row >> 2) < u.a0 ? ((((e >> 4) * 2 + (u.a1 >> 16)) * 16 + (e & 15)) * 4 + (row & 3)) : -1; }
    static __device__ __forceinline__ int o_off(const att::Ref& u, int row, int e) { const int i = l_idx(u, row, e); return i >= 0 ? i * 128 : -1; }
    static __device__ __forceinline__ int pos(const att::Ref& u, int, int e) { return (e >> 4) - 64 * (u.a1 & 0xffff); }
    static __device__ __forceinline__ int Wl(const att::Ref&, int) { return 1 << 30; }
};
__device__ __forceinline__ att::Ref nsel_ref(int L, const LAS int* tab, const LAS unsigned short* ulist, const int* NLIST, const bf16* QN, const bf16* KS, const bf16* VS, bf16* PSLC) {
    const int lid = __builtin_amdgcn_readfirstlane((int)ulist[L]), k = L - tab[512 + lid], g = lid >> 8, j = lid & 255;
    att::Ref r; r.Q = QN + g * 512; r.O = PSLC; r.K = KS + (size_t)j * 64 * 256 + g * 128; r.V = VS + (size_t)j * 64 * 256 + g * 128; r.kpitch = 256;
    r.list = NLIST + (size_t)lid * 16384 + k * 64; r.P0 = 0; r.W = 0; r.j_lo = 0; r.j_hi = 1; r.a0 = tab[lid] - k * 64; r.a1 = j | (g << 16); return r;
}

struct RFCmp {
    static __device__ __forceinline__ int entry(const att::Ref&, int) { return 0; }
    static __device__ __forceinline__ int q_off(const att::Ref&, int row, int) { return (row >> 2) * 1024 + (row & 3) * 128; }
    static __device__ __forceinline__ int o_off(const att::Ref&, int row, int) { return (row >> 2) * 1024 + (row & 3) * 128; }
    static __device__ __forceinline__ int l_idx(const att::Ref&, int, int) { return -1; }
    static __device__ __forceinline__ int pos(const att::Ref& u, int row, int) { const int t = u.P0 + (row >> 2); return t >= 31 ? (t - 31) >> 4 : -1; }
    static __device__ __forceinline__ int Wl(const att::Ref&, int) { return 1 << 30; }
};
__device__ __forceinline__ att::Ref cmp_ref(int L, const bf16* QN, const bf16* KCMP, const bf16* VCMP, bf16* OCMP) {
    const int g = L & 1, c = (L < 256) ? (L >> 1) : 255 - ((L - 256) >> 1);
    att::Ref r; r.Q = QN + (size_t)c * 64 * 1024 + g * 512; r.O = OCMP + (size_t)c * 64 * 1024 + g * 512; r.K = KCMP + g * 128; r.V = VCMP + g * 128; r.kpitch = 256; r.list = nullptr;
    r.P0 = c * 64; r.W = 0; r.j_lo = 0; r.j_hi = (4 * c + 3 + 63) >> 6; r.a0 = g; r.a1 = c; return r;
}

struct Args { const float* in[18]; float* out; unsigned char* ws; int ph_lo, ph_hi, li, pad; };
typedef const __attribute__((address_space(4))) Args* ArgsP;
__device__ __forceinline__ ArgsP get_args() { auto p = __builtin_amdgcn_kernarg_segment_ptr(); asm volatile("" : "+s"(p)); return (ArgsP)p; }

__global__ void __launch_bounds__(NTHR, 2) mk_fwd(Args args_unused) {
    extern __shared__ __attribute__((aligned(16))) unsigned char lds_raw[];
    LAS unsigned char* lds = (LAS unsigned char*)lds_raw;
    LAS float* sm = (LAS float*)lds;
    volatile LAS unsigned* MISC = (volatile LAS unsigned*)(lds + MISC_OFF);
    LAS int* moetab = (LAS int*)(lds + MOETAB_OFF);
    const int G = gridDim.x, bid = blockIdx.x, NGW = G * NWAVES;
#define PH_IDS() const int tid_ = wg_tid((const LAS int*)(lds + WIDTAB_OFF)); const int tid = tid_, lane = tid & 63, wave = __builtin_amdgcn_readfirstlane(tid >> 6), gw = bid * NWAVES + wave; (void)lane; (void)gw;
#define AP() get_args()
#define CTLP(ws) ((gu32*)((ws) + WS_CTL))

    for (int u = threadIdx.x; u < (LDS_BYTES - LDSCTL_OFF) / 4; u += NTHR) ((LAS unsigned*)(lds + LDSCTL_OFF))[u] = 0u;
    __syncthreads();
    { unsigned hw; asm volatile("s_getreg_b32 %0, hwreg(HW_REG_HW_ID, 0, 6)" : "=s"(hw)); if ((threadIdx.x & 63) == 0) ((LAS int*)(lds + WIDTAB_OFF))[hw] = (int)(threadIdx.x >> 6); }
    __syncthreads();
    XcdBarrier bar; bar.bar = nullptr; bar.x = 0; bar.st = nullptr;
    if (MK_N_LAUNCHES == 1) bar = xcd_barrier_post((unsigned*)(CTLP(AP()->ws) + CW_BAR), MISC + 8);
#define GRID_BAR() do { if (MK_N_LAUNCHES == 1) { XcdBarrier b_ = bar; b_.bar = (unsigned*)(CTLP(AP()->ws) + CW_BAR); xcd_barrier(b_, wg_tid((const LAS int*)(lds + WIDTAB_OFF)) == 0); } } while (0)
    const int lo = AP()->ph_lo, hi = AP()->ph_hi;
#define IN(k) (lo <= (k) && (k) < hi)
#define BOTH(k) (IN(k) && IN((k) + 1))

    if (IN(0)) {
        PH_IDS(); ArgsP ap = AP(); unsigned char* ws = ap->ws;
        LAS float* scr = (LAS float*)(lds + wave * 16384);
        constexpr int I_IN = 32 * 177, I_OUT = 32 * 64, I_GU = 32 * 16, I_DN = 8 * 64, I_W1 = 32 * 8;
        constexpr int N_IN = 2 * I_IN, N_OUT = 2 * I_OUT, N_G = 64 * I_GU, N_U = 64 * I_GU, N_D = 64 * I_DN, N_W1 = 8 * I_W1;
        constexpr int NITEMS = N_IN + N_OUT + N_G + N_U + N_D + N_W1;
        for (int it = gw; it < NITEMS; it += NGW) {
            int r = it;
            if (r < N_IN) { const int l = r / I_IN; transpose_item<1>(ap->in[6] + (size_t)l * D_ * IN_W, D_, IN_W, (bf16*)(ws + WS_WINT) + (size_t)l * NIN * D_, D_, 0, scr, r % I_IN, lane); continue; } r -= N_IN;
            if (r < N_OUT) { const int l = r / I_OUT; transpose_item<0>(ap->in[7] + (size_t)l * D_ * D_, D_, D_, (bf16*)(ws + WS_WOUTT) + (size_t)l * D_ * D_, D_, 0, scr, r % I_OUT, lane); continue; } r -= N_OUT;
            if (r < N_G) { const int le = r / I_GU; transpose_item<2>(ap->in[14] + (size_t)le * D_ * DEXP, D_, DEXP, (bf16*)(ws + WS_WGUT) + (size_t)le * 1024 * D_, D_, 0, scr, r % I_GU, lane); continue; } r -= N_G;
            if (r < N_U) { const int le = r / I_GU; transpose_item<3>(ap->in[15] + (size_t)le * D_ * DEXP, D_, DEXP, (bf16*)(ws + WS_WGUT) + (size_t)le * 1024 * D_, D_, 0, scr, r % I_GU, lane); continue; } r -= N_U;
            if (r < N_D) { const int le = r / I_DN; transpose_item<0>(ap->in[16] + (size_t)le * DEXP * D_, DEXP, D_, (bf16*)(ws + WS_WDT) + (size_t)le * D_ * DEXP, DEXP, 0, scr, r % I_DN, lane); continue; } r -= N_D;
            { const int m = r / I_W1, lk = m >> 1, half = m & 1;
              transpose_item<0>(ap->in[9] + (size_t)lk * 4096 * 256 + (size_t)half * 2048 * 256, 2048, 256, (bf16*)(ws + WS_WC1T) + (size_t)lk * 512 * 2048, 2048, half * 256, scr, r % I_W1, lane); }
        }
        { const float* w_router = ap->in[12]; bf16* WrT = (bf16*)(ws + WS_WRT);
          for (int idx = bid * NTHR + tid; idx < 32 * 2048; idx += G * NTHR) { const int e = idx >> 11, k = idx & 2047; const float w = w_router[(size_t)k * 32 + e];
            const unsigned hb = f2bf(w); const float rem = w - bf2f(hb); WrT[idx] = (bf16)hb; WrT[32 * 2048 + idx] = (bf16)f2bf(rem); } }
        { f32x2* ROPE = (f32x2*)(ws + WS_ROPE);
          for (int idx = bid * NTHR + tid; idx < S_ * 64; idx += G * NTHR) { const int pos = idx >> 6, i = idx & 63;
            const double inv = exp(-(double)i * (9.210340371976184 / 64.0)); const double ang = (double)pos * inv; double sv, cv; sincos(ang, &sv, &cv);
            ROPE[idx] = (f32x2){(float)cv, (float)sv}; } }
        __syncthreads();
        { float* MOD = (float*)(CTLP(ws) + CW_MOD); const float* c_in = ap->in[1]; const float* w_ada = ap->in[2]; const float* b_ada = ap->in[3];
          for (int k = tid; k < D_; k += NTHR) { const float cv = c_in[k]; sm[k] = cv / (1.f + __expf(-cv)); }
          __syncthreads();
          for (int it = bid; it < 2 * 96; it += G) { const int l = it / 96, cb = it % 96, grp = tid >> 5, col = cb * 128 + (tid & 31) * 4;
            f32x4 a = (f32x4){0.f, 0.f, 0.f, 0.f};
            const float* wp = w_ada + ((size_t)l * D_ + grp) * 12288 + col;
#pragma unroll 8
            for (int i = 0; i < 128; ++i) a += *(const f32x4*)(wp + (size_t)i * 16 * 12288) * sm[grp + 16 * i];
            *(LAS f32x4*)(sm + 4096 + grp * 128 + (tid & 31) * 4) = a;
            __syncthreads();
            if (tid < 128) { float s = b_ada[l * 12288 + cb * 128 + tid];
#pragma unroll
                for (int q = 0; q < 16; ++q) s += sm[4096 + q * 128 + tid];
                MOD[l * 12288 + cb * 128 + tid] = s; }
            __syncthreads(); } }
        { float* B1P = (float*)(CTLP(ws) + CW_B1E); const float* cmp_pe = ap->in[8]; const float* cmp_w1 = ap->in[9];
          for (int it = bid - 192; it >= 0 && it < 32; it += G) { const int lk = it >> 3, ks = it & 7, grp = tid >> 6, n = (tid & 63) * 4;
            f32x4 a = (f32x4){0.f, 0.f, 0.f, 0.f};
            const float* wp = cmp_w1 + ((size_t)lk * 4096 + ks * 512 + grp) * 256 + n; const float* pe = cmp_pe + (size_t)lk * 4096 + ks * 512 + grp;
#pragma unroll 8
            for (int i = 0; i < 64; ++i) a += *(const f32x4*)(wp + (size_t)i * 8 * 256) * pe[i * 8];
            *(LAS f32x4*)(sm + 4096 + grp * 256 + n) = a;
            __syncthreads();
            if (tid < 256) { float s = 0.f;
#pragma unroll
                for (int q = 0; q < 8; ++q) s += sm[4096 + q * 256 + tid];
                B1P[(lk * 8 + ks) * 256 + tid] = s; }
            __syncthreads(); } }
        if (BOTH(0)) GRID_BAR();
    }

    for (int l = 0; l < DEPTH; ++l) {
        const int pb = 1 + NPL * l;
#define LOAD_MOETAB(CNTP, NT_) do { __syncthreads(); if (tid < 32) moetab[tid] = (int)__hip_atomic_load((CNTP) + tid, RLX_AGENT); __syncthreads(); \
        if (tid == 0) { int us = 0, ps = 0; for (int e = 0; e < NEXP; ++e) { const int c = moetab[e], tl = (c + 255) >> 8; moetab[32 + e] = us; moetab[65 + e] = ps; us += tl * (NT_); ps += tl << 8; } moetab[64] = us; } \
        __syncthreads(); } while (0)

        if (IN(pb + 0)) {
            PH_IDS(); ArgsP ap = AP(); unsigned char* ws = ap->ws;
            const float* MOD = (const float*)(CTLP(ws) + CW_MOD); const float* mod = MOD + l * 12288;
            float* X = ap->out; bf16* H = (bf16*)(ws + WS_H); const bf16* Y = (const bf16*)(ws + WS_Y); const int* TE = (const int*)(ws + WS_TE);
            if (l > 0) LOAD_MOETAB((unsigned*)(CTLP(ws) + CW_CNT) + (l - 1) * 32, 1);
            { const float* g_attn = ap->in[4];
              for (int k = tid; k < D_; k += NTHR) { sm[k] = g_attn[l * D_ + k] * (1.f + mod[2048 + k]); sm[2048 + k] = mod[k]; sm[4096 + k] = (l > 0) ? MOD[(l - 1) * 12288 + 10240 + k] : 0.f; } }
            __syncthreads();
            const float* x_in = ap->in[0];
            for (int t = gw; t < S_; t += NGW) {
                f32x4 v[8]; float ss = 0.f;
                if (l == 0) {
#pragma unroll
                    for (int j = 0; j < 8; ++j) v[j] = *(const f32x4*)(x_in + (size_t)t * D_ + 256 * j + 4 * lane);
                } else {
                    const int4 te = *(const int4*)(TE + 4 * t);
                    const bf16* y0 = Y + (size_t)(moetab[65 + te.x] + te.y) * D_; const bf16* y1 = Y + (size_t)(moetab[65 + te.z] + te.w) * D_;
#pragma unroll
                    for (int j = 0; j < 8; ++j) { const int k = 256 * j + 4 * lane; const uint2 a = *(const uint2*)(y0 + k), b = *(const uint2*)(y1 + k);
                        const f32x4 gt2 = *(const LAS f32x4*)(sm + 4096 + k);
                        f32x4 ysum = (f32x4){bflo(a.x) + bflo(b.x), bfhi(a.x) + bfhi(b.x), bflo(a.y) + bflo(b.y), bfhi(a.y) + bfhi(b.y)};
                        v[j] = *(const f32x4*)(X + (size_t)t * D_ + k) + gt2 * ysum; *(f32x4*)(X + (size_t)t * D_ + k) = v[j]; }
                }
#pragma unroll
                for (int j = 0; j < 8; ++j) ss += (v[j][0] * v[j][0] + v[j][1] * v[j][1]) + (v[j][2] * v[j][2] + v[j][3] * v[j][3]);
                const float rstd = 1.f / sqrtf(wave_sum(ss, lane) * (1.f / D_) + RMS_EPS);
#pragma unroll
                for (int j = 0; j < 8; ++j) { const int k = 256 * j + 4 * lane; const f32x4 h = v[j] * rstd * *(const LAS f32x4*)(sm + k) + *(const LAS f32x4*)(sm + 2048 + k);
                    *(uint2*)(H + (size_t)t * D_ + k) = make_uint2(pk2(h[0], h[1]), pk2(h[2], h[3])); }
            }
            if (BOTH(pb + 0)) GRID_BAR();
        }
        if (IN(pb + 1)) {
            ArgsP ap = AP(); unsigned char* ws = ap->ws;
            pg8::Gemm g{(const bf16*)(ws + WS_H), (const bf16*)(ws + WS_WINT) + (size_t)l * NIN * D_, S_, NIN, D_}; pg8::StaticOrder So; So.init(S_, NIN, G, bid);
            EpiInProj E{(bf16*)(ws + WS_QN), (bf16*)(ws + WS_KC), (bf16*)(ws + WS_VC), (bf16*)(ws + WS_KS), (bf16*)(ws + WS_VS), (bf16*)(ws + WS_KW), (bf16*)(ws + WS_VW),
                        (bf16*)(ws + WS_QM), (bf16*)(ws + WS_KM), (bf16*)(ws + WS_VM), (float*)(ws + WS_GATES), (const float*)(ws + WS_ROPE)};
            pg8::gemm_phase<EpiInProj, pg8::StaticOrder, true, true>(lds, g, So, E);
            if (BOTH(pb + 1)) GRID_BAR();
        }
        if (IN(pb + 2)) {
            PH_IDS(); ArgsP ap = AP(); unsigned char* ws = ap->ws;
            if (bid < 32) {
                pg8::Gemm g{(const bf16*)(ws + WS_KC), (const bf16*)(ws + WS_WC1T) + (size_t)l * 2 * 512 * 2048, 4096, 512, 2048}; CompressOrder So{G, bid};
                EpiF32 E{(float*)(ws + WS_UL), 512};
                pg8::gemm_phase<EpiF32, CompressOrder, false, true>(lds, g, So, E);
            }
            {
                const bf16* KM = (const bf16*)(ws + WS_KM); bf16* KMEAN = (bf16*)(ws + WS_KMEAN);
                const int nb = (G > 32) ? G - 32 : G, b0 = (G > 32) ? bid - 32 : bid;
                if (b0 >= 0) for (int u = b0; u < 512; u += nb) { const int n = u >> 3, h = u & 7, rg = tid >> 4, c8 = (tid & 15) * 8;
                    float a8[8] = {0.f, 0.f, 0.f, 0.f, 0.f, 0.f, 0.f, 0.f};
#pragma unroll
                    for (int i = 0; i < 8; ++i) { const v4u kv = *(const v4u*)(KM + (size_t)(n * 256 + rg + 32 * i) * 1024 + h * 128 + c8);
                        a8[0] += bflo(kv.x); a8[1] += bfhi(kv.x); a8[2] += bflo(kv.y); a8[3] += bfhi(kv.y); a8[4] += bflo(kv.z); a8[5] += bfhi(kv.z); a8[6] += bflo(kv.w); a8[7] += bfhi(kv.w); }
#pragma unroll
                    for (int i = 0; i < 8; ++i) sm[rg * 128 + c8 + i] = a8[i];
                    __syncthreads();
                    if (tid < 128) { float s = 0.f;
#pragma unroll 8
                        for (int q = 0; q < 32; ++q) s += sm[q * 128 + tid];
                        KMEAN[(size_t)(h * 64 + n) * 128 + tid] = (bf16)f2bf(s * (1.f / 256.f)); }
                    __syncthreads(); }
            }
            {
                const bf16* QN = (const bf16*)(ws + WS_QN); const bf16* KW = (const bf16*)(ws + WS_KW); const bf16* VW = (const bf16*)(ws + WS_VW); bf16* OWIN = (bf16*)(ws + WS_OWIN);
                const bf16* QM = (const bf16*)(ws + WS_QM); const bf16* KM2 = (const bf16*)(ws + WS_KM); const bf16* VM = (const bf16*)(ws + WS_VM); bf16* POWN = (bf16*)(ws + WS_POWN); float* LSEO = (float*)(ws + WS_LSEO);
                const int nbw = (G > 32) ? G - 32 : G, bw = (G > 32) ? bid - 32 : bid;
                __syncthreads();
                att::Seam S; int L = bw;
                if (L >= 0 && L < 1024) { att::Ref cur = (L < 512) ? win_ref(L, QN, KW, VW, OWIN) : mown_ref(L - 512, QM, KM2, VM, POWN); att::prime<RFReg>(cur, (char*)lds_raw, S);
                    for (;;) { const int Ln = L + nbw; const bool more = Ln < 1024; const att::Ref nxt = more ? ((Ln < 512) ? win_ref(Ln, QN, KW, VW, OWIN) : mown_ref(Ln - 512, QM, KM2, VM, POWN)) : cur;
                        att::block<0, true, RFReg>(cur, nxt, LSEO, (char*)lds_raw, S);
                        if (!more) break; cur = nxt; L = Ln; } }
                __syncthreads();
            }
            if (BOTH(pb + 2)) GRID_BAR();
        }
        if (IN(pb + 3)) {
            PH_IDS(); ArgsP ap = AP(); unsigned char* ws = ap->ws;
            const float* UL = (const float*)(ws + WS_UL); const float* B1P = (const float*)(CTLP(ws) + CW_B1E); const float* cmp_b1 = ap->in[10]; const f32x2* ROPE = (const f32x2*)(ws + WS_ROPE);
            bf16* KCMP = (bf16*)(ws + WS_KCMP); bf16* VCMP = (bf16*)(ws + WS_VCMP); const float* cmp_w2 = ap->in[11];
            { const int kv = bid & 1; const float* w2 = cmp_w2 + (size_t)(l * 2 + kv) * 256 * 128; LAS float* be = (LAS float*)(lds + 135168 + 8192);
              if (tid < 256) { float s = cmp_b1[(l * 2 + kv) * 256 + tid];
#pragma unroll
                  for (int q = 0; q < 8; ++q) s += B1P[((l * 2 + kv) * 8 + q) * 256 + tid];
                  be[tid] = s; }
              for (int i = tid; i < 256 * 128 / 4; i += NTHR) *(LAS f32x4*)(sm + 4 * i) = *(const f32x4*)(w2 + 4 * i);
              LAS float* hid = (LAS float*)(lds + 135168) + wave * 256;
              __syncthreads();
              const int nb2 = (G + 1 - kv) >> 1;
              for (int r = (bid >> 1) * NWAVES + wave; r < NC * 2; r += nb2 * NWAVES) { const int c = r >> 1, g = r & 1;
                const float* Ur = UL + ((size_t)kv * 2048 + g * 1024 + c) * 512; const float* Lr = UL + ((size_t)kv * 2048 + g * 1024 + c + 1) * 512 + 256;
#pragma unroll
                for (int j = 0; j < 4; ++j) { const int n = lane + 64 * j; const float v = Ur[n] + Lr[n] + be[n];
                    hid[n] = 0.5f * v * (1.f + tanhf(0.7978845608028654f * (v + 0.044715f * v * v * v))); }
                LDS_WAIT(); asm volatile("" ::: "memory");
                float o0 = 0.f, o1 = 0.f;
#pragma unroll 8
                for (int n = 0; n < 256; ++n) { const float hv = hid[n]; o0 += hv * sm[n * 128 + lane]; o1 += hv * sm[n * 128 + 64 + lane]; }
                if (kv == 0) { const f32x2 cs = ROPE[(size_t)(16 * c + 31) * 64 + lane];
                    const float a = o0 * cs[0] - o1 * cs[1], b = o1 * cs[0] + o0 * cs[1];
                    *(unsigned*)(KCMP + ((size_t)c * 2 + g) * 128 + 2 * lane) = pk2(a, b);
                } else { VCMP[((size_t)c * 2 + g) * 128 + lane] = (bf16)f2bf(o0); VCMP[((size_t)c * 2 + g) * 128 + 64 + lane] = (bf16)f2bf(o1); }
                LDS_WAIT(); asm volatile("" ::: "memory");
              }
              __syncthreads(); }
            if (BOTH(pb + 3)) GRID_BAR();
        }
        if (IN(pb + 4)) {
            {   ArgsP ap = AP(); unsigned char* ws = ap->ws;
                const bf16* QN = (const bf16*)(ws + WS_QN); const bf16* KCMP = (const bf16*)(ws + WS_KCMP); const bf16* VCMP = (const bf16*)(ws + WS_VCMP);
                bf16* OCMP = (bf16*)(ws + WS_OCMP); float* IMP = (float*)(ws + WS_IMP);
                att::Seam S;
                for (int L = bid; L < 512; L += G) { const att::Ref cur = cmp_ref(L, QN, KCMP, VCMP, OCMP); float lse;
                    att::prime<RFCmp>(cur, (char*)lds_raw, S);
                    att::block<2, false, RFCmp>(cur, cur, nullptr, (char*)lds_raw, S, &lse);
                    att::imp_sweep<RFCmp>(cur, lse, IMP + ((size_t)cur.a1 * 64 * 2 + cur.a0) * 256, (char*)lds_raw, S); }
            }
            {   PH_IDS(); ArgsP ap = AP(); unsigned char* ws = ap->ws;
                const bf16* QM = (const bf16*)(ws + WS_QM); const bf16* KMEAN = (const bf16*)(ws + WS_KMEAN);
                unsigned* MCNT = (unsigned*)(CTLP(ws) + CW_MCNT) + l * 512 * CSTR; int* MLIST = (int*)(ws + WS_MLIST); float* LSES = (float*)(ws + WS_LSES);
                __syncthreads();
                att::Seam S;
                for (int L = bid; L < 512; L += G) { const int h = L & 7, nq = L >> 3;
                    att::Ref cur; cur.Q = QM + (size_t)nq * 256 * 1024 + h * 128; cur.O = nullptr; cur.K = KMEAN + (size_t)h * 64 * 128; cur.V = cur.K; cur.kpitch = 128; cur.list = nullptr;
                    cur.P0 = 0; cur.W = 0; cur.j_lo = 0; cur.j_hi = 1; cur.a0 = -1; cur.a1 = 0;
                    int sel[3]; att::gate_unit<RFReg>(cur, nq, (char*)lds_raw, S, sel);
                    if (lane < 32) { const int t = nq * 256 + wave * 32 + lane;
#pragma unroll
                        for (int s = 0; s < 3; ++s) {
                            if (sel[s] >= 0) { const unsigned p = atomicAdd(MCNT + (h * 64 + sel[s]) * CSTR, 1u); MLIST[(size_t)(h * 64 + sel[s]) * 16384 + p] = t * 4 + s; }
                            else LSES[(t * 8 + h) * 3 + s] = -INFINITY; } }
                }
            }
            if (BOTH(pb + 4)) GRID_BAR();
        }
        if (IN(pb + 5)) {
            PH_IDS(); ArgsP ap = AP(); unsigned char* ws = ap->ws;
            {   PH_IDS(); ArgsP ap = AP(); unsigned char* ws = ap->ws;
                const float* IMP = (const float*)(ws + WS_IMP); int* SEL = (int*)(ws + WS_SEL);
                unsigned* NCNT = (unsigned*)(CTLP(ws) + CW_NCNT) + l * 512 * CSTR; int* NLIST = (int*)(ws + WS_NLIST);
                const int lam = lane & 15, rho = lane >> 4;
                for (int ub = gw * 4; ub < S_ * 2; ub += NGW * 4) { const int u = ub + rho, t = u >> 1, g = u & 1, tb = t >> 6;
                    float v[16];
#pragma unroll
                    for (int i = 0; i < 16; ++i) { const int j = lam + 16 * i; const float im = IMP[(size_t)u * 256 + j]; const bool forced = (j == 0) || (j == tb) || (j == tb - 1);
                        v[i] = (j > tb) ? -INFINITY : (forced ? 1e9f : im); }
                    int mysel = -1;
                    for (int r = 0; r < 16; ++r) { const int pick = row_pick<16>(v, lam); if (lam == r) mysel = pick; if (__all(pick < 0)) break; }
                    SEL[(size_t)u * 16 + lam] = mysel;
                    if (mysel >= 0) {
                        unsigned p;
                        if (mysel == 0) p = (unsigned)t; else if (mysel == tb) p = (unsigned)(t & 63); else if (mysel == tb - 1) p = 64u + (unsigned)(t & 63);
                        else p = 128u + atomicAdd(NCNT + (g * 256 + mysel) * CSTR, 1u);
                        NLIST[(size_t)(g * 256 + mysel) * 16384 + p] = t * 16 + lam; }
                }
            }
            {   PH_IDS(); ArgsP ap = AP(); unsigned char* ws = ap->ws;
                const bf16* QM = (const bf16*)(ws + WS_QM); const bf16* KM = (const bf16*)(ws + WS_KM); const bf16* VM = (const bf16*)(ws + WS_VM);
                bf16* POWN = (bf16*)(ws + WS_POWN); bf16* PSEL = (bf16*)(ws + WS_PSEL); float* LSEO = (float*)(ws + WS_LSEO); float* LSES = (float*)(ws + WS_LSES);
                const int* MLIST = (const int*)(ws + WS_MLIST); unsigned* MCNT = (unsigned*)(CTLP(ws) + CW_MCNT) + l * 512 * CSTR;
                LAS int* mtab = (LAS int*)(lds + att::LDS_BYTES);
                __syncthreads();
                mtab[tid] = (int)__hip_atomic_load(MCNT + tid * CSTR, RLX_AGENT);
                __syncthreads();
                LAS unsigned short* ulist = (LAS unsigned short*)(lds + 108544);
                { int tot; const int nu = (mtab[tid] + 255) >> 8; const int ex = block_excl_scan(nu, mtab + 1040, tid, &tot); mtab[512 + tid] = ex; if (tid == 0) mtab[1024] = tot;
                  for (int u = 0; u < nu; ++u) ulist[ex + u] = (unsigned short)tid; }
                __syncthreads();
                const int nsel = mtab[1024];
                att::Seam S;
                { int L = bid;
                  if (L < nsel) { att::Ref cur = msel_ref(L, mtab, ulist, MLIST, QM, KM, VM, PSEL); att::prime<RFSel>(cur, (char*)lds_raw, S);
                    for (;;) { const bool more = L + G < nsel; const att::Ref nxt = more ? msel_ref(L + G, mtab, ulist, MLIST, QM, KM, VM, PSEL) : cur;
                        att::block<1, false, RFSel>(cur, nxt, LSES, (char*)lds_raw, S);
                        if (!more) break; cur = nxt; L += G; } } }
                __syncthreads();
            }
            if (BOTH(pb + 5)) GRID_BAR();
        }
        if (IN(pb + 6)) {
            PH_IDS(); ArgsP ap = AP(); unsigned char* ws = ap->ws;
            const bf16* POWN = (const bf16*)(ws + WS_POWN); const bf16* PSEL = (const bf16*)(ws + WS_PSEL); const float* LSEO = (const float*)(ws + WS_LSEO); const float* LSES = (const float*)(ws + WS_LSES);
            bf16* OMIX = (bf16*)(ws + WS_OMIX);
            for (int t = gw; t < S_; t += NGW) {
                const int hh = (lane >> 2) & 7, ii = lane & 3;
                const float lv = (ii == 0) ? LSEO[t * 8 + hh] : LSES[(t * 8 + hh) * 3 + ii - 1];
                float m = fmaxf(lv, lane_get(lv, lane ^ 1)); m = fmaxf(m, lane_get(m, lane ^ 2));
                float w = __expf(lv - m); float sw = w + lane_get(w, lane ^ 1); sw += lane_get(sw, lane ^ 2); w = w / sw;
#pragma unroll
                for (int hp = 0; hp < 2; ++hp) { const int h = hp * 4 + (lane >> 4), c8 = (lane & 15) * 8;
                    const float w0 = lane_get(w, h * 4), w1 = lane_get(w, h * 4 + 1), w2 = lane_get(w, h * 4 + 2), w3 = lane_get(w, h * 4 + 3);
                    const bf16* ps = PSEL + (size_t)((t * 8 + h) * 3) * 128 + c8;
                    const v4u a0 = *(const v4u*)(POWN + (size_t)t * 1024 + h * 128 + c8);
                    v4u a1 = (v4u){0u, 0u, 0u, 0u}, a2 = a1, a3 = a1;
                    if (w1 > 0.f) a1 = *(const v4u*)(ps); if (w2 > 0.f) a2 = *(const v4u*)(ps + 128); if (w3 > 0.f) a3 = *(const v4u*)(ps + 256);
                    v4u ov;
                    ov.x = pk2(w0 * bflo(a0.x) + w1 * bflo(a1.x) + w2 * bflo(a2.x) + w3 * bflo(a3.x), w0 * bfhi(a0.x) + w1 * bfhi(a1.x) + w2 * bfhi(a2.x) + w3 * bfhi(a3.x));
                    ov.y = pk2(w0 * bflo(a0.y) + w1 * bflo(a1.y) + w2 * bflo(a2.y) + w3 * bflo(a3.y), w0 * bfhi(a0.y) + w1 * bfhi(a1.y) + w2 * bfhi(a2.y) + w3 * bfhi(a3.y));
                    ov.z = pk2(w0 * bflo(a0.z) + w1 * bflo(a1.z) + w2 * bflo(a2.z) + w3 * bflo(a3.z), w0 * bfhi(a0.z) + w1 * bfhi(a1.z) + w2 * bfhi(a2.z) + w3 * bfhi(a3.z));
                    ov.w = pk2(w0 * bflo(a0.w) + w1 * bflo(a1.w) + w2 * bflo(a2.w) + w3 * bflo(a3.w), w0 * bfhi(a0.w) + w1 * bfhi(a1.w) + w2 * bfhi(a2.w) + w3 * bfhi(a3.w));
                    *(v4u*)(OMIX + (size_t)t * 2048 + 1024 + h * 128 + c8) = ov; }
            }
            if (BOTH(pb + 6)) GRID_BAR();

        }
        if (IN(pb + 7)) {
            PH_IDS(); ArgsP ap = AP(); unsigned char* ws = ap->ws;
            const bf16* QN = (const bf16*)(ws + WS_QN); const bf16* KS = (const bf16*)(ws + WS_KS); const bf16* VS = (const bf16*)(ws + WS_VS);
            bf16* PSLC = (bf16*)(ws + WS_PSLC); float* LSEN = (float*)(ws + WS_LSEN); const int* NLIST = (const int*)(ws + WS_NLIST); unsigned* NCNT = (unsigned*)(CTLP(ws) + CW_NCNT) + l * 512 * CSTR;
            LAS int* ntab = (LAS int*)(lds + att::LDS_BYTES);
            __syncthreads();
            { const int j = tid & 255; ntab[tid] = (j == 0) ? S_ : (int)__hip_atomic_load(NCNT + tid * CSTR, RLX_AGENT) + 64 + (j < 255 ? 64 : 0); }
            __syncthreads();
            LAS unsigned short* ulist = (LAS unsigned short*)(lds + 108544);
            { int tot; const int nu = (ntab[tid] + 63) >> 6; const int ex = block_excl_scan(nu, ntab + 1040, tid, &tot); ntab[512 + tid] = ex; if (tid == 0) ntab[1024] = tot;
              for (int u = 0; u < nu; ++u) ulist[ex + u] = (unsigned short)tid; }
            __syncthreads();
            const int nun = ntab[1024];
            att::Seam S; int L = bid;
            if (L < nun) { att::Ref cur = nsel_ref(L, ntab, ulist, NLIST, QN, KS, VS, PSLC); att::prime<RFSlc>(cur, (char*)lds_raw, S);
                for (;;) { const bool more = L + G < nun; const att::Ref nxt = more ? nsel_ref(L + G, ntab, ulist, NLIST, QN, KS, VS, PSLC) : cur;
                    att::block<2, false, RFSlc, true, true>(cur, nxt, LSEN, (char*)lds_raw, S);
                    if (!more) break; cur = nxt; L += G; } }
            __syncthreads();
            if (BOTH(pb + 7)) GRID_BAR();
        }
        if (IN(pb + 8)) {
            PH_IDS(); ArgsP ap = AP(); unsigned char* ws = ap->ws;
            const unsigned char* PSLC = (const unsigned char*)(ws + WS_PSLC); const float* LSEN = (const float*)(ws + WS_LSEN); const int* SEL = (const int*)(ws + WS_SEL); const float* GATES = (const float*)(ws + WS_GATES);
            const bf16* OCMP = (const bf16*)(ws + WS_OCMP); const bf16* OWIN = (const bf16*)(ws + WS_OWIN); bf16* OMIX = (bf16*)(ws + WS_OMIX);
            for (int u = gw; u < S_ * 2; u += NGW) { const int t = u >> 1, g = u & 1;
                const int sv = (lane < 16) ? SEL[(size_t)u * 16 + lane] : -1;
                const int nsel = __popcll(__ballot(sv >= 0));
                const float lv = ((lane >> 2) < nsel) ? LSEN[(size_t)u * 64 + lane] : -INFINITY;
                float m = lv;
#pragma unroll
                for (int o = 4; o < 64; o <<= 1) m = fmaxf(m, lane_get(m, lane ^ o));
                float w = __expf(lv - m), sw = w;
#pragma unroll
                for (int o = 4; o < 64; o <<= 1) sw += lane_get(sw, lane ^ o);
                w = w / sw * 0.0625f;
                const int r = lane >> 4, c8 = (lane & 15) * 8;
                float o8[8] = {0.f, 0.f, 0.f, 0.f, 0.f, 0.f, 0.f, 0.f};
                uint2 pv[16];
#pragma unroll
                for (int s = 0; s < 16; ++s) { const int sc = s < nsel ? s : nsel - 1; pv[s] = *(const uint2*)(PSLC + ((size_t)(u * 16 + sc) * 4 + r) * 128 + c8); }
#pragma unroll
                for (int s = 0; s < 16; ++s) { const float ws_ = lane_get(w, s * 4 + r);
                    o8[0] += ws_ * __builtin_amdgcn_cvt_f32_fp8((int)pv[s].x, 0); o8[1] += ws_ * __builtin_amdgcn_cvt_f32_fp8((int)pv[s].x, 1); o8[2] += ws_ * __builtin_amdgcn_cvt_f32_fp8((int)pv[s].x, 2); o8[3] += ws_ * __builtin_amdgcn_cvt_f32_fp8((int)pv[s].x, 3);
                    o8[4] += ws_ * __builtin_amdgcn_cvt_f32_fp8((int)pv[s].y, 0); o8[5] += ws_ * __builtin_amdgcn_cvt_f32_fp8((int)pv[s].y, 1); o8[6] += ws_ * __builtin_amdgcn_cvt_f32_fp8((int)pv[s].y, 2); o8[7] += ws_ * __builtin_amdgcn_cvt_f32_fp8((int)pv[s].y, 3); }
                const int hd = g * 4 + r; const float g0 = GATES[(size_t)t * 32 + hd * 3], g1 = GATES[(size_t)t * 32 + hd * 3 + 1], g2 = GATES[(size_t)t * 32 + hd * 3 + 2];
                const size_t oi = (size_t)t * 1024 + hd * 128 + c8;
                const v4u cv = *(const v4u*)(OCMP + oi), wv = *(const v4u*)(OWIN + oi);
                v4u ov;
                ov.x = pk2(g1 * o8[0] + g0 * bflo(cv.x) + g2 * bflo(wv.x), g1 * o8[1] + g0 * bfhi(cv.x) + g2 * bfhi(wv.x));
                ov.y = pk2(g1 * o8[2] + g0 * bflo(cv.y) + g2 * bflo(wv.y), g1 * o8[3] + g0 * bfhi(cv.y) + g2 * bfhi(wv.y));
                ov.z = pk2(g1 * o8[4] + g0 * bflo(cv.z) + g2 * bflo(wv.z), g1 * o8[5] + g0 * bfhi(cv.z) + g2 * bfhi(wv.z));
                ov.w = pk2(g1 * o8[6] + g0 * bflo(cv.w) + g2 * bflo(wv.w), g1 * o8[7] + g0 * bfhi(cv.w) + g2 * bfhi(wv.w));
                *(v4u*)(OMIX + (size_t)t * 2048 + hd * 128 + c8) = ov;
            }
            if (BOTH(pb + 8)) GRID_BAR();
        }
        if (IN(pb + 9)) {
            ArgsP ap = AP(); unsigned char* ws = ap->ws;
            pg8::Gemm g{(const bf16*)(ws + WS_OMIX), (const bf16*)(ws + WS_WOUTT) + (size_t)l * D_ * D_, S_, D_, D_}; pg8::StaticOrder So; So.init(S_, D_, G, bid);
            EpiOutProj E{l == 0 ? ap->in[0] : (const float*)ap->out, ap->out, (const float*)(CTLP(ws) + CW_MOD) + l * 12288 + 4096};
            pg8::gemm_phase<EpiOutProj, pg8::StaticOrder, true, true>(lds, g, So, E);
            if (BOTH(pb + 9)) GRID_BAR();
        }
        if (IN(pb + 10)) {
            PH_IDS(); ArgsP ap = AP(); unsigned char* ws = ap->ws;
            const float* mod = (const float*)(CTLP(ws) + CW_MOD) + l * 12288;
            const float* X = ap->out; bf16* H = (bf16*)(ws + WS_H); const bf16* WrT = (const bf16*)(ws + WS_WRT); const float* b_router = ap->in[13];
            unsigned* CNT = (unsigned*)(CTLP(ws) + CW_CNT) + l * 32; int* TE = (int*)(ws + WS_TE); int* TOKIDX = (int*)(ws + WS_TOKIDX); float* WTS = (float*)(ws + WS_WTS);
            { const float* g_ffn = ap->in[5];
              for (int k = tid; k < D_; k += NTHR) { sm[k] = g_ffn[l * D_ + k] * (1.f + mod[8192 + k]); sm[2048 + k] = mod[6144 + k]; }
              if (tid < 32) sm[4160 + tid] = b_router[tid]; }
            typedef short bf16x8_t __attribute__((ext_vector_type(8))); typedef float f32x16_t __attribute__((ext_vector_type(16)));
            for (int bt = bid; bt < S_ / 64; bt += G) { const int t0 = bt * 64;
                __syncthreads();
                for (int rr = 0; rr < 8; rr += 2) { const int row = wave * 8 + rr; float ss0 = 0.f, ss1 = 0.f; f32x4 va[8], vb[8];
#pragma unroll
                    for (int j = 0; j < 8; ++j) { va[j] = *(const f32x4*)(X + (size_t)(t0 + row) * D_ + 256 * j + 4 * lane); vb[j] = *(const f32x4*)(X + (size_t)(t0 + row + 1) * D_ + 256 * j + 4 * lane); }
#pragma unroll
                    for (int j = 0; j < 8; ++j) { ss0 += (va[j][0] * va[j][0] + va[j][1] * va[j][1]) + (va[j][2] * va[j][2] + va[j][3] * va[j][3]); ss1 += (vb[j][0] * vb[j][0] + vb[j][1] * vb[j][1]) + (vb[j][2] * vb[j][2] + vb[j][3] * vb[j][3]); }
                    ss0 = wave_sum(ss0, lane); ss1 = wave_sum(ss1, lane);
                    if (lane == 0) { sm[4096 + row] = 1.f / sqrtf(ss0 * (1.f / D_) + RMS_EPS); sm[4096 + row + 1] = 1.f / sqrtf(ss1 * (1.f / D_) + RMS_EPS); } }
                __syncthreads();
                { const int r = lane & 31, kh = lane >> 5; f32x16_t acc0 = {}, acc1 = {};
                  const float rs0 = sm[4096 + r], rs1 = sm[4096 + 32 + r];
#pragma unroll 2
                  for (int ks = 0; ks < 16; ++ks) { const int k = wave * 256 + ks * 16 + kh * 8;
                    const bf16x8_t wh = *(const bf16x8_t*)(WrT + (size_t)r * 2048 + k), wl = *(const bf16x8_t*)(WrT + 32 * 2048 + (size_t)r * 2048 + k);
                    const f32x4 gA = *(const LAS f32x4*)(sm + k), gB = *(const LAS f32x4*)(sm + k + 4), sA = *(const LAS f32x4*)(sm + 2048 + k), sB = *(const LAS f32x4*)(sm + 2048 + k + 4);
#pragma unroll
                    for (int rg = 0; rg < 2; ++rg) { const size_t ro = (size_t)(t0 + rg * 32 + r) * D_ + k; const float rs = rg ? rs1 : rs0;
                        const f32x4 xa = *(const f32x4*)(X + ro), xb = *(const f32x4*)(X + ro + 4);
                        const f32x4 ha = xa * rs * gA + sA, hb = xb * rs * gB + sB;
                        const unsigned h0 = pk2(ha[0], ha[1]), h1 = pk2(ha[2], ha[3]), h2 = pk2(hb[0], hb[1]), h3 = pk2(hb[2], hb[3]);
                        *(v4u*)(H + ro) = (v4u){h0, h1, h2, h3};
                        const unsigned l0 = pk2(ha[0] - bflo(h0), ha[1] - bfhi(h0)), l1 = pk2(ha[2] - bflo(h1), ha[3] - bfhi(h1)), l2 = pk2(hb[0] - bflo(h2), hb[1] - bfhi(h2)), l3 = pk2(hb[2] - bflo(h3), hb[3] - bfhi(h3));
                        const v4u hv = (v4u){h0, h1, h2, h3}, lv = (v4u){l0, l1, l2, l3};
                        const bf16x8_t ahi = __builtin_bit_cast(bf16x8_t, hv), alo = __builtin_bit_cast(bf16x8_t, lv);
                        if (rg == 0) { acc0 = __builtin_amdgcn_mfma_f32_32x32x16_bf16(wh, ahi, acc0, 0, 0, 0); acc0 = __builtin_amdgcn_mfma_f32_32x32x16_bf16(wl, ahi, acc0, 0, 0, 0); acc0 = __builtin_amdgcn_mfma_f32_32x32x16_bf16(wh, alo, acc0, 0, 0, 0); }
                        else         { acc1 = __builtin_amdgcn_mfma_f32_32x32x16_bf16(wh, ahi, acc1, 0, 0, 0); acc1 = __builtin_amdgcn_mfma_f32_32x32x16_bf16(wl, ahi, acc1, 0, 0, 0); acc1 = __builtin_amdgcn_mfma_f32_32x32x16_bf16(wh, alo, acc1, 0, 0, 0); } } }
#pragma unroll
                  for (int q = 0; q < 16; ++q) { const int e = (q & 3) + 8 * (q >> 2) + 4 * kh;
                      sm[5120 + ((wave * 2 + 0) * 32 + e) * 32 + r] = acc0[q]; sm[5120 + ((wave * 2 + 1) * 32 + e) * 32 + r] = acc1[q]; } }
                __syncthreads();
                { const int tk6 = tid & 63, eq = tid >> 6, rg = tk6 >> 5, tk = tk6 & 31;
#pragma unroll
                  for (int i = 0; i < 4; ++i) { const int e = eq * 4 + i; float s = 0.f;
#pragma unroll
                      for (int w = 0; w < 8; ++w) s += sm[5120 + ((w * 2 + rg) * 32 + e) * 32 + tk];
                      sm[5120 + 16384 + tk6 * 33 + e] = 1.f / (1.f + __expf(-s)); } }
                __syncthreads();
                if (tid < 64) { const int t = t0 + tid;
                    float lg[32];
#pragma unroll
                    for (int e = 0; e < 32; ++e) lg[e] = sm[5120 + 16384 + tid * 33 + e];
                    int grp = 0; float best = -INFINITY;
#pragma unroll
                    for (int gq = 0; gq < 4; ++gq) { float m1 = -INFINITY, m2 = -INFINITY;
#pragma unroll
                        for (int i = 0; i < 8; ++i) { const float b = lg[gq * 8 + i] + sm[4160 + gq * 8 + i]; if (b > m1) { m2 = m1; m1 = b; } else if (b > m2) m2 = b; }
                        const float sgs = m1 + m2; if (sgs > best) { best = sgs; grp = gq; } }
                    float m1 = -INFINITY, m2 = -INFINITY, s1 = 0.f, s2 = 0.f; int i1 = 0, i2 = 0;
#pragma unroll
                    for (int e = 0; e < 32; ++e) { const bool ing = (e >> 3) == grp; const float b = lg[e] + sm[4160 + e];
                        if (ing && b > m1) { m2 = m1; i2 = i1; s2 = s1; m1 = b; i1 = e; s1 = lg[e]; } else if (ing && b > m2) { m2 = b; i2 = e; s2 = lg[e]; } }
                    const float inv = 1.f / (s1 + s2);
                    const unsigned p1 = atomicAdd(CNT + i1, 1u), p2 = atomicAdd(CNT + i2, 1u);
                    TOKIDX[(size_t)i1 * ECAP + p1] = t; TOKIDX[(size_t)i2 * ECAP + p2] = t; WTS[(size_t)i1 * ECAP + p1] = s1 * inv; WTS[(size_t)i2 * ECAP + p2] = s2 * inv;
                    *(int4*)(TE + 4 * t) = make_int4(i1, (int)p1, i2, (int)p2);
                }
            }
            if (BOTH(pb + 10)) GRID_BAR();
        }
        if (IN(pb + 11)) {
            PH_IDS(); ArgsP ap = AP(); unsigned char* ws = ap->ws;
            LOAD_MOETAB((unsigned*)(CTLP(ws) + CW_CNT) + l * 32, 4);
            pg8::Gemm g{(const bf16*)(ws + WS_H), (const bf16*)(ws + WS_WGUT), 0, 0, D_}; MoeOrder<true> So{moetab, 4, G, bid, 4, l * 32 * 4, (const int*)(ws + WS_TOKIDX)};
            EpiGateUp E{(bf16*)(ws + WS_HACT)};
            pg8::gemm_phase<EpiGateUp, MoeOrder<true>, true, true>(lds, g, So, E);
            if (BOTH(pb + 11)) GRID_BAR();
        }
        if (IN(pb + 12)) {
            PH_IDS(); ArgsP ap = AP(); unsigned char* ws = ap->ws;
            LOAD_MOETAB((unsigned*)(CTLP(ws) + CW_CNT) + l * 32, 8);
            pg8::Gemm g{(const bf16*)(ws + WS_HACT), (const bf16*)(ws + WS_WDT), 0, 0, DEXP}; MoeOrder<false> So{moetab, 8, G, bid, 8, l * 32 * 8, nullptr};
            EpiDown E{(bf16*)(ws + WS_Y), (const float*)(ws + WS_WTS), moetab};
            pg8::gemm_phase<EpiDown, MoeOrder<false>, true, true>(lds, g, So, E);
            if (BOTH(pb + 12)) GRID_BAR();
        }
    }
    if (IN(NPH - 1)) {
        PH_IDS(); ArgsP ap = AP(); unsigned char* ws = ap->ws;
        float* X = ap->out; const bf16* Y = (const bf16*)(ws + WS_Y); const int* TE = (const int*)(ws + WS_TE);
        LOAD_MOETAB((unsigned*)(CTLP(ws) + CW_CNT) + 32, 1);
        const bool tmo_set = (MK_N_LAUNCHES == 1) && (__hip_atomic_load((unsigned*)(CTLP(ws) + CW_BAR) + XB_TMO, RLX_AGENT) != 0u);
        { const float* g_final = ap->in[17]; const float* MOD = (const float*)(CTLP(ws) + CW_MOD);
          for (int k = tid; k < D_; k += NTHR) { sm[k] = g_final[k]; sm[2048 + k] = MOD[12288 + 10240 + k]; } }
        __syncthreads();
        for (int t = gw; t < S_; t += NGW) {
            f32x4 v[8]; float ss = 0.f;
            const int4 te = *(const int4*)(TE + 4 * t);
            const bf16* y0 = Y + (size_t)(moetab[65 + te.x] + te.y) * D_; const bf16* y1 = Y + (size_t)(moetab[65 + te.z] + te.w) * D_;
#pragma unroll
            for (int j = 0; j < 8; ++j) { const int k = 256 * j + 4 * lane; const uint2 a = *(const uint2*)(y0 + k), b = *(const uint2*)(y1 + k);
                const f32x4 gt2 = *(const LAS f32x4*)(sm + 2048 + k);
                f32x4 ysum = (f32x4){bflo(a.x) + bflo(b.x), bfhi(a.x) + bfhi(b.x), bflo(a.y) + bflo(b.y), bfhi(a.y) + bfhi(b.y)};
                v[j] = *(const f32x4*)(X + (size_t)t * D_ + k) + gt2 * ysum;
                ss += (v[j][0] * v[j][0] + v[j][1] * v[j][1]) + (v[j][2] * v[j][2] + v[j][3] * v[j][3]); }
            const float rstd = (tmo_set ? __builtin_nanf("") : 1.f) / sqrtf(wave_sum(ss, lane) * (1.f / D_) + RMS_EPS);
#pragma unroll
            for (int j = 0; j < 8; ++j) { const int k = 256 * j + 4 * lane; *(f32x4*)(X + (size_t)t * D_ + k) = v[j] * rstd * *(const LAS f32x4*)(sm + k); }
        }
    }
#undef IN
#undef BOTH
#undef GRID_BAR
#undef LOAD_MOETAB
#undef AP
#undef CTLP
#undef PH_IDS
}

extern "C" void kernel_launch(void* const* d_in, const int* in_sizes, int n_in, void* d_out, int out_size, void* d_ws, size_t ws_size, hipStream_t stream) {
    static int grid = 0;
    if (grid == 0) {
        if (n_in != 18 || out_size != S_ * D_ || ws_size < WS_END) { fprintf(stderr, "kernel_launch: unexpected shapes (n_in %d out %d ws %zu)\n", n_in, out_size, ws_size); grid = -1; return; }
        int dev = 0, cus = 0, per_cu = 0;
        if (hipGetDevice(&dev) != hipSuccess || hipDeviceGetAttribute(&cus, hipDeviceAttributeMultiprocessorCount, dev) != hipSuccess) { grid = -1; return; }
        if (hipFuncSetAttribute((const void*)mk_fwd, hipFuncAttributeMaxDynamicSharedMemorySize, LDS_BYTES) != hipSuccess) { fprintf(stderr, "kernel_launch: hipFuncSetAttribute failed\n"); grid = -1; return; }
        if (hipOccupancyMaxActiveBlocksPerMultiprocessor(&per_cu, (const void*)mk_fwd, NTHR, LDS_BYTES) != hipSuccess || per_cu < 1) { fprintf(stderr, "kernel_launch: occupancy query says %d\n", per_cu); }
        (void)hipGetLastError();
        grid = cus;
    }
    if (grid < 0) return;
    if (hipMemsetAsync((char*)d_ws + WS_CTL, 0, CTL_ZERO_BYTES, stream) != hipSuccess) return;
    Args a{};
    for (int i = 0; i < 18; ++i) a.in[i] = (const float*)d_in[i];
    a.out = (float*)d_out; a.ws = (unsigned char*)d_ws; a.pad = 0;
    if (MK_N_LAUNCHES == 1) {
        a.ph_lo = 0; a.ph_hi = NPH; a.li = 0;
        hipLaunchKernelGGL(mk_fwd, dim3(grid), dim3(NTHR), LDS_BYTES, stream, a);
    } else {
        for (int p = 0; p < NPH; ++p) { a.ph_lo = p; a.ph_hi = p + 1; a.li = p; hipLaunchKernelGGL(mk_fwd, dim3(grid), dim3(NTHR), LDS_BYTES, stream, a); }
    }
}
```

```cpp
#include <hip/hip_runtime.h>
#include <cstdio>
#include <cstdint>


#define WIDTAB_OFF (131072 + 1024)
__device__ __forceinline__ int wg_tid(const __attribute__((address_space(3))) int* widtab) {
    unsigned hw; asm volatile("s_getreg_b32 %0, hwreg(HW_REG_HW_ID, 0, 6)" : "=s"(hw));
    int lane; asm volatile("v_mbcnt_lo_u32_b32 %0, -1, 0\n\tv_mbcnt_hi_u32_b32 %0, -1, %0" : "=v"(lane));
    return widtab[hw] * 64 + lane;
}

namespace pg8 {
#define PG8_LAS __attribute__((address_space(3)))
typedef unsigned short bf16_t;
typedef short bf16x8 __attribute__((ext_vector_type(8)));
typedef float f32x4 __attribute__((ext_vector_type(4)));
typedef unsigned u32x4 __attribute__((ext_vector_type(4)));
constexpr int BM = 256, BK = 64, HALF = 128, HTB = HALF * BK * 2, STAGE_BYTES = 8 * HTB, NXCD = 8, WGM = 8;

__host__ __device__ __forceinline__ int lds_byte(int r, int c) { const int st = (r >> 4) * 2 + (c >> 5), rr = r & 15, cc = c & 31, ob = rr * 64 + cc * 2; return st * 1024 + (ob ^ (((ob >> 9) & 1) << 5)); }
__host__ __device__ __forceinline__ void stage_rc(int b, int& R, int& C) { const int st = b / 1024, sb = b % 1024, swz = sb ^ (((sb >> 9) & 1) << 5); R = (st >> 1) * 16 + swz / 64; C = (st & 1) * 32 + (swz % 64) / 2; }
__host__ __device__ __forceinline__ int perm32(int rho) { const int n = rho >> 4, i = rho & 15; return 8 * (i >> 2) + 4 * n + (i & 3); }

struct Unit { int pm, pn, e, mt, pnl; };
struct Gemm { const bf16_t* A; const bf16_t* Bt; int M, N, K; };

struct StaticOrder {
    static constexpr bool GATHER = false;
    int nM, nN, nwg, G, c;
    __host__ __device__ void init(int M, int N, int G_, int c_) { nM = M / BM; nN = N / BM; nwg = nM * nN; G = G_; c = c_; }
    __host__ __device__ bool next(int i, Unit& u) const {
        const long L = (long)i * G + c; if (L >= nwg) return false;
        int wgid = (int)L; { const int q = nwg / NXCD, r = nwg % NXCD, xcd = wgid % NXCD, off = wgid / NXCD; wgid = (xcd < r ? xcd * (q + 1) : r * (q + 1) + (xcd - r) * q) + off; }
        const int nig = WGM * nN, gid = wgid / nig, fm = gid * WGM, gsz = (nM - fm) < WGM ? (nM - fm) : WGM;
        u.pm = fm + ((wgid % nig) % gsz); u.pn = (wgid % nig) / gsz; u.e = 0; u.mt = 0; u.pnl = u.pn; return true;
    }
    __device__ __forceinline__ void a_offs(const Unit&, int, int, int, int, int, unsigned (&)[2][2]) const {}
    __device__ __forceinline__ void a_ready(const Unit&) const {}
    __device__ __forceinline__ void done(const Unit&) const {}
};

__device__ __forceinline__ unsigned cvt_pk_bf16(float lo, float hi) { unsigned r; asm volatile("v_cvt_pk_bf16_f32 %0, %1, %2" : "=v"(r) : "v"(lo), "v"(hi)); return r; }

template <class Epi, class Sched, bool ALIGN_EPI = false, bool SP2 = false>
__device__ __forceinline__ void gemm_phase(PG8_LAS unsigned char* lds, const Gemm g, const Sched& S, const Epi& E) {
    const int tid_ = wg_tid((const PG8_LAS int*)(lds + WIDTAB_OFF));
    const int tid = tid_, wid = __builtin_amdgcn_readfirstlane(tid >> 6), lane = tid & 63, wr = wid >> 2, wc = wid & 3, fr = lane & 15, fq = lane >> 4;
    const int K = g.K, nt = K / BK;
    unsigned voffA[2], voffB[2]; int RR[2], CC[2];
#pragma unroll
    for (int i = 0; i < 2; ++i) { int R, C; stage_rc(tid * 16 + i * 8192, R, C); const int Rb = Epi::PERM ? ((R & ~31) + perm32(R & 31)) : R;
        RR[i] = R; CC[i] = C; voffA[i] = (unsigned)(R * K + C) * 2u; voffB[i] = (unsigned)(Rb * K + C) * 2u; }
    const size_t kstep = (size_t)(BK * 2);
    const size_t hstep = (size_t)HALF * K * 2;
    const size_t tstep = 2 * hstep;
    const unsigned ldsw = (unsigned)wid * 1024u;
    const int aoff = lds_byte(wr * 64 + fr, fq * 8), boff = lds_byte(wc * 32 + fr, fq * 8);
    const char* gA = (const char*)g.A;
    unsigned aoC[2][2] = {{0u, 0u}, {0u, 0u}}, aoN[2][2] = {{0u, 0u}, {0u, 0u}};
#define PG8_SA(b, h) (((b) * 2 + (h)) * HTB)
#define PG8_SB(b, h) ((4 + (b) * 2 + (h)) * HTB)
#define PG8_STAGE(bufoff, gbase, voff) do { _Pragma("unroll") for (int _i = 0; _i < 2; ++_i) \
        __builtin_amdgcn_global_load_lds((const unsigned*)((const char*)(gbase) + (voff)[_i]), (PG8_LAS unsigned*)(lds + (bufoff) + ldsw + _i * 8192), 16, 0, 0); } while (0)
#define PG8_STAGE_A(bufoff, h, PN, KO) do { if constexpr (Sched::GATHER) { _Pragma("unroll") for (int _i = 0; _i < 2; ++_i) \
        __builtin_amdgcn_global_load_lds((const unsigned*)(gA + aoC[h][_i] + (KO)), (PG8_LAS unsigned*)(lds + (bufoff) + ldsw + _i * 8192), 16, 0, 0); } \
        else { PG8_STAGE(bufoff, (PN) + (h) * hstep, voffA); } } while (0)
#define PG8_LDA(dst, b, h) do { _Pragma("unroll") for (int m = 0; m < 4; ++m) _Pragma("unroll") for (int k = 0; k < 2; ++k) dst[m][k] = *(const PG8_LAS bf16x8*)(lds + PG8_SA(b, h) + aoff + m * 2048 + k * 1024); } while (0)
#define PG8_LDB(dst, b, h) do { _Pragma("unroll") for (int n = 0; n < 2; ++n) _Pragma("unroll") for (int k = 0; k < 2; ++k) dst[n][k] = *(const PG8_LAS bf16x8*)(lds + PG8_SB(b, h) + boff + n * 2048 + k * 1024); } while (0)
#define PG8_MMA(ai, bj, At, Bt) do { __builtin_amdgcn_s_setprio(1); _Pragma("unroll") for (int m = 0; m < 4; ++m) _Pragma("unroll") for (int n = 0; n < 2; ++n) _Pragma("unroll") for (int k = 0; k < 2; ++k) \
        acc[ai][bj][m][n] = __builtin_amdgcn_mfma_f32_16x16x32_bf16(Bt[n][k], At[m][k], acc[ai][bj][m][n], 0, 0, 0); __builtin_amdgcn_s_setprio(0); } while (0)
#define PG8_WAIT_V(n) asm volatile("s_waitcnt vmcnt(" #n ")" ::: "memory")
#define PG8_WAIT_L(n) asm volatile("s_waitcnt lgkmcnt(" #n ")" ::: "memory")
#define PG8_BAR __builtin_amdgcn_s_barrier()
#define PG8_SCHED __builtin_amdgcn_sched_barrier(0)
    Unit cur, nxt; int ui = 0;
    if (!S.next(0, cur)) return;
    f32x4 acc[2][2][4][2];
#pragma unroll
    for (int a = 0; a < 2; ++a)
#pragma unroll
        for (int b = 0; b < 2; ++b)
#pragma unroll
            for (int m = 0; m < 4; ++m)
#pragma unroll
                for (int n = 0; n < 2; ++n) acc[a][b][m][n] = (f32x4){0.f, 0.f, 0.f, 0.f};
    bf16x8 At[4][2], B0[2][2], B1[2][2];
    const char* cA = (const char*)g.A + (size_t)cur.pm * tstep; const char* cB = (const char*)g.Bt + (size_t)cur.pn * tstep;
    if constexpr (Sched::GATHER) S.a_offs(cur, RR[0], RR[1], CC[0], CC[1], K, aoC);
    S.a_ready(cur);
    if constexpr (SP2) {
        PG8_STAGE(PG8_SB(0, 0), cB, voffB); PG8_STAGE(PG8_SB(0, 1), cB + hstep, voffB); PG8_STAGE_A(PG8_SA(0, 0), 0, cA, 0); PG8_STAGE_A(PG8_SA(0, 1), 1, cA, 0);
        if (wr == 1) PG8_BAR;
        PG8_WAIT_V(2); PG8_BAR;
        PG8_STAGE(PG8_SB(1, 0), cB + kstep, voffB); PG8_STAGE_A(PG8_SA(1, 0), 0, cA + kstep, kstep); PG8_STAGE(PG8_SB(1, 1), cB + hstep + kstep, voffB);
        PG8_WAIT_V(6); PG8_BAR;
    } else {
        PG8_STAGE(PG8_SB(0, 0), cB, voffB); PG8_STAGE_A(PG8_SA(0, 0), 0, cA, 0); PG8_STAGE(PG8_SB(0, 1), cB + hstep, voffB); PG8_STAGE_A(PG8_SA(0, 1), 1, cA, 0);
        if (wr == 1) PG8_BAR;
        PG8_WAIT_V(4); PG8_BAR;
        PG8_STAGE(PG8_SB(1, 0), cB + kstep, voffB); PG8_STAGE_A(PG8_SA(1, 0), 0, cA + kstep, kstep); PG8_STAGE(PG8_SB(1, 1), cB + hstep + kstep, voffB);
        PG8_WAIT_V(6); PG8_BAR;
    }
    for (;;) {
        const bool has_next = S.next(ui + 1, nxt);
        const char* nA = has_next ? (const char*)g.A + (size_t)nxt.pm * tstep : cA; const char* nB = has_next ? (const char*)g.Bt + (size_t)nxt.pn * tstep : cB;
        if constexpr (Sched::GATHER) {
            if (has_next) S.a_offs(nxt, RR[0], RR[1], CC[0], CC[1], K, aoN);
            else {
#pragma unroll
                for (int h = 0; h < 2; ++h)
#pragma unroll
                    for (int i = 0; i < 2; ++i) aoN[h][i] = aoC[h][i]; }
        }
        for (int t = 0; t < nt; t += 2) {
            const bool last = (t == nt - 2);
            const char* a1 = cA + (size_t)(t + 1) * kstep;
            const char* a2 = last ? nA : cA + (size_t)(t + 2) * kstep; const char* b2 = last ? nB : cB + (size_t)(t + 2) * kstep;
            const char* a3 = a2 + kstep; const char* b3 = b2 + kstep;
            const size_t k1 = (size_t)(t + 1) * kstep, k2 = last ? (size_t)0 : (size_t)(t + 2) * kstep, k3 = k2 + kstep;
            if (last && has_next) S.a_ready(nxt);
            if constexpr (SP2) {
            PG8_LDB(B0, 0, 0); PG8_LDB(B1, 0, 1); PG8_SCHED; PG8_LDA(At, 0, 0); PG8_STAGE_A(PG8_SA(1, 1), 1, a1, k1);
            if constexpr (Sched::GATHER) { if (last) {
#pragma unroll
                for (int h = 0; h < 2; ++h)
#pragma unroll
                    for (int i = 0; i < 2; ++i) aoC[h][i] = aoN[h][i]; } }
            PG8_WAIT_V(8); PG8_WAIT_L(0); PG8_BAR; PG8_MMA(0, 0, At, B0); PG8_MMA(0, 1, At, B1); PG8_BAR; PG8_SCHED;
            PG8_LDA(At, 0, 1); PG8_STAGE(PG8_SB(0, 0), b2, voffB); PG8_STAGE(PG8_SB(0, 1), b2 + hstep, voffB); PG8_STAGE_A(PG8_SA(0, 0), 0, a2, k2);
            PG8_WAIT_V(8); PG8_WAIT_L(0); PG8_BAR; PG8_MMA(1, 0, At, B0); PG8_MMA(1, 1, At, B1); PG8_BAR; PG8_SCHED;
            PG8_LDB(B0, 1, 0); PG8_LDB(B1, 1, 1); PG8_SCHED; PG8_LDA(At, 1, 0); PG8_STAGE_A(PG8_SA(0, 1), 1, a2, k2);
            PG8_WAIT_V(8); PG8_WAIT_L(0); PG8_BAR; PG8_MMA(0, 0, At, B0); PG8_MMA(0, 1, At, B1); PG8_BAR; PG8_SCHED;
            PG8_LDA(At, 1, 1); PG8_STAGE(PG8_SB(1, 0), b3, voffB); PG8_STAGE(PG8_SB(1, 1), b3 + hstep, voffB); PG8_STAGE_A(PG8_SA(1, 0), 0, a3, k3);
            PG8_WAIT_V(8); PG8_WAIT_L(0); PG8_BAR; PG8_MMA(1, 0, At, B0); PG8_MMA(1, 1, At, B1); PG8_BAR; PG8_SCHED;
            } else {
            PG8_LDB(B0, 0, 0); PG8_SCHED; PG8_LDA(At, 0, 0); PG8_STAGE_A(PG8_SA(1, 1), 1, a1, k1);
            if constexpr (Sched::GATHER) { if (last) {
#pragma unroll
                for (int h = 0; h < 2; ++h)
#pragma unroll
                    for (int i = 0; i < 2; ++i) aoC[h][i] = aoN[h][i]; } }
            PG8_WAIT_L(8); PG8_BAR; PG8_WAIT_L(0); PG8_MMA(0, 0, At, B0); PG8_BAR; PG8_SCHED;
            PG8_LDB(B1, 0, 1); PG8_STAGE(PG8_SB(0, 0), b2, voffB);
            PG8_BAR; PG8_WAIT_L(0); PG8_MMA(0, 1, At, B1); PG8_BAR;
            PG8_LDA(At, 0, 1); PG8_STAGE_A(PG8_SA(0, 0), 0, a2, k2);
            PG8_BAR; PG8_WAIT_L(0); PG8_MMA(1, 0, At, B0); PG8_BAR; PG8_SCHED;
            PG8_STAGE(PG8_SB(0, 1), b2 + hstep, voffB);
            PG8_WAIT_V(6); PG8_BAR; PG8_MMA(1, 1, At, B1); PG8_BAR;
            PG8_LDB(B0, 1, 0); PG8_SCHED; PG8_LDA(At, 1, 0); PG8_STAGE_A(PG8_SA(0, 1), 1, a2, k2);
            PG8_WAIT_L(8); PG8_BAR; PG8_WAIT_L(0); PG8_MMA(0, 0, At, B0); PG8_BAR; PG8_SCHED;
            PG8_LDB(B1, 1, 1); PG8_STAGE(PG8_SB(1, 0), b3, voffB);
            PG8_BAR; PG8_WAIT_L(0); PG8_MMA(0, 1, At, B1); PG8_BAR;
            PG8_LDA(At, 1, 1); PG8_STAGE_A(PG8_SA(1, 0), 0, a3, k3);
            PG8_BAR; PG8_WAIT_L(0); PG8_MMA(1, 0, At, B0); PG8_BAR; PG8_SCHED;
            PG8_STAGE(PG8_SB(1, 1), b3 + hstep, voffB);
            PG8_WAIT_V(6); PG8_BAR; PG8_MMA(1, 1, At, B1); PG8_BAR;
            }
        }
        if constexpr (ALIGN_EPI) { if (wr == 0) PG8_BAR; }
        E(acc, cur, wr, wc, fr, fq); S.done(cur);
        if (!has_next) break;
#pragma unroll
        for (int a = 0; a < 2; ++a)
#pragma unroll
            for (int b = 0; b < 2; ++b)
#pragma unroll
                for (int m = 0; m < 4; ++m)
#pragma unroll
                    for (int n = 0; n < 2; ++n) acc[a][b][m][n] = (f32x4){0.f, 0.f, 0.f, 0.f};
        cur = nxt; cA = nA; cB = nB; ++ui;
        if constexpr (ALIGN_EPI) { if (wr == 1) PG8_BAR; }
    }
    PG8_WAIT_V(0);
    if constexpr (!ALIGN_EPI) { if (wr == 0) PG8_BAR; }
    PG8_BAR;
#undef PG8_SA
#undef PG8_SB
#undef PG8_STAGE
#undef PG8_STAGE_A
#undef PG8_LDA
#undef PG8_LDB
#undef PG8_MMA
#undef PG8_WAIT_V
#undef PG8_WAIT_L
#undef PG8_BAR
#undef PG8_SCHED
}
}

#ifndef MK_N_LAUNCHES
#define MK_N_LAUNCHES 1
#endif
constexpr int NWAVES = 8, NTHR = 512;
constexpr int S_ = 16384, D_ = 2048, DEPTH = 2, HD = 128;
constexpr int IN_W = 5656, NIN = 5888;
constexpr int NC = 1023;
constexpr int NEXP = 32, DEXP = 512, ECAP = 16384, NSLOT = 40960;
constexpr float RMS_EPS = 1e-6f;
constexpr float ATT_SCALE = 0.08838834764831845f;
constexpr int NPL = 13, NPH = 2 + 2 * NPL;

constexpr size_t MiB = 1u << 20;
constexpr size_t WS_CTL = 0, CTL_ZERO_BYTES = 1 * MiB;
constexpr size_t WS_ROPE = 1 * MiB, WS_WINT = 9 * MiB, WS_WOUTT = 55 * MiB, WS_WGUT = 71 * MiB, WS_WDT = 327 * MiB, WS_WC1T = 455 * MiB;
constexpr size_t WS_H = 463 * MiB, WS_QN = 527 * MiB, WS_QM = 559 * MiB, WS_KM = 591 * MiB, WS_VM = 623 * MiB;
constexpr size_t WS_KC = 655 * MiB, WS_VC = 663 * MiB, WS_KS = 671 * MiB, WS_VS = 679 * MiB, WS_KW = 687 * MiB, WS_VW = 695 * MiB;
constexpr size_t WS_GATES = 703 * MiB, WS_UL = 705 * MiB, WS_KCMP = 713 * MiB, WS_VCMP = 713 * MiB + 512 * 1024, WS_KMEAN = 714 * MiB;
constexpr size_t WS_OMIX = 715 * MiB, WS_OCMP = 779 * MiB, WS_OWIN = 811 * MiB, WS_SEL = 843 * MiB, WS_TE = 845 * MiB, WS_TOKIDX = 846 * MiB, WS_WTS = 848 * MiB;
constexpr size_t WS_HACT = 850 * MiB, WS_Y = 890 * MiB;
constexpr size_t WS_WRT = 714 * MiB + 256 * 1024;
constexpr size_t WS_IMP = WS_H + 32 * MiB;
constexpr size_t WS_NLIST = WS_H, WS_PSLC = 850 * MiB, WS_LSEN = 1106 * MiB;
constexpr size_t WS_MLIST = 1050 * MiB, WS_PSEL = 1082 * MiB, WS_POWN = 1178 * MiB, WS_LSES = 1210 * MiB, WS_LSEO = 1211 * MiB + 512 * 1024, WS_END = 1212 * MiB;
constexpr int CW_TMO = 0, CW_BAR = 4096, CW_CNT = 8192, CW_MOD = 16384, CW_B1E = 40960, CW_MCNT = 65536, CW_NCNT = 131072, CSTR = 64;

constexpr int RING_BYTES = 131072, LDSCTL_OFF = RING_BYTES, MISC_OFF = LDSCTL_OFF + 320, MOETAB_OFF = LDSCTL_OFF + 512, LDS_BYTES = 147456;

#define GAS __attribute__((address_space(1)))
#define LAS __attribute__((address_space(3)))
typedef unsigned short bf16;
typedef unsigned v4u __attribute__((ext_vector_type(4)));
typedef float f32x4 __attribute__((ext_vector_type(4)));
typedef float f32x2 __attribute__((ext_vector_type(2)));
typedef GAS unsigned gu32;
#define RLX_AGENT __ATOMIC_RELAXED, __HIP_MEMORY_SCOPE_AGENT
#define LDS_WAIT() asm volatile("s_waitcnt lgkmcnt(0)" ::: "memory")
__device__ __forceinline__ unsigned f2bf(float f) { unsigned u = __builtin_bit_cast(unsigned, f); return (u + 0x7fffu + ((u >> 16) & 1u)) >> 16; }
__device__ __forceinline__ unsigned pk2(float lo, float hi) { return f2bf(lo) | (f2bf(hi) << 16); }
__device__ __forceinline__ float bf2f(unsigned b) { return __builtin_bit_cast(float, b << 16); }
__device__ __forceinline__ float bflo(unsigned w) { return __builtin_bit_cast(float, w << 16); }
__device__ __forceinline__ float bfhi(unsigned w) { return __builtin_bit_cast(float, w & 0xffff0000u); }

#define XB_TMO      128
#define XB_XCNT(j)  (256  + 64 * (j))
#define XB_XSUB(j)  (1280 + 64 * (j))
#define XB_XGEN(j)  (2304 + 64 * (j))
#define XB_TOP      3328
#define XB_TOPGEN   3392
#define XCD_BAR_WORDS 3456
#define XB_SPIN_CAP (1u << 20)
__device__ __forceinline__ unsigned xb_ld(unsigned* p)              { return __hip_atomic_load(p, __ATOMIC_RELAXED, __HIP_MEMORY_SCOPE_AGENT); }
__device__ __forceinline__ unsigned xb_add(unsigned* p, unsigned v) { return __hip_atomic_fetch_add(p, v, __ATOMIC_RELAXED, __HIP_MEMORY_SCOPE_AGENT); }
__device__ __forceinline__ unsigned xb_xcc_id() { return (unsigned)__builtin_amdgcn_s_getreg((3 << 11) | 20) & 0xFu; }
#define XB_SPIN(cond, bar) do { unsigned _sp = 0; while (cond) { __builtin_amdgcn_s_sleep(1); \
    if ((++_sp & 255u) == 0u) { if (xb_ld(&(bar)[XB_TMO])) break; if (_sp > XB_SPIN_CAP) { atomicAdd(&(bar)[XB_TMO], 1u); break; } } } } while (0)
struct XcdBarrier { unsigned* bar; unsigned x; volatile LAS unsigned* st; };
__device__ __forceinline__ XcdBarrier xcd_barrier_post(unsigned* bar, volatile LAS unsigned* st) {
    XcdBarrier b; b.bar = bar; b.x = xb_xcc_id(); b.st = st;
    if (threadIdx.x == 0) (void)xb_add(&bar[XB_XCNT(b.x)], 1u);
    return b;
}
__device__ __forceinline__ void xcd_barrier_complete(unsigned* bar, unsigned x, unsigned& nloc, unsigned& nx) {
    const unsigned G = gridDim.x * gridDim.y * gridDim.z;
    unsigned sum, cnt, mine, sp = 0u;
    for (;;) {
        sum = 0u; cnt = 0u; mine = 0u;
#pragma unroll
        for (unsigned j = 0; j < 16; ++j) { const unsigned c = xb_ld(&bar[XB_XCNT(j)]); sum += c; cnt += (c > 0u) ? 1u : 0u; mine = (j == x) ? c : mine; }
        if (sum == G) break;
        __builtin_amdgcn_s_sleep(1);
        if ((++sp & 255u) == 0u) { if (xb_ld(&bar[XB_TMO])) break; if (sp > XB_SPIN_CAP) { atomicAdd(&bar[XB_TMO], 1u); break; } }
    }
    nloc = mine > 0u ? mine : 1u; nx = cnt > 0u ? cnt : 1u;
}
__device__ __forceinline__ void xcd_barrier(const XcdBarrier& b, bool leader  ) {
    asm volatile("s_waitcnt vmcnt(0)" ::: "memory");
    __syncthreads();
    if (leader) {
        unsigned* bar = b.bar;
        __builtin_amdgcn_s_waitcnt(0);
        unsigned nloc = b.st[0], nx = b.st[1];
        if (nloc == 0u) { xcd_barrier_complete(bar, b.x, nloc, nx); b.st[0] = nloc; b.st[1] = nx; }
        const unsigned old = xb_add(&bar[XB_XSUB(b.x)], 1u);
        const unsigned gen = old / nloc;
        if (old + 1u == (gen + 1u) * nloc) {
            __builtin_amdgcn_fence(__ATOMIC_RELEASE, "agent");
            asm volatile("s_waitcnt vmcnt(0)" ::: "memory");
            const unsigned og = xb_add(&bar[XB_TOP], 1u);
            const unsigned tg = og / nx;
            if (og + 1u == (tg + 1u) * nx) xb_add(&bar[XB_TOPGEN], 1u);
            else XB_SPIN(xb_ld(&bar[XB_TOPGEN]) == tg, bar);
            __builtin_amdgcn_fence(__ATOMIC_ACQUIRE, "agent");
            xb_add(&bar[XB_XGEN(b.x)], 1u);
            asm volatile("s_waitcnt vmcnt(0)" ::: "memory");
        } else {
            XB_SPIN(xb_ld(&bar[XB_XGEN(b.x)]) == gen, bar);
            __builtin_amdgcn_fence(__ATOMIC_ACQUIRE, "agent");
            asm volatile("s_waitcnt vmcnt(0)" ::: "memory");
        }
    }
    __syncthreads();
}

__device__ __forceinline__ float lane_get(float v, int src) { return __builtin_bit_cast(float, __builtin_amdgcn_ds_bpermute(src << 2, __builtin_bit_cast(int, v))); }
__device__ __forceinline__ int lane_geti(int v, int src) { return __builtin_amdgcn_ds_bpermute(src << 2, v); }
__device__ __forceinline__ float wave_sum(float v, int lane) {
#pragma unroll
    for (int o = 1; o < 64; o <<= 1) v += lane_get(v, lane ^ o);
    return v;
}
__device__ __forceinline__ int block_excl_scan(int v, LAS int* scr, int tid, int* tot) {
    const int lane = tid & 63, wv = tid >> 6; int s = v;
#pragma unroll
    for (int o = 1; o < 64; o <<= 1) { const int n = lane_geti(s, lane - o); if (lane >= o) s += n; }
    if (lane == 63) scr[wv] = s;
    __syncthreads();
    int off = 0, all = 0;
#pragma unroll
    for (int w = 0; w < 8; ++w) { const int x = scr[w]; all += x; off += (w < wv) ? x : 0; }
    *tot = all;
    __syncthreads();
    return off + s - v;
}

__device__ __forceinline__ float row_max16(float v) {
    v = fmaxf(v, __builtin_bit_cast(float, __builtin_amdgcn_update_dpp(0, __builtin_bit_cast(int, v), 0xB1, 0xF, 0xF, false)));
    v = fmaxf(v, __builtin_bit_cast(float, __builtin_amdgcn_update_dpp(0, __builtin_bit_cast(int, v), 0x4E, 0xF, 0xF, false)));
    v = fmaxf(v, __builtin_bit_cast(float, __builtin_amdgcn_update_dpp(0, __builtin_bit_cast(int, v), 0x124, 0xF, 0xF, false)));
    v = fmaxf(v, __builtin_bit_cast(float, __builtin_amdgcn_update_dpp(0, __builtin_bit_cast(int, v), 0x128, 0xF, 0xF, false)));
    return v;
}
__device__ __forceinline__ int row_min16(int v) {
    v = min(v, __builtin_amdgcn_update_dpp(0, v, 0xB1, 0xF, 0xF, false));
    v = min(v, __builtin_amdgcn_update_dpp(0, v, 0x4E, 0xF, 0xF, false));
    v = min(v, __builtin_amdgcn_update_dpp(0, v, 0x124, 0xF, 0xF, false));
    v = min(v, __builtin_amdgcn_update_dpp(0, v, 0x128, 0xF, 0xF, false));
    return v;
}
template <int NV>
__device__ __forceinline__ int row_pick(float (&v)[NV], int lam) {
    float m = v[0];
#pragma unroll
    for (int i = 1; i < NV; ++i) m = fmaxf(m, v[i]);
    m = row_max16(m);
    int idx = 1 << 20;
#pragma unroll
    for (int i = NV - 1; i >= 0; --i) idx = (v[i] == m) ? lam + 16 * i : idx;
    idx = row_min16(idx);
    if (m == -INFINITY) idx = -1;
#pragma unroll
    for (int i = 0; i < NV; ++i) v[i] = (lam + 16 * i == idx) ? -INFINITY : v[i];
    return idx;
}

__device__ __forceinline__ int il(int d) { return (d < 64) ? 2 * d : 2 * (d - 64) + 1; }
__device__ __forceinline__ int inproj_row(int s) {
    if (s < 1024) return (s & ~127) + il(s & 127);
    if (s < 1536) return s;
    if (s < 1792) return (s & ~127) + il(s & 127);
    if (s < 2048) return s;
    if (s < 2304) return (s & ~127) + il(s & 127);
    if (s < 2560) return s;
    if (s < 2584) return 5632 + (s - 2560);
    if (s < 3608) { const int r = s - 2584; return 2560 + (r & ~127) + il(r & 127); }
    if (s < 4632) { const int r = s - 3608; return 3584 + (r & ~127) + il(r & 127); }
    return 4608 + (s - 4632);
}
template <int MODE>
__device__ __forceinline__ void transpose_item(const float* W, int K, int N, bf16* WT, int dpitch, int row_off, LAS float* scr, int item, int lane) {
    const int nblk = (N + 31) / 32, kb = item / nblk, nb = item % nblk, k0 = 64 * kb, n0 = 32 * nb;
    const int nsrc = n0 + (lane & 31);
#pragma unroll 8
    for (int i = 0; i < 32; ++i) { const int kk = 2 * i + (lane >> 5); scr[kk * 33 + (lane & 31)] = (nsrc < N) ? W[(size_t)(k0 + kk) * N + nsrc] : 0.f; }
    LDS_WAIT(); asm volatile("" ::: "memory");
    const int c = lane & 7;
#pragma unroll
    for (int j = 0; j < 4; ++j) { const int nl = (lane >> 3) + 8 * j, n = n0 + nl; const LAS float* s = scr + (8 * c) * 33 + nl;
        v4u o; o.x = pk2(s[0 * 33], s[1 * 33]); o.y = pk2(s[2 * 33], s[3 * 33]); o.z = pk2(s[4 * 33], s[5 * 33]); o.w = pk2(s[6 * 33], s[7 * 33]);
        if (n < N) { int dr;
            if (MODE == 0) dr = n; else if (MODE == 1) dr = inproj_row(n); else if (MODE == 2) dr = (n >> 7) * 256 + (n & 127); else dr = (n >> 7) * 256 + 128 + (n & 127);
            *(GAS v4u*)(WT + (size_t)(row_off + dr) * dpitch + k0 + 8 * c) = o; } }
    LDS_WAIT(); asm volatile("" ::: "memory");
}

using pg8::Unit;
struct EpiInProj {
    static constexpr bool PERM = true;
    bf16 *QN, *KC, *VC, *KS, *VS, *KW, *VW, *QM, *KM, *VM; float* GATES; const float* rope;
    __device__ __forceinline__ void operator()(const f32x4 (&acc)[2][2][4][2], const Unit& u, int wr, int wc, int fr, int fq) const {
        const int pn = u.pn, row0 = u.pm * 256 + wr * 64 + fr, c8 = wc * 32 + 8 * fq;
        if (pn == 22) {
            if (c8 < 24) {
#pragma unroll
                for (int ai = 0; ai < 2; ++ai)
#pragma unroll
                    for (int m = 0; m < 4; ++m) { const int row = row0 + ai * 128 + m * 16; float* gp = GATES + (size_t)row * 32 + c8;
                        f32x4 a = acc[ai][0][m][0], b = acc[ai][0][m][1], ga, gb;
#pragma unroll
                        for (int j = 0; j < 4; ++j) { ga[j] = 1.f / (1.f + __expf(-a[j])); gb[j] = 1.f / (1.f + __expf(-b[j])); }
                        *(f32x4*)gp = ga; *(f32x4*)(gp + 4) = gb; }
            }
            return;
        }
        bf16* base; int pitch; size_t bjs; bool rot;
        if (pn < 4)       { base = QN + pn * 256;        pitch = 1024; bjs = 128; rot = true; }
        else if (pn == 4) { base = KC;                   pitch = 128;  bjs = (size_t)S_ * 128; rot = false; }
        else if (pn == 5) { base = VC;                   pitch = 128;  bjs = (size_t)S_ * 128; rot = false; }
        else if (pn == 6) { base = KS;                   pitch = 256;  bjs = 128; rot = true; }
        else if (pn == 7) { base = VS;                   pitch = 256;  bjs = 128; rot = false; }
        else if (pn == 8) { base = KW;                   pitch = 256;  bjs = 128; rot = true; }
        else if (pn == 9) { base = VW;                   pitch = 256;  bjs = 128; rot = false; }
        else if (pn < 14) { base = QM + (pn - 10) * 256; pitch = 1024; bjs = 128; rot = true; }
        else if (pn < 18) { base = KM + (pn - 14) * 256; pitch = 1024; bjs = 128; rot = true; }
        else              { base = VM + (pn - 18) * 256; pitch = 1024; bjs = 128; rot = false; }
#pragma unroll
        for (int ai = 0; ai < 2; ++ai)
#pragma unroll
            for (int m = 0; m < 4; ++m) { const int row = row0 + ai * 128 + m * 16;
                f32x4 t0 = (f32x4){1.f, 0.f, 1.f, 0.f}, t1 = t0;
                if (rot) { const f32x4* tp = (const f32x4*)(rope + (size_t)row * 128 + (c8 >> 1) * 2); t0 = tp[0]; t1 = tp[1]; }
#pragma unroll
                for (int bj = 0; bj < 2; ++bj) { f32x4 v0 = acc[ai][bj][m][0], v1 = acc[ai][bj][m][1];
                    if (rot) { f32x4 w0, w1;
                        w0[0] = v0[0] * t0[0] - v0[1] * t0[1]; w0[1] = v0[1] * t0[0] + v0[0] * t0[1]; w0[2] = v0[2] * t0[2] - v0[3] * t0[3]; w0[3] = v0[3] * t0[2] + v0[2] * t0[3];
                        w1[0] = v1[0] * t1[0] - v1[1] * t1[1]; w1[1] = v1[1] * t1[0] + v1[0] * t1[1]; w1[2] = v1[2] * t1[2] - v1[3] * t1[3]; w1[3] = v1[3] * t1[2] + v1[2] * t1[3];
                        v0 = w0; v1 = w1; }
                    pg8::u32x4 w; w.x = pg8::cvt_pk_bf16(v0[0], v0[1]); w.y = pg8::cvt_pk_bf16(v0[2], v0[3]); w.z = pg8::cvt_pk_bf16(v1[0], v1[1]); w.w = pg8::cvt_pk_bf16(v1[2], v1[3]);
                    *(pg8::u32x4*)(base + (size_t)row * pitch + bj * bjs + c8) = w; } }
    }
};
struct EpiOutProj {
    static constexpr bool PERM = false;
    const float* xsrc; float* X; const float* gt;
    __device__ __forceinline__ void operator()(const f32x4 (&acc)[2][2][4][2], const Unit& u, int wr, int wc, int fr, int fq) const {
        const int row0 = u.pm * 256 + wr * 64 + fr, col0 = u.pnl * 256 + wc * 32 + 4 * fq;
        f32x4 gv[2][2];
#pragma unroll
        for (int bj = 0; bj < 2; ++bj)
#pragma unroll
            for (int n = 0; n < 2; ++n) gv[bj][n] = *(const f32x4*)(gt + col0 + bj * 128 + n * 16);
#pragma unroll
        for (int ai = 0; ai < 2; ++ai)
#pragma unroll
            for (int m = 0; m < 4; ++m) { const size_t ro = (size_t)(row0 + ai * 128 + m * 16) * D_ + col0;
#pragma unroll
                for (int bj = 0; bj < 2; ++bj)
#pragma unroll
                    for (int n = 0; n < 2; ++n) { const f32x4 xv = *(const f32x4*)(xsrc + ro + bj * 128 + n * 16); *(f32x4*)(X + ro + bj * 128 + n * 16) = xv + gv[bj][n] * acc[ai][bj][m][n]; } }
    }
};
struct EpiF32 {
    static constexpr bool PERM = false;
    float* C; int ldc;
    __device__ __forceinline__ void operator()(const f32x4 (&acc)[2][2][4][2], const Unit& u, int wr, int wc, int fr, int fq) const {
        const int row0 = u.pm * 256 + wr * 64 + fr, col0 = u.pnl * 256 + wc * 32 + 4 * fq;
#pragma unroll
        for (int ai = 0; ai < 2; ++ai)
#pragma unroll
            for (int m = 0; m < 4; ++m) { float* rowp = C + (size_t)(row0 + ai * 128 + m * 16) * ldc + col0;
#pragma unroll
                for (int bj = 0; bj < 2; ++bj)
#pragma unroll
                    for (int n = 0; n < 2; ++n) *(f32x4*)(rowp + bj * 128 + n * 16) = acc[ai][bj][m][n]; }
    }
};
struct EpiGateUp {
    static constexpr bool PERM = true;
    bf16* HACT;
    __device__ __forceinline__ void operator()(const f32x4 (&acc)[2][2][4][2], const Unit& u, int wr, int wc, int fr, int fq) const {
        const int row0 = u.pm * 256 + wr * 64 + fr, col0 = u.pnl * 128 + wc * 32 + 8 * fq;
#pragma unroll
        for (int ai = 0; ai < 2; ++ai)
#pragma unroll
            for (int m = 0; m < 4; ++m) { const int row = row0 + ai * 128 + m * 16; f32x4 h[2];
#pragma unroll
                for (int n = 0; n < 2; ++n)
#pragma unroll
                    for (int j = 0; j < 4; ++j) { const float gg = acc[ai][0][m][n][j], uu = acc[ai][1][m][n][j]; h[n][j] = gg / (1.f + __expf(-gg)) * uu; }
                pg8::u32x4 w; w.x = pg8::cvt_pk_bf16(h[0][0], h[0][1]); w.y = pg8::cvt_pk_bf16(h[0][2], h[0][3]); w.z = pg8::cvt_pk_bf16(h[1][0], h[1][1]); w.w = pg8::cvt_pk_bf16(h[1][2], h[1][3]);
                *(pg8::u32x4*)(HACT + (size_t)row * DEXP + col0) = w; }
    }
};
struct EpiDown {
    static constexpr bool PERM = true;
    bf16* Y; const float* WTS; const LAS int* tab;
    __device__ __forceinline__ void operator()(const f32x4 (&acc)[2][2][4][2], const Unit& u, int wr, int wc, int fr, int fq) const {
        const int rl0 = wr * 64 + fr, col0 = u.pnl * 256 + wc * 32 + 8 * fq, cnt = tab[u.e];
#pragma unroll
        for (int ai = 0; ai < 2; ++ai)
#pragma unroll
            for (int m = 0; m < 4; ++m) { const int rl = rl0 + ai * 128 + m * 16, pos = u.mt * 256 + rl;
                const float w = (pos < cnt) ? WTS[(size_t)u.e * ECAP + pos] : 0.f;
                bf16* rowp = Y + (size_t)(u.pm * 256 + rl) * D_ + col0;
#pragma unroll
                for (int bj = 0; bj < 2; ++bj) { const f32x4 v0 = acc[ai][bj][m][0] * w, v1 = acc[ai][bj][m][1] * w;
                    pg8::u32x4 o; o.x = pg8::cvt_pk_bf16(v0[0], v0[1]); o.y = pg8::cvt_pk_bf16(v0[2], v0[3]); o.z = pg8::cvt_pk_bf16(v1[0], v1[1]); o.w = pg8::cvt_pk_bf16(v1[2], v1[3]);
                    *(pg8::u32x4*)(rowp + bj * 128) = o; } }
    }
};

struct CompressOrder {
    static constexpr bool GATHER = false;
    int G, c;
    __device__ bool next(int i, Unit& u) const { const int L = i * G + c; if (L >= 32) return false; u.pm = L >> 1; u.pnl = L & 1; u.pn = (u.pm >= 8 ? 2 : 0) + u.pnl; u.e = 0; u.mt = 0; return true; }
    __device__ __forceinline__ void a_offs(const Unit&, int, int, int, int, int, unsigned (&)[2][2]) const {}
    __device__ __forceinline__ void a_ready(const Unit&) const {}
    __device__ __forceinline__ void done(const Unit&) const {}
};
template <bool GATHER_>
struct MoeOrder {
    static constexpr bool GATHER = GATHER_;
    const LAS int* tab; int NT, G, c, bt_per_e, bt_base; const int* tokidx;
    __device__ bool next(int i, Unit& u) const {
        const int L = i * G + c; if (L >= tab[64]) return false;
        int e = 0;
        for (int k = 1; k < NEXP; ++k) e += (L >= tab[32 + k]) ? 1 : 0;
        e = __builtin_amdgcn_readfirstlane(e);
        const int r = L - tab[32 + e];
        u.e = e; u.mt = r / NT; u.pnl = r % NT; u.pn = bt_base + e * bt_per_e + u.pnl; u.pm = (tab[65 + e] >> 8) + u.mt; return true;
    }
    __device__ __forceinline__ void a_offs(const Unit& u, int R0, int R1, int C0, int C1, int K, unsigned (&o)[2][2]) const {
        const int cnt = tab[u.e]; const int* tk = tokidx + (size_t)u.e * ECAP;
#pragma unroll
        for (int h = 0; h < 2; ++h) {
            int p0 = u.mt * 256 + h * 128 + R0, p1 = u.mt * 256 + h * 128 + R1; p0 = p0 < cnt ? p0 : cnt - 1; p1 = p1 < cnt ? p1 : cnt - 1;
            o[h][0] = ((unsigned)tk[p0] * (unsigned)K + (unsigned)C0) * 2u; o[h][1] = ((unsigned)tk[p1] * (unsigned)K + (unsigned)C1) * 2u; }
    }
    __device__ __forceinline__ void a_ready(const Unit&) const {}
    __device__ __forceinline__ void done(const Unit&) const {}
};

namespace att {
constexpr int D = 128, NW = 8, QBLK = 32, KVBLK = 64, QB = NW * QBLK;
constexpr int SHM_V = KVBLK * D * 2, SHM_K = KVBLK * D * 2;
constexpr int OFF_WS = 2 * SHM_V + 2 * SHM_K, OFF_OT = OFF_WS + NW * 64 * 4, LDS_BYTES = OFF_OT + NW * 32 * 4;
constexpr int OFF_ST = 73728, ST_ROW = 272, ST_WAVE = 16 * ST_ROW;
constexpr float SCALE = 0.08838834764831845f, THR = 8.f;
typedef short bf16x8 __attribute__((ext_vector_type(8)));
typedef short s16x4 __attribute__((ext_vector_type(4)));
typedef float f32x16 __attribute__((ext_vector_type(16)));
typedef float f32x4 __attribute__((ext_vector_type(4)));
typedef unsigned u32x4 __attribute__((ext_vector_type(4)));
typedef unsigned short bf16;
#define KSWZ(row, colB) ((row) * 256 + ((colB) ^ (((row) & 7) << 4)))
#define SBAR() __builtin_amdgcn_sched_barrier(0)
__device__ __forceinline__ int v_st(int k, int c) { const int kk = (k & ~0xC) | ((k & 4) << 1) | ((k & 8) >> 1); return ((kk >> 3) * 4 + (c >> 5)) * 512 + ((kk & 7) * 32 + (c & 31)) * 2; }
__device__ __forceinline__ int v_rd_base(int lane) { return ((lane & 3) << 3) | (((lane >> 2) & 3) << 6) | (((lane >> 4) & 1) << 5) | (((lane >> 5) & 1) << 8); }
constexpr int v_rd_off(int d0, int ks, int half) { return d0 * 512 + ks * 4096 + half * 2048; }
__device__ __forceinline__ int crow(int r, int hi) { return (r & 3) + 8 * (r >> 2) + 4 * hi; }
__device__ __forceinline__ unsigned cvtpk(float lo, float hi) { unsigned r; asm volatile("v_cvt_pk_bf16_f32 %0, %1, %2" : "=v"(r) : "v"(lo), "v"(hi)); return r; }
__device__ __forceinline__ bf16x8 load8(const bf16* p) { return *reinterpret_cast<const bf16x8*>(p); }
__device__ __forceinline__ void mask_tile(f32x16& p0, f32x16& p1, int dq, unsigned W) {
    const float NEG = -__builtin_inff();
#pragma unroll
    for (int r = 0; r < 16; ++r) {
        const int c = (r & 3) + 8 * (r >> 2);
        if ((unsigned)(dq - c) >= W) p0[r] = NEG;
        if ((unsigned)(dq - c - 32) >= W) p1[r] = NEG;
    }
}
__device__ __forceinline__ void partialSM(f32x16& p0, f32x16& p1, float& m_reg, float& mn, float& alpha) {
    float pmax = p0[0]; for (int r = 1; r < 16; ++r) pmax = fmaxf(pmax, p0[r]); for (int r = 0; r < 16; ++r) pmax = fmaxf(pmax, p1[r]);
    { auto rr = __builtin_amdgcn_permlane32_swap(__float_as_uint(pmax), __float_as_uint(pmax), false, false);
      pmax = fmaxf(__uint_as_float(rr[0]), __uint_as_float(rr[1])); }
    constexpr float C2 = 1.4426950408889634f * SCALE;
    if (__builtin_expect(__all((pmax - m_reg) * SCALE <= THR), 1)) { mn = m_reg; alpha = 1.f; }
    else { mn = fmaxf(m_reg, pmax); alpha = __builtin_amdgcn_exp2f((m_reg - mn) * C2); m_reg = mn; }
    const float mnL = -mn * C2;
    for (int r = 0; r < 16; ++r) p0[r] = fmaf(p0[r], C2, mnL); for (int r = 0; r < 16; ++r) p1[r] = fmaf(p1[r], C2, mnL);
    for (int r = 0; r < 16; ++r) p0[r] = __builtin_amdgcn_exp2f(p0[r]);
}
__device__ __forceinline__ void finishSM(f32x16& p0, f32x16& p1, float alpha, float& l_reg, bf16x8& pa0, bf16x8& pa1, bf16x8& pa2, bf16x8& pa3) {
    for (int r = 0; r < 16; ++r) p1[r] = __builtin_amdgcn_exp2f(p1[r]);
    float ps = 0; for (int r = 0; r < 16; ++r) ps += p0[r]; for (int r = 0; r < 16; ++r) ps += p1[r];
    { auto rr = __builtin_amdgcn_permlane32_swap(__float_as_uint(ps), __float_as_uint(ps), false, false);
      ps = __uint_as_float(rr[0]) + __uint_as_float(rr[1]); }
    l_reg = l_reg * alpha + ps;
#define PK4(P, B_, OUT) do { unsigned a0 = cvtpk(P[B_+0], P[B_+1]), a1 = cvtpk(P[B_+2], P[B_+3]);                          \
        unsigned b0 = cvtpk(P[B_+4], P[B_+5]), b1 = cvtpk(P[B_+6], P[B_+7]);                                             \
        auto r0 = __builtin_amdgcn_permlane32_swap(a0, b0, false, false); auto r1 = __builtin_amdgcn_permlane32_swap(a1, b1, false, false); \
        u32x4 w = {r0[0], r1[0], r0[1], r1[1]}; OUT = *reinterpret_cast<bf16x8*>(&w); } while (0)
    PK4(p0, 0, pa0); PK4(p0, 8, pa1); PK4(p1, 0, pa2); PK4(p1, 8, pa3);
#undef PK4
}
template <int KB, bool SK>
__device__ __forceinline__ void qkt(f32x16& p0, f32x16& p1, const char* K_lds, int r32, int hi, const bf16x8* qr, bool act) {
    if (SK && !act) { const float NEG = -__builtin_inff();
#pragma unroll
        for (int r = 0; r < 16; ++r) { p0[r] = NEG; p1[r] = NEG; } return; }
    p0 = f32x16{}; p1 = f32x16{};
    const char* kb[4];
#pragma unroll
    for (int dd = 0; dd < 4; ++dd) kb[dd] = K_lds + KB * SHM_K + KSWZ(r32, (dd * 16 + hi * 8) * 2);
#pragma unroll
    for (int d0 = 0; d0 < 8; ++d0) { const char* a = kb[d0 & 3] + (d0 >> 2) * 128;
        bf16x8 b0 = *reinterpret_cast<const bf16x8*>(a);
        bf16x8 b1 = *reinterpret_cast<const bf16x8*>(a + 32 * 256);
        p0 = __builtin_amdgcn_mfma_f32_32x32x16_bf16(b0, qr[d0], p0, 0, 0, 0);
        p1 = __builtin_amdgcn_mfma_f32_32x32x16_bf16(b1, qr[d0], p1, 0, 0, 0); }
}
template <int VB, bool SK>
__device__ __forceinline__ void pv_tile(f32x16* o, int vb0, bf16x8 pa0, bf16x8 pa1, bf16x8 pa2, bf16x8 pa3, bool act) {
    if (SK && !act) return;
#define TRRD(dst, off) asm volatile("ds_read_b64_tr_b16 %0, %1 offset:%2" : "=&v"(dst) : "v"(vb0), "i"(off) : "memory")
#define PV_D0(d0) do { s16x4 l0, l1, l2, l3, h0, h1, h2, h3; constexpr int b_ = VB * SHM_V + v_rd_off(d0, 0, 0); \
        TRRD(l0, b_); TRRD(h0, b_ + 2048); TRRD(l1, b_ + 4096); TRRD(h1, b_ + 6144); TRRD(l2, b_ + 8192); TRRD(h2, b_ + 10240); TRRD(l3, b_ + 12288); TRRD(h3, b_ + 14336); \
        asm volatile("s_waitcnt lgkmcnt(0)" ::: "memory"); SBAR();   \
        o[d0] = __builtin_amdgcn_mfma_f32_32x32x16_bf16(pa0, (bf16x8){l0[0], l0[1], l0[2], l0[3], h0[0], h0[1], h0[2], h0[3]}, o[d0], 0, 0, 0);   \
        o[d0] = __builtin_amdgcn_mfma_f32_32x32x16_bf16(pa1, (bf16x8){l1[0], l1[1], l1[2], l1[3], h1[0], h1[1], h1[2], h1[3]}, o[d0], 0, 0, 0);   \
        o[d0] = __builtin_amdgcn_mfma_f32_32x32x16_bf16(pa2, (bf16x8){l2[0], l2[1], l2[2], l2[3], h2[0], h2[1], h2[2], h2[3]}, o[d0], 0, 0, 0);   \
        o[d0] = __builtin_amdgcn_mfma_f32_32x32x16_bf16(pa3, (bf16x8){l3[0], l3[1], l3[2], l3[3], h3[0], h3[1], h3[2], h3[3]}, o[d0], 0, 0, 0); } while (0)
    PV_D0(0); PV_D0(1); PV_D0(2); PV_D0(3);
#undef PV_D0
#undef TRRD
}
struct Ref { const bf16* Q; const bf16* K; const bf16* V; bf16* O; const int* list; int kpitch, j_lo, j_hi, P0, W, a0, a1; };
struct Seam { bf16x8 qr[8]; bf16x8 st_v0, st_v1, st_k0, st_k1; };
#define ROW(p, kp, k0, rr) ((p) + (size_t)((k0) + (rr)) * (kp) + sc)
#define VMW() asm volatile("s_waitcnt vmcnt(0)" ::: "memory")
#define VMWN(n) asm volatile("s_waitcnt vmcnt(%0)" :: "i"(n) : "memory")
#define SLOAD_H(Kp, Vp, kp, k0) do { S.st_v0 = load8(ROW(Vp, kp, k0, sr)); S.st_v1 = load8(ROW(Vp, kp, k0, 32 + sr));              \
                         S.st_k0 = load8(ROW(Kp, kp, k0, sr)); S.st_k1 = load8(ROW(Kp, kp, k0, 32 + sr)); } while (0)
#define SWRITE_HK(bf) do { *(bf16x8*)(K_lds + (bf) * SHM_K + kws) = S.st_k0; *(bf16x8*)(K_lds + (bf) * SHM_K + kws + 32 * 256) = S.st_k1; } while (0)
#define SWRITE_HV(bf) do { *(bf16x8*)(V_lds + (bf) * SHM_V + vst0) = S.st_v0; *(bf16x8*)(V_lds + (bf) * SHM_V + vst1) = S.st_v1; } while (0)
#define SWRITE_H(bf) do { SWRITE_HV(bf); SWRITE_HK(bf); } while (0)
template <class RF>
__device__ __forceinline__ void prime(const Ref& cur, char* lds, Seam& S) {
    const int tid_ = wg_tid((const __attribute__((address_space(3))) int*)(uintptr_t)(unsigned)(uintptr_t)(lds + WIDTAB_OFF));
    const int tid = tid_, wid = __builtin_amdgcn_readfirstlane(tid >> 6), lane = tid & 63, r32 = lane & 31, hi = lane >> 5;
    const int sr = tid >> 4, sc = (tid & 15) * 8, kws = KSWZ(sr, sc * 2); char* K_lds = lds + 2 * SHM_V;
    const int kb0 = cur.j_lo * KVBLK;
    { const bf16* qrow = cur.Q + RF::q_off(cur, wid * QBLK + r32, RF::entry(cur, wid * QBLK + r32));
      for (int d0 = 0; d0 < 8; ++d0) S.qr[d0] = load8(qrow + d0 * 16 + hi * 8); }
    SLOAD_H(cur.K, cur.V, cur.kpitch, kb0); VMW(); SWRITE_HK(0);
    __syncthreads();
}
template <int MODE, bool WSKIP, class RF, bool O8 = false, bool ONE = false>
__device__ __forceinline__ void block(const Ref& cur, const Ref& nxt, float* LSE, char* lds, Seam& S, float* lse_lane = nullptr) {
    const int tid_ = wg_tid((const __attribute__((address_space(3))) int*)(uintptr_t)(unsigned)(uintptr_t)(lds + WIDTAB_OFF));
    const int tid = tid_, wid = __builtin_amdgcn_readfirstlane(tid >> 6), lane = tid & 63, r32 = lane & 31, hi = lane >> 5;
    const int j_lo = cur.j_lo, NT = cur.j_hi - cur.j_lo;
    const int kbn = nxt.j_lo * KVBLK;
    const int W = cur.W;
    const int qlo = cur.P0 + wid * QBLK;
    const int e_cur = RF::entry(cur, wid * QBLK + r32), e_nxt = RF::entry(nxt, wid * QBLK + r32);
    const int qm = (MODE == 2 ? RF::pos(cur, wid * QBLK + r32, e_cur) : qlo + r32) - 4 * hi;
    const unsigned Wm = (MODE == 2) ? (unsigned)RF::Wl(cur, wid * QBLK + r32) : (unsigned)W;
    char* V_lds = lds; char* K_lds = lds + 2 * SHM_V;
    float* ws = (float*)(lds + OFF_WS) + wid * 64; float* li_l = ws, * al_l = ws + 32; int* ot_l = (int*)(lds + OFF_OT) + wid * 32;
    float m_reg = -1e30f, l_reg = 0; f32x16 o[4] = {};
    const int sr = tid >> 4, sc = (tid & 15) * 8, vst0 = v_st(sr, sc), vst1 = v_st(32 + sr, sc), kws = KSWZ(sr, sc * 2);
    const int vb0 = (int)(uintptr_t)V_lds + v_rd_base(lane);
    const bf16* Kh = cur.K; const bf16* Vh = cur.V; const int kp = cur.kpitch;
#define RESC(a) do { if (__any((a) < 1.f)) { if (hi == 0) al_l[r32] = (a); asm volatile("s_waitcnt lgkmcnt(0)" ::: "memory");              \
                     for (int d_ = 0; d_ < 4; ++d_) for (int r = 0; r < 16; ++r) o[d_][r] *= al_l[crow(r, hi)]; } } while (0)
#define KBASE(t) ((j_lo + (t)) * KVBLK)
#define ACT(t) (MODE != 0 || (KBASE(t) <= qlo + QBLK - 1 && KBASE(t) + KVBLK - 1 >= qlo - W + 1))
#define MASKT(P0_, P1_, t) do { const int kb_ = KBASE(t); if (MODE == 2) mask_tile(P0_, P1_, qm - kb_, Wm); \
        else if (MODE == 0) { if ((!SK || ACT(t)) && (kb_ + KVBLK - 1 > qlo || kb_ <= qlo + QBLK - 1 - W)) mask_tile(P0_, P1_, qm - kb_, Wm); } } while (0)
    constexpr int NQL = 8;
    constexpr bool SK = WSKIP && MODE == 0;
#define SEAM_K0() do { VMWN(NQL); SWRITE_HK(0); SBAR(); } while (0)
    f32x16 pA0, pA1, pB0, pB1; float mnA, mnB, alA, alB; bf16x8 pa0, pa1, pa2, pa3;
    SWRITE_HV(0); SBAR();
    if constexpr (ONE) { SLOAD_H(nxt.K, nxt.V, nxt.kpitch, kbn); SBAR(); }
    if (NT > 1) { SLOAD_H(Kh, Vh, kp, KBASE(1)); }
    SBAR(); qkt<0, SK>(pA0, pA1, K_lds, r32, hi, S.qr, ACT(0));
    MASKT(pA0, pA1, 0); partialSM(pA0, pA1, m_reg, mnA, alA);
    if (NT > 1) { VMW(); SWRITE_H(1); }
    __syncthreads();
#define HALF_STEP(PX0, PX1, mnX, alX, PY0, PY1, alY, t, KB, VB, SB) do {                                                      \
        SBAR(); qkt<KB, SK>(PX0, PX1, K_lds, r32, hi, S.qr, ACT(t));                                             \
        finishSM(PY0, PY1, alY, l_reg, pa0, pa1, pa2, pa3); SBAR();                                                           \
        if ((t) + 1 < NT) { SLOAD_H(Kh, Vh, kp, KBASE((t) + 1)); SBAR(); }                                               \
        pv_tile<VB, SK>(o, vb0, pa0, pa1, pa2, pa3, ACT((t) - 1)); MASKT(PX0, PX1, (t)); partialSM(PX0, PX1, m_reg, mnX, alX);                                        \
        __syncthreads();                                                                                                      \
        if ((t) + 1 < NT) { VMW(); SWRITE_H(SB); }                                                                          \
        RESC(alX); __syncthreads(); } while (0)
    for (int t = 1; t + 1 < NT; t += 2) {
        HALF_STEP(pB0, pB1, mnB, alB, pA0, pA1, alA, t, 1, 0, 0);
        HALF_STEP(pA0, pA1, mnA, alA, pB0, pB1, alB, t + 1, 0, 1, 1);
    }
    const bool even = (NT & 1) == 0;
    if (even) { SBAR(); qkt<1, SK>(pB0, pB1, K_lds, r32, hi, S.qr, ACT(NT - 1)); SBAR(); }
    if constexpr (!ONE) { SLOAD_H(nxt.K, nxt.V, nxt.kpitch, kbn); SBAR(); }
    { const bf16* qrow = nxt.Q + RF::q_off(nxt, wid * QBLK + r32, e_nxt);
#pragma unroll
      for (int d0 = 0; d0 < 8; ++d0) S.qr[d0] = load8(qrow + d0 * 16 + hi * 8); }
    SBAR();
    finishSM(pA0, pA1, alA, l_reg, pa0, pa1, pa2, pa3); SBAR();
    pv_tile<0, SK>(o, vb0, pa0, pa1, pa2, pa3, ACT(even ? NT - 2 : NT - 1));
    if (even) { MASKT(pB0, pB1, NT - 1); partialSM(pB0, pB1, m_reg, mnB, alB); __syncthreads(); RESC(alB);
        finishSM(pB0, pB1, alB, l_reg, pa0, pa1, pa2, pa3); SBAR(); pv_tile<1, SK>(o, vb0, pa0, pa1, pa2, pa3, ACT(NT - 1)); }
    SBAR(); SEAM_K0();
    if (hi == 0) { li_l[r32] = l_reg; ot_l[r32] = RF::o_off(cur, wid * QBLK + r32, e_cur); } asm volatile("s_waitcnt lgkmcnt(0)" ::: "memory");
    if (LSE != nullptr && hi == 0) { const int lq = RF::l_idx(cur, wid * QBLK + r32, e_cur); if (lq >= 0) LSE[lq] = (l_reg > 0.f) ? m_reg * SCALE + __logf(l_reg) : -__builtin_inff(); }
    if (lse_lane != nullptr) *lse_lane = (l_reg > 0.f) ? m_reg * SCALE + __logf(l_reg) : -__builtin_inff();
    bf16* O = cur.O;
    { char* stg = lds + OFF_ST + wid * ST_WAVE;
#pragma unroll 1
      for (int p = 0; p < 2; ++p) {
#pragma unroll
        for (int rr = 0; rr < 8; ++rr) { const int r = 8 * p + rr, orow = crow(r, hi); const float lv = li_l[orow]; const float rl = (lv > 0.f) ? __builtin_amdgcn_rcpf(lv) : 0.f;
#pragma unroll
            for (int d0 = 0; d0 < 4; ++d0) {
                if constexpr (O8) *(unsigned char*)(stg + (orow - 16 * p) * ST_ROW + (d0 * 32 + r32)) = (unsigned char)__builtin_amdgcn_cvt_pk_fp8_f32(o[d0][r] * rl * 16.f, 0.f, 0, false);
                else *(unsigned short*)(stg + (orow - 16 * p) * ST_ROW + (d0 * 32 + r32) * 2) = (unsigned short)cvtpk(o[d0][r] * rl, 0.f); } }
        asm volatile("s_waitcnt lgkmcnt(0)" ::: "memory");
        { const int row = lane >> 2, ch = lane & 3, oo = ot_l[16 * p + row];
          if constexpr (O8) {
#pragma unroll
            for (int i = 0; i < 2; ++i) { const u32x4 x = *(const u32x4*)(stg + row * ST_ROW + (i * 4 + ch) * 16); if (oo >= 0) *(u32x4*)((char*)O + (size_t)oo + (i * 4 + ch) * 16) = x; }
          } else {
#pragma unroll
            for (int i = 0; i < 4; ++i) { const u32x4 x = *(const u32x4*)(stg + row * ST_ROW + (i * 4 + ch) * 16); if (oo >= 0) *(u32x4*)(O + (size_t)oo + (i * 4 + ch) * 8) = x; } } }
        asm volatile("s_waitcnt lgkmcnt(0)" ::: "memory");
      } }
    __syncthreads();
#undef RESC
#undef KBASE
#undef ACT
#undef MASKT
#undef SEAM_K0
#undef HALF_STEP
}

template <class RF>
__device__ __forceinline__ void imp_sweep(const Ref& cur, float lse_lane, float* IMP  , char* lds, Seam& S) {
    const int tid_ = wg_tid((const __attribute__((address_space(3))) int*)(uintptr_t)(unsigned)(uintptr_t)(lds + WIDTAB_OFF));
    const int tid = tid_, wid = __builtin_amdgcn_readfirstlane(tid >> 6), lane = tid & 63, r32 = lane & 31, hi = lane >> 5;
    const int NT = cur.j_hi - cur.j_lo;
    char* K_lds = lds + 2 * SHM_V;
    const int sr = tid >> 4, sc = (tid & 15) * 8, kws = KSWZ(sr, sc * 2);
    const bf16* Kh = cur.K; const int kp = cur.kpitch;
    const int row = wid * QBLK + r32;
    const int qm = RF::pos(cur, row, RF::entry(cur, row)) - 4 * hi; const unsigned Wm = (unsigned)RF::Wl(cur, row);
    constexpr float C2 = 1.4426950408889634f * SCALE;
    const float nl2 = (lse_lane == -__builtin_inff()) ? 0.f : -lse_lane * 1.4426950408889634f;
    float carry = 0.f;
    float* imp_row = IMP + (size_t)(row >> 2) * 512;
    f32x16 p0, p1;
#define IMP_TILE(t, KB) do { \
        if ((t) + 1 < NT) { S.st_k0 = load8(ROW(Kh, kp, (cur.j_lo + (t) + 1) * KVBLK, sr)); S.st_k1 = load8(ROW(Kh, kp, (cur.j_lo + (t) + 1) * KVBLK, 32 + sr)); } \
        SBAR(); qkt<KB, false>(p0, p1, K_lds, r32, hi, S.qr, true); \
        mask_tile(p0, p1, qm - (cur.j_lo + (t)) * KVBLK, Wm); \
        _Pragma("unroll") for (int r = 0; r < 16; ++r) { p0[r] = __builtin_amdgcn_exp2f(fmaf(p0[r], C2, nl2)); p1[r] = __builtin_amdgcn_exp2f(fmaf(p1[r], C2, nl2)); } \
        float Gs[8], Ls[8]; \
        _Pragma("unroll") for (int q = 0; q < 4; ++q) { Gs[q] = (p0[4 * q] + p0[4 * q + 1]) + (p0[4 * q + 2] + p0[4 * q + 3]); Ls[q] = p0[4 * q + 3]; \
                                              Gs[4 + q] = (p1[4 * q] + p1[4 * q + 1]) + (p1[4 * q + 2] + p1[4 * q + 3]); Ls[4 + q] = p1[4 * q + 3]; } \
          \
        float prevL = carry; \
        _Pragma("unroll") for (int q = 0; q < 8; ++q) { const float other = lane_get(Ls[q], lane ^ 32);        \
            const float add = hi ? other : prevL; prevL = other; Gs[q] += add; } \
        carry = prevL;                                            \
        _Pragma("unroll") for (int q = 0; q < 8; ++q) { float v = Gs[q]; v += lane_get(v, lane ^ 1); v += lane_get(v, lane ^ 2); \
            if ((r32 & 3) == 0) imp_row[((cur.j_lo + (t)) << 4) + 2 * q + hi] = v; } \
        if ((t) + 1 < NT) { asm volatile("s_waitcnt vmcnt(0)" ::: "memory"); *(bf16x8*)(K_lds + ((KB) ^ 1) * SHM_K + kws) = S.st_k0; *(bf16x8*)(K_lds + ((KB) ^ 1) * SHM_K + kws + 32 * 256) = S.st_k1; } \
        __syncthreads(); } while (0)
    for (int t = 0; t < NT; t += 2) { IMP_TILE(t, 0); if (t + 1 < NT) IMP_TILE(t + 1, 1); }
#undef IMP_TILE
}

template <class RF>
__device__ __forceinline__ void gate_unit(const Ref& cur, int nvis, char* lds, Seam& S, int (&sel)[3]) {
    const int tid_ = wg_tid((const __attribute__((address_space(3))) int*)(uintptr_t)(unsigned)(uintptr_t)(lds + WIDTAB_OFF));
    const int lane = tid_ & 63, r32 = lane & 31, hi = lane >> 5;
    char* K_lds = lds + 2 * SHM_V;
    prime<RF>(cur, lds, S);
    f32x16 p0, p1;
    qkt<0, false>(p0, p1, K_lds, r32, hi, S.qr, true);
    const float NEG = -__builtin_inff();
#pragma unroll
    for (int r = 0; r < 16; ++r) { const int k = crow(r, hi); if (k >= nvis) p0[r] = NEG; if (k + 32 >= nvis) p1[r] = NEG; }
    float bv[3]; int bk[3];
#pragma unroll
    for (int rd = 0; rd < 3; ++rd) { float best = NEG; int kb = 64;
#pragma unroll
        for (int r = 0; r < 16; ++r) if (p0[r] > best) { best = p0[r]; kb = crow(r, hi); }
#pragma unroll
        for (int r = 0; r < 16; ++r) if (p1[r] > best) { best = p1[r]; kb = 32 + crow(r, hi); }
        bv[rd] = best; bk[rd] = kb;
#pragma unroll
        for (int r = 0; r < 16; ++r) { if (crow(r, hi) == kb) p0[r] = NEG; if (32 + crow(r, hi) == kb) p1[r] = NEG; } }
    float ov[3]; int ok[3];
#pragma unroll
    for (int i = 0; i < 3; ++i) { ov[i] = lane_get(bv[i], lane ^ 32); ok[i] = lane_geti(bk[i], lane ^ 32); }
    int ia = 0, ib = 0;
#pragma unroll
    for (int rd = 0; rd < 3; ++rd) { const float va = ia == 0 ? bv[0] : (ia == 1 ? bv[1] : (ia == 2 ? bv[2] : NEG)), vb = ib == 0 ? ov[0] : (ib == 1 ? ov[1] : (ib == 2 ? ov[2] : NEG));
        const int ka = ia == 0 ? bk[0] : (ia == 1 ? bk[1] : (ia == 2 ? bk[2] : 64)), kb = ib == 0 ? ok[0] : (ib == 1 ? ok[1] : (ib == 2 ? ok[2] : 64));
        const bool ta = va > vb || (va == vb && ka < kb);
        const float v = ta ? va : vb; const int k = ta ? ka : kb; ia += ta ? 1 : 0; ib += ta ? 0 : 1;
        sel[rd] = (v == NEG) ? -1 : k; }
    __syncthreads();
}
#undef ROW
#undef VMW
#undef VMWN
#undef SLOAD_H
#undef SWRITE_HK
#undef SWRITE_HV
#undef SWRITE_H
#undef KSWZ
#undef SBAR
}

struct RFReg {
    static __device__ __forceinline__ int entry(const att::Ref&, int) { return 0; }
    static __device__ __forceinline__ int q_off(const att::Ref&, int row, int) { return row * 1024; }
    static __device__ __forceinline__ int o_off(const att::Ref&, int row, int) { return row * 1024; }
    static __device__ __forceinline__ int l_idx(const att::Ref& u, int row, int) { return u.a0 >= 0 ? u.a0 + row * 8 : -1; }
    static __device__ __forceinline__ int pos(const att::Ref& u, int row, int) { return u.P0 + row; }
    static __device__ __forceinline__ int Wl(const att::Ref& u, int) { return u.W; }
};
__device__ __forceinline__ att::Ref win_ref(int L, const bf16* QN, const bf16* KW, const bf16* VW, bf16* OWIN) {
    const int h = L & 7, qb = L >> 3;
    att::Ref r; r.Q = QN + (size_t)qb * 256 * 1024 + h * 128; r.O = OWIN + (size_t)qb * 256 * 1024 + h * 128; r.K = KW + (h >> 2) * 128; r.V = VW + (h >> 2) * 128; r.kpitch = 256; r.list = nullptr;
    r.P0 = qb * 256; r.W = 512; r.j_lo = (r.P0 >= 511) ? (r.P0 - 511) >> 6 : 0; r.j_hi = ((r.P0 + 255) >> 6) + 1; r.a0 = -1; r.a1 = 0; return r;
}
__device__ __forceinline__ att::Ref mown_ref(int L, const bf16* QM, const bf16* KM, const bf16* VM, bf16* POWN) {
    const int h = L & 7, n = L >> 3; const size_t o = (size_t)n * 256 * 1024 + h * 128;
    att::Ref r; r.Q = QM + o; r.O = POWN + o; r.K = KM + o; r.V = VM + o; r.kpitch = 1024; r.list = nullptr;
    r.P0 = 0; r.W = 1 << 20; r.j_lo = 0; r.j_hi = 4; r.a0 = n * 256 * 8 + h; r.a1 = 0; return r;
}
struct RFSel {
    static __device__ __forceinline__ int entry(const att::Ref& u, int row) { return u.list[row < u.a0 ? row : 0]; }
    static __device__ __forceinline__ int q_off(const att::Ref&, int, int e) { return (e >> 2) * 1024; }
    static __device__ __forceinline__ int o_off(const att::Ref& u, int row, int e) { return row < u.a0 ? (((e >> 2) * 8 + u.a1) * 3 + (e & 3)) * 128 : -1; }
    static __device__ __forceinline__ int l_idx(const att::Ref& u, int row, int e) { return row < u.a0 ? ((e >> 2) * 8 + u.a1) * 3 + (e & 3) : -1; }
    static __device__ __forceinline__ int pos(const att::Ref&, int, int) { return 0; }
    static __device__ __forceinline__ int Wl(const att::Ref&, int) { return 0; }
};
__device__ __forceinline__ att::Ref msel_ref(int L, const LAS int* tab, const LAS unsigned short* ulist, const int* MLIST, const bf16* QM, const bf16* KM, const bf16* VM, bf16* PSEL) {
    const int lid = __builtin_amdgcn_readfirstlane((int)ulist[L]), k = L - tab[512 + lid], h = lid >> 6, n = lid & 63;
    att::Ref r; r.Q = QM + h * 128; r.O = PSEL; r.K = KM + (size_t)n * 256 * 1024 + h * 128; r.V = VM + (size_t)n * 256 * 1024 + h * 128; r.kpitch = 1024;
    r.list = MLIST + (size_t)lid * 16384 + k * 256; r.P0 = 0; r.W = 0; r.j_lo = 0; r.j_hi = 4; r.a0 = tab[lid] - k * 256; r.a1 = h; return r;
}

struct RFSlc {
    static __device__ __forceinline__ int entry(const att::Ref& u, int row) { return u.list[(row >> 2) < u.a0 ? (row >> 2) : 0]; }
    static __device__ __forceinline__ int q_off(const att::Ref&, int row, int e) { return (e >> 4) * 1024 + (row & 3) * 128; }
    static __device__ __forceinline__ int l_idx(const att::Ref& u, int row, int e) { return (row >> 2) < u.a0 ? ((((e >> 4) * 2 + (u.a1 >> 16)) * 16 + (e & 15)) * 4 + (row & 3)) : -1; }
    static __device__ __forceinline__ int o_off(const att::Ref& u, int row, int e) { const int i = l_idx(u, row, e); return i >= 0 ? i * 128 : -1; }
    static __device__ __forceinline__ int pos(const att::Ref& u, int, int e) { return (e >> 4) - 64 * (u.a1 & 0xffff); }
    static __device__ __forceinline__ int Wl(const att::Ref&, int) { return 1 << 30; }
};
__device__ __forceinline__ att::Ref nsel_ref(int L, const LAS int* tab, const LAS unsigned short* ulist, const int* NLIST, const bf16* QN, const bf16* KS, const bf16* VS, bf16* PSLC) {
    const int lid = __builtin_amdgcn_readfirstlane((int)ulist[L]), k = L - tab[512 + lid], g = lid >> 8, j = lid & 255;
    att::Ref r; r.Q = QN + g * 512; r.O = PSLC; r.K = KS + (size_t)j * 64 * 256 + g * 128; r.V = VS + (size_t)j * 64 * 256 + g * 128; r.kpitch = 256;
    r.list = NLIST + (size_t)lid * 16384 + k * 64; r.P0 = 0; r.W = 0; r.j_lo = 0; r.j_hi = 1; r.a0 = tab[lid] - k * 64; r.a1 = j | (g << 16); return r;
}

struct RFCmp {
    static __device__ __forceinline__ int entry(const att::Ref&, int) { return 0; }
    static __device__ __forceinline__ int q_off(const att::Ref&, int row, int) { return (row >> 2) * 1024 + (row & 3) * 128; }
    static __device__ __forceinline__ int o_off(const att::Ref&, int row, int) { return (row >> 2) * 1024 + (row & 3) * 128; }
    static __device__ __forceinline__ int l_idx(const att::Ref&, int, int) { return -1; }
    static __device__ __forceinline__ int pos(const att::Ref& u, int row, int) { const int t = u.P0 + (row >> 2); return t >= 31 ? (t - 31) >> 4 : -1; }
    static __device__ __forceinline__ int Wl(const att::Ref&, int) { return 1 << 30; }
};
__device__ __forceinline__ att::Ref cmp_ref(int L, const bf16* QN, const bf16* KCMP, const bf16* VCMP, bf16* OCMP) {
    const int g = L & 1, c = (L < 256) ? (L >> 1) : 255 - ((L - 256) >> 1);
    att::Ref r; r.Q = QN + (size_t)c * 64 * 1024 + g * 512; r.O = OCMP + (size_t)c * 64 * 1024 + g * 512; r.K = KCMP + g * 128; r.V = VCMP + g * 128; r.kpitch = 256; r.list = nullptr;
    r.P0 = c * 64; r.W = 0; r.j_lo = 0; r.j_hi = (4 * c + 3 + 63) >> 6; r.a0 = g; r.a1 = c; return r;
}

struct Args { const float* in[18]; float* out; unsigned char* ws; int ph_lo, ph_hi, li, pad; };
typedef const __attribute__((address_space(4))) Args* ArgsP;
__device__ __forceinline__ ArgsP get_args() { auto p = __builtin_amdgcn_kernarg_segment_ptr(); asm volatile("" : "+s"(p)); return (ArgsP)p; }

__global__ void __launch_bounds__(NTHR, 2) mk_fwd(Args args_unused) {
    extern __shared__ __attribute__((aligned(16))) unsigned char lds_raw[];
    LAS unsigned char* lds = (LAS unsigned char*)lds_raw;
    LAS float* sm = (LAS float*)lds;
    volatile LAS unsigned* MISC = (volatile LAS unsigned*)(lds + MISC_OFF);
    LAS int* moetab = (LAS int*)(lds + MOETAB_OFF);
    const int G = gridDim.x, bid = blockIdx.x, NGW = G * NWAVES;
#define PH_IDS() const int tid_ = wg_tid((const LAS int*)(lds + WIDTAB_OFF)); const int tid = tid_, lane = tid & 63, wave = __builtin_amdgcn_readfirstlane(tid >> 6), gw = bid * NWAVES + wave; (void)lane; (void)gw;
#define AP() get_args()
#define CTLP(ws) ((gu32*)((ws) + WS_CTL))

    for (int u = threadIdx.x; u < (LDS_BYTES - LDSCTL_OFF) / 4; u += NTHR) ((LAS unsigned*)(lds + LDSCTL_OFF))[u] = 0u;
    __syncthreads();
    { unsigned hw; asm volatile("s_getreg_b32 %0, hwreg(HW_REG_HW_ID, 0, 6)" : "=s"(hw)); if ((threadIdx.x & 63) == 0) ((LAS int*)(lds + WIDTAB_OFF))[hw] = (int)(threadIdx.x >> 6); }
    __syncthreads();
    XcdBarrier bar; bar.bar = nullptr; bar.x = 0; bar.st = nullptr;
    if (MK_N_LAUNCHES == 1) bar = xcd_barrier_post((unsigned*)(CTLP(AP()->ws) + CW_BAR), MISC + 8);
#define GRID_BAR() do { if (MK_N_LAUNCHES == 1) { XcdBarrier b_ = bar; b_.bar = (unsigned*)(CTLP(AP()->ws) + CW_BAR); xcd_barrier(b_, wg_tid((const LAS int*)(lds + WIDTAB_OFF)) == 0); } } while (0)
    const int lo = AP()->ph_lo, hi = AP()->ph_hi;
#define IN(k) (lo <= (k) && (k) < hi)
#define BOTH(k) (IN(k) && IN((k) + 1))

    if (IN(0)) {
        PH_IDS(); ArgsP ap = AP(); unsigned char* ws = ap->ws;
        LAS float* scr = (LAS float*)(lds + wave * 16384);
        constexpr int I_IN = 32 * 177, I_OUT = 32 * 64, I_GU = 32 * 16, I_DN = 8 * 64, I_W1 = 32 * 8;
        constexpr int N_IN = 2 * I_IN, N_OUT = 2 * I_OUT, N_G = 64 * I_GU, N_U = 64 * I_GU, N_D = 64 * I_DN, N_W1 = 8 * I_W1;
        constexpr int NITEMS = N_IN + N_OUT + N_G + N_U + N_D + N_W1;
        for (int it = gw; it < NITEMS; it += NGW) {
            int r = it;
            if (r < N_IN) { const int l = r / I_IN; transpose_item<1>(ap->in[6] + (size_t)l * D_ * IN_W, D_, IN_W, (bf16*)(ws + WS_WINT) + (size_t)l * NIN * D_, D_, 0, scr, r % I_IN, lane); continue; } r -= N_IN;
            if (r < N_OUT) { const int l = r / I_OUT; transpose_item<0>(ap->in[7] + (size_t)l * D_ * D_, D_, D_, (bf16*)(ws + WS_WOUTT) + (size_t)l * D_ * D_, D_, 0, scr, r % I_OUT, lane); continue; } r -= N_OUT;
            if (r < N_G) { const int le = r / I_GU; transpose_item<2>(ap->in[14] + (size_t)le * D_ * DEXP, D_, DEXP, (bf16*)(ws + WS_WGUT) + (size_t)le * 1024 * D_, D_, 0, scr, r % I_GU, lane); continue; } r -= N_G;
            if (r < N_U) { const int le = r / I_GU; transpose_item<3>(ap->in[15] + (size_t)le * D_ * DEXP, D_, DEXP, (bf16*)(ws + WS_WGUT) + (size_t)le * 1024 * D_, D_, 0, scr, r % I_GU, lane); continue; } r -= N_U;
            if (r < N_D) { const int le = r / I_DN; transpose_item<0>(ap->in[16] + (size_t)le * DEXP * D_, DEXP, D_, (bf16*)(ws + WS_WDT) + (size_t)le * D_ * DEXP, DEXP, 0, scr, r % I_DN, lane); continue; } r -= N_D;
            { const int m = r / I_W1, lk = m >> 1, half = m & 1;
              transpose_item<0>(ap->in[9] + (size_t)lk * 4096 * 256 + (size_t)half * 2048 * 256, 2048, 256, (bf16*)(ws + WS_WC1T) + (size_t)lk * 512 * 2048, 2048, half * 256, scr, r % I_W1, lane); }
        }
        { const float* w_router = ap->in[12]; bf16* WrT = (bf16*)(ws + WS_WRT);
          for (int idx = bid * NTHR + tid; idx < 32 * 2048; idx += G * NTHR) { const int e = idx >> 11, k = idx & 2047; const float w = w_router[(size_t)k * 32 + e];
            const unsigned hb = f2bf(w); const float rem = w - bf2f(hb); WrT[idx] = (bf16)hb; WrT[32 * 2048 + idx] = (bf16)f2bf(rem); } }
        { f32x2* ROPE = (f32x2*)(ws + WS_ROPE);
          for (int idx = bid * NTHR + tid; idx < S_ * 64; idx += G * NTHR) { const int pos = idx >> 6, i = idx & 63;
            const double inv = exp(-(double)i * (9.210340371976184 / 64.0)); const double ang = (double)pos * inv; double sv, cv; sincos(ang, &sv, &cv);
            ROPE[idx] = (f32x2){(float)cv, (float)sv}; } }
        __syncthreads();
        { float* MOD = (float*)(CTLP(ws) + CW_MOD); const float* c_in = ap->in[1]; const float* w_ada = ap->in[2]; const float* b_ada = ap->in[3];
          for (int k = tid; k < D_; k += NTHR) { const float cv = c_in[k]; sm[k] = cv / (1.f + __expf(-cv)); }
          __syncthreads();
          for (int it = bid; it < 2 * 96; it += G) { const int l = it / 96, cb = it % 96, grp = tid >> 5, col = cb * 128 + (tid & 31) * 4;
            f32x4 a = (f32x4){0.f, 0.f, 0.f, 0.f};
            const float* wp = w_ada + ((size_t)l * D_ + grp) * 12288 + col;
#pragma unroll 8
            for (int i = 0; i < 128; ++i) a += *(const f32x4*)(wp + (size_t)i * 16 * 12288) * sm[grp + 16 * i];
            *(LAS f32x4*)(sm + 4096 + grp * 128 + (tid & 31) * 4) = a;
            __syncthreads();
            if (tid < 128) { float s = b_ada[l * 12288 + cb * 128 + tid];
#pragma unroll
                for (int q = 0; q < 16; ++q) s += sm[4096 + q * 128 + tid];
                MOD[l * 12288 + cb * 128 + tid] = s; }
            __syncthreads(); } }
        { float* B1P = (float*)(CTLP(ws) + CW_B1E); const float* cmp_pe = ap->in[8]; const float* cmp_w1 = ap->in[9];
          for (int it = bid - 192; it >= 0 && it < 32; it += G) { const int lk = it >> 3, ks = it & 7, grp = tid >> 6, n = (tid & 63) * 4;
            f32x4 a = (f32x4){0.f, 0.f, 0.f, 0.f};
            const float* wp = cmp_w1 + ((size_t)lk * 4096 + ks * 512 + grp) * 256 + n; const float* pe = cmp_pe + (size_t)lk * 4096 + ks * 512 + grp;
#pragma unroll 8
            for (int i = 0; i < 64; ++i) a += *(const f32x4*)(wp + (size_t)i * 8 * 256) * pe[i * 8];
            *(LAS f32x4*)(sm + 4096 + grp * 256 + n) = a;
            __syncthreads();
            if (tid < 256) { float s = 0.f;
#pragma unroll
                for (int q = 0; q < 8; ++q) s += sm[4096 + q * 256 + tid];
                B1P[(lk * 8 + ks) * 256 + tid] = s; }
            __syncthreads(); } }
        if (BOTH(0)) GRID_BAR();
    }

    for (int l = 0; l < DEPTH; ++l) {
        const int pb = 1 + NPL * l;
#define LOAD_MOETAB(CNTP, NT_) do { __syncthreads(); if (tid < 32) moetab[tid] = (int)__hip_atomic_load((CNTP) + tid * CSTR, RLX_AGENT); __syncthreads(); \
        if (tid == 0) { int us = 0, ps = 0; for (int e = 0; e < NEXP; ++e) { const int c = moetab[e], tl = (c + 255) >> 8; moetab[32 + e] = us; moetab[65 + e] = ps; us += tl * (NT_); ps += tl << 8; } moetab[64] = us; } \
        __syncthreads(); } while (0)

        if (IN(pb + 0)) {
            PH_IDS(); ArgsP ap = AP(); unsigned char* ws = ap->ws;
            const float* MOD = (const float*)(CTLP(ws) + CW_MOD); const float* mod = MOD + l * 12288;
            float* X = ap->out; bf16* H = (bf16*)(ws + WS_H); const bf16* Y = (const bf16*)(ws + WS_Y); const int* TE = (const int*)(ws + WS_TE);
            if (l > 0) LOAD_MOETAB((unsigned*)(CTLP(ws) + CW_CNT) + (l - 1) * 32 * CSTR, 1);
            { const float* g_attn = ap->in[4];
              for (int k = tid; k < D_; k += NTHR) { sm[k] = g_attn[l * D_ + k] * (1.f + mod[2048 + k]); sm[2048 + k] = mod[k]; sm[4096 + k] = (l > 0) ? MOD[(l - 1) * 12288 + 10240 + k] : 0.f; } }
            __syncthreads();
            const float* x_in = ap->in[0];
            for (int t = gw; t < S_; t += NGW) {
                f32x4 v[8]; float ss = 0.f;
                if (l == 0) {
#pragma unroll
                    for (int j = 0; j < 8; ++j) v[j] = *(const f32x4*)(x_in + (size_t)t * D_ + 256 * j + 4 * lane);
                } else {
                    const int4 te = *(const int4*)(TE + 4 * t);
                    const bf16* y0 = Y + (size_t)(moetab[65 + te.x] + te.y) * D_; const bf16* y1 = Y + (size_t)(moetab[65 + te.z] + te.w) * D_;
#pragma unroll
                    for (int j = 0; j < 8; ++j) { const int k = 256 * j + 4 * lane; const uint2 a = *(const uint2*)(y0 + k), b = *(const uint2*)(y1 + k);
                        const f32x4 gt2 = *(const LAS f32x4*)(sm + 4096 + k);
                        f32x4 ysum = (f32x4){bflo(a.x) + bflo(b.x), bfhi(a.x) + bfhi(b.x), bflo(a.y) + bflo(b.y), bfhi(a.y) + bfhi(b.y)};
                        v[j] = *(const f32x4*)(X + (size_t)t * D_ + k) + gt2 * ysum; *(f32x4*)(X + (size_t)t * D_ + k) = v[j]; }
                }
#pragma unroll
                for (int j = 0; j < 8; ++j) ss += (v[j][0] * v[j][0] + v[j][1] * v[j][1]) + (v[j][2] * v[j][2] + v[j][3] * v[j][3]);
                const float rstd = 1.f / sqrtf(wave_sum(ss, lane) * (1.f / D_) + RMS_EPS);
#pragma unroll
                for (int j = 0; j < 8; ++j) { const int k = 256 * j + 4 * lane; const f32x4 h = v[j] * rstd * *(const LAS f32x4*)(sm + k) + *(const LAS f32x4*)(sm + 2048 + k);
                    *(uint2*)(H + (size_t)t * D_ + k) = make_uint2(pk2(h[0], h[1]), pk2(h[2], h[3])); }
            }
            if (BOTH(pb + 0)) GRID_BAR();
        }
        if (IN(pb + 1)) {
            ArgsP ap = AP(); unsigned char* ws = ap->ws;
            pg8::Gemm g{(const bf16*)(ws + WS_H), (const bf16*)(ws + WS_WINT) + (size_t)l * NIN * D_, S_, NIN, D_}; pg8::StaticOrder So; So.init(S_, NIN, G, bid);
            EpiInProj E{(bf16*)(ws + WS_QN), (bf16*)(ws + WS_KC), (bf16*)(ws + WS_VC), (bf16*)(ws + WS_KS), (bf16*)(ws + WS_VS), (bf16*)(ws + WS_KW), (bf16*)(ws + WS_VW),
                        (bf16*)(ws + WS_QM), (bf16*)(ws + WS_KM), (bf16*)(ws + WS_VM), (float*)(ws + WS_GATES), (const float*)(ws + WS_ROPE)};
            pg8::gemm_phase<EpiInProj, pg8::StaticOrder, true, true>(lds, g, So, E);
            if (BOTH(pb + 1)) GRID_BAR();
        }
        if (IN(pb + 2)) {
            PH_IDS(); ArgsP ap = AP(); unsigned char* ws = ap->ws;
            if (bid < 32) {
                pg8::Gemm g{(const bf16*)(ws + WS_KC), (const bf16*)(ws + WS_WC1T) + (size_t)l * 2 * 512 * 2048, 4096, 512, 2048}; CompressOrder So{G, bid};
                EpiF32 E{(float*)(ws + WS_UL), 512};
                pg8::gemm_phase<EpiF32, CompressOrder, false, true>(lds, g, So, E);
            }
            {
                const bf16* KM = (const bf16*)(ws + WS_KM); bf16* KMEAN = (bf16*)(ws + WS_KMEAN);
                const int nb = (G > 32) ? G - 32 : G, b0 = (G > 32) ? bid - 32 : bid;
                if (b0 >= 0) for (int u = b0; u < 512; u += nb) { const int n = u >> 3, h = u & 7, rg = tid >> 4, c8 = (tid & 15) * 8;
                    float a8[8] = {0.f, 0.f, 0.f, 0.f, 0.f, 0.f, 0.f, 0.f};
#pragma unroll
                    for (int i = 0; i < 8; ++i) { const v4u kv = *(const v4u*)(KM + (size_t)(n * 256 + rg + 32 * i) * 1024 + h * 128 + c8);
                        a8[0] += bflo(kv.x); a8[1] += bfhi(kv.x); a8[2] += bflo(kv.y); a8[3] += bfhi(kv.y); a8[4] += bflo(kv.z); a8[5] += bfhi(kv.z); a8[6] += bflo(kv.w); a8[7] += bfhi(kv.w); }
#pragma unroll
                    for (int i = 0; i < 8; ++i) sm[rg * 128 + c8 + i] = a8[i];
                    __syncthreads();
                    if (tid < 128) { float s = 0.f;
#pragma unroll 8
                        for (int q = 0; q < 32; ++q) s += sm[q * 128 + tid];
                        KMEAN[(size_t)(h * 64 + n) * 128 + tid] = (bf16)f2bf(s * (1.f / 256.f)); }
                    __syncthreads(); }
            }
            {
                const bf16* QN = (const bf16*)(ws + WS_QN); const bf16* KW = (const bf16*)(ws + WS_KW); const bf16* VW = (const bf16*)(ws + WS_VW); bf16* OWIN = (bf16*)(ws + WS_OWIN);
                const bf16* QM = (const bf16*)(ws + WS_QM); const bf16* KM2 = (const bf16*)(ws + WS_KM); const bf16* VM = (const bf16*)(ws + WS_VM); bf16* POWN = (bf16*)(ws + WS_POWN); float* LSEO = (float*)(ws + WS_LSEO);
                const int nbw = (G > 32) ? G - 32 : G, bw = (G > 32) ? bid - 32 : bid;
                __syncthreads();
                att::Seam S; int L = bw;
                if (L >= 0 && L < 1024) { att::Ref cur = (L < 512) ? win_ref(L, QN, KW, VW, OWIN) : mown_ref(L - 512, QM, KM2, VM, POWN); att::prime<RFReg>(cur, (char*)lds_raw, S);
                    for (;;) { const int Ln = L + nbw; const bool more = Ln < 1024; const att::Ref nxt = more ? ((Ln < 512) ? win_ref(Ln, QN, KW, VW, OWIN) : mown_ref(Ln - 512, QM, KM2, VM, POWN)) : cur;
                        att::block<0, true, RFReg>(cur, nxt, LSEO, (char*)lds_raw, S);
                        if (!more) break; cur = nxt; L = Ln; } }
                __syncthreads();
            }
            if (BOTH(pb + 2)) GRID_BAR();
        }
        if (IN(pb + 3)) {
            PH_IDS(); ArgsP ap = AP(); unsigned char* ws = ap->ws;
            const float* UL = (const float*)(ws + WS_UL); const float* B1P = (const float*)(CTLP(ws) + CW_B1E); const float* cmp_b1 = ap->in[10]; const f32x2* ROPE = (const f32x2*)(ws + WS_ROPE);
            bf16* KCMP = (bf16*)(ws + WS_KCMP); bf16* VCMP = (bf16*)(ws + WS_VCMP); const float* cmp_w2 = ap->in[11];
            { const int kv = bid & 1; const float* w2 = cmp_w2 + (size_t)(l * 2 + kv) * 256 * 128; LAS float* be = (LAS float*)(lds + 135168 + 8192);
              if (tid < 256) { float s = cmp_b1[(l * 2 + kv) * 256 + tid];
#pragma unroll
                  for (int q = 0; q < 8; ++q) s += B1P[((l * 2 + kv) * 8 + q) * 256 + tid];
                  be[tid] = s; }
              for (int i = tid; i < 256 * 128 / 4; i += NTHR) *(LAS f32x4*)(sm + 4 * i) = *(const f32x4*)(w2 + 4 * i);
              LAS float* hid = (LAS float*)(lds + 135168) + wave * 256;
              __syncthreads();
              const int nb2 = (G + 1 - kv) >> 1;
              for (int r = (bid >> 1) * NWAVES + wave; r < NC * 2; r += nb2 * NWAVES) { const int c = r >> 1, g = r & 1;
                const float* Ur = UL + ((size_t)kv * 2048 + g * 1024 + c) * 512; const float* Lr = UL + ((size_t)kv * 2048 + g * 1024 + c + 1) * 512 + 256;
#pragma unroll
                for (int j = 0; j < 4; ++j) { const int n = lane + 64 * j; const float v = Ur[n] + Lr[n] + be[n];
                    hid[n] = 0.5f * v * (1.f + tanhf(0.7978845608028654f * (v + 0.044715f * v * v * v))); }
                LDS_WAIT(); asm volatile("" ::: "memory");
                float o0 = 0.f, o1 = 0.f;
#pragma unroll 8
                for (int n = 0; n < 256; ++n) { const float hv = hid[n]; o0 += hv * sm[n * 128 + lane]; o1 += hv * sm[n * 128 + 64 + lane]; }
                if (kv == 0) { const f32x2 cs = ROPE[(size_t)(16 * c + 31) * 64 + lane];
                    const float a = o0 * cs[0] - o1 * cs[1], b = o1 * cs[0] + o0 * cs[1];
                    *(unsigned*)(KCMP + ((size_t)c * 2 + g) * 128 + 2 * lane) = pk2(a, b);
                } else { VCMP[((size_t)c * 2 + g) * 128 + lane] = (bf16)f2bf(o0); VCMP[((size_t)c * 2 + g) * 128 + 64 + lane] = (bf16)f2bf(o1); }
                LDS_WAIT(); asm volatile("" ::: "memory");
              }
              __syncthreads(); }
            if (BOTH(pb + 3)) GRID_BAR();
        }
        if (IN(pb + 4)) {
            {   ArgsP ap = AP(); unsigned char* ws = ap->ws;
                const bf16* QN = (const bf16*)(ws + WS_QN); const bf16* KCMP = (const bf16*)(ws + WS_KCMP); const bf16* VCMP = (const bf16*)(ws + WS_VCMP);
                bf16* OCMP = (bf16*)(ws + WS_OCMP); float* IMP = (float*)(ws + WS_IMP);
                att::Seam S;
                for (int L = bid; L < 512; L += G) { const att::Ref cur = cmp_ref(L, QN, KCMP, VCMP, OCMP); float lse;
                    att::prime<RFCmp>(cur, (char*)lds_raw, S);
                    att::block<2, false, RFCmp>(cur, cur, nullptr, (char*)lds_raw, S, &lse);
                    att::imp_sweep<RFCmp>(cur, lse, IMP + ((size_t)cur.a1 * 64 * 2 + cur.a0) * 256, (char*)lds_raw, S); }
            }
            {   PH_IDS(); ArgsP ap = AP(); unsigned char* ws = ap->ws;
                const bf16* QM = (const bf16*)(ws + WS_QM); const bf16* KMEAN = (const bf16*)(ws + WS_KMEAN);
                unsigned* MCNT = (unsigned*)(CTLP(ws) + CW_MCNT) + l * 512 * CSTR; int* MLIST = (int*)(ws + WS_MLIST); float* LSES = (float*)(ws + WS_LSES);
                __syncthreads();
                att::Seam S;
                for (int L = bid; L < 512; L += G) { const int h = L & 7, nq = L >> 3;
                    att::Ref cur; cur.Q = QM + (size_t)nq * 256 * 1024 + h * 128; cur.O = nullptr; cur.K = KMEAN + (size_t)h * 64 * 128; cur.V = cur.K; cur.kpitch = 128; cur.list = nullptr;
                    cur.P0 = 0; cur.W = 0; cur.j_lo = 0; cur.j_hi = 1; cur.a0 = -1; cur.a1 = 0;
                    int sel[3]; att::gate_unit<RFReg>(cur, nq, (char*)lds_raw, S, sel);
                    if (lane < 32) { const int t = nq * 256 + wave * 32 + lane;
#pragma unroll
                        for (int s = 0; s < 3; ++s) {
                            if (sel[s] >= 0) { const unsigned p = atomicAdd(MCNT + (h * 64 + sel[s]) * CSTR, 1u); MLIST[(size_t)(h * 64 + sel[s]) * 16384 + p] = t * 4 + s; }
                            else LSES[(t * 8 + h) * 3 + s] = -INFINITY; } }
                }
            }
            if (BOTH(pb + 4)) GRID_BAR();
        }
        if (IN(pb + 5)) {
            PH_IDS(); ArgsP ap = AP(); unsigned char* ws = ap->ws;
            {   PH_IDS(); ArgsP ap = AP(); unsigned char* ws = ap->ws;
                const float* IMP = (const float*)(ws + WS_IMP); int* SEL = (int*)(ws + WS_SEL);
                unsigned* NCNT = (unsigned*)(CTLP(ws) + CW_NCNT) + l * 512 * CSTR; int* NLIST = (int*)(ws + WS_NLIST);
                const int lam = lane & 15, rho = lane >> 4;
                for (int ub = gw * 4; ub < S_ * 2; ub += NGW * 4) { const int u = ub + rho, t = u >> 1, g = u & 1, tb = t >> 6;
                    float v[16];
#pragma unroll
                    for (int i = 0; i < 16; ++i) { const int j = lam + 16 * i; const float im = IMP[(size_t)u * 256 + j]; const bool forced = (j == 0) || (j == tb) || (j == tb - 1);
                        v[i] = (j > tb) ? -INFINITY : (forced ? 1e9f : im); }
                    int mysel = -1;
                    for (int r = 0; r < 16; ++r) { const int pick = row_pick<16>(v, lam); if (lam == r) mysel = pick; if (__all(pick < 0)) break; }
                    SEL[(size_t)u * 16 + lam] = mysel;
                    if (mysel >= 0) {
                        unsigned p;
                        if (mysel == 0) p = (unsigned)t; else if (mysel == tb) p = (unsigned)(t & 63); else if (mysel == tb - 1) p = 64u + (unsigned)(t & 63);
                        else p = 128u + atomicAdd(NCNT + (g * 256 + mysel) * CSTR, 1u);
                        NLIST[(size_t)(g * 256 + mysel) * 16384 + p] = t * 16 + lam; }
                }
            }
            {   PH_IDS(); ArgsP ap = AP(); unsigned char* ws = ap->ws;
                const bf16* QM = (const bf16*)(ws + WS_QM); const bf16* KM = (const bf16*)(ws + WS_KM); const bf16* VM = (const bf16*)(ws + WS_VM);
                bf16* POWN = (bf16*)(ws + WS_POWN); bf16* PSEL = (bf16*)(ws + WS_PSEL); float* LSEO = (float*)(ws + WS_LSEO); float* LSES = (float*)(ws + WS_LSES);
                const int* MLIST = (const int*)(ws + WS_MLIST); unsigned* MCNT = (unsigned*)(CTLP(ws) + CW_MCNT) + l * 512 * CSTR;
                LAS int* mtab = (LAS int*)(lds + att::LDS_BYTES);
                __syncthreads();
                mtab[tid] = (int)__hip_atomic_load(MCNT + tid * CSTR, RLX_AGENT);
                __syncthreads();
                LAS unsigned short* ulist = (LAS unsigned short*)(lds + 108544);
                { int tot; const int nu = (mtab[tid] + 255) >> 8; const int ex = block_excl_scan(nu, mtab + 1040, tid, &tot); mtab[512 + tid] = ex; if (tid == 0) mtab[1024] = tot;
                  for (int u = 0; u < nu; ++u) ulist[ex + u] = (unsigned short)tid; }
                __syncthreads();
                const int nsel = mtab[1024];
                att::Seam S;
                { int L = bid;
                  if (L < nsel) { att::Ref cur = msel_ref(L, mtab, ulist, MLIST, QM, KM, VM, PSEL); att::prime<RFSel>(cur, (char*)lds_raw, S);
                    for (;;) { const bool more = L + G < nsel; const att::Ref nxt = more ? msel_ref(L + G, mtab, ulist, MLIST, QM, KM, VM, PSEL) : cur;
                        att::block<1, false, RFSel>(cur, nxt, LSES, (char*)lds_raw, S);
                        if (!more) break; cur = nxt; L += G; } } }
                __syncthreads();
            }
            if (BOTH(pb + 5)) GRID_BAR();
        }
        if (IN(pb + 6)) {
            PH_IDS(); ArgsP ap = AP(); unsigned char* ws = ap->ws;
            const bf16* POWN = (const bf16*)(ws + WS_POWN); const bf16* PSEL = (const bf16*)(ws + WS_PSEL); const float* LSEO = (const float*)(ws + WS_LSEO); const float* LSES = (const float*)(ws + WS_LSES);
            bf16* OMIX = (bf16*)(ws + WS_OMIX);
            for (int t = gw; t < S_; t += NGW) {
                const int hh = (lane >> 2) & 7, ii = lane & 3;
                const float lv = (ii == 0) ? LSEO[t * 8 + hh] : LSES[(t * 8 + hh) * 3 + ii - 1];
                float m = fmaxf(lv, lane_get(lv, lane ^ 1)); m = fmaxf(m, lane_get(m, lane ^ 2));
                float w = __expf(lv - m); float sw = w + lane_get(w, lane ^ 1); sw += lane_get(sw, lane ^ 2); w = w / sw;
#pragma unroll
                for (int hp = 0; hp < 2; ++hp) { const int h = hp * 4 + (lane >> 4), c8 = (lane & 15) * 8;
                    const float w0 = lane_get(w, h * 4), w1 = lane_get(w, h * 4 + 1), w2 = lane_get(w, h * 4 + 2), w3 = lane_get(w, h * 4 + 3);
                    const bf16* ps = PSEL + (size_t)((t * 8 + h) * 3) * 128 + c8;
                    const v4u a0 = *(const v4u*)(POWN + (size_t)t * 1024 + h * 128 + c8);
                    v4u a1 = (v4u){0u, 0u, 0u, 0u}, a2 = a1, a3 = a1;
                    if (w1 > 0.f) a1 = *(const v4u*)(ps); if (w2 > 0.f) a2 = *(const v4u*)(ps + 128); if (w3 > 0.f) a3 = *(const v4u*)(ps + 256);
                    v4u ov;
                    ov.x = pk2(w0 * bflo(a0.x) + w1 * bflo(a1.x) + w2 * bflo(a2.x) + w3 * bflo(a3.x), w0 * bfhi(a0.x) + w1 * bfhi(a1.x) + w2 * bfhi(a2.x) + w3 * bfhi(a3.x));
                    ov.y = pk2(w0 * bflo(a0.y) + w1 * bflo(a1.y) + w2 * bflo(a2.y) + w3 * bflo(a3.y), w0 * bfhi(a0.y) + w1 * bfhi(a1.y) + w2 * bfhi(a2.y) + w3 * bfhi(a3.y));
                    ov.z = pk2(w0 * bflo(a0.z) + w1 * bflo(a1.z) + w2 * bflo(a2.z) + w3 * bflo(a3.z), w0 * bfhi(a0.z) + w1 * bfhi(a1.z) + w2 * bfhi(a2.z) + w3 * bfhi(a3.z));
                    ov.w = pk2(w0 * bflo(a0.w) + w1 * bflo(a1.w) + w2 * bflo(a2.w) + w3 * bflo(a3.w), w0 * bfhi(a0.w) + w1 * bfhi(a1.w) + w2 * bfhi(a2.w) + w3 * bfhi(a3.w));
                    *(v4u*)(OMIX + (size_t)t * 2048 + 1024 + h * 128 + c8) = ov; }
            }
            if (BOTH(pb + 6)) GRID_BAR();

        }
        if (IN(pb + 7)) {
            PH_IDS(); ArgsP ap = AP(); unsigned char* ws = ap->ws;
            const bf16* QN = (const bf16*)(ws + WS_QN); const bf16* KS = (const bf16*)(ws + WS_KS); const bf16* VS = (const bf16*)(ws + WS_VS);
            bf16* PSLC = (bf16*)(ws + WS_PSLC); float* LSEN = (float*)(ws + WS_LSEN); const int* NLIST = (const int*)(ws + WS_NLIST); unsigned* NCNT = (unsigned*)(CTLP(ws) + CW_NCNT) + l * 512 * CSTR;
            LAS int* ntab = (LAS int*)(lds + att::LDS_BYTES);
            __syncthreads();
            { const int j = tid & 255; ntab[tid] = (j == 0) ? S_ : (int)__hip_atomic_load(NCNT + tid * CSTR, RLX_AGENT) + 64 + (j < 255 ? 64 : 0); }
            __syncthreads();
            LAS unsigned short* ulist = (LAS unsigned short*)(lds + 108544);
            { int tot; const int nu = (ntab[tid] + 63) >> 6; const int ex = block_excl_scan(nu, ntab + 1040, tid, &tot); ntab[512 + tid] = ex; if (tid == 0) ntab[1024] = tot;
              for (int u = 0; u < nu; ++u) ulist[ex + u] = (unsigned short)tid; }
            __syncthreads();
            const int nun = ntab[1024];
            att::Seam S; int L = bid;
            if (L < nun) { att::Ref cur = nsel_ref(L, ntab, ulist, NLIST, QN, KS, VS, PSLC); att::prime<RFSlc>(cur, (char*)lds_raw, S);
                for (;;) { const bool more = L + G < nun; const att::Ref nxt = more ? nsel_ref(L + G, ntab, ulist, NLIST, QN, KS, VS, PSLC) : cur;
                    att::block<2, false, RFSlc, true, true>(cur, nxt, LSEN, (char*)lds_raw, S);
                    if (!more) break; cur = nxt; L += G; } }
            __syncthreads();
            if (BOTH(pb + 7)) GRID_BAR();
        }
        if (IN(pb + 8)) {
            PH_IDS(); ArgsP ap = AP(); unsigned char* ws = ap->ws;
            const unsigned char* PSLC = (const unsigned char*)(ws + WS_PSLC); const float* LSEN = (const float*)(ws + WS_LSEN); const int* SEL = (const int*)(ws + WS_SEL); const float* GATES = (const float*)(ws + WS_GATES);
            const bf16* OCMP = (const bf16*)(ws + WS_OCMP); const bf16* OWIN = (const bf16*)(ws + WS_OWIN); bf16* OMIX = (bf16*)(ws + WS_OMIX);
            for (int u = gw; u < S_ * 2; u += NGW) { const int t = u >> 1, g = u & 1;
                const int sv = (lane < 16) ? SEL[(size_t)u * 16 + lane] : -1;
                const int nsel = __popcll(__ballot(sv >= 0));
                const float lv = ((lane >> 2) < nsel) ? LSEN[(size_t)u * 64 + lane] : -INFINITY;
                float m = lv;
#pragma unroll
                for (int o = 4; o < 64; o <<= 1) m = fmaxf(m, lane_get(m, lane ^ o));
                float w = __expf(lv - m), sw = w;
#pragma unroll
                for (int o = 4; o < 64; o <<= 1) sw += lane_get(sw, lane ^ o);
                w = w / sw * 0.0625f;
                const int r = lane >> 4, c8 = (lane & 15) * 8;
                float o8[8] = {0.f, 0.f, 0.f, 0.f, 0.f, 0.f, 0.f, 0.f};
                uint2 pv[16];
#pragma unroll
                for (int s = 0; s < 16; ++s) { const int sc = s < nsel ? s : nsel - 1; pv[s] = *(const uint2*)(PSLC + ((size_t)(u * 16 + sc) * 4 + r) * 128 + c8); }
#pragma unroll
                for (int s = 0; s < 16; ++s) { const float ws_ = lane_get(w, s * 4 + r);
                    o8[0] += ws_ * __builtin_amdgcn_cvt_f32_fp8((int)pv[s].x, 0); o8[1] += ws_ * __builtin_amdgcn_cvt_f32_fp8((int)pv[s].x, 1); o8[2] += ws_ * __builtin_amdgcn_cvt_f32_fp8((int)pv[s].x, 2); o8[3] += ws_ * __builtin_amdgcn_cvt_f32_fp8((int)pv[s].x, 3);
                    o8[4] += ws_ * __builtin_amdgcn_cvt_f32_fp8((int)pv[s].y, 0); o8[5] += ws_ * __builtin_amdgcn_cvt_f32_fp8((int)pv[s].y, 1); o8[6] += ws_ * __builtin_amdgcn_cvt_f32_fp8((int)pv[s].y, 2); o8[7] += ws_ * __builtin_amdgcn_cvt_f32_fp8((int)pv[s].y, 3); }
                const int hd = g * 4 + r; const float g0 = GATES[(size_t)t * 32 + hd * 3], g1 = GATES[(size_t)t * 32 + hd * 3 + 1], g2 = GATES[(size_t)t * 32 + hd * 3 + 2];
                const size_t oi = (size_t)t * 1024 + hd * 128 + c8;
                const v4u cv = *(const v4u*)(OCMP + oi), wv = *(const v4u*)(OWIN + oi);
                v4u ov;
                ov.x = pk2(g1 * o8[0] + g0 * bflo(cv.x) + g2 * bflo(wv.x), g1 * o8[1] + g0 * bfhi(cv.x) + g2 * bfhi(wv.x));
                ov.y = pk2(g1 * o8[2] + g0 * bflo(cv.y) + g2 * bflo(wv.y), g1 * o8[3] + g0 * bfhi(cv.y) + g2 * bfhi(wv.y));
                ov.z = pk2(g1 * o8[4] + g0 * bflo(cv.z) + g2 * bflo(wv.z), g1 * o8[5] + g0 * bfhi(cv.z) + g2 * bfhi(wv.z));
                ov.w = pk2(g1 * o8[6] + g0 * bflo(cv.w) + g2 * bflo(wv.w), g1 * o8[7] + g0 * bfhi(cv.w) + g2 * bfhi(wv.w));
                *(v4u*)(OMIX + (size_t)t * 2048 + hd * 128 + c8) = ov;
            }
            if (BOTH(pb + 8)) GRID_BAR();
        }
        if (IN(pb + 9)) {
            ArgsP ap = AP(); unsigned char* ws = ap->ws;
            pg8::Gemm g{(const bf16*)(ws + WS_OMIX), (const bf16*)(ws + WS_WOUTT) + (size_t)l * D_ * D_, S_, D_, D_}; pg8::StaticOrder So; So.init(S_, D_, G, bid);
            EpiOutProj E{l == 0 ? ap->in[0] : (const float*)ap->out, ap->out, (const float*)(CTLP(ws) + CW_MOD) + l * 12288 + 4096};
            pg8::gemm_phase<EpiOutProj, pg8::StaticOrder, true, true>(lds, g, So, E);
            if (BOTH(pb + 9)) GRID_BAR();
        }
        if (IN(pb + 10)) {
            PH_IDS(); ArgsP ap = AP(); unsigned char* ws = ap->ws;
            const float* mod = (const float*)(CTLP(ws) + CW_MOD) + l * 12288;
            const float* X = ap->out; bf16* H = (bf16*)(ws + WS_H); const bf16* WrT = (const bf16*)(ws + WS_WRT); const float* b_router = ap->in[13];
            unsigned* CNT = (unsigned*)(CTLP(ws) + CW_CNT) + l * 32 * CSTR; int* TE = (int*)(ws + WS_TE); int* TOKIDX = (int*)(ws + WS_TOKIDX); float* WTS = (float*)(ws + WS_WTS);
            { const float* g_ffn = ap->in[5];
              for (int k = tid; k < D_; k += NTHR) { sm[k] = g_ffn[l * D_ + k] * (1.f + mod[8192 + k]); sm[2048 + k] = mod[6144 + k]; }
              if (tid < 32) sm[4160 + tid] = b_router[tid]; }
            typedef short bf16x8_t __attribute__((ext_vector_type(8))); typedef float f32x16_t __attribute__((ext_vector_type(16)));
            for (int bt = bid; bt < S_ / 64; bt += G) { const int t0 = bt * 64;
                __syncthreads();
                for (int rr = 0; rr < 8; rr += 2) { const int row = wave * 8 + rr; float ss0 = 0.f, ss1 = 0.f; f32x4 va[8], vb[8];
#pragma unroll
                    for (int j = 0; j < 8; ++j) { va[j] = *(const f32x4*)(X + (size_t)(t0 + row) * D_ + 256 * j + 4 * lane); vb[j] = *(const f32x4*)(X + (size_t)(t0 + row + 1) * D_ + 256 * j + 4 * lane); }
#pragma unroll
                    for (int j = 0; j < 8; ++j) { ss0 += (va[j][0] * va[j][0] + va[j][1] * va[j][1]) + (va[j][2] * va[j][2] + va[j][3] * va[j][3]); ss1 += (vb[j][0] * vb[j][0] + vb[j][1] * vb[j][1]) + (vb[j][2] * vb[j][2] + vb[j][3] * vb[j][3]); }
                    ss0 = wave_sum(ss0, lane); ss1 = wave_sum(ss1, lane);
                    if (lane == 0) { sm[4096 + row] = 1.f / sqrtf(ss0 * (1.f / D_) + RMS_EPS); sm[4096 + row + 1] = 1.f / sqrtf(ss1 * (1.f / D_) + RMS_EPS); } }
                __syncthreads();
                { const int r = lane & 31, kh = lane >> 5; f32x16_t acc0 = {}, acc1 = {};
                  const float rs0 = sm[4096 + r], rs1 = sm[4096 + 32 + r];
#pragma unroll 2
                  for (int ks = 0; ks < 16; ++ks) { const int k = wave * 256 + ks * 16 + kh * 8;
                    const bf16x8_t wh = *(const bf16x8_t*)(WrT + (size_t)r * 2048 + k), wl = *(const bf16x8_t*)(WrT + 32 * 2048 + (size_t)r * 2048 + k);
                    const f32x4 gA = *(const LAS f32x4*)(sm + k), gB = *(const LAS f32x4*)(sm + k + 4), sA = *(const LAS f32x4*)(sm + 2048 + k), sB = *(const LAS f32x4*)(sm + 2048 + k + 4);
#pragma unroll
                    for (int rg = 0; rg < 2; ++rg) { const size_t ro = (size_t)(t0 + rg * 32 + r) * D_ + k; const float rs = rg ? rs1 : rs0;
                        const f32x4 xa = *(const f32x4*)(X + ro), xb = *(const f32x4*)(X + ro + 4);
                        const f32x4 ha = xa * rs * gA + sA, hb = xb * rs * gB + sB;
                        const unsigned h0 = pk2(ha[0], ha[1]), h1 = pk2(ha[2], ha[3]), h2 = pk2(hb[0], hb[1]), h3 = pk2(hb[2], hb[3]);
                        *(v4u*)(H + ro) = (v4u){h0, h1, h2, h3};
                        const unsigned l0 = pk2(ha[0] - bflo(h0), ha[1] - bfhi(h0)), l1 = pk2(ha[2] - bflo(h1), ha[3] - bfhi(h1)), l2 = pk2(hb[0] - bflo(h2), hb[1] - bfhi(h2)), l3 = pk2(hb[2] - bflo(h3), hb[3] - bfhi(h3));
                        const v4u hv = (v4u){h0, h1, h2, h3}, lv = (v4u){l0, l1, l2, l3};
                        const bf16x8_t ahi = __builtin_bit_cast(bf16x8_t, hv), alo = __builtin_bit_cast(bf16x8_t, lv);
                        if (rg == 0) { acc0 = __builtin_amdgcn_mfma_f32_32x32x16_bf16(wh, ahi, acc0, 0, 0, 0); acc0 = __builtin_amdgcn_mfma_f32_32x32x16_bf16(wl, ahi, acc0, 0, 0, 0); acc0 = __builtin_amdgcn_mfma_f32_32x32x16_bf16(wh, alo, acc0, 0, 0, 0); }
                        else         { acc1 = __builtin_amdgcn_mfma_f32_32x32x16_bf16(wh, ahi, acc1, 0, 0, 0); acc1 = __builtin_amdgcn_mfma_f32_32x32x16_bf16(wl, ahi, acc1, 0, 0, 0); acc1 = __builtin_amdgcn_mfma_f32_32x32x16_bf16(wh, alo, acc1, 0, 0, 0); } } }
#pragma unroll
                  for (int q = 0; q < 16; ++q) { const int e = (q & 3) + 8 * (q >> 2) + 4 * kh;
                      sm[5120 + ((wave * 2 + 0) * 32 + e) * 32 + r] = acc0[q]; sm[5120 + ((wave * 2 + 1) * 32 + e) * 32 + r] = acc1[q]; } }
                __syncthreads();
                { const int tk6 = tid & 63, eq = tid >> 6, rg = tk6 >> 5, tk = tk6 & 31;
#pragma unroll
                  for (int i = 0; i < 4; ++i) { const int e = eq * 4 + i; float s = 0.f;
#pragma unroll
                      for (int w = 0; w < 8; ++w) s += sm[5120 + ((w * 2 + rg) * 32 + e) * 32 + tk];
                      sm[5120 + 16384 + tk6 * 33 + e] = 1.f / (1.f + __expf(-s)); } }
                __syncthreads();
                if (tid < 64) { const int t = t0 + tid;
                    float lg[32];
#pragma unroll
                    for (int e = 0; e < 32; ++e) lg[e] = sm[5120 + 16384 + tid * 33 + e];
                    int grp = 0; float best = -INFINITY;
#pragma unroll
                    for (int gq = 0; gq < 4; ++gq) { float m1 = -INFINITY, m2 = -INFINITY;
#pragma unroll
                        for (int i = 0; i < 8; ++i) { const float b = lg[gq * 8 + i] + sm[4160 + gq * 8 + i]; if (b > m1) { m2 = m1; m1 = b; } else if (b > m2) m2 = b; }
                        const float sgs = m1 + m2; if (sgs > best) { best = sgs; grp = gq; } }
                    float m1 = -INFINITY, m2 = -INFINITY, s1 = 0.f, s2 = 0.f; int i1 = 0, i2 = 0;
#pragma unroll
                    for (int e = 0; e < 32; ++e) { const bool ing = (e >> 3) == grp; const float b = lg[e] + sm[4160 + e];
                        if (ing && b > m1) { m2 = m1; i2 = i1; s2 = s1; m1 = b; i1 = e; s1 = lg[e]; } else if (ing && b > m2) { m2 = b; i2 = e; s2 = lg[e]; } }
                    const float inv = 1.f / (s1 + s2);
                    const unsigned p1 = atomicAdd(CNT + i1 * CSTR, 1u), p2 = atomicAdd(CNT + i2 * CSTR, 1u);
                    TOKIDX[(size_t)i1 * ECAP + p1] = t; TOKIDX[(size_t)i2 * ECAP + p2] = t; WTS[(size_t)i1 * ECAP + p1] = s1 * inv; WTS[(size_t)i2 * ECAP + p2] = s2 * inv;
                    *(int4*)(TE + 4 * t) = make_int4(i1, (int)p1, i2, (int)p2);
                }
            }
            if (BOTH(pb + 10)) GRID_BAR();
        }
        if (IN(pb + 11)) {
            PH_IDS(); ArgsP ap = AP(); unsigned char* ws = ap->ws;
            LOAD_MOETAB((unsigned*)(CTLP(ws) + CW_CNT) + l * 32 * CSTR, 4);
            pg8::Gemm g{(const bf16*)(ws + WS_H), (const bf16*)(ws + WS_WGUT), 0, 0, D_}; MoeOrder<true> So{moetab, 4, G, bid, 4, l * 32 * 4, (const int*)(ws + WS_TOKIDX)};
            EpiGateUp E{(bf16*)(ws + WS_HACT)};
            pg8::gemm_phase<EpiGateUp, MoeOrder<true>, true, true>(lds, g, So, E);
            if (BOTH(pb + 11)) GRID_BAR();
        }
        if (IN(pb + 12)) {
            PH_IDS(); ArgsP ap = AP(); unsigned char* ws = ap->ws;
            LOAD_MOETAB((unsigned*)(CTLP(ws) + CW_CNT) + l * 32 * CSTR, 8);
            pg8::Gemm g{(const bf16*)(ws + WS_HACT), (const bf16*)(ws + WS_WDT), 0, 0, DEXP}; MoeOrder<false> So{moetab, 8, G, bid, 8, l * 32 * 8, nullptr};
            EpiDown E{(bf16*)(ws + WS_Y), (const float*)(ws + WS_WTS), moetab};
            pg8::gemm_phase<EpiDown, MoeOrder<false>, true, true>(lds, g, So, E);
            if (BOTH(pb + 12)) GRID_BAR();
        }
    }
    if (IN(NPH - 1)) {
        PH_IDS(); ArgsP ap = AP(); unsigned char* ws = ap->ws;
        float* X = ap->out; const bf16* Y = (const bf16*)(ws + WS_Y); const int* TE = (const int*)(ws + WS_TE);
        LOAD_MOETAB((unsigned*)(CTLP(ws) + CW_CNT) + 32 * CSTR, 1);
        const bool tmo_set = (MK_N_LAUNCHES == 1) && (__hip_atomic_load((unsigned*)(CTLP(ws) + CW_BAR) + XB_TMO, RLX_AGENT) != 0u);
        { const float* g_final = ap->in[17]; const float* MOD = (const float*)(CTLP(ws) + CW_MOD);
          for (int k = tid; k < D_; k += NTHR) { sm[k] = g_final[k]; sm[2048 + k] = MOD[12288 + 10240 + k]; } }
        __syncthreads();
        for (int t = gw; t < S_; t += NGW) {
            f32x4 v[8]; float ss = 0.f;
            const int4 te = *(const int4*)(TE + 4 * t);
            const bf16* y0 = Y + (size_t)(moetab[65 + te.x] + te.y) * D_; const bf16* y1 = Y + (size_t)(moetab[65 + te.z] + te.w) * D_;
#pragma unroll
            for (int j = 0; j < 8; ++j) { const int k = 256 * j + 4 * lane; const uint2 a = *(const uint2*)(y0 + k), b = *(const uint2*)(y1 + k);
                const f32x4 gt2 = *(const LAS f32x4*)(sm + 2048 + k);
                f32x4 ysum = (f32x4){bflo(a.x) + bflo(b.x), bfhi(a.x) + bfhi(b.x), bflo(a.y) + bflo(b.y), bfhi(a.y) + bfhi(b.y)};
                v[j] = *(const f32x4*)(X + (size_t)t * D_ + k) + gt2 * ysum;
                ss += (v[j][0] * v[j][0] + v[j][1] * v[j][1]) + (v[j][2] * v[j][2] + v[j][3] * v[j][3]); }
            const float rstd = (tmo_set ? __builtin_nanf("") : 1.f) / sqrtf(wave_sum(ss, lane) * (1.f / D_) + RMS_EPS);
#pragma unroll
            for (int j = 0; j < 8; ++j) { const int k = 256 * j + 4 * lane; *(f32x4*)(X + (size_t)t * D_ + k) = v[j] * rstd * *(const LAS f32x4*)(sm + k); }
        }
    }
#undef IN
#undef BOTH
#undef GRID_BAR
#undef LOAD_MOETAB
#undef AP
#undef CTLP
#undef PH_IDS
}

extern "C" void kernel_launch(void* const* d_in, const int* in_sizes, int n_in, void* d_out, int out_size, void* d_ws, size_t ws_size, hipStream_t stream) {
    static int grid = 0;
    if (grid == 0) {
        if (n_in != 18 || out_size != S_ * D_ || ws_size < WS_END) { fprintf(stderr, "kernel_launch: unexpected shapes (n_in %d out %d ws %zu)\n", n_in, out_size, ws_size); grid = -1; return; }
        int dev = 0, cus = 0, per_cu = 0;
        if (hipGetDevice(&dev) != hipSuccess || hipDeviceGetAttribute(&cus, hipDeviceAttributeMultiprocessorCount, dev) != hipSuccess) { grid = -1; return; }
        if (hipFuncSetAttribute((const void*)mk_fwd, hipFuncAttributeMaxDynamicSharedMemorySize, LDS_BYTES) != hipSuccess) { fprintf(stderr, "kernel_launch: hipFuncSetAttribute failed\n"); grid = -1; return; }
        if (hipOccupancyMaxActiveBlocksPerMultiprocessor(&per_cu, (const void*)mk_fwd, NTHR, LDS_BYTES) != hipSuccess || per_cu < 1) { fprintf(stderr, "kernel_launch: occupancy query says %d\n", per_cu); }
        (void)hipGetLastError();
        grid = cus;
    }
    if (grid < 0) return;
    if (hipMemsetAsync((char*)d_ws + WS_CTL, 0, CTL_ZERO_BYTES, stream) != hipSuccess) return;
    Args a{};
    for (int i = 0; i < 18; ++i) a.in[i] = (const float*)d_in[i];
    a.out = (float*)d_out; a.ws = (unsigned char*)d_ws; a.pad = 0;
    if (MK_N_LAUNCHES == 1) {
        a.ph_lo = 0; a.ph_hi = NPH; a.li = 0;
        hipLaunchKernelGGL(mk_fwd, dim3(grid), dim3(NTHR), LDS_BYTES, stream, a);
    } else {
        for (int p = 0; p < NPH; ++p) { a.ph_lo = p; a.ph_hi = p + 1; a.li = p; hipLaunchKernelGGL(mk_fwd, dim3(grid), dim3(NTHR), LDS_BYTES, stream, a); }
    }
}
```

```cpp
#include <hip/hip_runtime.h>
#include <cstdio>
#include <cstdint>


#define WIDTAB_OFF (131072 + 1024)
__device__ __forceinline__ int wg_tid(const __attribute__((address_space(3))) int* widtab) {
    unsigned hw; asm volatile("s_getreg_b32 %0, hwreg(HW_REG_HW_ID, 0, 6)" : "=s"(hw));
    int lane; asm volatile("v_mbcnt_lo_u32_b32 %0, -1, 0\n\tv_mbcnt_hi_u32_b32 %0, -1, %0" : "=v"(lane));
    return widtab[hw] * 64 + lane;
}

namespace pg8 {
#define PG8_LAS __attribute__((address_space(3)))
typedef unsigned short bf16_t;
typedef short bf16x8 __attribute__((ext_vector_type(8)));
typedef float f32x4 __attribute__((ext_vector_type(4)));
typedef unsigned u32x4 __attribute__((ext_vector_type(4)));
constexpr int BM = 256, BK = 64, HALF = 128, HTB = HALF * BK * 2, STAGE_BYTES = 8 * HTB, NXCD = 8, WGM = 8;

__host__ __device__ __forceinline__ int lds_byte(int r, int c) { const int st = (r >> 4) * 2 + (c >> 5), rr = r & 15, cc = c & 31, ob = rr * 64 + cc * 2; return st * 1024 + (ob ^ (((ob >> 9) & 1) << 5)); }
__host__ __device__ __forceinline__ void stage_rc(int b, int& R, int& C) { const int st = b / 1024, sb = b % 1024, swz = sb ^ (((sb >> 9) & 1) << 5); R = (st >> 1) * 16 + swz / 64; C = (st & 1) * 32 + (swz % 64) / 2; }
__host__ __device__ __forceinline__ int perm32(int rho) { const int n = rho >> 4, i = rho & 15; return 8 * (i >> 2) + 4 * n + (i & 3); }

struct Unit { int pm, pn, e, mt, pnl; };
struct Gemm { const bf16_t* A; const bf16_t* Bt; int M, N, K; };

struct StaticOrder {
    static constexpr bool GATHER = false;
    int nM, nN, nwg, G, c;
    __host__ __device__ void init(int M, int N, int G_, int c_) { nM = M / BM; nN = N / BM; nwg = nM * nN; G = G_; c = c_; }
    __host__ __device__ bool next(int i, Unit& u) const {
        const long L = (long)i * G + c; if (L >= nwg) return false;
        int wgid = (int)L; { const int q = nwg / NXCD, r = nwg % NXCD, xcd = wgid % NXCD, off = wgid / NXCD; wgid = (xcd < r ? xcd * (q + 1) : r * (q + 1) + (xcd - r) * q) + off; }
        const int nig = WGM * nN, gid = wgid / nig, fm = gid * WGM, gsz = (nM - fm) < WGM ? (nM - fm) : WGM;
        u.pm = fm + ((wgid % nig) % gsz); u.pn = (wgid % nig) / gsz; u.e = 0; u.mt = 0; u.pnl = u.pn; return true;
    }
    __device__ __forceinline__ void a_offs(const Unit&, int, int, int, int, int, unsigned (&)[2][2]) const {}
    __device__ __forceinline__ void a_ready(const Unit&) const {}
    __device__ __forceinline__ void done(const Unit&) const {}
};

__device__ __forceinline__ unsigned cvt_pk_bf16(float lo, float hi) { unsigned r; asm volatile("v_cvt_pk_bf16_f32 %0, %1, %2" : "=v"(r) : "v"(lo), "v"(hi)); return r; }

template <class Epi, class Sched, bool ALIGN_EPI = false, bool SP2 = false>
__device__ __forceinline__ void gemm_phase(PG8_LAS unsigned char* lds, const Gemm g, const Sched& S, const Epi& E) {
    const int tid_ = wg_tid((const PG8_LAS int*)(lds + WIDTAB_OFF));
    const int tid = tid_, wid = __builtin_amdgcn_readfirstlane(tid >> 6), lane = tid & 63, wr = wid >> 2, wc = wid & 3, fr = lane & 15, fq = lane >> 4;
    const int K = g.K, nt = K / BK;
    unsigned voffA[2], voffB[2]; int RR[2], CC[2];
#pragma unroll
    for (int i = 0; i < 2; ++i) { int R, C; stage_rc(tid * 16 + i * 8192, R, C); const int Rb = Epi::PERM ? ((R & ~31) + perm32(R & 31)) : R;
        RR[i] = R; CC[i] = C; voffA[i] = (unsigned)(R * K + C) * 2u; voffB[i] = (unsigned)(Rb * K + C) * 2u; }
    const size_t kstep = (size_t)(BK * 2);
    const size_t hstep = (size_t)HALF * K * 2;
    const size_t tstep = 2 * hstep;
    const unsigned ldsw = (unsigned)wid * 1024u;
    const int aoff = lds_byte(wr * 64 + fr, fq * 8), boff = lds_byte(wc * 32 + fr, fq * 8);
    const char* gA = (const char*)g.A;
    unsigned aoC[2][2] = {{0u, 0u}, {0u, 0u}}, aoN[2][2] = {{0u, 0u}, {0u, 0u}};
#define PG8_SA(b, h) (((b) * 2 + (h)) * HTB)
#define PG8_SB(b, h) ((4 + (b) * 2 + (h)) * HTB)
#define PG8_STAGE(bufoff, gbase, voff) do { _Pragma("unroll") for (int _i = 0; _i < 2; ++_i) \
        __builtin_amdgcn_global_load_lds((const unsigned*)((const char*)(gbase) + (voff)[_i]), (PG8_LAS unsigned*)(lds + (bufoff) + ldsw + _i * 8192), 16, 0, 0); } while (0)
#define PG8_STAGE_A(bufoff, h, PN, KO) do { if constexpr (Sched::GATHER) { _Pragma("unroll") for (int _i = 0; _i < 2; ++_i) \
        __builtin_amdgcn_global_load_lds((const unsigned*)(gA + aoC[h][_i] + (KO)), (PG8_LAS unsigned*)(lds + (bufoff) + ldsw + _i * 8192), 16, 0, 0); } \
        else { PG8_STAGE(bufoff, (PN) + (h) * hstep, voffA); } } while (0)
#define PG8_LDA(dst, b, h) do { _Pragma("unroll") for (int m = 0; m < 4; ++m) _Pragma("unroll") for (int k = 0; k < 2; ++k) dst[m][k] = *(const PG8_LAS bf16x8*)(lds + PG8_SA(b, h) + aoff + m * 2048 + k * 1024); } while (0)
#define PG8_LDB(dst, b, h) do { _Pragma("unroll") for (int n = 0; n < 2; ++n) _Pragma("unroll") for (int k = 0; k < 2; ++k) dst[n][k] = *(const PG8_LAS bf16x8*)(lds + PG8_SB(b, h) + boff + n * 2048 + k * 1024); } while (0)
#define PG8_MMA(ai, bj, At, Bt) do { __builtin_amdgcn_s_setprio(1); _Pragma("unroll") for (int m = 0; m < 4; ++m) _Pragma("unroll") for (int n = 0; n < 2; ++n) _Pragma("unroll") for (int k = 0; k < 2; ++k) \
        acc[ai][bj][m][n] = __builtin_amdgcn_mfma_f32_16x16x32_bf16(Bt[n][k], At[m][k], acc[ai][bj][m][n], 0, 0, 0); __builtin_amdgcn_s_setprio(0); } while (0)
#define PG8_WAIT_V(n) asm volatile("s_waitcnt vmcnt(" #n ")" ::: "memory")
#define PG8_WAIT_L(n) asm volatile("s_waitcnt lgkmcnt(" #n ")" ::: "memory")
#define PG8_BAR __builtin_amdgcn_s_barrier()
#define PG8_SCHED __builtin_amdgcn_sched_barrier(0)
    Unit cur, nxt; int ui = 0;
    if (!S.next(0, cur)) return;
    f32x4 acc[2][2][4][2];
#pragma unroll
    for (int a = 0; a < 2; ++a)
#pragma unroll
        for (int b = 0; b < 2; ++b)
#pragma unroll
            for (int m = 0; m < 4; ++m)
#pragma unroll
                for (int n = 0; n < 2; ++n) acc[a][b][m][n] = (f32x4){0.f, 0.f, 0.f, 0.f};
    bf16x8 At[4][2], B0[2][2], B1[2][2];
    const char* cA = (const char*)g.A + (size_t)cur.pm * tstep; const char* cB = (const char*)g.Bt + (size_t)cur.pn * tstep;
    if constexpr (Sched::GATHER) S.a_offs(cur, RR[0], RR[1], CC[0], CC[1], K, aoC);
    S.a_ready(cur);
    if constexpr (SP2) {
        PG8_STAGE(PG8_SB(0, 0), cB, voffB); PG8_STAGE(PG8_SB(0, 1), cB + hstep, voffB); PG8_STAGE_A(PG8_SA(0, 0), 0, cA, 0); PG8_STAGE_A(PG8_SA(0, 1), 1, cA, 0);
        if (wr == 1) PG8_BAR;
        PG8_WAIT_V(2); PG8_BAR;
        PG8_STAGE(PG8_SB(1, 0), cB + kstep, voffB); PG8_STAGE_A(PG8_SA(1, 0), 0, cA + kstep, kstep); PG8_STAGE(PG8_SB(1, 1), cB + hstep + kstep, voffB);
        PG8_WAIT_V(6); PG8_BAR;
    } else {
        PG8_STAGE(PG8_SB(0, 0), cB, voffB); PG8_STAGE_A(PG8_SA(0, 0), 0, cA, 0); PG8_STAGE(PG8_SB(0, 1), cB + hstep, voffB); PG8_STAGE_A(PG8_SA(0, 1), 1, cA, 0);
        if (wr == 1) PG8_BAR;
        PG8_WAIT_V(4); PG8_BAR;
        PG8_STAGE(PG8_SB(1, 0), cB + kstep, voffB); PG8_STAGE_A(PG8_SA(1, 0), 0, cA + kstep, kstep); PG8_STAGE(PG8_SB(1, 1), cB + hstep + kstep, voffB);
        PG8_WAIT_V(6); PG8_BAR;
    }
    for (;;) {
        const bool has_next = S.next(ui + 1, nxt);
        const char* nA = has_next ? (const char*)g.A + (size_t)nxt.pm * tstep : cA; const char* nB = has_next ? (const char*)g.Bt + (size_t)nxt.pn * tstep : cB;
        if constexpr (Sched::GATHER) {
            if (has_next) S.a_offs(nxt, RR[0], RR[1], CC[0], CC[1], K, aoN);
            else {
#pragma unroll
                for (int h = 0; h < 2; ++h)
#pragma unroll
                    for (int i = 0; i < 2; ++i) aoN[h][i] = aoC[h][i]; }
        }
        for (int t = 0; t < nt; t += 2) {
            const bool last = (t == nt - 2);
            const char* a1 = cA + (size_t)(t + 1) * kstep;
            const char* a2 = last ? nA : cA + (size_t)(t + 2) * kstep; const char* b2 = last ? nB : cB + (size_t)(t + 2) * kstep;
            const char* a3 = a2 + kstep; const char* b3 = b2 + kstep;
            const size_t k1 = (size_t)(t + 1) * kstep, k2 = last ? (size_t)0 : (size_t)(t + 2) * kstep, k3 = k2 + kstep;
            if (last && has_next) S.a_ready(nxt);
            if constexpr (SP2) {
            PG8_LDB(B0, 0, 0); PG8_LDB(B1, 0, 1); PG8_SCHED; PG8_LDA(At, 0, 0); PG8_STAGE_A(PG8_SA(1, 1), 1, a1, k1);
            if constexpr (Sched::GATHER) { if (last) {
#pragma unroll
                for (int h = 0; h < 2; ++h)
#pragma unroll
                    for (int i = 0; i < 2; ++i) aoC[h][i] = aoN[h][i]; } }
            PG8_WAIT_V(8); PG8_WAIT_L(0); PG8_BAR; PG8_MMA(0, 0, At, B0); PG8_MMA(0, 1, At, B1); PG8_BAR; PG8_SCHED;
            PG8_LDA(At, 0, 1); PG8_STAGE(PG8_SB(0, 0), b2, voffB); PG8_STAGE(PG8_SB(0, 1), b2 + hstep, voffB); PG8_STAGE_A(PG8_SA(0, 0), 0, a2, k2);
            PG8_WAIT_V(8); PG8_WAIT_L(0); PG8_BAR; PG8_MMA(1, 0, At, B0); PG8_MMA(1, 1, At, B1); PG8_BAR; PG8_SCHED;
            PG8_LDB(B0, 1, 0); PG8_LDB(B1, 1, 1); PG8_SCHED; PG8_LDA(At, 1, 0); PG8_STAGE_A(PG8_SA(0, 1), 1, a2, k2);
            PG8_WAIT_V(8); PG8_WAIT_L(0); PG8_BAR; PG8_MMA(0, 0, At, B0); PG8_MMA(0, 1, At, B1); PG8_BAR; PG8_SCHED;
            PG8_LDA(At, 1, 1); PG8_STAGE(PG8_SB(1, 0), b3, voffB); PG8_STAGE(PG8_SB(1, 1), b3 + hstep, voffB); PG8_STAGE_A(PG8_SA(1, 0), 0, a3, k3);
            PG8_WAIT_V(8); PG8_WAIT_L(0); PG8_BAR; PG8_MMA(1, 0, At, B0); PG8_MMA(1, 1, At, B1); PG8_BAR; PG8_SCHED;
            } else {
            PG8_LDB(B0, 0, 0); PG8_SCHED; PG8_LDA(At, 0, 0); PG8_STAGE_A(PG8_SA(1, 1), 1, a1, k1);
            if constexpr (Sched::GATHER) { if (last) {
#pragma unroll
                for (int h = 0; h < 2; ++h)
#pragma unroll
                    for (int i = 0; i < 2; ++i) aoC[h][i] = aoN[h][i]; } }
            PG8_WAIT_L(8); PG8_BAR; PG8_WAIT_L(0); PG8_MMA(0, 0, At, B0); PG8_BAR; PG8_SCHED;
            PG8_LDB(B1, 0, 1); PG8_STAGE(PG8_SB(0, 0), b2, voffB);
            PG8_BAR; PG8_WAIT_L(0); PG8_MMA(0, 1, At, B1); PG8_BAR;
            PG8_LDA(At, 0, 1); PG8_STAGE_A(PG8_SA(0, 0), 0, a2, k2);
            PG8_BAR; PG8_WAIT_L(0); PG8_MMA(1, 0, At, B0); PG8_BAR; PG8_SCHED;
            PG8_STAGE(PG8_SB(0, 1), b2 + hstep, voffB);
            PG8_WAIT_V(6); PG8_BAR; PG8_MMA(1, 1, At, B1); PG8_BAR;
            PG8_LDB(B0, 1, 0); PG8_SCHED; PG8_LDA(At, 1, 0); PG8_STAGE_A(PG8_SA(0, 1), 1, a2, k2);
            PG8_WAIT_L(8); PG8_BAR; PG8_WAIT_L(0); PG8_MMA(0, 0, At, B0); PG8_BAR; PG8_SCHED;
            PG8_LDB(B1, 1, 1); PG8_STAGE(PG8_SB(1, 0), b3, voffB);
            PG8_BAR; PG8_WAIT_L(0); PG8_MMA(0, 1, At, B1); PG8_BAR;
            PG8_LDA(At, 1, 1); PG8_STAGE_A(PG8_SA(1, 0), 0, a3, k3);
            PG8_BAR; PG8_WAIT_L(0); PG8_MMA(1, 0, At, B0); PG8_BAR; PG8_SCHED;
            PG8_STAGE(PG8_SB(1, 1), b3 + hstep, voffB);
            PG8_WAIT_V(6); PG8_BAR; PG8_MMA(1, 1, At, B1); PG8_BAR;
            }
        }
        if constexpr (ALIGN_EPI) { if (wr == 0) PG8_BAR; }
        E(acc, cur, wr, wc, fr, fq); S.done(cur);
        if (!has_next) break;
#pragma unroll
        for (int a = 0; a < 2; ++a)
#pragma unroll
            for (int b = 0; b < 2; ++b)
#pragma unroll
                for (int m = 0; m < 4; ++m)
#pragma unroll
                    for (int n = 0; n < 2; ++n) acc[a][b][m][n] = (f32x4){0.f, 0.f, 0.f, 0.f};
        cur = nxt; cA = nA; cB = nB; ++ui;
        if constexpr (ALIGN_EPI) { if (wr == 1) PG8_BAR; }
    }
    PG8_WAIT_V(0);
    if constexpr (!ALIGN_EPI) { if (wr == 0) PG8_BAR; }
    PG8_BAR;
#undef PG8_SA
#undef PG8_SB
#undef PG8_STAGE
#undef PG8_STAGE_A
#undef PG8_LDA
#undef PG8_LDB
#undef PG8_MMA
#undef PG8_WAIT_V
#undef PG8_WAIT_L
#undef PG8_BAR
#undef PG8_SCHED
}
}

#ifndef MK_N_LAUNCHES
#define MK_N_LAUNCHES 1
#endif
constexpr int NWAVES = 8, NTHR = 512;
constexpr int S_ = 16384, D_ = 2048, DEPTH = 2, HD = 128;
constexpr int IN_W = 5656, NIN = 5888;
constexpr int NC = 1023;
constexpr int NEXP = 32, DEXP = 512, ECAP = 16384, NSLOT = 40960;
constexpr float RMS_EPS = 1e-6f;
constexpr float ATT_SCALE = 0.08838834764831845f;
constexpr int NPL = 13, NPH = 2 + 2 * NPL;

constexpr size_t MiB = 1u << 20;
constexpr size_t WS_CTL = 0, CTL_ZERO_BYTES = 1 * MiB;
constexpr size_t WS_ROPE = 1 * MiB, WS_WINT = 9 * MiB, WS_WOUTT = 55 * MiB, WS_WGUT = 71 * MiB, WS_WDT = 327 * MiB, WS_WC1T = 455 * MiB;
constexpr size_t WS_H = 463 * MiB, WS_QN = 527 * MiB, WS_QM = 559 * MiB, WS_KM = 591 * MiB, WS_VM = 623 * MiB;
constexpr size_t WS_KC = 655 * MiB, WS_VC = 663 * MiB, WS_KS = 671 * MiB, WS_VS = 679 * MiB, WS_KW = 687 * MiB, WS_VW = 695 * MiB;
constexpr size_t WS_GATES = 703 * MiB, WS_UL = 705 * MiB, WS_KCMP = 713 * MiB, WS_VCMP = 713 * MiB + 512 * 1024, WS_KMEAN = 714 * MiB;
constexpr size_t WS_OMIX = 715 * MiB, WS_OCMP = 779 * MiB, WS_OWIN = 811 * MiB, WS_SEL = 843 * MiB, WS_TE = 845 * MiB, WS_TOKIDX = 846 * MiB, WS_WTS = 848 * MiB;
constexpr size_t WS_HACT = 850 * MiB, WS_Y = 890 * MiB;
constexpr size_t WS_WRT = 714 * MiB + 256 * 1024;
constexpr size_t WS_IMP = WS_H + 32 * MiB;
constexpr size_t WS_NLIST = WS_H, WS_PSLC = 850 * MiB, WS_LSEN = 1106 * MiB;
constexpr size_t WS_MLIST = 1050 * MiB, WS_PSEL = 1082 * MiB, WS_POWN = 1178 * MiB, WS_LSES = 1210 * MiB, WS_LSEO = 1211 * MiB + 512 * 1024, WS_END = 1212 * MiB;
constexpr int CW_TMO = 0, CW_BAR = 4096, CW_CNT = 8192, CW_MOD = 16384, CW_B1E = 40960, CW_MCNT = 65536, CW_NCNT = 131072, CSTR = 64;

constexpr int RING_BYTES = 131072, LDSCTL_OFF = RING_BYTES, MISC_OFF = LDSCTL_OFF + 320, MOETAB_OFF = LDSCTL_OFF + 512, LDS_BYTES = 147456;

#define GAS __attribute__((address_space(1)))
#define LAS __attribute__((address_space(3)))
typedef unsigned short bf16;
typedef unsigned v4u __attribute__((ext_vector_type(4)));
typedef float f32x4 __attribute__((ext_vector_type(4)));
typedef float f32x2 __attribute__((ext_vector_type(2)));
typedef GAS unsigned gu32;
#define RLX_AGENT __ATOMIC_RELAXED, __HIP_MEMORY_SCOPE_AGENT
#define LDS_WAIT() asm volatile("s_waitcnt lgkmcnt(0)" ::: "memory")
__device__ __forceinline__ unsigned f2bf(float f) { unsigned u = __builtin_bit_cast(unsigned, f); return (u + 0x7fffu + ((u >> 16) & 1u)) >> 16; }
__device__ __forceinline__ unsigned pk2(float lo, float hi) { return f2bf(lo) | (f2bf(hi) << 16); }
__device__ __forceinline__ float bf2f(unsigned b) { return __builtin_bit_cast(float, b << 16); }
__device__ __forceinline__ float bflo(unsigned w) { return __builtin_bit_cast(float, w << 16); }
__device__ __forceinline__ float bfhi(unsigned w) { return __builtin_bit_cast(float, w & 0xffff0000u); }

#define XB_TMO      128
#define XB_XCNT(j)  (256  + 64 * (j))
#define XB_XSUB(j)  (1280 + 64 * (j))
#define XB_XGEN(j)  (2304 + 64 * (j))
#define XB_TOP      3328
#define XB_TOPGEN   3392
#define XCD_BAR_WORDS 3456
#define XB_SPIN_CAP (1u << 20)
__device__ __forceinline__ unsigned xb_ld(unsigned* p)              { return __hip_atomic_load(p, __ATOMIC_RELAXED, __HIP_MEMORY_SCOPE_AGENT); }
__device__ __forceinline__ unsigned xb_add(unsigned* p, unsigned v) { return __hip_atomic_fetch_add(p, v, __ATOMIC_RELAXED, __HIP_MEMORY_SCOPE_AGENT); }
__device__ __forceinline__ unsigned xb_xcc_id() { return (unsigned)__builtin_amdgcn_s_getreg((3 << 11) | 20) & 0xFu; }
#define XB_SPIN(cond, bar) do { unsigned _sp = 0; while (cond) { __builtin_amdgcn_s_sleep(1); \
    if ((++_sp & 255u) == 0u) { if (xb_ld(&(bar)[XB_TMO])) break; if (_sp > XB_SPIN_CAP) { atomicAdd(&(bar)[XB_TMO], 1u); break; } } } } while (0)
struct XcdBarrier { unsigned* bar; unsigned x; volatile LAS unsigned* st; };
__device__ __forceinline__ XcdBarrier xcd_barrier_post(unsigned* bar, volatile LAS unsigned* st) {
    XcdBarrier b; b.bar = bar; b.x = xb_xcc_id(); b.st = st;
    if (threadIdx.x == 0) (void)xb_add(&bar[XB_XCNT(b.x)], 1u);
    return b;
}
__device__ __forceinline__ void xcd_barrier_complete(unsigned* bar, unsigned x, unsigned& nloc, unsigned& nx) {
    const unsigned G = gridDim.x * gridDim.y * gridDim.z;
    unsigned sum, cnt, mine, sp = 0u;
    for (;;) {
        sum = 0u; cnt = 0u; mine = 0u;
#pragma unroll
        for (unsigned j = 0; j < 16; ++j) { const unsigned c = xb_ld(&bar[XB_XCNT(j)]); sum += c; cnt += (c > 0u) ? 1u : 0u; mine = (j == x) ? c : mine; }
        if (sum == G) break;
        __builtin_amdgcn_s_sleep(1);
        if ((++sp & 255u) == 0u) { if (xb_ld(&bar[XB_TMO])) break; if (sp > XB_SPIN_CAP) { atomicAdd(&bar[XB_TMO], 1u); break; } }
    }
    nloc = mine > 0u ? mine : 1u; nx = cnt > 0u ? cnt : 1u;
}
__device__ __forceinline__ void xcd_barrier(const XcdBarrier& b, bool leader  ) {
    asm volatile("s_waitcnt vmcnt(0)" ::: "memory");
    __syncthreads();
    if (leader) {
        unsigned* bar = b.bar;
        __builtin_amdgcn_s_waitcnt(0);
        unsigned nloc = b.st[0], nx = b.st[1];
        if (nloc == 0u) { xcd_barrier_complete(bar, b.x, nloc, nx); b.st[0] = nloc; b.st[1] = nx; }
        const unsigned old = xb_add(&bar[XB_XSUB(b.x)], 1u);
        const unsigned gen = old / nloc;
        if (old + 1u == (gen + 1u) * nloc) {
            __builtin_amdgcn_fence(__ATOMIC_RELEASE, "agent");
            asm volatile("s_waitcnt vmcnt(0)" ::: "memory");
            const unsigned og = xb_add(&bar[XB_TOP], 1u);
            const unsigned tg = og / nx;
            if (og + 1u == (tg + 1u) * nx) xb_add(&bar[XB_TOPGEN], 1u);
            else XB_SPIN(xb_ld(&bar[XB_TOPGEN]) == tg, bar);
            __builtin_amdgcn_fence(__ATOMIC_ACQUIRE, "agent");
            xb_add(&bar[XB_XGEN(b.x)], 1u);
            asm volatile("s_waitcnt vmcnt(0)" ::: "memory");
        } else {
            XB_SPIN(xb_ld(&bar[XB_XGEN(b.x)]) == gen, bar);
            __builtin_amdgcn_fence(__ATOMIC_ACQUIRE, "agent");
            asm volatile("s_waitcnt vmcnt(0)" ::: "memory");
        }
    }
    __syncthreads();
}

__device__ __forceinline__ float lane_get(float v, int src) { return __builtin_bit_cast(float, __builtin_amdgcn_ds_bpermute(src << 2, __builtin_bit_cast(int, v))); }
__device__ __forceinline__ int lane_geti(int v, int src) { return __builtin_amdgcn_ds_bpermute(src << 2, v); }
__device__ __forceinline__ float wave_sum(float v, int lane) {
#pragma unroll
    for (int o = 1; o < 64; o <<= 1) v += lane_get(v, lane ^ o);
    return v;
}
__device__ __forceinline__ int block_excl_scan(int v, LAS int* scr, int tid, int* tot) {
    const int lane = tid & 63, wv = tid >> 6; int s = v;
#pragma unroll
    for (int o = 1; o < 64; o <<= 1) { const int n = lane_geti(s, lane - o); if (lane >= o) s += n; }
    if (lane == 63) scr[wv] = s;
    __syncthreads();
    int off = 0, all = 0;
#pragma unroll
    for (int w = 0; w < 8; ++w) { const int x = scr[w]; all += x; off += (w < wv) ? x : 0; }
    *tot = all;
    __syncthreads();
    return off + s - v;
}

__device__ __forceinline__ float row_max16(float v) {
    v = fmaxf(v, __builtin_bit_cast(float, __builtin_amdgcn_update_dpp(0, __builtin_bit_cast(int, v), 0xB1, 0xF, 0xF, false)));
    v = fmaxf(v, __builtin_bit_cast(float, __builtin_amdgcn_update_dpp(0, __builtin_bit_cast(int, v), 0x4E, 0xF, 0xF, false)));
    v = fmaxf(v, __builtin_bit_cast(float, __builtin_amdgcn_update_dpp(0, __builtin_bit_cast(int, v), 0x124, 0xF, 0xF, false)));
    v = fmaxf(v, __builtin_bit_cast(float, __builtin_amdgcn_update_dpp(0, __builtin_bit_cast(int, v), 0x128, 0xF, 0xF, false)));
    return v;
}
__device__ __forceinline__ int row_min16(int v) {
    v = min(v, __builtin_amdgcn_update_dpp(0, v, 0xB1, 0xF, 0xF, false));
    v = min(v, __builtin_amdgcn_update_dpp(0, v, 0x4E, 0xF, 0xF, false));
    v = min(v, __builtin_amdgcn_update_dpp(0, v, 0x124, 0xF, 0xF, false));
    v = min(v, __builtin_amdgcn_update_dpp(0, v, 0x128, 0xF, 0xF, false));
    return v;
}
template <int NV>
__device__ __forceinline__ int row_pick(float (&v)[NV], int lam) {
    float m = v[0];
#pragma unroll
    for (int i = 1; i < NV; ++i) m = fmaxf(m, v[i]);
    m = row_max16(m);
    int idx = 1 << 20;
#pragma unroll
    for (int i = NV - 1; i >= 0; --i) idx = (v[i] == m) ? lam + 16 * i : idx;
    idx = row_min16(idx);
    if (m == -INFINITY) idx = -1;
#pragma unroll
    for (int i = 0; i < NV; ++i) v[i] = (lam + 16 * i == idx) ? -INFINITY : v[i];
    return idx;
}

__device__ __forceinline__ int il(int d) { return (d < 64) ? 2 * d : 2 * (d - 64) + 1; }
__device__ __forceinline__ int inproj_row(int s) {
    if (s < 1024) return (s & ~127) + il(s & 127);
    if (s < 1536) return s;
    if (s < 1792) return (s & ~127) + il(s & 127);
    if (s < 2048) return s;
    if (s < 2304) return (s & ~127) + il(s & 127);
    if (s < 2560) return s;
    if (s < 2584) return 5632 + (s - 2560);
    if (s < 3608) { const int r = s - 2584; return 2560 + (r & ~127) + il(r & 127); }
    if (s < 4632) { const int r = s - 3608; return 3584 + (r & ~127) + il(r & 127); }
    return 4608 + (s - 4632);
}
template <int MODE>
__device__ __forceinline__ void transpose_item(const float* W, int K, int N, bf16* WT, int dpitch, int row_off, LAS float* scr, int item, int lane) {
    const int nblk = (N + 31) / 32, kb = item / nblk, nb = item % nblk, k0 = 64 * kb, n0 = 32 * nb;
    const int nsrc = n0 + (lane & 31);
#pragma unroll 8
    for (int i = 0; i < 32; ++i) { const int kk = 2 * i + (lane >> 5); scr[kk * 33 + (lane & 31)] = (nsrc < N) ? W[(size_t)(k0 + kk) * N + nsrc] : 0.f; }
    LDS_WAIT(); asm volatile("" ::: "memory");
    const int c = lane & 7;
#pragma unroll
    for (int j = 0; j < 4; ++j) { const int nl = (lane >> 3) + 8 * j, n = n0 + nl; const LAS float* s = scr + (8 * c) * 33 + nl;
        v4u o; o.x = pk2(s[0 * 33], s[1 * 33]); o.y = pk2(s[2 * 33], s[3 * 33]); o.z = pk2(s[4 * 33], s[5 * 33]); o.w = pk2(s[6 * 33], s[7 * 33]);
        if (n < N) { int dr;
            if (MODE == 0) dr = n; else if (MODE == 1) dr = inproj_row(n); else if (MODE == 2) dr = (n >> 7) * 256 + (n & 127); else dr = (n >> 7) * 256 + 128 + (n & 127);
            *(GAS v4u*)(WT + (size_t)(row_off + dr) * dpitch + k0 + 8 * c) = o; } }
    LDS_WAIT(); asm volatile("" ::: "memory");
}

using pg8::Unit;
struct EpiInProj {
    static constexpr bool PERM = true;
    bf16 *QN, *KC, *VC, *KS, *VS, *KW, *VW, *QM, *KM, *VM; float* GATES; const float* rope;
    __device__ __forceinline__ void operator()(const f32x4 (&acc)[2][2][4][2], const Unit& u, int wr, int wc, int fr, int fq) const {
        const int pn = u.pn, row0 = u.pm * 256 + wr * 64 + fr, c8 = wc * 32 + 8 * fq;
        if (pn == 22) {
            if (c8 < 24) {
#pragma unroll
                for (int ai = 0; ai < 2; ++ai)
#pragma unroll
                    for (int m = 0; m < 4; ++m) { const int row = row0 + ai * 128 + m * 16; float* gp = GATES + (size_t)row * 32 + c8;
                        f32x4 a = acc[ai][0][m][0], b = acc[ai][0][m][1], ga, gb;
#pragma unroll
                        for (int j = 0; j < 4; ++j) { ga[j] = 1.f / (1.f + __expf(-a[j])); gb[j] = 1.f / (1.f + __expf(-b[j])); }
                        *(f32x4*)gp = ga; *(f32x4*)(gp + 4) = gb; }
            }
            return;
        }
        bf16* base; int pitch; size_t bjs; bool rot;
        if (pn < 4)       { base = QN + pn * 256;        pitch = 1024; bjs = 128; rot = true; }
        else if (pn == 4) { base = KC;                   pitch = 128;  bjs = (size_t)S_ * 128; rot = false; }
        else if (pn == 5) { base = VC;                   pitch = 128;  bjs = (size_t)S_ * 128; rot = false; }
        else if (pn == 6) { base = KS;                   pitch = 256;  bjs = 128; rot = true; }
        else if (pn == 7) { base = VS;                   pitch = 256;  bjs = 128; rot = false; }
        else if (pn == 8) { base = KW;                   pitch = 256;  bjs = 128; rot = true; }
        else if (pn == 9) { base = VW;                   pitch = 256;  bjs = 128; rot = false; }
        else if (pn < 14) { base = QM + (pn - 10) * 256; pitch = 1024; bjs = 128; rot = true; }
        else if (pn < 18) { base = KM + (pn - 14) * 256; pitch = 1024; bjs = 128; rot = true; }
        else              { base = VM + (pn - 18) * 256; pitch = 1024; bjs = 128; rot = false; }
#pragma unroll
        for (int ai = 0; ai < 2; ++ai)
#pragma unroll
            for (int m = 0; m < 4; ++m) { const int row = row0 + ai * 128 + m * 16;
                f32x4 t0 = (f32x4){1.f, 0.f, 1.f, 0.f}, t1 = t0;
                if (rot) { const f32x4* tp = (const f32x4*)(rope + (size_t)row * 128 + (c8 >> 1) * 2); t0 = tp[0]; t1 = tp[1]; }
#pragma unroll
                for (int bj = 0; bj < 2; ++bj) { f32x4 v0 = acc[ai][bj][m][0], v1 = acc[ai][bj][m][1];
                    if (rot) { f32x4 w0, w1;
                        w0[0] = v0[0] * t0[0] - v0[1] * t0[1]; w0[1] = v0[1] * t0[0] + v0[0] * t0[1]; w0[2] = v0[2] * t0[2] - v0[3] * t0[3]; w0[3] = v0[3] * t0[2] + v0[2] * t0[3];
                        w1[0] = v1[0] * t1[0] - v1[1] * t1[1]; w1[1] = v1[1] * t1[0] + v1[0] * t1[1]; w1[2] = v1[2] * t1[2] - v1[3] * t1[3]; w1[3] = v1[3] * t1[2] + v1[2] * t1[3];
                        v0 = w0; v1 = w1; }
                    pg8::u32x4 w; w.x = pg8::cvt_pk_bf16(v0[0], v0[1]); w.y = pg8::cvt_pk_bf16(v0[2], v0[3]); w.z = pg8::cvt_pk_bf16(v1[0], v1[1]); w.w = pg8::cvt_pk_bf16(v1[2], v1[3]);
                    *(pg8::u32x4*)(base + (size_t)row * pitch + bj * bjs + c8) = w; } }
    }
};
struct EpiOutProj {
    static constexpr bool PERM = false;
    const float* xsrc; float* X; const float* gt;
    __device__ __forceinline__ void operator()(const f32x4 (&acc)[2][2][4][2], const Unit& u, int wr, int wc, int fr, int fq) const {
        const int row0 = u.pm * 256 + wr * 64 + fr, col0 = u.pnl * 256 + wc * 32 + 4 * fq;
        f32x4 gv[2][2];
#pragma unroll
        for (int bj = 0; bj < 2; ++bj)
#pragma unroll
            for (int n = 0; n < 2; ++n) gv[bj][n] = *(const f32x4*)(gt + col0 + bj * 128 + n * 16);
#pragma unroll
        for (int ai = 0; ai < 2; ++ai)
#pragma unroll
            for (int m = 0; m < 4; ++m) { const size_t ro = (size_t)(row0 + ai * 128 + m * 16) * D_ + col0;
#pragma unroll
                for (int bj = 0; bj < 2; ++bj)
#pragma unroll
                    for (int n = 0; n < 2; ++n) { const f32x4 xv = *(const f32x4*)(xsrc + ro + bj * 128 + n * 16); *(f32x4*)(X + ro + bj * 128 + n * 16) = xv + gv[bj][n] * acc[ai][bj][m][n]; } }
    }
};
struct EpiF32 {
    static constexpr bool PERM = false;
    float* C; int ldc;
    __device__ __forceinline__ void operator()(const f32x4 (&acc)[2][2][4][2], const Unit& u, int wr, int wc, int fr, int fq) const {
        const int row0 = u.pm * 256 + wr * 64 + fr, col0 = u.pnl * 256 + wc * 32 + 4 * fq;
#pragma unroll
        for (int ai = 0; ai < 2; ++ai)
#pragma unroll
            for (int m = 0; m < 4; ++m) { float* rowp = C + (size_t)(row0 + ai * 128 + m * 16) * ldc + col0;
#pragma unroll
                for (int bj = 0; bj < 2; ++bj)
#pragma unroll
                    for (int n = 0; n < 2; ++n) *(f32x4*)(rowp + bj * 128 + n * 16) = acc[ai][bj][m][n]; }
    }
};
struct EpiGateUp {
    static constexpr bool PERM = true;
    bf16* HACT;
    __device__ __forceinline__ void operator()(const f32x4 (&acc)[2][2][4][2], const Unit& u, int wr, int wc, int fr, int fq) const {
        const int row0 = u.pm * 256 + wr * 64 + fr, col0 = u.pnl * 128 + wc * 32 + 8 * fq;
#pragma unroll
        for (int ai = 0; ai < 2; ++ai)
#pragma unroll
            for (int m = 0; m < 4; ++m) { const int row = row0 + ai * 128 + m * 16; f32x4 h[2];
#pragma unroll
                for (int n = 0; n < 2; ++n)
#pragma unroll
                    for (int j = 0; j < 4; ++j) { const float gg = acc[ai][0][m][n][j], uu = acc[ai][1][m][n][j]; h[n][j] = gg / (1.f + __expf(-gg)) * uu; }
                pg8::u32x4 w; w.x = pg8::cvt_pk_bf16(h[0][0], h[0][1]); w.y = pg8::cvt_pk_bf16(h[0][2], h[0][3]); w.z = pg8::cvt_pk_bf16(h[1][0], h[1][1]); w.w = pg8::cvt_pk_bf16(h[1][2], h[1][3]);
                *(pg8::u32x4*)(HACT + (size_t)row * DEXP + col0) = w; }
    }
};
struct EpiDown {
    static constexpr bool PERM = true;
    bf16* Y; const float* WTS; const LAS int* tab;
    __device__ __forceinline__ void operator()(const f32x4 (&acc)[2][2][4][2], const Unit& u, int wr, int wc, int fr, int fq) const {
        const int rl0 = wr * 64 + fr, col0 = u.pnl * 256 + wc * 32 + 8 * fq, cnt = tab[u.e];
#pragma unroll
        for (int ai = 0; ai < 2; ++ai)
#pragma unroll
            for (int m = 0; m < 4; ++m) { const int rl = rl0 + ai * 128 + m * 16, pos = u.mt * 256 + rl;
                const float w = (pos < cnt) ? WTS[(size_t)u.e * ECAP + pos] : 0.f;
                bf16* rowp = Y + (size_t)(u.pm * 256 + rl) * D_ + col0;
#pragma unroll
                for (int bj = 0; bj < 2; ++bj) { const f32x4 v0 = acc[ai][bj][m][0] * w, v1 = acc[ai][bj][m][1] * w;
                    pg8::u32x4 o; o.x = pg8::cvt_pk_bf16(v0[0], v0[1]); o.y = pg8::cvt_pk_bf16(v0[2], v0[3]); o.z = pg8::cvt_pk_bf16(v1[0], v1[1]); o.w = pg8::cvt_pk_bf16(v1[2], v1[3]);
                    *(pg8::u32x4*)(rowp + bj * 128) = o; } }
    }
};

struct CompressOrder {
    static constexpr bool GATHER = false;
    int G, c;
    __device__ bool next(int i, Unit& u) const { const int L = i * G + c; if (L >= 32) return false; u.pm = L >> 1; u.pnl = L & 1; u.pn = (u.pm >= 8 ? 2 : 0) + u.pnl; u.e = 0; u.mt = 0; return true; }
    __device__ __forceinline__ void a_offs(const Unit&, int, int, int, int, int, unsigned (&)[2][2]) const {}
    __device__ __forceinline__ void a_ready(const Unit&) const {}
    __device__ __forceinline__ void done(const Unit&) const {}
};
template <bool GATHER_>
struct MoeOrder {
    static constexpr bool GATHER = GATHER_;
    const LAS int* tab; int NT, G, c, bt_per_e, bt_base; const int* tokidx;
    __device__ bool next(int i, Unit& u) const {
        const int L = i * G + c; if (L >= tab[64]) return false;
        int e = 0;
        for (int k = 1; k < NEXP; ++k) e += (L >= tab[32 + k]) ? 1 : 0;
        e = __builtin_amdgcn_readfirstlane(e);
        const int r = L - tab[32 + e];
        u.e = e; u.mt = r / NT; u.pnl = r % NT; u.pn = bt_base + e * bt_per_e + u.pnl; u.pm = (tab[65 + e] >> 8) + u.mt; return true;
    }
    __device__ __forceinline__ void a_offs(const Unit& u, int R0, int R1, int C0, int C1, int K, unsigned (&o)[2][2]) const {
        const int cnt = tab[u.e]; const int* tk = tokidx + (size_t)u.e * ECAP;
#pragma unroll
        for (int h = 0; h < 2; ++h) {
            int p0 = u.mt * 256 + h * 128 + R0, p1 = u.mt * 256 + h * 128 + R1; p0 = p0 < cnt ? p0 : cnt - 1; p1 = p1 < cnt ? p1 : cnt - 1;
            o[h][0] = ((unsigned)tk[p0] * (unsigned)K + (unsigned)C0) * 2u; o[h][1] = ((unsigned)tk[p1] * (unsigned)K + (unsigned)C1) * 2u; }
    }
    __device__ __forceinline__ void a_ready(const Unit&) const {}
    __device__ __forceinline__ void done(const Unit&) const {}
};

namespace att {
constexpr int D = 128, NW = 8, QBLK = 32, KVBLK = 64, QB = NW * QBLK;
constexpr int SHM_V = KVBLK * D * 2, SHM_K = KVBLK * D * 2;
constexpr int OFF_WS = 2 * SHM_V + 2 * SHM_K, OFF_OT = OFF_WS + NW * 64 * 4, LDS_BYTES = OFF_OT + NW * 32 * 4;
constexpr int OFF_ST = 73728, ST_ROW = 272, ST_WAVE = 16 * ST_ROW;
constexpr float SCALE = 0.08838834764831845f, THR = 8.f;
typedef short bf16x8 __attribute__((ext_vector_type(8)));
typedef short s16x4 __attribute__((ext_vector_type(4)));
typedef float f32x16 __attribute__((ext_vector_type(16)));
typedef float f32x4 __attribute__((ext_vector_type(4)));
typedef unsigned u32x4 __attribute__((ext_vector_type(4)));
typedef unsigned short bf16;
#define KSWZ(row, colB) ((row) * 256 + ((colB) ^ (((row) & 7) << 4)))
#define SBAR() __builtin_amdgcn_sched_barrier(0)
__device__ __forceinline__ int v_st(int k, int c) { const int kk = (k & ~0xC) | ((k & 4) << 1) | ((k & 8) >> 1); return ((kk >> 3) * 4 + (c >> 5)) * 512 + ((kk & 7) * 32 + (c & 31)) * 2; }
__device__ __forceinline__ int v_rd_base(int lane) { return ((lane & 3) << 3) | (((lane >> 2) & 3) << 6) | (((lane >> 4) & 1) << 5) | (((lane >> 5) & 1) << 8); }
constexpr int v_rd_off(int d0, int ks, int half) { return d0 * 512 + ks * 4096 + half * 2048; }
__device__ __forceinline__ int crow(int r, int hi) { return (r & 3) + 8 * (r >> 2) + 4 * hi; }
__device__ __forceinline__ unsigned cvtpk(float lo, float hi) { unsigned r; asm volatile("v_cvt_pk_bf16_f32 %0, %1, %2" : "=v"(r) : "v"(lo), "v"(hi)); return r; }
__device__ __forceinline__ bf16x8 load8(const bf16* p) { return *reinterpret_cast<const bf16x8*>(p); }
__device__ __forceinline__ void mask_tile(f32x16& p0, f32x16& p1, int dq, unsigned W) {
    const float NEG = -__builtin_inff();
#pragma unroll
    for (int r = 0; r < 16; ++r) {
        const int c = (r & 3) + 8 * (r >> 2);
        if ((unsigned)(dq - c) >= W) p0[r] = NEG;
        if ((unsigned)(dq - c - 32) >= W) p1[r] = NEG;
    }
}
__device__ __forceinline__ void partialSM(f32x16& p0, f32x16& p1, float& m_reg, float& mn, float& alpha) {
    float pmax = p0[0]; for (int r = 1; r < 16; ++r) pmax = fmaxf(pmax, p0[r]); for (int r = 0; r < 16; ++r) pmax = fmaxf(pmax, p1[r]);
    { auto rr = __builtin_amdgcn_permlane32_swap(__float_as_uint(pmax), __float_as_uint(pmax), false, false);
      pmax = fmaxf(__uint_as_float(rr[0]), __uint_as_float(rr[1])); }
    constexpr float C2 = 1.4426950408889634f * SCALE;
    if (__builtin_expect(__all((pmax - m_reg) * SCALE <= THR), 1)) { mn = m_reg; alpha = 1.f; }
    else { mn = fmaxf(m_reg, pmax); alpha = __builtin_amdgcn_exp2f((m_reg - mn) * C2); m_reg = mn; }
    const float mnL = -mn * C2;
    for (int r = 0; r < 16; ++r) p0[r] = fmaf(p0[r], C2, mnL); for (int r = 0; r < 16; ++r) p1[r] = fmaf(p1[r], C2, mnL);
    for (int r = 0; r < 16; ++r) p0[r] = __builtin_amdgcn_exp2f(p0[r]);
}
__device__ __forceinline__ void finishSM(f32x16& p0, f32x16& p1, float alpha, float& l_reg, bf16x8& pa0, bf16x8& pa1, bf16x8& pa2, bf16x8& pa3) {
    for (int r = 0; r < 16; ++r) p1[r] = __builtin_amdgcn_exp2f(p1[r]);
    float ps = 0; for (int r = 0; r < 16; ++r) ps += p0[r]; for (int r = 0; r < 16; ++r) ps += p1[r];
    { auto rr = __builtin_amdgcn_permlane32_swap(__float_as_uint(ps), __float_as_uint(ps), false, false);
      ps = __uint_as_float(rr[0]) + __uint_as_float(rr[1]); }
    l_reg = l_reg * alpha + ps;
#define PK4(P, B_, OUT) do { unsigned a0 = cvtpk(P[B_+0], P[B_+1]), a1 = cvtpk(P[B_+2], P[B_+3]);                          \
        unsigned b0 = cvtpk(P[B_+4], P[B_+5]), b1 = cvtpk(P[B_+6], P[B_+7]);                                             \
        auto r0 = __builtin_amdgcn_permlane32_swap(a0, b0, false, false); auto r1 = __builtin_amdgcn_permlane32_swap(a1, b1, false, false); \
        u32x4 w = {r0[0], r1[0], r0[1], r1[1]}; OUT = *reinterpret_cast<bf16x8*>(&w); } while (0)
    PK4(p0, 0, pa0); PK4(p0, 8, pa1); PK4(p1, 0, pa2); PK4(p1, 8, pa3);
#undef PK4
}
template <int KB, bool SK>
__device__ __forceinline__ void qkt(f32x16& p0, f32x16& p1, const char* K_lds, int r32, int hi, const bf16x8* qr, bool act) {
    if (SK && !act) { const float NEG = -__builtin_inff();
#pragma unroll
        for (int r = 0; r < 16; ++r) { p0[r] = NEG; p1[r] = NEG; } return; }
    p0 = f32x16{}; p1 = f32x16{};
    const char* kb[4];
#pragma unroll
    for (int dd = 0; dd < 4; ++dd) kb[dd] = K_lds + KB * SHM_K + KSWZ(r32, (dd * 16 + hi * 8) * 2);
#pragma unroll
    for (int d0 = 0; d0 < 8; ++d0) { const char* a = kb[d0 & 3] + (d0 >> 2) * 128;
        bf16x8 b0 = *reinterpret_cast<const bf16x8*>(a);
        bf16x8 b1 = *reinterpret_cast<const bf16x8*>(a + 32 * 256);
        p0 = __builtin_amdgcn_mfma_f32_32x32x16_bf16(b0, qr[d0], p0, 0, 0, 0);
        p1 = __builtin_amdgcn_mfma_f32_32x32x16_bf16(b1, qr[d0], p1, 0, 0, 0); }
}
template <int VB, bool SK>
__device__ __forceinline__ void pv_tile(f32x16* o, int vb0, bf16x8 pa0, bf16x8 pa1, bf16x8 pa2, bf16x8 pa3, bool act) {
    if (SK && !act) return;
#define TRRD(dst, off) asm volatile("ds_read_b64_tr_b16 %0, %1 offset:%2" : "=&v"(dst) : "v"(vb0), "i"(off) : "memory")
#define PV_D0(d0) do { s16x4 l0, l1, l2, l3, h0, h1, h2, h3; constexpr int b_ = VB * SHM_V + v_rd_off(d0, 0, 0); \
        TRRD(l0, b_); TRRD(h0, b_ + 2048); TRRD(l1, b_ + 4096); TRRD(h1, b_ + 6144); TRRD(l2, b_ + 8192); TRRD(h2, b_ + 10240); TRRD(l3, b_ + 12288); TRRD(h3, b_ + 14336); \
        asm volatile("s_waitcnt lgkmcnt(0)" ::: "memory"); SBAR();   \
        o[d0] = __builtin_amdgcn_mfma_f32_32x32x16_bf16(pa0, (bf16x8){l0[0], l0[1], l0[2], l0[3], h0[0], h0[1], h0[2], h0[3]}, o[d0], 0, 0, 0);   \
        o[d0] = __builtin_amdgcn_mfma_f32_32x32x16_bf16(pa1, (bf16x8){l1[0], l1[1], l1[2], l1[3], h1[0], h1[1], h1[2], h1[3]}, o[d0], 0, 0, 0);   \
        o[d0] = __builtin_amdgcn_mfma_f32_32x32x16_bf16(pa2, (bf16x8){l2[0], l2[1], l2[2], l2[3], h2[0], h2[1], h2[2], h2[3]}, o[d0], 0, 0, 0);   \
        o[d0] = __builtin_amdgcn_mfma_f32_32x32x16_bf16(pa3, (bf16x8){l3[0], l3[1], l3[2], l3[3], h3[0], h3[1], h3[2], h3[3]}, o[d0], 0, 0, 0); } while (0)
    PV_D0(0); PV_D0(1); PV_D0(2); PV_D0(3);
#undef PV_D0
#undef TRRD
}
struct Ref { const bf16* Q; const bf16* K; const bf16* V; bf16* O; const int* list; int kpitch, j_lo, j_hi, P0, W, a0, a1; };
struct Seam { bf16x8 qr[8]; bf16x8 st_v0, st_v1, st_k0, st_k1; };
#define ROW(p, kp, k0, rr) ((p) + (size_t)((k0) + (rr)) * (kp) + sc)
#define VMW() asm volatile("s_waitcnt vmcnt(0)" ::: "memory")
#define VMWN(n) asm volatile("s_waitcnt vmcnt(%0)" :: "i"(n) : "memory")
#define SLOAD_H(Kp, Vp, kp, k0) do { S.st_v0 = load8(ROW(Vp, kp, k0, sr)); S.st_v1 = load8(ROW(Vp, kp, k0, 32 + sr));              \
                         S.st_k0 = load8(ROW(Kp, kp, k0, sr)); S.st_k1 = load8(ROW(Kp, kp, k0, 32 + sr)); } while (0)
#define SWRITE_HK(bf) do { *(bf16x8*)(K_lds + (bf) * SHM_K + kws) = S.st_k0; *(bf16x8*)(K_lds + (bf) * SHM_K + kws + 32 * 256) = S.st_k1; } while (0)
#define SWRITE_HV(bf) do { *(bf16x8*)(V_lds + (bf) * SHM_V + vst0) = S.st_v0; *(bf16x8*)(V_lds + (bf) * SHM_V + vst1) = S.st_v1; } while (0)
#define SWRITE_H(bf) do { SWRITE_HV(bf); SWRITE_HK(bf); } while (0)
template <class RF>
__device__ __forceinline__ void prime(const Ref& cur, char* lds, Seam& S) {
    const int tid_ = wg_tid((const __attribute__((address_space(3))) int*)(uintptr_t)(unsigned)(uintptr_t)(lds + WIDTAB_OFF));
    const int tid = tid_, wid = __builtin_amdgcn_readfirstlane(tid >> 6), lane = tid & 63, r32 = lane & 31, hi = lane >> 5;
    const int sr = tid >> 4, sc = (tid & 15) * 8, kws = KSWZ(sr, sc * 2); char* K_lds = lds + 2 * SHM_V;
    const int kb0 = cur.j_lo * KVBLK;
    { const bf16* qrow = cur.Q + RF::q_off(cur, wid * QBLK + r32, RF::entry(cur, wid * QBLK + r32));
      for (int d0 = 0; d0 < 8; ++d0) S.qr[d0] = load8(qrow + d0 * 16 + hi * 8); }
    SLOAD_H(cur.K, cur.V, cur.kpitch, kb0); VMW(); SWRITE_HK(0);
    __syncthreads();
}
template <int MODE, bool WSKIP, class RF, bool O8 = false, bool ONE = false>
__device__ __forceinline__ void block(const Ref& cur, const Ref& nxt, float* LSE, char* lds, Seam& S, float* lse_lane = nullptr) {
    const int tid_ = wg_tid((const __attribute__((address_space(3))) int*)(uintptr_t)(unsigned)(uintptr_t)(lds + WIDTAB_OFF));
    const int tid = tid_, wid = __builtin_amdgcn_readfirstlane(tid >> 6), lane = tid & 63, r32 = lane & 31, hi = lane >> 5;
    const int j_lo = cur.j_lo, NT = cur.j_hi - cur.j_lo;
    const int kbn = nxt.j_lo * KVBLK;
    const int W = cur.W;
    const int qlo = cur.P0 + wid * QBLK;
    const int e_cur = RF::entry(cur, wid * QBLK + r32), e_nxt = RF::entry(nxt, wid * QBLK + r32);
    const int qm = (MODE == 2 ? RF::pos(cur, wid * QBLK + r32, e_cur) : qlo + r32) - 4 * hi;
    const unsigned Wm = (MODE == 2) ? (unsigned)RF::Wl(cur, wid * QBLK + r32) : (unsigned)W;
    char* V_lds = lds; char* K_lds = lds + 2 * SHM_V;
    float* ws = (float*)(lds + OFF_WS) + wid * 64; float* li_l = ws, * al_l = ws + 32; int* ot_l = (int*)(lds + OFF_OT) + wid * 32;
    float m_reg = -1e30f, l_reg = 0; f32x16 o[4] = {};
    const int sr = tid >> 4, sc = (tid & 15) * 8, vst0 = v_st(sr, sc), vst1 = v_st(32 + sr, sc), kws = KSWZ(sr, sc * 2);
    const int vb0 = (int)(uintptr_t)V_lds + v_rd_base(lane);
    const bf16* Kh = cur.K; const bf16* Vh = cur.V; const int kp = cur.kpitch;
#define RESC(a) do { if (__any((a) < 1.f)) { if (hi == 0) al_l[r32] = (a); asm volatile("s_waitcnt lgkmcnt(0)" ::: "memory");              \
                     for (int d_ = 0; d_ < 4; ++d_) for (int r = 0; r < 16; ++r) o[d_][r] *= al_l[crow(r, hi)]; } } while (0)
#define KBASE(t) ((j_lo + (t)) * KVBLK)
#define ACT(t) (MODE != 0 || (KBASE(t) <= qlo + QBLK - 1 && KBASE(t) + KVBLK - 1 >= qlo - W + 1))
#define MASKT(P0_, P1_, t) do { const int kb_ = KBASE(t); if (MODE == 2) mask_tile(P0_, P1_, qm - kb_, Wm); \
        else if (MODE == 0) { if ((!SK || ACT(t)) && (kb_ + KVBLK - 1 > qlo || kb_ <= qlo + QBLK - 1 - W)) mask_tile(P0_, P1_, qm - kb_, Wm); } } while (0)
    constexpr int NQL = 8;
    constexpr bool SK = WSKIP && MODE == 0;
#define SEAM_K0() do { VMWN(NQL); SWRITE_HK(0); SBAR(); } while (0)
    f32x16 pA0, pA1, pB0, pB1; float mnA, mnB, alA, alB; bf16x8 pa0, pa1, pa2, pa3;
    SWRITE_HV(0); SBAR();
    if constexpr (ONE) { SLOAD_H(nxt.K, nxt.V, nxt.kpitch, kbn); SBAR(); }
    if (NT > 1) { SLOAD_H(Kh, Vh, kp, KBASE(1)); }
    SBAR(); qkt<0, SK>(pA0, pA1, K_lds, r32, hi, S.qr, ACT(0));
    MASKT(pA0, pA1, 0); partialSM(pA0, pA1, m_reg, mnA, alA);
    if (NT > 1) { VMW(); SWRITE_H(1); }
    __syncthreads();
#define HALF_STEP(PX0, PX1, mnX, alX, PY0, PY1, alY, t, KB, VB, SB) do {                                                      \
        SBAR(); qkt<KB, SK>(PX0, PX1, K_lds, r32, hi, S.qr, ACT(t));                                             \
        finishSM(PY0, PY1, alY, l_reg, pa0, pa1, pa2, pa3); SBAR();                                                           \
        if ((t) + 1 < NT) { SLOAD_H(Kh, Vh, kp, KBASE((t) + 1)); SBAR(); }                                               \
        pv_tile<VB, SK>(o, vb0, pa0, pa1, pa2, pa3, ACT((t) - 1)); MASKT(PX0, PX1, (t)); partialSM(PX0, PX1, m_reg, mnX, alX);                                        \
        __syncthreads();                                                                                                      \
        if ((t) + 1 < NT) { VMW(); SWRITE_H(SB); }                                                                          \
        RESC(alX); __syncthreads(); } while (0)
    for (int t = 1; t + 1 < NT; t += 2) {
        HALF_STEP(pB0, pB1, mnB, alB, pA0, pA1, alA, t, 1, 0, 0);
        HALF_STEP(pA0, pA1, mnA, alA, pB0, pB1, alB, t + 1, 0, 1, 1);
    }
    const bool even = (NT & 1) == 0;
    if (even) { SBAR(); qkt<1, SK>(pB0, pB1, K_lds, r32, hi, S.qr, ACT(NT - 1)); SBAR(); }
    if constexpr (!ONE) { SLOAD_H(nxt.K, nxt.V, nxt.kpitch, kbn); SBAR(); }
    { const bf16* qrow = nxt.Q + RF::q_off(nxt, wid * QBLK + r32, e_nxt);
#pragma unroll
      for (int d0 = 0; d0 < 8; ++d0) S.qr[d0] = load8(qrow + d0 * 16 + hi * 8); }
    SBAR();
    finishSM(pA0, pA1, alA, l_reg, pa0, pa1, pa2, pa3); SBAR();
    pv_tile<0, SK>(o, vb0, pa0, pa1, pa2, pa3, ACT(even ? NT - 2 : NT - 1));
    if (even) { MASKT(pB0, pB1, NT - 1); partialSM(pB0, pB1, m_reg, mnB, alB); __syncthreads(); RESC(alB);
        finishSM(pB0, pB1, alB, l_reg, pa0, pa1, pa2, pa3); SBAR(); pv_tile<1, SK>(o, vb0, pa0, pa1, pa2, pa3, ACT(NT - 1)); }
    SBAR(); SEAM_K0();
    if (hi == 0) { li_l[r32] = l_reg; ot_l[r32] = RF::o_off(cur, wid * QBLK + r32, e_cur); } asm volatile("s_waitcnt lgkmcnt(0)" ::: "memory");
    if (LSE != nullptr && hi == 0) { const int lq = RF::l_idx(cur, wid * QBLK + r32, e_cur); if (lq >= 0) LSE[lq] = (l_reg > 0.f) ? m_reg * SCALE + __logf(l_reg) : -__builtin_inff(); }
    if (lse_lane != nullptr) *lse_lane = (l_reg > 0.f) ? m_reg * SCALE + __logf(l_reg) : -__builtin_inff();
    bf16* O = cur.O;
    { char* stg = lds + OFF_ST + wid * ST_WAVE;
#pragma unroll 1
      for (int p = 0; p < 2; ++p) {
#pragma unroll
        for (int rr = 0; rr < 8; ++rr) { const int r = 8 * p + rr, orow = crow(r, hi); const float lv = li_l[orow]; const float rl = (lv > 0.f) ? __builtin_amdgcn_rcpf(lv) : 0.f;
#pragma unroll
            for (int d0 = 0; d0 < 4; ++d0) {
                if constexpr (O8) *(unsigned char*)(stg + (orow - 16 * p) * ST_ROW + (d0 * 32 + r32)) = (unsigned char)__builtin_amdgcn_cvt_pk_fp8_f32(o[d0][r] * rl * 16.f, 0.f, 0, false);
                else *(unsigned short*)(stg + (orow - 16 * p) * ST_ROW + (d0 * 32 + r32) * 2) = (unsigned short)cvtpk(o[d0][r] * rl, 0.f); } }
        asm volatile("s_waitcnt lgkmcnt(0)" ::: "memory");
        { const int row = lane >> 2, ch = lane & 3, oo = ot_l[16 * p + row];
          if constexpr (O8) {
#pragma unroll
            for (int i = 0; i < 2; ++i) { const u32x4 x = *(const u32x4*)(stg + row * ST_ROW + (i * 4 + ch) * 16); if (oo >= 0) *(u32x4*)((char*)O + (size_t)oo + (i * 4 + ch) * 16) = x; }
          } else {
#pragma unroll
            for (int i = 0; i < 4; ++i) { const u32x4 x = *(const u32x4*)(stg + row * ST_ROW + (i * 4 + ch) * 16); if (oo >= 0) *(u32x4*)(O + (size_t)oo + (i * 4 + ch) * 8) = x; } } }
        asm volatile("s_waitcnt lgkmcnt(0)" ::: "memory");
      } }
    __syncthreads();
#undef RESC
#undef KBASE
#undef ACT
#undef MASKT
#undef SEAM_K0
#undef HALF_STEP
}

template <class RF>
__device__ __forceinline__ void imp_sweep(const Ref& cur, float lse_lane, float* IMP  , char* lds, Seam& S) {
    const int tid_ = wg_tid((const __attribute__((address_space(3))) int*)(uintptr_t)(unsigned)(uintptr_t)(lds + WIDTAB_OFF));
    const int tid = tid_, wid = __builtin_amdgcn_readfirstlane(tid >> 6), lane = tid & 63, r32 = lane & 31, hi = lane >> 5;
    const int NT = cur.j_hi - cur.j_lo;
    char* K_lds = lds + 2 * SHM_V;
    const int sr = tid >> 4, sc = (tid & 15) * 8, kws = KSWZ(sr, sc * 2);
    const bf16* Kh = cur.K; const int kp = cur.kpitch;
    const int row = wid * QBLK + r32;
    const int qm = RF::pos(cur, row, RF::entry(cur, row)) - 4 * hi; const unsigned Wm = (unsigned)RF::Wl(cur, row);
    constexpr float C2 = 1.4426950408889634f * SCALE;
    const float nl2 = (lse_lane == -__builtin_inff()) ? 0.f : -lse_lane * 1.4426950408889634f;
    float carry = 0.f;
    float* imp_row = IMP + (size_t)(row >> 2) * 512;
    f32x16 p0, p1;
#define IMP_TILE(t, KB) do { \
        if ((t) + 1 < NT) { S.st_k0 = load8(ROW(Kh, kp, (cur.j_lo + (t) + 1) * KVBLK, sr)); S.st_k1 = load8(ROW(Kh, kp, (cur.j_lo + (t) + 1) * KVBLK, 32 + sr)); } \
        SBAR(); qkt<KB, false>(p0, p1, K_lds, r32, hi, S.qr, true); \
        mask_tile(p0, p1, qm - (cur.j_lo + (t)) * KVBLK, Wm); \
        _Pragma("unroll") for (int r = 0; r < 16; ++r) { p0[r] = __builtin_amdgcn_exp2f(fmaf(p0[r], C2, nl2)); p1[r] = __builtin_amdgcn_exp2f(fmaf(p1[r], C2, nl2)); } \
        float Gs[8], Ls[8]; \
        _Pragma("unroll") for (int q = 0; q < 4; ++q) { Gs[q] = (p0[4 * q] + p0[4 * q + 1]) + (p0[4 * q + 2] + p0[4 * q + 3]); Ls[q] = p0[4 * q + 3]; \
                                              Gs[4 + q] = (p1[4 * q] + p1[4 * q + 1]) + (p1[4 * q + 2] + p1[4 * q + 3]); Ls[4 + q] = p1[4 * q + 3]; } \
          \
        float prevL = carry; \
        _Pragma("unroll") for (int q = 0; q < 8; ++q) { const float other = lane_get(Ls[q], lane ^ 32);        \
            const float add = hi ? other : prevL; prevL = other; Gs[q] += add; } \
        carry = prevL;                                            \
        _Pragma("unroll") for (int q = 0; q < 8; ++q) { float v = Gs[q]; v += lane_get(v, lane ^ 1); v += lane_get(v, lane ^ 2); \
            if ((r32 & 3) == 0) imp_row[((cur.j_lo + (t)) << 4) + 2 * q + hi] = v; } \
        if ((t) + 1 < NT) { asm volatile("s_waitcnt vmcnt(0)" ::: "memory"); *(bf16x8*)(K_lds + ((KB) ^ 1) * SHM_K + kws) = S.st_k0; *(bf16x8*)(K_lds + ((KB) ^ 1) * SHM_K + kws + 32 * 256) = S.st_k1; } \
        __syncthreads(); } while (0)
    for (int t = 0; t < NT; t += 2) { IMP_TILE(t, 0); if (t + 1 < NT) IMP_TILE(t + 1, 1); }
#undef IMP_TILE
}

template <class RF>
__device__ __forceinline__ void gate_unit(const Ref& cur, int nvis, char* lds, Seam& S, int (&sel)[3]) {
    const int tid_ = wg_tid((const __attribute__((address_space(3))) int*)(uintptr_t)(unsigned)(uintptr_t)(lds + WIDTAB_OFF));
    const int lane = tid_ & 63, r32 = lane & 31, hi = lane >> 5;
    char* K_lds = lds + 2 * SHM_V;
    prime<RF>(cur, lds, S);
    f32x16 p0, p1;
    qkt<0, false>(p0, p1, K_lds, r32, hi, S.qr, true);
    const float NEG = -__builtin_inff();
#pragma unroll
    for (int r = 0; r < 16; ++r) { const int k = crow(r, hi); if (k >= nvis) p0[r] = NEG; if (k + 32 >= nvis) p1[r] = NEG; }
    float bv[3]; int bk[3];
#pragma unroll
    for (int rd = 0; rd < 3; ++rd) { float best = NEG; int kb = 64;
#pragma unroll
        for (int r = 0; r < 16; ++r) if (p0[r] > best) { best = p0[r]; kb = crow(r, hi); }
#pragma unroll
        for (int r = 0; r < 16; ++r) if (p1[r] > best) { best = p1[r]; kb = 32 + crow(r, hi); }
        bv[rd] = best; bk[rd] = kb;
#pragma unroll
        for (int r = 0; r < 16; ++r) { if (crow(r, hi) == kb) p0[r] = NEG; if (32 + crow(r, hi) == kb) p1[r] = NEG; } }
    float ov[3]; int ok[3];
#pragma unroll
    for (int i = 0; i < 3; ++i) { ov[i] = lane_get(bv[i], lane ^ 32); ok[i] = lane_geti(bk[i], lane ^ 32); }
    int ia = 0, ib = 0;
#pragma unroll
    for (int rd = 0; rd < 3; ++rd) { const float va = ia == 0 ? bv[0] : (ia == 1 ? bv[1] : (ia == 2 ? bv[2] : NEG)), vb = ib == 0 ? ov[0] : (ib == 1 ? ov[1] : (ib == 2 ? ov[2] : NEG));
        const int ka = ia == 0 ? bk[0] : (ia == 1 ? bk[1] : (ia == 2 ? bk[2] : 64)), kb = ib == 0 ? ok[0] : (ib == 1 ? ok[1] : (ib == 2 ? ok[2] : 64));
        const bool ta = va > vb || (va == vb && ka < kb);
        const float v = ta ? va : vb; const int k = ta ? ka : kb; ia += ta ? 1 : 0; ib += ta ? 0 : 1;
        sel[rd] = (v == NEG) ? -1 : k; }
    __syncthreads();
}
#undef ROW
#undef VMW
#undef VMWN
#undef SLOAD_H
#undef SWRITE_HK
#undef SWRITE_HV
#undef SWRITE_H
#undef KSWZ
#undef SBAR
}

struct RFReg {
    static __device__ __forceinline__ int entry(const att::Ref&, int) { return 0; }
    static __device__ __forceinline__ int q_off(const att::Ref&, int row, int) { return row * 1024; }
    static __device__ __forceinline__ int o_off(const att::Ref&, int row, int) { return row * 1024; }
    static __device__ __forceinline__ int l_idx(const att::Ref& u, int row, int) { return u.a0 >= 0 ? u.a0 + row * 8 : -1; }
    static __device__ __forceinline__ int pos(const att::Ref& u, int row, int) { return u.P0 + row; }
    static __device__ __forceinline__ int Wl(const att::Ref& u, int) { return u.W; }
};
__device__ __forceinline__ att::Ref win_ref(int L, const bf16* QN, const bf16* KW, const bf16* VW, bf16* OWIN) {
    const int h = L & 7, qb = L >> 3;
    att::Ref r; r.Q = QN + (size_t)qb * 256 * 1024 + h * 128; r.O = OWIN + (size_t)qb * 256 * 1024 + h * 128; r.K = KW + (h >> 2) * 128; r.V = VW + (h >> 2) * 128; r.kpitch = 256; r.list = nullptr;
    r.P0 = qb * 256; r.W = 512; r.j_lo = (r.P0 >= 511) ? (r.P0 - 511) >> 6 : 0; r.j_hi = ((r.P0 + 255) >> 6) + 1; r.a0 = -1; r.a1 = 0; return r;
}
__device__ __forceinline__ att::Ref mown_ref(int L, const bf16* QM, const bf16* KM, const bf16* VM, bf16* POWN) {
    const int h = L & 7, n = L >> 3; const size_t o = (size_t)n * 256 * 1024 + h * 128;
    att::Ref r; r.Q = QM + o; r.O = POWN + o; r.K = KM + o; r.V = VM + o; r.kpitch = 1024; r.list = nullptr;
    r.P0 = 0; r.W = 1 << 20; r.j_lo = 0; r.j_hi = 4; r.a0 = n * 256 * 8 + h; r.a1 = 0; return r;
}
struct RFSel {
    static __device__ __forceinline__ int entry(const att::Ref& u, int row) { return u.list[row < u.a0 ? row : 0]; }
    static __device__ __forceinline__ int q_off(const att::Ref&, int, int e) { return (e >> 2) * 1024; }
    static __device__ __forceinline__ int o_off(const att::Ref& u, int row, int e) { return row < u.a0 ? (((e >> 2) * 8 + u.a1) * 3 + (e & 3)) * 128 : -1; }
    static __device__ __forceinline__ int l_idx(const att::Ref& u, int row, int e) { return row < u.a0 ? ((e >> 2) * 8 + u.a1) * 3 + (e & 3) : -1; }
    static __device__ __forceinline__ int pos(const att::Ref&, int, int) { return 0; }
    static __device__ __forceinline__ int Wl(const att::Ref&, int) { return 0; }
};
__device__ __forceinline__ att::Ref msel_ref(int L, const LAS int* tab, const LAS unsigned short* ulist, const int* MLIST, const bf16* QM, const bf16* KM, const bf16* VM, bf16* PSEL) {
    const int lid = __builtin_amdgcn_readfirstlane((int)ulist[L]), k = L - tab[512 + lid], h = lid >> 6, n = lid & 63;
    att::Ref r; r.Q = QM + h * 128; r.O = PSEL; r.K = KM + (size_t)n * 256 * 1024 + h * 128; r.V = VM + (size_t)n * 256 * 1024 + h * 128; r.kpitch = 1024;
    r.list = MLIST + (size_t)lid * 16384 + k * 256; r.P0 = 0; r.W = 0; r.j_lo = 0; r.j_hi = 4; r.a0 = tab[lid] - k * 256; r.a1 = h; return r;
}

struct RFSlc {
    static __device__ __forceinline__ int entry(const att::Ref& u, int row) { return u.list[(row >> 2) < u.a0 ? (row >> 2) : 0]; }
    static __device__ __forceinline__ int q_off(const att::Ref&, int row, int e) { return (e >> 4) * 1024 + (row & 3) * 128; }
    static __device__ __forceinline__ int l_idx(const att::Ref& u, int row, int e) { return (row >> 2) < u.a0 ? ((((e >> 4) * 2 + (u.a1 >> 16)) * 16 + (e & 15)) * 4 + (row & 3)) : -1; }
    static __device__ __forceinline__ int o_off(const att::Ref& u, int row, int e) { const int i = l_idx(u, row, e); return i >= 0 ? i * 128 : -1; }
    static __device__ __forceinline__ int pos(const att::Ref& u, int, int e) { return (e >> 4) - 64 * (u.a1 & 0xffff); }
    static __device__ __forceinline__ int Wl(const att::Ref&, int) { return 1 << 30; }
};
__device__ __forceinline__ att::Ref nsel_ref(int L, const LAS int* tab, const LAS unsigned short* ulist, const int* NLIST, const bf16* QN, const bf16* KS, const bf16* VS, bf16* PSLC) {
    const int lid = __builtin_amdgcn_readfirstlane((int)ulist[L]), k = L - tab[512 + lid], g = lid >> 8, j = lid & 255;
    att::Ref r; r.Q = QN + g * 512; r.O = PSLC; r.K = KS + (size_t)j * 64 * 256 + g * 128; r.V = VS + (size_t)j * 64 * 256 + g * 128; r.kpitch = 256;
    r.list = NLIST + (size_t)lid * 16384 + k * 64; r.P0 = 0; r.W = 0; r.j_lo = 0; r.j_hi = 1; r.a0 = tab[lid] - k * 64; r.a1 = j | (g << 16); return r;
}

struct RFCmp {
    static __device__ __forceinline__ int entry(const att::Ref&, int) { return 0; }
    static __device__ __forceinline__ int q_off(const att::Ref&, int row, int) { return (row >> 2) * 1024 + (row & 3) * 128; }
    static __device__ __forceinline__ int o_off(const att::Ref&, int row, int) { return (row >> 2) * 1024 + (row & 3) * 128; }
    static __device__ __forceinline__ int l_idx(const att::Ref&, int, int) { return -1; }
    static __device__ __forceinline__ int pos(const att::Ref& u, int row, int) { const int t = u.P0 + (row >> 2); return t >= 31 ? (t - 31) >> 4 : -1; }
    static __device__ __forceinline__ int Wl(const att::Ref&, int) { return 1 << 30; }
};
__device__ __forceinline__ att::Ref cmp_ref(int L, const bf16* QN, const bf16* KCMP, const bf16* VCMP, bf16* OCMP) {
    const int g = L & 1, c = (L < 256) ? (L >> 1) : 255 - ((L - 256) >> 1);
    att::Ref r; r.Q = QN + (size_t)c * 64 * 1024 + g * 512; r.O = OCMP + (size_t)c * 64 * 1024 + g * 512; r.K = KCMP + g * 128; r.V = VCMP + g * 128; r.kpitch = 256; r.list = nullptr;
    r.P0 = c * 64; r.W = 0; r.j_lo = 0; r.j_hi = (4 * c + 3 + 63) >> 6; r.a0 = g; r.a1 = c; return r;
}

struct RFWinG {
    static __device__ __forceinline__ int entry(const att::Ref&, int) { return 0; }
    static __device__ __forceinline__ int q_off(const att::Ref&, int row, int) { return (row >> 2) * 1024 + (row & 3) * 128; }
    static __device__ __forceinline__ int o_off(const att::Ref&, int row, int) { return (row >> 2) * 1024 + (row & 3) * 128; }
    static __device__ __forceinline__ int l_idx(const att::Ref&, int, int) { return -1; }
    static __device__ __forceinline__ int pos(const att::Ref& u, int row, int) { return u.P0 + (row >> 2); }
    static __device__ __forceinline__ int Wl(const att::Ref&, int) { return 512; }
};
__device__ __forceinline__ att::Ref wing_ref(int L, const bf16* QN, const bf16* KW, const bf16* VW, bf16* OWIN) {
    const int g = L & 1, c = L >> 1;
    att::Ref r; r.Q = QN + (size_t)c * 64 * 1024 + g * 512; r.O = OWIN + (size_t)c * 64 * 1024 + g * 512; r.K = KW + g * 128; r.V = VW + g * 128; r.kpitch = 256; r.list = nullptr;
    r.P0 = c * 64; r.W = 512; r.j_lo = (c >= 8) ? c - 8 : 0; r.j_hi = c + 1; r.a0 = -1; r.a1 = 0; return r;
}

struct Args { const float* in[18]; float* out; unsigned char* ws; int ph_lo, ph_hi, li, pad; };
typedef const __attribute__((address_space(4))) Args* ArgsP;
__device__ __forceinline__ ArgsP get_args() { auto p = __builtin_amdgcn_kernarg_segment_ptr(); asm volatile("" : "+s"(p)); return (ArgsP)p; }

__global__ void __launch_bounds__(NTHR, 2) mk_fwd(Args args_unused) {
    extern __shared__ __attribute__((aligned(16))) unsigned char lds_raw[];
    LAS unsigned char* lds = (LAS unsigned char*)lds_raw;
    LAS float* sm = (LAS float*)lds;
    volatile LAS unsigned* MISC = (volatile LAS unsigned*)(lds + MISC_OFF);
    LAS int* moetab = (LAS int*)(lds + MOETAB_OFF);
    const int G = gridDim.x, bid = blockIdx.x, NGW = G * NWAVES;
#define PH_IDS() const int tid_ = wg_tid((const LAS int*)(lds + WIDTAB_OFF)); const int tid = tid_, lane = tid & 63, wave = __builtin_amdgcn_readfirstlane(tid >> 6), gw = bid * NWAVES + wave; (void)lane; (void)gw;
#define AP() get_args()
#define CTLP(ws) ((gu32*)((ws) + WS_CTL))

    for (int u = threadIdx.x; u < (LDS_BYTES - LDSCTL_OFF) / 4; u += NTHR) ((LAS unsigned*)(lds + LDSCTL_OFF))[u] = 0u;
    __syncthreads();
    { unsigned hw; asm volatile("s_getreg_b32 %0, hwreg(HW_REG_HW_ID, 0, 6)" : "=s"(hw)); if ((threadIdx.x & 63) == 0) ((LAS int*)(lds + WIDTAB_OFF))[hw] = (int)(threadIdx.x >> 6); }
    __syncthreads();
    XcdBarrier bar; bar.bar = nullptr; bar.x = 0; bar.st = nullptr;
    if (MK_N_LAUNCHES == 1) bar = xcd_barrier_post((unsigned*)(CTLP(AP()->ws) + CW_BAR), MISC + 8);
#define GRID_BAR() do { if (MK_N_LAUNCHES == 1) { XcdBarrier b_ = bar; b_.bar = (unsigned*)(CTLP(AP()->ws) + CW_BAR); xcd_barrier(b_, wg_tid((const LAS int*)(lds + WIDTAB_OFF)) == 0); } } while (0)
    const int lo = AP()->ph_lo, hi = AP()->ph_hi;
#define IN(k) (lo <= (k) && (k) < hi)
#define BOTH(k) (IN(k) && IN((k) + 1))

    if (IN(0)) {
        PH_IDS(); ArgsP ap = AP(); unsigned char* ws = ap->ws;
        LAS float* scr = (LAS float*)(lds + wave * 16384);
        constexpr int I_IN = 32 * 177, I_OUT = 32 * 64, I_GU = 32 * 16, I_DN = 8 * 64, I_W1 = 32 * 8;
        constexpr int N_IN = 2 * I_IN, N_OUT = 2 * I_OUT, N_G = 64 * I_GU, N_U = 64 * I_GU, N_D = 64 * I_DN, N_W1 = 8 * I_W1;
        constexpr int NITEMS = N_IN + N_OUT + N_G + N_U + N_D + N_W1;
        for (int it = gw; it < NITEMS; it += NGW) {
            int r = it;
            if (r < N_IN) { const int l = r / I_IN; transpose_item<1>(ap->in[6] + (size_t)l * D_ * IN_W, D_, IN_W, (bf16*)(ws + WS_WINT) + (size_t)l * NIN * D_, D_, 0, scr, r % I_IN, lane); continue; } r -= N_IN;
            if (r < N_OUT) { const int l = r / I_OUT; transpose_item<0>(ap->in[7] + (size_t)l * D_ * D_, D_, D_, (bf16*)(ws + WS_WOUTT) + (size_t)l * D_ * D_, D_, 0, scr, r % I_OUT, lane); continue; } r -= N_OUT;
            if (r < N_G) { const int le = r / I_GU; transpose_item<2>(ap->in[14] + (size_t)le * D_ * DEXP, D_, DEXP, (bf16*)(ws + WS_WGUT) + (size_t)le * 1024 * D_, D_, 0, scr, r % I_GU, lane); continue; } r -= N_G;
            if (r < N_U) { const int le = r / I_GU; transpose_item<3>(ap->in[15] + (size_t)le * D_ * DEXP, D_, DEXP, (bf16*)(ws + WS_WGUT) + (size_t)le * 1024 * D_, D_, 0, scr, r % I_GU, lane); continue; } r -= N_U;
            if (r < N_D) { const int le = r / I_DN; transpose_item<0>(ap->in[16] + (size_t)le * DEXP * D_, DEXP, D_, (bf16*)(ws + WS_WDT) + (size_t)le * D_ * DEXP, DEXP, 0, scr, r % I_DN, lane); continue; } r -= N_D;
            { const int m = r / I_W1, lk = m >> 1, half = m & 1;
              transpose_item<0>(ap->in[9] + (size_t)lk * 4096 * 256 + (size_t)half * 2048 * 256, 2048, 256, (bf16*)(ws + WS_WC1T) + (size_t)lk * 512 * 2048, 2048, half * 256, scr, r % I_W1, lane); }
        }
        { const float* w_router = ap->in[12]; bf16* WrT = (bf16*)(ws + WS_WRT);
          for (int idx = bid * NTHR + tid; idx < 32 * 2048; idx += G * NTHR) { const int e = idx >> 11, k = idx & 2047; const float w = w_router[(size_t)k * 32 + e];
            const unsigned hb = f2bf(w); const float rem = w - bf2f(hb); WrT[idx] = (bf16)hb; WrT[32 * 2048 + idx] = (bf16)f2bf(rem); } }
        { f32x2* ROPE = (f32x2*)(ws + WS_ROPE);
          for (int idx = bid * NTHR + tid; idx < S_ * 64; idx += G * NTHR) { const int pos = idx >> 6, i = idx & 63;
            const double inv = exp(-(double)i * (9.210340371976184 / 64.0)); const double ang = (double)pos * inv; double sv, cv; sincos(ang, &sv, &cv);
            ROPE[idx] = (f32x2){(float)cv, (float)sv}; } }
        __syncthreads();
        { float* MOD = (float*)(CTLP(ws) + CW_MOD); const float* c_in = ap->in[1]; const float* w_ada = ap->in[2]; const float* b_ada = ap->in[3];
          for (int k = tid; k < D_; k += NTHR) { const float cv = c_in[k]; sm[k] = cv / (1.f + __expf(-cv)); }
          __syncthreads();
          for (int it = bid; it < 2 * 96; it += G) { const int l = it / 96, cb = it % 96, grp = tid >> 5, col = cb * 128 + (tid & 31) * 4;
            f32x4 a = (f32x4){0.f, 0.f, 0.f, 0.f};
            const float* wp = w_ada + ((size_t)l * D_ + grp) * 12288 + col;
#pragma unroll 8
            for (int i = 0; i < 128; ++i) a += *(const f32x4*)(wp + (size_t)i * 16 * 12288) * sm[grp + 16 * i];
            *(LAS f32x4*)(sm + 4096 + grp * 128 + (tid & 31) * 4) = a;
            __syncthreads();
            if (tid < 128) { float s = b_ada[l * 12288 + cb * 128 + tid];
#pragma unroll
                for (int q = 0; q < 16; ++q) s += sm[4096 + q * 128 + tid];
                MOD[l * 12288 + cb * 128 + tid] = s; }
            __syncthreads(); } }
        { float* B1P = (float*)(CTLP(ws) + CW_B1E); const float* cmp_pe = ap->in[8]; const float* cmp_w1 = ap->in[9];
          for (int it = bid - 192; it >= 0 && it < 32; it += G) { const int lk = it >> 3, ks = it & 7, grp = tid >> 6, n = (tid & 63) * 4;
            f32x4 a = (f32x4){0.f, 0.f, 0.f, 0.f};
            const float* wp = cmp_w1 + ((size_t)lk * 4096 + ks * 512 + grp) * 256 + n; const float* pe = cmp_pe + (size_t)lk * 4096 + ks * 512 + grp;
#pragma unroll 8
            for (int i = 0; i < 64; ++i) a += *(const f32x4*)(wp + (size_t)i * 8 * 256) * pe[i * 8];
            *(LAS f32x4*)(sm + 4096 + grp * 256 + n) = a;
            __syncthreads();
            if (tid < 256) { float s = 0.f;
#pragma unroll
                for (int q = 0; q < 8; ++q) s += sm[4096 + q * 256 + tid];
                B1P[(lk * 8 + ks) * 256 + tid] = s; }
            __syncthreads(); } }
        if (BOTH(0)) GRID_BAR();
    }

    for (int l = 0; l < DEPTH; ++l) {
        const int pb = 1 + NPL * l;
#define LOAD_MOETAB(CNTP, NT_) do { __syncthreads(); if (tid < 32) moetab[tid] = (int)__hip_atomic_load((CNTP) + tid * CSTR, RLX_AGENT); __syncthreads(); \
        if (tid == 0) { int us = 0, ps = 0; for (int e = 0; e < NEXP; ++e) { const int c = moetab[e], tl = (c + 255) >> 8; moetab[32 + e] = us; moetab[65 + e] = ps; us += tl * (NT_); ps += tl << 8; } moetab[64] = us; } \
        __syncthreads(); } while (0)

        if (IN(pb + 0)) {
            PH_IDS(); ArgsP ap = AP(); unsigned char* ws = ap->ws;
            const float* MOD = (const float*)(CTLP(ws) + CW_MOD); const float* mod = MOD + l * 12288;
            float* X = ap->out; bf16* H = (bf16*)(ws + WS_H); const bf16* Y = (const bf16*)(ws + WS_Y); const int* TE = (const int*)(ws + WS_TE);
            if (l > 0) LOAD_MOETAB((unsigned*)(CTLP(ws) + CW_CNT) + (l - 1) * 32 * CSTR, 1);
            { const float* g_attn = ap->in[4];
              for (int k = tid; k < D_; k += NTHR) { sm[k] = g_attn[l * D_ + k] * (1.f + mod[2048 + k]); sm[2048 + k] = mod[k]; sm[4096 + k] = (l > 0) ? MOD[(l - 1) * 12288 + 10240 + k] : 0.f; } }
            __syncthreads();
            const float* x_in = ap->in[0];
            for (int t = gw; t < S_; t += NGW) {
                f32x4 v[8]; float ss = 0.f;
                if (l == 0) {
#pragma unroll
                    for (int j = 0; j < 8; ++j) v[j] = *(const f32x4*)(x_in + (size_t)t * D_ + 256 * j + 4 * lane);
                } else {
                    const int4 te = *(const int4*)(TE + 4 * t);
                    const bf16* y0 = Y + (size_t)(moetab[65 + te.x] + te.y) * D_; const bf16* y1 = Y + (size_t)(moetab[65 + te.z] + te.w) * D_;
#pragma unroll
                    for (int j = 0; j < 8; ++j) { const int k = 256 * j + 4 * lane; const uint2 a = *(const uint2*)(y0 + k), b = *(const uint2*)(y1 + k);
                        const f32x4 gt2 = *(const LAS f32x4*)(sm + 4096 + k);
                        f32x4 ysum = (f32x4){bflo(a.x) + bflo(b.x), bfhi(a.x) + bfhi(b.x), bflo(a.y) + bflo(b.y), bfhi(a.y) + bfhi(b.y)};
                        v[j] = *(const f32x4*)(X + (size_t)t * D_ + k) + gt2 * ysum; *(f32x4*)(X + (size_t)t * D_ + k) = v[j]; }
                }
#pragma unroll
                for (int j = 0; j < 8; ++j) ss += (v[j][0] * v[j][0] + v[j][1] * v[j][1]) + (v[j][2] * v[j][2] + v[j][3] * v[j][3]);
                const float rstd = 1.f / sqrtf(wave_sum(ss, lane) * (1.f / D_) + RMS_EPS);
#pragma unroll
                for (int j = 0; j < 8; ++j) { const int k = 256 * j + 4 * lane; const f32x4 h = v[j] * rstd * *(const LAS f32x4*)(sm + k) + *(const LAS f32x4*)(sm + 2048 + k);
                    *(uint2*)(H + (size_t)t * D_ + k) = make_uint2(pk2(h[0], h[1]), pk2(h[2], h[3])); }
            }
            if (BOTH(pb + 0)) GRID_BAR();
        }
        if (IN(pb + 1)) {
            ArgsP ap = AP(); unsigned char* ws = ap->ws;
            pg8::Gemm g{(const bf16*)(ws + WS_H), (const bf16*)(ws + WS_WINT) + (size_t)l * NIN * D_, S_, NIN, D_}; pg8::StaticOrder So; So.init(S_, NIN, G, bid);
            EpiInProj E{(bf16*)(ws + WS_QN), (bf16*)(ws + WS_KC), (bf16*)(ws + WS_VC), (bf16*)(ws + WS_KS), (bf16*)(ws + WS_VS), (bf16*)(ws + WS_KW), (bf16*)(ws + WS_VW),
                        (bf16*)(ws + WS_QM), (bf16*)(ws + WS_KM), (bf16*)(ws + WS_VM), (float*)(ws + WS_GATES), (const float*)(ws + WS_ROPE)};
            pg8::gemm_phase<EpiInProj, pg8::StaticOrder, true, true>(lds, g, So, E);
            if (BOTH(pb + 1)) GRID_BAR();
        }
        if (IN(pb + 2)) {
            PH_IDS(); ArgsP ap = AP(); unsigned char* ws = ap->ws;
            if (bid < 32) {
                pg8::Gemm g{(const bf16*)(ws + WS_KC), (const bf16*)(ws + WS_WC1T) + (size_t)l * 2 * 512 * 2048, 4096, 512, 2048}; CompressOrder So{G, bid};
                EpiF32 E{(float*)(ws + WS_UL), 512};
                pg8::gemm_phase<EpiF32, CompressOrder, false, true>(lds, g, So, E);
            }
            {
                const bf16* KM = (const bf16*)(ws + WS_KM); bf16* KMEAN = (bf16*)(ws + WS_KMEAN);
                const int nb = (G > 32) ? G - 32 : G, b0 = (G > 32) ? bid - 32 : bid;
                if (b0 >= 0) for (int u = b0; u < 512; u += nb) { const int n = u >> 3, h = u & 7, rg = tid >> 4, c8 = (tid & 15) * 8;
                    float a8[8] = {0.f, 0.f, 0.f, 0.f, 0.f, 0.f, 0.f, 0.f};
#pragma unroll
                    for (int i = 0; i < 8; ++i) { const v4u kv = *(const v4u*)(KM + (size_t)(n * 256 + rg + 32 * i) * 1024 + h * 128 + c8);
                        a8[0] += bflo(kv.x); a8[1] += bfhi(kv.x); a8[2] += bflo(kv.y); a8[3] += bfhi(kv.y); a8[4] += bflo(kv.z); a8[5] += bfhi(kv.z); a8[6] += bflo(kv.w); a8[7] += bfhi(kv.w); }
#pragma unroll
                    for (int i = 0; i < 8; ++i) sm[rg * 128 + c8 + i] = a8[i];
                    __syncthreads();
                    if (tid < 128) { float s = 0.f;
#pragma unroll 8
                        for (int q = 0; q < 32; ++q) s += sm[q * 128 + tid];
                        KMEAN[(size_t)(h * 64 + n) * 128 + tid] = (bf16)f2bf(s * (1.f / 256.f)); }
                    __syncthreads(); }
            }
            {
                const bf16* QN = (const bf16*)(ws + WS_QN); const bf16* KW = (const bf16*)(ws + WS_KW); const bf16* VW = (const bf16*)(ws + WS_VW); bf16* OWIN = (bf16*)(ws + WS_OWIN);
                const bf16* QM = (const bf16*)(ws + WS_QM); const bf16* KM2 = (const bf16*)(ws + WS_KM); const bf16* VM = (const bf16*)(ws + WS_VM); bf16* POWN = (bf16*)(ws + WS_POWN); float* LSEO = (float*)(ws + WS_LSEO);
                int bidl = bid; asm volatile("" : "+s"(bidl));
                const int nbw = (G > 32) ? G - 32 : G, bw = (G > 32) ? bidl - 32 : bidl;
                __syncthreads();
                att::Seam S;
                if (bw >= 0) {
                    { int L = bw;
                      if (L < 512) { att::Ref cur = wing_ref(L, QN, KW, VW, OWIN); att::prime<RFWinG>(cur, (char*)lds_raw, S);
                        for (;;) { const int Ln = L + nbw; const bool more = Ln < 512; const att::Ref nxt = more ? wing_ref(Ln, QN, KW, VW, OWIN) : cur;
                            att::block<2, false, RFWinG>(cur, nxt, nullptr, (char*)lds_raw, S);
                            if (!more) break; cur = nxt; L = Ln; } } }
                    __syncthreads();
                    {
                        const int heavy = 512 - 2 * nbw;
                        int f, n;
                        if (heavy >= 0 && heavy <= nbw && 3 * (nbw - heavy) <= 512 && 512 - 3 * (nbw - heavy) <= heavy) { if (bw >= heavy) { f = 3 * (bw - heavy); n = 3; } else { f = 3 * (nbw - heavy) + bw; n = (f < 512) ? 1 : 0; } }
                        else { f = bw; n = -1; }
                        if (n != 0 && f < 512) { int L = f, k = 1; att::Ref cur = mown_ref(L, QM, KM2, VM, POWN); att::prime<RFReg>(cur, (char*)lds_raw, S);
                            for (;;) { const int Ln = (n < 0) ? L + nbw : L + 1; const bool more = (n < 0) ? (Ln < 512) : (k < n && Ln < 512); const att::Ref nxt = more ? mown_ref(Ln, QM, KM2, VM, POWN) : cur;
                                att::block<0, true, RFReg>(cur, nxt, LSEO, (char*)lds_raw, S);
                                if (!more) break; cur = nxt; L = Ln; ++k; } } }
                }
                __syncthreads();
            }
            if (BOTH(pb + 2)) GRID_BAR();
        }
        if (IN(pb + 3)) {
            PH_IDS(); ArgsP ap = AP(); unsigned char* ws = ap->ws;
            const float* UL = (const float*)(ws + WS_UL); const float* B1P = (const float*)(CTLP(ws) + CW_B1E); const float* cmp_b1 = ap->in[10]; const f32x2* ROPE = (const f32x2*)(ws + WS_ROPE);
            bf16* KCMP = (bf16*)(ws + WS_KCMP); bf16* VCMP = (bf16*)(ws + WS_VCMP); const float* cmp_w2 = ap->in[11];
            { const int kv = bid & 1; const float* w2 = cmp_w2 + (size_t)(l * 2 + kv) * 256 * 128; LAS float* be = (LAS float*)(lds + 135168 + 8192);
              if (tid < 256) { float s = cmp_b1[(l * 2 + kv) * 256 + tid];
#pragma unroll
                  for (int q = 0; q < 8; ++q) s += B1P[((l * 2 + kv) * 8 + q) * 256 + tid];
                  be[tid] = s; }
              for (int i = tid; i < 256 * 128 / 4; i += NTHR) *(LAS f32x4*)(sm + 4 * i) = *(const f32x4*)(w2 + 4 * i);
              LAS float* hid = (LAS float*)(lds + 135168) + wave * 256;
              __syncthreads();
              const int nb2 = (G + 1 - kv) >> 1;
              for (int r = (bid >> 1) * NWAVES + wave; r < NC * 2; r += nb2 * NWAVES) { const int c = r >> 1, g = r & 1;
                const float* Ur = UL + ((size_t)kv * 2048 + g * 1024 + c) * 512; const float* Lr = UL + ((size_t)kv * 2048 + g * 1024 + c + 1) * 512 + 256;
#pragma unroll
                for (int j = 0; j < 4; ++j) { const int n = lane + 64 * j; const float v = Ur[n] + Lr[n] + be[n];
                    hid[n] = 0.5f * v * (1.f + tanhf(0.7978845608028654f * (v + 0.044715f * v * v * v))); }
                LDS_WAIT(); asm volatile("" ::: "memory");
                float o0 = 0.f, o1 = 0.f;
#pragma unroll 8
                for (int n = 0; n < 256; ++n) { const float hv = hid[n]; o0 += hv * sm[n * 128 + lane]; o1 += hv * sm[n * 128 + 64 + lane]; }
                if (kv == 0) { const f32x2 cs = ROPE[(size_t)(16 * c + 31) * 64 + lane];
                    const float a = o0 * cs[0] - o1 * cs[1], b = o1 * cs[0] + o0 * cs[1];
                    *(unsigned*)(KCMP + ((size_t)c * 2 + g) * 128 + 2 * lane) = pk2(a, b);
                } else { VCMP[((size_t)c * 2 + g) * 128 + lane] = (bf16)f2bf(o0); VCMP[((size_t)c * 2 + g) * 128 + 64 + lane] = (bf16)f2bf(o1); }
                LDS_WAIT(); asm volatile("" ::: "memory");
              }
              __syncthreads(); }
            if (BOTH(pb + 3)) GRID_BAR();
        }
        if (IN(pb + 4)) {
            {   ArgsP ap = AP(); unsigned char* ws = ap->ws;
                const bf16* QN = (const bf16*)(ws + WS_QN); const bf16* KCMP = (const bf16*)(ws + WS_KCMP); const bf16* VCMP = (const bf16*)(ws + WS_VCMP);
                bf16* OCMP = (bf16*)(ws + WS_OCMP); float* IMP = (float*)(ws + WS_IMP);
                att::Seam S;
                for (int L = bid; L < 512; L += G) { const att::Ref cur = cmp_ref(L, QN, KCMP, VCMP, OCMP); float lse;
                    att::prime<RFCmp>(cur, (char*)lds_raw, S);
                    att::block<2, false, RFCmp>(cur, cur, nullptr, (char*)lds_raw, S, &lse);
                    att::imp_sweep<RFCmp>(cur, lse, IMP + ((size_t)cur.a1 * 64 * 2 + cur.a0) * 256, (char*)lds_raw, S); }
            }
            {   PH_IDS(); ArgsP ap = AP(); unsigned char* ws = ap->ws;
                const bf16* QM = (const bf16*)(ws + WS_QM); const bf16* KMEAN = (const bf16*)(ws + WS_KMEAN);
                unsigned* MCNT = (unsigned*)(CTLP(ws) + CW_MCNT) + l * 512 * CSTR; int* MLIST = (int*)(ws + WS_MLIST); float* LSES = (float*)(ws + WS_LSES);
                __syncthreads();
                att::Seam S;
                for (int L = bid; L < 512; L += G) { const int h = L & 7, nq = L >> 3;
                    att::Ref cur; cur.Q = QM + (size_t)nq * 256 * 1024 + h * 128; cur.O = nullptr; cur.K = KMEAN + (size_t)h * 64 * 128; cur.V = cur.K; cur.kpitch = 128; cur.list = nullptr;
                    cur.P0 = 0; cur.W = 0; cur.j_lo = 0; cur.j_hi = 1; cur.a0 = -1; cur.a1 = 0;
                    int sel[3]; att::gate_unit<RFReg>(cur, nq, (char*)lds_raw, S, sel);
                    if (lane < 32) { const int t = nq * 256 + wave * 32 + lane;
#pragma unroll
                        for (int s = 0; s < 3; ++s) {
                            if (sel[s] >= 0) { const unsigned p = atomicAdd(MCNT + (h * 64 + sel[s]) * CSTR, 1u); MLIST[(size_t)(h * 64 + sel[s]) * 16384 + p] = t * 4 + s; }
                            else LSES[(t * 8 + h) * 3 + s] = -INFINITY; } }
                }
            }
            if (BOTH(pb + 4)) GRID_BAR();
        }
        if (IN(pb + 5)) {
            PH_IDS(); ArgsP ap = AP(); unsigned char* ws = ap->ws;
            {   PH_IDS(); ArgsP ap = AP(); unsigned char* ws = ap->ws;
                const float* IMP = (const float*)(ws + WS_IMP); int* SEL = (int*)(ws + WS_SEL);
                unsigned* NCNT = (unsigned*)(CTLP(ws) + CW_NCNT) + l * 512 * CSTR; int* NLIST = (int*)(ws + WS_NLIST);
                const int lam = lane & 15, rho = lane >> 4;
                for (int ub = gw * 4; ub < S_ * 2; ub += NGW * 4) { const int u = ub + rho, t = u >> 1, g = u & 1, tb = t >> 6;
                    float v[16];
#pragma unroll
                    for (int i = 0; i < 16; ++i) { const int j = lam + 16 * i; const float im = IMP[(size_t)u * 256 + j]; const bool forced = (j == 0) || (j == tb) || (j == tb - 1);
                        v[i] = (j > tb) ? -INFINITY : (forced ? 1e9f : im); }
                    int mysel = -1;
                    for (int r = 0; r < 16; ++r) { const int pick = row_pick<16>(v, lam); if (lam == r) mysel = pick; if (__all(pick < 0)) break; }
                    SEL[(size_t)u * 16 + lam] = mysel;
                    if (mysel >= 0) {
                        unsigned p;
                        if (mysel == 0) p = (unsigned)t; else if (mysel == tb) p = (unsigned)(t & 63); else if (mysel == tb - 1) p = 64u + (unsigned)(t & 63);
                        else p = 128u + atomicAdd(NCNT + (g * 256 + mysel) * CSTR, 1u);
                        NLIST[(size_t)(g * 256 + mysel) * 16384 + p] = t * 16 + lam; }
                }
            }
            {   PH_IDS(); ArgsP ap = AP(); unsigned char* ws = ap->ws;
                const bf16* QM = (const bf16*)(ws + WS_QM); const bf16* KM = (const bf16*)(ws + WS_KM); const bf16* VM = (const bf16*)(ws + WS_VM);
                bf16* POWN = (bf16*)(ws + WS_POWN); bf16* PSEL = (bf16*)(ws + WS_PSEL); float* LSEO = (float*)(ws + WS_LSEO); float* LSES = (float*)(ws + WS_LSES);
                const int* MLIST = (const int*)(ws + WS_MLIST); unsigned* MCNT = (unsigned*)(CTLP(ws) + CW_MCNT) + l * 512 * CSTR;
                LAS int* mtab = (LAS int*)(lds + att::LDS_BYTES);
                __syncthreads();
                mtab[tid] = (int)__hip_atomic_load(MCNT + tid * CSTR, RLX_AGENT);
                __syncthreads();
                LAS unsigned short* ulist = (LAS unsigned short*)(lds + 108544);
                { int tot; const int nu = (mtab[tid] + 255) >> 8; const int ex = block_excl_scan(nu, mtab + 1040, tid, &tot); mtab[512 + tid] = ex; if (tid == 0) mtab[1024] = tot;
                  for (int u = 0; u < nu; ++u) ulist[ex + u] = (unsigned short)tid; }
                __syncthreads();
                const int nsel = mtab[1024];
                att::Seam S;
                { int L = bid;
                  if (L < nsel) { att::Ref cur = msel_ref(L, mtab, ulist, MLIST, QM, KM, VM, PSEL); att::prime<RFSel>(cur, (char*)lds_raw, S);
                    for (;;) { const bool more = L + G < nsel; const att::Ref nxt = more ? msel_ref(L + G, mtab, ulist, MLIST, QM, KM, VM, PSEL) : cur;
                        att::block<1, false, RFSel>(cur, nxt, LSES, (char*)lds_raw, S);
                        if (!more) break; cur = nxt; L += G; } } }
                __syncthreads();
            }
            if (BOTH(pb + 5)) GRID_BAR();
        }
        if (IN(pb + 6)) {
            PH_IDS(); ArgsP ap = AP(); unsigned char* ws = ap->ws;
            const bf16* POWN = (const bf16*)(ws + WS_POWN); const bf16* PSEL = (const bf16*)(ws + WS_PSEL); const float* LSEO = (const float*)(ws + WS_LSEO); const float* LSES = (const float*)(ws + WS_LSES);
            bf16* OMIX = (bf16*)(ws + WS_OMIX);
            for (int t = gw; t < S_; t += NGW) {
                const int hh = (lane >> 2) & 7, ii = lane & 3;
                const float lv = (ii == 0) ? LSEO[t * 8 + hh] : LSES[(t * 8 + hh) * 3 + ii - 1];
                float m = fmaxf(lv, lane_get(lv, lane ^ 1)); m = fmaxf(m, lane_get(m, lane ^ 2));
                float w = __expf(lv - m); float sw = w + lane_get(w, lane ^ 1); sw += lane_get(sw, lane ^ 2); w = w / sw;
#pragma unroll
                for (int hp = 0; hp < 2; ++hp) { const int h = hp * 4 + (lane >> 4), c8 = (lane & 15) * 8;
                    const float w0 = lane_get(w, h * 4), w1 = lane_get(w, h * 4 + 1), w2 = lane_get(w, h * 4 + 2), w3 = lane_get(w, h * 4 + 3);
                    const bf16* ps = PSEL + (size_t)((t * 8 + h) * 3) * 128 + c8;
                    const v4u a0 = *(const v4u*)(POWN + (size_t)t * 1024 + h * 128 + c8);
                    v4u a1 = (v4u){0u, 0u, 0u, 0u}, a2 = a1, a3 = a1;
                    if (w1 > 0.f) a1 = *(const v4u*)(ps); if (w2 > 0.f) a2 = *(const v4u*)(ps + 128); if (w3 > 0.f) a3 = *(const v4u*)(ps + 256);
                    v4u ov;
                    ov.x = pk2(w0 * bflo(a0.x) + w1 * bflo(a1.x) + w2 * bflo(a2.x) + w3 * bflo(a3.x), w0 * bfhi(a0.x) + w1 * bfhi(a1.x) + w2 * bfhi(a2.x) + w3 * bfhi(a3.x));
                    ov.y = pk2(w0 * bflo(a0.y) + w1 * bflo(a1.y) + w2 * bflo(a2.y) + w3 * bflo(a3.y), w0 * bfhi(a0.y) + w1 * bfhi(a1.y) + w2 * bfhi(a2.y) + w3 * bfhi(a3.y));
                    ov.z = pk2(w0 * bflo(a0.z) + w1 * bflo(a1.z) + w2 * bflo(a2.z) + w3 * bflo(a3.z), w0 * bfhi(a0.z) + w1 * bfhi(a1.z) + w2 * bfhi(a2.z) + w3 * bfhi(a3.z));
                    ov.w = pk2(w0 * bflo(a0.w) + w1 * bflo(a1.w) + w2 * bflo(a2.w) + w3 * bflo(a3.w), w0 * bfhi(a0.w) + w1 * bfhi(a1.w) + w2 * bfhi(a2.w) + w3 * bfhi(a3.w));
                    *(v4u*)(OMIX + (size_t)t * 2048 + 1024 + h * 128 + c8) = ov; }
            }
            if (BOTH(pb + 6)) GRID_BAR();

        }
        if (IN(pb + 7)) {
            PH_IDS(); ArgsP ap = AP(); unsigned char* ws = ap->ws;
            const bf16* QN = (const bf16*)(ws + WS_QN); const bf16* KS = (const bf16*)(ws + WS_KS); const bf16* VS = (const bf16*)(ws + WS_VS);
            bf16* PSLC = (bf16*)(ws + WS_PSLC); float* LSEN = (float*)(ws + WS_LSEN); const int* NLIST = (const int*)(ws + WS_NLIST); unsigned* NCNT = (unsigned*)(CTLP(ws) + CW_NCNT) + l * 512 * CSTR;
            LAS int* ntab = (LAS int*)(lds + att::LDS_BYTES);
            __syncthreads();
            { const int j = tid & 255; ntab[tid] = (j == 0) ? S_ : (int)__hip_atomic_load(NCNT + tid * CSTR, RLX_AGENT) + 64 + (j < 255 ? 64 : 0); }
            __syncthreads();
            LAS unsigned short* ulist = (LAS unsigned short*)(lds + 108544);
            { int tot; const int nu = (ntab[tid] + 63) >> 6; const int ex = block_excl_scan(nu, ntab + 1040, tid, &tot); ntab[512 + tid] = ex; if (tid == 0) ntab[1024] = tot;
              for (int u = 0; u < nu; ++u) ulist[ex + u] = (unsigned short)tid; }
            __syncthreads();
            const int nun = ntab[1024];
            att::Seam S; int L = bid;
            if (L < nun) { att::Ref cur = nsel_ref(L, ntab, ulist, NLIST, QN, KS, VS, PSLC); att::prime<RFSlc>(cur, (char*)lds_raw, S);
                for (;;) { const bool more = L + G < nun; const att::Ref nxt = more ? nsel_ref(L + G, ntab, ulist, NLIST, QN, KS, VS, PSLC) : cur;
                    att::block<2, false, RFSlc, true, true>(cur, nxt, LSEN, (char*)lds_raw, S);
                    if (!more) break; cur = nxt; L += G; } }
            __syncthreads();
            if (BOTH(pb + 7)) GRID_BAR();
        }
        if (IN(pb + 8)) {
            PH_IDS(); ArgsP ap = AP(); unsigned char* ws = ap->ws;
            const unsigned char* PSLC = (const unsigned char*)(ws + WS_PSLC); const float* LSEN = (const float*)(ws + WS_LSEN); const int* SEL = (const int*)(ws + WS_SEL); const float* GATES = (const float*)(ws + WS_GATES);
            const bf16* OCMP = (const bf16*)(ws + WS_OCMP); const bf16* OWIN = (const bf16*)(ws + WS_OWIN); bf16* OMIX = (bf16*)(ws + WS_OMIX);
            for (int u = gw; u < S_ * 2; u += NGW) { const int t = u >> 1, g = u & 1;
                const int sv = (lane < 16) ? SEL[(size_t)u * 16 + lane] : -1;
                const int nsel = __popcll(__ballot(sv >= 0));
                const float lv = ((lane >> 2) < nsel) ? LSEN[(size_t)u * 64 + lane] : -INFINITY;
                float m = lv;
#pragma unroll
                for (int o = 4; o < 64; o <<= 1) m = fmaxf(m, lane_get(m, lane ^ o));
                float w = __expf(lv - m), sw = w;
#pragma unroll
                for (int o = 4; o < 64; o <<= 1) sw += lane_get(sw, lane ^ o);
                w = w / sw * 0.0625f;
                const int r = lane >> 4, c8 = (lane & 15) * 8;
                float o8[8] = {0.f, 0.f, 0.f, 0.f, 0.f, 0.f, 0.f, 0.f};
                uint2 pv[16];
#pragma unroll
                for (int s = 0; s < 16; ++s) { const int sc = s < nsel ? s : nsel - 1; pv[s] = *(const uint2*)(PSLC + ((size_t)(u * 16 + sc) * 4 + r) * 128 + c8); }
#pragma unroll
                for (int s = 0; s < 16; ++s) { const float ws_ = lane_get(w, s * 4 + r);
                    o8[0] += ws_ * __builtin_amdgcn_cvt_f32_fp8((int)pv[s].x, 0); o8[1] += ws_ * __builtin_amdgcn_cvt_f32_fp8((int)pv[s].x, 1); o8[2] += ws_ * __builtin_amdgcn_cvt_f32_fp8((int)pv[s].x, 2); o8[3] += ws_ * __builtin_amdgcn_cvt_f32_fp8((int)pv[s].x, 3);
                    o8[4] += ws_ * __builtin_amdgcn_cvt_f32_fp8((int)pv[s].y, 0); o8[5] += ws_ * __builtin_amdgcn_cvt_f32_fp8((int)pv[s].y, 1); o8[6] += ws_ * __builtin_amdgcn_cvt_f32_fp8((int)pv[s].y, 2); o8[7] += ws_ * __builtin_amdgcn_cvt_f32_fp8((int)pv[s].y, 3); }
                const int hd = g * 4 + r; const float g0 = GATES[(size_t)t * 32 + hd * 3], g1 = GATES[(size_t)t * 32 + hd * 3 + 1], g2 = GATES[(size_t)t * 32 + hd * 3 + 2];
                const size_t oi = (size_t)t * 1024 + hd * 128 + c8;
                const v4u cv = *(const v4u*)(OCMP + oi), wv = *(const v4u*)(OWIN + oi);
                v4u ov;
                ov.x = pk2(g1 * o8[0] + g0 * bflo(cv.x) + g2 * bflo(wv.x), g1 * o8[1] + g0 * bfhi(cv.x) + g2 * bfhi(wv.x));
                ov.y = pk2(g1 * o8[2] + g0 * bflo(cv.y) + g2 * bflo(wv.y), g1 * o8[3] + g0 * bfhi(cv.y) + g2 * bfhi(wv.y));
                ov.z = pk2(g1 * o8[4] + g0 * bflo(cv.z) + g2 * bflo(wv.z), g1 * o8[5] + g0 * bfhi(cv.z) + g2 * bfhi(wv.z));
                ov.w = pk2(g1 * o8[6] + g0 * bflo(cv.w) + g2 * bflo(wv.w), g1 * o8[7] + g0 * bfhi(cv.w) + g2 * bfhi(wv.w));
                *(v4u*)(OMIX + (size_t)t * 2048 + hd * 128 + c8) = ov;
            }
            if (BOTH(pb + 8)) GRID_BAR();
        }
        if (IN(pb + 9)) {
            ArgsP ap = AP(); unsigned char* ws = ap->ws;
            pg8::Gemm g{(const bf16*)(ws + WS_OMIX), (const bf16*)(ws + WS_WOUTT) + (size_t)l * D_ * D_, S_, D_, D_}; pg8::StaticOrder So; So.init(S_, D_, G, bid);
            EpiOutProj E{l == 0 ? ap->in[0] : (const float*)ap->out, ap->out, (const float*)(CTLP(ws) + CW_MOD) + l * 12288 + 4096};
            pg8::gemm_phase<EpiOutProj, pg8::StaticOrder, true, true>(lds, g, So, E);
            if (BOTH(pb + 9)) GRID_BAR();
        }
        if (IN(pb + 10)) {
            PH_IDS(); ArgsP ap = AP(); unsigned char* ws = ap->ws;
            const float* mod = (const float*)(CTLP(ws) + CW_MOD) + l * 12288;
            const float* X = ap->out; bf16* H = (bf16*)(ws + WS_H); const bf16* WrT = (const bf16*)(ws + WS_WRT); const float* b_router = ap->in[13];
            unsigned* CNT = (unsigned*)(CTLP(ws) + CW_CNT) + l * 32 * CSTR; int* TE = (int*)(ws + WS_TE); int* TOKIDX = (int*)(ws + WS_TOKIDX); float* WTS = (float*)(ws + WS_WTS);
            { const float* g_ffn = ap->in[5];
              for (int k = tid; k < D_; k += NTHR) { sm[k] = g_ffn[l * D_ + k] * (1.f + mod[8192 + k]); sm[2048 + k] = mod[6144 + k]; }
              if (tid < 32) sm[4160 + tid] = b_router[tid]; }
            typedef short bf16x8_t __attribute__((ext_vector_type(8))); typedef float f32x16_t __attribute__((ext_vector_type(16)));
            for (int bt = bid; bt < S_ / 64; bt += G) { const int t0 = bt * 64;
                __syncthreads();
                for (int rr = 0; rr < 8; rr += 2) { const int row = wave * 8 + rr; float ss0 = 0.f, ss1 = 0.f; f32x4 va[8], vb[8];
#pragma unroll
                    for (int j = 0; j < 8; ++j) { va[j] = *(const f32x4*)(X + (size_t)(t0 + row) * D_ + 256 * j + 4 * lane); vb[j] = *(const f32x4*)(X + (size_t)(t0 + row + 1) * D_ + 256 * j + 4 * lane); }
#pragma unroll
                    for (int j = 0; j < 8; ++j) { ss0 += (va[j][0] * va[j][0] + va[j][1] * va[j][1]) + (va[j][2] * va[j][2] + va[j][3] * va[j][3]); ss1 += (vb[j][0] * vb[j][0] + vb[j][1] * vb[j][1]) + (vb[j][2] * vb[j][2] + vb[j][3] * vb[j][3]); }
                    ss0 = wave_sum(ss0, lane); ss1 = wave_sum(ss1, lane);
                    if (lane == 0) { sm[4096 + row] = 1.f / sqrtf(ss0 * (1.f / D_) + RMS_EPS); sm[4096 + row + 1] = 1.f / sqrtf(ss1 * (1.f / D_) + RMS_EPS); } }
                __syncthreads();
                { const int r = lane & 31, kh = lane >> 5; f32x16_t acc0 = {}, acc1 = {};
                  const float rs0 = sm[4096 + r], rs1 = sm[4096 + 32 + r];
#pragma unroll 2
                  for (int ks = 0; ks < 16; ++ks) { const int k = wave * 256 + ks * 16 + kh * 8;
                    const bf16x8_t wh = *(const bf16x8_t*)(WrT + (size_t)r * 2048 + k), wl = *(const bf16x8_t*)(WrT + 32 * 2048 + (size_t)r * 2048 + k);
                    const f32x4 gA = *(const LAS f32x4*)(sm + k), gB = *(const LAS f32x4*)(sm + k + 4), sA = *(const LAS f32x4*)(sm + 2048 + k), sB = *(const LAS f32x4*)(sm + 2048 + k + 4);
#pragma unroll
                    for (int rg = 0; rg < 2; ++rg) { const size_t ro = (size_t)(t0 + rg * 32 + r) * D_ + k; const float rs = rg ? rs1 : rs0;
                        const f32x4 xa = *(const f32x4*)(X + ro), xb = *(const f32x4*)(X + ro + 4);
                        const f32x4 ha = xa * rs * gA + sA, hb = xb * rs * gB + sB;
                        const unsigned h0 = pk2(ha[0], ha[1]), h1 = pk2(ha[2], ha[3]), h2 = pk2(hb[0], hb[1]), h3 = pk2(hb[2], hb[3]);
                        *(v4u*)(H + ro) = (v4u){h0, h1, h2, h3};
                        const unsigned l0 = pk2(ha[0] - bflo(h0), ha[1] - bfhi(h0)), l1 = pk2(ha[2] - bflo(h1), ha[3] - bfhi(h1)), l2 = pk2(hb[0] - bflo(h2), hb[1] - bfhi(h2)), l3 = pk2(hb[2] - bflo(h3), hb[3] - bfhi(h3));
                        const v4u hv = (v4u){h0, h1, h2, h3}, lv = (v4u){l0, l1, l2, l3};
                        const bf16x8_t ahi = __builtin_bit_cast(bf16x8_t, hv), alo = __builtin_bit_cast(bf16x8_t, lv);
                        if (rg == 0) { acc0 = __builtin_amdgcn_mfma_f32_32x32x16_bf16(wh, ahi, acc0, 0, 0, 0); acc0 = __builtin_amdgcn_mfma_f32_32x32x16_bf16(wl, ahi, acc0, 0, 0, 0); acc0 = __builtin_amdgcn_mfma_f32_32x32x16_bf16(wh, alo, acc0, 0, 0, 0); }
                        else         { acc1 = __builtin_amdgcn_mfma_f32_32x32x16_bf16(wh, ahi, acc1, 0, 0, 0); acc1 = __builtin_amdgcn_mfma_f32_32x32x16_bf16(wl, ahi, acc1, 0, 0, 0); acc1 = __builtin_amdgcn_mfma_f32_32x32x16_bf16(wh, alo, acc1, 0, 0, 0); } } }
#pragma unroll
                  for (int q = 0; q < 16; ++q) { const int e = (q & 3) + 8 * (q >> 2) + 4 * kh;
                      sm[5120 + ((wave * 2 + 0) * 32 + e) * 32 + r] = acc0[q]; sm[5120 + ((wave * 2 + 1) * 32 + e) * 32 + r] = acc1[q]; } }
                __syncthreads();
                { const int tk6 = tid & 63, eq = tid >> 6, rg = tk6 >> 5, tk = tk6 & 31;
#pragma unroll
                  for (int i = 0; i < 4; ++i) { const int e = eq * 4 + i; float s = 0.f;
#pragma unroll
                      for (int w = 0; w < 8; ++w) s += sm[5120 + ((w * 2 + rg) * 32 + e) * 32 + tk];
                      sm[5120 + 16384 + tk6 * 33 + e] = 1.f / (1.f + __expf(-s)); } }
                __syncthreads();
                if (tid < 64) { const int t = t0 + tid;
                    float lg[32];
#pragma unroll
                    for (int e = 0; e < 32; ++e) lg[e] = sm[5120 + 16384 + tid * 33 + e];
                    int grp = 0; float best = -INFINITY;
#pragma unroll
                    for (int gq = 0; gq < 4; ++gq) { float m1 = -INFINITY, m2 = -INFINITY;
#pragma unroll
                        for (int i = 0; i < 8; ++i) { const float b = lg[gq * 8 + i] + sm[4160 + gq * 8 + i]; if (b > m1) { m2 = m1; m1 = b; } else if (b > m2) m2 = b; }
                        const float sgs = m1 + m2; if (sgs > best) { best = sgs; grp = gq; } }
                    float m1 = -INFINITY, m2 = -INFINITY, s1 = 0.f, s2 = 0.f; int i1 = 0, i2 = 0;
#pragma unroll
                    for (int e = 0; e < 32; ++e) { const bool ing = (e >> 3) == grp; const float b = lg[e] + sm[4160 + e];
                        if (ing && b > m1) { m2 = m1; i2 = i1; s2 = s1; m1 = b; i1 = e; s1 = lg[e]; } else if (ing && b > m2) { m2 = b; i2 = e; s2 = lg[e]; } }
                    const float inv = 1.f / (s1 + s2);
                    const unsigned p1 = atomicAdd(CNT + i1 * CSTR, 1u), p2 = atomicAdd(CNT + i2 * CSTR, 1u);
                    TOKIDX[(size_t)i1 * ECAP + p1] = t; TOKIDX[(size_t)i2 * ECAP + p2] = t; WTS[(size_t)i1 * ECAP + p1] = s1 * inv; WTS[(size_t)i2 * ECAP + p2] = s2 * inv;
                    *(int4*)(TE + 4 * t) = make_int4(i1, (int)p1, i2, (int)p2);
                }
            }
            if (BOTH(pb + 10)) GRID_BAR();
        }
        if (IN(pb + 11)) {
            PH_IDS(); ArgsP ap = AP(); unsigned char* ws = ap->ws;
            LOAD_MOETAB((unsigned*)(CTLP(ws) + CW_CNT) + l * 32 * CSTR, 4);
            pg8::Gemm g{(const bf16*)(ws + WS_H), (const bf16*)(ws + WS_WGUT), 0, 0, D_}; MoeOrder<true> So{moetab, 4, G, bid, 4, l * 32 * 4, (const int*)(ws + WS_TOKIDX)};
            EpiGateUp E{(bf16*)(ws + WS_HACT)};
            pg8::gemm_phase<EpiGateUp, MoeOrder<true>, true, true>(lds, g, So, E);
            if (BOTH(pb + 11)) GRID_BAR();
        }
        if (IN(pb + 12)) {
            PH_IDS(); ArgsP ap = AP(); unsigned char* ws = ap->ws;
            LOAD_MOETAB((unsigned*)(CTLP(ws) + CW_CNT) + l * 32 * CSTR, 8);
            pg8::Gemm g{(const bf16*)(ws + WS_HACT), (const bf16*)(ws + WS_WDT), 0, 0, DEXP}; MoeOrder<false> So{moetab, 8, G, bid, 8, l * 32 * 8, nullptr};
            EpiDown E{(bf16*)(ws + WS_Y), (const float*)(ws + WS_WTS), moetab};
            pg8::gemm_phase<EpiDown, MoeOrder<false>, true, true>(lds, g, So, E);
            if (BOTH(pb + 12)) GRID_BAR();
        }
    }
    if (IN(NPH - 1)) {
        PH_IDS(); ArgsP ap = AP(); unsigned char* ws = ap->ws;
        float* X = ap->out; const bf16* Y = (const bf16*)(ws + WS_Y); const int* TE = (const int*)(ws + WS_TE);
        LOAD_MOETAB((unsigned*)(CTLP(ws) + CW_CNT) + 32 * CSTR, 1);
        const bool tmo_set = (MK_N_LAUNCHES == 1) && (__hip_atomic_load((unsigned*)(CTLP(ws) + CW_BAR) + XB_TMO, RLX_AGENT) != 0u);
        { const float* g_final = ap->in[17]; const float* MOD = (const float*)(CTLP(ws) + CW_MOD);
          for (int k = tid; k < D_; k += NTHR) { sm[k] = g_final[k]; sm[2048 + k] = MOD[12288 + 10240 + k]; } }
        __syncthreads();
        for (int t = gw; t < S_; t += NGW) {
            f32x4 v[8]; float ss = 0.f;
            const int4 te = *(const int4*)(TE + 4 * t);
            const bf16* y0 = Y + (size_t)(moetab[65 + te.x] + te.y) * D_; const bf16* y1 = Y + (size_t)(moetab[65 + te.z] + te.w) * D_;
#pragma unroll
            for (int j = 0; j < 8; ++j) { const int k = 256 * j + 4 * lane; const uint2 a = *(const uint2*)(y0 + k), b = *(const uint2*)(y1 + k);
                const f32x4 gt2 = *(const LAS f32x4*)(sm + 2048 + k);
                f32x4 ysum = (f32x4){bflo(a.x) + bflo(b.x), bfhi(a.x) + bfhi(b.x), bflo(a.y) + bflo(b.y), bfhi(a.y) + bfhi(b.y)};
                v[j] = *(const f32x4*)(X + (size_t)t * D_ + k) + gt2 * ysum;
                ss += (v[j][0] * v[j][0] + v[j][1] * v[j][1]) + (v[j][2] * v[j][2] + v[j][3] * v[j][3]); }
            const float rstd = (tmo_set ? __builtin_nanf("") : 1.f) / sqrtf(wave_sum(ss, lane) * (1.f / D_) + RMS_EPS);
#pragma unroll
            for (int j = 0; j < 8; ++j) { const int k = 256 * j + 4 * lane; *(f32x4*)(X + (size_t)t * D_ + k) = v[j] * rstd * *(const LAS f32x4*)(sm + k); }
        }
    }
#undef IN
#undef BOTH
#undef GRID_BAR
#undef LOAD_MOETAB
#undef AP
#undef CTLP
#undef PH_IDS
}

extern "C" void kernel_launch(void* const* d_in, const int* in_sizes, int n_in, void* d_out, int out_size, void* d_ws, size_t ws_size, hipStream_t stream) {
    static int grid = 0;
    if (grid == 0) {
        if (n_in != 18 || out_size != S_ * D_ || ws_size < WS_END) { fprintf(stderr, "kernel_launch: unexpected shapes (n_in %d out %d ws %zu)\n", n_in, out_size, ws_size); grid = -1; return; }
        int dev = 0, cus = 0, per_cu = 0;
        if (hipGetDevice(&dev) != hipSuccess || hipDeviceGetAttribute(&cus, hipDeviceAttributeMultiprocessorCount, dev) != hipSuccess) { grid = -1; return; }
        if (hipFuncSetAttribute((const void*)mk_fwd, hipFuncAttributeMaxDynamicSharedMemorySize, LDS_BYTES) != hipSuccess) { fprintf(stderr, "kernel_launch: hipFuncSetAttribute failed\n"); grid = -1; return; }
        if (hipOccupancyMaxActiveBlocksPerMultiprocessor(&per_cu, (const void*)mk_fwd, NTHR, LDS_BYTES) != hipSuccess || per_cu < 1) { fprintf(stderr, "kernel_launch: occupancy query says %d\n", per_cu); }
        (void)hipGetLastError();
        grid = cus;
    }
    if (grid < 0) return;
    if (hipMemsetAsync((char*)d_ws + WS_CTL, 0, CTL_ZERO_BYTES, stream) != hipSuccess) return;
    Args a{};
    for (int i = 0; i < 18; ++i) a.in[i] = (const float*)d_in[i];
    a.out = (float*)d_out; a.ws = (unsigned char*)d_ws; a.pad = 0;
    if (MK_N_LAUNCHES == 1) {
        a.ph_lo = 0; a.ph_hi = NPH; a.li = 0;
        hipLaunchKernelGGL(mk_fwd, dim3(grid), dim3(NTHR), LDS_BYTES, stream, a);
    } else {
        for (int p = 0; p < NPH; ++p) { a.ph_lo = p; a.ph_hi = p + 1; a.li = p; hipLaunchKernelGGL(mk_fwd, dim3(grid), dim3(NTHR), LDS_BYTES, stream, a); }
    }
}
```

```cpp
#include <hip/hip_runtime.h>
#include <cstdio>
#include <cstdint>


#define WIDTAB_OFF (131072 + 1024)
__device__ __forceinline__ int wg_tid(const __attribute__((address_space(3))) int* widtab) {
    unsigned hw; asm volatile("s_getreg_b32 %0, hwreg(HW_REG_HW_ID, 0, 6)" : "=s"(hw));
    int lane; asm volatile("v_mbcnt_lo_u32_b32 %0, -1, 0\n\tv_mbcnt_hi_u32_b32 %0, -1, %0" : "=v"(lane));
    return widtab[hw] * 64 + lane;
}

namespace pg8 {
#define PG8_LAS __attribute__((address_space(3)))
typedef unsigned short bf16_t;
typedef short bf16x8 __attribute__((ext_vector_type(8)));
typedef float f32x4 __attribute__((ext_vector_type(4)));
typedef unsigned u32x4 __attribute__((ext_vector_type(4)));
constexpr int BM = 256, BK = 64, HALF = 128, HTB = HALF * BK * 2, STAGE_BYTES = 8 * HTB, NXCD = 8, WGM = 8;

__host__ __device__ __forceinline__ int lds_byte(int r, int c) { const int st = (r >> 4) * 2 + (c >> 5), rr = r & 15, cc = c & 31, ob = rr * 64 + cc * 2; return st * 1024 + (ob ^ (((ob >> 9) & 1) << 5)); }
__host__ __device__ __forceinline__ void stage_rc(int b, int& R, int& C) { const int st = b / 1024, sb = b % 1024, swz = sb ^ (((sb >> 9) & 1) << 5); R = (st >> 1) * 16 + swz / 64; C = (st & 1) * 32 + (swz % 64) / 2; }
__host__ __device__ __forceinline__ int perm32(int rho) { const int n = rho >> 4, i = rho & 15; return 8 * (i >> 2) + 4 * n + (i & 3); }

struct Unit { int pm, pn, e, mt, pnl; };
struct Gemm { const bf16_t* A; const bf16_t* Bt; int M, N, K; };

struct StaticOrder {
    static constexpr bool GATHER = false;
    int nM, nN, nwg, G, c;
    __host__ __device__ void init(int M, int N, int G_, int c_) { nM = M / BM; nN = N / BM; nwg = nM * nN; G = G_; c = c_; }
    __host__ __device__ bool next(int i, Unit& u) const {
        const long L = (long)i * G + c; if (L >= nwg) return false;
        int wgid = (int)L; { const int q = nwg / NXCD, r = nwg % NXCD, xcd = wgid % NXCD, off = wgid / NXCD; wgid = (xcd < r ? xcd * (q + 1) : r * (q + 1) + (xcd - r) * q) + off; }
        const int nig = WGM * nN, gid = wgid / nig, fm = gid * WGM, gsz = (nM - fm) < WGM ? (nM - fm) : WGM;
        u.pm = fm + ((wgid % nig) % gsz); u.pn = (wgid % nig) / gsz; u.e = 0; u.mt = 0; u.pnl = u.pn; return true;
    }
    __device__ __forceinline__ void a_offs(const Unit&, int, int, int, int, int, unsigned (&)[2][2]) const {}
    __device__ __forceinline__ void a_ready(const Unit&) const {}
    __device__ __forceinline__ void done(const Unit&) const {}
};

__device__ __forceinline__ unsigned cvt_pk_bf16(float lo, float hi) { unsigned r; asm volatile("v_cvt_pk_bf16_f32 %0, %1, %2" : "=v"(r) : "v"(lo), "v"(hi)); return r; }

template <class Epi, class Sched, bool ALIGN_EPI = false, bool SP2 = false>
__device__ __forceinline__ void gemm_phase(PG8_LAS unsigned char* lds, const Gemm g, const Sched& S, const Epi& E) {
    const int tid_ = wg_tid((const PG8_LAS int*)(lds + WIDTAB_OFF));
    const int tid = tid_, wid = __builtin_amdgcn_readfirstlane(tid >> 6), lane = tid & 63, wr = wid >> 2, wc = wid & 3, fr = lane & 15, fq = lane >> 4;
    const int K = g.K, nt = K / BK;
    unsigned voffA[2], voffB[2]; int RR[2], CC[2];
#pragma unroll
    for (int i = 0; i < 2; ++i) { int R, C; stage_rc(tid * 16 + i * 8192, R, C); const int Rb = Epi::PERM ? ((R & ~31) + perm32(R & 31)) : R;
        RR[i] = R; CC[i] = C; voffA[i] = (unsigned)(R * K + C) * 2u; voffB[i] = (unsigned)(Rb * K + C) * 2u; }
    const size_t kstep = (size_t)(BK * 2);
    const size_t hstep = (size_t)HALF * K * 2;
    const size_t tstep = 2 * hstep;
    const unsigned ldsw = (unsigned)wid * 1024u;
    const int aoff = lds_byte(wr * 64 + fr, fq * 8), boff = lds_byte(wc * 32 + fr, fq * 8);
    const char* gA = (const char*)g.A;
    unsigned aoC[2][2] = {{0u, 0u}, {0u, 0u}}, aoN[2][2] = {{0u, 0u}, {0u, 0u}};
#define PG8_SA(b, h) (((b) * 2 + (h)) * HTB)
#define PG8_SB(b, h) ((4 + (b) * 2 + (h)) * HTB)
#define PG8_STAGE(bufoff, gbase, voff) do { _Pragma("unroll") for (int _i = 0; _i < 2; ++_i) \
        __builtin_amdgcn_global_load_lds((const unsigned*)((const char*)(gbase) + (voff)[_i]), (PG8_LAS unsigned*)(lds + (bufoff) + ldsw + _i * 8192), 16, 0, 0); } while (0)
#define PG8_STAGE_A(bufoff, h, PN, KO) do { if constexpr (Sched::GATHER) { _Pragma("unroll") for (int _i = 0; _i < 2; ++_i) \
        __builtin_amdgcn_global_load_lds((const unsigned*)(gA + aoC[h][_i] + (KO)), (PG8_LAS unsigned*)(lds + (bufoff) + ldsw + _i * 8192), 16, 0, 0); } \
        else { PG8_STAGE(bufoff, (PN) + (h) * hstep, voffA); } } while (0)
#define PG8_LDA(dst, b, h) do { _Pragma("unroll") for (int m = 0; m < 4; ++m) _Pragma("unroll") for (int k = 0; k < 2; ++k) dst[m][k] = *(const PG8_LAS bf16x8*)(lds + PG8_SA(b, h) + aoff + m * 2048 + k * 1024); } while (0)
#define PG8_LDB(dst, b, h) do { _Pragma("unroll") for (int n = 0; n < 2; ++n) _Pragma("unroll") for (int k = 0; k < 2; ++k) dst[n][k] = *(const PG8_LAS bf16x8*)(lds + PG8_SB(b, h) + boff + n * 2048 + k * 1024); } while (0)
#define PG8_MMA(ai, bj, At, Bt) do { __builtin_amdgcn_s_setprio(1); _Pragma("unroll") for (int m = 0; m < 4; ++m) _Pragma("unroll") for (int n = 0; n < 2; ++n) _Pragma("unroll") for (int k = 0; k < 2; ++k) \
        acc[ai][bj][m][n] = __builtin_amdgcn_mfma_f32_16x16x32_bf16(Bt[n][k], At[m][k], acc[ai][bj][m][n], 0, 0, 0); __builtin_amdgcn_s_setprio(0); } while (0)
#define PG8_WAIT_V(n) asm volatile("s_waitcnt vmcnt(" #n ")" ::: "memory")
#define PG8_WAIT_L(n) asm volatile("s_waitcnt lgkmcnt(" #n ")" ::: "memory")
#define PG8_BAR __builtin_amdgcn_s_barrier()
#define PG8_SCHED __builtin_amdgcn_sched_barrier(0)
    Unit cur, nxt; int ui = 0;
    if (!S.next(0, cur)) return;
    f32x4 acc[2][2][4][2];
#pragma unroll
    for (int a = 0; a < 2; ++a)
#pragma unroll
        for (int b = 0; b < 2; ++b)
#pragma unroll
            for (int m = 0; m < 4; ++m)
#pragma unroll
                for (int n = 0; n < 2; ++n) acc[a][b][m][n] = (f32x4){0.f, 0.f, 0.f, 0.f};
    bf16x8 At[4][2], B0[2][2], B1[2][2];
    const char* cA = (const char*)g.A + (size_t)cur.pm * tstep; const char* cB = (const char*)g.Bt + (size_t)cur.pn * tstep;
    if constexpr (Sched::GATHER) S.a_offs(cur, RR[0], RR[1], CC[0], CC[1], K, aoC);
    S.a_ready(cur);
    if constexpr (SP2) {
        PG8_STAGE(PG8_SB(0, 0), cB, voffB); PG8_STAGE(PG8_SB(0, 1), cB + hstep, voffB); PG8_STAGE_A(PG8_SA(0, 0), 0, cA, 0); PG8_STAGE_A(PG8_SA(0, 1), 1, cA, 0);
        if (wr == 1) PG8_BAR;
        PG8_WAIT_V(2); PG8_BAR;
        PG8_STAGE(PG8_SB(1, 0), cB + kstep, voffB); PG8_STAGE_A(PG8_SA(1, 0), 0, cA + kstep, kstep); PG8_STAGE(PG8_SB(1, 1), cB + hstep + kstep, voffB);
        PG8_WAIT_V(6); PG8_BAR;
    } else {
        PG8_STAGE(PG8_SB(0, 0), cB, voffB); PG8_STAGE_A(PG8_SA(0, 0), 0, cA, 0); PG8_STAGE(PG8_SB(0, 1), cB + hstep, voffB); PG8_STAGE_A(PG8_SA(0, 1), 1, cA, 0);
        if (wr == 1) PG8_BAR;
        PG8_WAIT_V(4); PG8_BAR;
        PG8_STAGE(PG8_SB(1, 0), cB + kstep, voffB); PG8_STAGE_A(PG8_SA(1, 0), 0, cA + kstep, kstep); PG8_STAGE(PG8_SB(1, 1), cB + hstep + kstep, voffB);
        PG8_WAIT_V(6); PG8_BAR;
    }
    for (;;) {
        const bool has_next = S.next(ui + 1, nxt);
        const char* nA = has_next ? (const char*)g.A + (size_t)nxt.pm * tstep : cA; const char* nB = has_next ? (const char*)g.Bt + (size_t)nxt.pn * tstep : cB;
        if constexpr (Sched::GATHER) {
            if (has_next) S.a_offs(nxt, RR[0], RR[1], CC[0], CC[1], K, aoN);
            else {
#pragma unroll
                for (int h = 0; h < 2; ++h)
#pragma unroll
                    for (int i = 0; i < 2; ++i) aoN[h][i] = aoC[h][i]; }
        }
        for (int t = 0; t < nt; t += 2) {
            const bool last = (t == nt - 2);
            const char* a1 = cA + (size_t)(t + 1) * kstep;
            const char* a2 = last ? nA : cA + (size_t)(t + 2) * kstep; const char* b2 = last ? nB : cB + (size_t)(t + 2) * kstep;
            const char* a3 = a2 + kstep; const char* b3 = b2 + kstep;
            const size_t k1 = (size_t)(t + 1) * kstep, k2 = last ? (size_t)0 : (size_t)(t + 2) * kstep, k3 = k2 + kstep;
            if (last && has_next) S.a_ready(nxt);
            if constexpr (SP2) {
            PG8_LDB(B0, 0, 0); PG8_LDB(B1, 0, 1); PG8_SCHED; PG8_LDA(At, 0, 0); PG8_STAGE_A(PG8_SA(1, 1), 1, a1, k1);
            if constexpr (Sched::GATHER) { if (last) {
#pragma unroll
                for (int h = 0; h < 2; ++h)
#pragma unroll
                    for (int i = 0; i < 2; ++i) aoC[h][i] = aoN[h][i]; } }
            PG8_WAIT_V(8); PG8_WAIT_L(0); PG8_BAR; PG8_MMA(0, 0, At, B0); PG8_MMA(0, 1, At, B1); PG8_BAR; PG8_SCHED;
            PG8_LDA(At, 0, 1); PG8_STAGE(PG8_SB(0, 0), b2, voffB); PG8_STAGE(PG8_SB(0, 1), b2 + hstep, voffB); PG8_STAGE_A(PG8_SA(0, 0), 0, a2, k2);
            PG8_WAIT_V(8); PG8_WAIT_L(0); PG8_BAR; PG8_MMA(1, 0, At, B0); PG8_MMA(1, 1, At, B1); PG8_BAR; PG8_SCHED;
            PG8_LDB(B0, 1, 0); PG8_LDB(B1, 1, 1); PG8_SCHED; PG8_LDA(At, 1, 0); PG8_STAGE_A(PG8_SA(0, 1), 1, a2, k2);
            PG8_WAIT_V(8); PG8_WAIT_L(0); PG8_BAR; PG8_MMA(0, 0, At, B0); PG8_MMA(0, 1, At, B1); PG8_BAR; PG8_SCHED;
            PG8_LDA(At, 1, 1); PG8_STAGE(PG8_SB(1, 0), b3, voffB); PG8_STAGE(PG8_SB(1, 1), b3 + hstep, voffB); PG8_STAGE_A(PG8_SA(1, 0), 0, a3, k3);
            PG8_WAIT_V(8); PG8_WAIT_L(0); PG8_BAR; PG8_MMA(1, 0, At, B0); PG8_MMA(1, 1, At, B1); PG8_BAR; PG8_SCHED;
            } else {
            PG8_LDB(B0, 0, 0); PG8_SCHED; PG8_LDA(At, 0, 0); PG8_STAGE_A(PG8_SA(1, 1), 1, a1, k1);
            if constexpr (Sched::GATHER) { if (last) {
#pragma unroll
                for (int h = 0; h < 2; ++h)
#pragma unroll
                    for (int i = 0; i < 2; ++i) aoC[h][i] = aoN[h][i]; } }
            PG8_WAIT_L(8); PG8_BAR; PG8_WAIT_L(0); PG8_MMA(0, 0, At, B0); PG8_BAR; PG8_SCHED;
            PG8_LDB(B1, 0, 1); PG8_STAGE(PG8_SB(0, 0), b2, voffB);
            PG8_BAR; PG8_WAIT_L(0); PG8_MMA(0, 1, At, B1); PG8_BAR;
            PG8_LDA(At, 0, 1); PG8_STAGE_A(PG8_SA(0, 0), 0, a2, k2);
            PG8_BAR; PG8_WAIT_L(0); PG8_MMA(1, 0, At, B0); PG8_BAR; PG8_SCHED;
            PG8_STAGE(PG8_SB(0, 1), b2 + hstep, voffB);
            PG8_WAIT_V(6); PG8_BAR; PG8_MMA(1, 1, At, B1); PG8_BAR;
            PG8_LDB(B0, 1, 0); PG8_SCHED; PG8_LDA(At, 1, 0); PG8_STAGE_A(PG8_SA(0, 1), 1, a2, k2);
            PG8_WAIT_L(8); PG8_BAR; PG8_WAIT_L(0); PG8_MMA(0, 0, At, B0); PG8_BAR; PG8_SCHED;
            PG8_LDB(B1, 1, 1); PG8_STAGE(PG8_SB(1, 0), b3, voffB);
            PG8_BAR; PG8_WAIT_L(0); PG8_MMA(0, 1, At, B1); PG8_BAR;
            PG8_LDA(At, 1, 1); PG8_STAGE_A(PG8_SA(1, 0), 0, a3, k3);
            PG8_BAR; PG8_WAIT_L(0); PG8_MMA(1, 0, At, B0); PG8_BAR; PG8_SCHED;
            PG8_STAGE(PG8_SB(1, 1), b3 + hstep, voffB);
            PG8_WAIT_V(6); PG8_BAR; PG8_MMA(1, 1, At, B1); PG8_BAR;
            }
        }
        if constexpr (ALIGN_EPI) { if (wr == 0) PG8_BAR; }
        E(acc, cur, wr, wc, fr, fq); S.done(cur);
        if (!has_next) break;
#pragma unroll
        for (int a = 0; a < 2; ++a)
#pragma unroll
            for (int b = 0; b < 2; ++b)
#pragma unroll
                for (int m = 0; m < 4; ++m)
#pragma unroll
                    for (int n = 0; n < 2; ++n) acc[a][b][m][n] = (f32x4){0.f, 0.f, 0.f, 0.f};
        cur = nxt; cA = nA; cB = nB; ++ui;
        if constexpr (ALIGN_EPI) { if (wr == 1) PG8_BAR; }
    }
    PG8_WAIT_V(0);
    if constexpr (!ALIGN_EPI) { if (wr == 0) PG8_BAR; }
    PG8_BAR;
#undef PG8_SA
#undef PG8_SB
#undef PG8_STAGE
#undef PG8_STAGE_A
#undef PG8_LDA
#undef PG8_LDB
#undef PG8_MMA
#undef PG8_WAIT_V
#undef PG8_WAIT_L
#undef PG8_BAR
#undef PG8_SCHED
}
}

#ifndef MK_N_LAUNCHES
#define MK_N_LAUNCHES 1
#endif
constexpr int NWAVES = 8, NTHR = 512;
constexpr int S_ = 16384, D_ = 2048, DEPTH = 2, HD = 128;
constexpr int IN_W = 5656, NIN = 5888;
constexpr int NC = 1023;
constexpr int NEXP = 32, DEXP = 512, ECAP = 16384, NSLOT = 40960;
constexpr float RMS_EPS = 1e-6f;
constexpr float ATT_SCALE = 0.08838834764831845f;
constexpr int NPL = 13, NPH = 2 + 2 * NPL;

constexpr size_t MiB = 1u << 20;
constexpr size_t WS_CTL = 0, CTL_ZERO_BYTES = 1 * MiB;
constexpr size_t WS_ROPE = 1 * MiB, WS_WINT = 9 * MiB, WS_WOUTT = 55 * MiB, WS_WGUT = 71 * MiB, WS_WDT = 327 * MiB, WS_WC1T = 455 * MiB;
constexpr size_t WS_H = 463 * MiB, WS_QN = 527 * MiB, WS_QM = 559 * MiB, WS_KM = 591 * MiB, WS_VM = 623 * MiB;
constexpr size_t WS_KC = 655 * MiB, WS_VC = 663 * MiB, WS_KS = 671 * MiB, WS_VS = 679 * MiB, WS_KW = 687 * MiB, WS_VW = 695 * MiB;
constexpr size_t WS_GATES = 703 * MiB, WS_UL = 705 * MiB, WS_KCMP = 713 * MiB, WS_VCMP = 713 * MiB + 512 * 1024, WS_KMEAN = 714 * MiB;
constexpr size_t WS_OMIX = 715 * MiB, WS_OCMP = 779 * MiB, WS_OWIN = 811 * MiB, WS_SEL = 843 * MiB, WS_TE = 845 * MiB, WS_TOKIDX = 846 * MiB, WS_WTS = 848 * MiB;
constexpr size_t WS_HACT = 850 * MiB, WS_Y = 890 * MiB;
constexpr size_t WS_WRT = 714 * MiB + 256 * 1024;
constexpr size_t WS_IMP = WS_H + 32 * MiB;
constexpr size_t WS_NLIST = WS_H, WS_PSLC = 850 * MiB, WS_LSEN = 1106 * MiB;
constexpr size_t WS_MLIST = 1050 * MiB, WS_PSEL = 1082 * MiB, WS_POWN = 1178 * MiB, WS_LSES = 1210 * MiB, WS_LSEO = 1211 * MiB + 512 * 1024, WS_END = 1212 * MiB;
constexpr int CW_TMO = 0, CW_BAR = 4096, CW_CNT = 8192, CW_MOD = 16384, CW_B1E = 40960, CW_MCNT = 65536, CW_NCNT = 131072, CSTR = 64;

constexpr int RING_BYTES = 131072, LDSCTL_OFF = RING_BYTES, MISC_OFF = LDSCTL_OFF + 320, MOETAB_OFF = LDSCTL_OFF + 512, LDS_BYTES = 147456;

#define GAS __attribute__((address_space(1)))
#define LAS __attribute__((address_space(3)))
typedef unsigned short bf16;
typedef unsigned v4u __attribute__((ext_vector_type(4)));
typedef float f32x4 __attribute__((ext_vector_type(4)));
typedef float f32x2 __attribute__((ext_vector_type(2)));
typedef GAS unsigned gu32;
#define RLX_AGENT __ATOMIC_RELAXED, __HIP_MEMORY_SCOPE_AGENT
#define LDS_WAIT() asm volatile("s_waitcnt lgkmcnt(0)" ::: "memory")
__device__ __forceinline__ unsigned f2bf(float f) { unsigned u = __builtin_bit_cast(unsigned, f); return (u + 0x7fffu + ((u >> 16) & 1u)) >> 16; }
__device__ __forceinline__ unsigned pk2(float lo, float hi) { return f2bf(lo) | (f2bf(hi) << 16); }
__device__ __forceinline__ float bf2f(unsigned b) { return __builtin_bit_cast(float, b << 16); }
__device__ __forceinline__ float bflo(unsigned w) { return __builtin_bit_cast(float, w << 16); }
__device__ __forceinline__ float bfhi(unsigned w) { return __builtin_bit_cast(float, w & 0xffff0000u); }

#define XB_TMO      128
#define XB_XCNT(j)  (256  + 64 * (j))
#define XB_XSUB(j)  (1280 + 64 * (j))
#define XB_XGEN(j)  (2304 + 64 * (j))
#define XB_TOP      3328
#define XB_TOPGEN   3392
#define XCD_BAR_WORDS 3456
#define XB_SPIN_CAP (1u << 20)
__device__ __forceinline__ unsigned xb_ld(unsigned* p)              { return __hip_atomic_load(p, __ATOMIC_RELAXED, __HIP_MEMORY_SCOPE_AGENT); }
__device__ __forceinline__ unsigned xb_add(unsigned* p, unsigned v) { return __hip_atomic_fetch_add(p, v, __ATOMIC_RELAXED, __HIP_MEMORY_SCOPE_AGENT); }
__device__ __forceinline__ unsigned xb_xcc_id() { return (unsigned)__builtin_amdgcn_s_getreg((3 << 11) | 20) & 0xFu; }
#define XB_SPIN(cond, bar) do { unsigned _sp = 0; while (cond) { __builtin_amdgcn_s_sleep(1); \
    if ((++_sp & 255u) == 0u) { if (xb_ld(&(bar)[XB_TMO])) break; if (_sp > XB_SPIN_CAP) { atomicAdd(&(bar)[XB_TMO], 1u); break; } } } } while (0)
struct XcdBarrier { unsigned* bar; unsigned x; volatile LAS unsigned* st; };
__device__ __forceinline__ XcdBarrier xcd_barrier_post(unsigned* bar, volatile LAS unsigned* st) {
    XcdBarrier b; b.bar = bar; b.x = xb_xcc_id(); b.st = st;
    if (threadIdx.x == 0) (void)xb_add(&bar[XB_XCNT(b.x)], 1u);
    return b;
}
__device__ __forceinline__ void xcd_barrier_complete(unsigned* bar, unsigned x, unsigned& nloc, unsigned& nx) {
    const unsigned G = gridDim.x * gridDim.y * gridDim.z;
    unsigned sum, cnt, mine, sp = 0u;
    for (;;) {
        sum = 0u; cnt = 0u; mine = 0u;
#pragma unroll
        for (unsigned j = 0; j < 16; ++j) { const unsigned c = xb_ld(&bar[XB_XCNT(j)]); sum += c; cnt += (c > 0u) ? 1u : 0u; mine = (j == x) ? c : mine; }
        if (sum == G) break;
        __builtin_amdgcn_s_sleep(1);
        if ((++sp & 255u) == 0u) { if (xb_ld(&bar[XB_TMO])) break; if (sp > XB_SPIN_CAP) { atomicAdd(&bar[XB_TMO], 1u); break; } }
    }
    nloc = mine > 0u ? mine : 1u; nx = cnt > 0u ? cnt : 1u;
}
__device__ __forceinline__ void xcd_barrier(const XcdBarrier& b, bool leader  ) {
    asm volatile("s_waitcnt vmcnt(0)" ::: "memory");
    __syncthreads();
    if (leader) {
        unsigned* bar = b.bar;
        __builtin_amdgcn_s_waitcnt(0);
        unsigned nloc = b.st[0], nx = b.st[1];
        if (nloc == 0u) { xcd_barrier_complete(bar, b.x, nloc, nx); b.st[0] = nloc; b.st[1] = nx; }
        const unsigned old = xb_add(&bar[XB_XSUB(b.x)], 1u);
        const unsigned gen = old / nloc;
        if (old + 1u == (gen + 1u) * nloc) {
            __builtin_amdgcn_fence(__ATOMIC_RELEASE, "agent");
            asm volatile("s_waitcnt vmcnt(0)" ::: "memory");
            const unsigned og = xb_add(&bar[XB_TOP], 1u);
            const unsigned tg = og / nx;
            if (og + 1u == (tg + 1u) * nx) xb_add(&bar[XB_TOPGEN], 1u);
            else XB_SPIN(xb_ld(&bar[XB_TOPGEN]) == tg, bar);
            __builtin_amdgcn_fence(__ATOMIC_ACQUIRE, "agent");
            xb_add(&bar[XB_XGEN(b.x)], 1u);
            asm volatile("s_waitcnt vmcnt(0)" ::: "memory");
        } else {
            XB_SPIN(xb_ld(&bar[XB_XGEN(b.x)]) == gen, bar);
            __builtin_amdgcn_fence(__ATOMIC_ACQUIRE, "agent");
            asm volatile("s_waitcnt vmcnt(0)" ::: "memory");
        }
    }
    __syncthreads();
}

__device__ __forceinline__ float lane_get(float v, int src) { return __builtin_bit_cast(float, __builtin_amdgcn_ds_bpermute(src << 2, __builtin_bit_cast(int, v))); }
__device__ __forceinline__ int lane_geti(int v, int src) { return __builtin_amdgcn_ds_bpermute(src << 2, v); }
__device__ __forceinline__ float wave_sum(float v, int lane) {
#pragma unroll
    for (int o = 1; o < 64; o <<= 1) v += lane_get(v, lane ^ o);
    return v;
}
__device__ __forceinline__ int block_excl_scan(int v, LAS int* scr, int tid, int* tot) {
    const int lane = tid & 63, wv = tid >> 6; int s = v;
#pragma unroll
    for (int o = 1; o < 64; o <<= 1) { const int n = lane_geti(s, lane - o); if (lane >= o) s += n; }
    if (lane == 63) scr[wv] = s;
    __syncthreads();
    int off = 0, all = 0;
#pragma unroll
    for (int w = 0; w < 8; ++w) { const int x = scr[w]; all += x; off += (w < wv) ? x : 0; }
    *tot = all;
    __syncthreads();
    return off + s - v;
}

__device__ __forceinline__ float row_max16(float v) {
    v = fmaxf(v, __builtin_bit_cast(float, __builtin_amdgcn_update_dpp(0, __builtin_bit_cast(int, v), 0xB1, 0xF, 0xF, false)));
    v = fmaxf(v, __builtin_bit_cast(float, __builtin_amdgcn_update_dpp(0, __builtin_bit_cast(int, v), 0x4E, 0xF, 0xF, false)));
    v = fmaxf(v, __builtin_bit_cast(float, __builtin_amdgcn_update_dpp(0, __builtin_bit_cast(int, v), 0x124, 0xF, 0xF, false)));
    v = fmaxf(v, __builtin_bit_cast(float, __builtin_amdgcn_update_dpp(0, __builtin_bit_cast(int, v), 0x128, 0xF, 0xF, false)));
    return v;
}
__device__ __forceinline__ int row_min16(int v) {
    v = min(v, __builtin_amdgcn_update_dpp(0, v, 0xB1, 0xF, 0xF, false));
    v = min(v, __builtin_amdgcn_update_dpp(0, v, 0x4E, 0xF, 0xF, false));
    v = min(v, __builtin_amdgcn_update_dpp(0, v, 0x124, 0xF, 0xF, false));
    v = min(v, __builtin_amdgcn_update_dpp(0, v, 0x128, 0xF, 0xF, false));
    return v;
}
template <int NV>
__device__ __forceinline__ int row_pick(float (&v)[NV], int lam) {
    float m = v[0];
#pragma unroll
    for (int i = 1; i < NV; ++i) m = fmaxf(m, v[i]);
    m = row_max16(m);
    int idx = 1 << 20;
#pragma unroll
    for (int i = NV - 1; i >= 0; --i) idx = (v[i] == m) ? lam + 16 * i : idx;
    idx = row_min16(idx);
    if (m == -INFINITY) idx = -1;
#pragma unroll
    for (int i = 0; i < NV; ++i) v[i] = (lam + 16 * i == idx) ? -INFINITY : v[i];
    return idx;
}

__device__ __forceinline__ int il(int d) { return (d < 64) ? 2 * d : 2 * (d - 64) + 1; }
__device__ __forceinline__ int inproj_row(int s) {
    if (s < 1024) return (s & ~127) + il(s & 127);
    if (s < 1536) return s;
    if (s < 1792) return (s & ~127) + il(s & 127);
    if (s < 2048) return s;
    if (s < 2304) return (s & ~127) + il(s & 127);
    if (s < 2560) return s;
    if (s < 2584) return 5632 + (s - 2560);
    if (s < 3608) { const int r = s - 2584; return 2560 + (r & ~127) + il(r & 127); }
    if (s < 4632) { const int r = s - 3608; return 3584 + (r & ~127) + il(r & 127); }
    return 4608 + (s - 4632);
}
template <int MODE>
__device__ __forceinline__ void transpose_item(const float* W, int K, int N, bf16* WT, int dpitch, int row_off, LAS float* scr, int item, int lane) {
    const int nblk = (N + 31) / 32, kb = item / nblk, nb = item % nblk, k0 = 64 * kb, n0 = 32 * nb;
    const int nsrc = n0 + (lane & 31);
#pragma unroll 8
    for (int i = 0; i < 32; ++i) { const int kk = 2 * i + (lane >> 5); scr[kk * 33 + (lane & 31)] = (nsrc < N) ? W[(size_t)(k0 + kk) * N + nsrc] : 0.f; }
    LDS_WAIT(); asm volatile("" ::: "memory");
    const int c = lane & 7;
#pragma unroll
    for (int j = 0; j < 4; ++j) { const int nl = (lane >> 3) + 8 * j, n = n0 + nl; const LAS float* s = scr + (8 * c) * 33 + nl;
        v4u o; o.x = pk2(s[0 * 33], s[1 * 33]); o.y = pk2(s[2 * 33], s[3 * 33]); o.z = pk2(s[4 * 33], s[5 * 33]); o.w = pk2(s[6 * 33], s[7 * 33]);
        if (n < N) { int dr;
            if (MODE == 0) dr = n; else if (MODE == 1) dr = inproj_row(n); else if (MODE == 2) dr = (n >> 7) * 256 + (n & 127); else dr = (n >> 7) * 256 + 128 + (n & 127);
            *(GAS v4u*)(WT + (size_t)(row_off + dr) * dpitch + k0 + 8 * c) = o; } }
    LDS_WAIT(); asm volatile("" ::: "memory");
}

using pg8::Unit;
struct EpiInProj {
    static constexpr bool PERM = true;
    bf16 *QN, *KC, *VC, *KS, *VS, *KW, *VW, *QM, *KM, *VM; float* GATES; const float* rope;
    __device__ __forceinline__ void operator()(const f32x4 (&acc)[2][2][4][2], const Unit& u, int wr, int wc, int fr, int fq) const {
        const int pn = u.pn, row0 = u.pm * 256 + wr * 64 + fr, c8 = wc * 32 + 8 * fq;
        if (pn == 22) {
            if (c8 < 24) {
#pragma unroll
                for (int ai = 0; ai < 2; ++ai)
#pragma unroll
                    for (int m = 0; m < 4; ++m) { const int row = row0 + ai * 128 + m * 16; float* gp = GATES + (size_t)row * 32 + c8;
                        f32x4 a = acc[ai][0][m][0], b = acc[ai][0][m][1], ga, gb;
#pragma unroll
                        for (int j = 0; j < 4; ++j) { ga[j] = 1.f / (1.f + __expf(-a[j])); gb[j] = 1.f / (1.f + __expf(-b[j])); }
                        *(f32x4*)gp = ga; *(f32x4*)(gp + 4) = gb; }
            }
            return;
        }
        bf16* base; int pitch; size_t bjs; bool rot;
        if (pn < 4)       { base = QN + pn * 256;        pitch = 1024; bjs = 128; rot = true; }
        else if (pn == 4) { base = KC;                   pitch = 128;  bjs = (size_t)S_ * 128; rot = false; }
        else if (pn == 5) { base = VC;                   pitch = 128;  bjs = (size_t)S_ * 128; rot = false; }
        else if (pn == 6) { base = KS;                   pitch = 256;  bjs = 128; rot = true; }
        else if (pn == 7) { base = VS;                   pitch = 256;  bjs = 128; rot = false; }
        else if (pn == 8) { base = KW;                   pitch = 256;  bjs = 128; rot = true; }
        else if (pn == 9) { base = VW;                   pitch = 256;  bjs = 128; rot = false; }
        else if (pn < 14) { base = QM + (pn - 10) * 256; pitch = 1024; bjs = 128; rot = true; }
        else if (pn < 18) { base = KM + (pn - 14) * 256; pitch = 1024; bjs = 128; rot = true; }
        else              { base = VM + (pn - 18) * 256; pitch = 1024; bjs = 128; rot = false; }
#pragma unroll
        for (int ai = 0; ai < 2; ++ai)
#pragma unroll
            for (int m = 0; m < 4; ++m) { const int row = row0 + ai * 128 + m * 16;
                f32x4 t0 = (f32x4){1.f, 0.f, 1.f, 0.f}, t1 = t0;
                if (rot) { const f32x4* tp = (const f32x4*)(rope + (size_t)row * 128 + (c8 >> 1) * 2); t0 = tp[0]; t1 = tp[1]; }
#pragma unroll
                for (int bj = 0; bj < 2; ++bj) { f32x4 v0 = acc[ai][bj][m][0], v1 = acc[ai][bj][m][1];
                    if (rot) { f32x4 w0, w1;
                        w0[0] = v0[0] * t0[0] - v0[1] * t0[1]; w0[1] = v0[1] * t0[0] + v0[0] * t0[1]; w0[2] = v0[2] * t0[2] - v0[3] * t0[3]; w0[3] = v0[3] * t0[2] + v0[2] * t0[3];
                        w1[0] = v1[0] * t1[0] - v1[1] * t1[1]; w1[1] = v1[1] * t1[0] + v1[0] * t1[1]; w1[2] = v1[2] * t1[2] - v1[3] * t1[3]; w1[3] = v1[3] * t1[2] + v1[2] * t1[3];
                        v0 = w0; v1 = w1; }
                    pg8::u32x4 w; w.x = pg8::cvt_pk_bf16(v0[0], v0[1]); w.y = pg8::cvt_pk_bf16(v0[2], v0[3]); w.z = pg8::cvt_pk_bf16(v1[0], v1[1]); w.w = pg8::cvt_pk_bf16(v1[2], v1[3]);
                    *(pg8::u32x4*)(base + (size_t)row * pitch + bj * bjs + c8) = w; } }
    }
};
struct EpiOutProj {
    static constexpr bool PERM = false;
    const float* xsrc; float* X; const float* gt;
    __device__ __forceinline__ void operator()(const f32x4 (&acc)[2][2][4][2], const Unit& u, int wr, int wc, int fr, int fq) const {
        const int row0 = u.pm * 256 + wr * 64 + fr, col0 = u.pnl * 256 + wc * 32 + 4 * fq;
        f32x4 gv[2][2];
#pragma unroll
        for (int bj = 0; bj < 2; ++bj)
#pragma unroll
            for (int n = 0; n < 2; ++n) gv[bj][n] = *(const f32x4*)(gt + col0 + bj * 128 + n * 16);
#pragma unroll
        for (int ai = 0; ai < 2; ++ai)
#pragma unroll
            for (int m = 0; m < 4; ++m) { const size_t ro = (size_t)(row0 + ai * 128 + m * 16) * D_ + col0;
#pragma unroll
                for (int bj = 0; bj < 2; ++bj)
#pragma unroll
                    for (int n = 0; n < 2; ++n) { const f32x4 xv = *(const f32x4*)(xsrc + ro + bj * 128 + n * 16); *(f32x4*)(X + ro + bj * 128 + n * 16) = xv + gv[bj][n] * acc[ai][bj][m][n]; } }
    }
};
struct EpiF32 {
    static constexpr bool PERM = false;
    float* C; int ldc;
    __device__ __forceinline__ void operator()(const f32x4 (&acc)[2][2][4][2], const Unit& u, int wr, int wc, int fr, int fq) const {
        const int row0 = u.pm * 256 + wr * 64 + fr, col0 = u.pnl * 256 + wc * 32 + 4 * fq;
#pragma unroll
        for (int ai = 0; ai < 2; ++ai)
#pragma unroll
            for (int m = 0; m < 4; ++m) { float* rowp = C + (size_t)(row0 + ai * 128 + m * 16) * ldc + col0;
#pragma unroll
                for (int bj = 0; bj < 2; ++bj)
#pragma unroll
                    for (int n = 0; n < 2; ++n) *(f32x4*)(rowp + bj * 128 + n * 16) = acc[ai][bj][m][n]; }
    }
};
struct EpiGateUp {
    static constexpr bool PERM = true;
    bf16* HACT;
    __device__ __forceinline__ void operator()(const f32x4 (&acc)[2][2][4][2], const Unit& u, int wr, int wc, int fr, int fq) const {
        const int row0 = u.pm * 256 + wr * 64 + fr, col0 = u.pnl * 128 + wc * 32 + 8 * fq;
#pragma unroll
        for (int ai = 0; ai < 2; ++ai)
#pragma unroll
            for (int m = 0; m < 4; ++m) { const int row = row0 + ai * 128 + m * 16; f32x4 h[2];
#pragma unroll
                for (int n = 0; n < 2; ++n)
#pragma unroll
                    for (int j = 0; j < 4; ++j) { const float gg = acc[ai][0][m][n][j], uu = acc[ai][1][m][n][j]; h[n][j] = gg / (1.f + __expf(-gg)) * uu; }
                pg8::u32x4 w; w.x = pg8::cvt_pk_bf16(h[0][0], h[0][1]); w.y = pg8::cvt_pk_bf16(h[0][2], h[0][3]); w.z = pg8::cvt_pk_bf16(h[1][0], h[1][1]); w.w = pg8::cvt_pk_bf16(h[1][2], h[1][3]);
                *(pg8::u32x4*)(HACT + (size_t)row * DEXP + col0) = w; }
    }
};
struct EpiDown {
    static constexpr bool PERM = true;
    bf16* Y; const float* WTS; const LAS int* tab;
    __device__ __forceinline__ void operator()(const f32x4 (&acc)[2][2][4][2], const Unit& u, int wr, int wc, int fr, int fq) const {
        const int rl0 = wr * 64 + fr, col0 = u.pnl * 256 + wc * 32 + 8 * fq, cnt = tab[u.e];
#pragma unroll
        for (int ai = 0; ai < 2; ++ai)
#pragma unroll
            for (int m = 0; m < 4; ++m) { const int rl = rl0 + ai * 128 + m * 16, pos = u.mt * 256 + rl;
                const float w = (pos < cnt) ? WTS[(size_t)u.e * ECAP + pos] : 0.f;
                bf16* rowp = Y + (size_t)(u.pm * 256 + rl) * D_ + col0;
#pragma unroll
                for (int bj = 0; bj < 2; ++bj) { const f32x4 v0 = acc[ai][bj][m][0] * w, v1 = acc[ai][bj][m][1] * w;
                    pg8::u32x4 o; o.x = pg8::cvt_pk_bf16(v0[0], v0[1]); o.y = pg8::cvt_pk_bf16(v0[2], v0[3]); o.z = pg8::cvt_pk_bf16(v1[0], v1[1]); o.w = pg8::cvt_pk_bf16(v1[2], v1[3]);
                    *(pg8::u32x4*)(rowp + bj * 128) = o; } }
    }
};

struct CompressOrder {
    static constexpr bool GATHER = false;
    int G, c;
    __device__ bool next(int i, Unit& u) const { const int L = i * G + c; if (L >= 32) return false; u.pm = L >> 1; u.pnl = L & 1; u.pn = (u.pm >= 8 ? 2 : 0) + u.pnl; u.e = 0; u.mt = 0; return true; }
    __device__ __forceinline__ void a_offs(const Unit&, int, int, int, int, int, unsigned (&)[2][2]) const {}
    __device__ __forceinline__ void a_ready(const Unit&) const {}
    __device__ __forceinline__ void done(const Unit&) const {}
};
template <bool GATHER_>
struct MoeOrder {
    static constexpr bool GATHER = GATHER_;
    const LAS int* tab; int NT, G, c, bt_per_e, bt_base; const int* tokidx;
    __device__ bool next(int i, Unit& u) const {
        const int L = i * G + c; if (L >= tab[64]) return false;
        int e = 0;
        for (int k = 1; k < NEXP; ++k) e += (L >= tab[32 + k]) ? 1 : 0;
        e = __builtin_amdgcn_readfirstlane(e);
        const int r = L - tab[32 + e];
        u.e = e; u.mt = r / NT; u.pnl = r % NT; u.pn = bt_base + e * bt_per_e + u.pnl; u.pm = (tab[65 + e] >> 8) + u.mt; return true;
    }
    __device__ __forceinline__ void a_offs(const Unit& u, int R0, int R1, int C0, int C1, int K, unsigned (&o)[2][2]) const {
        const int cnt = tab[u.e]; const int* tk = tokidx + (size_t)u.e * ECAP;
#pragma unroll
        for (int h = 0; h < 2; ++h) {
            int p0 = u.mt * 256 + h * 128 + R0, p1 = u.mt * 256 + h * 128 + R1; p0 = p0 < cnt ? p0 : cnt - 1; p1 = p1 < cnt ? p1 : cnt - 1;
            o[h][0] = ((unsigned)tk[p0] * (unsigned)K + (unsigned)C0) * 2u; o[h][1] = ((unsigned)tk[p1] * (unsigned)K + (unsigned)C1) * 2u; }
    }
    __device__ __forceinline__ void a_ready(const Unit&) const {}
    __device__ __forceinline__ void done(const Unit&) const {}
};

namespace att {
constexpr int D = 128, NW = 8, QBLK = 32, KVBLK = 64, QB = NW * QBLK;
constexpr int SHM_V = KVBLK * D * 2, SHM_K = KVBLK * D * 2;
constexpr int OFF_WS = 2 * SHM_V + 2 * SHM_K, OFF_OT = OFF_WS + NW * 64 * 4, LDS_BYTES = OFF_OT + NW * 32 * 4;
constexpr int OFF_ST = 73728, ST_ROW = 272, ST_WAVE = 16 * ST_ROW;
constexpr float SCALE = 0.08838834764831845f, THR = 8.f;
typedef short bf16x8 __attribute__((ext_vector_type(8)));
typedef short s16x4 __attribute__((ext_vector_type(4)));
typedef float f32x16 __attribute__((ext_vector_type(16)));
typedef float f32x4 __attribute__((ext_vector_type(4)));
typedef unsigned u32x4 __attribute__((ext_vector_type(4)));
typedef unsigned short bf16;
#define KSWZ(row, colB) ((row) * 256 + ((colB) ^ (((row) & 7) << 4)))
#define SBAR() __builtin_amdgcn_sched_barrier(0)
__device__ __forceinline__ int v_st(int k, int c) { const int kk = (k & ~0xC) | ((k & 4) << 1) | ((k & 8) >> 1); return ((kk >> 3) * 4 + (c >> 5)) * 512 + ((kk & 7) * 32 + (c & 31)) * 2; }
__device__ __forceinline__ int v_rd_base(int lane) { return ((lane & 3) << 3) | (((lane >> 2) & 3) << 6) | (((lane >> 4) & 1) << 5) | (((lane >> 5) & 1) << 8); }
constexpr int v_rd_off(int d0, int ks, int half) { return d0 * 512 + ks * 4096 + half * 2048; }
__device__ __forceinline__ int crow(int r, int hi) { return (r & 3) + 8 * (r >> 2) + 4 * hi; }
__device__ __forceinline__ unsigned cvtpk(float lo, float hi) { unsigned r; asm volatile("v_cvt_pk_bf16_f32 %0, %1, %2" : "=v"(r) : "v"(lo), "v"(hi)); return r; }
__device__ __forceinline__ bf16x8 load8(const bf16* p) { return *reinterpret_cast<const bf16x8*>(p); }
__device__ __forceinline__ void mask_tile(f32x16& p0, f32x16& p1, int dq, unsigned W) {
    const float NEG = -__builtin_inff();
#pragma unroll
    for (int r = 0; r < 16; ++r) {
        const int c = (r & 3) + 8 * (r >> 2);
        if ((unsigned)(dq - c) >= W) p0[r] = NEG;
        if ((unsigned)(dq - c - 32) >= W) p1[r] = NEG;
    }
}
__device__ __forceinline__ void partialSM(f32x16& p0, f32x16& p1, float& m_reg, float& mn, float& alpha) {
    float pmax = p0[0]; for (int r = 1; r < 16; ++r) pmax = fmaxf(pmax, p0[r]); for (int r = 0; r < 16; ++r) pmax = fmaxf(pmax, p1[r]);
    { auto rr = __builtin_amdgcn_permlane32_swap(__float_as_uint(pmax), __float_as_uint(pmax), false, false);
      pmax = fmaxf(__uint_as_float(rr[0]), __uint_as_float(rr[1])); }
    constexpr float C2 = 1.4426950408889634f * SCALE;
    if (__builtin_expect(__all((pmax - m_reg) * SCALE <= THR), 1)) { mn = m_reg; alpha = 1.f; }
    else { mn = fmaxf(m_reg, pmax); alpha = __builtin_amdgcn_exp2f((m_reg - mn) * C2); m_reg = mn; }
    const float mnL = -mn * C2;
    for (int r = 0; r < 16; ++r) p0[r] = fmaf(p0[r], C2, mnL); for (int r = 0; r < 16; ++r) p1[r] = fmaf(p1[r], C2, mnL);
    for (int r = 0; r < 16; ++r) p0[r] = __builtin_amdgcn_exp2f(p0[r]);
}
__device__ __forceinline__ void finishSM(f32x16& p0, f32x16& p1, float alpha, float& l_reg, bf16x8& pa0, bf16x8& pa1, bf16x8& pa2, bf16x8& pa3) {
    for (int r = 0; r < 16; ++r) p1[r] = __builtin_amdgcn_exp2f(p1[r]);
    float ps = 0; for (int r = 0; r < 16; ++r) ps += p0[r]; for (int r = 0; r < 16; ++r) ps += p1[r];
    { auto rr = __builtin_amdgcn_permlane32_swap(__float_as_uint(ps), __float_as_uint(ps), false, false);
      ps = __uint_as_float(rr[0]) + __uint_as_float(rr[1]); }
    l_reg = l_reg * alpha + ps;
#define PK4(P, B_, OUT) do { unsigned a0 = cvtpk(P[B_+0], P[B_+1]), a1 = cvtpk(P[B_+2], P[B_+3]);                          \
        unsigned b0 = cvtpk(P[B_+4], P[B_+5]), b1 = cvtpk(P[B_+6], P[B_+7]);                                             \
        auto r0 = __builtin_amdgcn_permlane32_swap(a0, b0, false, false); auto r1 = __builtin_amdgcn_permlane32_swap(a1, b1, false, false); \
        u32x4 w = {r0[0], r1[0], r0[1], r1[1]}; OUT = *reinterpret_cast<bf16x8*>(&w); } while (0)
    PK4(p0, 0, pa0); PK4(p0, 8, pa1); PK4(p1, 0, pa2); PK4(p1, 8, pa3);
#undef PK4
}
template <int KB, bool SK>
__device__ __forceinline__ void qkt(f32x16& p0, f32x16& p1, const char* K_lds, int r32, int hi, const bf16x8* qr, bool act) {
    if (SK && !act) { const float NEG = -__builtin_inff();
#pragma unroll
        for (int r = 0; r < 16; ++r) { p0[r] = NEG; p1[r] = NEG; } return; }
    p0 = f32x16{}; p1 = f32x16{};
    const char* kb[4];
#pragma unroll
    for (int dd = 0; dd < 4; ++dd) kb[dd] = K_lds + KB * SHM_K + KSWZ(r32, (dd * 16 + hi * 8) * 2);
#pragma unroll
    for (int d0 = 0; d0 < 8; ++d0) { const char* a = kb[d0 & 3] + (d0 >> 2) * 128;
        bf16x8 b0 = *reinterpret_cast<const bf16x8*>(a);
        bf16x8 b1 = *reinterpret_cast<const bf16x8*>(a + 32 * 256);
        p0 = __builtin_amdgcn_mfma_f32_32x32x16_bf16(b0, qr[d0], p0, 0, 0, 0);
        p1 = __builtin_amdgcn_mfma_f32_32x32x16_bf16(b1, qr[d0], p1, 0, 0, 0); }
}
template <int VB, bool SK>
__device__ __forceinline__ void pv_tile(f32x16* o, int vb0, bf16x8 pa0, bf16x8 pa1, bf16x8 pa2, bf16x8 pa3, bool act) {
    if (SK && !act) return;
#define TRRD(dst, off) asm volatile("ds_read_b64_tr_b16 %0, %1 offset:%2" : "=&v"(dst) : "v"(vb0), "i"(off) : "memory")
#define PV_D0(d0) do { s16x4 l0, l1, l2, l3, h0, h1, h2, h3; constexpr int b_ = VB * SHM_V + v_rd_off(d0, 0, 0); \
        TRRD(l0, b_); TRRD(h0, b_ + 2048); TRRD(l1, b_ + 4096); TRRD(h1, b_ + 6144); TRRD(l2, b_ + 8192); TRRD(h2, b_ + 10240); TRRD(l3, b_ + 12288); TRRD(h3, b_ + 14336); \
        asm volatile("s_waitcnt lgkmcnt(0)" ::: "memory"); SBAR();   \
        o[d0] = __builtin_amdgcn_mfma_f32_32x32x16_bf16(pa0, (bf16x8){l0[0], l0[1], l0[2], l0[3], h0[0], h0[1], h0[2], h0[3]}, o[d0], 0, 0, 0);   \
        o[d0] = __builtin_amdgcn_mfma_f32_32x32x16_bf16(pa1, (bf16x8){l1[0], l1[1], l1[2], l1[3], h1[0], h1[1], h1[2], h1[3]}, o[d0], 0, 0, 0);   \
        o[d0] = __builtin_amdgcn_mfma_f32_32x32x16_bf16(pa2, (bf16x8){l2[0], l2[1], l2[2], l2[3], h2[0], h2[1], h2[2], h2[3]}, o[d0], 0, 0, 0);   \
        o[d0] = __builtin_amdgcn_mfma_f32_32x32x16_bf16(pa3, (bf16x8){l3[0], l3[1], l3[2], l3[3], h3[0], h3[1], h3[2], h3[3]}, o[d0], 0, 0, 0); } while (0)
    PV_D0(0); PV_D0(1); PV_D0(2); PV_D0(3);
#undef PV_D0
#undef TRRD
}
struct Ref { const bf16* Q; const bf16* K; const bf16* V; bf16* O; const int* list; int kpitch, j_lo, j_hi, P0, W, a0, a1, nm_lo, nm_hi; };
struct Seam { bf16x8 qr[8]; bf16x8 st_v0, st_v1, st_k0, st_k1; };
#define ROW(p, kp, k0, rr) ((p) + (size_t)((k0) + (rr)) * (kp) + sc)
#define VMW() asm volatile("s_waitcnt vmcnt(0)" ::: "memory")
#define VMWN(n) asm volatile("s_waitcnt vmcnt(%0)" :: "i"(n) : "memory")
#define SLOAD_H(Kp, Vp, kp, k0) do { S.st_v0 = load8(ROW(Vp, kp, k0, sr)); S.st_v1 = load8(ROW(Vp, kp, k0, 32 + sr));              \
                         S.st_k0 = load8(ROW(Kp, kp, k0, sr)); S.st_k1 = load8(ROW(Kp, kp, k0, 32 + sr)); } while (0)
#define SWRITE_HK(bf) do { *(bf16x8*)(K_lds + (bf) * SHM_K + kws) = S.st_k0; *(bf16x8*)(K_lds + (bf) * SHM_K + kws + 32 * 256) = S.st_k1; } while (0)
#define SWRITE_HV(bf) do { *(bf16x8*)(V_lds + (bf) * SHM_V + vst0) = S.st_v0; *(bf16x8*)(V_lds + (bf) * SHM_V + vst1) = S.st_v1; } while (0)
#define SWRITE_H(bf) do { SWRITE_HV(bf); SWRITE_HK(bf); } while (0)
template <class RF>
__device__ __forceinline__ void prime(const Ref& cur, char* lds, Seam& S) {
    const int tid_ = wg_tid((const __attribute__((address_space(3))) int*)(uintptr_t)(unsigned)(uintptr_t)(lds + WIDTAB_OFF));
    const int tid = tid_, wid = __builtin_amdgcn_readfirstlane(tid >> 6), lane = tid & 63, r32 = lane & 31, hi = lane >> 5;
    const int sr = tid >> 4, sc = (tid & 15) * 8, kws = KSWZ(sr, sc * 2); char* K_lds = lds + 2 * SHM_V;
    const int kb0 = cur.j_lo * KVBLK;
    { const bf16* qrow = cur.Q + RF::q_off(cur, wid * QBLK + r32, RF::entry(cur, wid * QBLK + r32));
      for (int d0 = 0; d0 < 8; ++d0) S.qr[d0] = load8(qrow + d0 * 16 + hi * 8); }
    SLOAD_H(cur.K, cur.V, cur.kpitch, kb0); VMW(); SWRITE_HK(0);
    __syncthreads();
}
template <int MODE, bool WSKIP, class RF, bool O8 = false, bool ONE = false>
__device__ __forceinline__ void block(const Ref& cur, const Ref& nxt, float* LSE, char* lds, Seam& S, float* lse_lane = nullptr) {
    const int tid_ = wg_tid((const __attribute__((address_space(3))) int*)(uintptr_t)(unsigned)(uintptr_t)(lds + WIDTAB_OFF));
    const int tid = tid_, wid = __builtin_amdgcn_readfirstlane(tid >> 6), lane = tid & 63, r32 = lane & 31, hi = lane >> 5;
    const int j_lo = cur.j_lo, NT = cur.j_hi - cur.j_lo;
    const int kbn = nxt.j_lo * KVBLK;
    const int W = cur.W;
    const int qlo = cur.P0 + wid * QBLK;
    const int e_cur = RF::entry(cur, wid * QBLK + r32), e_nxt = RF::entry(nxt, wid * QBLK + r32);
    const int qm = (MODE == 2 ? RF::pos(cur, wid * QBLK + r32, e_cur) : qlo + r32) - 4 * hi;
    const unsigned Wm = (MODE == 2) ? (unsigned)RF::Wl(cur, wid * QBLK + r32) : (unsigned)W;
    char* V_lds = lds; char* K_lds = lds + 2 * SHM_V;
    float* ws = (float*)(lds + OFF_WS) + wid * 64; float* li_l = ws, * al_l = ws + 32; int* ot_l = (int*)(lds + OFF_OT) + wid * 32;
    float m_reg = -1e30f, l_reg = 0; f32x16 o[4] = {};
    const int sr = tid >> 4, sc = (tid & 15) * 8, vst0 = v_st(sr, sc), vst1 = v_st(32 + sr, sc), kws = KSWZ(sr, sc * 2);
    const int vb0 = (int)(uintptr_t)V_lds + v_rd_base(lane);
    const bf16* Kh = cur.K; const bf16* Vh = cur.V; const int kp = cur.kpitch;
#define RESC(a) do { if (__any((a) < 1.f)) { if (hi == 0) al_l[r32] = (a); asm volatile("s_waitcnt lgkmcnt(0)" ::: "memory");              \
                     for (int d_ = 0; d_ < 4; ++d_) for (int r = 0; r < 16; ++r) o[d_][r] *= al_l[crow(r, hi)]; } } while (0)
#define KBASE(t) ((j_lo + (t)) * KVBLK)
#define ACT(t) (MODE != 0 || (KBASE(t) <= qlo + QBLK - 1 && KBASE(t) + KVBLK - 1 >= qlo - W + 1))
#define MASKT(P0_, P1_, t) do { const int kb_ = KBASE(t); if (MODE == 2) { const int jt_ = j_lo + (t); if (!(jt_ >= cur.nm_lo && jt_ < cur.nm_hi)) mask_tile(P0_, P1_, qm - kb_, Wm); } \
        else if (MODE == 0) { if ((!SK || ACT(t)) && (kb_ + KVBLK - 1 > qlo || kb_ <= qlo + QBLK - 1 - W)) mask_tile(P0_, P1_, qm - kb_, Wm); } } while (0)
    constexpr int NQL = 8;
    constexpr bool SK = WSKIP && MODE == 0;
#define SEAM_K0() do { VMWN(NQL); SWRITE_HK(0); SBAR(); } while (0)
    f32x16 pA0, pA1, pB0, pB1; float mnA, mnB, alA, alB; bf16x8 pa0, pa1, pa2, pa3;
    SWRITE_HV(0); SBAR();
    if constexpr (ONE) { SLOAD_H(nxt.K, nxt.V, nxt.kpitch, kbn); SBAR(); }
    if (NT > 1) { SLOAD_H(Kh, Vh, kp, KBASE(1)); }
    SBAR(); qkt<0, SK>(pA0, pA1, K_lds, r32, hi, S.qr, ACT(0));
    MASKT(pA0, pA1, 0); partialSM(pA0, pA1, m_reg, mnA, alA);
    if (NT > 1) { VMW(); SWRITE_H(1); }
    __syncthreads();
#define HALF_STEP(PX0, PX1, mnX, alX, PY0, PY1, alY, t, KB, VB, SB) do {                                                      \
        SBAR(); qkt<KB, SK>(PX0, PX1, K_lds, r32, hi, S.qr, ACT(t));                                             \
        finishSM(PY0, PY1, alY, l_reg, pa0, pa1, pa2, pa3); SBAR();                                                           \
        if ((t) + 1 < NT) { SLOAD_H(Kh, Vh, kp, KBASE((t) + 1)); SBAR(); }                                               \
        pv_tile<VB, SK>(o, vb0, pa0, pa1, pa2, pa3, ACT((t) - 1)); MASKT(PX0, PX1, (t)); partialSM(PX0, PX1, m_reg, mnX, alX);                                        \
        __syncthreads();                                                                                                      \
        if ((t) + 1 < NT) { VMW(); SWRITE_H(SB); }                                                                          \
        RESC(alX); __syncthreads(); } while (0)
    for (int t = 1; t + 1 < NT; t += 2) {
        HALF_STEP(pB0, pB1, mnB, alB, pA0, pA1, alA, t, 1, 0, 0);
        HALF_STEP(pA0, pA1, mnA, alA, pB0, pB1, alB, t + 1, 0, 1, 1);
    }
    const bool even = (NT & 1) == 0;
    if (even) { SBAR(); qkt<1, SK>(pB0, pB1, K_lds, r32, hi, S.qr, ACT(NT - 1)); SBAR(); }
    if constexpr (!ONE) { SLOAD_H(nxt.K, nxt.V, nxt.kpitch, kbn); SBAR(); }
    { const bf16* qrow = nxt.Q + RF::q_off(nxt, wid * QBLK + r32, e_nxt);
#pragma unroll
      for (int d0 = 0; d0 < 8; ++d0) S.qr[d0] = load8(qrow + d0 * 16 + hi * 8); }
    SBAR();
    finishSM(pA0, pA1, alA, l_reg, pa0, pa1, pa2, pa3); SBAR();
    pv_tile<0, SK>(o, vb0, pa0, pa1, pa2, pa3, ACT(even ? NT - 2 : NT - 1));
    if (even) { MASKT(pB0, pB1, NT - 1); partialSM(pB0, pB1, m_reg, mnB, alB); __syncthreads(); RESC(alB);
        finishSM(pB0, pB1, alB, l_reg, pa0, pa1, pa2, pa3); SBAR(); pv_tile<1, SK>(o, vb0, pa0, pa1, pa2, pa3, ACT(NT - 1)); }
    SBAR(); SEAM_K0();
    if (hi == 0) { li_l[r32] = l_reg; ot_l[r32] = RF::o_off(cur, wid * QBLK + r32, e_cur); } asm volatile("s_waitcnt lgkmcnt(0)" ::: "memory");
    if (LSE != nullptr && hi == 0) { const int lq = RF::l_idx(cur, wid * QBLK + r32, e_cur); if (lq >= 0) LSE[lq] = (l_reg > 0.f) ? m_reg * SCALE + __logf(l_reg) : -__builtin_inff(); }
    if (lse_lane != nullptr) *lse_lane = (l_reg > 0.f) ? m_reg * SCALE + __logf(l_reg) : -__builtin_inff();
    bf16* O = cur.O;
    { char* stg = lds + OFF_ST + wid * ST_WAVE;
#pragma unroll 1
      for (int p = 0; p < 2; ++p) {
#pragma unroll
        for (int rr = 0; rr < 8; ++rr) { const int r = 8 * p + rr, orow = crow(r, hi); const float lv = li_l[orow]; const float rl = (lv > 0.f) ? __builtin_amdgcn_rcpf(lv) : 0.f;
#pragma unroll
            for (int d0 = 0; d0 < 4; ++d0) {
                if constexpr (O8) *(unsigned char*)(stg + (orow - 16 * p) * ST_ROW + (d0 * 32 + r32)) = (unsigned char)__builtin_amdgcn_cvt_pk_fp8_f32(o[d0][r] * rl * 16.f, 0.f, 0, false);
                else *(unsigned short*)(stg + (orow - 16 * p) * ST_ROW + (d0 * 32 + r32) * 2) = (unsigned short)cvtpk(o[d0][r] * rl, 0.f); } }
        asm volatile("s_waitcnt lgkmcnt(0)" ::: "memory");
        { const int row = lane >> 2, ch = lane & 3, oo = ot_l[16 * p + row];
          if constexpr (O8) {
#pragma unroll
            for (int i = 0; i < 2; ++i) { const u32x4 x = *(const u32x4*)(stg + row * ST_ROW + (i * 4 + ch) * 16); if (oo >= 0) *(u32x4*)((char*)O + (size_t)oo + (i * 4 + ch) * 16) = x; }
          } else {
#pragma unroll
            for (int i = 0; i < 4; ++i) { const u32x4 x = *(const u32x4*)(stg + row * ST_ROW + (i * 4 + ch) * 16); if (oo >= 0) *(u32x4*)(O + (size_t)oo + (i * 4 + ch) * 8) = x; } } }
        asm volatile("s_waitcnt lgkmcnt(0)" ::: "memory");
      } }
    __syncthreads();
#undef RESC
#undef KBASE
#undef ACT
#undef MASKT
#undef SEAM_K0
#undef HALF_STEP
}

template <class RF>
__device__ __forceinline__ void imp_sweep(const Ref& cur, float lse_lane, float* IMP  , char* lds, Seam& S) {
    const int tid_ = wg_tid((const __attribute__((address_space(3))) int*)(uintptr_t)(unsigned)(uintptr_t)(lds + WIDTAB_OFF));
    const int tid = tid_, wid = __builtin_amdgcn_readfirstlane(tid >> 6), lane = tid & 63, r32 = lane & 31, hi = lane >> 5;
    const int NT = cur.j_hi - cur.j_lo;
    char* K_lds = lds + 2 * SHM_V;
    const int sr = tid >> 4, sc = (tid & 15) * 8, kws = KSWZ(sr, sc * 2);
    const bf16* Kh = cur.K; const int kp = cur.kpitch;
    const int row = wid * QBLK + r32;
    const int qm = RF::pos(cur, row, RF::entry(cur, row)) - 4 * hi; const unsigned Wm = (unsigned)RF::Wl(cur, row);
    constexpr float C2 = 1.4426950408889634f * SCALE;
    const float nl2 = (lse_lane == -__builtin_inff()) ? 0.f : -lse_lane * 1.4426950408889634f;
    float carry = 0.f;
    float* imp_row = IMP + (size_t)(row >> 2) * 512;
    f32x16 p0, p1;
#define IMP_TILE(t, KB) do { \
        if ((t) + 1 < NT) { S.st_k0 = load8(ROW(Kh, kp, (cur.j_lo + (t) + 1) * KVBLK, sr)); S.st_k1 = load8(ROW(Kh, kp, (cur.j_lo + (t) + 1) * KVBLK, 32 + sr)); } \
        SBAR(); qkt<KB, false>(p0, p1, K_lds, r32, hi, S.qr, true); \
        { const int jt_ = cur.j_lo + (t); if (!(jt_ >= cur.nm_lo && jt_ < cur.nm_hi)) mask_tile(p0, p1, qm - jt_ * KVBLK, Wm); } \
        _Pragma("unroll") for (int r = 0; r < 16; ++r) { p0[r] = __builtin_amdgcn_exp2f(fmaf(p0[r], C2, nl2)); p1[r] = __builtin_amdgcn_exp2f(fmaf(p1[r], C2, nl2)); } \
        float Gs[8], Ls[8]; \
        _Pragma("unroll") for (int q = 0; q < 4; ++q) { Gs[q] = (p0[4 * q] + p0[4 * q + 1]) + (p0[4 * q + 2] + p0[4 * q + 3]); Ls[q] = p0[4 * q + 3]; \
                                              Gs[4 + q] = (p1[4 * q] + p1[4 * q + 1]) + (p1[4 * q + 2] + p1[4 * q + 3]); Ls[4 + q] = p1[4 * q + 3]; } \
          \
        float prevL = carry; \
        _Pragma("unroll") for (int q = 0; q < 8; ++q) { const float other = lane_get(Ls[q], lane ^ 32);        \
            const float add = hi ? other : prevL; prevL = other; Gs[q] += add; } \
        carry = prevL;                                            \
        _Pragma("unroll") for (int q = 0; q < 8; ++q) { float v = Gs[q]; v += lane_get(v, lane ^ 1); v += lane_get(v, lane ^ 2); \
            if ((r32 & 3) == 0) imp_row[((cur.j_lo + (t)) << 4) + 2 * q + hi] = v; } \
        if ((t) + 1 < NT) { asm volatile("s_waitcnt vmcnt(0)" ::: "memory"); *(bf16x8*)(K_lds + ((KB) ^ 1) * SHM_K + kws) = S.st_k0; *(bf16x8*)(K_lds + ((KB) ^ 1) * SHM_K + kws + 32 * 256) = S.st_k1; } \
        __syncthreads(); } while (0)
    for (int t = 0; t < NT; t += 2) { IMP_TILE(t, 0); if (t + 1 < NT) IMP_TILE(t + 1, 1); }
#undef IMP_TILE
}

template <class RF>
__device__ __forceinline__ void gate_unit(const Ref& cur, int nvis, char* lds, Seam& S, int (&sel)[3]) {
    const int tid_ = wg_tid((const __attribute__((address_space(3))) int*)(uintptr_t)(unsigned)(uintptr_t)(lds + WIDTAB_OFF));
    const int lane = tid_ & 63, r32 = lane & 31, hi = lane >> 5;
    char* K_lds = lds + 2 * SHM_V;
    prime<RF>(cur, lds, S);
    f32x16 p0, p1;
    qkt<0, false>(p0, p1, K_lds, r32, hi, S.qr, true);
    const float NEG = -__builtin_inff();
#pragma unroll
    for (int r = 0; r < 16; ++r) { const int k = crow(r, hi); if (k >= nvis) p0[r] = NEG; if (k + 32 >= nvis) p1[r] = NEG; }
    float bv[3]; int bk[3];
#pragma unroll
    for (int rd = 0; rd < 3; ++rd) { float best = NEG; int kb = 64;
#pragma unroll
        for (int r = 0; r < 16; ++r) if (p0[r] > best) { best = p0[r]; kb = crow(r, hi); }
#pragma unroll
        for (int r = 0; r < 16; ++r) if (p1[r] > best) { best = p1[r]; kb = 32 + crow(r, hi); }
        bv[rd] = best; bk[rd] = kb;
#pragma unroll
        for (int r = 0; r < 16; ++r) { if (crow(r, hi) == kb) p0[r] = NEG; if (32 + crow(r, hi) == kb) p1[r] = NEG; } }
    float ov[3]; int ok[3];
#pragma unroll
    for (int i = 0; i < 3; ++i) { ov[i] = lane_get(bv[i], lane ^ 32); ok[i] = lane_geti(bk[i], lane ^ 32); }
    int ia = 0, ib = 0;
#pragma unroll
    for (int rd = 0; rd < 3; ++rd) { const float va = ia == 0 ? bv[0] : (ia == 1 ? bv[1] : (ia == 2 ? bv[2] : NEG)), vb = ib == 0 ? ov[0] : (ib == 1 ? ov[1] : (ib == 2 ? ov[2] : NEG));
        const int ka = ia == 0 ? bk[0] : (ia == 1 ? bk[1] : (ia == 2 ? bk[2] : 64)), kb = ib == 0 ? ok[0] : (ib == 1 ? ok[1] : (ib == 2 ? ok[2] : 64));
        const bool ta = va > vb || (va == vb && ka < kb);
        const float v = ta ? va : vb; const int k = ta ? ka : kb; ia += ta ? 1 : 0; ib += ta ? 0 : 1;
        sel[rd] = (v == NEG) ? -1 : k; }
    __syncthreads();
}
#undef ROW
#undef VMW
#undef VMWN
#undef SLOAD_H
#undef SWRITE_HK
#undef SWRITE_HV
#undef SWRITE_H
#undef KSWZ
#undef SBAR
}

struct RFReg {
    static __device__ __forceinline__ int entry(const att::Ref&, int) { return 0; }
    static __device__ __forceinline__ int q_off(const att::Ref&, int row, int) { return row * 1024; }
    static __device__ __forceinline__ int o_off(const att::Ref&, int row, int) { return row * 1024; }
    static __device__ __forceinline__ int l_idx(const att::Ref& u, int row, int) { return u.a0 >= 0 ? u.a0 + row * 8 : -1; }
    static __device__ __forceinline__ int pos(const att::Ref& u, int row, int) { return u.P0 + row; }
    static __device__ __forceinline__ int Wl(const att::Ref& u, int) { return u.W; }
};
__device__ __forceinline__ att::Ref win_ref(int L, const bf16* QN, const bf16* KW, const bf16* VW, bf16* OWIN) {
    const int h = L & 7, qb = L >> 3;
    att::Ref r; r.Q = QN + (size_t)qb * 256 * 1024 + h * 128; r.O = OWIN + (size_t)qb * 256 * 1024 + h * 128; r.K = KW + (h >> 2) * 128; r.V = VW + (h >> 2) * 128; r.kpitch = 256; r.list = nullptr;
    r.P0 = qb * 256; r.W = 512; r.j_lo = (r.P0 >= 511) ? (r.P0 - 511) >> 6 : 0; r.j_hi = ((r.P0 + 255) >> 6) + 1; r.a0 = -1; r.a1 = 0; r.nm_lo = 0; r.nm_hi = 0; return r;
}
__device__ __forceinline__ att::Ref mown_ref(int L, const bf16* QM, const bf16* KM, const bf16* VM, bf16* POWN) {
    const int h = L & 7, n = L >> 3; const size_t o = (size_t)n * 256 * 1024 + h * 128;
    att::Ref r; r.Q = QM + o; r.O = POWN + o; r.K = KM + o; r.V = VM + o; r.kpitch = 1024; r.list = nullptr;
    r.P0 = 0; r.W = 1 << 20; r.j_lo = 0; r.j_hi = 4; r.a0 = n * 256 * 8 + h; r.a1 = 0; r.nm_lo = 0; r.nm_hi = 0; return r;
}
struct RFSel {
    static __device__ __forceinline__ int entry(const att::Ref& u, int row) { return u.list[row < u.a0 ? row : 0]; }
    static __device__ __forceinline__ int q_off(const att::Ref&, int, int e) { return (e >> 2) * 1024; }
    static __device__ __forceinline__ int o_off(const att::Ref& u, int row, int e) { return row < u.a0 ? (((e >> 2) * 8 + u.a1) * 3 + (e & 3)) * 128 : -1; }
    static __device__ __forceinline__ int l_idx(const att::Ref& u, int row, int e) { return row < u.a0 ? ((e >> 2) * 8 + u.a1) * 3 + (e & 3) : -1; }
    static __device__ __forceinline__ int pos(const att::Ref&, int, int) { return 0; }
    static __device__ __forceinline__ int Wl(const att::Ref&, int) { return 0; }
};
__device__ __forceinline__ att::Ref msel_ref(int L, const LAS int* tab, const LAS unsigned short* ulist, const int* MLIST, const bf16* QM, const bf16* KM, const bf16* VM, bf16* PSEL) {
    const int lid = __builtin_amdgcn_readfirstlane((int)ulist[L]), k = L - tab[512 + lid], h = lid >> 6, n = lid & 63;
    att::Ref r; r.Q = QM + h * 128; r.O = PSEL; r.K = KM + (size_t)n * 256 * 1024 + h * 128; r.V = VM + (size_t)n * 256 * 1024 + h * 128; r.kpitch = 1024;
    r.list = MLIST + (size_t)lid * 16384 + k * 256; r.P0 = 0; r.W = 0; r.j_lo = 0; r.j_hi = 4; r.a0 = tab[lid] - k * 256; r.a1 = h; r.nm_lo = 0; r.nm_hi = 0; return r;
}

struct RFSlc {
    static __device__ __forceinline__ int entry(const att::Ref& u, int row) { return u.list[(row >> 2) < u.a0 ? (row >> 2) : 0]; }
    static __device__ __forceinline__ int q_off(const att::Ref&, int row, int e) { return (e >> 4) * 1024 + (row & 3) * 128; }
    static __device__ __forceinline__ int l_idx(const att::Ref& u, int row, int e) { return (row >> 2) < u.a0 ? ((((e >> 4) * 2 + (u.a1 >> 16)) * 16 + (e & 15)) * 4 + (row & 3)) : -1; }
    static __device__ __forceinline__ int o_off(const att::Ref& u, int row, int e) { const int i = l_idx(u, row, e); return i >= 0 ? i * 128 : -1; }
    static __device__ __forceinline__ int pos(const att::Ref& u, int, int e) { return (e >> 4) - 64 * (u.a1 & 0xffff); }
    static __device__ __forceinline__ int Wl(const att::Ref&, int) { return 1 << 30; }
};
__device__ __forceinline__ att::Ref nsel_ref(int L, const LAS int* tab, const LAS unsigned short* ulist, const int* NLIST, const bf16* QN, const bf16* KS, const bf16* VS, bf16* PSLC) {
    const int lid = __builtin_amdgcn_readfirstlane((int)ulist[L]), k = L - tab[512 + lid], g = lid >> 8, j = lid & 255;
    att::Ref r; r.Q = QN + g * 512; r.O = PSLC; r.K = KS + (size_t)j * 64 * 256 + g * 128; r.V = VS + (size_t)j * 64 * 256 + g * 128; r.kpitch = 256;
    r.list = NLIST + (size_t)lid * 16384 + k * 64; r.P0 = 0; r.W = 0; r.j_lo = 0; r.j_hi = 1; r.a0 = tab[lid] - k * 64; r.a1 = j | (g << 16); r.nm_lo = 0; r.nm_hi = (k >= 1) ? 1 : 0; return r;
}

struct RFCmp {
    static __device__ __forceinline__ int entry(const att::Ref&, int) { return 0; }
    static __device__ __forceinline__ int q_off(const att::Ref&, int row, int) { return (row >> 2) * 1024 + (row & 3) * 128; }
    static __device__ __forceinline__ int o_off(const att::Ref&, int row, int) { return (row >> 2) * 1024 + (row & 3) * 128; }
    static __device__ __forceinline__ int l_idx(const att::Ref&, int, int) { return -1; }
    static __device__ __forceinline__ int pos(const att::Ref& u, int row, int) { const int t = u.P0 + (row >> 2); return t >= 31 ? (t - 31) >> 4 : -1; }
    static __device__ __forceinline__ int Wl(const att::Ref&, int) { return 1 << 30; }
};
__device__ __forceinline__ att::Ref cmp_ref(int L, const bf16* QN, const bf16* KCMP, const bf16* VCMP, bf16* OCMP) {
    const int g = L & 1, c = (L < 256) ? (L >> 1) : 255 - ((L - 256) >> 1);
    att::Ref r; r.Q = QN + (size_t)c * 64 * 1024 + g * 512; r.O = OCMP + (size_t)c * 64 * 1024 + g * 512; r.K = KCMP + g * 128; r.V = VCMP + g * 128; r.kpitch = 256; r.list = nullptr;
    r.P0 = c * 64; r.W = 0; r.j_lo = 0; r.j_hi = (4 * c + 3 + 63) >> 6; r.a0 = g; r.a1 = c; r.nm_lo = 0; r.nm_hi = (c >= 1) ? ((((64 * c - 31) >> 4) + 1) >> 6) : 0; return r;
}

struct RFWinG {
    static __device__ __forceinline__ int entry(const att::Ref&, int) { return 0; }
    static __device__ __forceinline__ int q_off(const att::Ref&, int row, int) { return (row >> 2) * 1024 + (row & 3) * 128; }
    static __device__ __forceinline__ int o_off(const att::Ref&, int row, int) { return (row >> 2) * 1024 + (row & 3) * 128; }
    static __device__ __forceinline__ int l_idx(const att::Ref&, int, int) { return -1; }
    static __device__ __forceinline__ int pos(const att::Ref& u, int row, int) { return u.P0 + (row >> 2); }
    static __device__ __forceinline__ int Wl(const att::Ref&, int) { return 512; }
};
__device__ __forceinline__ att::Ref wing_ref(int L, const bf16* QN, const bf16* KW, const bf16* VW, bf16* OWIN) {
    const int g = L & 1, c = L >> 1;
    att::Ref r; r.Q = QN + (size_t)c * 64 * 1024 + g * 512; r.O = OWIN + (size_t)c * 64 * 1024 + g * 512; r.K = KW + g * 128; r.V = VW + g * 128; r.kpitch = 256; r.list = nullptr;
    r.P0 = c * 64; r.W = 512; r.j_lo = (c >= 8) ? c - 8 : 0; r.j_hi = c + 1; r.a0 = -1; r.a1 = 0; r.nm_lo = (c >= 7) ? c - 7 : 0; r.nm_hi = c; return r;
}

struct Args { const float* in[18]; float* out; unsigned char* ws; int ph_lo, ph_hi, li, pad; };
typedef const __attribute__((address_space(4))) Args* ArgsP;
__device__ __forceinline__ ArgsP get_args() { auto p = __builtin_amdgcn_kernarg_segment_ptr(); asm volatile("" : "+s"(p)); return (ArgsP)p; }

__global__ void __launch_bounds__(NTHR, 2) mk_fwd(Args args_unused) {
    extern __shared__ __attribute__((aligned(16))) unsigned char lds_raw[];
    LAS unsigned char* lds = (LAS unsigned char*)lds_raw;
    LAS float* sm = (LAS float*)lds;
    volatile LAS unsigned* MISC = (volatile LAS unsigned*)(lds + MISC_OFF);
    LAS int* moetab = (LAS int*)(lds + MOETAB_OFF);
    const int G = gridDim.x, bid = blockIdx.x, NGW = G * NWAVES;
#define PH_IDS() const int tid_ = wg_tid((const LAS int*)(lds + WIDTAB_OFF)); const int tid = tid_, lane = tid & 63, wave = __builtin_amdgcn_readfirstlane(tid >> 6), gw = bid * NWAVES + wave; (void)lane; (void)gw;
#define AP() get_args()
#define CTLP(ws) ((gu32*)((ws) + WS_CTL))

    for (int u = threadIdx.x; u < (LDS_BYTES - LDSCTL_OFF) / 4; u += NTHR) ((LAS unsigned*)(lds + LDSCTL_OFF))[u] = 0u;
    __syncthreads();
    { unsigned hw; asm volatile("s_getreg_b32 %0, hwreg(HW_REG_HW_ID, 0, 6)" : "=s"(hw)); if ((threadIdx.x & 63) == 0) ((LAS int*)(lds + WIDTAB_OFF))[hw] = (int)(threadIdx.x >> 6); }
    __syncthreads();
    XcdBarrier bar; bar.bar = nullptr; bar.x = 0; bar.st = nullptr;
    if (MK_N_LAUNCHES == 1) bar = xcd_barrier_post((unsigned*)(CTLP(AP()->ws) + CW_BAR), MISC + 8);
#define GRID_BAR() do { if (MK_N_LAUNCHES == 1) { XcdBarrier b_ = bar; b_.bar = (unsigned*)(CTLP(AP()->ws) + CW_BAR); xcd_barrier(b_, wg_tid((const LAS int*)(lds + WIDTAB_OFF)) == 0); } } while (0)
    const int lo = AP()->ph_lo, hi = AP()->ph_hi;
#define IN(k) (lo <= (k) && (k) < hi)
#define BOTH(k) (IN(k) && IN((k) + 1))

    if (IN(0)) {
        PH_IDS(); ArgsP ap = AP(); unsigned char* ws = ap->ws;
        LAS float* scr = (LAS float*)(lds + wave * 16384);
        constexpr int I_IN = 32 * 177, I_OUT = 32 * 64, I_GU = 32 * 16, I_DN = 8 * 64, I_W1 = 32 * 8;
        constexpr int N_IN = 2 * I_IN, N_OUT = 2 * I_OUT, N_G = 64 * I_GU, N_U = 64 * I_GU, N_D = 64 * I_DN, N_W1 = 8 * I_W1;
        constexpr int NITEMS = N_IN + N_OUT + N_G + N_U + N_D + N_W1;
        for (int it = gw; it < NITEMS; it += NGW) {
            int r = it;
            if (r < N_IN) { const int l = r / I_IN; transpose_item<1>(ap->in[6] + (size_t)l * D_ * IN_W, D_, IN_W, (bf16*)(ws + WS_WINT) + (size_t)l * NIN * D_, D_, 0, scr, r % I_IN, lane); continue; } r -= N_IN;
            if (r < N_OUT) { const int l = r / I_OUT; transpose_item<0>(ap->in[7] + (size_t)l * D_ * D_, D_, D_, (bf16*)(ws + WS_WOUTT) + (size_t)l * D_ * D_, D_, 0, scr, r % I_OUT, lane); continue; } r -= N_OUT;
            if (r < N_G) { const int le = r / I_GU; transpose_item<2>(ap->in[14] + (size_t)le * D_ * DEXP, D_, DEXP, (bf16*)(ws + WS_WGUT) + (size_t)le * 1024 * D_, D_, 0, scr, r % I_GU, lane); continue; } r -= N_G;
            if (r < N_U) { const int le = r / I_GU; transpose_item<3>(ap->in[15] + (size_t)le * D_ * DEXP, D_, DEXP, (bf16*)(ws + WS_WGUT) + (size_t)le * 1024 * D_, D_, 0, scr, r % I_GU, lane); continue; } r -= N_U;
            if (r < N_D) { const int le = r / I_DN; transpose_item<0>(ap->in[16] + (size_t)le * DEXP * D_, DEXP, D_, (bf16*)(ws + WS_WDT) + (size_t)le * D_ * DEXP, DEXP, 0, scr, r % I_DN, lane); continue; } r -= N_D;
            { const int m = r / I_W1, lk = m >> 1, half = m & 1;
              transpose_item<0>(ap->in[9] + (size_t)lk * 4096 * 256 + (size_t)half * 2048 * 256, 2048, 256, (bf16*)(ws + WS_WC1T) + (size_t)lk * 512 * 2048, 2048, half * 256, scr, r % I_W1, lane); }
        }
        { const float* w_router = ap->in[12]; bf16* WrT = (bf16*)(ws + WS_WRT);
          for (int idx = bid * NTHR + tid; idx < 32 * 2048; idx += G * NTHR) { const int e = idx >> 11, k = idx & 2047; const float w = w_router[(size_t)k * 32 + e];
            const unsigned hb = f2bf(w); const float rem = w - bf2f(hb); WrT[idx] = (bf16)hb; WrT[32 * 2048 + idx] = (bf16)f2bf(rem); } }
        { f32x2* ROPE = (f32x2*)(ws + WS_ROPE);
          for (int idx = bid * NTHR + tid; idx < S_ * 64; idx += G * NTHR) { const int pos = idx >> 6, i = idx & 63;
            const double inv = exp(-(double)i * (9.210340371976184 / 64.0)); const double ang = (double)pos * inv; double sv, cv; sincos(ang, &sv, &cv);
            ROPE[idx] = (f32x2){(float)cv, (float)sv}; } }
        __syncthreads();
        { float* MOD = (float*)(CTLP(ws) + CW_MOD); const float* c_in = ap->in[1]; const float* w_ada = ap->in[2]; const float* b_ada = ap->in[3];
          for (int k = tid; k < D_; k += NTHR) { const float cv = c_in[k]; sm[k] = cv / (1.f + __expf(-cv)); }
          __syncthreads();
          for (int it = bid; it < 2 * 96; it += G) { const int l = it / 96, cb = it % 96, grp = tid >> 5, col = cb * 128 + (tid & 31) * 4;
            f32x4 a = (f32x4){0.f, 0.f, 0.f, 0.f};
            const float* wp = w_ada + ((size_t)l * D_ + grp) * 12288 + col;
#pragma unroll 8
            for (int i = 0; i < 128; ++i) a += *(const f32x4*)(wp + (size_t)i * 16 * 12288) * sm[grp + 16 * i];
            *(LAS f32x4*)(sm + 4096 + grp * 128 + (tid & 31) * 4) = a;
            __syncthreads();
            if (tid < 128) { float s = b_ada[l * 12288 + cb * 128 + tid];
#pragma unroll
                for (int q = 0; q < 16; ++q) s += sm[4096 + q * 128 + tid];
                MOD[l * 12288 + cb * 128 + tid] = s; }
            __syncthreads(); } }
        { float* B1P = (float*)(CTLP(ws) + CW_B1E); const float* cmp_pe = ap->in[8]; const float* cmp_w1 = ap->in[9];
          for (int it = bid - 192; it >= 0 && it < 32; it += G) { const int lk = it >> 3, ks = it & 7, grp = tid >> 6, n = (tid & 63) * 4;
            f32x4 a = (f32x4){0.f, 0.f, 0.f, 0.f};
            const float* wp = cmp_w1 + ((size_t)lk * 4096 + ks * 512 + grp) * 256 + n; const float* pe = cmp_pe + (size_t)lk * 4096 + ks * 512 + grp;
#pragma unroll 8
            for (int i = 0; i < 64; ++i) a += *(const f32x4*)(wp + (size_t)i * 8 * 256) * pe[i * 8];
            *(LAS f32x4*)(sm + 4096 + grp * 256 + n) = a;
            __syncthreads();
            if (tid < 256) { float s = 0.f;
#pragma unroll
                for (int q = 0; q < 8; ++q) s += sm[4096 + q * 256 + tid];
                B1P[(lk * 8 + ks) * 256 + tid] = s; }
            __syncthreads(); } }
        if (BOTH(0)) GRID_BAR();
    }

    for (int l = 0; l < DEPTH; ++l) {
        const int pb = 1 + NPL * l;
#define LOAD_MOETAB(CNTP, NT_) do { __syncthreads(); if (tid < 32) moetab[tid] = (int)__hip_atomic_load((CNTP) + tid * CSTR, RLX_AGENT); __syncthreads(); \
        if (tid == 0) { int us = 0, ps = 0; for (int e = 0; e < NEXP; ++e) { const int c = moetab[e], tl = (c + 255) >> 8; moetab[32 + e] = us; moetab[65 + e] = ps; us += tl * (NT_); ps += tl << 8; } moetab[64] = us; } \
        __syncthreads(); } while (0)

        if (IN(pb + 0)) {
            PH_IDS(); ArgsP ap = AP(); unsigned char* ws = ap->ws;
            const float* MOD = (const float*)(CTLP(ws) + CW_MOD); const float* mod = MOD + l * 12288;
            float* X = ap->out; bf16* H = (bf16*)(ws + WS_H); const bf16* Y = (const bf16*)(ws + WS_Y); const int* TE = (const int*)(ws + WS_TE);
            if (l > 0) LOAD_MOETAB((unsigned*)(CTLP(ws) + CW_CNT) + (l - 1) * 32 * CSTR, 1);
            { const float* g_attn = ap->in[4];
              for (int k = tid; k < D_; k += NTHR) { sm[k] = g_attn[l * D_ + k] * (1.f + mod[2048 + k]); sm[2048 + k] = mod[k]; sm[4096 + k] = (l > 0) ? MOD[(l - 1) * 12288 + 10240 + k] : 0.f; } }
            __syncthreads();
            const float* x_in = ap->in[0];
            for (int t = gw; t < S_; t += NGW) {
                f32x4 v[8]; float ss = 0.f;
                if (l == 0) {
#pragma unroll
                    for (int j = 0; j < 8; ++j) v[j] = *(const f32x4*)(x_in + (size_t)t * D_ + 256 * j + 4 * lane);
                } else {
                    const int4 te = *(const int4*)(TE + 4 * t);
                    const bf16* y0 = Y + (size_t)(moetab[65 + te.x] + te.y) * D_; const bf16* y1 = Y + (size_t)(moetab[65 + te.z] + te.w) * D_;
#pragma unroll
                    for (int j = 0; j < 8; ++j) { const int k = 256 * j + 4 * lane; const uint2 a = *(const uint2*)(y0 + k), b = *(const uint2*)(y1 + k);
                        const f32x4 gt2 = *(const LAS f32x4*)(sm + 4096 + k);
                        f32x4 ysum = (f32x4){bflo(a.x) + bflo(b.x), bfhi(a.x) + bfhi(b.x), bflo(a.y) + bflo(b.y), bfhi(a.y) + bfhi(b.y)};
                        v[j] = *(const f32x4*)(X + (size_t)t * D_ + k) + gt2 * ysum; *(f32x4*)(X + (size_t)t * D_ + k) = v[j]; }
                }
#pragma unroll
                for (int j = 0; j < 8; ++j) ss += (v[j][0] * v[j][0] + v[j][1] * v[j][1]) + (v[j][2] * v[j][2] + v[j][3] * v[j][3]);
                const float rstd = 1.f / sqrtf(wave_sum(ss, lane) * (1.f / D_) + RMS_EPS);
#pragma unroll
                for (int j = 0; j < 8; ++j) { const int k = 256 * j + 4 * lane; const f32x4 h = v[j] * rstd * *(const LAS f32x4*)(sm + k) + *(const LAS f32x4*)(sm + 2048 + k);
                    *(uint2*)(H + (size_t)t * D_ + k) = make_uint2(pk2(h[0], h[1]), pk2(h[2], h[3])); }
            }
            if (BOTH(pb + 0)) GRID_BAR();
        }
        if (IN(pb + 1)) {
            ArgsP ap = AP(); unsigned char* ws = ap->ws;
            pg8::Gemm g{(const bf16*)(ws + WS_H), (const bf16*)(ws + WS_WINT) + (size_t)l * NIN * D_, S_, NIN, D_}; pg8::StaticOrder So; So.init(S_, NIN, G, bid);
            EpiInProj E{(bf16*)(ws + WS_QN), (bf16*)(ws + WS_KC), (bf16*)(ws + WS_VC), (bf16*)(ws + WS_KS), (bf16*)(ws + WS_VS), (bf16*)(ws + WS_KW), (bf16*)(ws + WS_VW),
                        (bf16*)(ws + WS_QM), (bf16*)(ws + WS_KM), (bf16*)(ws + WS_VM), (float*)(ws + WS_GATES), (const float*)(ws + WS_ROPE)};
            pg8::gemm_phase<EpiInProj, pg8::StaticOrder, true, true>(lds, g, So, E);
            if (BOTH(pb + 1)) GRID_BAR();
        }
        if (IN(pb + 2)) {
            PH_IDS(); ArgsP ap = AP(); unsigned char* ws = ap->ws;
            if (bid < 32) {
                pg8::Gemm g{(const bf16*)(ws + WS_KC), (const bf16*)(ws + WS_WC1T) + (size_t)l * 2 * 512 * 2048, 4096, 512, 2048}; CompressOrder So{G, bid};
                EpiF32 E{(float*)(ws + WS_UL), 512};
                pg8::gemm_phase<EpiF32, CompressOrder, false, true>(lds, g, So, E);
            }
            {
                const bf16* KM = (const bf16*)(ws + WS_KM); bf16* KMEAN = (bf16*)(ws + WS_KMEAN);
                const int nb = (G > 32) ? G - 32 : G, b0 = (G > 32) ? bid - 32 : bid;
                if (b0 >= 0) for (int u = b0; u < 512; u += nb) { const int n = u >> 3, h = u & 7, rg = tid >> 4, c8 = (tid & 15) * 8;
                    float a8[8] = {0.f, 0.f, 0.f, 0.f, 0.f, 0.f, 0.f, 0.f};
#pragma unroll
                    for (int i = 0; i < 8; ++i) { const v4u kv = *(const v4u*)(KM + (size_t)(n * 256 + rg + 32 * i) * 1024 + h * 128 + c8);
                        a8[0] += bflo(kv.x); a8[1] += bfhi(kv.x); a8[2] += bflo(kv.y); a8[3] += bfhi(kv.y); a8[4] += bflo(kv.z); a8[5] += bfhi(kv.z); a8[6] += bflo(kv.w); a8[7] += bfhi(kv.w); }
#pragma unroll
                    for (int i = 0; i < 8; ++i) sm[rg * 128 + c8 + i] = a8[i];
                    __syncthreads();
                    if (tid < 128) { float s = 0.f;
#pragma unroll 8
                        for (int q = 0; q < 32; ++q) s += sm[q * 128 + tid];
                        KMEAN[(size_t)(h * 64 + n) * 128 + tid] = (bf16)f2bf(s * (1.f / 256.f)); }
                    __syncthreads(); }
            }
            {
                const bf16* QN = (const bf16*)(ws + WS_QN); const bf16* KW = (const bf16*)(ws + WS_KW); const bf16* VW = (const bf16*)(ws + WS_VW); bf16* OWIN = (bf16*)(ws + WS_OWIN);
                const bf16* QM = (const bf16*)(ws + WS_QM); const bf16* KM2 = (const bf16*)(ws + WS_KM); const bf16* VM = (const bf16*)(ws + WS_VM); bf16* POWN = (bf16*)(ws + WS_POWN); float* LSEO = (float*)(ws + WS_LSEO);
                int bidl = bid; asm volatile("" : "+s"(bidl));
                const int nbw = (G > 32) ? G - 32 : G, bw = (G > 32) ? bidl - 32 : bidl;
                __syncthreads();
                att::Seam S;
                if (bw >= 0) {
                    { int L = bw;
                      if (L < 512) { att::Ref cur = wing_ref(L, QN, KW, VW, OWIN); att::prime<RFWinG>(cur, (char*)lds_raw, S);
                        for (;;) { const int Ln = L + nbw; const bool more = Ln < 512; const att::Ref nxt = more ? wing_ref(Ln, QN, KW, VW, OWIN) : cur;
                            att::block<2, false, RFWinG>(cur, nxt, nullptr, (char*)lds_raw, S);
                            if (!more) break; cur = nxt; L = Ln; } } }
                    __syncthreads();
                    {
                        const int heavy = 512 - 2 * nbw;
                        int f, n;
                        if (heavy >= 0 && heavy <= nbw && 3 * (nbw - heavy) <= 512 && 512 - 3 * (nbw - heavy) <= heavy) { if (bw >= heavy) { f = 3 * (bw - heavy); n = 3; } else { f = 3 * (nbw - heavy) + bw; n = (f < 512) ? 1 : 0; } }
                        else { f = bw; n = -1; }
                        if (n != 0 && f < 512) { int L = f, k = 1; att::Ref cur = mown_ref(L, QM, KM2, VM, POWN); att::prime<RFReg>(cur, (char*)lds_raw, S);
                            for (;;) { const int Ln = (n < 0) ? L + nbw : L + 1; const bool more = (n < 0) ? (Ln < 512) : (k < n && Ln < 512); const att::Ref nxt = more ? mown_ref(Ln, QM, KM2, VM, POWN) : cur;
                                att::block<0, true, RFReg>(cur, nxt, LSEO, (char*)lds_raw, S);
                                if (!more) break; cur = nxt; L = Ln; ++k; } } }
                }
                __syncthreads();
            }
            if (BOTH(pb + 2)) GRID_BAR();
        }
        if (IN(pb + 3)) {
            PH_IDS(); ArgsP ap = AP(); unsigned char* ws = ap->ws;
            const float* UL = (const float*)(ws + WS_UL); const float* B1P = (const float*)(CTLP(ws) + CW_B1E); const float* cmp_b1 = ap->in[10]; const f32x2* ROPE = (const f32x2*)(ws + WS_ROPE);
            bf16* KCMP = (bf16*)(ws + WS_KCMP); bf16* VCMP = (bf16*)(ws + WS_VCMP); const float* cmp_w2 = ap->in[11];
            { const int kv = bid & 1; const float* w2 = cmp_w2 + (size_t)(l * 2 + kv) * 256 * 128; LAS float* be = (LAS float*)(lds + 135168 + 8192);
              if (tid < 256) { float s = cmp_b1[(l * 2 + kv) * 256 + tid];
#pragma unroll
                  for (int q = 0; q < 8; ++q) s += B1P[((l * 2 + kv) * 8 + q) * 256 + tid];
                  be[tid] = s; }
              for (int i = tid; i < 256 * 128 / 4; i += NTHR) *(LAS f32x4*)(sm + 4 * i) = *(const f32x4*)(w2 + 4 * i);
              LAS float* hid = (LAS float*)(lds + 135168) + wave * 256;
              __syncthreads();
              const int nb2 = (G + 1 - kv) >> 1;
              for (int r = (bid >> 1) * NWAVES + wave; r < NC * 2; r += nb2 * NWAVES) { const int c = r >> 1, g = r & 1;
                const float* Ur = UL + ((size_t)kv * 2048 + g * 1024 + c) * 512; const float* Lr = UL + ((size_t)kv * 2048 + g * 1024 + c + 1) * 512 + 256;
#pragma unroll
                for (int j = 0; j < 4; ++j) { const int n = lane + 64 * j; const float v = Ur[n] + Lr[n] + be[n];
                    hid[n] = 0.5f * v * (1.f + tanhf(0.7978845608028654f * (v + 0.044715f * v * v * v))); }
                LDS_WAIT(); asm volatile("" ::: "memory");
                float o0 = 0.f, o1 = 0.f;
#pragma unroll 8
                for (int n = 0; n < 256; ++n) { const float hv = hid[n]; o0 += hv * sm[n * 128 + lane]; o1 += hv * sm[n * 128 + 64 + lane]; }
                if (kv == 0) { const f32x2 cs = ROPE[(size_t)(16 * c + 31) * 64 + lane];
                    const float a = o0 * cs[0] - o1 * cs[1], b = o1 * cs[0] + o0 * cs[1];
                    *(unsigned*)(KCMP + ((size_t)c * 2 + g) * 128 + 2 * lane) = pk2(a, b);
                } else { VCMP[((size_t)c * 2 + g) * 128 + lane] = (bf16)f2bf(o0); VCMP[((size_t)c * 2 + g) * 128 + 64 + lane] = (bf16)f2bf(o1); }
                LDS_WAIT(); asm volatile("" ::: "memory");
              }
              __syncthreads(); }
            if (BOTH(pb + 3)) GRID_BAR();
        }
        if (IN(pb + 4)) {
            {   ArgsP ap = AP(); unsigned char* ws = ap->ws;
                const bf16* QN = (const bf16*)(ws + WS_QN); const bf16* KCMP = (const bf16*)(ws + WS_KCMP); const bf16* VCMP = (const bf16*)(ws + WS_VCMP);
                bf16* OCMP = (bf16*)(ws + WS_OCMP); float* IMP = (float*)(ws + WS_IMP);
                att::Seam S;
                for (int L = bid; L < 512; L += G) { const att::Ref cur = cmp_ref(L, QN, KCMP, VCMP, OCMP); float lse;
                    att::prime<RFCmp>(cur, (char*)lds_raw, S);
                    att::block<2, false, RFCmp>(cur, cur, nullptr, (char*)lds_raw, S, &lse);
                    att::imp_sweep<RFCmp>(cur, lse, IMP + ((size_t)cur.a1 * 64 * 2 + cur.a0) * 256, (char*)lds_raw, S); }
            }
            {   PH_IDS(); ArgsP ap = AP(); unsigned char* ws = ap->ws;
                const bf16* QM = (const bf16*)(ws + WS_QM); const bf16* KMEAN = (const bf16*)(ws + WS_KMEAN);
                unsigned* MCNT = (unsigned*)(CTLP(ws) + CW_MCNT) + l * 512 * CSTR; int* MLIST = (int*)(ws + WS_MLIST); float* LSES = (float*)(ws + WS_LSES);
                __syncthreads();
                att::Seam S;
                for (int L = bid; L < 512; L += G) { const int h = L & 7, nq = L >> 3;
                    att::Ref cur; cur.Q = QM + (size_t)nq * 256 * 1024 + h * 128; cur.O = nullptr; cur.K = KMEAN + (size_t)h * 64 * 128; cur.V = cur.K; cur.kpitch = 128; cur.list = nullptr;
                    cur.P0 = 0; cur.W = 0; cur.j_lo = 0; cur.j_hi = 1; cur.a0 = -1; cur.a1 = 0; cur.nm_lo = 0; cur.nm_hi = 0;
                    int sel[3]; att::gate_unit<RFReg>(cur, nq, (char*)lds_raw, S, sel);
                    if (lane < 32) { const int t = nq * 256 + wave * 32 + lane;
#pragma unroll
                        for (int s = 0; s < 3; ++s) {
                            if (sel[s] >= 0) { const unsigned p = atomicAdd(MCNT + (h * 64 + sel[s]) * CSTR, 1u); MLIST[(size_t)(h * 64 + sel[s]) * 16384 + p] = t * 4 + s; }
                            else LSES[(t * 8 + h) * 3 + s] = -INFINITY; } }
                }
            }
            if (BOTH(pb + 4)) GRID_BAR();
        }
        if (IN(pb + 5)) {
            PH_IDS(); ArgsP ap = AP(); unsigned char* ws = ap->ws;
            {   PH_IDS(); ArgsP ap = AP(); unsigned char* ws = ap->ws;
                const float* IMP = (const float*)(ws + WS_IMP); int* SEL = (int*)(ws + WS_SEL);
                unsigned* NCNT = (unsigned*)(CTLP(ws) + CW_NCNT) + l * 512 * CSTR; int* NLIST = (int*)(ws + WS_NLIST);
                const int lam = lane & 15, rho = lane >> 4;
                for (int ub = gw * 4; ub < S_ * 2; ub += NGW * 4) { const int u = ub + rho, t = u >> 1, g = u & 1, tb = t >> 6;
                    float v[16];
#pragma unroll
                    for (int i = 0; i < 16; ++i) { const int j = lam + 16 * i; const float im = IMP[(size_t)u * 256 + j]; const bool forced = (j == 0) || (j == tb) || (j == tb - 1);
                        v[i] = (j > tb) ? -INFINITY : (forced ? 1e9f : im); }
                    int mysel = -1;
                    for (int r = 0; r < 16; ++r) { const int pick = row_pick<16>(v, lam); if (lam == r) mysel = pick; if (__all(pick < 0)) break; }
                    SEL[(size_t)u * 16 + lam] = mysel;
                    if (mysel >= 0) {
                        unsigned p;
                        if (mysel == 0) p = (unsigned)t; else if (mysel == tb) p = (unsigned)(t & 63); else if (mysel == tb - 1) p = 64u + (unsigned)(t & 63);
                        else p = 128u + atomicAdd(NCNT + (g * 256 + mysel) * CSTR, 1u);
                        NLIST[(size_t)(g * 256 + mysel) * 16384 + p] = t * 16 + lam; }
                }
            }
            {   PH_IDS(); ArgsP ap = AP(); unsigned char* ws = ap->ws;
                const bf16* QM = (const bf16*)(ws + WS_QM); const bf16* KM = (const bf16*)(ws + WS_KM); const bf16* VM = (const bf16*)(ws + WS_VM);
                bf16* POWN = (bf16*)(ws + WS_POWN); bf16* PSEL = (bf16*)(ws + WS_PSEL); float* LSEO = (float*)(ws + WS_LSEO); float* LSES = (float*)(ws + WS_LSES);
                const int* MLIST = (const int*)(ws + WS_MLIST); unsigned* MCNT = (unsigned*)(CTLP(ws) + CW_MCNT) + l * 512 * CSTR;
                LAS int* mtab = (LAS int*)(lds + att::LDS_BYTES);
                __syncthreads();
                mtab[tid] = (int)__hip_atomic_load(MCNT + tid * CSTR, RLX_AGENT);
                __syncthreads();
                LAS unsigned short* ulist = (LAS unsigned short*)(lds + 108544);
                { int tot; const int nu = (mtab[tid] + 255) >> 8; const int ex = block_excl_scan(nu, mtab + 1040, tid, &tot); mtab[512 + tid] = ex; if (tid == 0) mtab[1024] = tot;
                  for (int u = 0; u < nu; ++u) ulist[ex + u] = (unsigned short)tid; }
                __syncthreads();
                const int nsel = mtab[1024];
                att::Seam S;
                { int L = bid;
                  if (L < nsel) { att::Ref cur = msel_ref(L, mtab, ulist, MLIST, QM, KM, VM, PSEL); att::prime<RFSel>(cur, (char*)lds_raw, S);
                    for (;;) { const bool more = L + G < nsel; const att::Ref nxt = more ? msel_ref(L + G, mtab, ulist, MLIST, QM, KM, VM, PSEL) : cur;
                        att::block<1, false, RFSel>(cur, nxt, LSES, (char*)lds_raw, S);
                        if (!more) break; cur = nxt; L += G; } } }
                __syncthreads();
            }
            if (BOTH(pb + 5)) GRID_BAR();
        }
        if (IN(pb + 6)) {
            PH_IDS(); ArgsP ap = AP(); unsigned char* ws = ap->ws;
            const bf16* POWN = (const bf16*)(ws + WS_POWN); const bf16* PSEL = (const bf16*)(ws + WS_PSEL); const float* LSEO = (const float*)(ws + WS_LSEO); const float* LSES = (const float*)(ws + WS_LSES);
            bf16* OMIX = (bf16*)(ws + WS_OMIX);
            for (int t = gw; t < S_; t += NGW) {
                const int hh = (lane >> 2) & 7, ii = lane & 3;
                const float lv = (ii == 0) ? LSEO[t * 8 + hh] : LSES[(t * 8 + hh) * 3 + ii - 1];
                float m = fmaxf(lv, lane_get(lv, lane ^ 1)); m = fmaxf(m, lane_get(m, lane ^ 2));
                float w = __expf(lv - m); float sw = w + lane_get(w, lane ^ 1); sw += lane_get(sw, lane ^ 2); w = w / sw;
#pragma unroll
                for (int hp = 0; hp < 2; ++hp) { const int h = hp * 4 + (lane >> 4), c8 = (lane & 15) * 8;
                    const float w0 = lane_get(w, h * 4), w1 = lane_get(w, h * 4 + 1), w2 = lane_get(w, h * 4 + 2), w3 = lane_get(w, h * 4 + 3);
                    const bf16* ps = PSEL + (size_t)((t * 8 + h) * 3) * 128 + c8;
                    const v4u a0 = *(const v4u*)(POWN + (size_t)t * 1024 + h * 128 + c8);
                    v4u a1 = (v4u){0u, 0u, 0u, 0u}, a2 = a1, a3 = a1;
                    if (w1 > 0.f) a1 = *(const v4u*)(ps); if (w2 > 0.f) a2 = *(const v4u*)(ps + 128); if (w3 > 0.f) a3 = *(const v4u*)(ps + 256);
                    v4u ov;
                    ov.x = pk2(w0 * bflo(a0.x) + w1 * bflo(a1.x) + w2 * bflo(a2.x) + w3 * bflo(a3.x), w0 * bfhi(a0.x) + w1 * bfhi(a1.x) + w2 * bfhi(a2.x) + w3 * bfhi(a3.x));
                    ov.y = pk2(w0 * bflo(a0.y) + w1 * bflo(a1.y) + w2 * bflo(a2.y) + w3 * bflo(a3.y), w0 * bfhi(a0.y) + w1 * bfhi(a1.y) + w2 * bfhi(a2.y) + w3 * bfhi(a3.y));
                    ov.z = pk2(w0 * bflo(a0.z) + w1 * bflo(a1.z) + w2 * bflo(a2.z) + w3 * bflo(a3.z), w0 * bfhi(a0.z) + w1 * bfhi(a1.z) + w2 * bfhi(a2.z) + w3 * bfhi(a3.z));
                    ov.w = pk2(w0 * bflo(a0.w) + w1 * bflo(a1.w) + w2 * bflo(a2.w) + w3 * bflo(a3.w), w0 * bfhi(a0.w) + w1 * bfhi(a1.w) + w2 * bfhi(a2.w) + w3 * bfhi(a3.w));
                    *(v4u*)(OMIX + (size_t)t * 2048 + 1024 + h * 128 + c8) = ov; }
            }
            if (BOTH(pb + 6)) GRID_BAR();

        }
        if (IN(pb + 7)) {
            PH_IDS(); ArgsP ap = AP(); unsigned char* ws = ap->ws;
            const bf16* QN = (const bf16*)(ws + WS_QN); const bf16* KS = (const bf16*)(ws + WS_KS); const bf16* VS = (const bf16*)(ws + WS_VS);
            bf16* PSLC = (bf16*)(ws + WS_PSLC); float* LSEN = (float*)(ws + WS_LSEN); const int* NLIST = (const int*)(ws + WS_NLIST); unsigned* NCNT = (unsigned*)(CTLP(ws) + CW_NCNT) + l * 512 * CSTR;
            LAS int* ntab = (LAS int*)(lds + att::LDS_BYTES);
            __syncthreads();
            { const int j = tid & 255; ntab[tid] = (j == 0) ? S_ : (int)__hip_atomic_load(NCNT + tid * CSTR, RLX_AGENT) + 64 + (j < 255 ? 64 : 0); }
            __syncthreads();
            LAS unsigned short* ulist = (LAS unsigned short*)(lds + 108544);
            { int tot; const int nu = (ntab[tid] + 63) >> 6; const int ex = block_excl_scan(nu, ntab + 1040, tid, &tot); ntab[512 + tid] = ex; if (tid == 0) ntab[1024] = tot;
              for (int u = 0; u < nu; ++u) ulist[ex + u] = (unsigned short)tid; }
            __syncthreads();
            const int nun = ntab[1024];
            att::Seam S; int L = bid;
            if (L < nun) { att::Ref cur = nsel_ref(L, ntab, ulist, NLIST, QN, KS, VS, PSLC); att::prime<RFSlc>(cur, (char*)lds_raw, S);
                for (;;) { const bool more = L + G < nun; const att::Ref nxt = more ? nsel_ref(L + G, ntab, ulist, NLIST, QN, KS, VS, PSLC) : cur;
                    att::block<2, false, RFSlc, true, true>(cur, nxt, LSEN, (char*)lds_raw, S);
                    if (!more) break; cur = nxt; L += G; } }
            __syncthreads();
            if (BOTH(pb + 7)) GRID_BAR();
        }
        if (IN(pb + 8)) {
            PH_IDS(); ArgsP ap = AP(); unsigned char* ws = ap->ws;
            const unsigned char* PSLC = (const unsigned char*)(ws + WS_PSLC); const float* LSEN = (const float*)(ws + WS_LSEN); const int* SEL = (const int*)(ws + WS_SEL); const float* GATES = (const float*)(ws + WS_GATES);
            const bf16* OCMP = (const bf16*)(ws + WS_OCMP); const bf16* OWIN = (const bf16*)(ws + WS_OWIN); bf16* OMIX = (bf16*)(ws + WS_OMIX);
            for (int u = gw; u < S_ * 2; u += NGW) { const int t = u >> 1, g = u & 1;
                const int sv = (lane < 16) ? SEL[(size_t)u * 16 + lane] : -1;
                const int nsel = __popcll(__ballot(sv >= 0));
                const float lv = ((lane >> 2) < nsel) ? LSEN[(size_t)u * 64 + lane] : -INFINITY;
                float m = lv;
#pragma unroll
                for (int o = 4; o < 64; o <<= 1) m = fmaxf(m, lane_get(m, lane ^ o));
                float w = __expf(lv - m), sw = w;
#pragma unroll
                for (int o = 4; o < 64; o <<= 1) sw += lane_get(sw, lane ^ o);
                w = w / sw * 0.0625f;
                const int r = lane >> 4, c8 = (lane & 15) * 8;
                float o8[8] = {0.f, 0.f, 0.f, 0.f, 0.f, 0.f, 0.f, 0.f};
                uint2 pv[16];
#pragma unroll
                for (int s = 0; s < 16; ++s) { const int sc = s < nsel ? s : nsel - 1; pv[s] = *(const uint2*)(PSLC + ((size_t)(u * 16 + sc) * 4 + r) * 128 + c8); }
#pragma unroll
                for (int s = 0; s < 16; ++s) { const float ws_ = lane_get(w, s * 4 + r);
                    o8[0] += ws_ * __builtin_amdgcn_cvt_f32_fp8((int)pv[s].x, 0); o8[1] += ws_ * __builtin_amdgcn_cvt_f32_fp8((int)pv[s].x, 1); o8[2] += ws_ * __builtin_amdgcn_cvt_f32_fp8((int)pv[s].x, 2); o8[3] += ws_ * __builtin_amdgcn_cvt_f32_fp8((int)pv[s].x, 3);
                    o8[4] += ws_ * __builtin_amdgcn_cvt_f32_fp8((int)pv[s].y, 0); o8[5] += ws_ * __builtin_amdgcn_cvt_f32_fp8((int)pv[s].y, 1); o8[6] += ws_ * __builtin_amdgcn_cvt_f32_fp8((int)pv[s].y, 2); o8[7] += ws_ * __builtin_amdgcn_cvt_f32_fp8((int)pv[s].y, 3); }
                const int hd = g * 4 + r; const float g0 = GATES[(size_t)t * 32 + hd * 3], g1 = GATES[(size_t)t * 32 + hd * 3 + 1], g2 = GATES[(size_t)t * 32 + hd * 3 + 2];
                const size_t oi = (size_t)t * 1024 + hd * 128 + c8;
                const v4u cv = *(const v4u*)(OCMP + oi), wv = *(const v4u*)(OWIN + oi);
                v4u ov;
                ov.x = pk2(g1 * o8[0] + g0 * bflo(cv.x) + g2 * bflo(wv.x), g1 * o8[1] + g0 * bfhi(cv.x) + g2 * bfhi(wv.x));
                ov.y = pk2(g1 * o8[2] + g0 * bflo(cv.y) + g2 * bflo(wv.y), g1 * o8[3] + g0 * bfhi(cv.y) + g2 * bfhi(wv.y));
                ov.z = pk2(g1 * o8[4] + g0 * bflo(cv.z) + g2 * bflo(wv.z), g1 * o8[5] + g0 * bfhi(cv.z) + g2 * bfhi(wv.z));
                ov.w = pk2(g1 * o8[6] + g0 * bflo(cv.w) + g2 * bflo(wv.w), g1 * o8[7] + g0 * bfhi(cv.w) + g2 * bfhi(wv.w));
                *(v4u*)(OMIX + (size_t)t * 2048 + hd * 128 + c8) = ov;
            }
            if (BOTH(pb + 8)) GRID_BAR();
        }
        if (IN(pb + 9)) {
            ArgsP ap = AP(); unsigned char* ws = ap->ws;
            pg8::Gemm g{(const bf16*)(ws + WS_OMIX), (const bf16*)(ws + WS_WOUTT) + (size_t)l * D_ * D_, S_, D_, D_}; pg8::StaticOrder So; So.init(S_, D_, G, bid);
            EpiOutProj E{l == 0 ? ap->in[0] : (const float*)ap->out, ap->out, (const float*)(CTLP(ws) + CW_MOD) + l * 12288 + 4096};
            pg8::gemm_phase<EpiOutProj, pg8::StaticOrder, true, true>(lds, g, So, E);
            if (BOTH(pb + 9)) GRID_BAR();
        }
        if (IN(pb + 10)) {
            PH_IDS(); ArgsP ap = AP(); unsigned char* ws = ap->ws;
            const float* mod = (const float*)(CTLP(ws) + CW_MOD) + l * 12288;
            const float* X = ap->out; bf16* H = (bf16*)(ws + WS_H); const bf16* WrT = (const bf16*)(ws + WS_WRT); const float* b_router = ap->in[13];
            unsigned* CNT = (unsigned*)(CTLP(ws) + CW_CNT) + l * 32 * CSTR; int* TE = (int*)(ws + WS_TE); int* TOKIDX = (int*)(ws + WS_TOKIDX); float* WTS = (float*)(ws + WS_WTS);
            { const float* g_ffn = ap->in[5];
              for (int k = tid; k < D_; k += NTHR) { sm[k] = g_ffn[l * D_ + k] * (1.f + mod[8192 + k]); sm[2048 + k] = mod[6144 + k]; }
              if (tid < 32) sm[4160 + tid] = b_router[tid]; }
            typedef short bf16x8_t __attribute__((ext_vector_type(8))); typedef float f32x16_t __attribute__((ext_vector_type(16)));
            for (int bt = bid; bt < S_ / 64; bt += G) { const int t0 = bt * 64;
                __syncthreads();
                for (int rr = 0; rr < 8; rr += 2) { const int row = wave * 8 + rr; float ss0 = 0.f, ss1 = 0.f; f32x4 va[8], vb[8];
#pragma unroll
                    for (int j = 0; j < 8; ++j) { va[j] = *(const f32x4*)(X + (size_t)(t0 + row) * D_ + 256 * j + 4 * lane); vb[j] = *(const f32x4*)(X + (size_t)(t0 + row + 1) * D_ + 256 * j + 4 * lane); }
#pragma unroll
                    for (int j = 0; j < 8; ++j) { ss0 += (va[j][0] * va[j][0] + va[j][1] * va[j][1]) + (va[j][2] * va[j][2] + va[j][3] * va[j][3]); ss1 += (vb[j][0] * vb[j][0] + vb[j][1] * vb[j][1]) + (vb[j][2] * vb[j][2] + vb[j][3] * vb[j][3]); }
                    ss0 = wave_sum(ss0, lane); ss1 = wave_sum(ss1, lane);
                    if (lane == 0) { sm[4096 + row] = 1.f / sqrtf(ss0 * (1.f / D_) + RMS_EPS); sm[4096 + row + 1] = 1.f / sqrtf(ss1 * (1.f / D_) + RMS_EPS); } }
                __syncthreads();
                { const int r = lane & 31, kh = lane >> 5; f32x16_t acc0 = {}, acc1 = {};
                  const float rs0 = sm[4096 + r], rs1 = sm[4096 + 32 + r];
#pragma unroll 2
                  for (int ks = 0; ks < 16; ++ks) { const int k = wave * 256 + ks * 16 + kh * 8;
                    const bf16x8_t wh = *(const bf16x8_t*)(WrT + (size_t)r * 2048 + k), wl = *(const bf16x8_t*)(WrT + 32 * 2048 + (size_t)r * 2048 + k);
                    const f32x4 gA = *(const LAS f32x4*)(sm + k), gB = *(const LAS f32x4*)(sm + k + 4), sA = *(const LAS f32x4*)(sm + 2048 + k), sB = *(const LAS f32x4*)(sm + 2048 + k + 4);
#pragma unroll
                    for (int rg = 0; rg < 2; ++rg) { const size_t ro = (size_t)(t0 + rg * 32 + r) * D_ + k; const float rs = rg ? rs1 : rs0;
                        const f32x4 xa = *(const f32x4*)(X + ro), xb = *(const f32x4*)(X + ro + 4);
                        const f32x4 ha = xa * rs * gA + sA, hb = xb * rs * gB + sB;
                        const unsigned h0 = pk2(ha[0], ha[1]), h1 = pk2(ha[2], ha[3]), h2 = pk2(hb[0], hb[1]), h3 = pk2(hb[2], hb[3]);
                        *(v4u*)(H + ro) = (v4u){h0, h1, h2, h3};
                        const unsigned l0 = pk2(ha[0] - bflo(h0), ha[1] - bfhi(h0)), l1 = pk2(ha[2] - bflo(h1), ha[3] - bfhi(h1)), l2 = pk2(hb[0] - bflo(h2), hb[1] - bfhi(h2)), l3 = pk2(hb[2] - bflo(h3), hb[3] - bfhi(h3));
                        const v4u hv = (v4u){h0, h1, h2, h3}, lv = (v4u){l0, l1, l2, l3};
                        const bf16x8_t ahi = __builtin_bit_cast(bf16x8_t, hv), alo = __builtin_bit_cast(bf16x8_t, lv);
                        if (rg == 0) { acc0 = __builtin_amdgcn_mfma_f32_32x32x16_bf16(wh, ahi, acc0, 0, 0, 0); acc0 = __builtin_amdgcn_mfma_f32_32x32x16_bf16(wl, ahi, acc0, 0, 0, 0); acc0 = __builtin_amdgcn_mfma_f32_32x32x16_bf16(wh, alo, acc0, 0, 0, 0); }
                        else         { acc1 = __builtin_amdgcn_mfma_f32_32x32x16_bf16(wh, ahi, acc1, 0, 0, 0); acc1 = __builtin_amdgcn_mfma_f32_32x32x16_bf16(wl, ahi, acc1, 0, 0, 0); acc1 = __builtin_amdgcn_mfma_f32_32x32x16_bf16(wh, alo, acc1, 0, 0, 0); } } }
#pragma unroll
                  for (int q = 0; q < 16; ++q) { const int e = (q & 3) + 8 * (q >> 2) + 4 * kh;
                      sm[5120 + ((wave * 2 + 0) * 32 + e) * 32 + r] = acc0[q]; sm[5120 + ((wave * 2 + 1) * 32 + e) * 32 + r] = acc1[q]; } }
                __syncthreads();
                { const int tk6 = tid & 63, eq = tid >> 6, rg = tk6 >> 5, tk = tk6 & 31;
#pragma unroll
                  for (int i = 0; i < 4; ++i) { const int e = eq * 4 + i; float s = 0.f;
#pragma unroll
                      for (int w = 0; w < 8; ++w) s += sm[5120 + ((w * 2 + rg) * 32 + e) * 32 + tk];
                      sm[5120 + 16384 + tk6 * 33 + e] = 1.f / (1.f + __expf(-s)); } }
                __syncthreads();
                if (tid < 64) { const int t = t0 + tid;
                    float lg[32];
#pragma unroll
                    for (int e = 0; e < 32; ++e) lg[e] = sm[5120 + 16384 + tid * 33 + e];
                    int grp = 0; float best = -INFINITY;
#pragma unroll
                    for (int gq = 0; gq < 4; ++gq) { float m1 = -INFINITY, m2 = -INFINITY;
#pragma unroll
                        for (int i = 0; i < 8; ++i) { const float b = lg[gq * 8 + i] + sm[4160 + gq * 8 + i]; if (b > m1) { m2 = m1; m1 = b; } else if (b > m2) m2 = b; }
                        const float sgs = m1 + m2; if (sgs > best) { best = sgs; grp = gq; } }
                    float m1 = -INFINITY, m2 = -INFINITY, s1 = 0.f, s2 = 0.f; int i1 = 0, i2 = 0;
#pragma unroll
                    for (int e = 0; e < 32; ++e) { const bool ing = (e >> 3) == grp; const float b = lg[e] + sm[4160 + e];
                        if (ing && b > m1) { m2 = m1; i2 = i1; s2 = s1; m1 = b; i1 = e; s1 = lg[e]; } else if (ing && b > m2) { m2 = b; i2 = e; s2 = lg[e]; } }
                    const float inv = 1.f / (s1 + s2);
                    const unsigned p1 = atomicAdd(CNT + i1 * CSTR, 1u), p2 = atomicAdd(CNT + i2 * CSTR, 1u);
                    TOKIDX[(size_t)i1 * ECAP + p1] = t; TOKIDX[(size_t)i2 * ECAP + p2] = t; WTS[(size_t)i1 * ECAP + p1] = s1 * inv; WTS[(size_t)i2 * ECAP + p2] = s2 * inv;
                    *(int4*)(TE + 4 * t) = make_int4(i1, (int)p1, i2, (int)p2);
                }
            }
            if (BOTH(pb + 10)) GRID_BAR();
        }
        if (IN(pb + 11)) {
            PH_IDS(); ArgsP ap = AP(); unsigned char* ws = ap->ws;
            LOAD_MOETAB((unsigned*)(CTLP(ws) + CW_CNT) + l * 32 * CSTR, 4);
            pg8::Gemm g{(const bf16*)(ws + WS_H), (const bf16*)(ws + WS_WGUT), 0, 0, D_}; MoeOrder<true> So{moetab, 4, G, bid, 4, l * 32 * 4, (const int*)(ws + WS_TOKIDX)};
            EpiGateUp E{(bf16*)(ws + WS_HACT)};
            pg8::gemm_phase<EpiGateUp, MoeOrder<true>, true, true>(lds, g, So, E);
            if (BOTH(pb + 11)) GRID_BAR();
        }
        if (IN(pb + 12)) {
            PH_IDS(); ArgsP ap = AP(); unsigned char* ws = ap->ws;
            LOAD_MOETAB((unsigned*)(CTLP(ws) + CW_CNT) + l * 32 * CSTR, 8);
            pg8::Gemm g{(const bf16*)(ws + WS_HACT), (const bf16*)(ws + WS_WDT), 0, 0, DEXP}; MoeOrder<false> So{moetab, 8, G, bid, 8, l * 32 * 8, nullptr};
            EpiDown E{(bf16*)(ws + WS_Y), (const float*)(ws + WS_WTS), moetab};
            pg8::gemm_phase<EpiDown, MoeOrder<false>, true, true>(lds, g, So, E);
            if (BOTH(pb + 12)) GRID_BAR();
        }
    }
    if (IN(NPH - 1)) {
        PH_IDS(); ArgsP ap = AP(); unsigned char* ws = ap->ws;
        float* X = ap->out; const bf16* Y = (const bf16*)(ws + WS_Y); const int* TE = (const int*)(ws + WS_TE);
        LOAD_MOETAB((unsigned*)(CTLP(ws) + CW_CNT) + 32 * CSTR, 1);
        const bool tmo_set = (MK_N_LAUNCHES == 1) && (__hip_atomic_load((unsigned*)(CTLP(ws) + CW_BAR) + XB_TMO, RLX_AGENT) != 0u);
        { const float* g_final = ap->in[17]; const float* MOD = (const float*)(CTLP(ws) + CW_MOD);
          for (int k = tid; k < D_; k += NTHR) { sm[k] = g_final[k]; sm[2048 + k] = MOD[12288 + 10240 + k]; } }
        __syncthreads();
        for (int t = gw; t < S_; t += NGW) {
            f32x4 v[8]; float ss = 0.f;
            const int4 te = *(const int4*)(TE + 4 * t);
            const bf16* y0 = Y + (size_t)(moetab[65 + te.x] + te.y) * D_; const bf16* y1 = Y + (size_t)(moetab[65 + te.z] + te.w) * D_;
#pragma unroll
            for (int j = 0; j < 8; ++j) { const int k = 256 * j + 4 * lane; const uint2 a = *(const uint2*)(y0 + k), b = *(const uint2*)(y1 + k);
                const f32x4 gt2 = *(const LAS f32x4*)(sm + 2048 + k);
                f32x4 ysum = (f32x4){bflo(a.x) + bflo(b.x), bfhi(a.x) + bfhi(b.x), bflo(a.y) + bflo(b.y), bfhi(a.y) + bfhi(b.y)};
                v[j] = *(const f32x4*)(X + (size_t)t * D_ + k) + gt2 * ysum;
                ss += (v[j][0] * v[j][0] + v[j][1] * v[j][1]) + (v[j][2] * v[j][2] + v[j][3] * v[j][3]); }
            const float rstd = (tmo_set ? __builtin_nanf("") : 1.f) / sqrtf(wave_sum(ss, lane) * (1.f / D_) + RMS_EPS);
#pragma unroll
            for (int j = 0; j < 8; ++j) { const int k = 256 * j + 4 * lane; *(f32x4*)(X + (size_t)t * D_ + k) = v[j] * rstd * *(const LAS f32x4*)(sm + k); }
        }
    }
#undef IN
#undef BOTH
#undef GRID_BAR
#undef LOAD_MOETAB
#undef AP
#undef CTLP
#undef PH_IDS
}

extern "C" void kernel_launch(void* const* d_in, const int* in_sizes, int n_in, void* d_out, int out_size, void* d_ws, size_t ws_size, hipStream_t stream) {
    static int grid = 0;
    if (grid == 0) {
        if (n_in != 18 || out_size != S_ * D_ || ws_size < WS_END) { fprintf(stderr, "kernel_launch: unexpected shapes (n_in %d out %d ws %zu)\n", n_in, out_size, ws_size); grid = -1; return; }
        int dev = 0, cus = 0, per_cu = 0;
        if (hipGetDevice(&dev) != hipSuccess || hipDeviceGetAttribute(&cus, hipDeviceAttributeMultiprocessorCount, dev) != hipSuccess) { grid = -1; return; }
        if (hipFuncSetAttribute((const void*)mk_fwd, hipFuncAttributeMaxDynamicSharedMemorySize, LDS_BYTES) != hipSuccess) { fprintf(stderr, "kernel_launch: hipFuncSetAttribute failed\n"); grid = -1; return; }
        if (hipOccupancyMaxActiveBlocksPerMultiprocessor(&per_cu, (const void*)mk_fwd, NTHR, LDS_BYTES) != hipSuccess || per_cu < 1) { fprintf(stderr, "kernel_launch: occupancy query says %d\n", per_cu); }
        (void)hipGetLastError();
        grid = cus;
    }
    if (grid < 0) return;
    if (hipMemsetAsync((char*)d_ws + WS_CTL, 0, CTL_ZERO_BYTES, stream) != hipSuccess) return;
    Args a{};
    for (int i = 0; i < 18; ++i) a.in[i] = (const float*)d_in[i];
    a.out = (float*)d_out; a.ws = (unsigned char*)d_ws; a.pad = 0;
    if (MK_N_LAUNCHES == 1) {
        a.ph_lo = 0; a.ph_hi = NPH; a.li = 0;
        hipLaunchKernelGGL(mk_fwd, dim3(grid), dim3(NTHR), LDS_BYTES, stream, a);
    } else {
        for (int p = 0; p < NPH; ++p) { a.ph_lo = p; a.ph_hi = p + 1; a.li = p; hipLaunchKernelGGL(mk_fwd, dim3(grid), dim3(NTHR), LDS_BYTES, stream, a); }
    }
}
```

```cpp
#include <hip/hip_runtime.h>
#include <cstdio>
#include <cstdint>


#define WIDTAB_OFF (131072 + 1024)
__device__ __forceinline__ int wg_tid(const __attribute__((address_space(3))) int* widtab) {
    unsigned hw; asm volatile("s_getreg_b32 %0, hwreg(HW_REG_HW_ID, 0, 6)" : "=s"(hw));
    int lane; asm volatile("v_mbcnt_lo_u32_b32 %0, -1, 0\n\tv_mbcnt_hi_u32_b32 %0, -1, %0" : "=v"(lane));
    return widtab[hw] * 64 + lane;
}

namespace pg8 {
#define PG8_LAS __attribute__((address_space(3)))
typedef unsigned short bf16_t;
typedef short bf16x8 __attribute__((ext_vector_type(8)));
typedef float f32x4 __attribute__((ext_vector_type(4)));
typedef unsigned u32x4 __attribute__((ext_vector_type(4)));
constexpr int BM = 256, BK = 64, HALF = 128, HTB = HALF * BK * 2, STAGE_BYTES = 8 * HTB, NXCD = 8, WGM = 8;

__host__ __device__ __forceinline__ int lds_byte(int r, int c) { const int st = (r >> 4) * 2 + (c >> 5), rr = r & 15, cc = c & 31, ob = rr * 64 + cc * 2; return st * 1024 + (ob ^ (((ob >> 9) & 1) << 5)); }
__host__ __device__ __forceinline__ void stage_rc(int b, int& R, int& C) { const int st = b / 1024, sb = b % 1024, swz = sb ^ (((sb >> 9) & 1) << 5); R = (st >> 1) * 16 + swz / 64; C = (st & 1) * 32 + (swz % 64) / 2; }
__host__ __device__ __forceinline__ int perm32(int rho) { const int n = rho >> 4, i = rho & 15; return 8 * (i >> 2) + 4 * n + (i & 3); }

struct Unit { int pm, pn, e, mt, pnl; };
struct Gemm { const bf16_t* A; const bf16_t* Bt; int M, N, K; };

struct StaticOrder {
    static constexpr bool GATHER = false;
    int nM, nN, nwg, G, c;
    __host__ __device__ void init(int M, int N, int G_, int c_) { nM = M / BM; nN = N / BM; nwg = nM * nN; G = G_; c = c_; }
    __host__ __device__ bool next(int i, Unit& u) const {
        const long L = (long)i * G + c; if (L >= nwg) return false;
        int wgid = (int)L; { const int q = nwg / NXCD, r = nwg % NXCD, xcd = wgid % NXCD, off = wgid / NXCD; wgid = (xcd < r ? xcd * (q + 1) : r * (q + 1) + (xcd - r) * q) + off; }
        const int nig = WGM * nN, gid = wgid / nig, fm = gid * WGM, gsz = (nM - fm) < WGM ? (nM - fm) : WGM;
        u.pm = fm + ((wgid % nig) % gsz); u.pn = (wgid % nig) / gsz; u.e = 0; u.mt = 0; u.pnl = u.pn; return true;
    }
    __device__ __forceinline__ void a_offs(const Unit&, int, int, int, int, int, unsigned (&)[2][2]) const {}
    __device__ __forceinline__ void a_ready(const Unit&) const {}
    __device__ __forceinline__ void done(const Unit&) const {}
};

__device__ __forceinline__ unsigned cvt_pk_bf16(float lo, float hi) { unsigned r; asm volatile("v_cvt_pk_bf16_f32 %0, %1, %2" : "=v"(r) : "v"(lo), "v"(hi)); return r; }

template <class Epi, class Sched, bool ALIGN_EPI = false, bool SP2 = false>
__device__ __forceinline__ void gemm_phase(PG8_LAS unsigned char* lds, const Gemm g, const Sched& S, const Epi& E) {
    const int tid_ = wg_tid((const PG8_LAS int*)(lds + WIDTAB_OFF));
    const int tid = tid_, wid = __builtin_amdgcn_readfirstlane(tid >> 6), lane = tid & 63, wr = wid >> 2, wc = wid & 3, fr = lane & 15, fq = lane >> 4;
    const int K = g.K, nt = K / BK;
    unsigned voffA[2], voffB[2]; int RR[2], CC[2];
#pragma unroll
    for (int i = 0; i < 2; ++i) { int R, C; stage_rc(tid * 16 + i * 8192, R, C); const int Rb = Epi::PERM ? ((R & ~31) + perm32(R & 31)) : R;
        RR[i] = R; CC[i] = C; voffA[i] = (unsigned)(R * K + C) * 2u; voffB[i] = (unsigned)(Rb * K + C) * 2u; }
    const size_t kstep = (size_t)(BK * 2);
    const size_t hstep = (size_t)HALF * K * 2;
    const size_t tstep = 2 * hstep;
    const unsigned ldsw = (unsigned)wid * 1024u;
    const int aoff = lds_byte(wr * 64 + fr, fq * 8), boff = lds_byte(wc * 32 + fr, fq * 8);
    const char* gA = (const char*)g.A;
    unsigned aoC[2][2] = {{0u, 0u}, {0u, 0u}}, aoN[2][2] = {{0u, 0u}, {0u, 0u}};
#define PG8_SA(b, h) (((b) * 2 + (h)) * HTB)
#define PG8_SB(b, h) ((4 + (b) * 2 + (h)) * HTB)
#define PG8_STAGE(bufoff, gbase, voff) do { _Pragma("unroll") for (int _i = 0; _i < 2; ++_i) \
        __builtin_amdgcn_global_load_lds((const unsigned*)((const char*)(gbase) + (voff)[_i]), (PG8_LAS unsigned*)(lds + (bufoff) + ldsw + _i * 8192), 16, 0, 0); } while (0)
#define PG8_STAGE_A(bufoff, h, PN, KO) do { if constexpr (Sched::GATHER) { _Pragma("unroll") for (int _i = 0; _i < 2; ++_i) \
        __builtin_amdgcn_global_load_lds((const unsigned*)(gA + aoC[h][_i] + (KO)), (PG8_LAS unsigned*)(lds + (bufoff) + ldsw + _i * 8192), 16, 0, 0); } \
        else { PG8_STAGE(bufoff, (PN) + (h) * hstep, voffA); } } while (0)
#define PG8_LDA(dst, b, h) do { _Pragma("unroll") for (int m = 0; m < 4; ++m) _Pragma("unroll") for (int k = 0; k < 2; ++k) dst[m][k] = *(const PG8_LAS bf16x8*)(lds + PG8_SA(b, h) + aoff + m * 2048 + k * 1024); } while (0)
#define PG8_LDB(dst, b, h) do { _Pragma("unroll") for (int n = 0; n < 2; ++n) _Pragma("unroll") for (int k = 0; k < 2; ++k) dst[n][k] = *(const PG8_LAS bf16x8*)(lds + PG8_SB(b, h) + boff + n * 2048 + k * 1024); } while (0)
#define PG8_MMA(ai, bj, At, Bt) do { __builtin_amdgcn_s_setprio(1); _Pragma("unroll") for (int m = 0; m < 4; ++m) _Pragma("unroll") for (int n = 0; n < 2; ++n) _Pragma("unroll") for (int k = 0; k < 2; ++k) \
        acc[ai][bj][m][n] = __builtin_amdgcn_mfma_f32_16x16x32_bf16(Bt[n][k], At[m][k], acc[ai][bj][m][n], 0, 0, 0); __builtin_amdgcn_s_setprio(0); } while (0)
#define PG8_WAIT_V(n) asm volatile("s_waitcnt vmcnt(" #n ")" ::: "memory")
#define PG8_WAIT_L(n) asm volatile("s_waitcnt lgkmcnt(" #n ")" ::: "memory")
#define PG8_BAR __builtin_amdgcn_s_barrier()
#define PG8_SCHED __builtin_amdgcn_sched_barrier(0)
    Unit cur, nxt; int ui = 0;
    if (!S.next(0, cur)) return;
    f32x4 acc[2][2][4][2];
#pragma unroll
    for (int a = 0; a < 2; ++a)
#pragma unroll
        for (int b = 0; b < 2; ++b)
#pragma unroll
            for (int m = 0; m < 4; ++m)
#pragma unroll
                for (int n = 0; n < 2; ++n) acc[a][b][m][n] = (f32x4){0.f, 0.f, 0.f, 0.f};
    bf16x8 At[4][2], B0[2][2], B1[2][2];
    const char* cA = (const char*)g.A + (size_t)cur.pm * tstep; const char* cB = (const char*)g.Bt + (size_t)cur.pn * tstep;
    if constexpr (Sched::GATHER) S.a_offs(cur, RR[0], RR[1], CC[0], CC[1], K, aoC);
    S.a_ready(cur);
    if constexpr (SP2) {
        PG8_STAGE(PG8_SB(0, 0), cB, voffB); PG8_STAGE(PG8_SB(0, 1), cB + hstep, voffB); PG8_STAGE_A(PG8_SA(0, 0), 0, cA, 0); PG8_STAGE_A(PG8_SA(0, 1), 1, cA, 0);
        if (wr == 1) PG8_BAR;
        PG8_WAIT_V(2); PG8_BAR;
        PG8_STAGE(PG8_SB(1, 0), cB + kstep, voffB); PG8_STAGE_A(PG8_SA(1, 0), 0, cA + kstep, kstep); PG8_STAGE(PG8_SB(1, 1), cB + hstep + kstep, voffB);
        PG8_WAIT_V(6); PG8_BAR;
    } else {
        PG8_STAGE(PG8_SB(0, 0), cB, voffB); PG8_STAGE_A(PG8_SA(0, 0), 0, cA, 0); PG8_STAGE(PG8_SB(0, 1), cB + hstep, voffB); PG8_STAGE_A(PG8_SA(0, 1), 1, cA, 0);
        if (wr == 1) PG8_BAR;
        PG8_WAIT_V(4); PG8_BAR;
        PG8_STAGE(PG8_SB(1, 0), cB + kstep, voffB); PG8_STAGE_A(PG8_SA(1, 0), 0, cA + kstep, kstep); PG8_STAGE(PG8_SB(1, 1), cB + hstep + kstep, voffB);
        PG8_WAIT_V(6); PG8_BAR;
    }
    for (;;) {
        const bool has_next = S.next(ui + 1, nxt);
        const char* nA = has_next ? (const char*)g.A + (size_t)nxt.pm * tstep : cA; const char* nB = has_next ? (const char*)g.Bt + (size_t)nxt.pn * tstep : cB;
        if constexpr (Sched::GATHER) {
            if (has_next) S.a_offs(nxt, RR[0], RR[1], CC[0], CC[1], K, aoN);
            else {
#pragma unroll
                for (int h = 0; h < 2; ++h)
#pragma unroll
                    for (int i = 0; i < 2; ++i) aoN[h][i] = aoC[h][i]; }
        }
        for (int t = 0; t < nt; t += 2) {
            const bool last = (t == nt - 2);
            const char* a1 = cA + (size_t)(t + 1) * kstep;
            const char* a2 = last ? nA : cA + (size_t)(t + 2) * kstep; const char* b2 = last ? nB : cB + (size_t)(t + 2) * kstep;
            const char* a3 = a2 + kstep; const char* b3 = b2 + kstep;
            const size_t k1 = (size_t)(t + 1) * kstep, k2 = last ? (size_t)0 : (size_t)(t + 2) * kstep, k3 = k2 + kstep;
            if (last && has_next) S.a_ready(nxt);
            if constexpr (SP2) {
            PG8_LDB(B0, 0, 0); PG8_LDB(B1, 0, 1); PG8_SCHED; PG8_LDA(At, 0, 0); PG8_STAGE_A(PG8_SA(1, 1), 1, a1, k1);
            if constexpr (Sched::GATHER) { if (last) {
#pragma unroll
                for (int h = 0; h < 2; ++h)
#pragma unroll
                    for (int i = 0; i < 2; ++i) aoC[h][i] = aoN[h][i]; } }
            PG8_WAIT_V(8); PG8_WAIT_L(0); PG8_BAR; PG8_MMA(0, 0, At, B0); PG8_MMA(0, 1, At, B1); PG8_BAR; PG8_SCHED;
            PG8_LDA(At, 0, 1); PG8_STAGE(PG8_SB(0, 0), b2, voffB); PG8_STAGE(PG8_SB(0, 1), b2 + hstep, voffB); PG8_STAGE_A(PG8_SA(0, 0), 0, a2, k2);
            PG8_WAIT_V(8); PG8_WAIT_L(0); PG8_BAR; PG8_MMA(1, 0, At, B0); PG8_MMA(1, 1, At, B1); PG8_BAR; PG8_SCHED;
            PG8_LDB(B0, 1, 0); PG8_LDB(B1, 1, 1); PG8_SCHED; PG8_LDA(At, 1, 0); PG8_STAGE_A(PG8_SA(0, 1), 1, a2, k2);
            PG8_WAIT_V(8); PG8_WAIT_L(0); PG8_BAR; PG8_MMA(0, 0, At, B0); PG8_MMA(0, 1, At, B1); PG8_BAR; PG8_SCHED;
            PG8_LDA(At, 1, 1); PG8_STAGE(PG8_SB(1, 0), b3, voffB); PG8_STAGE(PG8_SB(1, 1), b3 + hstep, voffB); PG8_STAGE_A(PG8_SA(1, 0), 0, a3, k3);
            PG8_WAIT_V(8); PG8_WAIT_L(0); PG8_BAR; PG8_MMA(1, 0, At, B0); PG8_MMA(1, 1, At, B1); PG8_BAR; PG8_SCHED;
            } else {
            PG8_LDB(B0, 0, 0); PG8_SCHED; PG8_LDA(At, 0, 0); PG8_STAGE_A(PG8_SA(1, 1), 1, a1, k1);
            if constexpr (Sched::GATHER) { if (last) {
#pragma unroll
                for (int h = 0; h < 2; ++h)
#pragma unroll
                    for (int i = 0; i < 2; ++i) aoC[h][i] = aoN[h][i]; } }
            PG8_WAIT_L(8); PG8_BAR; PG8_WAIT_L(0); PG8_MMA(0, 0, At, B0); PG8_BAR; PG8_SCHED;
            PG8_LDB(B1, 0, 1); PG8_STAGE(PG8_SB(0, 0), b2, voffB);
            PG8_BAR; PG8_WAIT_L(0); PG8_MMA(0, 1, At, B1); PG8_BAR;
            PG8_LDA(At, 0, 1); PG8_STAGE_A(PG8_SA(0, 0), 0, a2, k2);
            PG8_BAR; PG8_WAIT_L(0); PG8_MMA(1, 0, At, B0); PG8_BAR; PG8_SCHED;
            PG8_STAGE(PG8_SB(0, 1), b2 + hstep, voffB);
            PG8_WAIT_V(6); PG8_BAR; PG8_MMA(1, 1, At, B1); PG8_BAR;
            PG8_LDB(B0, 1, 0); PG8_SCHED; PG8_LDA(At, 1, 0); PG8_STAGE_A(PG8_SA(0, 1), 1, a2, k2);
            PG8_WAIT_L(8); PG8_BAR; PG8_WAIT_L(0); PG8_MMA(0, 0, At, B0); PG8_BAR; PG8_SCHED;
            PG8_LDB(B1, 1, 1); PG8_STAGE(PG8_SB(1, 0), b3, voffB);
            PG8_BAR; PG8_WAIT_L(0); PG8_MMA(0, 1, At, B1); PG8_BAR;
            PG8_LDA(At, 1, 1); PG8_STAGE_A(PG8_SA(1, 0), 0, a3, k3);
            PG8_BAR; PG8_WAIT_L(0); PG8_MMA(1, 0, At, B0); PG8_BAR; PG8_SCHED;
            PG8_STAGE(PG8_SB(1, 1), b3 + hstep, voffB);
            PG8_WAIT_V(6); PG8_BAR; PG8_MMA(1, 1, At, B1); PG8_BAR;
            }
        }
        if constexpr (ALIGN_EPI) { if (wr == 0) PG8_BAR; }
        E(acc, cur, wr, wc, fr, fq); S.done(cur);
        if (!has_next) break;
#pragma unroll
        for (int a = 0; a < 2; ++a)
#pragma unroll
            for (int b = 0; b < 2; ++b)
#pragma unroll
                for (int m = 0; m < 4; ++m)
#pragma unroll
                    for (int n = 0; n < 2; ++n) acc[a][b][m][n] = (f32x4){0.f, 0.f, 0.f, 0.f};
        cur = nxt; cA = nA; cB = nB; ++ui;
        if constexpr (ALIGN_EPI) { if (wr == 1) PG8_BAR; }
    }
    PG8_WAIT_V(0);
    if constexpr (!ALIGN_EPI) { if (wr == 0) PG8_BAR; }
    PG8_BAR;
#undef PG8_SA
#undef PG8_SB
#undef PG8_STAGE
#undef PG8_STAGE_A
#undef PG8_LDA
#undef PG8_LDB
#undef PG8_MMA
#undef PG8_WAIT_V
#undef PG8_WAIT_L
#undef PG8_BAR
#undef PG8_SCHED
}
}

#ifndef MK_N_LAUNCHES
#define MK_N_LAUNCHES 1
#endif
constexpr int NWAVES = 8, NTHR = 512;
constexpr int S_ = 16384, D_ = 2048, DEPTH = 2, HD = 128;
constexpr int IN_W = 5656, NIN = 5888;
constexpr int NC = 1023;
constexpr int NEXP = 32, DEXP = 512, ECAP = 16384, NSLOT = 40960;
constexpr float RMS_EPS = 1e-6f;
constexpr float ATT_SCALE = 0.08838834764831845f;
constexpr int NPL = 13, NPH = 2 + 2 * NPL;

constexpr size_t MiB = 1u << 20;
constexpr size_t WS_CTL = 0, CTL_ZERO_BYTES = 1 * MiB;
constexpr size_t WS_ROPE = 1 * MiB, WS_WINT = 9 * MiB, WS_WOUTT = 55 * MiB, WS_WGUT = 71 * MiB, WS_WDT = 327 * MiB, WS_WC1T = 455 * MiB;
constexpr size_t WS_H = 463 * MiB, WS_QN = 527 * MiB, WS_QM = 559 * MiB, WS_KM = 591 * MiB, WS_VM = 623 * MiB;
constexpr size_t WS_KC = 655 * MiB, WS_VC = 663 * MiB, WS_KS = 671 * MiB, WS_VS = 679 * MiB, WS_KW = 687 * MiB, WS_VW = 695 * MiB;
constexpr size_t WS_GATES = 703 * MiB, WS_UL = 705 * MiB, WS_KCMP = 713 * MiB, WS_VCMP = 713 * MiB + 512 * 1024, WS_KMEAN = 714 * MiB;
constexpr size_t WS_OMIX = 715 * MiB, WS_OCMP = 779 * MiB, WS_OWIN = 811 * MiB, WS_SEL = 843 * MiB, WS_TE = 845 * MiB, WS_TOKIDX = 846 * MiB, WS_WTS = 848 * MiB;
constexpr size_t WS_HACT = 850 * MiB, WS_Y = 890 * MiB;
constexpr size_t WS_WRT = 714 * MiB + 256 * 1024;
constexpr size_t WS_IMP = WS_H + 32 * MiB;
constexpr size_t WS_NLIST = WS_H, WS_PSLC = 850 * MiB, WS_LSEN = 1106 * MiB;
constexpr size_t WS_MLIST = 1050 * MiB, WS_PSEL = 1082 * MiB, WS_POWN = 1178 * MiB, WS_LSES = 1210 * MiB, WS_LSEO = 1211 * MiB + 512 * 1024, WS_END = 1212 * MiB;
constexpr int CW_TMO = 0, CW_BAR = 4096, CW_CNT = 8192, CW_MOD = 16384, CW_B1E = 40960, CW_MCNT = 65536, CW_NCNT = 131072, CSTR = 64;

constexpr int RING_BYTES = 131072, LDSCTL_OFF = RING_BYTES, MISC_OFF = LDSCTL_OFF + 320, MOETAB_OFF = LDSCTL_OFF + 512, LDS_BYTES = 147456;

#define GAS __attribute__((address_space(1)))
#define LAS __attribute__((address_space(3)))
typedef unsigned short bf16;
typedef unsigned v4u __attribute__((ext_vector_type(4)));
typedef float f32x4 __attribute__((ext_vector_type(4)));
typedef float f32x2 __attribute__((ext_vector_type(2)));
typedef GAS unsigned gu32;
#define RLX_AGENT __ATOMIC_RELAXED, __HIP_MEMORY_SCOPE_AGENT
#define LDS_WAIT() asm volatile("s_waitcnt lgkmcnt(0)" ::: "memory")
__device__ __forceinline__ unsigned f2bf(float f) { unsigned u = __builtin_bit_cast(unsigned, f); return (u + 0x7fffu + ((u >> 16) & 1u)) >> 16; }
__device__ __forceinline__ unsigned pk2(float lo, float hi) { return f2bf(lo) | (f2bf(hi) << 16); }
__device__ __forceinline__ float bf2f(unsigned b) { return __builtin_bit_cast(float, b << 16); }
__device__ __forceinline__ float bflo(unsigned w) { return __builtin_bit_cast(float, w << 16); }
__device__ __forceinline__ float bfhi(unsigned w) { return __builtin_bit_cast(float, w & 0xffff0000u); }

#define XB_TMO      128
#define XB_XCNT(j)  (256  + 64 * (j))
#define XB_XSUB(j)  (1280 + 64 * (j))
#define XB_XGEN(j)  (2304 + 64 * (j))
#define XB_TOP      3328
#define XB_TOPGEN   3392
#define XCD_BAR_WORDS 3456
#define XB_SPIN_CAP (1u << 20)
__device__ __forceinline__ unsigned xb_ld(unsigned* p)              { return __hip_atomic_load(p, __ATOMIC_RELAXED, __HIP_MEMORY_SCOPE_AGENT); }
__device__ __forceinline__ unsigned xb_add(unsigned* p, unsigned v) { return __hip_atomic_fetch_add(p, v, __ATOMIC_RELAXED, __HIP_MEMORY_SCOPE_AGENT); }
__device__ __forceinline__ unsigned xb_xcc_id() { return (unsigned)__builtin_amdgcn_s_getreg((3 << 11) | 20) & 0xFu; }
#define XB_SPIN(cond, bar) do { unsigned _sp = 0; while (cond) { __builtin_amdgcn_s_sleep(1); \
    if ((++_sp & 255u) == 0u) { if (xb_ld(&(bar)[XB_TMO])) break; if (_sp > XB_SPIN_CAP) { atomicAdd(&(bar)[XB_TMO], 1u); break; } } } } while (0)
struct XcdBarrier { unsigned* bar; unsigned x; volatile LAS unsigned* st; };
__device__ __forceinline__ XcdBarrier xcd_barrier_post(unsigned* bar, volatile LAS unsigned* st) {
    XcdBarrier b; b.bar = bar; b.x = xb_xcc_id(); b.st = st;
    if (threadIdx.x == 0) (void)xb_add(&bar[XB_XCNT(b.x)], 1u);
    return b;
}
__device__ __forceinline__ void xcd_barrier_complete(unsigned* bar, unsigned x, unsigned& nloc, unsigned& nx) {
    const unsigned G = gridDim.x * gridDim.y * gridDim.z;
    unsigned sum, cnt, mine, sp = 0u;
    for (;;) {
        sum = 0u; cnt = 0u; mine = 0u;
#pragma unroll
        for (unsigned j = 0; j < 16; ++j) { const unsigned c = xb_ld(&bar[XB_XCNT(j)]); sum += c; cnt += (c > 0u) ? 1u : 0u; mine = (j == x) ? c : mine; }
        if (sum == G) break;
        __builtin_amdgcn_s_sleep(1);
        if ((++sp & 255u) == 0u) { if (xb_ld(&bar[XB_TMO])) break; if (sp > XB_SPIN_CAP) { atomicAdd(&bar[XB_TMO], 1u); break; } }
    }
    nloc = mine > 0u ? mine : 1u; nx = cnt > 0u ? cnt : 1u;
}
__device__ __forceinline__ void xcd_barrier(const XcdBarrier& b, bool leader  ) {
    asm volatile("s_waitcnt vmcnt(0)" ::: "memory");
    __syncthreads();
    if (leader) {
        unsigned* bar = b.bar;
        __builtin_amdgcn_s_waitcnt(0);
        unsigned nloc = b.st[0], nx = b.st[1];
        if (nloc == 0u) { xcd_barrier_complete(bar, b.x, nloc, nx); b.st[0] = nloc; b.st[1] = nx; }
        const unsigned old = xb_add(&bar[XB_XSUB(b.x)], 1u);
        const unsigned gen = old / nloc;
        if (old + 1u == (gen + 1u) * nloc) {
            __builtin_amdgcn_fence(__ATOMIC_RELEASE, "agent");
            asm volatile("s_waitcnt vmcnt(0)" ::: "memory");
            const unsigned og = xb_add(&bar[XB_TOP], 1u);
            const unsigned tg = og / nx;
            if (og + 1u == (tg + 1u) * nx) xb_add(&bar[XB_TOPGEN], 1u);
            else XB_SPIN(xb_ld(&bar[XB_TOPGEN]) == tg, bar);
            __builtin_amdgcn_fence(__ATOMIC_ACQUIRE, "agent");
            xb_add(&bar[XB_XGEN(b.x)], 1u);
            asm volatile("s_waitcnt vmcnt(0)" ::: "memory");
        } else {
            XB_SPIN(xb_ld(&bar[XB_XGEN(b.x)]) == gen, bar);
            __builtin_amdgcn_fence(__ATOMIC_ACQUIRE, "agent");
            asm volatile("s_waitcnt vmcnt(0)" ::: "memory");
        }
    }
    __syncthreads();
}

__device__ __forceinline__ float lane_get(float v, int src) { return __builtin_bit_cast(float, __builtin_amdgcn_ds_bpermute(src << 2, __builtin_bit_cast(int, v))); }
__device__ __forceinline__ int lane_geti(int v, int src) { return __builtin_amdgcn_ds_bpermute(src << 2, v); }
__device__ __forceinline__ float wave_sum(float v, int lane) {
#pragma unroll
    for (int o = 1; o < 64; o <<= 1) v += lane_get(v, lane ^ o);
    return v;
}
__device__ __forceinline__ int block_excl_scan(int v, LAS int* scr, int tid, int* tot) {
    const int lane = tid & 63, wv = tid >> 6; int s = v;
#pragma unroll
    for (int o = 1; o < 64; o <<= 1) { const int n = lane_geti(s, lane - o); if (lane >= o) s += n; }
    if (lane == 63) scr[wv] = s;
    __syncthreads();
    int off = 0, all = 0;
#pragma unroll
    for (int w = 0; w < 8; ++w) { const int x = scr[w]; all += x; off += (w < wv) ? x : 0; }
    *tot = all;
    __syncthreads();
    return off + s - v;
}

__device__ __forceinline__ float row_max16(float v) {
    v = fmaxf(v, __builtin_bit_cast(float, __builtin_amdgcn_update_dpp(0, __builtin_bit_cast(int, v), 0xB1, 0xF, 0xF, false)));
    v = fmaxf(v, __builtin_bit_cast(float, __builtin_amdgcn_update_dpp(0, __builtin_bit_cast(int, v), 0x4E, 0xF, 0xF, false)));
    v = fmaxf(v, __builtin_bit_cast(float, __builtin_amdgcn_update_dpp(0, __builtin_bit_cast(int, v), 0x124, 0xF, 0xF, false)));
    v = fmaxf(v, __builtin_bit_cast(float, __builtin_amdgcn_update_dpp(0, __builtin_bit_cast(int, v), 0x128, 0xF, 0xF, false)));
    return v;
}
__device__ __forceinline__ int row_min16(int v) {
    v = min(v, __builtin_amdgcn_update_dpp(0, v, 0xB1, 0xF, 0xF, false));
    v = min(v, __builtin_amdgcn_update_dpp(0, v, 0x4E, 0xF, 0xF, false));
    v = min(v, __builtin_amdgcn_update_dpp(0, v, 0x124, 0xF, 0xF, false));
    v = min(v, __builtin_amdgcn_update_dpp(0, v, 0x128, 0xF, 0xF, false));
    return v;
}
template <int NV>
__device__ __forceinline__ int row_pick(float (&v)[NV], int lam) {
    float m = v[0];
#pragma unroll
    for (int i = 1; i < NV; ++i) m = fmaxf(m, v[i]);
    m = row_max16(m);
    int idx = 1 << 20;
#pragma unroll
    for (int i = NV - 1; i >= 0; --i) idx = (v[i] == m) ? lam + 16 * i : idx;
    idx = row_min16(idx);
    if (m == -INFINITY) idx = -1;
#pragma unroll
    for (int i = 0; i < NV; ++i) v[i] = (lam + 16 * i == idx) ? -INFINITY : v[i];
    return idx;
}

__device__ __forceinline__ int il(int d) { return (d < 64) ? 2 * d : 2 * (d - 64) + 1; }
__device__ __forceinline__ int inproj_row(int s) {
    if (s < 1024) return (s & ~127) + il(s & 127);
    if (s < 1536) return s;
    if (s < 1792) return (s & ~127) + il(s & 127);
    if (s < 2048) return s;
    if (s < 2304) return (s & ~127) + il(s & 127);
    if (s < 2560) return s;
    if (s < 2584) return 5632 + (s - 2560);
    if (s < 3608) { const int r = s - 2584; return 2560 + (r & ~127) + il(r & 127); }
    if (s < 4632) { const int r = s - 3608; return 3584 + (r & ~127) + il(r & 127); }
    return 4608 + (s - 4632);
}
template <int MODE>
__device__ __forceinline__ void transpose_item(const float* W, int K, int N, bf16* WT, int dpitch, int row_off, LAS float* scr, int item, int lane) {
    const int nblk = (N + 31) / 32, kb = item / nblk, nb = item % nblk, k0 = 64 * kb, n0 = 32 * nb;
    const int nsrc = n0 + (lane & 31);
#pragma unroll 8
    for (int i = 0; i < 32; ++i) { const int kk = 2 * i + (lane >> 5); scr[kk * 33 + (lane & 31)] = (nsrc < N) ? W[(size_t)(k0 + kk) * N + nsrc] : 0.f; }
    LDS_WAIT(); asm volatile("" ::: "memory");
    const int c = lane & 7;
#pragma unroll
    for (int j = 0; j < 4; ++j) { const int nl = (lane >> 3) + 8 * j, n = n0 + nl; const LAS float* s = scr + (8 * c) * 33 + nl;
        v4u o; o.x = pk2(s[0 * 33], s[1 * 33]); o.y = pk2(s[2 * 33], s[3 * 33]); o.z = pk2(s[4 * 33], s[5 * 33]); o.w = pk2(s[6 * 33], s[7 * 33]);
        if (n < N) { int dr;
            if (MODE == 0) dr = n; else if (MODE == 1) dr = inproj_row(n); else if (MODE == 2) dr = (n >> 7) * 256 + (n & 127); else dr = (n >> 7) * 256 + 128 + (n & 127);
            *(GAS v4u*)(WT + (size_t)(row_off + dr) * dpitch + k0 + 8 * c) = o; } }
    LDS_WAIT(); asm volatile("" ::: "memory");
}

using pg8::Unit;
struct EpiInProj {
    static constexpr bool PERM = true;
    bf16 *QN, *KC, *VC, *KS, *VS, *KW, *VW, *QM, *KM, *VM; float* GATES; const float* rope;
    __device__ __forceinline__ void operator()(const f32x4 (&acc)[2][2][4][2], const Unit& u, int wr, int wc, int fr, int fq) const {
        const int pn = u.pn, row0 = u.pm * 256 + wr * 64 + fr, c8 = wc * 32 + 8 * fq;
        if (pn == 22) {
            if (c8 < 24) {
#pragma unroll
                for (int ai = 0; ai < 2; ++ai)
#pragma unroll
                    for (int m = 0; m < 4; ++m) { const int row = row0 + ai * 128 + m * 16; float* gp = GATES + (size_t)row * 32 + c8;
                        f32x4 a = acc[ai][0][m][0], b = acc[ai][0][m][1], ga, gb;
#pragma unroll
                        for (int j = 0; j < 4; ++j) { ga[j] = 1.f / (1.f + __expf(-a[j])); gb[j] = 1.f / (1.f + __expf(-b[j])); }
                        *(f32x4*)gp = ga; *(f32x4*)(gp + 4) = gb; }
            }
            return;
        }
        bf16* base; int pitch; size_t bjs; bool rot;
        if (pn < 4)       { base = QN + pn * 256;        pitch = 1024; bjs = 128; rot = true; }
        else if (pn == 4) { base = KC;                   pitch = 128;  bjs = (size_t)S_ * 128; rot = false; }
        else if (pn == 5) { base = VC;                   pitch = 128;  bjs = (size_t)S_ * 128; rot = false; }
        else if (pn == 6) { base = KS;                   pitch = 256;  bjs = 128; rot = true; }
        else if (pn == 7) { base = VS;                   pitch = 256;  bjs = 128; rot = false; }
        else if (pn == 8) { base = KW;                   pitch = 256;  bjs = 128; rot = true; }
        else if (pn == 9) { base = VW;                   pitch = 256;  bjs = 128; rot = false; }
        else if (pn < 14) { base = QM + (pn - 10) * 256; pitch = 1024; bjs = 128; rot = true; }
        else if (pn < 18) { base = KM + (pn - 14) * 256; pitch = 1024; bjs = 128; rot = true; }
        else              { base = VM + (pn - 18) * 256; pitch = 1024; bjs = 128; rot = false; }
#pragma unroll
        for (int ai = 0; ai < 2; ++ai)
#pragma unroll
            for (int m = 0; m < 4; ++m) { const int row = row0 + ai * 128 + m * 16;
                f32x4 t0 = (f32x4){1.f, 0.f, 1.f, 0.f}, t1 = t0;
                if (rot) { const f32x4* tp = (const f32x4*)(rope + (size_t)row * 128 + (c8 >> 1) * 2); t0 = tp[0]; t1 = tp[1]; }
#pragma unroll
                for (int bj = 0; bj < 2; ++bj) { f32x4 v0 = acc[ai][bj][m][0], v1 = acc[ai][bj][m][1];
                    if (rot) { f32x4 w0, w1;
                        w0[0] = v0[0] * t0[0] - v0[1] * t0[1]; w0[1] = v0[1] * t0[0] + v0[0] * t0[1]; w0[2] = v0[2] * t0[2] - v0[3] * t0[3]; w0[3] = v0[3] * t0[2] + v0[2] * t0[3];
                        w1[0] = v1[0] * t1[0] - v1[1] * t1[1]; w1[1] = v1[1] * t1[0] + v1[0] * t1[1]; w1[2] = v1[2] * t1[2] - v1[3] * t1[3]; w1[3] = v1[3] * t1[2] + v1[2] * t1[3];
                        v0 = w0; v1 = w1; }
                    pg8::u32x4 w; w.x = pg8::cvt_pk_bf16(v0[0], v0[1]); w.y = pg8::cvt_pk_bf16(v0[2], v0[3]); w.z = pg8::cvt_pk_bf16(v1[0], v1[1]); w.w = pg8::cvt_pk_bf16(v1[2], v1[3]);
                    *(pg8::u32x4*)(base + (size_t)row * pitch + bj * bjs + c8) = w; } }
    }
};
struct EpiOutProj {
    static constexpr bool PERM = false;
    const float* xsrc; float* X; const float* gt;
    __device__ __forceinline__ void operator()(const f32x4 (&acc)[2][2][4][2], const Unit& u, int wr, int wc, int fr, int fq) const {
        const int row0 = u.pm * 256 + wr * 64 + fr, col0 = u.pnl * 256 + wc * 32 + 4 * fq;
        f32x4 gv[2][2];
#pragma unroll
        for (int bj = 0; bj < 2; ++bj)
#pragma unroll
            for (int n = 0; n < 2; ++n) gv[bj][n] = *(const f32x4*)(gt + col0 + bj * 128 + n * 16);
#pragma unroll
        for (int ai = 0; ai < 2; ++ai)
#pragma unroll
            for (int m = 0; m < 4; ++m) { const size_t ro = (size_t)(row0 + ai * 128 + m * 16) * D_ + col0;
#pragma unroll
                for (int bj = 0; bj < 2; ++bj)
#pragma unroll
                    for (int n = 0; n < 2; ++n) { const f32x4 xv = *(const f32x4*)(xsrc + ro + bj * 128 + n * 16); *(f32x4*)(X + ro + bj * 128 + n * 16) = xv + gv[bj][n] * acc[ai][bj][m][n]; } }
    }
};
struct EpiF32 {
    static constexpr bool PERM = false;
    float* C; int ldc;
    __device__ __forceinline__ void operator()(const f32x4 (&acc)[2][2][4][2], const Unit& u, int wr, int wc, int fr, int fq) const {
        const int row0 = u.pm * 256 + wr * 64 + fr, col0 = u.pnl * 256 + wc * 32 + 4 * fq;
#pragma unroll
        for (int ai = 0; ai < 2; ++ai)
#pragma unroll
            for (int m = 0; m < 4; ++m) { float* rowp = C + (size_t)(row0 + ai * 128 + m * 16) * ldc + col0;
#pragma unroll
                for (int bj = 0; bj < 2; ++bj)
#pragma unroll
                    for (int n = 0; n < 2; ++n) *(f32x4*)(rowp + bj * 128 + n * 16) = acc[ai][bj][m][n]; }
    }
};
struct EpiGateUp {
    static constexpr bool PERM = true;
    bf16* HACT;
    __device__ __forceinline__ void operator()(const f32x4 (&acc)[2][2][4][2], const Unit& u, int wr, int wc, int fr, int fq) const {
        const int row0 = u.pm * 256 + wr * 64 + fr, col0 = u.pnl * 128 + wc * 32 + 8 * fq;
#pragma unroll
        for (int ai = 0; ai < 2; ++ai)
#pragma unroll
            for (int m = 0; m < 4; ++m) { const int row = row0 + ai * 128 + m * 16; f32x4 h[2];
#pragma unroll
                for (int n = 0; n < 2; ++n)
#pragma unroll
                    for (int j = 0; j < 4; ++j) { const float gg = acc[ai][0][m][n][j], uu = acc[ai][1][m][n][j]; h[n][j] = gg / (1.f + __expf(-gg)) * uu; }
                pg8::u32x4 w; w.x = pg8::cvt_pk_bf16(h[0][0], h[0][1]); w.y = pg8::cvt_pk_bf16(h[0][2], h[0][3]); w.z = pg8::cvt_pk_bf16(h[1][0], h[1][1]); w.w = pg8::cvt_pk_bf16(h[1][2], h[1][3]);
                *(pg8::u32x4*)(HACT + (size_t)row * DEXP + col0) = w; }
    }
};
struct EpiDown {
    static constexpr bool PERM = true;
    bf16* Y; const float* WTS; const LAS int* tab;
    __device__ __forceinline__ void operator()(const f32x4 (&acc)[2][2][4][2], const Unit& u, int wr, int wc, int fr, int fq) const {
        const int rl0 = wr * 64 + fr, col0 = u.pnl * 256 + wc * 32 + 8 * fq, cnt = tab[u.e];
#pragma unroll
        for (int ai = 0; ai < 2; ++ai)
#pragma unroll
            for (int m = 0; m < 4; ++m) { const int rl = rl0 + ai * 128 + m * 16, pos = u.mt * 256 + rl;
                const float w = (pos < cnt) ? WTS[(size_t)u.e * ECAP + pos] : 0.f;
                bf16* rowp = Y + (size_t)(u.pm * 256 + rl) * D_ + col0;
#pragma unroll
                for (int bj = 0; bj < 2; ++bj) { const f32x4 v0 = acc[ai][bj][m][0] * w, v1 = acc[ai][bj][m][1] * w;
                    pg8::u32x4 o; o.x = pg8::cvt_pk_bf16(v0[0], v0[1]); o.y = pg8::cvt_pk_bf16(v0[2], v0[3]); o.z = pg8::cvt_pk_bf16(v1[0], v1[1]); o.w = pg8::cvt_pk_bf16(v1[2], v1[3]);
                    *(pg8::u32x4*)(rowp + bj * 128) = o; } }
    }
};

struct CompressOrder {
    static constexpr bool GATHER = false;
    int G, c;
    __device__ bool next(int i, Unit& u) const { const int L = i * G + c; if (L >= 32) return false; u.pm = L >> 1; u.pnl = L & 1; u.pn = (u.pm >= 8 ? 2 : 0) + u.pnl; u.e = 0; u.mt = 0; return true; }
    __device__ __forceinline__ void a_offs(const Unit&, int, int, int, int, int, unsigned (&)[2][2]) const {}
    __device__ __forceinline__ void a_ready(const Unit&) const {}
    __device__ __forceinline__ void done(const Unit&) const {}
};
template <bool GATHER_>
struct MoeOrder {
    static constexpr bool GATHER = GATHER_;
    const LAS int* tab; int NT, G, c, bt_per_e, bt_base; const int* tokidx;
    __device__ bool next(int i, Unit& u) const {
        const int L = i * G + c; if (L >= tab[64]) return false;
        int e = 0;
        for (int k = 1; k < NEXP; ++k) e += (L >= tab[32 + k]) ? 1 : 0;
        e = __builtin_amdgcn_readfirstlane(e);
        const int r = L - tab[32 + e];
        u.e = e; u.mt = r / NT; u.pnl = r % NT; u.pn = bt_base + e * bt_per_e + u.pnl; u.pm = (tab[65 + e] >> 8) + u.mt; return true;
    }
    __device__ __forceinline__ void a_offs(const Unit& u, int R0, int R1, int C0, int C1, int K, unsigned (&o)[2][2]) const {
        const int cnt = tab[u.e]; const int* tk = tokidx + (size_t)u.e * ECAP;
#pragma unroll
        for (int h = 0; h < 2; ++h) {
            int p0 = u.mt * 256 + h * 128 + R0, p1 = u.mt * 256 + h * 128 + R1; p0 = p0 < cnt ? p0 : cnt - 1; p1 = p1 < cnt ? p1 : cnt - 1;
            o[h][0] = ((unsigned)tk[p0] * (unsigned)K + (unsigned)C0) * 2u; o[h][1] = ((unsigned)tk[p1] * (unsigned)K + (unsigned)C1) * 2u; }
    }
    __device__ __forceinline__ void a_ready(const Unit&) const {}
    __device__ __forceinline__ void done(const Unit&) const {}
};

namespace att {
constexpr int D = 128, NW = 8, QBLK = 32, KVBLK = 64, QB = NW * QBLK;
constexpr int SHM_V = KVBLK * D * 2, SHM_K = KVBLK * D * 2;
constexpr int OFF_WS = 2 * SHM_V + 2 * SHM_K, OFF_OT = OFF_WS + NW * 64 * 4, LDS_BYTES = OFF_OT + NW * 32 * 4;
constexpr int OFF_ST = 73728, ST_ROW = 272, ST_WAVE = 16 * ST_ROW;
constexpr float SCALE = 0.08838834764831845f, THR = 8.f;
typedef short bf16x8 __attribute__((ext_vector_type(8)));
typedef short s16x4 __attribute__((ext_vector_type(4)));
typedef float f32x16 __attribute__((ext_vector_type(16)));
typedef float f32x4 __attribute__((ext_vector_type(4)));
typedef unsigned u32x4 __attribute__((ext_vector_type(4)));
typedef unsigned short bf16;
#define KSWZ(row, colB) ((row) * 256 + ((colB) ^ (((row) & 7) << 4)))
#define SBAR() __builtin_amdgcn_sched_barrier(0)
__device__ __forceinline__ int v_st(int k, int c) { const int kk = (k & ~0xC) | ((k & 4) << 1) | ((k & 8) >> 1); return ((kk >> 3) * 4 + (c >> 5)) * 512 + ((kk & 7) * 32 + (c & 31)) * 2; }
__device__ __forceinline__ int v_rd_base(int lane) { return ((lane & 3) << 3) | (((lane >> 2) & 3) << 6) | (((lane >> 4) & 1) << 5) | (((lane >> 5) & 1) << 8); }
constexpr int v_rd_off(int d0, int ks, int half) { return d0 * 512 + ks * 4096 + half * 2048; }
__device__ __forceinline__ int crow(int r, int hi) { return (r & 3) + 8 * (r >> 2) + 4 * hi; }
__device__ __forceinline__ unsigned cvtpk(float lo, float hi) { unsigned r; asm volatile("v_cvt_pk_bf16_f32 %0, %1, %2" : "=v"(r) : "v"(lo), "v"(hi)); return r; }
__device__ __forceinline__ bf16x8 load8(const bf16* p) { return *reinterpret_cast<const bf16x8*>(p); }
__device__ __forceinline__ void mask_tile(f32x16& p0, f32x16& p1, int dq, unsigned W) {
    const float NEG = -__builtin_inff();
#pragma unroll
    for (int r = 0; r < 16; ++r) {
        const int c = (r & 3) + 8 * (r >> 2);
        if ((unsigned)(dq - c) >= W) p0[r] = NEG;
        if ((unsigned)(dq - c - 32) >= W) p1[r] = NEG;
    }
}
__device__ __forceinline__ void partialSM(f32x16& p0, f32x16& p1, float& m_reg, float& mn, float& alpha) {
    float pmax = p0[0]; for (int r = 1; r < 16; ++r) pmax = fmaxf(pmax, p0[r]); for (int r = 0; r < 16; ++r) pmax = fmaxf(pmax, p1[r]);
    { auto rr = __builtin_amdgcn_permlane32_swap(__float_as_uint(pmax), __float_as_uint(pmax), false, false);
      pmax = fmaxf(__uint_as_float(rr[0]), __uint_as_float(rr[1])); }
    constexpr float C2 = 1.4426950408889634f * SCALE;
    if (__builtin_expect(__all((pmax - m_reg) * SCALE <= THR), 1)) { mn = m_reg; alpha = 1.f; }
    else { mn = fmaxf(m_reg, pmax); alpha = __builtin_amdgcn_exp2f((m_reg - mn) * C2); m_reg = mn; }
    const float mnL = -mn * C2;
    for (int r = 0; r < 16; ++r) p0[r] = fmaf(p0[r], C2, mnL); for (int r = 0; r < 16; ++r) p1[r] = fmaf(p1[r], C2, mnL);
    for (int r = 0; r < 16; ++r) p0[r] = __builtin_amdgcn_exp2f(p0[r]);
}
__device__ __forceinline__ void finishSM(f32x16& p0, f32x16& p1, float alpha, float& l_reg, bf16x8& pa0, bf16x8& pa1, bf16x8& pa2, bf16x8& pa3) {
    for (int r = 0; r < 16; ++r) p1[r] = __builtin_amdgcn_exp2f(p1[r]);
    float ps = 0; for (int r = 0; r < 16; ++r) ps += p0[r]; for (int r = 0; r < 16; ++r) ps += p1[r];
    { auto rr = __builtin_amdgcn_permlane32_swap(__float_as_uint(ps), __float_as_uint(ps), false, false);
      ps = __uint_as_float(rr[0]) + __uint_as_float(rr[1]); }
    l_reg = l_reg * alpha + ps;
#define PK4(P, B_, OUT) do { unsigned a0 = cvtpk(P[B_+0], P[B_+1]), a1 = cvtpk(P[B_+2], P[B_+3]);                          \
        unsigned b0 = cvtpk(P[B_+4], P[B_+5]), b1 = cvtpk(P[B_+6], P[B_+7]);                                             \
        auto r0 = __builtin_amdgcn_permlane32_swap(a0, b0, false, false); auto r1 = __builtin_amdgcn_permlane32_swap(a1, b1, false, false); \
        u32x4 w = {r0[0], r1[0], r0[1], r1[1]}; OUT = *reinterpret_cast<bf16x8*>(&w); } while (0)
    PK4(p0, 0, pa0); PK4(p0, 8, pa1); PK4(p1, 0, pa2); PK4(p1, 8, pa3);
#undef PK4
}
template <int KB, bool SK>
__device__ __forceinline__ void qkt(f32x16& p0, f32x16& p1, const char* K_lds, int r32, int hi, const bf16x8* qr, bool act) {
    if (SK && !act) { const float NEG = -__builtin_inff();
#pragma unroll
        for (int r = 0; r < 16; ++r) { p0[r] = NEG; p1[r] = NEG; } return; }
    p0 = f32x16{}; p1 = f32x16{};
    const char* kb[4];
#pragma unroll
    for (int dd = 0; dd < 4; ++dd) kb[dd] = K_lds + KB * SHM_K + KSWZ(r32, (dd * 16 + hi * 8) * 2);
#pragma unroll
    for (int d0 = 0; d0 < 8; ++d0) { const char* a = kb[d0 & 3] + (d0 >> 2) * 128;
        bf16x8 b0 = *reinterpret_cast<const bf16x8*>(a);
        bf16x8 b1 = *reinterpret_cast<const bf16x8*>(a + 32 * 256);
        p0 = __builtin_amdgcn_mfma_f32_32x32x16_bf16(b0, qr[d0], p0, 0, 0, 0);
        p1 = __builtin_amdgcn_mfma_f32_32x32x16_bf16(b1, qr[d0], p1, 0, 0, 0); }
}
template <int VB, bool SK>
__device__ __forceinline__ void pv_tile(f32x16* o, int vb0, bf16x8 pa0, bf16x8 pa1, bf16x8 pa2, bf16x8 pa3, bool act) {
    if (SK && !act) return;
#define TRRD(dst, off) asm volatile("ds_read_b64_tr_b16 %0, %1 offset:%2" : "=&v"(dst) : "v"(vb0), "i"(off) : "memory")
#define PV_D0(d0) do { s16x4 l0, l1, l2, l3, h0, h1, h2, h3; constexpr int b_ = VB * SHM_V + v_rd_off(d0, 0, 0); \
        TRRD(l0, b_); TRRD(h0, b_ + 2048); TRRD(l1, b_ + 4096); TRRD(h1, b_ + 6144); TRRD(l2, b_ + 8192); TRRD(h2, b_ + 10240); TRRD(l3, b_ + 12288); TRRD(h3, b_ + 14336); \
        asm volatile("s_waitcnt lgkmcnt(0)" ::: "memory"); SBAR();   \
        o[d0] = __builtin_amdgcn_mfma_f32_32x32x16_bf16(pa0, (bf16x8){l0[0], l0[1], l0[2], l0[3], h0[0], h0[1], h0[2], h0[3]}, o[d0], 0, 0, 0);   \
        o[d0] = __builtin_amdgcn_mfma_f32_32x32x16_bf16(pa1, (bf16x8){l1[0], l1[1], l1[2], l1[3], h1[0], h1[1], h1[2], h1[3]}, o[d0], 0, 0, 0);   \
        o[d0] = __builtin_amdgcn_mfma_f32_32x32x16_bf16(pa2, (bf16x8){l2[0], l2[1], l2[2], l2[3], h2[0], h2[1], h2[2], h2[3]}, o[d0], 0, 0, 0);   \
        o[d0] = __builtin_amdgcn_mfma_f32_32x32x16_bf16(pa3, (bf16x8){l3[0], l3[1], l3[2], l3[3], h3[0], h3[1], h3[2], h3[3]}, o[d0], 0, 0, 0); } while (0)
    PV_D0(0); PV_D0(1); PV_D0(2); PV_D0(3);
#undef PV_D0
#undef TRRD
}
struct Ref { const bf16* Q; const bf16* K; const bf16* V; bf16* O; const int* list; int kpitch, j_lo, j_hi, P0, W, a0, a1, nm_lo, nm_hi; };
struct Seam { bf16x8 qr[8]; bf16x8 st_v0, st_v1, st_k0, st_k1; };
#define ROW(p, kp, k0, rr) ((p) + (size_t)((k0) + (rr)) * (kp) + sc)
#define VMW() asm volatile("s_waitcnt vmcnt(0)" ::: "memory")
#define VMWN(n) asm volatile("s_waitcnt vmcnt(%0)" :: "i"(n) : "memory")
#define SLOAD_H(Kp, Vp, kp, k0) do { S.st_v0 = load8(ROW(Vp, kp, k0, sr)); S.st_v1 = load8(ROW(Vp, kp, k0, 32 + sr));              \
                         S.st_k0 = load8(ROW(Kp, kp, k0, sr)); S.st_k1 = load8(ROW(Kp, kp, k0, 32 + sr)); } while (0)
#define SWRITE_HK(bf) do { *(bf16x8*)(K_lds + (bf) * SHM_K + kws) = S.st_k0; *(bf16x8*)(K_lds + (bf) * SHM_K + kws + 32 * 256) = S.st_k1; } while (0)
#define SWRITE_HV(bf) do { *(bf16x8*)(V_lds + (bf) * SHM_V + vst0) = S.st_v0; *(bf16x8*)(V_lds + (bf) * SHM_V + vst1) = S.st_v1; } while (0)
#define SWRITE_H(bf) do { SWRITE_HV(bf); SWRITE_HK(bf); } while (0)
template <class RF>
__device__ __forceinline__ void prime(const Ref& cur, char* lds, Seam& S) {
    const int tid_ = wg_tid((const __attribute__((address_space(3))) int*)(uintptr_t)(unsigned)(uintptr_t)(lds + WIDTAB_OFF));
    const int tid = tid_, wid = __builtin_amdgcn_readfirstlane(tid >> 6), lane = tid & 63, r32 = lane & 31, hi = lane >> 5;
    const int sr = tid >> 4, sc = (tid & 15) * 8, kws = KSWZ(sr, sc * 2); char* K_lds = lds + 2 * SHM_V;
    const int kb0 = cur.j_lo * KVBLK;
    { const bf16* qrow = cur.Q + RF::q_off(cur, wid * QBLK + r32, RF::entry(cur, wid * QBLK + r32));
      for (int d0 = 0; d0 < 8; ++d0) S.qr[d0] = load8(qrow + d0 * 16 + hi * 8); }
    SLOAD_H(cur.K, cur.V, cur.kpitch, kb0); VMW(); SWRITE_HK(0);
    __syncthreads();
}
template <int MODE, bool WSKIP, class RF, bool O8 = false, bool ONE = false>
__device__ __forceinline__ void block(const Ref& cur, const Ref& nxt, float* LSE, char* lds, Seam& S, float* lse_lane = nullptr) {
    const int tid_ = wg_tid((const __attribute__((address_space(3))) int*)(uintptr_t)(unsigned)(uintptr_t)(lds + WIDTAB_OFF));
    const int tid = tid_, wid = __builtin_amdgcn_readfirstlane(tid >> 6), lane = tid & 63, r32 = lane & 31, hi = lane >> 5;
    const int j_lo = cur.j_lo, NT = cur.j_hi - cur.j_lo;
    const int kbn = nxt.j_lo * KVBLK;
    const int W = cur.W;
    const int qlo = cur.P0 + wid * QBLK;
    const int e_cur = RF::entry(cur, wid * QBLK + r32), e_nxt = RF::entry(nxt, wid * QBLK + r32);
    const int qm = (MODE == 2 ? RF::pos(cur, wid * QBLK + r32, e_cur) : qlo + r32) - 4 * hi;
    const unsigned Wm = (MODE == 2) ? (unsigned)RF::Wl(cur, wid * QBLK + r32) : (unsigned)W;
    char* V_lds = lds; char* K_lds = lds + 2 * SHM_V;
    float* ws = (float*)(lds + OFF_WS) + wid * 64; float* li_l = ws, * al_l = ws + 32; int* ot_l = (int*)(lds + OFF_OT) + wid * 32;
    float m_reg = -1e30f, l_reg = 0; f32x16 o[4] = {};
    const int sr = tid >> 4, sc = (tid & 15) * 8, vst0 = v_st(sr, sc), vst1 = v_st(32 + sr, sc), kws = KSWZ(sr, sc * 2);
    const int vb0 = (int)(uintptr_t)V_lds + v_rd_base(lane);
    const bf16* Kh = cur.K; const bf16* Vh = cur.V; const int kp = cur.kpitch;
#define RESC(a) do { if (__any((a) < 1.f)) { if (hi == 0) al_l[r32] = (a); asm volatile("s_waitcnt lgkmcnt(0)" ::: "memory");              \
                     for (int d_ = 0; d_ < 4; ++d_) for (int r = 0; r < 16; ++r) o[d_][r] *= al_l[crow(r, hi)]; } } while (0)
#define KBASE(t) ((j_lo + (t)) * KVBLK)
#define ACT(t) (MODE != 0 || (KBASE(t) <= qlo + QBLK - 1 && KBASE(t) + KVBLK - 1 >= qlo - W + 1))
#define MASKT(P0_, P1_, t) do { const int kb_ = KBASE(t); if (MODE == 2) { const int jt_ = j_lo + (t); if (!(jt_ >= cur.nm_lo && jt_ < cur.nm_hi)) mask_tile(P0_, P1_, qm - kb_, Wm); } \
        else if (MODE == 0) { if ((!SK || ACT(t)) && (kb_ + KVBLK - 1 > qlo || kb_ <= qlo + QBLK - 1 - W)) mask_tile(P0_, P1_, qm - kb_, Wm); } } while (0)
    constexpr int NQL = 8;
    constexpr bool SK = WSKIP && MODE == 0;
#define SEAM_K0() do { VMWN(NQL); SWRITE_HK(0); SBAR(); } while (0)
    f32x16 pA0, pA1, pB0, pB1; float mnA, mnB, alA, alB; bf16x8 pa0, pa1, pa2, pa3;
    SWRITE_HV(0); SBAR();
    if constexpr (ONE) { SLOAD_H(nxt.K, nxt.V, nxt.kpitch, kbn); SBAR(); }
    if (NT > 1) { SLOAD_H(Kh, Vh, kp, KBASE(1)); }
    SBAR(); qkt<0, SK>(pA0, pA1, K_lds, r32, hi, S.qr, ACT(0));
    MASKT(pA0, pA1, 0); partialSM(pA0, pA1, m_reg, mnA, alA);
    if (NT > 1) { VMW(); SWRITE_H(1); }
    __syncthreads();
#define HALF_STEP(PX0, PX1, mnX, alX, PY0, PY1, alY, t, KB, VB, SB) do {                                                      \
        SBAR(); qkt<KB, SK>(PX0, PX1, K_lds, r32, hi, S.qr, ACT(t));                                             \
        finishSM(PY0, PY1, alY, l_reg, pa0, pa1, pa2, pa3); SBAR();                                                           \
        if ((t) + 1 < NT) { SLOAD_H(Kh, Vh, kp, KBASE((t) + 1)); SBAR(); }                                               \
        pv_tile<VB, SK>(o, vb0, pa0, pa1, pa2, pa3, ACT((t) - 1)); MASKT(PX0, PX1, (t)); partialSM(PX0, PX1, m_reg, mnX, alX);                                        \
        __syncthreads();                                                                                                      \
        if ((t) + 1 < NT) { VMW(); SWRITE_H(SB); }                                                                          \
        RESC(alX); __syncthreads(); } while (0)
    for (int t = 1; t + 1 < NT; t += 2) {
        HALF_STEP(pB0, pB1, mnB, alB, pA0, pA1, alA, t, 1, 0, 0);
        HALF_STEP(pA0, pA1, mnA, alA, pB0, pB1, alB, t + 1, 0, 1, 1);
    }
    const bool even = (NT & 1) == 0;
    if (even) { SBAR(); qkt<1, SK>(pB0, pB1, K_lds, r32, hi, S.qr, ACT(NT - 1)); SBAR(); }
    if constexpr (!ONE) { SLOAD_H(nxt.K, nxt.V, nxt.kpitch, kbn); SBAR(); }
    { const bf16* qrow = nxt.Q + RF::q_off(nxt, wid * QBLK + r32, e_nxt);
#pragma unroll
      for (int d0 = 0; d0 < 8; ++d0) S.qr[d0] = load8(qrow + d0 * 16 + hi * 8); }
    SBAR();
    finishSM(pA0, pA1, alA, l_reg, pa0, pa1, pa2, pa3); SBAR();
    pv_tile<0, SK>(o, vb0, pa0, pa1, pa2, pa3, ACT(even ? NT - 2 : NT - 1));
    if (even) { MASKT(pB0, pB1, NT - 1); partialSM(pB0, pB1, m_reg, mnB, alB); __syncthreads(); RESC(alB);
        finishSM(pB0, pB1, alB, l_reg, pa0, pa1, pa2, pa3); SBAR(); pv_tile<1, SK>(o, vb0, pa0, pa1, pa2, pa3, ACT(NT - 1)); }
    SBAR(); SEAM_K0();
    if (hi == 0) { li_l[r32] = l_reg; ot_l[r32] = RF::o_off(cur, wid * QBLK + r32, e_cur); } asm volatile("s_waitcnt lgkmcnt(0)" ::: "memory");
    if (LSE != nullptr && hi == 0) { const int lq = RF::l_idx(cur, wid * QBLK + r32, e_cur); if (lq >= 0) LSE[lq] = (l_reg > 0.f) ? m_reg * SCALE + __logf(l_reg) : -__builtin_inff(); }
    if (lse_lane != nullptr) *lse_lane = (l_reg > 0.f) ? m_reg * SCALE + __logf(l_reg) : -__builtin_inff();
    bf16* O = cur.O;
    { char* stg = lds + OFF_ST + wid * ST_WAVE;
#pragma unroll 1
      for (int p = 0; p < 2; ++p) {
#pragma unroll
        for (int rr = 0; rr < 8; ++rr) { const int r = 8 * p + rr, orow = crow(r, hi); const float lv = li_l[orow]; const float rl = (lv > 0.f) ? __builtin_amdgcn_rcpf(lv) * (O8 ? 16.f : 1.f) : 0.f;
#pragma unroll
            for (int d0 = 0; d0 < 4; ++d0) {
                if constexpr (O8) *(unsigned char*)(stg + (orow - 16 * p) * ST_ROW + (d0 * 32 + r32)) = (unsigned char)__builtin_amdgcn_cvt_pk_fp8_f32(o[d0][r] * rl, 0.f, 0, false);
                else *(unsigned short*)(stg + (orow - 16 * p) * ST_ROW + (d0 * 32 + r32) * 2) = (unsigned short)cvtpk(o[d0][r] * rl, 0.f); } }
        asm volatile("s_waitcnt lgkmcnt(0)" ::: "memory");
        { const int row = lane >> 2, ch = lane & 3, oo = ot_l[16 * p + row];
          if constexpr (O8) {
#pragma unroll
            for (int i = 0; i < 2; ++i) { const u32x4 x = *(const u32x4*)(stg + row * ST_ROW + (i * 4 + ch) * 16); if (oo >= 0) *(u32x4*)((char*)O + (size_t)oo + (i * 4 + ch) * 16) = x; }
          } else {
#pragma unroll
            for (int i = 0; i < 4; ++i) { const u32x4 x = *(const u32x4*)(stg + row * ST_ROW + (i * 4 + ch) * 16); if (oo >= 0) *(u32x4*)(O + (size_t)oo + (i * 4 + ch) * 8) = x; } } }
        asm volatile("s_waitcnt lgkmcnt(0)" ::: "memory");
      } }
    __syncthreads();
#undef RESC
#undef KBASE
#undef ACT
#undef MASKT
#undef SEAM_K0
#undef HALF_STEP
}

template <class RF>
__device__ __forceinline__ void imp_sweep(const Ref& cur, float lse_lane, float* IMP  , char* lds, Seam& S) {
    const int tid_ = wg_tid((const __attribute__((address_space(3))) int*)(uintptr_t)(unsigned)(uintptr_t)(lds + WIDTAB_OFF));
    const int tid = tid_, wid = __builtin_amdgcn_readfirstlane(tid >> 6), lane = tid & 63, r32 = lane & 31, hi = lane >> 5;
    const int NT = cur.j_hi - cur.j_lo;
    char* K_lds = lds + 2 * SHM_V;
    const int sr = tid >> 4, sc = (tid & 15) * 8, kws = KSWZ(sr, sc * 2);
    const bf16* Kh = cur.K; const int kp = cur.kpitch;
    const int row = wid * QBLK + r32;
    const int qm = RF::pos(cur, row, RF::entry(cur, row)) - 4 * hi; const unsigned Wm = (unsigned)RF::Wl(cur, row);
    constexpr float C2 = 1.4426950408889634f * SCALE;
    const float nl2 = (lse_lane == -__builtin_inff()) ? 0.f : -lse_lane * 1.4426950408889634f;
    float carry = 0.f;
    float* imp_row = IMP + (size_t)(row >> 2) * 512;
    f32x16 p0, p1;
#define IMP_TILE(t, KB) do { \
        if ((t) + 1 < NT) { S.st_k0 = load8(ROW(Kh, kp, (cur.j_lo + (t) + 1) * KVBLK, sr)); S.st_k1 = load8(ROW(Kh, kp, (cur.j_lo + (t) + 1) * KVBLK, 32 + sr)); } \
        SBAR(); qkt<KB, false>(p0, p1, K_lds, r32, hi, S.qr, true); \
        { const int jt_ = cur.j_lo + (t); if (!(jt_ >= cur.nm_lo && jt_ < cur.nm_hi)) mask_tile(p0, p1, qm - jt_ * KVBLK, Wm); } \
        _Pragma("unroll") for (int r = 0; r < 16; ++r) { p0[r] = __builtin_amdgcn_exp2f(fmaf(p0[r], C2, nl2)); p1[r] = __builtin_amdgcn_exp2f(fmaf(p1[r], C2, nl2)); } \
        float Gs[8], Ls[8]; \
        _Pragma("unroll") for (int q = 0; q < 4; ++q) { Gs[q] = (p0[4 * q] + p0[4 * q + 1]) + (p0[4 * q + 2] + p0[4 * q + 3]); Ls[q] = p0[4 * q + 3]; \
                                              Gs[4 + q] = (p1[4 * q] + p1[4 * q + 1]) + (p1[4 * q + 2] + p1[4 * q + 3]); Ls[4 + q] = p1[4 * q + 3]; } \
          \
        float prevL = carry; \
        _Pragma("unroll") for (int q = 0; q < 8; ++q) { const float other = ({ auto rr_ = __builtin_amdgcn_permlane32_swap(__float_as_uint(Ls[q]), __float_as_uint(Ls[q]), false, false); __uint_as_float(hi ? rr_[0] : rr_[1]); });        \
            const float add = hi ? other : prevL; prevL = other; Gs[q] += add; } \
        carry = prevL;                                            \
        _Pragma("unroll") for (int q = 0; q < 8; ++q) { float v = Gs[q]; v += __builtin_bit_cast(float, __builtin_amdgcn_update_dpp(0, __builtin_bit_cast(int, v), 0xB1, 0xF, 0xF, false)); v += __builtin_bit_cast(float, __builtin_amdgcn_update_dpp(0, __builtin_bit_cast(int, v), 0x4E, 0xF, 0xF, false)); \
            if ((r32 & 3) == 0) imp_row[((cur.j_lo + (t)) << 4) + 2 * q + hi] = v; } \
        if ((t) + 1 < NT) { asm volatile("s_waitcnt vmcnt(0)" ::: "memory"); *(bf16x8*)(K_lds + ((KB) ^ 1) * SHM_K + kws) = S.st_k0; *(bf16x8*)(K_lds + ((KB) ^ 1) * SHM_K + kws + 32 * 256) = S.st_k1; } \
        __syncthreads(); } while (0)
    for (int t = 0; t < NT; t += 2) { IMP_TILE(t, 0); if (t + 1 < NT) IMP_TILE(t + 1, 1); }
#undef IMP_TILE
}

template <class RF>
__device__ __forceinline__ void gate_unit(const Ref& cur, int nvis, char* lds, Seam& S, int (&sel)[3]) {
    const int tid_ = wg_tid((const __attribute__((address_space(3))) int*)(uintptr_t)(unsigned)(uintptr_t)(lds + WIDTAB_OFF));
    const int lane = tid_ & 63, r32 = lane & 31, hi = lane >> 5;
    char* K_lds = lds + 2 * SHM_V;
    prime<RF>(cur, lds, S);
    f32x16 p0, p1;
    qkt<0, false>(p0, p1, K_lds, r32, hi, S.qr, true);
    const float NEG = -__builtin_inff();
#pragma unroll
    for (int r = 0; r < 16; ++r) { const int k = crow(r, hi); if (k >= nvis) p0[r] = NEG; if (k + 32 >= nvis) p1[r] = NEG; }
    float bv[3]; int bk[3];
#pragma unroll
    for (int rd = 0; rd < 3; ++rd) { float best = NEG; int kb = 64;
#pragma unroll
        for (int r = 0; r < 16; ++r) if (p0[r] > best) { best = p0[r]; kb = crow(r, hi); }
#pragma unroll
        for (int r = 0; r < 16; ++r) if (p1[r] > best) { best = p1[r]; kb = 32 + crow(r, hi); }
        bv[rd] = best; bk[rd] = kb;
#pragma unroll
        for (int r = 0; r < 16; ++r) { if (crow(r, hi) == kb) p0[r] = NEG; if (32 + crow(r, hi) == kb) p1[r] = NEG; } }
    float ov[3]; int ok[3];
#pragma unroll
    for (int i = 0; i < 3; ++i) { ov[i] = lane_get(bv[i], lane ^ 32); ok[i] = lane_geti(bk[i], lane ^ 32); }
    int ia = 0, ib = 0;
#pragma unroll
    for (int rd = 0; rd < 3; ++rd) { const float va = ia == 0 ? bv[0] : (ia == 1 ? bv[1] : (ia == 2 ? bv[2] : NEG)), vb = ib == 0 ? ov[0] : (ib == 1 ? ov[1] : (ib == 2 ? ov[2] : NEG));
        const int ka = ia == 0 ? bk[0] : (ia == 1 ? bk[1] : (ia == 2 ? bk[2] : 64)), kb = ib == 0 ? ok[0] : (ib == 1 ? ok[1] : (ib == 2 ? ok[2] : 64));
        const bool ta = va > vb || (va == vb && ka < kb);
        const float v = ta ? va : vb; const int k = ta ? ka : kb; ia += ta ? 1 : 0; ib += ta ? 0 : 1;
        sel[rd] = (v == NEG) ? -1 : k; }
    __syncthreads();
}
#undef ROW
#undef VMW
#undef VMWN
#undef SLOAD_H
#undef SWRITE_HK
#undef SWRITE_HV
#undef SWRITE_H
#undef KSWZ
#undef SBAR
}

struct RFReg {
    static __device__ __forceinline__ int entry(const att::Ref&, int) { return 0; }
    static __device__ __forceinline__ int q_off(const att::Ref&, int row, int) { return row * 1024; }
    static __device__ __forceinline__ int o_off(const att::Ref&, int row, int) { return row * 1024; }
    static __device__ __forceinline__ int l_idx(const att::Ref& u, int row, int) { return u.a0 >= 0 ? u.a0 + row * 8 : -1; }
    static __device__ __forceinline__ int pos(const att::Ref& u, int row, int) { return u.P0 + row; }
    static __device__ __forceinline__ int Wl(const att::Ref& u, int) { return u.W; }
};
__device__ __forceinline__ att::Ref win_ref(int L, const bf16* QN, const bf16* KW, const bf16* VW, bf16* OWIN) {
    const int h = L & 7, qb = L >> 3;
    att::Ref r; r.Q = QN + (size_t)qb * 256 * 1024 + h * 128; r.O = OWIN + (size_t)qb * 256 * 1024 + h * 128; r.K = KW + (h >> 2) * 128; r.V = VW + (h >> 2) * 128; r.kpitch = 256; r.list = nullptr;
    r.P0 = qb * 256; r.W = 512; r.j_lo = (r.P0 >= 511) ? (r.P0 - 511) >> 6 : 0; r.j_hi = ((r.P0 + 255) >> 6) + 1; r.a0 = -1; r.a1 = 0; r.nm_lo = 0; r.nm_hi = 0; return r;
}
__device__ __forceinline__ att::Ref mown_ref(int L, const bf16* QM, const bf16* KM, const bf16* VM, bf16* POWN) {
    const int h = L & 7, n = L >> 3; const size_t o = (size_t)n * 256 * 1024 + h * 128;
    att::Ref r; r.Q = QM + o; r.O = POWN + o; r.K = KM + o; r.V = VM + o; r.kpitch = 1024; r.list = nullptr;
    r.P0 = 0; r.W = 1 << 20; r.j_lo = 0; r.j_hi = 4; r.a0 = n * 256 * 8 + h; r.a1 = 0; r.nm_lo = 0; r.nm_hi = 0; return r;
}
struct RFSel {
    static __device__ __forceinline__ int entry(const att::Ref& u, int row) { return u.list[row < u.a0 ? row : 0]; }
    static __device__ __forceinline__ int q_off(const att::Ref&, int, int e) { return (e >> 2) * 1024; }
    static __device__ __forceinline__ int o_off(const att::Ref& u, int row, int e) { return row < u.a0 ? (((e >> 2) * 8 + u.a1) * 3 + (e & 3)) * 128 : -1; }
    static __device__ __forceinline__ int l_idx(const att::Ref& u, int row, int e) { return row < u.a0 ? ((e >> 2) * 8 + u.a1) * 3 + (e & 3) : -1; }
    static __device__ __forceinline__ int pos(const att::Ref&, int, int) { return 0; }
    static __device__ __forceinline__ int Wl(const att::Ref&, int) { return 0; }
};
__device__ __forceinline__ att::Ref msel_ref(int L, const LAS int* tab, const LAS unsigned short* ulist, const int* MLIST, const bf16* QM, const bf16* KM, const bf16* VM, bf16* PSEL) {
    const int lid = __builtin_amdgcn_readfirstlane((int)ulist[L]), k = L - tab[512 + lid], h = lid >> 6, n = lid & 63;
    att::Ref r; r.Q = QM + h * 128; r.O = PSEL; r.K = KM + (size_t)n * 256 * 1024 + h * 128; r.V = VM + (size_t)n * 256 * 1024 + h * 128; r.kpitch = 1024;
    r.list = MLIST + (size_t)lid * 16384 + k * 256; r.P0 = 0; r.W = 0; r.j_lo = 0; r.j_hi = 4; r.a0 = tab[lid] - k * 256; r.a1 = h; r.nm_lo = 0; r.nm_hi = 0; return r;
}

struct RFSlc {
    static __device__ __forceinline__ int entry(const att::Ref& u, int row) { return u.list[(row >> 2) < u.a0 ? (row >> 2) : 0]; }
    static __device__ __forceinline__ int q_off(const att::Ref&, int row, int e) { return (e >> 4) * 1024 + (row & 3) * 128; }
    static __device__ __forceinline__ int l_idx(const att::Ref& u, int row, int e) { return (row >> 2) < u.a0 ? ((((e >> 4) * 2 + (u.a1 >> 16)) * 16 + (e & 15)) * 4 + (row & 3)) : -1; }
    static __device__ __forceinline__ int o_off(const att::Ref& u, int row, int e) { const int i = l_idx(u, row, e); return i >= 0 ? i * 128 : -1; }
    static __device__ __forceinline__ int pos(const att::Ref& u, int, int e) { return (e >> 4) - 64 * (u.a1 & 0xffff); }
    static __device__ __forceinline__ int Wl(const att::Ref&, int) { return 1 << 30; }
};
__device__ __forceinline__ att::Ref nsel_ref(int L, const LAS int* tab, const LAS unsigned short* ulist, const int* NLIST, const bf16* QN, const bf16* KS, const bf16* VS, bf16* PSLC) {
    const int lid = __builtin_amdgcn_readfirstlane((int)ulist[L]), k = L - tab[512 + lid], g = lid >> 8, j = lid & 255;
    att::Ref r; r.Q = QN + g * 512; r.O = PSLC; r.K = KS + (size_t)j * 64 * 256 + g * 128; r.V = VS + (size_t)j * 64 * 256 + g * 128; r.kpitch = 256;
    r.list = NLIST + (size_t)lid * 16384 + k * 64; r.P0 = 0; r.W = 0; r.j_lo = 0; r.j_hi = 1; r.a0 = tab[lid] - k * 64; r.a1 = j | (g << 16); r.nm_lo = 0; r.nm_hi = (k >= 1) ? 1 : 0; return r;
}

struct RFCmp {
    static __device__ __forceinline__ int entry(const att::Ref&, int) { return 0; }
    static __device__ __forceinline__ int q_off(const att::Ref&, int row, int) { return (row >> 2) * 1024 + (row & 3) * 128; }
    static __device__ __forceinline__ int o_off(const att::Ref&, int row, int) { return (row >> 2) * 1024 + (row & 3) * 128; }
    static __device__ __forceinline__ int l_idx(const att::Ref&, int, int) { return -1; }
    static __device__ __forceinline__ int pos(const att::Ref& u, int row, int) { const int t = u.P0 + (row >> 2); return t >= 31 ? (t - 31) >> 4 : -1; }
    static __device__ __forceinline__ int Wl(const att::Ref&, int) { return 1 << 30; }
};
__device__ __forceinline__ att::Ref cmp_ref(int L, const bf16* QN, const bf16* KCMP, const bf16* VCMP, bf16* OCMP) {
    const int g = L & 1, c = (L < 256) ? (L >> 1) : 255 - ((L - 256) >> 1);
    att::Ref r; r.Q = QN + (size_t)c * 64 * 1024 + g * 512; r.O = OCMP + (size_t)c * 64 * 1024 + g * 512; r.K = KCMP + g * 128; r.V = VCMP + g * 128; r.kpitch = 256; r.list = nullptr;
    r.P0 = c * 64; r.W = 0; r.j_lo = 0; r.j_hi = (4 * c + 3 + 63) >> 6; r.a0 = g; r.a1 = c; r.nm_lo = 0; r.nm_hi = (c >= 1) ? ((((64 * c - 31) >> 4) + 1) >> 6) : 0; return r;
}

struct RFWinG {
    static __device__ __forceinline__ int entry(const att::Ref&, int) { return 0; }
    static __device__ __forceinline__ int q_off(const att::Ref&, int row, int) { return (row >> 2) * 1024 + (row & 3) * 128; }
    static __device__ __forceinline__ int o_off(const att::Ref&, int row, int) { return (row >> 2) * 1024 + (row & 3) * 128; }
    static __device__ __forceinline__ int l_idx(const att::Ref&, int, int) { return -1; }
    static __device__ __forceinline__ int pos(const att::Ref& u, int row, int) { return u.P0 + (row >> 2); }
    static __device__ __forceinline__ int Wl(const att::Ref&, int) { return 512; }
};
__device__ __forceinline__ att::Ref wing_ref(int L, const bf16* QN, const bf16* KW, const bf16* VW, bf16* OWIN) {
    const int g = L & 1, c = L >> 1;
    att::Ref r; r.Q = QN + (size_t)c * 64 * 1024 + g * 512; r.O = OWIN + (size_t)c * 64 * 1024 + g * 512; r.K = KW + g * 128; r.V = VW + g * 128; r.kpitch = 256; r.list = nullptr;
    r.P0 = c * 64; r.W = 512; r.j_lo = (c >= 8) ? c - 8 : 0; r.j_hi = c + 1; r.a0 = -1; r.a1 = 0; r.nm_lo = (c >= 7) ? c - 7 : 0; r.nm_hi = c; return r;
}

struct Args { const float* in[18]; float* out; unsigned char* ws; int ph_lo, ph_hi, li, pad; };
typedef const __attribute__((address_space(4))) Args* ArgsP;
__device__ __forceinline__ ArgsP get_args() { auto p = __builtin_amdgcn_kernarg_segment_ptr(); asm volatile("" : "+s"(p)); return (ArgsP)p; }

__global__ void __launch_bounds__(NTHR, 2) mk_fwd(Args args_unused) {
    extern __shared__ __attribute__((aligned(16))) unsigned char lds_raw[];
    LAS unsigned char* lds = (LAS unsigned char*)lds_raw;
    LAS float* sm = (LAS float*)lds;
    volatile LAS unsigned* MISC = (volatile LAS unsigned*)(lds + MISC_OFF);
    LAS int* moetab = (LAS int*)(lds + MOETAB_OFF);
    const int G = gridDim.x, bid = blockIdx.x, NGW = G * NWAVES;
#define PH_IDS() const int tid_ = wg_tid((const LAS int*)(lds + WIDTAB_OFF)); const int tid = tid_, lane = tid & 63, wave = __builtin_amdgcn_readfirstlane(tid >> 6), gw = bid * NWAVES + wave; (void)lane; (void)gw;
#define AP() get_args()
#define CTLP(ws) ((gu32*)((ws) + WS_CTL))

    for (int u = threadIdx.x; u < (LDS_BYTES - LDSCTL_OFF) / 4; u += NTHR) ((LAS unsigned*)(lds + LDSCTL_OFF))[u] = 0u;
    __syncthreads();
    { unsigned hw; asm volatile("s_getreg_b32 %0, hwreg(HW_REG_HW_ID, 0, 6)" : "=s"(hw)); if ((threadIdx.x & 63) == 0) ((LAS int*)(lds + WIDTAB_OFF))[hw] = (int)(threadIdx.x >> 6); }
    __syncthreads();
    XcdBarrier bar; bar.bar = nullptr; bar.x = 0; bar.st = nullptr;
    if (MK_N_LAUNCHES == 1) bar = xcd_barrier_post((unsigned*)(CTLP(AP()->ws) + CW_BAR), MISC + 8);
#define GRID_BAR() do { if (MK_N_LAUNCHES == 1) { XcdBarrier b_ = bar; b_.bar = (unsigned*)(CTLP(AP()->ws) + CW_BAR); xcd_barrier(b_, wg_tid((const LAS int*)(lds + WIDTAB_OFF)) == 0); } } while (0)
    const int lo = AP()->ph_lo, hi = AP()->ph_hi;
#define IN(k) (lo <= (k) && (k) < hi)
#define BOTH(k) (IN(k) && IN((k) + 1))

    if (IN(0)) {
        PH_IDS(); ArgsP ap = AP(); unsigned char* ws = ap->ws;
        LAS float* scr = (LAS float*)(lds + wave * 16384);
        constexpr int I_IN = 32 * 177, I_OUT = 32 * 64, I_GU = 32 * 16, I_DN = 8 * 64, I_W1 = 32 * 8;
        constexpr int N_IN = 2 * I_IN, N_OUT = 2 * I_OUT, N_G = 64 * I_GU, N_U = 64 * I_GU, N_D = 64 * I_DN, N_W1 = 8 * I_W1;
        constexpr int NITEMS = N_IN + N_OUT + N_G + N_U + N_D + N_W1;
        for (int it = gw; it < NITEMS; it += NGW) {
            int r = it;
            if (r < N_IN) { const int l = r / I_IN; transpose_item<1>(ap->in[6] + (size_t)l * D_ * IN_W, D_, IN_W, (bf16*)(ws + WS_WINT) + (size_t)l * NIN * D_, D_, 0, scr, r % I_IN, lane); continue; } r -= N_IN;
            if (r < N_OUT) { const int l = r / I_OUT; transpose_item<0>(ap->in[7] + (size_t)l * D_ * D_, D_, D_, (bf16*)(ws + WS_WOUTT) + (size_t)l * D_ * D_, D_, 0, scr, r % I_OUT, lane); continue; } r -= N_OUT;
            if (r < N_G) { const int le = r / I_GU; transpose_item<2>(ap->in[14] + (size_t)le * D_ * DEXP, D_, DEXP, (bf16*)(ws + WS_WGUT) + (size_t)le * 1024 * D_, D_, 0, scr, r % I_GU, lane); continue; } r -= N_G;
            if (r < N_U) { const int le = r / I_GU; transpose_item<3>(ap->in[15] + (size_t)le * D_ * DEXP, D_, DEXP, (bf16*)(ws + WS_WGUT) + (size_t)le * 1024 * D_, D_, 0, scr, r % I_GU, lane); continue; } r -= N_U;
            if (r < N_D) { const int le = r / I_DN; transpose_item<0>(ap->in[16] + (size_t)le * DEXP * D_, DEXP, D_, (bf16*)(ws + WS_WDT) + (size_t)le * D_ * DEXP, DEXP, 0, scr, r % I_DN, lane); continue; } r -= N_D;
            { const int m = r / I_W1, lk = m >> 1, half = m & 1;
              transpose_item<0>(ap->in[9] + (size_t)lk * 4096 * 256 + (size_t)half * 2048 * 256, 2048, 256, (bf16*)(ws + WS_WC1T) + (size_t)lk * 512 * 2048, 2048, half * 256, scr, r % I_W1, lane); }
        }
        { const float* w_router = ap->in[12]; bf16* WrT = (bf16*)(ws + WS_WRT);
          for (int idx = bid * NTHR + tid; idx < 32 * 2048; idx += G * NTHR) { const int e = idx >> 11, k = idx & 2047; const float w = w_router[(size_t)k * 32 + e];
            const unsigned hb = f2bf(w); const float rem = w - bf2f(hb); WrT[idx] = (bf16)hb; WrT[32 * 2048 + idx] = (bf16)f2bf(rem); } }
        { f32x2* ROPE = (f32x2*)(ws + WS_ROPE);
          for (int idx = bid * NTHR + tid; idx < S_ * 64; idx += G * NTHR) { const int pos = idx >> 6, i = idx & 63;
            const double inv = exp(-(double)i * (9.210340371976184 / 64.0)); const double ang = (double)pos * inv; double sv, cv; sincos(ang, &sv, &cv);
            ROPE[idx] = (f32x2){(float)cv, (float)sv}; } }
        __syncthreads();
        { float* MOD = (float*)(CTLP(ws) + CW_MOD); const float* c_in = ap->in[1]; const float* w_ada = ap->in[2]; const float* b_ada = ap->in[3];
          for (int k = tid; k < D_; k += NTHR) { const float cv = c_in[k]; sm[k] = cv / (1.f + __expf(-cv)); }
          __syncthreads();
          for (int it = bid; it < 2 * 96; it += G) { const int l = it / 96, cb = it % 96, grp = tid >> 5, col = cb * 128 + (tid & 31) * 4;
            f32x4 a = (f32x4){0.f, 0.f, 0.f, 0.f};
            const float* wp = w_ada + ((size_t)l * D_ + grp) * 12288 + col;
#pragma unroll 8
            for (int i = 0; i < 128; ++i) a += *(const f32x4*)(wp + (size_t)i * 16 * 12288) * sm[grp + 16 * i];
            *(LAS f32x4*)(sm + 4096 + grp * 128 + (tid & 31) * 4) = a;
            __syncthreads();
            if (tid < 128) { float s = b_ada[l * 12288 + cb * 128 + tid];
#pragma unroll
                for (int q = 0; q < 16; ++q) s += sm[4096 + q * 128 + tid];
                MOD[l * 12288 + cb * 128 + tid] = s; }
            __syncthreads(); } }
        { float* B1P = (float*)(CTLP(ws) + CW_B1E); const float* cmp_pe = ap->in[8]; const float* cmp_w1 = ap->in[9];
          for (int it = bid - 192; it >= 0 && it < 32; it += G) { const int lk = it >> 3, ks = it & 7, grp = tid >> 6, n = (tid & 63) * 4;
            f32x4 a = (f32x4){0.f, 0.f, 0.f, 0.f};
            const float* wp = cmp_w1 + ((size_t)lk * 4096 + ks * 512 + grp) * 256 + n; const float* pe = cmp_pe + (size_t)lk * 4096 + ks * 512 + grp;
#pragma unroll 8
            for (int i = 0; i < 64; ++i) a += *(const f32x4*)(wp + (size_t)i * 8 * 256) * pe[i * 8];
            *(LAS f32x4*)(sm + 4096 + grp * 256 + n) = a;
            __syncthreads();
            if (tid < 256) { float s = 0.f;
#pragma unroll
                for (int q = 0; q < 8; ++q) s += sm[4096 + q * 256 + tid];
                B1P[(lk * 8 + ks) * 256 + tid] = s; }
            __syncthreads(); } }
        if (BOTH(0)) GRID_BAR();
    }

    for (int l = 0; l < DEPTH; ++l) {
        const int pb = 1 + NPL * l;
#define LOAD_MOETAB(CNTP, NT_) do { __syncthreads(); if (tid < 32) moetab[tid] = (int)__hip_atomic_load((CNTP) + tid * CSTR, RLX_AGENT); __syncthreads(); \
        if (tid == 0) { int us = 0, ps = 0; for (int e = 0; e < NEXP; ++e) { const int c = moetab[e], tl = (c + 255) >> 8; moetab[32 + e] = us; moetab[65 + e] = ps; us += tl * (NT_); ps += tl << 8; } moetab[64] = us; } \
        __syncthreads(); } while (0)

        if (IN(pb + 0)) {
            PH_IDS(); ArgsP ap = AP(); unsigned char* ws = ap->ws;
            const float* MOD = (const float*)(CTLP(ws) + CW_MOD); const float* mod = MOD + l * 12288;
            float* X = ap->out; bf16* H = (bf16*)(ws + WS_H); const bf16* Y = (const bf16*)(ws + WS_Y); const int* TE = (const int*)(ws + WS_TE);
            if (l > 0) LOAD_MOETAB((unsigned*)(CTLP(ws) + CW_CNT) + (l - 1) * 32 * CSTR, 1);
            { const float* g_attn = ap->in[4];
              for (int k = tid; k < D_; k += NTHR) { sm[k] = g_attn[l * D_ + k] * (1.f + mod[2048 + k]); sm[2048 + k] = mod[k]; sm[4096 + k] = (l > 0) ? MOD[(l - 1) * 12288 + 10240 + k] : 0.f; } }
            __syncthreads();
            const float* x_in = ap->in[0];
            for (int t = gw; t < S_; t += NGW) {
                f32x4 v[8]; float ss = 0.f;
                if (l == 0) {
#pragma unroll
                    for (int j = 0; j < 8; ++j) v[j] = *(const f32x4*)(x_in + (size_t)t * D_ + 256 * j + 4 * lane);
                } else {
                    const int4 te = *(const int4*)(TE + 4 * t);
                    const bf16* y0 = Y + (size_t)(moetab[65 + te.x] + te.y) * D_; const bf16* y1 = Y + (size_t)(moetab[65 + te.z] + te.w) * D_;
#pragma unroll
                    for (int j = 0; j < 8; ++j) { const int k = 256 * j + 4 * lane; const uint2 a = *(const uint2*)(y0 + k), b = *(const uint2*)(y1 + k);
                        const f32x4 gt2 = *(const LAS f32x4*)(sm + 4096 + k);
                        f32x4 ysum = (f32x4){bflo(a.x) + bflo(b.x), bfhi(a.x) + bfhi(b.x), bflo(a.y) + bflo(b.y), bfhi(a.y) + bfhi(b.y)};
                        v[j] = *(const f32x4*)(X + (size_t)t * D_ + k) + gt2 * ysum; *(f32x4*)(X + (size_t)t * D_ + k) = v[j]; }
                }
#pragma unroll
                for (int j = 0; j < 8; ++j) ss += (v[j][0] * v[j][0] + v[j][1] * v[j][1]) + (v[j][2] * v[j][2] + v[j][3] * v[j][3]);
                const float rstd = 1.f / sqrtf(wave_sum(ss, lane) * (1.f / D_) + RMS_EPS);
#pragma unroll
                for (int j = 0; j < 8; ++j) { const int k = 256 * j + 4 * lane; const f32x4 h = v[j] * rstd * *(const LAS f32x4*)(sm + k) + *(const LAS f32x4*)(sm + 2048 + k);
                    *(uint2*)(H + (size_t)t * D_ + k) = make_uint2(pk2(h[0], h[1]), pk2(h[2], h[3])); }
            }
            if (BOTH(pb + 0)) GRID_BAR();
        }
        if (IN(pb + 1)) {
            ArgsP ap = AP(); unsigned char* ws = ap->ws;
            pg8::Gemm g{(const bf16*)(ws + WS_H), (const bf16*)(ws + WS_WINT) + (size_t)l * NIN * D_, S_, NIN, D_}; pg8::StaticOrder So; So.init(S_, NIN, G, bid);
            EpiInProj E{(bf16*)(ws + WS_QN), (bf16*)(ws + WS_KC), (bf16*)(ws + WS_VC), (bf16*)(ws + WS_KS), (bf16*)(ws + WS_VS), (bf16*)(ws + WS_KW), (bf16*)(ws + WS_VW),
                        (bf16*)(ws + WS_QM), (bf16*)(ws + WS_KM), (bf16*)(ws + WS_VM), (float*)(ws + WS_GATES), (const float*)(ws + WS_ROPE)};
            pg8::gemm_phase<EpiInProj, pg8::StaticOrder, true, true>(lds, g, So, E);
            if (BOTH(pb + 1)) GRID_BAR();
        }
        if (IN(pb + 2)) {
            PH_IDS(); ArgsP ap = AP(); unsigned char* ws = ap->ws;
            if (bid < 32) {
                pg8::Gemm g{(const bf16*)(ws + WS_KC), (const bf16*)(ws + WS_WC1T) + (size_t)l * 2 * 512 * 2048, 4096, 512, 2048}; CompressOrder So{G, bid};
                EpiF32 E{(float*)(ws + WS_UL), 512};
                pg8::gemm_phase<EpiF32, CompressOrder, false, true>(lds, g, So, E);
            }
            {
                const bf16* KM = (const bf16*)(ws + WS_KM); bf16* KMEAN = (bf16*)(ws + WS_KMEAN);
                const int nb = (G > 32) ? G - 32 : G, b0 = (G > 32) ? bid - 32 : bid;
                if (b0 >= 0) for (int u = b0; u < 512; u += nb) { const int n = u >> 3, h = u & 7, rg = tid >> 4, c8 = (tid & 15) * 8;
                    float a8[8] = {0.f, 0.f, 0.f, 0.f, 0.f, 0.f, 0.f, 0.f};
#pragma unroll
                    for (int i = 0; i < 8; ++i) { const v4u kv = *(const v4u*)(KM + (size_t)(n * 256 + rg + 32 * i) * 1024 + h * 128 + c8);
                        a8[0] += bflo(kv.x); a8[1] += bfhi(kv.x); a8[2] += bflo(kv.y); a8[3] += bfhi(kv.y); a8[4] += bflo(kv.z); a8[5] += bfhi(kv.z); a8[6] += bflo(kv.w); a8[7] += bfhi(kv.w); }
#pragma unroll
                    for (int i = 0; i < 8; ++i) sm[rg * 128 + c8 + i] = a8[i];
                    __syncthreads();
                    if (tid < 128) { float s = 0.f;
#pragma unroll 8
                        for (int q = 0; q < 32; ++q) s += sm[q * 128 + tid];
                        KMEAN[(size_t)(h * 64 + n) * 128 + tid] = (bf16)f2bf(s * (1.f / 256.f)); }
                    __syncthreads(); }
            }
            {
                const bf16* QN = (const bf16*)(ws + WS_QN); const bf16* KW = (const bf16*)(ws + WS_KW); const bf16* VW = (const bf16*)(ws + WS_VW); bf16* OWIN = (bf16*)(ws + WS_OWIN);
                const bf16* QM = (const bf16*)(ws + WS_QM); const bf16* KM2 = (const bf16*)(ws + WS_KM); const bf16* VM = (const bf16*)(ws + WS_VM); bf16* POWN = (bf16*)(ws + WS_POWN); float* LSEO = (float*)(ws + WS_LSEO);
                int bidl = bid; asm volatile("" : "+s"(bidl));
                const int nbw = (G > 32) ? G - 32 : G, bw = (G > 32) ? bidl - 32 : bidl;
                __syncthreads();
                att::Seam S;
                if (bw >= 0) {
                    { int L = bw;
                      if (L < 512) { att::Ref cur = wing_ref(L, QN, KW, VW, OWIN); att::prime<RFWinG>(cur, (char*)lds_raw, S);
                        for (;;) { const int Ln = L + nbw; const bool more = Ln < 512; const att::Ref nxt = more ? wing_ref(Ln, QN, KW, VW, OWIN) : cur;
                            att::block<2, false, RFWinG>(cur, nxt, nullptr, (char*)lds_raw, S);
                            if (!more) break; cur = nxt; L = Ln; } } }
                    __syncthreads();
                    {
                        const int heavy = 512 - 2 * nbw;
                        int f, n;
                        if (heavy >= 0 && heavy <= nbw && 3 * (nbw - heavy) <= 512 && 512 - 3 * (nbw - heavy) <= heavy) { if (bw >= heavy) { f = 3 * (bw - heavy); n = 3; } else { f = 3 * (nbw - heavy) + bw; n = (f < 512) ? 1 : 0; } }
                        else { f = bw; n = -1; }
                        if (n != 0 && f < 512) { int L = f, k = 1; att::Ref cur = mown_ref(L, QM, KM2, VM, POWN); att::prime<RFReg>(cur, (char*)lds_raw, S);
                            for (;;) { const int Ln = (n < 0) ? L + nbw : L + 1; const bool more = (n < 0) ? (Ln < 512) : (k < n && Ln < 512); const att::Ref nxt = more ? mown_ref(Ln, QM, KM2, VM, POWN) : cur;
                                att::block<0, true, RFReg>(cur, nxt, LSEO, (char*)lds_raw, S);
                                if (!more) break; cur = nxt; L = Ln; ++k; } } }
                }
                __syncthreads();
            }
            if (BOTH(pb + 2)) GRID_BAR();
        }
        if (IN(pb + 3)) {
            PH_IDS(); ArgsP ap = AP(); unsigned char* ws = ap->ws;
            const float* UL = (const float*)(ws + WS_UL); const float* B1P = (const float*)(CTLP(ws) + CW_B1E); const float* cmp_b1 = ap->in[10]; const f32x2* ROPE = (const f32x2*)(ws + WS_ROPE);
            bf16* KCMP = (bf16*)(ws + WS_KCMP); bf16* VCMP = (bf16*)(ws + WS_VCMP); const float* cmp_w2 = ap->in[11];
            { const int kv = bid & 1; const float* w2 = cmp_w2 + (size_t)(l * 2 + kv) * 256 * 128; LAS float* be = (LAS float*)(lds + 135168 + 8192);
              if (tid < 256) { float s = cmp_b1[(l * 2 + kv) * 256 + tid];
#pragma unroll
                  for (int q = 0; q < 8; ++q) s += B1P[((l * 2 + kv) * 8 + q) * 256 + tid];
                  be[tid] = s; }
              for (int i = tid; i < 256 * 128 / 4; i += NTHR) *(LAS f32x4*)(sm + 4 * i) = *(const f32x4*)(w2 + 4 * i);
              LAS float* hid = (LAS float*)(lds + 135168) + wave * 256;
              __syncthreads();
              const int nb2 = (G + 1 - kv) >> 1;
              for (int r = (bid >> 1) * NWAVES + wave; r < NC * 2; r += nb2 * NWAVES) { const int c = r >> 1, g = r & 1;
                const float* Ur = UL + ((size_t)kv * 2048 + g * 1024 + c) * 512; const float* Lr = UL + ((size_t)kv * 2048 + g * 1024 + c + 1) * 512 + 256;
#pragma unroll
                for (int j = 0; j < 4; ++j) { const int n = lane + 64 * j; const float v = Ur[n] + Lr[n] + be[n];
                    hid[n] = 0.5f * v * (1.f + tanhf(0.7978845608028654f * (v + 0.044715f * v * v * v))); }
                LDS_WAIT(); asm volatile("" ::: "memory");
                float o0 = 0.f, o1 = 0.f;
#pragma unroll 8
                for (int n = 0; n < 256; ++n) { const float hv = hid[n]; o0 += hv * sm[n * 128 + lane]; o1 += hv * sm[n * 128 + 64 + lane]; }
                if (kv == 0) { const f32x2 cs = ROPE[(size_t)(16 * c + 31) * 64 + lane];
                    const float a = o0 * cs[0] - o1 * cs[1], b = o1 * cs[0] + o0 * cs[1];
                    *(unsigned*)(KCMP + ((size_t)c * 2 + g) * 128 + 2 * lane) = pk2(a, b);
                } else { VCMP[((size_t)c * 2 + g) * 128 + lane] = (bf16)f2bf(o0); VCMP[((size_t)c * 2 + g) * 128 + 64 + lane] = (bf16)f2bf(o1); }
                LDS_WAIT(); asm volatile("" ::: "memory");
              }
              __syncthreads(); }
            if (BOTH(pb + 3)) GRID_BAR();
        }
        if (IN(pb + 4)) {
            {   ArgsP ap = AP(); unsigned char* ws = ap->ws;
                const bf16* QN = (const bf16*)(ws + WS_QN); const bf16* KCMP = (const bf16*)(ws + WS_KCMP); const bf16* VCMP = (const bf16*)(ws + WS_VCMP);
                bf16* OCMP = (bf16*)(ws + WS_OCMP); float* IMP = (float*)(ws + WS_IMP);
                att::Seam S;
                for (int L = bid; L < 512; L += G) { const att::Ref cur = cmp_ref(L, QN, KCMP, VCMP, OCMP); float lse;
                    att::prime<RFCmp>(cur, (char*)lds_raw, S);
                    att::block<2, false, RFCmp>(cur, cur, nullptr, (char*)lds_raw, S, &lse);
                    att::imp_sweep<RFCmp>(cur, lse, IMP + ((size_t)cur.a1 * 64 * 2 + cur.a0) * 256, (char*)lds_raw, S); }
            }
            {   PH_IDS(); ArgsP ap = AP(); unsigned char* ws = ap->ws;
                const bf16* QM = (const bf16*)(ws + WS_QM); const bf16* KMEAN = (const bf16*)(ws + WS_KMEAN);
                unsigned* MCNT = (unsigned*)(CTLP(ws) + CW_MCNT) + l * 512 * CSTR; int* MLIST = (int*)(ws + WS_MLIST); float* LSES = (float*)(ws + WS_LSES);
                __syncthreads();
                att::Seam S;
                for (int L = bid; L < 512; L += G) { const int h = L & 7, nq = L >> 3;
                    att::Ref cur; cur.Q = QM + (size_t)nq * 256 * 1024 + h * 128; cur.O = nullptr; cur.K = KMEAN + (size_t)h * 64 * 128; cur.V = cur.K; cur.kpitch = 128; cur.list = nullptr;
                    cur.P0 = 0; cur.W = 0; cur.j_lo = 0; cur.j_hi = 1; cur.a0 = -1; cur.a1 = 0; cur.nm_lo = 0; cur.nm_hi = 0;
                    int sel[3]; att::gate_unit<RFReg>(cur, nq, (char*)lds_raw, S, sel);
                    if (lane < 32) { const int t = nq * 256 + wave * 32 + lane;
#pragma unroll
                        for (int s = 0; s < 3; ++s) {
                            if (sel[s] >= 0) { const unsigned p = atomicAdd(MCNT + (h * 64 + sel[s]) * CSTR, 1u); MLIST[(size_t)(h * 64 + sel[s]) * 16384 + p] = t * 4 + s; }
                            else LSES[(t * 8 + h) * 3 + s] = -INFINITY; } }
                }
            }
            if (BOTH(pb + 4)) GRID_BAR();
        }
        if (IN(pb + 5)) {
            PH_IDS(); ArgsP ap = AP(); unsigned char* ws = ap->ws;
            {   PH_IDS(); ArgsP ap = AP(); unsigned char* ws = ap->ws;
                const float* IMP = (const float*)(ws + WS_IMP); int* SEL = (int*)(ws + WS_SEL);
                unsigned* NCNT = (unsigned*)(CTLP(ws) + CW_NCNT) + l * 512 * CSTR; int* NLIST = (int*)(ws + WS_NLIST);
                const int lam = lane & 15, rho = lane >> 4;
                for (int ub = gw * 4; ub < S_ * 2; ub += NGW * 4) { const int u = ub + rho, t = u >> 1, g = u & 1, tb = t >> 6;
                    float v[16];
#pragma unroll
                    for (int i = 0; i < 16; ++i) { const int j = lam + 16 * i; const float im = IMP[(size_t)u * 256 + j]; const bool forced = (j == 0) || (j == tb) || (j == tb - 1);
                        v[i] = (j > tb) ? -INFINITY : (forced ? 1e9f : im); }
                    int mysel = -1;
                    for (int r = 0; r < 16; ++r) { const int pick = row_pick<16>(v, lam); if (lam == r) mysel = pick; if (__all(pick < 0)) break; }
                    SEL[(size_t)u * 16 + lam] = mysel;
                    if (mysel >= 0) {
                        unsigned p;
                        if (mysel == 0) p = (unsigned)t; else if (mysel == tb) p = (unsigned)(t & 63); else if (mysel == tb - 1) p = 64u + (unsigned)(t & 63);
                        else p = 128u + atomicAdd(NCNT + (g * 256 + mysel) * CSTR, 1u);
                        NLIST[(size_t)(g * 256 + mysel) * 16384 + p] = t * 16 + lam; }
                }
            }
            {   PH_IDS(); ArgsP ap = AP(); unsigned char* ws = ap->ws;
                const bf16* QM = (const bf16*)(ws + WS_QM); const bf16* KM = (const bf16*)(ws + WS_KM); const bf16* VM = (const bf16*)(ws + WS_VM);
                bf16* POWN = (bf16*)(ws + WS_POWN); bf16* PSEL = (bf16*)(ws + WS_PSEL); float* LSEO = (float*)(ws + WS_LSEO); float* LSES = (float*)(ws + WS_LSES);
                const int* MLIST = (const int*)(ws + WS_MLIST); unsigned* MCNT = (unsigned*)(CTLP(ws) + CW_MCNT) + l * 512 * CSTR;
                LAS int* mtab = (LAS int*)(lds + att::LDS_BYTES);
                __syncthreads();
                mtab[tid] = (int)__hip_atomic_load(MCNT + tid * CSTR, RLX_AGENT);
                __syncthreads();
                LAS unsigned short* ulist = (LAS unsigned short*)(lds + 108544);
                { int tot; const int nu = (mtab[tid] + 255) >> 8; const int ex = block_excl_scan(nu, mtab + 1040, tid, &tot); mtab[512 + tid] = ex; if (tid == 0) mtab[1024] = tot;
                  for (int u = 0; u < nu; ++u) ulist[ex + u] = (unsigned short)tid; }
                __syncthreads();
                const int nsel = mtab[1024];
                att::Seam S;
                { int L = bid;
                  if (L < nsel) { att::Ref cur = msel_ref(L, mtab, ulist, MLIST, QM, KM, VM, PSEL); att::prime<RFSel>(cur, (char*)lds_raw, S);
                    for (;;) { const bool more = L + G < nsel; const att::Ref nxt = more ? msel_ref(L + G, mtab, ulist, MLIST, QM, KM, VM, PSEL) : cur;
                        att::block<1, false, RFSel>(cur, nxt, LSES, (char*)lds_raw, S);
                        if (!more) break; cur = nxt; L += G; } } }
                __syncthreads();
            }
            if (BOTH(pb + 5)) GRID_BAR();
        }
        if (IN(pb + 6)) {
            PH_IDS(); ArgsP ap = AP(); unsigned char* ws = ap->ws;
            const bf16* POWN = (const bf16*)(ws + WS_POWN); const bf16* PSEL = (const bf16*)(ws + WS_PSEL); const float* LSEO = (const float*)(ws + WS_LSEO); const float* LSES = (const float*)(ws + WS_LSES);
            bf16* OMIX = (bf16*)(ws + WS_OMIX);
            for (int t = gw; t < S_; t += NGW) {
                const int hh = (lane >> 2) & 7, ii = lane & 3;
                const float lv = (ii == 0) ? LSEO[t * 8 + hh] : LSES[(t * 8 + hh) * 3 + ii - 1];
                float m = fmaxf(lv, lane_get(lv, lane ^ 1)); m = fmaxf(m, lane_get(m, lane ^ 2));
                float w = __expf(lv - m); float sw = w + lane_get(w, lane ^ 1); sw += lane_get(sw, lane ^ 2); w = w / sw;
#pragma unroll
                for (int hp = 0; hp < 2; ++hp) { const int h = hp * 4 + (lane >> 4), c8 = (lane & 15) * 8;
                    const float w0 = lane_get(w, h * 4), w1 = lane_get(w, h * 4 + 1), w2 = lane_get(w, h * 4 + 2), w3 = lane_get(w, h * 4 + 3);
                    const bf16* ps = PSEL + (size_t)((t * 8 + h) * 3) * 128 + c8;
                    const v4u a0 = *(const v4u*)(POWN + (size_t)t * 1024 + h * 128 + c8);
                    v4u a1 = (v4u){0u, 0u, 0u, 0u}, a2 = a1, a3 = a1;
                    if (w1 > 0.f) a1 = *(const v4u*)(ps); if (w2 > 0.f) a2 = *(const v4u*)(ps + 128); if (w3 > 0.f) a3 = *(const v4u*)(ps + 256);
                    v4u ov;
                    ov.x = pk2(w0 * bflo(a0.x) + w1 * bflo(a1.x) + w2 * bflo(a2.x) + w3 * bflo(a3.x), w0 * bfhi(a0.x) + w1 * bfhi(a1.x) + w2 * bfhi(a2.x) + w3 * bfhi(a3.x));
                    ov.y = pk2(w0 * bflo(a0.y) + w1 * bflo(a1.y) + w2 * bflo(a2.y) + w3 * bflo(a3.y), w0 * bfhi(a0.y) + w1 * bfhi(a1.y) + w2 * bfhi(a2.y) + w3 * bfhi(a3.y));
                    ov.z = pk2(w0 * bflo(a0.z) + w1 * bflo(a1.z) + w2 * bflo(a2.z) + w3 * bflo(a3.z), w0 * bfhi(a0.z) + w1 * bfhi(a1.z) + w2 * bfhi(a2.z) + w3 * bfhi(a3.z));
                    ov.w = pk2(w0 * bflo(a0.w) + w1 * bflo(a1.w) + w2 * bflo(a2.w) + w3 * bflo(a3.w), w0 * bfhi(a0.w) + w1 * bfhi(a1.w) + w2 * bfhi(a2.w) + w3 * bfhi(a3.w));
                    *(v4u*)(OMIX + (size_t)t * 2048 + 1024 + h * 128 + c8) = ov; }
            }
            if (BOTH(pb + 6)) GRID_BAR();

        }
        if (IN(pb + 7)) {
            PH_IDS(); ArgsP ap = AP(); unsigned char* ws = ap->ws;
            const bf16* QN = (const bf16*)(ws + WS_QN); const bf16* KS = (const bf16*)(ws + WS_KS); const bf16* VS = (const bf16*)(ws + WS_VS);
            bf16* PSLC = (bf16*)(ws + WS_PSLC); float* LSEN = (float*)(ws + WS_LSEN); const int* NLIST = (const int*)(ws + WS_NLIST); unsigned* NCNT = (unsigned*)(CTLP(ws) + CW_NCNT) + l * 512 * CSTR;
            LAS int* ntab = (LAS int*)(lds + att::LDS_BYTES);
            __syncthreads();
            { const int j = tid & 255; ntab[tid] = (j == 0) ? S_ : (int)__hip_atomic_load(NCNT + tid * CSTR, RLX_AGENT) + 64 + (j < 255 ? 64 : 0); }
            __syncthreads();
            LAS unsigned short* ulist = (LAS unsigned short*)(lds + 108544);
            { int tot; const int nu = (ntab[tid] + 63) >> 6; const int ex = block_excl_scan(nu, ntab + 1040, tid, &tot); ntab[512 + tid] = ex; if (tid == 0) ntab[1024] = tot;
              for (int u = 0; u < nu; ++u) ulist[ex + u] = (unsigned short)tid; }
            __syncthreads();
            const int nun = ntab[1024];
            att::Seam S; int L = bid;
            if (L < nun) { att::Ref cur = nsel_ref(L, ntab, ulist, NLIST, QN, KS, VS, PSLC); att::prime<RFSlc>(cur, (char*)lds_raw, S);
                for (;;) { const bool more = L + G < nun; const att::Ref nxt = more ? nsel_ref(L + G, ntab, ulist, NLIST, QN, KS, VS, PSLC) : cur;
                    att::block<2, false, RFSlc, true, true>(cur, nxt, LSEN, (char*)lds_raw, S);
                    if (!more) break; cur = nxt; L += G; } }
            __syncthreads();
            if (BOTH(pb + 7)) GRID_BAR();
        }
        if (IN(pb + 8)) {
            PH_IDS(); ArgsP ap = AP(); unsigned char* ws = ap->ws;
            const unsigned char* PSLC = (const unsigned char*)(ws + WS_PSLC); const float* LSEN = (const float*)(ws + WS_LSEN); const int* SEL = (const int*)(ws + WS_SEL); const float* GATES = (const float*)(ws + WS_GATES);
            const bf16* OCMP = (const bf16*)(ws + WS_OCMP); const bf16* OWIN = (const bf16*)(ws + WS_OWIN); bf16* OMIX = (bf16*)(ws + WS_OMIX);
            for (int u = gw; u < S_ * 2; u += NGW) { const int t = u >> 1, g = u & 1;
                const int sv = (lane < 16) ? SEL[(size_t)u * 16 + lane] : -1;
                const int nsel = __popcll(__ballot(sv >= 0));
                const float lv = ((lane >> 2) < nsel) ? LSEN[(size_t)u * 64 + lane] : -INFINITY;
                float m = lv;
#pragma unroll
                for (int o = 4; o < 64; o <<= 1) m = fmaxf(m, lane_get(m, lane ^ o));
                float w = __expf(lv - m), sw = w;
#pragma unroll
                for (int o = 4; o < 64; o <<= 1) sw += lane_get(sw, lane ^ o);
                w = w / sw * 0.0625f;
                const int r = lane >> 4, c8 = (lane & 15) * 8;
                float o8[8] = {0.f, 0.f, 0.f, 0.f, 0.f, 0.f, 0.f, 0.f};
                uint2 pv[16];
#pragma unroll
                for (int s = 0; s < 16; ++s) { const int sc = s < nsel ? s : nsel - 1; pv[s] = *(const uint2*)(PSLC + ((size_t)(u * 16 + sc) * 4 + r) * 128 + c8); }
#pragma unroll
                for (int s = 0; s < 16; ++s) { const float ws_ = lane_get(w, s * 4 + r);
                    o8[0] += ws_ * __builtin_amdgcn_cvt_f32_fp8((int)pv[s].x, 0); o8[1] += ws_ * __builtin_amdgcn_cvt_f32_fp8((int)pv[s].x, 1); o8[2] += ws_ * __builtin_amdgcn_cvt_f32_fp8((int)pv[s].x, 2); o8[3] += ws_ * __builtin_amdgcn_cvt_f32_fp8((int)pv[s].x, 3);
                    o8[4] += ws_ * __builtin_amdgcn_cvt_f32_fp8((int)pv[s].y, 0); o8[5] += ws_ * __builtin_amdgcn_cvt_f32_fp8((int)pv[s].y, 1); o8[6] += ws_ * __builtin_amdgcn_cvt_f32_fp8((int)pv[s].y, 2); o8[7] += ws_ * __builtin_amdgcn_cvt_f32_fp8((int)pv[s].y, 3); }
                const int hd = g * 4 + r; const float g0 = GATES[(size_t)t * 32 + hd * 3], g1 = GATES[(size_t)t * 32 + hd * 3 + 1], g2 = GATES[(size_t)t * 32 + hd * 3 + 2];
                const size_t oi = (size_t)t * 1024 + hd * 128 + c8;
                const v4u cv = *(const v4u*)(OCMP + oi), wv = *(const v4u*)(OWIN + oi);
                v4u ov;
                ov.x = pk2(g1 * o8[0] + g0 * bflo(cv.x) + g2 * bflo(wv.x), g1 * o8[1] + g0 * bfhi(cv.x) + g2 * bfhi(wv.x));
                ov.y = pk2(g1 * o8[2] + g0 * bflo(cv.y) + g2 * bflo(wv.y), g1 * o8[3] + g0 * bfhi(cv.y) + g2 * bfhi(wv.y));
                ov.z = pk2(g1 * o8[4] + g0 * bflo(cv.z) + g2 * bflo(wv.z), g1 * o8[5] + g0 * bfhi(cv.z) + g2 * bfhi(wv.z));
                ov.w = pk2(g1 * o8[6] + g0 * bflo(cv.w) + g2 * bflo(wv.w), g1 * o8[7] + g0 * bfhi(cv.w) + g2 * bfhi(wv.w));
                *(v4u*)(OMIX + (size_t)t * 2048 + hd * 128 + c8) = ov;
            }
            if (BOTH(pb + 8)) GRID_BAR();
        }
        if (IN(pb + 9)) {
            ArgsP ap = AP(); unsigned char* ws = ap->ws;
            pg8::Gemm g{(const bf16*)(ws + WS_OMIX), (const bf16*)(ws + WS_WOUTT) + (size_t)l * D_ * D_, S_, D_, D_}; pg8::StaticOrder So; So.init(S_, D_, G, bid);
            EpiOutProj E{l == 0 ? ap->in[0] : (const float*)ap->out, ap->out, (const float*)(CTLP(ws) + CW_MOD) + l * 12288 + 4096};
            pg8::gemm_phase<EpiOutProj, pg8::StaticOrder, true, true>(lds, g, So, E);
            if (BOTH(pb + 9)) GRID_BAR();
        }
        if (IN(pb + 10)) {
            PH_IDS(); ArgsP ap = AP(); unsigned char* ws = ap->ws;
            const float* mod = (const float*)(CTLP(ws) + CW_MOD) + l * 12288;
            const float* X = ap->out; bf16* H = (bf16*)(ws + WS_H); const bf16* WrT = (const bf16*)(ws + WS_WRT); const float* b_router = ap->in[13];
            unsigned* CNT = (unsigned*)(CTLP(ws) + CW_CNT) + l * 32 * CSTR; int* TE = (int*)(ws + WS_TE); int* TOKIDX = (int*)(ws + WS_TOKIDX); float* WTS = (float*)(ws + WS_WTS);
            { const float* g_ffn = ap->in[5];
              for (int k = tid; k < D_; k += NTHR) { sm[k] = g_ffn[l * D_ + k] * (1.f + mod[8192 + k]); sm[2048 + k] = mod[6144 + k]; }
              if (tid < 32) sm[4160 + tid] = b_router[tid]; }
            typedef short bf16x8_t __attribute__((ext_vector_type(8))); typedef float f32x16_t __attribute__((ext_vector_type(16)));
            for (int bt = bid; bt < S_ / 64; bt += G) { const int t0 = bt * 64;
                __syncthreads();
                for (int rr = 0; rr < 8; rr += 2) { const int row = wave * 8 + rr; float ss0 = 0.f, ss1 = 0.f; f32x4 va[8], vb[8];
#pragma unroll
                    for (int j = 0; j < 8; ++j) { va[j] = *(const f32x4*)(X + (size_t)(t0 + row) * D_ + 256 * j + 4 * lane); vb[j] = *(const f32x4*)(X + (size_t)(t0 + row + 1) * D_ + 256 * j + 4 * lane); }
#pragma unroll
                    for (int j = 0; j < 8; ++j) { ss0 += (va[j][0] * va[j][0] + va[j][1] * va[j][1]) + (va[j][2] * va[j][2] + va[j][3] * va[j][3]); ss1 += (vb[j][0] * vb[j][0] + vb[j][1] * vb[j][1]) + (vb[j][2] * vb[j][2] + vb[j][3] * vb[j][3]); }
                    ss0 = wave_sum(ss0, lane); ss1 = wave_sum(ss1, lane);
                    if (lane == 0) { sm[4096 + row] = 1.f / sqrtf(ss0 * (1.f / D_) + RMS_EPS); sm[4096 + row + 1] = 1.f / sqrtf(ss1 * (1.f / D_) + RMS_EPS); } }
                __syncthreads();
                { const int r = lane & 31, kh = lane >> 5, rsub = lane >> 3, c4 = (lane & 7) * 4; f32x16_t acc0 = {}, acc1 = {};
                  LAS unsigned char* thi = lds + 20480 + wave * 10240; LAS unsigned char* tlo = thi + 5120;
                  const float* xb = X + (size_t)t0 * D_ + wave * 256 + c4;
                  f32x4 xc[8]; typedef unsigned v2u_t __attribute__((ext_vector_type(2)));
#pragma unroll
                  for (int i = 0; i < 8; ++i) xc[i] = *(const f32x4*)(xb + (size_t)(8 * i + rsub) * D_);
#pragma unroll 1
                  for (int ch = 0; ch < 8; ++ch) { const int k0 = wave * 256 + ch * 32;
                    const f32x4 gA = *(const LAS f32x4*)(sm + k0 + c4), sA = *(const LAS f32x4*)(sm + 2048 + k0 + c4);
#pragma unroll
                    for (int i = 0; i < 8; ++i) { const int row = 8 * i + rsub; const float rs = sm[4096 + row];
                        const f32x4 h = xc[i] * rs * gA + sA;
                        const unsigned h0 = pk2(h[0], h[1]), h1 = pk2(h[2], h[3]);
                        *(uint2*)(H + (size_t)(t0 + row) * D_ + k0 + c4) = make_uint2(h0, h1);
                        const unsigned l0 = pk2(h[0] - bflo(h0), h[1] - bfhi(h0)), l1 = pk2(h[2] - bflo(h1), h[3] - bfhi(h1));
                        *(LAS v2u_t*)(thi + row * 80 + c4 * 2) = (v2u_t){h0, h1}; *(LAS v2u_t*)(tlo + row * 80 + c4 * 2) = (v2u_t){l0, l1}; }
                    if (ch + 1 < 8) {
#pragma unroll
                        for (int i = 0; i < 8; ++i) xc[i] = *(const f32x4*)(xb + (size_t)(8 * i + rsub) * D_ + (ch + 1) * 32); }
                    LDS_WAIT(); asm volatile("" ::: "memory");
#pragma unroll
                    for (int ks2 = 0; ks2 < 2; ++ks2) { const int k = k0 + ks2 * 16 + kh * 8;
                        const bf16x8_t wh = *(const bf16x8_t*)(WrT + (size_t)r * 2048 + k), wl = *(const bf16x8_t*)(WrT + 32 * 2048 + (size_t)r * 2048 + k);
                        const bf16x8_t ah0 = *(const LAS bf16x8_t*)(thi + r * 80 + (ks2 * 16 + kh * 8) * 2), al0 = *(const LAS bf16x8_t*)(tlo + r * 80 + (ks2 * 16 + kh * 8) * 2);
                        const bf16x8_t ah1 = *(const LAS bf16x8_t*)(thi + (32 + r) * 80 + (ks2 * 16 + kh * 8) * 2), al1 = *(const LAS bf16x8_t*)(tlo + (32 + r) * 80 + (ks2 * 16 + kh * 8) * 2);
                        acc0 = __builtin_amdgcn_mfma_f32_32x32x16_bf16(wh, ah0, acc0, 0, 0, 0); acc0 = __builtin_amdgcn_mfma_f32_32x32x16_bf16(wl, ah0, acc0, 0, 0, 0); acc0 = __builtin_amdgcn_mfma_f32_32x32x16_bf16(wh, al0, acc0, 0, 0, 0);
                        acc1 = __builtin_amdgcn_mfma_f32_32x32x16_bf16(wh, ah1, acc1, 0, 0, 0); acc1 = __builtin_amdgcn_mfma_f32_32x32x16_bf16(wl, ah1, acc1, 0, 0, 0); acc1 = __builtin_amdgcn_mfma_f32_32x32x16_bf16(wh, al1, acc1, 0, 0, 0); }
                    LDS_WAIT(); asm volatile("" ::: "memory"); }
                  __syncthreads();
#pragma unroll
                  for (int q = 0; q < 16; ++q) { const int e = (q & 3) + 8 * (q >> 2) + 4 * kh;
                      sm[5120 + ((wave * 2 + 0) * 32 + e) * 32 + r] = acc0[q]; sm[5120 + ((wave * 2 + 1) * 32 + e) * 32 + r] = acc1[q]; } }
                __syncthreads();
                { const int tk6 = tid & 63, eq = tid >> 6, rg = tk6 >> 5, tk = tk6 & 31;
#pragma unroll
                  for (int i = 0; i < 4; ++i) { const int e = eq * 4 + i; float s = 0.f;
#pragma unroll
                      for (int w = 0; w < 8; ++w) s += sm[5120 + ((w * 2 + rg) * 32 + e) * 32 + tk];
                      sm[5120 + 16384 + tk6 * 33 + e] = 1.f / (1.f + __expf(-s)); } }
                __syncthreads();
                if (tid < 64) { const int t = t0 + tid;
                    float lg[32];
#pragma unroll
                    for (int e = 0; e < 32; ++e) lg[e] = sm[5120 + 16384 + tid * 33 + e];
                    int grp = 0; float best = -INFINITY;
#pragma unroll
                    for (int gq = 0; gq < 4; ++gq) { float m1 = -INFINITY, m2 = -INFINITY;
#pragma unroll
                        for (int i = 0; i < 8; ++i) { const float b = lg[gq * 8 + i] + sm[4160 + gq * 8 + i]; if (b > m1) { m2 = m1; m1 = b; } else if (b > m2) m2 = b; }
                        const float sgs = m1 + m2; if (sgs > best) { best = sgs; grp = gq; } }
                    float m1 = -INFINITY, m2 = -INFINITY, s1 = 0.f, s2 = 0.f; int i1 = 0, i2 = 0;
#pragma unroll
                    for (int e = 0; e < 32; ++e) { const bool ing = (e >> 3) == grp; const float b = lg[e] + sm[4160 + e];
                        if (ing && b > m1) { m2 = m1; i2 = i1; s2 = s1; m1 = b; i1 = e; s1 = lg[e]; } else if (ing && b > m2) { m2 = b; i2 = e; s2 = lg[e]; } }
                    const float inv = 1.f / (s1 + s2);
                    const unsigned p1 = atomicAdd(CNT + i1 * CSTR, 1u), p2 = atomicAdd(CNT + i2 * CSTR, 1u);
                    TOKIDX[(size_t)i1 * ECAP + p1] = t; TOKIDX[(size_t)i2 * ECAP + p2] = t; WTS[(size_t)i1 * ECAP + p1] = s1 * inv; WTS[(size_t)i2 * ECAP + p2] = s2 * inv;
                    *(int4*)(TE + 4 * t) = make_int4(i1, (int)p1, i2, (int)p2);
                }
            }
            if (BOTH(pb + 10)) GRID_BAR();
        }
        if (IN(pb + 11)) {
            PH_IDS(); ArgsP ap = AP(); unsigned char* ws = ap->ws;
            LOAD_MOETAB((unsigned*)(CTLP(ws) + CW_CNT) + l * 32 * CSTR, 4);
            pg8::Gemm g{(const bf16*)(ws + WS_H), (const bf16*)(ws + WS_WGUT), 0, 0, D_}; MoeOrder<true> So{moetab, 4, G, bid, 4, l * 32 * 4, (const int*)(ws + WS_TOKIDX)};
            EpiGateUp E{(bf16*)(ws + WS_HACT)};
            pg8::gemm_phase<EpiGateUp, MoeOrder<true>, true, true>(lds, g, So, E);
            if (BOTH(pb + 11)) GRID_BAR();
        }
        if (IN(pb + 12)) {
            PH_IDS(); ArgsP ap = AP(); unsigned char* ws = ap->ws;
            LOAD_MOETAB((unsigned*)(CTLP(ws) + CW_CNT) + l * 32 * CSTR, 8);
            pg8::Gemm g{(const bf16*)(ws + WS_HACT), (const bf16*)(ws + WS_WDT), 0, 0, DEXP}; MoeOrder<false> So{moetab, 8, G, bid, 8, l * 32 * 8, nullptr};
            EpiDown E{(bf16*)(ws + WS_Y), (const float*)(ws + WS_WTS), moetab};
            pg8::gemm_phase<EpiDown, MoeOrder<false>, true, true>(lds, g, So, E);
            if (BOTH(pb + 12)) GRID_BAR();
        }
    }
    if (IN(NPH - 1)) {
        PH_IDS(); ArgsP ap = AP(); unsigned char* ws = ap->ws;
        float* X = ap->out; const bf16* Y = (const bf16*)(ws + WS_Y); const int* TE = (const int*)(ws + WS_TE);
        LOAD_MOETAB((unsigned*)(CTLP(ws) + CW_CNT) + 32 * CSTR, 1);
        const bool tmo_set = (MK_N_LAUNCHES == 1) && (__hip_atomic_load((unsigned*)(CTLP(ws) + CW_BAR) + XB_TMO, RLX_AGENT) != 0u);
        { const float* g_final = ap->in[17]; const float* MOD = (const float*)(CTLP(ws) + CW_MOD);
          for (int k = tid; k < D_; k += NTHR) { sm[k] = g_final[k]; sm[2048 + k] = MOD[12288 + 10240 + k]; } }
        __syncthreads();
        for (int t = gw; t < S_; t += NGW) {
            f32x4 v[8]; float ss = 0.f;
            const int4 te = *(const int4*)(TE + 4 * t);
            const bf16* y0 = Y + (size_t)(moetab[65 + te.x] + te.y) * D_; const bf16* y1 = Y + (size_t)(moetab[65 + te.z] + te.w) * D_;
#pragma unroll
            for (int j = 0; j < 8; ++j) { const int k = 256 * j + 4 * lane; const uint2 a = *(const uint2*)(y0 + k), b = *(const uint2*)(y1 + k);
                const f32x4 gt2 = *(const LAS f32x4*)(sm + 2048 + k);
                f32x4 ysum = (f32x4){bflo(a.x) + bflo(b.x), bfhi(a.x) + bfhi(b.x), bflo(a.y) + bflo(b.y), bfhi(a.y) + bfhi(b.y)};
                v[j] = *(const f32x4*)(X + (size_t)t * D_ + k) + gt2 * ysum;
                ss += (v[j][0] * v[j][0] + v[j][1] * v[j][1]) + (v[j][2] * v[j][2] + v[j][3] * v[j][3]); }
            const float rstd = (tmo_set ? __builtin_nanf("") : 1.f) / sqrtf(wave_sum(ss, lane) * (1.f / D_) + RMS_EPS);
#pragma unroll
            for (int j = 0; j < 8; ++j) { const int k = 256 * j + 4 * lane; *(f32x4*)(X + (size_t)t * D_ + k) = v[j] * rstd * *(const LAS f32x4*)(sm + k); }
        }
    }
#undef IN
#undef BOTH
#undef GRID_BAR
#undef LOAD_MOETAB
#undef AP
#undef CTLP
#undef PH_IDS
}

extern "C" void kernel_launch(void* const* d_in, const int* in_sizes, int n_in, void* d_out, int out_size, void* d_ws, size_t ws_size, hipStream_t stream) {
    static int grid = 0;
    if (grid == 0) {
        if (n_in != 18 || out_size != S_ * D_ || ws_size < WS_END) { fprintf(stderr, "kernel_launch: unexpected shapes (n_in %d out %d ws %zu)\n", n_in, out_size, ws_size); grid = -1; return; }
        int dev = 0, cus = 0, per_cu = 0;
        if (hipGetDevice(&dev) != hipSuccess || hipDeviceGetAttribute(&cus, hipDeviceAttributeMultiprocessorCount, dev) != hipSuccess) { grid = -1; return; }
        if (hipFuncSetAttribute((const void*)mk_fwd, hipFuncAttributeMaxDynamicSharedMemorySize, LDS_BYTES) != hipSuccess) { fprintf(stderr, "kernel_launch: hipFuncSetAttribute failed\n"); grid = -1; return; }
        if (hipOccupancyMaxActiveBlocksPerMultiprocessor(&per_cu, (const void*)mk_fwd, NTHR, LDS_BYTES) != hipSuccess || per_cu < 1) { fprintf(stderr, "kernel_launch: occupancy query says %d\n", per_cu); }
        (void)hipGetLastError();
        grid = cus;
    }
    if (grid < 0) return;
    if (hipMemsetAsync((char*)d_ws + WS_CTL, 0, CTL_ZERO_BYTES, stream) != hipSuccess) return;
    Args a{};
    for (int i = 0; i < 18; ++i) a.in[i] = (const float*)d_in[i];
    a.out = (float*)d_out; a.ws = (unsigned char*)d_ws; a.pad = 0;
    if (MK_N_LAUNCHES == 1) {
        a.ph_lo = 0; a.ph_hi = NPH; a.li = 0;
        hipLaunchKernelGGL(mk_fwd, dim3(grid), dim3(NTHR), LDS_BYTES, stream, a);
    } else {
        for (int p = 0; p < NPH; ++p) { a.ph_lo = p; a.ph_hi = p + 1; a.li = p; hipLaunchKernelGGL(mk_fwd, dim3(grid), dim3(NTHR), LDS_BYTES, stream, a); }
    }
}
```
